# Optimizing an MI355X kernel written in HIP

```python
import math
import jax
import jax.numpy as jnp
from jax import lax
import numpy as np

D_MODEL = 1024
BATCH = 16
SEQ = 2048
DEPTH = 2

ROPE_THETA = 10000.0
NORM_EPS = 1e-6
Q_BLOCK = 128

MOBA_HEADS = 8
MOBA_HEAD_DIM = 64
MOBA_WIDTH = MOBA_HEADS * MOBA_HEAD_DIM
MOBA_BLOCK = 256
MOBA_TOPK = 3

SSD_HEADS = 8
SSD_HEAD_DIM = 64
SSD_INNER = SSD_HEADS * SSD_HEAD_DIM
SSD_GROUPS = 2
SSD_STATE = 128
SSD_CONV = 4
SSD_CHUNK = 128
SSD_XBC = SSD_INNER + 2 * SSD_GROUPS * SSD_STATE

EVEN_IN = 3 * MOBA_WIDTH + SSD_INNER + SSD_XBC + SSD_HEADS
EVEN_MIX = MOBA_WIDTH + SSD_INNER

MLA_HEADS = 16
MLA_NOPE = 64
MLA_ROPE = 32
MLA_QK = MLA_NOPE + MLA_ROPE
MLA_V = 64
MLA_Q_RANK = 512
MLA_KV_RANK = 256
MLA_IN = MLA_Q_RANK + MLA_KV_RANK + MLA_ROPE

D_FF = 2816
FFN_CONV = 3

kernel_name = "hybrid_moba_ssd_mla_convffn"


def rms_norm(x, g):
    xf = x.astype(jnp.float32)
    y = xf * lax.rsqrt(jnp.mean(xf * xf, axis=-1, keepdims=True) + NORM_EPS)
    return (y * g.astype(jnp.float32)).astype(x.dtype)


def apply_rope(x):
    d = x.shape[-1]
    inv_freq = 1.0 / (ROPE_THETA ** (jnp.arange(0, d, 2, dtype=jnp.float32) / d))
    ang = jnp.arange(x.shape[1], dtype=jnp.float32)[:, None] * inv_freq[None, :]
    cos = jnp.cos(ang)[None, :, None, :]
    sin = jnp.sin(ang)[None, :, None, :]
    xf = x.astype(jnp.float32)
    x1, x2 = xf[..., : d // 2], xf[..., d // 2:]
    return jnp.concatenate([x1 * cos - x2 * sin, x1 * sin + x2 * cos], axis=-1).astype(x.dtype)


def causal_dwconv(x, w, b):
    K = w.shape[0]
    S = x.shape[1]
    xp = jnp.pad(x, ((0, 0), (K - 1, 0), (0, 0)))
    y = b
    for k in range(K):
        y = y + xp[:, k:k + S] * w[k]
    return y


def moba_attention(q, k, v):
    bsz, S, H, dh = q.shape
    scale = dh ** -0.5
    n_blk = -(-S // MOBA_BLOCK)
    pad = n_blk * MOBA_BLOCK - S
    n_sel = min(MOBA_TOPK, n_blk)
    nqb = S // Q_BLOCK
    padw = ((0, 0), (0, pad), (0, 0), (0, 0))
    kb = jnp.pad(k, padw).reshape(bsz, n_blk, MOBA_BLOCK, H, dh).transpose(0, 3, 1, 2, 4)
    vb = jnp.pad(v, padw).reshape(bsz, n_blk, MOBA_BLOCK, H, dh).transpose(0, 3, 1, 2, 4)
    qt = q.transpose(0, 2, 1, 3)
    k_mean = jnp.mean(kb.astype(jnp.float32), axis=3)
    gate = jnp.einsum("bhsd,bhnd->bhsn", qt.astype(jnp.float32), k_mean)
    own = jnp.arange(S) // MOBA_BLOCK
    fully_past = jnp.arange(n_blk)[None, :] < own[:, None]
    gate = jnp.where(fully_past, gate, -jnp.inf)
    _, sel = lax.top_k(gate, n_sel)
    sel_ok = sel < own[None, None, :, None]

    def to_qblocks(t):
        t = t.reshape(bsz, H, nqb, Q_BLOCK, t.shape[-1]).transpose(0, 2, 1, 3, 4)
        return t.reshape(bsz * nqb, H, Q_BLOCK, t.shape[-1])

    b_ids = jnp.repeat(jnp.arange(bsz), nqb)
    j_ids = jnp.tile(jnp.arange(nqb), bsz)
    heads = jnp.arange(H)[:, None, None]
    blk_pos = jnp.arange(MOBA_BLOCK)
    q_off = jnp.arange(Q_BLOCK)

    def one_block(args):
        qi, idx, ok, b, j = args
        k_b = kb[b]
        v_b = vb[b]
        k_sel = k_b[heads, idx]
        v_sel = v_b[heads, idx]
        own_j = (j * Q_BLOCK) // MOBA_BLOCK
        k_own = lax.dynamic_index_in_dim(k_b, own_j, axis=1, keepdims=False)
        v_own = lax.dynamic_index_in_dim(v_b, own_j, axis=1, keepdims=False)
        s_sel = jnp.einsum("hqd,hqnld->hqnl", qi, k_sel, preferred_element_type=jnp.float32) * scale
        s_sel = jnp.where(ok[..., None], s_sel, -jnp.inf).reshape(H, Q_BLOCK, n_sel * MOBA_BLOCK)
        s_own = jnp.einsum("hqd,hld->hql", qi, k_own, preferred_element_type=jnp.float32) * scale
        causal = (own_j * MOBA_BLOCK + blk_pos)[None, :] <= (j * Q_BLOCK + q_off)[:, None]
        s_own = jnp.where(causal[None], s_own, -jnp.inf)
        p = jax.nn.softmax(jnp.concatenate([s_sel, s_own], axis=-1), axis=-1).astype(v.dtype)
        p_sel = p[..., : n_sel * MOBA_BLOCK].reshape(H, Q_BLOCK, n_sel, MOBA_BLOCK)
        p_own = p[..., n_sel * MOBA_BLOCK:]
        return jnp.einsum("hqnl,hqnld->hqd", p_sel, v_sel) + jnp.einsum("hql,hld->hqd", p_own, v_own)

    out = lax.map(one_block, (to_qblocks(qt), to_qblocks(sel), to_qblocks(sel_ok), b_ids, j_ids))
    out = out.reshape(bsz, nqb, H, Q_BLOCK, dh).transpose(0, 1, 3, 2, 4)
    return out.reshape(bsz, S, H, dh)


def segsum(a):
    T = a.shape[-1]
    rep = jnp.broadcast_to(a[..., :, None], a.shape + (T,))
    rep = jnp.where(jnp.tril(jnp.ones((T, T), dtype=bool), -1), rep, 0.0)
    ss = jnp.cumsum(rep, axis=-2)
    return jnp.where(jnp.tril(jnp.ones((T, T), dtype=bool)), ss, -jnp.inf)


def ssd_chunked(x, dt, A, Bm, Cm):
    bsz, S, H, P = x.shape
    G, N = Bm.shape[-2], Bm.shape[-1]
    E = H // G
    Q = SSD_CHUNK
    nc = S // Q
    xd = (x * dt[..., None]).reshape(bsz, nc, Q, G, E, P)
    a = (dt * A).reshape(bsz, nc, Q, G, E).transpose(0, 3, 4, 1, 2)
    Bc = Bm.reshape(bsz, nc, Q, G, N)
    Cc = Cm.reshape(bsz, nc, Q, G, N)
    a_cs = jnp.cumsum(a, axis=-1)
    L = jnp.exp(segsum(a))
    CB = jnp.einsum("bclgn,bcsgn->bgcls", Cc, Bc)
    y_diag = jnp.einsum("bgecls,bcsgep->bclgep", CB[:, :, None] * L, xd)
    decay_to_end = jnp.exp(a_cs[..., -1:] - a_cs).transpose(0, 3, 4, 1, 2)
    states = jnp.einsum("bclgn,bclgep->bcgepn", Bc, xd * decay_to_end[..., None])
    chunk_decay = jnp.exp(a_cs[..., -1]).transpose(3, 0, 1, 2)

    def carry_state(h, inp):
        s_c, d_c = inp
        return h * d_c[..., None, None] + s_c, h

    h0 = jnp.zeros((bsz, G, E, P, N), x.dtype)
    _, h_in = lax.scan(carry_state, h0, (states.transpose(1, 0, 2, 3, 4, 5), chunk_decay))
    decay_from_start = jnp.exp(a_cs).transpose(0, 3, 4, 1, 2)
    y_off = jnp.einsum("bclgn,cbgepn->bclgep", Cc, h_in) * decay_from_start[..., None]
    return (y_diag + y_off).reshape(bsz, S, H, P)


def moba_ssd_mixer(h, w_in, conv_w, conv_b, dt_bias, a_log, d_skip, ssd_norm, q_norm, k_norm, w_out):
    bsz, S, _ = h.shape
    proj = h @ w_in
    cuts = [MOBA_WIDTH, 2 * MOBA_WIDTH, 3 * MOBA_WIDTH, 3 * MOBA_WIDTH + SSD_INNER,
            3 * MOBA_WIDTH + SSD_INNER + SSD_XBC]
    q, k, v, z, xbc, dt = jnp.split(proj, cuts, axis=-1)
    hs = (bsz, S, MOBA_HEADS, MOBA_HEAD_DIM)
    q = apply_rope(rms_norm(q.reshape(hs), q_norm))
    k = apply_rope(rms_norm(k.reshape(hs), k_norm))
    o_attn = moba_attention(q, k, v.reshape(hs)).reshape(bsz, S, MOBA_WIDTH)
    xbc = jax.nn.silu(causal_dwconv(xbc, conv_w, conv_b))
    xs, Bm, Cm = jnp.split(xbc, [SSD_INNER, SSD_INNER + SSD_GROUPS * SSD_STATE], axis=-1)
    f32 = jnp.float32
    xs = xs.reshape(bsz, S, SSD_HEADS, SSD_HEAD_DIM).astype(f32)
    dt = jax.nn.softplus(dt.astype(f32) + dt_bias.astype(f32))
    A = -jnp.exp(a_log.astype(f32))
    y = ssd_chunked(xs, dt, A,
                    Bm.reshape(bsz, S, SSD_GROUPS, SSD_STATE).astype(f32),
                    Cm.reshape(bsz, S, SSD_GROUPS, SSD_STATE).astype(f32))
    y = y + d_skip.astype(f32)[:, None] * xs
    y = y.reshape(bsz, S, SSD_INNER).astype(h.dtype) * jax.nn.silu(z)
    gs = SSD_INNER // SSD_GROUPS
    y = rms_norm(y.reshape(bsz, S, SSD_GROUPS, gs), ssd_norm.reshape(SSD_GROUPS, gs)).reshape(bsz, S, SSD_INNER)
    return jnp.concatenate([o_attn, y], axis=-1) @ w_out


def causal_attention(q, k, v):
    bsz, S, H, dq = q.shape
    dv = v.shape[-1]
    scale = dq ** -0.5
    nqb = S // Q_BLOCK
    qb = q.reshape(bsz, nqb, Q_BLOCK, H, dq).transpose(1, 0, 2, 3, 4)
    kpos = jnp.arange(S)
    q_off = jnp.arange(Q_BLOCK)

    def one_block(args):
        qi, j = args
        s = jnp.einsum("bqhd,bkhd->bhqk", qi, k, preferred_element_type=jnp.float32) * scale
        mask = kpos[None, :] <= (j * Q_BLOCK + q_off)[:, None]
        p = jax.nn.softmax(jnp.where(mask, s, -jnp.inf), axis=-1).astype(v.dtype)
        return jnp.einsum("bhqk,bkhd->bqhd", p, v)

    o = lax.map(one_block, (qb, jnp.arange(nqb)))
    return o.transpose(1, 0, 2, 3, 4).reshape(bsz, S, H, dv)


def mla_mixer(h, w_in, q_a_norm, w_uq, kv_a_norm, w_ukv, q_norm, k_norm, w_out):
    bsz, S, _ = h.shape
    c = h @ w_in
    cq, ckv, k_pe = jnp.split(c, [MLA_Q_RANK, MLA_Q_RANK + MLA_KV_RANK], axis=-1)
    q = (rms_norm(cq, q_a_norm) @ w_uq).reshape(bsz, S, MLA_HEADS, MLA_QK)
    kv = (rms_norm(ckv, kv_a_norm) @ w_ukv).reshape(bsz, S, MLA_HEADS, MLA_NOPE + MLA_V)
    k_nope, v = kv[..., :MLA_NOPE], kv[..., MLA_NOPE:]
    k_pe = jnp.broadcast_to(k_pe[:, :, None, :], (bsz, S, MLA_HEADS, MLA_ROPE))
    k = jnp.concatenate([k_nope, k_pe], axis=-1)
    q = rms_norm(q, q_norm)
    k = rms_norm(k, k_norm)
    q = jnp.concatenate([q[..., :MLA_NOPE], apply_rope(q[..., MLA_NOPE:])], axis=-1)
    k = jnp.concatenate([k[..., :MLA_NOPE], apply_rope(k[..., MLA_NOPE:])], axis=-1)
    o = causal_attention(q, k, v)
    return o.reshape(bsz, S, MLA_HEADS * MLA_V) @ w_out


def conv_ffn(h, w_up, conv_w, conv_b, w_down):
    u = causal_dwconv(h @ w_up, conv_w, conv_b)
    g, u = jnp.split(u, 2, axis=-1)
    return (jax.nn.silu(g) * u) @ w_down


def setup_inputs(seed: int = 0) -> dict:
    key = jax.random.key(seed)
    ks = iter(jax.random.split(key, 32))
    f32 = jnp.float32
    n_even = (DEPTH + 1) // 2
    n_odd = DEPTH // 2

    def w(shape, fan_in):
        return jax.random.normal(next(ks), shape, f32) * fan_in ** -0.5

    def gain(shape):
        return 1.0 + 0.05 * jax.random.normal(next(ks), shape, f32)

    def bias(shape):
        return 0.02 * jax.random.normal(next(ks), shape, f32)

    x = jax.random.normal(next(ks), (BATCH, SEQ, D_MODEL), f32)
    mix_norm = gain((DEPTH, D_MODEL))
    ffn_norm = gain((DEPTH, D_MODEL))
    ev_w_in = w((n_even, D_MODEL, EVEN_IN), D_MODEL)
    ev_conv_w = w((n_even, SSD_CONV, SSD_XBC), SSD_CONV)
    ev_conv_b = bias((n_even, SSD_XBC))
    dt0 = jnp.exp(jax.random.uniform(next(ks), (n_even, SSD_HEADS), f32,
                                     minval=math.log(1e-3), maxval=math.log(1e-1)))
    ev_dt_bias = dt0 + jnp.log(-jnp.expm1(-dt0))
    ev_a_log = jnp.log(jax.random.uniform(next(ks), (n_even, SSD_HEADS), f32, minval=1.0, maxval=16.0))
    ev_d_skip = gain((n_even, SSD_HEADS))
    ev_ssd_norm = gain((n_even, SSD_INNER))
    ev_q_norm = gain((n_even, MOBA_HEAD_DIM))
    ev_k_norm = gain((n_even, MOBA_HEAD_DIM))
    ev_w_out = w((n_even, EVEN_MIX, D_MODEL), EVEN_MIX)
    od_w_in = w((n_odd, D_MODEL, MLA_IN), D_MODEL)
    od_q_a_norm = gain((n_odd, MLA_Q_RANK))
    od_w_uq = w((n_odd, MLA_Q_RANK, MLA_HEADS * MLA_QK), MLA_Q_RANK)
    od_kv_a_norm = gain((n_odd, MLA_KV_RANK))
    od_w_ukv = w((n_odd, MLA_KV_RANK, MLA_HEADS * (MLA_NOPE + MLA_V)), MLA_KV_RANK)
    od_q_norm = gain((n_odd, MLA_QK))
    od_k_norm = gain((n_odd, MLA_QK))
    od_w_out = w((n_odd, MLA_HEADS * MLA_V, D_MODEL), MLA_HEADS * MLA_V)
    ffn_w_up = w((DEPTH, D_MODEL, 2 * D_FF), D_MODEL)
    ffn_conv_w = w((DEPTH, FFN_CONV, 2 * D_FF), FFN_CONV)
    ffn_conv_b = bias((DEPTH, 2 * D_FF))
    ffn_w_down = w((DEPTH, D_FF, D_MODEL), D_FF)
    return {
        "x": x, "mix_norm": mix_norm, "ffn_norm": ffn_norm,
        "ev_w_in": ev_w_in, "ev_conv_w": ev_conv_w, "ev_conv_b": ev_conv_b,
        "ev_dt_bias": ev_dt_bias, "ev_a_log": ev_a_log, "ev_d_skip": ev_d_skip,
        "ev_ssd_norm": ev_ssd_norm, "ev_q_norm": ev_q_norm, "ev_k_norm": ev_k_norm,
        "ev_w_out": ev_w_out,
        "od_w_in": od_w_in, "od_q_a_norm": od_q_a_norm, "od_w_uq": od_w_uq,
        "od_kv_a_norm": od_kv_a_norm, "od_w_ukv": od_w_ukv, "od_q_norm": od_q_norm,
        "od_k_norm": od_k_norm, "od_w_out": od_w_out,
        "ffn_w_up": ffn_w_up, "ffn_conv_w": ffn_conv_w, "ffn_conv_b": ffn_conv_b,
        "ffn_w_down": ffn_w_down,
    }


def reference(x, mix_norm, ffn_norm,
              ev_w_in, ev_conv_w, ev_conv_b, ev_dt_bias, ev_a_log, ev_d_skip,
              ev_ssd_norm, ev_q_norm, ev_k_norm, ev_w_out,
              od_w_in, od_q_a_norm, od_w_uq, od_kv_a_norm, od_w_ukv, od_q_norm,
              od_k_norm, od_w_out,
              ffn_w_up, ffn_conv_w, ffn_conv_b, ffn_w_down):
    for layer in range(DEPTH):
        i = layer // 2
        hn = rms_norm(x, mix_norm[layer])
        if layer % 2 == 0:
            x = x + moba_ssd_mixer(hn, ev_w_in[i], ev_conv_w[i], ev_conv_b[i], ev_dt_bias[i],
                                   ev_a_log[i], ev_d_skip[i], ev_ssd_norm[i], ev_q_norm[i],
                                   ev_k_norm[i], ev_w_out[i])
        else:
            x = x + mla_mixer(hn, od_w_in[i], od_q_a_norm[i], od_w_uq[i], od_kv_a_norm[i],
                              od_w_ukv[i], od_q_norm[i], od_k_norm[i], od_w_out[i])
        x = x + conv_ffn(rms_norm(x, ffn_norm[layer]), ffn_w_up[layer], ffn_conv_w[layer],
                         ffn_conv_b[layer], ffn_w_down[layer])
    return x
```

```cpp
#include <hip/hip_runtime.h>
#include <cstdio>
#include <cstdint>
namespace pg8 {
#define PG8_LAS __attribute__((address_space(3)))
typedef unsigned short bf16_t;
typedef short bf16x8 __attribute__((ext_vector_type(8)));
typedef float f32x4 __attribute__((ext_vector_type(4)));
typedef unsigned u32x4 __attribute__((ext_vector_type(4)));
constexpr int BM = 256, BK = 64, HALF = 128, HTB = HALF * BK * 2  , STAGE_BYTES = 8 * HTB, NXCD = 8, WGM = 8;

__host__ __device__ __forceinline__ int lds_byte(int r, int c) { const int st = (r >> 4) * 2 + (c >> 5), rr = r & 15, cc = c & 31, ob = rr * 64 + cc * 2; return st * 1024 + (ob ^ (((ob >> 9) & 1) << 5)); }
__host__ __device__ __forceinline__ void stage_rc(int b, int& R, int& C) { const int st = b / 1024, sb = b % 1024, swz = sb ^ (((sb >> 9) & 1) << 5); R = (st >> 1) * 16 + swz / 64; C = (st & 1) * 32 + (swz % 64) / 2; }
__host__ __device__ __forceinline__ int perm32(int rho) { const int n = rho >> 4, i = rho & 15; return 8 * (i >> 2) + 4 * n + (i & 3); }

struct Unit { int pm, pn; };
struct Gemm { const bf16_t* A; const bf16_t* Bt; int M, N, K; };

struct StaticOrder {
    int nM, nN, nwg, G, c;
    __host__ __device__ void init(int M, int N, int G_, int c_) { nM = M / BM; nN = N / BM; nwg = nM * nN; G = G_; c = c_; }
    __host__ __device__ bool next(int i, Unit& u) const {
        const long L = (long)i * G + c; if (L >= nwg) return false;
        int wgid = (int)L; { const int q = nwg / NXCD, r = nwg % NXCD, xcd = wgid % NXCD, off = wgid / NXCD; wgid = (xcd < r ? xcd * (q + 1) : r * (q + 1) + (xcd - r) * q) + off; }
        const int nig = WGM * nN, gid = wgid / nig, fm = gid * WGM, gsz = (nM - fm) < WGM ? (nM - fm) : WGM;
        u.pm = fm + ((wgid % nig) % gsz); u.pn = (wgid % nig) / gsz; return true;
    }
    __device__ __forceinline__ void a_ready(const Unit&) const {}
    __device__ __forceinline__ void done(const Unit&) const {}
};

__device__ __forceinline__ unsigned cvt_pk_bf16(float lo, float hi) { unsigned r; asm volatile("v_cvt_pk_bf16_f32 %0, %1, %2" : "=v"(r) : "v"(lo), "v"(hi)); return r; }
typedef float f32x2 __attribute__((ext_vector_type(2)));
__device__ __forceinline__ f32x2 gelu_pk(f32x2 v) {
    const f32x2 av = __builtin_elementwise_abs(v), d = av * 0.2316418882f + 1.0f;
    f32x2 t; t.x = __builtin_amdgcn_rcpf(d.x); t.y = __builtin_amdgcn_rcpf(d.y);
    f32x2 q = t * 0.5307027145f + (-0.7265760135f); q = q * t + 0.7107068705f; q = q * t + (-0.142248368f); q = q * t + 0.127414796f; q = q * t;
    const f32x2 s = (v * v) * (-0.72134752044f);
    f32x2 e; e.x = __builtin_amdgcn_exp2f(s.x); e.y = __builtin_amdgcn_exp2f(s.y);
    const f32x2 m = v * (q * e), r = v - m;
    f32x2 o; o.x = v.x < 0.f ? m.x : r.x; o.y = v.y < 0.f ? m.y : r.y; return o;
}

template <int ACT  > struct EpiBf16 {
    static constexpr bool PERM = true, AFTER_DRAIN = false; static_assert(ACT == 0 || ACT == 1, "EpiBf16: ACT is 0 (none) or 1 (gelu_pk)");
    bf16_t* O; int ldc; const float* bias; int split_cols; size_t split_stride; float scale0;
    __device__ __forceinline__ void operator()(const f32x4 (&acc)[2][2][4][2], const Unit& u, int wr, int wc, int fr, int fq) const {
        const int row0 = u.pm * BM + wr * 64 + fr; int colt = u.pn * BM; bf16_t* base = O;
        float sc = 1.f; if (split_cols) { const int t = colt / split_cols; base += (size_t)t * split_stride; colt -= t * split_cols; if (t == 0) sc = scale0; }
        const int col0 = colt + wc * 32 + 8 * fq, bcol0 = u.pn * BM + wc * 32 + 8 * fq;
        f32x4 bv[2][2];
#pragma unroll
        for (int bj = 0; bj < 2; ++bj)
#pragma unroll
            for (int n = 0; n < 2; ++n) bv[bj][n] = bias ? *(const f32x4*)(bias + bcol0 + bj * HALF + 4 * n) : (f32x4){0.f, 0.f, 0.f, 0.f};
#pragma unroll
        for (int ai = 0; ai < 2; ++ai)
#pragma unroll
            for (int m = 0; m < 4; ++m) { bf16_t* rowp = base + (size_t)(row0 + ai * HALF + m * 16) * ldc + col0;
#pragma unroll
                for (int bj = 0; bj < 2; ++bj) { f32x4 v0 = acc[ai][bj][m][0] + bv[bj][0], v1 = acc[ai][bj][m][1] + bv[bj][1];
                    if (ACT == 1) { f32x2 a = gelu_pk((f32x2){v0[0], v0[1]}), b = gelu_pk((f32x2){v0[2], v0[3]}), c = gelu_pk((f32x2){v1[0], v1[1]}), d = gelu_pk((f32x2){v1[2], v1[3]});
                        v0 = (f32x4){a.x, a.y, b.x, b.y}; v1 = (f32x4){c.x, c.y, d.x, d.y}; }
                    v0 = v0 * sc; v1 = v1 * sc; u32x4 w; w.x = cvt_pk_bf16(v0[0], v0[1]); w.y = cvt_pk_bf16(v0[2], v0[3]); w.z = cvt_pk_bf16(v1[0], v1[1]); w.w = cvt_pk_bf16(v1[2], v1[3]);
                    *(u32x4*)(rowp + bj * HALF) = w; } }
    }
};

struct PanelStats {
    unsigned* xbuf;
    unsigned* cnt;
    unsigned* tmo;
    int ntn; float eps;
    unsigned code;
    __device__ __forceinline__ bool run(const f32x4 (&v)[2][2][4][2], const Unit& u, int wr, int wc, int fr, int fq, PG8_LAS unsigned char* lds, int wid, int lane) const {
        typedef float f32x2v __attribute__((ext_vector_type(2)));
        PG8_LAS f32x2v* P = (PG8_LAS f32x2v*)lds;
        PG8_LAS f32x2v* S = (PG8_LAS f32x2v*)(lds + 8192);
        PG8_LAS unsigned* flag = (PG8_LAS unsigned*)(lds + 8192 + 2048);
#pragma unroll
        for (int ai = 0; ai < 2; ++ai)
#pragma unroll
            for (int m = 0; m < 4; ++m) {
                float s = 0.f;
#pragma unroll
                for (int bj = 0; bj < 2; ++bj)
#pragma unroll
                    for (int n = 0; n < 2; ++n) { const f32x4 x = v[ai][bj][m][n]; s += (x[0] + x[1]) + (x[2] + x[3]); }
                s += __shfl_xor(s, 16); s += __shfl_xor(s, 32);
                const float mw = s * (1.0f / 64.0f); float q = 0.f;
#pragma unroll
                for (int bj = 0; bj < 2; ++bj)
#pragma unroll
                    for (int n = 0; n < 2; ++n) { const f32x4 d = v[ai][bj][m][n] - mw; q += (d[0] * d[0] + d[1] * d[1]) + (d[2] * d[2] + d[3] * d[3]); }
                q += __shfl_xor(q, 16); q += __shfl_xor(q, 32);
                if (fq == 0) P[(ai * HALF + wr * 64 + m * 16 + fr) * 4 + wc] = (f32x2v){mw, q};
            }
        asm volatile("s_waitcnt lgkmcnt(0)" ::: "memory"); __builtin_amdgcn_s_barrier(); asm volatile("" ::: "memory");
#if defined(BROKEN_EXCHANGE_NO_WAIT)
#warning BROKEN CONTROL BUILD: the row-statistics exchange does not wait; results are wrong by design
        if (blockIdx.x >= 64) { const long long t0_ = clock64(); while (clock64() - t0_ < 60000) __builtin_amdgcn_s_sleep(8); }
#endif
        const int row = wid * 32 + (lane & 31);
        if (lane < 32) {
            const f32x2v a = P[row * 4 + 0], b = P[row * 4 + 1], c = P[row * 4 + 2], d = P[row * 4 + 3];
            const float mt = (a.x + b.x + c.x + d.x) * 0.25f;
            const float da = a.x - mt, db = b.x - mt, dc = c.x - mt, dd = d.x - mt;
            const float m2 = (a.y + b.y) + (c.y + d.y) + 64.0f * ((da * da + db * db) + (dc * dc + dd * dd));
            unsigned long long* slot = (unsigned long long*)xbuf + ((size_t)(u.pm * BM + row) * 4 + u.pn);
            __hip_atomic_store(slot, ((unsigned long long)__float_as_uint(m2) << 32) | __float_as_uint(mt), __ATOMIC_RELAXED, __HIP_MEMORY_SCOPE_AGENT);
        }
        asm volatile("s_waitcnt vmcnt(0)" ::: "memory");
        if (lane == 0) __hip_atomic_fetch_add(cnt + 64 * u.pm, 1u, __ATOMIC_RELAXED, __HIP_MEMORY_SCOPE_AGENT);
        if (wid == 0) {
            bool dead = false; const unsigned long long t0 = __builtin_amdgcn_s_memrealtime(); const unsigned want = 8u * (unsigned)ntn;
            for (;;) {
#if defined(BROKEN_EXCHANGE_NO_WAIT)
                break;
#endif
                if ((unsigned)__builtin_amdgcn_readfirstlane(__hip_atomic_load(cnt + 64 * u.pm, __ATOMIC_RELAXED, __HIP_MEMORY_SCOPE_AGENT)) >= want) break;
                if (__builtin_amdgcn_s_memrealtime() - t0 > 2000000ull) {
                    if (lane == 0) { unsigned expect = 0u; __hip_atomic_compare_exchange_strong(tmo + 1, &expect, code | (unsigned)(u.pm & 0xff), __ATOMIC_RELAXED, __ATOMIC_RELAXED, __HIP_MEMORY_SCOPE_AGENT);
                                     __hip_atomic_store(tmo, 1u, __ATOMIC_RELAXED, __HIP_MEMORY_SCOPE_AGENT); }
                    dead = true; break; }
                __builtin_amdgcn_s_sleep(2);
            }
            __builtin_amdgcn_fence(__ATOMIC_ACQUIRE, "agent");
            if (lane == 0) flag[0] = dead ? 1u : 0u;
        }
        asm volatile("s_waitcnt vmcnt(0) lgkmcnt(0)" ::: "memory"); __builtin_amdgcn_s_barrier(); asm volatile("" ::: "memory");
        const bool bad = flag[0] != 0u;
        if (lane < 32) {
            const unsigned long long* slot = (const unsigned long long*)xbuf + (size_t)(u.pm * BM + row) * 4; float mt[4], m2[4]; float ms = 0.f;
#pragma unroll
            for (int t = 0; t < 4; ++t) { if (t < ntn) { const unsigned long long w = __hip_atomic_load(slot + t, __ATOMIC_RELAXED, __HIP_MEMORY_SCOPE_AGENT); mt[t] = __uint_as_float((unsigned)w); m2[t] = __uint_as_float((unsigned)(w >> 32)); } else { mt[t] = 0.f; m2[t] = 0.f; } ms += mt[t]; }
            const float mean = ms / (float)ntn; float q = 0.f;
#pragma unroll
            for (int t = 0; t < 4; ++t) if (t < ntn) { const float dm = mt[t] - mean; q += m2[t] + 256.0f * dm * dm; }
            S[row] = (f32x2v){mean, 1.0f / sqrtf(q / (256.0f * (float)ntn) + eps)};
        }
        asm volatile("s_waitcnt lgkmcnt(0)" ::: "memory"); __builtin_amdgcn_s_barrier(); asm volatile("" ::: "memory");
        return bad;
    }
};
struct EpiLnRes {
    static constexpr bool PERM = false, AFTER_DRAIN = true;
    const float* base; float* out; int ldc; const float* bias; PanelStats st; unsigned poison;
    __device__ __forceinline__ void fused(f32x4 (&acc)[2][2][4][2], const Unit& u, int wr, int wc, int fr, int fq, PG8_LAS unsigned char* lds, int wid, int lane) const {
        typedef float f32x2v __attribute__((ext_vector_type(2)));
        const PG8_LAS f32x2v* S = (const PG8_LAS f32x2v*)(lds + 8192);
        const int col0 = u.pn * BM + wc * 32 + 4 * fq;
#pragma unroll
        for (int bj = 0; bj < 2; ++bj)
#pragma unroll
            for (int n = 0; n < 2; ++n) { const f32x4 bv = bias ? *(const f32x4*)(bias + col0 + bj * HALF + n * 16) : (f32x4){0.f, 0.f, 0.f, 0.f};
#pragma unroll
                for (int ai = 0; ai < 2; ++ai)
#pragma unroll
                    for (int m = 0; m < 4; ++m) acc[ai][bj][m][n] += bv; }
        f32x4 pre[4][2][2];
#pragma unroll
        for (int m = 0; m < 4; ++m) { const size_t off = (size_t)(u.pm * BM + wr * 64 + m * 16 + fr) * ldc + col0;
#pragma unroll
            for (int bj = 0; bj < 2; ++bj)
#pragma unroll
                for (int n = 0; n < 2; ++n) pre[m][bj][n] = *(const f32x4*)(base + off + bj * HALF + n * 16); }
        const bool bad = st.run(acc, u, wr, wc, fr, fq, lds, wid, lane) || poison != 0u;
        const float qnan = __builtin_nanf("");
#pragma unroll
        for (int ai = 0; ai < 2; ++ai)
#pragma unroll
            for (int m = 0; m < 4; ++m) { const int r = ai * HALF + wr * 64 + m * 16 + fr; const f32x2v sr = S[r]; const size_t off = (size_t)(u.pm * BM + r) * ldc + col0;
#pragma unroll
                for (int bj = 0; bj < 2; ++bj)
#pragma unroll
                    for (int n = 0; n < 2; ++n) { const f32x4 bs = ai == 0 ? pre[m][bj][n] : *(const f32x4*)(base + off + bj * HALF + n * 16); f32x4 o = bs + (acc[ai][bj][m][n] - sr.x) * sr.y;
                        if (bad) o = (f32x4){qnan, qnan, qnan, qnan}; *(f32x4*)(out + off + bj * HALF + n * 16) = o; }
                if (m & 1) asm volatile("" ::: "memory"); }
    }
};
struct EpiLnResLn {
    static constexpr bool PERM = false, AFTER_DRAIN = true;
    const float* base; float* out; bf16_t* xn; int ldc; const float* bias; PanelStats st1, st2; unsigned poison;
    __device__ __forceinline__ void fused(f32x4 (&acc)[2][2][4][2], const Unit& u, int wr, int wc, int fr, int fq, PG8_LAS unsigned char* lds, int wid, int lane) const {
        typedef float f32x2v __attribute__((ext_vector_type(2))); typedef unsigned u32x2v __attribute__((ext_vector_type(2)));
        const PG8_LAS f32x2v* S = (const PG8_LAS f32x2v*)(lds + 8192);
        const int col0 = u.pn * BM + wc * 32 + 4 * fq;
#pragma unroll
        for (int bj = 0; bj < 2; ++bj)
#pragma unroll
            for (int n = 0; n < 2; ++n) { const f32x4 bv = bias ? *(const f32x4*)(bias + col0 + bj * HALF + n * 16) : (f32x4){0.f, 0.f, 0.f, 0.f};
#pragma unroll
                for (int ai = 0; ai < 2; ++ai)
#pragma unroll
                    for (int m = 0; m < 4; ++m) acc[ai][bj][m][n] += bv; }
        bool bad = st1.run(acc, u, wr, wc, fr, fq, lds, wid, lane) || poison != 0u;
        const float qnan = __builtin_nanf("");
#pragma unroll
        for (int ai = 0; ai < 2; ++ai)
#pragma unroll
            for (int m = 0; m < 4; ++m) { const int r = ai * HALF + wr * 64 + m * 16 + fr; const f32x2v sr = S[r]; const size_t off = (size_t)(u.pm * BM + r) * ldc + col0;
#pragma unroll
                for (int bj = 0; bj < 2; ++bj)
#pragma unroll
                    for (int n = 0; n < 2; ++n) { const f32x4 bs = *(const f32x4*)(base + off + bj * HALF + n * 16); acc[ai][bj][m][n] = bs + (acc[ai][bj][m][n] - sr.x) * sr.y; }
                asm volatile("" : "+v"(acc[ai][0][m][0]), "+v"(acc[ai][0][m][1]), "+v"(acc[ai][1][m][0]), "+v"(acc[ai][1][m][1]));
                if (m & 1) asm volatile("" ::: "memory"); }
        const bool bad1 = bad;
        bad = st2.run(acc, u, wr, wc, fr, fq, lds, wid, lane) || bad;
#pragma unroll
        for (int ai = 0; ai < 2; ++ai)
#pragma unroll
            for (int m = 0; m < 4; ++m) { const int r = ai * HALF + wr * 64 + m * 16 + fr; const f32x2v sr = S[r]; const size_t off = (size_t)(u.pm * BM + r) * ldc + col0;
#pragma unroll
                for (int bj = 0; bj < 2; ++bj)
#pragma unroll
                    for (int n = 0; n < 2; ++n) { const f32x4 x1 = acc[ai][bj][m][n]; *(f32x4*)(out + off + bj * HALF + n * 16) = bad1 ? (f32x4){qnan, qnan, qnan, qnan} : x1;
                        const f32x4 o = (x1 - sr.x) * sr.y; u32x2v w; w.x = cvt_pk_bf16(o[0], o[1]); w.y = cvt_pk_bf16(o[2], o[3]);
                        if (bad) { w.x = 0x7fc07fc0u; w.y = 0x7fc07fc0u; } *(u32x2v*)(xn + off + bj * HALF + n * 16) = w; }
                asm volatile("" ::: "memory"); }
    }
};

template <class Epi, class Sched, bool ALIGN_EPI = false, bool SP2 = false>
__device__ __forceinline__ void gemm_phase(PG8_LAS unsigned char* lds, const Gemm g, const Sched& S, const Epi& E) {
    int tid_ = threadIdx.x; asm volatile("" : "+v"(tid_));
    const int tid = tid_, wid = __builtin_amdgcn_readfirstlane(tid >> 6), lane = tid & 63, wr = wid >> 2, wc = wid & 3, fr = lane & 15, fq = lane >> 4;
    const int K = g.K, nt = K / BK;
    unsigned voffA[2], voffB[2];
#pragma unroll
    for (int i = 0; i < 2; ++i) { int R, C; stage_rc(tid * 16 + i * 8192, R, C); const int Rb = Epi::PERM ? ((R & ~31) + perm32(R & 31)) : R;
        voffA[i] = (unsigned)(R * K + C) * 2u; voffB[i] = (unsigned)(Rb * K + C) * 2u; }
    const size_t kstep = (size_t)(BK * 2);
    const size_t hstep = (size_t)HALF * K * 2;
    const size_t tstep = 2 * hstep;
    const unsigned ldsw = (unsigned)wid * 1024u;
    const int aoff = lds_byte(wr * 64 + fr, fq * 8), boff = lds_byte(wc * 32 + fr, fq * 8);
#define PG8_SA(b, h) (((b) * 2 + (h)) * HTB)
#define PG8_SB(b, h) ((4 + (b) * 2 + (h)) * HTB)
#define PG8_STAGE(bufoff, gbase, voff) do { _Pragma("unroll") for (int _i = 0; _i < 2; ++_i) \
        __builtin_amdgcn_global_load_lds((const unsigned*)((const char*)(gbase) + (voff)[_i]), (PG8_LAS unsigned*)(lds + (bufoff) + ldsw + _i * 8192), 16, 0, 0); } while (0)
#define PG8_LDA(dst, b, h) do { _Pragma("unroll") for (int m = 0; m < 4; ++m) _Pragma("unroll") for (int k = 0; k < 2; ++k) dst[m][k] = *(const PG8_LAS bf16x8*)(lds + PG8_SA(b, h) + aoff + m * 2048 + k * 1024); } while (0)
#define PG8_LDB(dst, b, h) do { _Pragma("unroll") for (int n = 0; n < 2; ++n) _Pragma("unroll") for (int k = 0; k < 2; ++k) dst[n][k] = *(const PG8_LAS bf16x8*)(lds + PG8_SB(b, h) + boff + n * 2048 + k * 1024); } while (0)
#define PG8_MMA(ai, bj, At, Bt) do { __builtin_amdgcn_s_setprio(1); _Pragma("unroll") for (int m = 0; m < 4; ++m) _Pragma("unroll") for (int n = 0; n < 2; ++n) _Pragma("unroll") for (int k = 0; k < 2; ++k) \
        acc[ai][bj][m][n] = __builtin_amdgcn_mfma_f32_16x16x32_bf16(Bt[n][k], At[m][k], acc[ai][bj][m][n], 0, 0, 0); __builtin_amdgcn_s_setprio(0); } while (0)
#define PG8_WAIT_V(n) asm volatile("s_waitcnt vmcnt(" #n ")" ::: "memory")
#define PG8_WAIT_L(n) asm volatile("s_waitcnt lgkmcnt(" #n ")" ::: "memory")
#define PG8_BAR __builtin_amdgcn_s_barrier()
#define PG8_SCHED __builtin_amdgcn_sched_barrier(0)
    Unit cur, nxt; int ui = 0;
    if (!S.next(0, cur)) return;
    f32x4 acc[2][2][4][2];
#pragma unroll
    for (int a = 0; a < 2; ++a)
#pragma unroll
        for (int b = 0; b < 2; ++b)
#pragma unroll
            for (int m = 0; m < 4; ++m)
#pragma unroll
                for (int n = 0; n < 2; ++n) acc[a][b][m][n] = (f32x4){0.f, 0.f, 0.f, 0.f};
    bf16x8 At[4][2], B0[2][2], B1[2][2];
    const char* cA = (const char*)g.A + (size_t)cur.pm * tstep; const char* cB = (const char*)g.Bt + (size_t)cur.pn * tstep;
    S.a_ready(cur);
    if constexpr (SP2) {
        PG8_STAGE(PG8_SB(0, 0), cB, voffB); PG8_STAGE(PG8_SB(0, 1), cB + hstep, voffB); PG8_STAGE(PG8_SA(0, 0), cA, voffA); PG8_STAGE(PG8_SA(0, 1), cA + hstep, voffA);
        if (wr == 1) PG8_BAR;
        PG8_WAIT_V(2); PG8_BAR;
        PG8_STAGE(PG8_SB(1, 0), cB + kstep, voffB); PG8_STAGE(PG8_SA(1, 0), cA + kstep, voffA); PG8_STAGE(PG8_SB(1, 1), cB + hstep + kstep, voffB);
        PG8_WAIT_V(6); PG8_BAR;
    } else {
        PG8_STAGE(PG8_SB(0, 0), cB, voffB); PG8_STAGE(PG8_SA(0, 0), cA, voffA); PG8_STAGE(PG8_SB(0, 1), cB + hstep, voffB); PG8_STAGE(PG8_SA(0, 1), cA + hstep, voffA);
        if (wr == 1) PG8_BAR;
        PG8_WAIT_V(4); PG8_BAR;
        PG8_STAGE(PG8_SB(1, 0), cB + kstep, voffB); PG8_STAGE(PG8_SA(1, 0), cA + kstep, voffA); PG8_STAGE(PG8_SB(1, 1), cB + hstep + kstep, voffB);
        PG8_WAIT_V(6); PG8_BAR;
    }
    for (;;) {
        const bool has_next = S.next(ui + 1, nxt);
        const char* nA = has_next ? (const char*)g.A + (size_t)nxt.pm * tstep : cA; const char* nB = has_next ? (const char*)g.Bt + (size_t)nxt.pn * tstep : cB;
        for (int t = 0; t < nt; t += 2) {
            const bool last = (t == nt - 2);
            const char* a1 = cA + (size_t)(t + 1) * kstep;
            const char* a2 = last ? nA : cA + (size_t)(t + 2) * kstep; const char* b2 = last ? nB : cB + (size_t)(t + 2) * kstep;
            const char* a3 = a2 + kstep; const char* b3 = b2 + kstep;
            if (last && has_next) S.a_ready(nxt);
            if constexpr (SP2) {
            PG8_LDB(B0, 0, 0); PG8_LDB(B1, 0, 1); PG8_SCHED; PG8_LDA(At, 0, 0); PG8_STAGE(PG8_SA(1, 1), a1 + hstep, voffA);
            PG8_WAIT_V(8); PG8_WAIT_L(0); PG8_BAR; PG8_MMA(0, 0, At, B0); PG8_MMA(0, 1, At, B1); PG8_BAR; PG8_SCHED;
            PG8_LDA(At, 0, 1); PG8_STAGE(PG8_SB(0, 0), b2, voffB); PG8_STAGE(PG8_SB(0, 1), b2 + hstep, voffB); PG8_STAGE(PG8_SA(0, 0), a2, voffA);
            PG8_WAIT_V(8); PG8_WAIT_L(0); PG8_BAR; PG8_MMA(1, 0, At, B0); PG8_MMA(1, 1, At, B1); PG8_BAR; PG8_SCHED;
            PG8_LDB(B0, 1, 0); PG8_LDB(B1, 1, 1); PG8_SCHED; PG8_LDA(At, 1, 0); PG8_STAGE(PG8_SA(0, 1), a2 + hstep, voffA);
            PG8_WAIT_V(8); PG8_WAIT_L(0); PG8_BAR; PG8_MMA(0, 0, At, B0); PG8_MMA(0, 1, At, B1); PG8_BAR; PG8_SCHED;
            PG8_LDA(At, 1, 1); PG8_STAGE(PG8_SB(1, 0), b3, voffB); PG8_STAGE(PG8_SB(1, 1), b3 + hstep, voffB); PG8_STAGE(PG8_SA(1, 0), a3, voffA);
            PG8_WAIT_V(8); PG8_WAIT_L(0); PG8_BAR; PG8_MMA(1, 0, At, B0); PG8_MMA(1, 1, At, B1); PG8_BAR; PG8_SCHED;
            } else {
            PG8_LDB(B0, 0, 0); PG8_SCHED; PG8_LDA(At, 0, 0); PG8_STAGE(PG8_SA(1, 1), a1 + hstep, voffA);
            PG8_WAIT_L(8); PG8_BAR; PG8_WAIT_L(0); PG8_MMA(0, 0, At, B0); PG8_BAR; PG8_SCHED;
            PG8_LDB(B1, 0, 1); PG8_STAGE(PG8_SB(0, 0), b2, voffB);
            PG8_BAR; PG8_WAIT_L(0); PG8_MMA(0, 1, At, B1); PG8_BAR;
            PG8_LDA(At, 0, 1); PG8_STAGE(PG8_SA(0, 0), a2, voffA);
            PG8_BAR; PG8_WAIT_L(0); PG8_MMA(1, 0, At, B0); PG8_BAR; PG8_SCHED;
            PG8_STAGE(PG8_SB(0, 1), b2 + hstep, voffB);
            PG8_WAIT_V(6); PG8_BAR; PG8_MMA(1, 1, At, B1); PG8_BAR;
            PG8_LDB(B0, 1, 0); PG8_SCHED; PG8_LDA(At, 1, 0); PG8_STAGE(PG8_SA(0, 1), a2 + hstep, voffA);
            PG8_WAIT_L(8); PG8_BAR; PG8_WAIT_L(0); PG8_MMA(0, 0, At, B0); PG8_BAR; PG8_SCHED;
            PG8_LDB(B1, 1, 1); PG8_STAGE(PG8_SB(1, 0), b3, voffB);
            PG8_BAR; PG8_WAIT_L(0); PG8_MMA(0, 1, At, B1); PG8_BAR;
            PG8_LDA(At, 1, 1); PG8_STAGE(PG8_SA(1, 0), a3, voffA);
            PG8_BAR; PG8_WAIT_L(0); PG8_MMA(1, 0, At, B0); PG8_BAR; PG8_SCHED;
            PG8_STAGE(PG8_SB(1, 1), b3 + hstep, voffB);
            PG8_WAIT_V(6); PG8_BAR; PG8_MMA(1, 1, At, B1); PG8_BAR;
            }
        }
        if constexpr (ALIGN_EPI) { if (wr == 0) PG8_BAR; }
        if constexpr (!Epi::AFTER_DRAIN) { E(acc, cur, wr, wc, fr, fq); S.done(cur); }
        if (!has_next) break;
#pragma unroll
        for (int a = 0; a < 2; ++a)
#pragma unroll
            for (int b = 0; b < 2; ++b)
#pragma unroll
                for (int m = 0; m < 4; ++m)
#pragma unroll
                    for (int n = 0; n < 2; ++n) acc[a][b][m][n] = (f32x4){0.f, 0.f, 0.f, 0.f};
        cur = nxt; cA = nA; cB = nB; ++ui;
        if constexpr (ALIGN_EPI) { if (wr == 1) PG8_BAR; }
    }
    PG8_WAIT_V(0);
    if constexpr (!ALIGN_EPI) { if (wr == 0) PG8_BAR; }
    PG8_BAR;
    if constexpr (Epi::AFTER_DRAIN) { E.fused(acc, cur, wr, wc, fr, fq, lds, wid, lane); S.done(cur); }
#undef PG8_SA
#undef PG8_SB
#undef PG8_STAGE
#undef PG8_LDA
#undef PG8_LDB
#undef PG8_MMA
#undef PG8_WAIT_V
#undef PG8_WAIT_L
#undef PG8_BAR
#undef PG8_SCHED
}
}

#ifndef PG8_SP2
#define PG8_SP2 true
#endif
#ifndef PG8_ALIGN
#define PG8_ALIGN true
#endif
#define GAS __attribute__((address_space(1)))
#define LAS __attribute__((address_space(3)))
typedef unsigned short bf16;
typedef unsigned v4u __attribute__((ext_vector_type(4)));
typedef float f32x4 __attribute__((ext_vector_type(4)));
typedef short bf16x8 __attribute__((ext_vector_type(8)));
typedef GAS unsigned gu32;
typedef GAS unsigned long long gu64;
#define RLX_AGENT __ATOMIC_RELAXED, __HIP_MEMORY_SCOPE_AGENT
#define LDS_WAIT() asm volatile("s_waitcnt lgkmcnt(0)" ::: "memory")
#define VM_WAIT() asm volatile("s_waitcnt vmcnt(0)" ::: "memory")
__device__ __forceinline__ unsigned long long rt() { return __builtin_amdgcn_s_memrealtime(); }
__device__ __forceinline__ unsigned f2bf(float f) { unsigned u = __builtin_bit_cast(unsigned, f); return (u + 0x7fffu + ((u >> 16) & 1u)) >> 16; }
__device__ __forceinline__ unsigned pk2(float lo, float hi) { return f2bf(lo) | (f2bf(hi) << 16); }

#define XB_TMO      128
#define XB_XCNT(j)  (256  + 64 * (j))
#define XB_XSUB(j)  (1280 + 64 * (j))
#define XB_XGEN(j)  (2304 + 64 * (j))
#define XB_TOP      3328
#define XB_TOPGEN   3392
#define XCD_BAR_WORDS 3456
#define XB_SPIN_CAP (1u << 18)

__device__ __forceinline__ unsigned xb_ld(unsigned* p)              { return __hip_atomic_load(p, __ATOMIC_RELAXED, __HIP_MEMORY_SCOPE_AGENT); }
__device__ __forceinline__ unsigned xb_add(unsigned* p, unsigned v) { return __hip_atomic_fetch_add(p, v, __ATOMIC_RELAXED, __HIP_MEMORY_SCOPE_AGENT); }
__device__ __forceinline__ unsigned xb_xcc_id() { return (unsigned)__builtin_amdgcn_s_getreg((3 << 11) | 20) & 0xFu; }
#define XB_SPIN(cond, bar) do { unsigned _sp = 0; while (cond) { __builtin_amdgcn_s_sleep(1); \
    if ((++_sp & 255u) == 0u) { if (xb_ld(&(bar)[XB_TMO])) break; if (_sp > XB_SPIN_CAP) { atomicAdd(&(bar)[XB_TMO], 1u); break; } } } } while (0)

struct XcdBarrier {
    unsigned* bar; unsigned x;
    volatile LAS unsigned* st;
};

__device__ __forceinline__ XcdBarrier xcd_barrier_post(unsigned* bar, volatile LAS unsigned* st) {
    XcdBarrier b; b.bar = bar; b.x = xb_xcc_id(); b.st = st;
    if (threadIdx.x == 0) (void)xb_add(&bar[XB_XCNT(b.x)], 1u);
    return b;
}
__device__ __forceinline__ void xcd_barrier_complete(unsigned* bar, unsigned x, unsigned& nloc, unsigned& nx) {
    const unsigned G = gridDim.x * gridDim.y * gridDim.z;
    unsigned sum, cnt, mine, sp = 0u;
    for (;;) {
        sum = 0u; cnt = 0u; mine = 0u;
#pragma unroll
        for (unsigned j = 0; j < 16; ++j) { const unsigned c = xb_ld(&bar[XB_XCNT(j)]); sum += c; cnt += (c > 0u) ? 1u : 0u; mine = (j == x) ? c : mine; }
        if (sum == G) break;
        __builtin_amdgcn_s_sleep(1);
        if ((++sp & 255u) == 0u) { if (xb_ld(&bar[XB_TMO])) break; if (sp > XB_SPIN_CAP) { atomicAdd(&bar[XB_TMO], 1u); break; } }
    }
    nloc = mine > 0u ? mine : 1u; nx = cnt > 0u ? cnt : 1u;
}

__device__ __forceinline__ void xcd_barrier(const XcdBarrier& b) {
    asm volatile("s_waitcnt vmcnt(0)" ::: "memory");
    __syncthreads();
    if (threadIdx.x == 0) {
        unsigned* bar = b.bar;
        __builtin_amdgcn_s_waitcnt(0);
        unsigned nloc = b.st[0], nx = b.st[1];
        if (nloc == 0u) { xcd_barrier_complete(bar, b.x, nloc, nx); b.st[0] = nloc; b.st[1] = nx; }
        const unsigned old = xb_add(&bar[XB_XSUB(b.x)], 1u);
        const unsigned gen = old / nloc;
        if (old + 1u == (gen + 1u) * nloc) {
            __builtin_amdgcn_fence(__ATOMIC_RELEASE, "agent");
            asm volatile("s_waitcnt vmcnt(0)" ::: "memory");
            const unsigned og = xb_add(&bar[XB_TOP], 1u);
            const unsigned tg = og / nx;
            if (og + 1u == (tg + 1u) * nx) xb_add(&bar[XB_TOPGEN], 1u);
            else XB_SPIN(xb_ld(&bar[XB_TOPGEN]) == tg, bar);
            __builtin_amdgcn_fence(__ATOMIC_ACQUIRE, "agent");
            xb_add(&bar[XB_XGEN(b.x)], 1u);
            asm volatile("s_waitcnt vmcnt(0)" ::: "memory");
        } else {
            XB_SPIN(xb_ld(&bar[XB_XGEN(b.x)]) == gen, bar);
            __builtin_amdgcn_fence(__ATOMIC_ACQUIRE, "agent");
            asm volatile("s_waitcnt vmcnt(0)" ::: "memory");
        }
    }
    __syncthreads();
}

constexpr int NWAVES = 8, NTHR = 512;
constexpr int T_ = 32768, S_ = 2048, NB_ = 16, D_ = 1024;
constexpr int DFF = 2816, DFF2 = 5632;
constexpr float EPS = 1e-6f;
constexpr size_t MiB = 1u << 20;
constexpr size_t WS_CTL = 0, CTL_ZERO_BYTES = 1 * MiB;
constexpr size_t WS_W_IN0 = 2 * MiB;
constexpr size_t WS_W_OUT0 = WS_W_IN0 + 6656 * 1024;
constexpr size_t WS_W_IN1 = WS_W_OUT0 + 2 * MiB;
constexpr size_t WS_W_UQ = WS_W_IN1 + 2 * MiB;
constexpr size_t WS_W_UKV = WS_W_UQ + 1536 * 1024;
constexpr size_t WS_W_OUT1 = WS_W_UKV + 1 * MiB;
constexpr size_t WS_W_UP = WS_W_OUT1 + 2 * MiB;
constexpr size_t WS_W_DN = WS_W_UP + 22 * MiB;
constexpr size_t WS_TAB64 = 50 * MiB;
constexpr size_t WS_TAB32 = WS_TAB64 + 512 * 1024;
constexpr size_t WS_KMEAN = 51 * MiB;
constexpr size_t WS_DT = 52 * MiB;
constexpr size_t WS_CS = 53 * MiB;
constexpr size_t WS_XN = 56 * MiB;
constexpr size_t WS_BIG = 120 * MiB;
static_assert(WS_W_DN + 11 * MiB <= WS_TAB64, "weights fit");
constexpr size_t L0_QK = WS_BIG, L0_VZ = WS_BIG + 64 * MiB, L0_XBC = WS_BIG + 128 * MiB, L0_DTR = WS_BIG + 192 * MiB, L0_XBCA = WS_BIG + 256 * MiB, L0_MIX = WS_BIG + 320 * MiB;
constexpr size_t L0_ST = L0_XBC;
constexpr size_t L0_CB = L0_DTR;
constexpr size_t L0_YG = L0_QK;
constexpr size_t FF_U = WS_BIG, FF_ACT = WS_BIG + 176 * MiB;
constexpr size_t L1_C1 = WS_BIG, L1_CQN = WS_BIG + 64 * MiB, L1_CKVN = WS_BIG + 96 * MiB, L1_KPE = WS_BIG + 112 * MiB, L1_QR = WS_BIG + 116 * MiB, L1_KV = WS_BIG + 212 * MiB;
constexpr size_t L1_K2 = WS_BIG;
constexpr size_t L1_O = WS_XN;
constexpr size_t WS_END = 512 * MiB;
constexpr int CW_BAR = 4096;

constexpr int RING_OFF = 0, RING_BYTES = 131072;
constexpr int LDSCTL_OFF = RING_BYTES, MISC_OFF = LDSCTL_OFF + 320;
constexpr int LDS_BYTES = 147456;

__device__ __forceinline__ float bf2f(bf16 v) { return __builtin_bit_cast(float, (unsigned)v << 16); }
__device__ __forceinline__ float bflo(unsigned w) { return __builtin_bit_cast(float, w << 16); }
__device__ __forceinline__ float bfhi(unsigned w) { return __builtin_bit_cast(float, w & 0xffff0000u); }
__device__ __forceinline__ float silu_f(float v) { return v / (1.f + __expf(-v)); }
__device__ __forceinline__ float wave_sum(float v) {
#pragma unroll
    for (int o = 1; o < 64; o <<= 1) v += __shfl_xor(v, o);
    return v;
}

struct Args { const float* in[25]; float* out; unsigned char* ws; int ph_lo, ph_hi; };
typedef const __attribute__((address_space(4))) Args* KArgs;
__device__ __forceinline__ KArgs kargs() { KArgs p = (KArgs)__builtin_amdgcn_kernarg_segment_ptr(); asm volatile("" : "+s"(p)); return p; }
#define PH_VARS KArgs A_ = kargs(); unsigned char* ws = A_->ws; float* out = A_->out; const float* x = A_->in[0]; bf16* XN = (bf16*)(ws + WS_XN); const float* TAB64 = (const float*)(ws + WS_TAB64); const float* TAB32 = (const float*)(ws + WS_TAB32); \
    int tid_ = threadIdx.x; asm volatile("" : "+v"(tid_)); const int tid = tid_, lane = tid & 63, wave = __builtin_amdgcn_readfirstlane(tid >> 6); int G = gridDim.x; asm volatile("" : "+s"(G)); const int gw = blockIdx.x * NWAVES + wave, NGW = G * NWAVES; const int gt = blockIdx.x * NTHR + tid, NGT = G * NTHR; \
    (void)out; (void)x; (void)XN; (void)TAB64; (void)TAB32; (void)lane; (void)gw; (void)NGW; (void)gt; (void)NGT;

__device__ __forceinline__ void transpose_item(const float* W, int K, int Nsrc, bf16* WT, LAS float* scr, int item, int nblk, int lane) {
    const int kb = item / nblk, nb = item % nblk, k0 = 64 * kb, n0 = 32 * nb;
    const int nn = n0 + (lane & 31);
#pragma unroll 8
    for (int i = 0; i < 32; ++i) { const int kk = 2 * i + (lane >> 5); scr[kk * 33 + (lane & 31)] = (nn < Nsrc) ? W[(size_t)(k0 + kk) * Nsrc + nn] : 0.f; }
    LDS_WAIT(); asm volatile("" ::: "memory");
    const int c = lane & 7;
#pragma unroll
    for (int j = 0; j < 4; ++j) { const int n = (lane >> 3) + 8 * j; const LAS float* s = scr + (8 * c) * 33 + n;
        v4u o; o.x = pk2(s[0 * 33], s[1 * 33]); o.y = pk2(s[2 * 33], s[3 * 33]); o.z = pk2(s[4 * 33], s[5 * 33]); o.w = pk2(s[6 * 33], s[7 * 33]);
        *(GAS v4u*)(WT + (size_t)(n0 + n) * K + k0 + 8 * c) = o; }
    LDS_WAIT(); asm volatile("" ::: "memory");
}
__device__ __forceinline__ void transpose_mat(const float* W, int K, int Nsrc, int Npad, bf16* WT, LAS float* scr, int gw, int NGW, int lane) {
    const int nblk = Npad / 32, nitems = (K / 64) * nblk;
    for (int it = gw; it < nitems; it += NGW) transpose_item(W, K, Nsrc, WT, scr, it, nblk, lane);
}

__device__ __forceinline__ void rms_rows_1024(const float* x, const float* g, bf16* o, int gw, int NGW, int lane) {
    for (int m = gw; m < T_; m += NGW) {
        const f32x4* xr = (const f32x4*)(x + (size_t)m * D_) + lane;
        f32x4 v[4]; float s = 0.f;
#pragma unroll
        for (int j = 0; j < 4; ++j) { v[j] = xr[64 * j]; s += (v[j].x * v[j].x + v[j].y * v[j].y) + (v[j].z * v[j].z + v[j].w * v[j].w); }
        const float rstd = 1.f / sqrtf(wave_sum(s) * (1.f / D_) + EPS);
        unsigned long long* o8 = (unsigned long long*)(o + (size_t)m * D_) + lane;
#pragma unroll
        for (int j = 0; j < 4; ++j) { const f32x4 gg = ((const f32x4*)g)[lane + 64 * j];
            o8[64 * j] = (unsigned long long)pk2(v[j].x * rstd * gg.x, v[j].y * rstd * gg.y) | ((unsigned long long)pk2(v[j].z * rstd * gg.z, v[j].w * rstd * gg.w) << 32); }
    }
}

struct EpiF32Res {
    static constexpr bool PERM = false, AFTER_DRAIN = false;
    float* C; const float* R; int ldc;
    __device__ __forceinline__ void operator()(const pg8::f32x4 (&acc)[2][2][4][2], const pg8::Unit& u, int wr, int wc, int fr, int fq) const {
        const int row0 = u.pm * pg8::BM + wr * 64 + fr, col0 = u.pn * pg8::BM + wc * 32 + 4 * fq;
#pragma unroll
        for (int ai = 0; ai < 2; ++ai)
#pragma unroll
            for (int m = 0; m < 4; ++m) { const size_t off = (size_t)(row0 + ai * pg8::HALF + m * 16) * ldc + col0;
                f32x4 r[2][2];
#pragma unroll
                for (int bj = 0; bj < 2; ++bj)
#pragma unroll
                    for (int n = 0; n < 2; ++n) r[bj][n] = *(const f32x4*)(R + off + bj * pg8::HALF + n * 16);
#pragma unroll
                for (int bj = 0; bj < 2; ++bj)
#pragma unroll
                    for (int n = 0; n < 2; ++n) *(f32x4*)(C + off + bj * pg8::HALF + n * 16) = acc[ai][bj][m][n] + r[bj][n];
                asm volatile("" ::: "memory"); }
    }
};

template <class Epi> __device__ __forceinline__ void run_gemm(LAS unsigned char* lds, const bf16* A, const bf16* Bt, int M, int N, int K, const Epi& E) {
    pg8::Gemm g{A, Bt, M, N, K}; pg8::StaticOrder S; S.init(M, N, (int)gridDim.x, (int)blockIdx.x);
    pg8::gemm_phase<Epi, pg8::StaticOrder, PG8_ALIGN, PG8_SP2>(lds + RING_OFF, g, S, E);
}

#define NPHASES 40
__global__ void __launch_bounds__(NTHR, 2) fwd(Args args) {
    extern __shared__ __attribute__((aligned(16))) unsigned char lds_raw[];
    LAS unsigned char* lds = (LAS unsigned char*)lds_raw;
    volatile LAS unsigned* MISC = (volatile LAS unsigned*)(lds + MISC_OFF);
    {
        const int tid0 = threadIdx.x;
        for (int u = tid0; u < (LDS_BYTES - LDSCTL_OFF) / 4; u += NTHR) ((LAS unsigned*)(lds + LDSCTL_OFF))[u] = 0u;
    }
    __syncthreads();
    int lo, hi; { KArgs A0 = kargs(); lo = A0->ph_lo; hi = A0->ph_hi; }
    const bool multi = (hi - lo) > 1;
    XcdBarrier bar; bar.bar = nullptr; bar.x = 0; bar.st = nullptr;
    if (multi) { KArgs A0 = kargs(); bar = xcd_barrier_post((unsigned*)((gu32*)(A0->ws + WS_CTL) + CW_BAR), MISC + 8); }
#define IN(k) (lo <= (k) && (k) < hi)
#define SEAM(k) do { if (IN(k) && IN((k) + 1)) xcd_barrier(bar); } while (0)

    if (IN(0)) { PH_VARS
        LAS float* scr = (LAS float*)(lds + RING_OFF + wave * 16384);
        transpose_mat(A_->in[3], 1024, 3080, 3328, (bf16*)(ws + WS_W_IN0), scr, gw, NGW, lane);
        transpose_mat(A_->in[12], 1024, 1024, 1024, (bf16*)(ws + WS_W_OUT0), scr, gw, NGW, lane);
        transpose_mat(A_->in[13], 1024, 800, 1024, (bf16*)(ws + WS_W_IN1), scr, gw, NGW, lane);
        transpose_mat(A_->in[15], 512, 1536, 1536, (bf16*)(ws + WS_W_UQ), scr, gw, NGW, lane);
        transpose_mat(A_->in[17], 256, 2048, 2048, (bf16*)(ws + WS_W_UKV), scr, gw, NGW, lane);
        transpose_mat(A_->in[20], 1024, 1024, 1024, (bf16*)(ws + WS_W_OUT1), scr, gw, NGW, lane);
        for (int l = 0; l < 2; ++l) {
            transpose_mat(A_->in[21] + (size_t)l * 1024 * DFF2, 1024, DFF2, DFF2, (bf16*)(ws + WS_W_UP) + (size_t)l * DFF2 * 1024, scr, gw, NGW, lane);
            transpose_mat(A_->in[24] + (size_t)l * DFF * 1024, DFF, 1024, 1024, (bf16*)(ws + WS_W_DN) + (size_t)l * 1024 * DFF, scr, gw, NGW, lane);
        }
        float* t64 = (float*)(ws + WS_TAB64); float* t32 = (float*)(ws + WS_TAB32);
        for (int i = gt; i < 2048 * 32; i += NGT) { const int pos = i >> 5, f = i & 31; const float inv = 1.0f / powf(10000.0f, (float)(2 * f) / 64.0f); const float ang = (float)pos * inv; t64[2 * i] = cosf(ang); t64[2 * i + 1] = sinf(ang); }
        for (int i = gt; i < 2048 * 16; i += NGT) { const int pos = i >> 4, f = i & 15; const float inv = 1.0f / powf(10000.0f, (float)(2 * f) / 32.0f); const float ang = (float)pos * inv; t32[2 * i] = cosf(ang); t32[2 * i + 1] = sinf(ang); }
    }
    SEAM(0);
    if (IN(1)) { PH_VARS rms_rows_1024(x, A_->in[1], XN, gw, NGW, lane); }
    SEAM(1);
    if (IN(2)) { PH_VARS pg8::EpiBf16<0> E{(bf16*)(ws + L0_QK), 1024, nullptr, 1024, (size_t)(64 * MiB / 2), 1.f}; run_gemm(lds, XN, (const bf16*)(ws + WS_W_IN0), T_, 3328, 1024, E); }
    SEAM(2);
    if (IN(3)) { PH_VARS
        bf16* QK = (bf16*)(ws + L0_QK);
        for (int i = gt; i < T_ * 16; i += NGT) {
            const int t = i >> 4, wh = i & 15, pos = t & 2047; const float* gn = (wh < 8) ? A_->in[10] : A_->in[11];
            v4u* p = (v4u*)(QK + (size_t)t * 1024 + wh * 64); float v[64]; float s = 0.f;
#pragma unroll
            for (int c = 0; c < 8; ++c) { const v4u w = p[c]; v[8*c] = bflo(w.x); v[8*c+1] = bfhi(w.x); v[8*c+2] = bflo(w.y); v[8*c+3] = bfhi(w.y); v[8*c+4] = bflo(w.z); v[8*c+5] = bfhi(w.z); v[8*c+6] = bflo(w.w); v[8*c+7] = bfhi(w.w); }
#pragma unroll
            for (int d = 0; d < 64; ++d) s += v[d] * v[d];
            const float rstd = 1.f / sqrtf(s * (1.f / 64.f) + EPS);
#pragma unroll
            for (int d = 0; d < 64; ++d) v[d] = v[d] * rstd * gn[d];
#pragma unroll
            for (int d = 0; d < 32; ++d) { const float c = TAB64[(pos * 32 + d) * 2], sn = TAB64[(pos * 32 + d) * 2 + 1]; const float a = v[d], b = v[d + 32]; v[d] = a * c - b * sn; v[d + 32] = a * sn + b * c; }
#pragma unroll
            for (int c = 0; c < 8; ++c) { v4u w; w.x = pk2(v[8*c], v[8*c+1]); w.y = pk2(v[8*c+2], v[8*c+3]); w.z = pk2(v[8*c+4], v[8*c+5]); w.w = pk2(v[8*c+6], v[8*c+7]); p[c] = w; }
        }
        const bf16* DTR = (const bf16*)(ws + L0_DTR); float* DT = (float*)(ws + WS_DT); float* CS = (float*)(ws + WS_CS);
        for (int i = gt; i < 16 * 16 * 8; i += NGT) {
            const int h = i & 7, bc = i >> 3; const float bias = A_->in[6][h], A = -expf(A_->in[7][h]); float cs = 0.f;
            for (int l = 0; l < 128; ++l) { const int t = bc * 128 + l; const float r = bf2f(DTR[(size_t)t * 1024 + h]) + bias; const float dt = (r > 20.f) ? r : log1pf(expf(r)); DT[t * 8 + h] = dt; cs += dt * A; CS[t * 8 + h] = cs; }
        }
        const bf16* XB = (const bf16*)(ws + L0_XBC); bf16* XA = (bf16*)(ws + L0_XBCA); const float* cw = A_->in[4]; const float* cb = A_->in[5];
        for (int i = gt; i < T_ * 128; i += NGT) {
            const int t = i >> 7, c0 = (i & 127) * 8, pos = t & 2047; float acc[8];
#pragma unroll
            for (int j = 0; j < 8; ++j) acc[j] = cb[c0 + j];
#pragma unroll
            for (int k = 0; k < 4; ++k) { const int dtk = 3 - k; if (pos - dtk >= 0) { const v4u w = *(const v4u*)(XB + (size_t)(t - dtk) * 1024 + c0); const float* wk = cw + k * 1024 + c0;
                    acc[0] += wk[0] * bflo(w.x); acc[1] += wk[1] * bfhi(w.x); acc[2] += wk[2] * bflo(w.y); acc[3] += wk[3] * bfhi(w.y); acc[4] += wk[4] * bflo(w.z); acc[5] += wk[5] * bfhi(w.z); acc[6] += wk[6] * bflo(w.w); acc[7] += wk[7] * bfhi(w.w); } }
            v4u o; o.x = pk2(silu_f(acc[0]), silu_f(acc[1])); o.y = pk2(silu_f(acc[2]), silu_f(acc[3])); o.z = pk2(silu_f(acc[4]), silu_f(acc[5])); o.w = pk2(silu_f(acc[6]), silu_f(acc[7]));
            *(v4u*)(XA + (size_t)t * 1024 + c0) = o;
        }
    }
    SEAM(3);
    if (IN(4)) { PH_VARS
        const bf16* QK = (const bf16*)(ws + L0_QK); float* KM = (float*)(ws + WS_KMEAN);
        for (int i = gt; i < 16 * 8 * 512; i += NGT) {
            const int c = i & 511, bb = i >> 9; float s = 0.f;
            for (int r = 0; r < 256; ++r) s += bf2f(QK[(size_t)(bb * 256 + r) * 1024 + 512 + c]);
            KM[i] = s * (1.f / 256.f);
        }
        const bf16* XA = (const bf16*)(ws + L0_XBCA); const float* DT = (const float*)(ws + WS_DT); const float* CS = (const float*)(ws + WS_CS); float* ST = (float*)(ws + L0_ST);
        for (long i = gt; i < (long)16 * 16 * 8 * 64 * 128; i += NGT) {
            const int n = (int)(i & 127), p = (int)((i >> 7) & 63), h = (int)((i >> 13) & 7), bc = (int)(i >> 16); const int g = h >> 2;
            const int t0 = bc * 128; const float cend = CS[(t0 + 127) * 8 + h]; float s = 0.f;
            for (int l = 0; l < 128; ++l) { const int t = t0 + l; const float w = DT[t * 8 + h] * __expf(cend - CS[t * 8 + h]);
                s += bf2f(XA[(size_t)t * 1024 + 512 + g * 128 + n]) * bf2f(XA[(size_t)t * 1024 + h * 64 + p]) * w; }
            ST[i] = s;
        }
        float* CB = (float*)(ws + L0_CB);
        for (int i = gt; i < 16 * 16 * 2 * 128 * 128; i += NGT) {
            const int s_ = i & 127, l = (i >> 7) & 127, g = (i >> 14) & 1, bc = i >> 15; const int t0 = bc * 128;
            const bf16* cr = XA + (size_t)(t0 + l) * 1024 + 768 + g * 128; const bf16* br = XA + (size_t)(t0 + s_) * 1024 + 512 + g * 128; float a = 0.f;
            if (s_ <= l) { for (int n = 0; n < 128; ++n) a += bf2f(cr[n]) * bf2f(br[n]); }
            CB[i] = a;
        }
    }
    SEAM(4);
    if (IN(5)) { PH_VARS
        float* ST = (float*)(ws + L0_ST); const float* CS = (const float*)(ws + WS_CS);
        for (int i = gt; i < 16 * 8 * 64 * 128; i += NGT) {
            const int pn = i & 8191, h = (i >> 13) & 7, b = i >> 16; float hst = 0.f;
            for (int c = 0; c < 16; ++c) { const size_t idx = ((size_t)((b * 16 + c) * 8 + h) << 13) + pn; const float tmp = ST[idx]; ST[idx] = hst; hst = hst * __expf(CS[((b * 16 + c) * 128 + 127) * 8 + h]) + tmp; }
        }
        const bf16* QK = (const bf16*)(ws + L0_QK); const bf16* VZ = (const bf16*)(ws + L0_VZ); const float* KM = (const float*)(ws + WS_KMEAN); bf16* MIX = (bf16*)(ws + L0_MIX);
        for (int i = gt; i < 16 * 8 * 2048; i += NGT) {
            const int q = i & 2047, h = (i >> 11) & 7, b = i >> 14; const int own = q >> 8; const size_t trow = (size_t)b * 2048;
            float qv[64];
            { const v4u* p = (const v4u*)(QK + (trow + q) * 1024 + h * 64);
#pragma unroll
              for (int c = 0; c < 8; ++c) { const v4u w = p[c]; qv[8*c] = bflo(w.x); qv[8*c+1] = bfhi(w.x); qv[8*c+2] = bflo(w.y); qv[8*c+3] = bfhi(w.y); qv[8*c+4] = bflo(w.z); qv[8*c+5] = bfhi(w.z); qv[8*c+6] = bflo(w.w); qv[8*c+7] = bfhi(w.w); } }
            unsigned sel = 0u;
            { float gate[8];
#pragma unroll
              for (int j = 0; j < 8; ++j) { float a = -INFINITY; if (j < own) { a = 0.f; const float* km = KM + ((b * 8 + j) * 8 + h) * 64;
#pragma unroll
                      for (int d = 0; d < 64; ++d) a += qv[d] * km[d]; } gate[j] = a; }
#pragma unroll
              for (int r = 0; r < 3; ++r) { int best = -1; float bv = -INFINITY;
#pragma unroll
                  for (int j = 0; j < 8; ++j) if (!((sel >> j) & 1u) && gate[j] > bv) { bv = gate[j]; best = j; }
                  if (best >= 0) sel |= 1u << best; } }
            float o[64];
#pragma unroll
            for (int d = 0; d < 64; ++d) o[d] = 0.f;
            float m = -INFINITY, l = 0.f;
            const int kend = own * 256 + 256;
            for (int kp = 0; kp < kend; ++kp) {
                const int kb = kp >> 8; const bool act = (kb == own) ? (kp <= q) : (((sel >> kb) & 1u) != 0u);
                if (act) {
                    const v4u* kr = (const v4u*)(QK + (trow + kp) * 1024 + 512 + h * 64); float s = 0.f;
#pragma unroll
                    for (int c = 0; c < 8; ++c) { const v4u w = kr[c]; s += qv[8*c] * bflo(w.x) + qv[8*c+1] * bfhi(w.x) + qv[8*c+2] * bflo(w.y) + qv[8*c+3] * bfhi(w.y) + qv[8*c+4] * bflo(w.z) + qv[8*c+5] * bfhi(w.z) + qv[8*c+6] * bflo(w.w) + qv[8*c+7] * bfhi(w.w); }
                    s *= 0.125f;
                    if (s > m) { const float f = __expf(m - s); l *= f;
#pragma unroll
                        for (int d = 0; d < 64; ++d) o[d] *= f;
                        m = s; }
                    const float pr = __expf(s - m); l += pr;
                    const v4u* vr = (const v4u*)(VZ + (trow + kp) * 1024 + h * 64);
#pragma unroll
                    for (int c = 0; c < 8; ++c) { const v4u w = vr[c]; o[8*c] += pr * bflo(w.x); o[8*c+1] += pr * bfhi(w.x); o[8*c+2] += pr * bflo(w.y); o[8*c+3] += pr * bfhi(w.y); o[8*c+4] += pr * bflo(w.z); o[8*c+5] += pr * bfhi(w.z); o[8*c+6] += pr * bflo(w.w); o[8*c+7] += pr * bfhi(w.w); }
                }
            }
            const float il = 1.f / l; v4u* op = (v4u*)(MIX + (trow + q) * 1024 + h * 64);
#pragma unroll
            for (int c = 0; c < 8; ++c) { v4u w; w.x = pk2(o[8*c] * il, o[8*c+1] * il); w.y = pk2(o[8*c+2] * il, o[8*c+3] * il); w.z = pk2(o[8*c+4] * il, o[8*c+5] * il); w.w = pk2(o[8*c+6] * il, o[8*c+7] * il); op[c] = w; }
        }
    }
    SEAM(5);
    if (IN(6)) { PH_VARS
        const bf16* XA = (const bf16*)(ws + L0_XBCA); const bf16* VZ = (const bf16*)(ws + L0_VZ); const float* DT = (const float*)(ws + WS_DT); const float* CS = (const float*)(ws + WS_CS);
        const float* ST = (const float*)(ws + L0_ST); const float* CB = (const float*)(ws + L0_CB); float* YG = (float*)(ws + L0_YG);
        for (int i = gt; i < T_ * 512; i += NGT) {
            const int p = i & 63, h = (i >> 6) & 7, t = i >> 9; const int g = h >> 2, l = t & 127, bc = t >> 7, t0 = bc * 128;
            const float csl = CS[t * 8 + h]; const float* cbr = CB + (((size_t)(bc * 2 + g) * 128 + l) << 7); float yd = 0.f;
            for (int s_ = 0; s_ <= l; ++s_) { const int ts = t0 + s_; yd += cbr[s_] * __expf(csl - CS[ts * 8 + h]) * DT[ts * 8 + h] * bf2f(XA[(size_t)ts * 1024 + h * 64 + p]); }
            const float* hin = ST + (((size_t)(bc * 8 + h) * 64 + p) << 7); const bf16* cr = XA + (size_t)t * 1024 + 768 + g * 128; float yo = 0.f;
            for (int n = 0; n < 128; ++n) yo += bf2f(cr[n]) * hin[n];
            const float xs = bf2f(XA[(size_t)t * 1024 + h * 64 + p]);
            const float y = yd + yo * __expf(csl) + A_->in[8][h] * xs;
            const float z = bf2f(VZ[(size_t)t * 1024 + 512 + h * 64 + p]);
            YG[i] = y * silu_f(z);
        }
    }
    SEAM(6);
    if (IN(7)) { PH_VARS
        const float* YG = (const float*)(ws + L0_YG); bf16* MIX = (bf16*)(ws + L0_MIX); const float* gn = A_->in[9];
        for (int i = gw; i < T_ * 2; i += NGW) {
            const f32x4 v = ((const f32x4*)(YG + (size_t)i * 256))[lane]; const float s = wave_sum(v.x * v.x + v.y * v.y + v.z * v.z + v.w * v.w);
            const float rstd = 1.f / sqrtf(s * (1.f / 256.f) + EPS); const int g = i & 1, t = i >> 1; const f32x4 gg = ((const f32x4*)(gn + g * 256))[lane];
            *(unsigned long long*)(MIX + (size_t)t * 1024 + 512 + g * 256 + lane * 4) = (unsigned long long)pk2(v.x * rstd * gg.x, v.y * rstd * gg.y) | ((unsigned long long)pk2(v.z * rstd * gg.z, v.w * rstd * gg.w) << 32);
        }
    }
    SEAM(7);
    if (IN(8)) { PH_VARS EpiF32Res E{out, x, 1024}; run_gemm(lds, (const bf16*)(ws + L0_MIX), (const bf16*)(ws + WS_W_OUT0), T_, 1024, 1024, E); }
    SEAM(8);
#define FFN_PHASES(P, L) \
    if (IN(P)) { PH_VARS rms_rows_1024(out, A_->in[2] + (L) * 1024, XN, gw, NGW, lane); } \
    SEAM(P); \
    for (int hf = 0; hf < 2; ++hf) { \
        if (IN((P) + 1 + 3 * hf)) { PH_VARS pg8::EpiBf16<0> E{(bf16*)(ws + FF_U), DFF2, nullptr, 0, 0, 1.f}; run_gemm(lds, XN + (size_t)hf * 16384 * 1024, (const bf16*)(ws + WS_W_UP) + (size_t)(L) * DFF2 * 1024, 16384, DFF2, 1024, E); } \
        SEAM((P) + 1 + 3 * hf); \
        if (IN((P) + 2 + 3 * hf)) { PH_VARS \
            const bf16* U = (const bf16*)(ws + FF_U); bf16* ACT = (bf16*)(ws + FF_ACT); const float* cw = A_->in[22] + (size_t)(L) * 3 * DFF2; const float* cb = A_->in[23] + (size_t)(L) * DFF2; \
            for (int i = gt; i < 16384 * (DFF / 8); i += NGT) { \
                const int t = i / (DFF / 8), c0 = (i % (DFF / 8)) * 8, pos = t & 2047; float ag[8], au[8]; \
                _Pragma("unroll") for (int j = 0; j < 8; ++j) { ag[j] = cb[c0 + j]; au[j] = cb[DFF + c0 + j]; } \
                _Pragma("unroll") for (int k = 0; k < 3; ++k) { const int dtk = 2 - k; if (pos - dtk >= 0) { \
                    const v4u wg = *(const v4u*)(U + (size_t)(t - dtk) * DFF2 + c0); const v4u wu = *(const v4u*)(U + (size_t)(t - dtk) * DFF2 + DFF + c0); const float* kg = cw + k * DFF2 + c0; const float* ku = kg + DFF; \
                    ag[0] += kg[0] * bflo(wg.x); ag[1] += kg[1] * bfhi(wg.x); ag[2] += kg[2] * bflo(wg.y); ag[3] += kg[3] * bfhi(wg.y); ag[4] += kg[4] * bflo(wg.z); ag[5] += kg[5] * bfhi(wg.z); ag[6] += kg[6] * bflo(wg.w); ag[7] += kg[7] * bfhi(wg.w); \
                    au[0] += ku[0] * bflo(wu.x); au[1] += ku[1] * bfhi(wu.x); au[2] += ku[2] * bflo(wu.y); au[3] += ku[3] * bfhi(wu.y); au[4] += ku[4] * bflo(wu.z); au[5] += ku[5] * bfhi(wu.z); au[6] += ku[6] * bflo(wu.w); au[7] += ku[7] * bfhi(wu.w); } } \
                v4u o; o.x = pk2(silu_f(ag[0]) * au[0], silu_f(ag[1]) * au[1]); o.y = pk2(silu_f(ag[2]) * au[2], silu_f(ag[3]) * au[3]); o.z = pk2(silu_f(ag[4]) * au[4], silu_f(ag[5]) * au[5]); o.w = pk2(silu_f(ag[6]) * au[6], silu_f(ag[7]) * au[7]); \
                *(v4u*)(ACT + (size_t)t * DFF + c0) = o; } } \
        SEAM((P) + 2 + 3 * hf); \
        if (IN((P) + 3 + 3 * hf)) { PH_VARS float* oh = out + (size_t)hf * 16384 * 1024; EpiF32Res E{oh, oh, 1024}; run_gemm(lds, (const bf16*)(ws + FF_ACT), (const bf16*)(ws + WS_W_DN) + (size_t)(L) * 1024 * DFF, 16384, 1024, DFF, E); } \
        SEAM((P) + 3 + 3 * hf); \
    }
    FFN_PHASES(9, 0)
    if (IN(16)) { PH_VARS rms_rows_1024(out, A_->in[1] + 1024, XN, gw, NGW, lane); }
    SEAM(16);
    if (IN(17)) { PH_VARS pg8::EpiBf16<0> E{(bf16*)(ws + L1_C1), 1024, nullptr, 0, 0, 1.f}; run_gemm(lds, XN, (const bf16*)(ws + WS_W_IN1), T_, 1024, 1024, E); }
    SEAM(17);
    if (IN(18)) { PH_VARS
        const bf16* C1 = (const bf16*)(ws + L1_C1); bf16* CQN = (bf16*)(ws + L1_CQN); bf16* CKVN = (bf16*)(ws + L1_CKVN); float* KPE = (float*)(ws + L1_KPE);
        for (int t = gw; t < T_; t += NGW) {
            const bf16* r = C1 + (size_t)t * 1024; float a[8]; float s = 0.f;
            { const v4u w = ((const v4u*)r)[lane]; a[0] = bflo(w.x); a[1] = bfhi(w.x); a[2] = bflo(w.y); a[3] = bfhi(w.y); a[4] = bflo(w.z); a[5] = bfhi(w.z); a[6] = bflo(w.w); a[7] = bfhi(w.w); }
#pragma unroll
            for (int j = 0; j < 8; ++j) s += a[j] * a[j];
            float rstd = 1.f / sqrtf(wave_sum(s) * (1.f / 512.f) + EPS); const float* g1 = A_->in[14] + lane * 8;
            { v4u o; o.x = pk2(a[0] * rstd * g1[0], a[1] * rstd * g1[1]); o.y = pk2(a[2] * rstd * g1[2], a[3] * rstd * g1[3]); o.z = pk2(a[4] * rstd * g1[4], a[5] * rstd * g1[5]); o.w = pk2(a[6] * rstd * g1[6], a[7] * rstd * g1[7]); ((v4u*)(CQN + (size_t)t * 512))[lane] = o; }
            float b4[4]; { const unsigned long long w = ((const unsigned long long*)(r + 512))[lane]; b4[0] = bflo((unsigned)w); b4[1] = bfhi((unsigned)w); b4[2] = bflo((unsigned)(w >> 32)); b4[3] = bfhi((unsigned)(w >> 32)); }
            s = b4[0] * b4[0] + b4[1] * b4[1] + b4[2] * b4[2] + b4[3] * b4[3];
            rstd = 1.f / sqrtf(wave_sum(s) * (1.f / 256.f) + EPS); const float* g2 = A_->in[16] + lane * 4;
            ((unsigned long long*)(CKVN + (size_t)t * 256))[lane] = (unsigned long long)pk2(b4[0] * rstd * g2[0], b4[1] * rstd * g2[1]) | ((unsigned long long)pk2(b4[2] * rstd * g2[2], b4[3] * rstd * g2[3]) << 32);
            if (lane < 32) KPE[(size_t)t * 32 + lane] = bf2f(r[768 + lane]);
        }
    }
    SEAM(18);
    if (IN(19)) { PH_VARS pg8::EpiBf16<0> E{(bf16*)(ws + L1_QR), 1536, nullptr, 0, 0, 1.f}; run_gemm(lds, (const bf16*)(ws + L1_CQN), (const bf16*)(ws + WS_W_UQ), T_, 1536, 512, E); }
    SEAM(19);
    if (IN(20)) { PH_VARS pg8::EpiBf16<0> E{(bf16*)(ws + L1_KV), 2048, nullptr, 0, 0, 1.f}; run_gemm(lds, (const bf16*)(ws + L1_CKVN), (const bf16*)(ws + WS_W_UKV), T_, 2048, 256, E); }
    SEAM(20);
    if (IN(21)) { PH_VARS
        bf16* QR = (bf16*)(ws + L1_QR); const bf16* KV = (const bf16*)(ws + L1_KV); const float* KPE = (const float*)(ws + L1_KPE); bf16* K2 = (bf16*)(ws + L1_K2);
        for (int i = gt; i < T_ * 32; i += NGT) {
            const int t = i >> 5, wh = i & 31, h = wh & 15, pos = t & 2047; const bool isk = wh >= 16; const float* gn = isk ? A_->in[19] : A_->in[18];
            float v[96];
            if (!isk) { const v4u* p = (const v4u*)(QR + (size_t)t * 1536 + h * 96);
#pragma unroll
                for (int c = 0; c < 12; ++c) { const v4u w = p[c]; v[8*c] = bflo(w.x); v[8*c+1] = bfhi(w.x); v[8*c+2] = bflo(w.y); v[8*c+3] = bfhi(w.y); v[8*c+4] = bflo(w.z); v[8*c+5] = bfhi(w.z); v[8*c+6] = bflo(w.w); v[8*c+7] = bfhi(w.w); } }
            else { const v4u* p = (const v4u*)(KV + (size_t)t * 2048 + h * 128);
#pragma unroll
                for (int c = 0; c < 8; ++c) { const v4u w = p[c]; v[8*c] = bflo(w.x); v[8*c+1] = bfhi(w.x); v[8*c+2] = bflo(w.y); v[8*c+3] = bfhi(w.y); v[8*c+4] = bflo(w.z); v[8*c+5] = bfhi(w.z); v[8*c+6] = bflo(w.w); v[8*c+7] = bfhi(w.w); }
#pragma unroll
                for (int d = 0; d < 32; ++d) v[64 + d] = KPE[(size_t)t * 32 + d]; }
            float s = 0.f;
#pragma unroll
            for (int d = 0; d < 96; ++d) s += v[d] * v[d];
            const float rstd = 1.f / sqrtf(s * (1.f / 96.f) + EPS);
#pragma unroll
            for (int d = 0; d < 96; ++d) v[d] = v[d] * rstd * gn[d];
#pragma unroll
            for (int d = 0; d < 16; ++d) { const float c = TAB32[(pos * 16 + d) * 2], sn = TAB32[(pos * 16 + d) * 2 + 1]; const float a = v[64 + d], b = v[80 + d]; v[64 + d] = a * c - b * sn; v[80 + d] = a * sn + b * c; }
            v4u* op = isk ? (v4u*)(K2 + (size_t)t * 1536 + h * 96) : (v4u*)(QR + (size_t)t * 1536 + h * 96);
#pragma unroll
            for (int c = 0; c < 12; ++c) { v4u w; w.x = pk2(v[8*c], v[8*c+1]); w.y = pk2(v[8*c+2], v[8*c+3]); w.z = pk2(v[8*c+4], v[8*c+5]); w.w = pk2(v[8*c+6], v[8*c+7]); op[c] = w; }
        }
    }
    SEAM(21);
    if (IN(22)) { PH_VARS
        const bf16* Q2 = (const bf16*)(ws + L1_QR); const bf16* K2 = (const bf16*)(ws + L1_K2); const bf16* KV = (const bf16*)(ws + L1_KV); bf16* O = (bf16*)(ws + L1_O);
        const float scale = 0.10206207261596577f;
        for (int i = gt; i < 16 * 16 * 2048; i += NGT) {
            const int q = i & 2047, h = (i >> 11) & 15, b = i >> 15; const size_t trow = (size_t)b * 2048;
            float qv[96];
            { const v4u* p = (const v4u*)(Q2 + (trow + q) * 1536 + h * 96);
#pragma unroll
              for (int c = 0; c < 12; ++c) { const v4u w = p[c]; qv[8*c] = bflo(w.x); qv[8*c+1] = bfhi(w.x); qv[8*c+2] = bflo(w.y); qv[8*c+3] = bfhi(w.y); qv[8*c+4] = bflo(w.z); qv[8*c+5] = bfhi(w.z); qv[8*c+6] = bflo(w.w); qv[8*c+7] = bfhi(w.w); } }
            float o[64];
#pragma unroll
            for (int d = 0; d < 64; ++d) o[d] = 0.f;
            float m = -INFINITY, l = 0.f;
            const int kend = (q | 63) + 1;
            for (int kp = 0; kp < kend; ++kp) {
                if (kp <= q) {
                    const v4u* kr = (const v4u*)(K2 + (trow + kp) * 1536 + h * 96); float s = 0.f;
#pragma unroll
                    for (int c = 0; c < 12; ++c) { const v4u w = kr[c]; s += qv[8*c] * bflo(w.x) + qv[8*c+1] * bfhi(w.x) + qv[8*c+2] * bflo(w.y) + qv[8*c+3] * bfhi(w.y) + qv[8*c+4] * bflo(w.z) + qv[8*c+5] * bfhi(w.z) + qv[8*c+6] * bflo(w.w) + qv[8*c+7] * bfhi(w.w); }
                    s *= scale;
                    if (s > m) { const float f = __expf(m - s); l *= f;
#pragma unroll
                        for (int d = 0; d < 64; ++d) o[d] *= f;
                        m = s; }
                    const float pr = __expf(s - m); l += pr;
                    const v4u* vr = (const v4u*)(KV + (trow + kp) * 2048 + h * 128 + 64);
#pragma unroll
                    for (int c = 0; c < 8; ++c) { const v4u w = vr[c]; o[8*c] += pr * bflo(w.x); o[8*c+1] += pr * bfhi(w.x); o[8*c+2] += pr * bflo(w.y); o[8*c+3] += pr * bfhi(w.y); o[8*c+4] += pr * bflo(w.z); o[8*c+5] += pr * bfhi(w.z); o[8*c+6] += pr * bflo(w.w); o[8*c+7] += pr * bfhi(w.w); }
                }
            }
            const float il = 1.f / l; v4u* op = (v4u*)(O + (trow + q) * 1024 + h * 64);
#pragma unroll
            for (int c = 0; c < 8; ++c) { v4u w; w.x = pk2(o[8*c] * il, o[8*c+1] * il); w.y = pk2(o[8*c+2] * il, o[8*c+3] * il); w.z = pk2(o[8*c+4] * il, o[8*c+5] * il); w.w = pk2(o[8*c+6] * il, o[8*c+7] * il); op[c] = w; }
        }
    }
    SEAM(22);
    if (IN(23)) { PH_VARS EpiF32Res E{out, out, 1024}; run_gemm(lds, (const bf16*)(ws + L1_O), (const bf16*)(ws + WS_W_OUT1), T_, 1024, 1024, E); }
    SEAM(23);
    if (IN(24)) { }
    SEAM(24);
    FFN_PHASES(25, 1)
#undef IN
#undef SEAM
}
constexpr int LAST_PHASE = 32;

#ifndef MK_ONE_LAUNCH
#define MK_ONE_LAUNCH 1
#endif
extern "C" void kernel_launch(void* const* d_in, const int* in_sizes, int n_in, void* d_out, int out_size, void* d_ws, size_t ws_size, hipStream_t stream) {
    static int grid = 0;
    if (grid == 0) {
        if (n_in != 25 || out_size != T_ * D_ || ws_size < WS_END) { fprintf(stderr, "kernel_launch: unexpected shapes: n_in %d out %d ws %zu\n", n_in, out_size, ws_size); grid = -1; return; }
        if (hipFuncSetAttribute((const void*)fwd, hipFuncAttributeMaxDynamicSharedMemorySize, LDS_BYTES) != hipSuccess) { fprintf(stderr, "kernel_launch: hipFuncSetAttribute failed\n"); grid = -1; return; }
        int dev = 0, cus = 0, per_cu = 0;
        hipGetDevice(&dev); hipDeviceGetAttribute(&cus, hipDeviceAttributeMultiprocessorCount, dev);
        hipOccupancyMaxActiveBlocksPerMultiprocessor(&per_cu, (const void*)fwd, NTHR, LDS_BYTES);
        (void)hipGetLastError();
        grid = (per_cu >= 1) ? cus : -1;
        if (grid < 0) { fprintf(stderr, "kernel_launch: occupancy query says 0 blocks per CU\n"); return; }
    }
    if (grid < 0) return;
    hipMemsetAsync((char*)d_ws + WS_CTL, 0, CTL_ZERO_BYTES, stream);
    Args a{};
    for (int i = 0; i < 25; ++i) a.in[i] = (const float*)d_in[i];
    a.out = (float*)d_out; a.ws = (unsigned char*)d_ws;
#if MK_ONE_LAUNCH
    a.ph_lo = 0; a.ph_hi = LAST_PHASE;
    hipLaunchKernelGGL(fwd, dim3(grid), dim3(NTHR), LDS_BYTES, stream, a);
#else
    for (int p = 0; p < LAST_PHASE; ++p) { if (p == 24) continue; a.ph_lo = p; a.ph_hi = p + 1; hipLaunchKernelGGL(fwd, dim3(grid), dim3(NTHR), LDS_BYTES, stream, a); }
#endif
}
```

```cpp
#include <hip/hip_runtime.h>
#include <cstdio>
#include <cstdint>
namespace pg8 {
#define PG8_LAS __attribute__((address_space(3)))
typedef unsigned short bf16_t;
typedef short bf16x8 __attribute__((ext_vector_type(8)));
typedef float f32x4 __attribute__((ext_vector_type(4)));
typedef unsigned u32x4 __attribute__((ext_vector_type(4)));
constexpr int BM = 256, BK = 64, HALF = 128, HTB = HALF * BK * 2  , STAGE_BYTES = 8 * HTB, NXCD = 8, WGM = 8;

__host__ __device__ __forceinline__ int lds_byte(int r, int c) { const int st = (r >> 4) * 2 + (c >> 5), rr = r & 15, cc = c & 31, ob = rr * 64 + cc * 2; return st * 1024 + (ob ^ (((ob >> 9) & 1) << 5)); }
__host__ __device__ __forceinline__ void stage_rc(int b, int& R, int& C) { const int st = b / 1024, sb = b % 1024, swz = sb ^ (((sb >> 9) & 1) << 5); R = (st >> 1) * 16 + swz / 64; C = (st & 1) * 32 + (swz % 64) / 2; }
__host__ __device__ __forceinline__ int perm32(int rho) { const int n = rho >> 4, i = rho & 15; return 8 * (i >> 2) + 4 * n + (i & 3); }

struct Unit { int pm, pn; };
struct Gemm { const bf16_t* A; const bf16_t* Bt; int M, N, K, lda; };

struct StaticOrder {
    int nM, nN, nwg, G, c;
    __host__ __device__ void init(int M, int N, int G_, int c_) { nM = M / BM; nN = N / BM; nwg = nM * nN; G = G_; c = c_; }
    __host__ __device__ bool next(int i, Unit& u) const {
        const long L = (long)i * G + c; if (L >= nwg) return false;
        int wgid = (int)L; { const int q = nwg / NXCD, r = nwg % NXCD, xcd = wgid % NXCD, off = wgid / NXCD; wgid = (xcd < r ? xcd * (q + 1) : r * (q + 1) + (xcd - r) * q) + off; }
        const int nig = WGM * nN, gid = wgid / nig, fm = gid * WGM, gsz = (nM - fm) < WGM ? (nM - fm) : WGM;
        u.pm = fm + ((wgid % nig) % gsz); u.pn = (wgid % nig) / gsz; return true;
    }
    __device__ __forceinline__ void a_ready(const Unit&) const {}
    __device__ __forceinline__ void done(const Unit&) const {}
};

__device__ __forceinline__ unsigned cvt_pk_bf16(float lo, float hi) { unsigned r; asm volatile("v_cvt_pk_bf16_f32 %0, %1, %2" : "=v"(r) : "v"(lo), "v"(hi)); return r; }
typedef float f32x2 __attribute__((ext_vector_type(2)));
__device__ __forceinline__ f32x2 gelu_pk(f32x2 v) {
    const f32x2 av = __builtin_elementwise_abs(v), d = av * 0.2316418882f + 1.0f;
    f32x2 t; t.x = __builtin_amdgcn_rcpf(d.x); t.y = __builtin_amdgcn_rcpf(d.y);
    f32x2 q = t * 0.5307027145f + (-0.7265760135f); q = q * t + 0.7107068705f; q = q * t + (-0.142248368f); q = q * t + 0.127414796f; q = q * t;
    const f32x2 s = (v * v) * (-0.72134752044f);
    f32x2 e; e.x = __builtin_amdgcn_exp2f(s.x); e.y = __builtin_amdgcn_exp2f(s.y);
    const f32x2 m = v * (q * e), r = v - m;
    f32x2 o; o.x = v.x < 0.f ? m.x : r.x; o.y = v.y < 0.f ? m.y : r.y; return o;
}

template <int ACT  > struct EpiBf16 {
    static constexpr bool PERM = true, AFTER_DRAIN = false; static_assert(ACT == 0 || ACT == 1, "EpiBf16: ACT is 0 (none) or 1 (gelu_pk)");
    bf16_t* O; int ldc; const float* bias; int split_cols; size_t split_stride; float scale0;
    __device__ __forceinline__ void operator()(const f32x4 (&acc)[2][2][4][2], const Unit& u, int wr, int wc, int fr, int fq) const {
        const int row0 = u.pm * BM + wr * 64 + fr; int colt = u.pn * BM; bf16_t* base = O;
        float sc = 1.f; if (split_cols) { const int t = colt / split_cols; base += (size_t)t * split_stride; colt -= t * split_cols; if (t == 0) sc = scale0; }
        const int col0 = colt + wc * 32 + 8 * fq, bcol0 = u.pn * BM + wc * 32 + 8 * fq;
        f32x4 bv[2][2];
#pragma unroll
        for (int bj = 0; bj < 2; ++bj)
#pragma unroll
            for (int n = 0; n < 2; ++n) bv[bj][n] = bias ? *(const f32x4*)(bias + bcol0 + bj * HALF + 4 * n) : (f32x4){0.f, 0.f, 0.f, 0.f};
#pragma unroll
        for (int ai = 0; ai < 2; ++ai)
#pragma unroll
            for (int m = 0; m < 4; ++m) { bf16_t* rowp = base + (size_t)(row0 + ai * HALF + m * 16) * ldc + col0;
#pragma unroll
                for (int bj = 0; bj < 2; ++bj) { f32x4 v0 = acc[ai][bj][m][0] + bv[bj][0], v1 = acc[ai][bj][m][1] + bv[bj][1];
                    if (ACT == 1) { f32x2 a = gelu_pk((f32x2){v0[0], v0[1]}), b = gelu_pk((f32x2){v0[2], v0[3]}), c = gelu_pk((f32x2){v1[0], v1[1]}), d = gelu_pk((f32x2){v1[2], v1[3]});
                        v0 = (f32x4){a.x, a.y, b.x, b.y}; v1 = (f32x4){c.x, c.y, d.x, d.y}; }
                    v0 = v0 * sc; v1 = v1 * sc; u32x4 w; w.x = cvt_pk_bf16(v0[0], v0[1]); w.y = cvt_pk_bf16(v0[2], v0[3]); w.z = cvt_pk_bf16(v1[0], v1[1]); w.w = cvt_pk_bf16(v1[2], v1[3]);
                    *(u32x4*)(rowp + bj * HALF) = w; } }
    }
};

struct PanelStats {
    unsigned* xbuf;
    unsigned* cnt;
    unsigned* tmo;
    int ntn; float eps;
    unsigned code;
    __device__ __forceinline__ bool run(const f32x4 (&v)[2][2][4][2], const Unit& u, int wr, int wc, int fr, int fq, PG8_LAS unsigned char* lds, int wid, int lane) const {
        typedef float f32x2v __attribute__((ext_vector_type(2)));
        PG8_LAS f32x2v* P = (PG8_LAS f32x2v*)lds;
        PG8_LAS f32x2v* S = (PG8_LAS f32x2v*)(lds + 8192);
        PG8_LAS unsigned* flag = (PG8_LAS unsigned*)(lds + 8192 + 2048);
#pragma unroll
        for (int ai = 0; ai < 2; ++ai)
#pragma unroll
            for (int m = 0; m < 4; ++m) {
                float s = 0.f;
#pragma unroll
                for (int bj = 0; bj < 2; ++bj)
#pragma unroll
                    for (int n = 0; n < 2; ++n) { const f32x4 x = v[ai][bj][m][n]; s += (x[0] + x[1]) + (x[2] + x[3]); }
                s += __shfl_xor(s, 16); s += __shfl_xor(s, 32);
                const float mw = s * (1.0f / 64.0f); float q = 0.f;
#pragma unroll
                for (int bj = 0; bj < 2; ++bj)
#pragma unroll
                    for (int n = 0; n < 2; ++n) { const f32x4 d = v[ai][bj][m][n] - mw; q += (d[0] * d[0] + d[1] * d[1]) + (d[2] * d[2] + d[3] * d[3]); }
                q += __shfl_xor(q, 16); q += __shfl_xor(q, 32);
                if (fq == 0) P[(ai * HALF + wr * 64 + m * 16 + fr) * 4 + wc] = (f32x2v){mw, q};
            }
        asm volatile("s_waitcnt lgkmcnt(0)" ::: "memory"); __builtin_amdgcn_s_barrier(); asm volatile("" ::: "memory");
#if defined(BROKEN_EXCHANGE_NO_WAIT)
#warning BROKEN CONTROL BUILD: the row-statistics exchange does not wait; results are wrong by design
        if (blockIdx.x >= 64) { const long long t0_ = clock64(); while (clock64() - t0_ < 60000) __builtin_amdgcn_s_sleep(8); }
#endif
        const int row = wid * 32 + (lane & 31);
        if (lane < 32) {
            const f32x2v a = P[row * 4 + 0], b = P[row * 4 + 1], c = P[row * 4 + 2], d = P[row * 4 + 3];
            const float mt = (a.x + b.x + c.x + d.x) * 0.25f;
            const float da = a.x - mt, db = b.x - mt, dc = c.x - mt, dd = d.x - mt;
            const float m2 = (a.y + b.y) + (c.y + d.y) + 64.0f * ((da * da + db * db) + (dc * dc + dd * dd));
            unsigned long long* slot = (unsigned long long*)xbuf + ((size_t)(u.pm * BM + row) * 4 + u.pn);
            __hip_atomic_store(slot, ((unsigned long long)__float_as_uint(m2) << 32) | __float_as_uint(mt), __ATOMIC_RELAXED, __HIP_MEMORY_SCOPE_AGENT);
        }
        asm volatile("s_waitcnt vmcnt(0)" ::: "memory");
        if (lane == 0) __hip_atomic_fetch_add(cnt + 64 * u.pm, 1u, __ATOMIC_RELAXED, __HIP_MEMORY_SCOPE_AGENT);
        if (wid == 0) {
            bool dead = false; const unsigned long long t0 = __builtin_amdgcn_s_memrealtime(); const unsigned want = 8u * (unsigned)ntn;
            for (;;) {
#if defined(BROKEN_EXCHANGE_NO_WAIT)
                break;
#endif
                if ((unsigned)__builtin_amdgcn_readfirstlane(__hip_atomic_load(cnt + 64 * u.pm, __ATOMIC_RELAXED, __HIP_MEMORY_SCOPE_AGENT)) >= want) break;
                if (__builtin_amdgcn_s_memrealtime() - t0 > 2000000ull) {
                    if (lane == 0) { unsigned expect = 0u; __hip_atomic_compare_exchange_strong(tmo + 1, &expect, code | (unsigned)(u.pm & 0xff), __ATOMIC_RELAXED, __ATOMIC_RELAXED, __HIP_MEMORY_SCOPE_AGENT);
                                     __hip_atomic_store(tmo, 1u, __ATOMIC_RELAXED, __HIP_MEMORY_SCOPE_AGENT); }
                    dead = true; break; }
                __builtin_amdgcn_s_sleep(2);
            }
            __builtin_amdgcn_fence(__ATOMIC_ACQUIRE, "agent");
            if (lane == 0) flag[0] = dead ? 1u : 0u;
        }
        asm volatile("s_waitcnt vmcnt(0) lgkmcnt(0)" ::: "memory"); __builtin_amdgcn_s_barrier(); asm volatile("" ::: "memory");
        const bool bad = flag[0] != 0u;
        if (lane < 32) {
            const unsigned long long* slot = (const unsigned long long*)xbuf + (size_t)(u.pm * BM + row) * 4; float mt[4], m2[4]; float ms = 0.f;
#pragma unroll
            for (int t = 0; t < 4; ++t) { if (t < ntn) { const unsigned long long w = __hip_atomic_load(slot + t, __ATOMIC_RELAXED, __HIP_MEMORY_SCOPE_AGENT); mt[t] = __uint_as_float((unsigned)w); m2[t] = __uint_as_float((unsigned)(w >> 32)); } else { mt[t] = 0.f; m2[t] = 0.f; } ms += mt[t]; }
            const float mean = ms / (float)ntn; float q = 0.f;
#pragma unroll
            for (int t = 0; t < 4; ++t) if (t < ntn) { const float dm = mt[t] - mean; q += m2[t] + 256.0f * dm * dm; }
            S[row] = (f32x2v){mean, 1.0f / sqrtf(q / (256.0f * (float)ntn) + eps)};
        }
        asm volatile("s_waitcnt lgkmcnt(0)" ::: "memory"); __builtin_amdgcn_s_barrier(); asm volatile("" ::: "memory");
        return bad;
    }
};
struct EpiLnRes {
    static constexpr bool PERM = false, AFTER_DRAIN = true;
    const float* base; float* out; int ldc; const float* bias; PanelStats st; unsigned poison;
    __device__ __forceinline__ void fused(f32x4 (&acc)[2][2][4][2], const Unit& u, int wr, int wc, int fr, int fq, PG8_LAS unsigned char* lds, int wid, int lane) const {
        typedef float f32x2v __attribute__((ext_vector_type(2)));
        const PG8_LAS f32x2v* S = (const PG8_LAS f32x2v*)(lds + 8192);
        const int col0 = u.pn * BM + wc * 32 + 4 * fq;
#pragma unroll
        for (int bj = 0; bj < 2; ++bj)
#pragma unroll
            for (int n = 0; n < 2; ++n) { const f32x4 bv = bias ? *(const f32x4*)(bias + col0 + bj * HALF + n * 16) : (f32x4){0.f, 0.f, 0.f, 0.f};
#pragma unroll
                for (int ai = 0; ai < 2; ++ai)
#pragma unroll
                    for (int m = 0; m < 4; ++m) acc[ai][bj][m][n] += bv; }
        f32x4 pre[4][2][2];
#pragma unroll
        for (int m = 0; m < 4; ++m) { const size_t off = (size_t)(u.pm * BM + wr * 64 + m * 16 + fr) * ldc + col0;
#pragma unroll
            for (int bj = 0; bj < 2; ++bj)
#pragma unroll
                for (int n = 0; n < 2; ++n) pre[m][bj][n] = *(const f32x4*)(base + off + bj * HALF + n * 16); }
        const bool bad = st.run(acc, u, wr, wc, fr, fq, lds, wid, lane) || poison != 0u;
        const float qnan = __builtin_nanf("");
#pragma unroll
        for (int ai = 0; ai < 2; ++ai)
#pragma unroll
            for (int m = 0; m < 4; ++m) { const int r = ai * HALF + wr * 64 + m * 16 + fr; const f32x2v sr = S[r]; const size_t off = (size_t)(u.pm * BM + r) * ldc + col0;
#pragma unroll
                for (int bj = 0; bj < 2; ++bj)
#pragma unroll
                    for (int n = 0; n < 2; ++n) { const f32x4 bs = ai == 0 ? pre[m][bj][n] : *(const f32x4*)(base + off + bj * HALF + n * 16); f32x4 o = bs + (acc[ai][bj][m][n] - sr.x) * sr.y;
                        if (bad) o = (f32x4){qnan, qnan, qnan, qnan}; *(f32x4*)(out + off + bj * HALF + n * 16) = o; }
                if (m & 1) asm volatile("" ::: "memory"); }
    }
};
struct EpiLnResLn {
    static constexpr bool PERM = false, AFTER_DRAIN = true;
    const float* base; float* out; bf16_t* xn; int ldc; const float* bias; PanelStats st1, st2; unsigned poison;
    __device__ __forceinline__ void fused(f32x4 (&acc)[2][2][4][2], const Unit& u, int wr, int wc, int fr, int fq, PG8_LAS unsigned char* lds, int wid, int lane) const {
        typedef float f32x2v __attribute__((ext_vector_type(2))); typedef unsigned u32x2v __attribute__((ext_vector_type(2)));
        const PG8_LAS f32x2v* S = (const PG8_LAS f32x2v*)(lds + 8192);
        const int col0 = u.pn * BM + wc * 32 + 4 * fq;
#pragma unroll
        for (int bj = 0; bj < 2; ++bj)
#pragma unroll
            for (int n = 0; n < 2; ++n) { const f32x4 bv = bias ? *(const f32x4*)(bias + col0 + bj * HALF + n * 16) : (f32x4){0.f, 0.f, 0.f, 0.f};
#pragma unroll
                for (int ai = 0; ai < 2; ++ai)
#pragma unroll
                    for (int m = 0; m < 4; ++m) acc[ai][bj][m][n] += bv; }
        bool bad = st1.run(acc, u, wr, wc, fr, fq, lds, wid, lane) || poison != 0u;
        const float qnan = __builtin_nanf("");
#pragma unroll
        for (int ai = 0; ai < 2; ++ai)
#pragma unroll
            for (int m = 0; m < 4; ++m) { const int r = ai * HALF + wr * 64 + m * 16 + fr; const f32x2v sr = S[r]; const size_t off = (size_t)(u.pm * BM + r) * ldc + col0;
#pragma unroll
                for (int bj = 0; bj < 2; ++bj)
#pragma unroll
                    for (int n = 0; n < 2; ++n) { const f32x4 bs = *(const f32x4*)(base + off + bj * HALF + n * 16); acc[ai][bj][m][n] = bs + (acc[ai][bj][m][n] - sr.x) * sr.y; }
                asm volatile("" : "+v"(acc[ai][0][m][0]), "+v"(acc[ai][0][m][1]), "+v"(acc[ai][1][m][0]), "+v"(acc[ai][1][m][1]));
                if (m & 1) asm volatile("" ::: "memory"); }
        const bool bad1 = bad;
        bad = st2.run(acc, u, wr, wc, fr, fq, lds, wid, lane) || bad;
#pragma unroll
        for (int ai = 0; ai < 2; ++ai)
#pragma unroll
            for (int m = 0; m < 4; ++m) { const int r = ai * HALF + wr * 64 + m * 16 + fr; const f32x2v sr = S[r]; const size_t off = (size_t)(u.pm * BM + r) * ldc + col0;
#pragma unroll
                for (int bj = 0; bj < 2; ++bj)
#pragma unroll
                    for (int n = 0; n < 2; ++n) { const f32x4 x1 = acc[ai][bj][m][n]; *(f32x4*)(out + off + bj * HALF + n * 16) = bad1 ? (f32x4){qnan, qnan, qnan, qnan} : x1;
                        const f32x4 o = (x1 - sr.x) * sr.y; u32x2v w; w.x = cvt_pk_bf16(o[0], o[1]); w.y = cvt_pk_bf16(o[2], o[3]);
                        if (bad) { w.x = 0x7fc07fc0u; w.y = 0x7fc07fc0u; } *(u32x2v*)(xn + off + bj * HALF + n * 16) = w; }
                asm volatile("" ::: "memory"); }
    }
};

template <class Epi, class Sched, bool ALIGN_EPI = false, bool SP2 = false, int AROW = 0>
__device__ __forceinline__ void gemm_phase(PG8_LAS unsigned char* lds, const Gemm g, const Sched& S, const Epi& E) {
    int tid_ = threadIdx.x; asm volatile("" : "+v"(tid_));
    const int tid = tid_, wid = __builtin_amdgcn_readfirstlane(tid >> 6), lane = tid & 63, wr = wid >> 2, wc = wid & 3, fr = lane & 15, fq = lane >> 4;
    const int K = g.K, nt = K / BK;
    unsigned voffA[2], voffB[2];
#pragma unroll
    for (int i = 0; i < 2; ++i) { int R, C; stage_rc(tid * 16 + i * 8192, R, C); const int Rb = Epi::PERM ? ((R & ~31) + perm32(R & 31)) : R;
        const int Ra = (AROW == 1) ? ((R & ~63) + 4 * (R & 15) + ((R >> 4) & 3)) : R;
        voffA[i] = (unsigned)(Ra * g.lda + C) * 2u; voffB[i] = (unsigned)(Rb * K + C) * 2u;
        if (AROW == 2) { const int tp = 4 * ((lane >> 2) & 3) + (lane >> 4), c = lane & 3;
            voffA[i] = (unsigned)((64 * i + 16 * (wid & 3) + tp) * g.lda + 32 * (wid >> 2) + 8 * c) * 2u; } }
    const size_t kstep = (size_t)(BK * 2);
    const size_t hstep = (size_t)HALF * K * 2;
    const size_t tstep = 2 * hstep;
    const size_t hstepA = (size_t)HALF * g.lda * 2, tstepA = 2 * hstepA;
    const unsigned ldsw = (unsigned)wid * 1024u;
    constexpr int PSTR = 1056, HTBA = (AROW == 2) ? 16 * PSTR : HTB;
    const int aoff = (AROW == 2) ? (wr * 8 + (fr >> 2)) * PSTR + 64 * (fr & 3) + 16 * fq : lds_byte(wr * 64 + fr, fq * 8), boff = lds_byte(wc * 32 + fr, fq * 8);
    constexpr int AM = (AROW == 2) ? 256 : 2048, AK = (AROW == 2) ? 4 * PSTR : 1024;
    const unsigned ldswA = (AROW == 2) ? (unsigned)wid * PSTR : (unsigned)wid * 1024u; constexpr unsigned ISTRA = (AROW == 2) ? 8u * PSTR : 8192u;
#define PG8_SA(b, h) (((b) * 2 + (h)) * HTBA)
#define PG8_SB(b, h) (4 * HTBA + ((b) * 2 + (h)) * HTB)
#define PG8_STAGEA(bufoff, gbase, voff) do { _Pragma("unroll") for (int _i = 0; _i < 2; ++_i) \
        __builtin_amdgcn_global_load_lds((const unsigned*)((const char*)(gbase) + (voff)[_i]), (PG8_LAS unsigned*)(lds + (bufoff) + ldswA + _i * ISTRA), 16, 0, 0); } while (0)
#define PG8_STAGE(bufoff, gbase, voff) do { _Pragma("unroll") for (int _i = 0; _i < 2; ++_i) \
        __builtin_amdgcn_global_load_lds((const unsigned*)((const char*)(gbase) + (voff)[_i]), (PG8_LAS unsigned*)(lds + (bufoff) + ldsw + _i * 8192), 16, 0, 0); } while (0)
#define PG8_LDA(dst, b, h) do { _Pragma("unroll") for (int m = 0; m < 4; ++m) _Pragma("unroll") for (int k = 0; k < 2; ++k) dst[m][k] = *(const PG8_LAS bf16x8*)(lds + PG8_SA(b, h) + aoff + m * AM + k * AK); } while (0)
#define PG8_LDB(dst, b, h) do { _Pragma("unroll") for (int n = 0; n < 2; ++n) _Pragma("unroll") for (int k = 0; k < 2; ++k) dst[n][k] = *(const PG8_LAS bf16x8*)(lds + PG8_SB(b, h) + boff + n * 2048 + k * 1024); } while (0)
#define PG8_MMA(ai, bj, At, Bt) do { __builtin_amdgcn_s_setprio(1); _Pragma("unroll") for (int m = 0; m < 4; ++m) _Pragma("unroll") for (int n = 0; n < 2; ++n) _Pragma("unroll") for (int k = 0; k < 2; ++k) \
        acc[ai][bj][m][n] = __builtin_amdgcn_mfma_f32_16x16x32_bf16(Bt[n][k], At[m][k], acc[ai][bj][m][n], 0, 0, 0); __builtin_amdgcn_s_setprio(0); } while (0)
#define PG8_WAIT_V(n) asm volatile("s_waitcnt vmcnt(" #n ")" ::: "memory")
#define PG8_WAIT_L(n) asm volatile("s_waitcnt lgkmcnt(" #n ")" ::: "memory")
#define PG8_BAR __builtin_amdgcn_s_barrier()
#define PG8_SCHED __builtin_amdgcn_sched_barrier(0)
    Unit cur, nxt; int ui = 0;
    if (!S.next(0, cur)) return;
    f32x4 acc[2][2][4][2];
#pragma unroll
    for (int a = 0; a < 2; ++a)
#pragma unroll
        for (int b = 0; b < 2; ++b)
#pragma unroll
            for (int m = 0; m < 4; ++m)
#pragma unroll
                for (int n = 0; n < 2; ++n) acc[a][b][m][n] = (f32x4){0.f, 0.f, 0.f, 0.f};
    bf16x8 At[4][2], B0[2][2], B1[2][2];
    const char* cA = (const char*)g.A + (size_t)cur.pm * tstepA; const char* cB = (const char*)g.Bt + (size_t)cur.pn * tstep;
    S.a_ready(cur);
    if constexpr (SP2) {
        PG8_STAGE(PG8_SB(0, 0), cB, voffB); PG8_STAGE(PG8_SB(0, 1), cB + hstep, voffB); PG8_STAGEA(PG8_SA(0, 0), cA, voffA); PG8_STAGEA(PG8_SA(0, 1), cA + hstepA, voffA);
        if (wr == 1) PG8_BAR;
        PG8_WAIT_V(2); PG8_BAR;
        PG8_STAGE(PG8_SB(1, 0), cB + kstep, voffB); PG8_STAGEA(PG8_SA(1, 0), cA + kstep, voffA); PG8_STAGE(PG8_SB(1, 1), cB + hstep + kstep, voffB);
        PG8_WAIT_V(6); PG8_BAR;
    } else {
        PG8_STAGE(PG8_SB(0, 0), cB, voffB); PG8_STAGEA(PG8_SA(0, 0), cA, voffA); PG8_STAGE(PG8_SB(0, 1), cB + hstep, voffB); PG8_STAGEA(PG8_SA(0, 1), cA + hstepA, voffA);
        if (wr == 1) PG8_BAR;
        PG8_WAIT_V(4); PG8_BAR;
        PG8_STAGE(PG8_SB(1, 0), cB + kstep, voffB); PG8_STAGEA(PG8_SA(1, 0), cA + kstep, voffA); PG8_STAGE(PG8_SB(1, 1), cB + hstep + kstep, voffB);
        PG8_WAIT_V(6); PG8_BAR;
    }
    for (;;) {
        const bool has_next = S.next(ui + 1, nxt);
        const char* nA = has_next ? (const char*)g.A + (size_t)nxt.pm * tstepA : cA; const char* nB = has_next ? (const char*)g.Bt + (size_t)nxt.pn * tstep : cB;
#pragma unroll 1
        for (int t = 0; t < nt; t += 2) {
            const bool last = (t == nt - 2);
            const char* a1 = cA + (size_t)(t + 1) * kstep;
            const char* a2 = last ? nA : cA + (size_t)(t + 2) * kstep; const char* b2 = last ? nB : cB + (size_t)(t + 2) * kstep;
            const char* a3 = a2 + kstep; const char* b3 = b2 + kstep;
            if (last && has_next) S.a_ready(nxt);
            if constexpr (SP2) {
            PG8_LDB(B0, 0, 0); PG8_LDB(B1, 0, 1); PG8_SCHED; PG8_LDA(At, 0, 0); PG8_STAGEA(PG8_SA(1, 1), a1 + hstepA, voffA);
            PG8_WAIT_V(8); PG8_WAIT_L(0); PG8_BAR; PG8_MMA(0, 0, At, B0); PG8_MMA(0, 1, At, B1); PG8_BAR; PG8_SCHED;
            PG8_LDA(At, 0, 1); PG8_STAGE(PG8_SB(0, 0), b2, voffB); PG8_STAGE(PG8_SB(0, 1), b2 + hstep, voffB); PG8_STAGEA(PG8_SA(0, 0), a2, voffA);
            PG8_WAIT_V(8); PG8_WAIT_L(0); PG8_BAR; PG8_MMA(1, 0, At, B0); PG8_MMA(1, 1, At, B1); PG8_BAR; PG8_SCHED;
            PG8_LDB(B0, 1, 0); PG8_LDB(B1, 1, 1); PG8_SCHED; PG8_LDA(At, 1, 0); PG8_STAGEA(PG8_SA(0, 1), a2 + hstepA, voffA);
            PG8_WAIT_V(8); PG8_WAIT_L(0); PG8_BAR; PG8_MMA(0, 0, At, B0); PG8_MMA(0, 1, At, B1); PG8_BAR; PG8_SCHED;
            PG8_LDA(At, 1, 1); PG8_STAGE(PG8_SB(1, 0), b3, voffB); PG8_STAGE(PG8_SB(1, 1), b3 + hstep, voffB); PG8_STAGEA(PG8_SA(1, 0), a3, voffA);
            PG8_WAIT_V(8); PG8_WAIT_L(0); PG8_BAR; PG8_MMA(1, 0, At, B0); PG8_MMA(1, 1, At, B1); PG8_BAR; PG8_SCHED;
            } else {
            PG8_LDB(B0, 0, 0); PG8_SCHED; PG8_LDA(At, 0, 0); PG8_STAGEA(PG8_SA(1, 1), a1 + hstepA, voffA);
            PG8_WAIT_L(8); PG8_BAR; PG8_WAIT_L(0); PG8_MMA(0, 0, At, B0); PG8_BAR; PG8_SCHED;
            PG8_LDB(B1, 0, 1); PG8_STAGE(PG8_SB(0, 0), b2, voffB);
            PG8_BAR; PG8_WAIT_L(0); PG8_MMA(0, 1, At, B1); PG8_BAR;
            PG8_LDA(At, 0, 1); PG8_STAGEA(PG8_SA(0, 0), a2, voffA);
            PG8_BAR; PG8_WAIT_L(0); PG8_MMA(1, 0, At, B0); PG8_BAR; PG8_SCHED;
            PG8_STAGE(PG8_SB(0, 1), b2 + hstep, voffB);
            PG8_WAIT_V(6); PG8_BAR; PG8_MMA(1, 1, At, B1); PG8_BAR;
            PG8_LDB(B0, 1, 0); PG8_SCHED; PG8_LDA(At, 1, 0); PG8_STAGEA(PG8_SA(0, 1), a2 + hstepA, voffA);
            PG8_WAIT_L(8); PG8_BAR; PG8_WAIT_L(0); PG8_MMA(0, 0, At, B0); PG8_BAR; PG8_SCHED;
            PG8_LDB(B1, 1, 1); PG8_STAGE(PG8_SB(1, 0), b3, voffB);
            PG8_BAR; PG8_WAIT_L(0); PG8_MMA(0, 1, At, B1); PG8_BAR;
            PG8_LDA(At, 1, 1); PG8_STAGEA(PG8_SA(1, 0), a3, voffA);
            PG8_BAR; PG8_WAIT_L(0); PG8_MMA(1, 0, At, B0); PG8_BAR; PG8_SCHED;
            PG8_STAGE(PG8_SB(1, 1), b3 + hstep, voffB);
            PG8_WAIT_V(6); PG8_BAR; PG8_MMA(1, 1, At, B1); PG8_BAR;
            }
        }
        if constexpr (ALIGN_EPI) { if (wr == 0) PG8_BAR; }
        if constexpr (!Epi::AFTER_DRAIN) { E(acc, cur, wr, wc, fr, fq); S.done(cur); }
        if (!has_next) break;
#pragma unroll
        for (int a = 0; a < 2; ++a)
#pragma unroll
            for (int b = 0; b < 2; ++b)
#pragma unroll
                for (int m = 0; m < 4; ++m)
#pragma unroll
                    for (int n = 0; n < 2; ++n) acc[a][b][m][n] = (f32x4){0.f, 0.f, 0.f, 0.f};
        cur = nxt; cA = nA; cB = nB; ++ui;
        if constexpr (ALIGN_EPI) { if (wr == 1) PG8_BAR; }
    }
    PG8_WAIT_V(0);
    if constexpr (!ALIGN_EPI) { if (wr == 0) PG8_BAR; }
    PG8_BAR;
    if constexpr (Epi::AFTER_DRAIN) { E.fused(acc, cur, wr, wc, fr, fq, lds, wid, lane); S.done(cur); }
#undef PG8_SA
#undef PG8_SB
#undef PG8_STAGE
#undef PG8_STAGEA
#undef PG8_LDA
#undef PG8_LDB
#undef PG8_MMA
#undef PG8_WAIT_V
#undef PG8_WAIT_L
#undef PG8_BAR
#undef PG8_SCHED
}
}

#ifndef PG8_SP2
#define PG8_SP2 true
#endif
#ifndef PG8_ALIGN
#define PG8_ALIGN true
#endif
#define GAS __attribute__((address_space(1)))
#define LAS __attribute__((address_space(3)))
typedef unsigned short bf16;
typedef unsigned v4u __attribute__((ext_vector_type(4)));
typedef float f32x4 __attribute__((ext_vector_type(4)));
typedef short bf16x8 __attribute__((ext_vector_type(8)));
typedef GAS unsigned gu32;
typedef GAS unsigned long long gu64;
#define RLX_AGENT __ATOMIC_RELAXED, __HIP_MEMORY_SCOPE_AGENT
#define LDS_WAIT() asm volatile("s_waitcnt lgkmcnt(0)" ::: "memory")
#define VM_WAIT() asm volatile("s_waitcnt vmcnt(0)" ::: "memory")
__device__ __forceinline__ unsigned long long rt() { return __builtin_amdgcn_s_memrealtime(); }
__device__ __forceinline__ unsigned f2bf(float f) { unsigned u = __builtin_bit_cast(unsigned, f); return (u + 0x7fffu + ((u >> 16) & 1u)) >> 16; }
typedef float pk_f32x2_t __attribute__((ext_vector_type(2))); typedef __bf16 pk_bf16x2_t __attribute__((ext_vector_type(2)));
__device__ __forceinline__ unsigned pk2(float lo, float hi) { pk_f32x2_t v = {lo, hi}; pk_bf16x2_t b = __builtin_convertvector(v, pk_bf16x2_t); return __builtin_bit_cast(unsigned, b); }

#define XB_TMO      128
#define XB_XCNT(j)  (256  + 64 * (j))
#define XB_XSUB(j)  (1280 + 64 * (j))
#define XB_XGEN(j)  (2304 + 64 * (j))
#define XB_TOP      3328
#define XB_TOPGEN   3392
#define XCD_BAR_WORDS 3456
#define XB_SPIN_CAP (1u << 18)

__device__ __forceinline__ unsigned xb_ld(unsigned* p)              { return __hip_atomic_load(p, __ATOMIC_RELAXED, __HIP_MEMORY_SCOPE_AGENT); }
__device__ __forceinline__ unsigned xb_add(unsigned* p, unsigned v) { return __hip_atomic_fetch_add(p, v, __ATOMIC_RELAXED, __HIP_MEMORY_SCOPE_AGENT); }
__device__ __forceinline__ unsigned xb_xcc_id() { return (unsigned)__builtin_amdgcn_s_getreg((3 << 11) | 20) & 0xFu; }
#define XB_SPIN(cond, bar) do { unsigned _sp = 0; while (cond) { __builtin_amdgcn_s_sleep(1); \
    if ((++_sp & 255u) == 0u) { if (xb_ld(&(bar)[XB_TMO])) break; if (_sp > XB_SPIN_CAP) { atomicAdd(&(bar)[XB_TMO], 1u); break; } } } } while (0)

struct XcdBarrier {
    unsigned* bar; unsigned x;
    volatile LAS unsigned* st;
};

__device__ __forceinline__ XcdBarrier xcd_barrier_post(unsigned* bar, volatile LAS unsigned* st) {
    XcdBarrier b; b.bar = bar; b.x = xb_xcc_id(); b.st = st;
    if (threadIdx.x == 0) (void)xb_add(&bar[XB_XCNT(b.x)], 1u);
    return b;
}
__device__ __forceinline__ void xcd_barrier_complete(unsigned* bar, unsigned x, unsigned& nloc, unsigned& nx) {
    const unsigned G = gridDim.x * gridDim.y * gridDim.z;
    unsigned sum, cnt, mine, sp = 0u;
    for (;;) {
        sum = 0u; cnt = 0u; mine = 0u;
#pragma unroll
        for (unsigned j = 0; j < 16; ++j) { const unsigned c = xb_ld(&bar[XB_XCNT(j)]); sum += c; cnt += (c > 0u) ? 1u : 0u; mine = (j == x) ? c : mine; }
        if (sum == G) break;
        __builtin_amdgcn_s_sleep(1);
        if ((++sp & 255u) == 0u) { if (xb_ld(&bar[XB_TMO])) break; if (sp > XB_SPIN_CAP) { atomicAdd(&bar[XB_TMO], 1u); break; } }
    }
    nloc = mine > 0u ? mine : 1u; nx = cnt > 0u ? cnt : 1u;
}

__device__ __forceinline__ void xcd_barrier(const XcdBarrier& b) {
    asm volatile("s_waitcnt vmcnt(0)" ::: "memory");
    __syncthreads();
    if (threadIdx.x == 0) {
        unsigned* bar = b.bar;
        __builtin_amdgcn_s_waitcnt(0);
        unsigned nloc = b.st[0], nx = b.st[1];
        if (nloc == 0u) { xcd_barrier_complete(bar, b.x, nloc, nx); b.st[0] = nloc; b.st[1] = nx; }
        const unsigned old = xb_add(&bar[XB_XSUB(b.x)], 1u);
        const unsigned gen = old / nloc;
        if (old + 1u == (gen + 1u) * nloc) {
            __builtin_amdgcn_fence(__ATOMIC_RELEASE, "agent");
            asm volatile("s_waitcnt vmcnt(0)" ::: "memory");
            const unsigned og = xb_add(&bar[XB_TOP], 1u);
            const unsigned tg = og / nx;
            if (og + 1u == (tg + 1u) * nx) xb_add(&bar[XB_TOPGEN], 1u);
            else XB_SPIN(xb_ld(&bar[XB_TOPGEN]) == tg, bar);
            __builtin_amdgcn_fence(__ATOMIC_ACQUIRE, "agent");
            xb_add(&bar[XB_XGEN(b.x)], 1u);
            asm volatile("s_waitcnt vmcnt(0)" ::: "memory");
        } else {
            XB_SPIN(xb_ld(&bar[XB_XGEN(b.x)]) == gen, bar);
            __builtin_amdgcn_fence(__ATOMIC_ACQUIRE, "agent");
            asm volatile("s_waitcnt vmcnt(0)" ::: "memory");
        }
    }
    __syncthreads();
}
__device__ __forceinline__ float bf2f(bf16 v) { return __builtin_bit_cast(float, (unsigned)v << 16); }
__device__ __forceinline__ float bflo(unsigned w) { return __builtin_bit_cast(float, w << 16); }
__device__ __forceinline__ float bfhi(unsigned w) { return __builtin_bit_cast(float, w & 0xffff0000u); }
__device__ __forceinline__ float silu_f(float v) { return v / (1.f + __expf(-v)); }
__device__ __forceinline__ float wave_sum(float v) {
#pragma unroll
    for (int o = 1; o < 64; o <<= 1) v += __shfl_xor(v, o);
    return v;
}


namespace at2 {
typedef short bf16x8 __attribute__((ext_vector_type(8)));
typedef short s16x4 __attribute__((ext_vector_type(4)));
typedef float f32x16 __attribute__((ext_vector_type(16)));
typedef unsigned u32x4 __attribute__((ext_vector_type(4)));
typedef float f32x2_t __attribute__((ext_vector_type(2))); typedef __bf16 bf16x2_t __attribute__((ext_vector_type(2)));
#define AT_LAS __attribute__((address_space(3)))
__device__ __forceinline__ int crow(int r, int hi) { return (r & 3) + 8 * (r >> 2) + 4 * hi; }
__device__ __forceinline__ void glds16(const void* gsrc, unsigned lds_dst) { unsigned keep;
    asm volatile("s_mov_b32 %0, m0\n\ts_mov_b32 m0, %2\n\ts_nop 0\n\tglobal_load_lds_dwordx4 %1, off\n\ts_mov_b32 m0, %0" : "=&s"(keep) : "v"(gsrc), "s"(lds_dst) : "memory"); }
__device__ __forceinline__ unsigned cvtpk(float lo, float hi) { f32x2_t v = {lo, hi}; bf16x2_t b = __builtin_convertvector(v, bf16x2_t); return __builtin_bit_cast(unsigned, b); }
__device__ __forceinline__ float swap_max(float m) { auto rr = __builtin_amdgcn_permlane32_swap(__float_as_uint(m), __float_as_uint(m), false, false); float r; asm("v_max_f32_e32 %0, %1, %2" : "=v"(r) : "v"(__uint_as_float(rr[0])), "v"(__uint_as_float(rr[1]))); return r; }
__device__ __forceinline__ float swap_sum(float m) { auto rr = __builtin_amdgcn_permlane32_swap(__float_as_uint(m), __float_as_uint(m), false, false); return __uint_as_float(rr[0]) + __uint_as_float(rr[1]); }

__device__ __forceinline__ float max3f(float a, float b, float c) { float r; asm("v_max3_f32 %0, %1, %2, %3" : "=v"(r) : "v"(a), "v"(b), "v"(c)); return r; }
__device__ __forceinline__ float max2f(float a, float b) { float r; asm("v_max_f32_e32 %0, %1, %2" : "=v"(r) : "v"(a), "v"(b)); return r; }
constexpr float NEGM = -1e30f;
constexpr float THR = 8.0f;

struct Tensors { const unsigned short* Q; const unsigned short* K; const unsigned short* V; unsigned short* O; int pq, pk, pv, po; };

__device__ __forceinline__ void pv(f32x16* o, int vb, bf16x8 pa0, bf16x8 pa1, bf16x8 pa2, bf16x8 pa3) {
#pragma unroll
    for (int d0 = 0; d0 < 2; ++d0) { s16x4 lo[4], hi[4];
#pragma unroll
        for (int ks = 0; ks < 4; ++ks) {
            asm volatile("ds_read_b64_tr_b16 %0,%1 offset:%c2" : "=&v"(lo[ks]) : "v"(vb), "i"(d0 * 4096 + ks * 1024) : "memory");
            asm volatile("ds_read_b64_tr_b16 %0,%1 offset:%c2" : "=&v"(hi[ks]) : "v"(vb), "i"(d0 * 4096 + ks * 1024 + 512) : "memory"); }
        asm volatile("s_waitcnt lgkmcnt(0)" ::: "memory"); __builtin_amdgcn_sched_barrier(0);
#define AT_PK(k) (bf16x8){lo[k][0], lo[k][1], lo[k][2], lo[k][3], hi[k][0], hi[k][1], hi[k][2], hi[k][3]}
        o[d0] = __builtin_amdgcn_mfma_f32_32x32x16_bf16(pa0, AT_PK(0), o[d0], 0, 0, 0);
        o[d0] = __builtin_amdgcn_mfma_f32_32x32x16_bf16(pa1, AT_PK(1), o[d0], 0, 0, 0);
        o[d0] = __builtin_amdgcn_mfma_f32_32x32x16_bf16(pa2, AT_PK(2), o[d0], 0, 0, 0);
        o[d0] = __builtin_amdgcn_mfma_f32_32x32x16_bf16(pa3, AT_PK(3), o[d0], 0, 0, 0);
#undef AT_PK
    }
}

typedef short v4i16_t __attribute__((ext_vector_type(4)));
__device__ __forceinline__ s16x4 vtr(const AT_LAS unsigned char* p) { return __builtin_bit_cast(s16x4, __builtin_amdgcn_ds_read_tr16_b64_v4i16((AT_LAS v4i16_t*)p)); }
__device__ __forceinline__ void pv2(f32x16* o, const AT_LAS unsigned char* vp, bf16x8 pa0, bf16x8 pa1, bf16x8 pa2, bf16x8 pa3) {
#pragma unroll
    for (int d0 = 0; d0 < 2; ++d0) { s16x4 lo[4], hi[4];
#pragma unroll
        for (int ks = 0; ks < 4; ++ks) { lo[ks] = vtr(vp + d0 * 4096 + ks * 1024); hi[ks] = vtr(vp + d0 * 4096 + ks * 1024 + 512); }
#define AT_PK(k) (bf16x8){lo[k][0], lo[k][1], lo[k][2], lo[k][3], hi[k][0], hi[k][1], hi[k][2], hi[k][3]}
        o[d0] = __builtin_amdgcn_mfma_f32_32x32x16_bf16(pa0, AT_PK(0), o[d0], 0, 0, 0);
        o[d0] = __builtin_amdgcn_mfma_f32_32x32x16_bf16(pa1, AT_PK(1), o[d0], 0, 0, 0);
        o[d0] = __builtin_amdgcn_mfma_f32_32x32x16_bf16(pa2, AT_PK(2), o[d0], 0, 0, 0);
        o[d0] = __builtin_amdgcn_mfma_f32_32x32x16_bf16(pa3, AT_PK(3), o[d0], 0, 0, 0);
#undef AT_PK
    }
}

template <int DQ, bool MOBA, bool QNORM, int G>
__device__ __forceinline__ void attn_unit(AT_LAS unsigned char* lds, const Tensors& T, long rowbase, int qb, const float* km, const float* qg, const float* tab) {
    constexpr int NKP = DQ / 8, NP = NKP + 8, SLOTB = NKP * 1024 + 8192, ND0 = DQ / 16;
    constexpr int NSLOT = 3 * G, LDS_WS = NSLOT * SLOTB, LDS_OST = 0;
    int tid_ = threadIdx.x; asm volatile("" : "+v"(tid_));
    const int tid = tid_, lane = tid & 63, r32 = lane & 31, hi = lane >> 5; const int wid = __builtin_amdgcn_readfirstlane(tid >> 6);
    const int q0 = qb * 256, NT = 4 * (qb + 1);
    const unsigned lds0 = (unsigned)(size_t)lds;
    AT_LAS float* wsf = (AT_LAS float*)(lds + LDS_WS) + wid * 64;
    asm volatile("s_waitcnt vmcnt(0)" ::: "memory");
    const unsigned short* src[3]; unsigned dsto[3];
#pragma unroll
    for (int k = 0; k < 3; ++k) { const int pi = wid + 8 * k;
        if (pi < NKP) { src[k] = (T.pk == 0) ? T.K + pi * 512 + lane * 8 : T.K + (rowbase + lane) * T.pk + 8 * pi; dsto[k] = pi * 1024; }
        else { const int v = pi - NKP; src[k] = (T.pv == 0) ? T.V + v * 512 + lane * 8 : T.V + (rowbase + 16 * (v & 3) + (lane >> 2)) * T.pv + 32 * (v >> 2) + 8 * (lane & 3); dsto[k] = NKP * 1024 + v * 1024; } }
    const long kstep = (T.pk == 0) ? (long)NKP * 512 : (long)64 * T.pk, vstep = (T.pv == 0) ? (long)4096 : (long)64 * T.pv;
#define AT_DMA(t, slot) do { _Pragma("unroll") for (int k_ = 0; k_ < 3; ++k_) { const int pi_ = wid + 8 * k_; if (pi_ < NP) { \
        const unsigned short* s_ = src[k_] + (long)(t) * ((pi_ < NKP) ? kstep : vstep); glds16(s_, (unsigned)__builtin_amdgcn_readfirstlane(lds0 + (slot) * SLOTB + dsto[k_])); } } } while (0)
    _Pragma("unroll") for (int i_ = 0; i_ < G; ++i_) AT_DMA(i_, i_);
    __builtin_amdgcn_sched_barrier(0);
    bf16x8 qr[ND0];
    { const unsigned short* Qw = T.Q + (rowbase + q0 + wid * 32 + r32) * T.pq + hi * 8;
#pragma unroll
      for (int d0 = 0; d0 < ND0; ++d0) qr[d0] = *(const bf16x8*)(Qw + d0 * 16); }
    __builtin_amdgcn_sched_barrier(0);
    if constexpr (QNORM) {
        float s = 0.f;
#pragma unroll
        for (int d0 = 0; d0 < ND0; ++d0)
#pragma unroll
            for (int j = 0; j < 8; ++j) { const float x = bf2f((unsigned short)qr[d0][j]); s += x * x; }
        s = swap_sum(s);
        const float rstd = 0.14724445073472677f / sqrtf(s * (1.f / 96.f) + 1e-6f);
#pragma unroll
        for (int d0 = 0; d0 < 4; ++d0) { const f32x4 g0 = *(const f32x4*)(qg + d0 * 16 + hi * 8), g1 = *(const f32x4*)(qg + d0 * 16 + hi * 8 + 4); u32x4 w;
            w.x = cvtpk(bf2f((unsigned short)qr[d0][0]) * rstd * g0.x, bf2f((unsigned short)qr[d0][1]) * rstd * g0.y); w.y = cvtpk(bf2f((unsigned short)qr[d0][2]) * rstd * g0.z, bf2f((unsigned short)qr[d0][3]) * rstd * g0.w);
            w.z = cvtpk(bf2f((unsigned short)qr[d0][4]) * rstd * g1.x, bf2f((unsigned short)qr[d0][5]) * rstd * g1.y); w.w = cvtpk(bf2f((unsigned short)qr[d0][6]) * rstd * g1.z, bf2f((unsigned short)qr[d0][7]) * rstd * g1.w);
            qr[d0] = __builtin_bit_cast(bf16x8, w); asm volatile("" : "+v"(qr[d0])); }
        { const int pos = q0 + wid * 32 + r32; const float* tb = tab + (pos * 16 + hi * 8) * 2; const float* ga = qg + 64 + hi * 8; const float* gb = qg + 80 + hi * 8; float oa[8], ob[8];
#pragma unroll
          for (int j = 0; j < 8; ++j) { const float x1 = bf2f((unsigned short)qr[4][j]) * rstd * ga[j], x2 = bf2f((unsigned short)qr[5][j]) * rstd * gb[j]; const float c = tb[2 * j], sn = tb[2 * j + 1]; oa[j] = x1 * c - x2 * sn; ob[j] = x1 * sn + x2 * c; }
          u32x4 w; w.x = cvtpk(oa[0], oa[1]); w.y = cvtpk(oa[2], oa[3]); w.z = cvtpk(oa[4], oa[5]); w.w = cvtpk(oa[6], oa[7]); qr[4] = __builtin_bit_cast(bf16x8, w);
          w.x = cvtpk(ob[0], ob[1]); w.y = cvtpk(ob[2], ob[3]); w.z = cvtpk(ob[4], ob[5]); w.w = cvtpk(ob[6], ob[7]); qr[5] = __builtin_bit_cast(bf16x8, w); }
    }
    __builtin_amdgcn_sched_barrier(0);
    unsigned sel = 0xffffffffu;
    if (MOBA) {
        sel = 0u; float gate[8];
#pragma unroll
        for (int j = 0; j < 7; ++j) { float a = 0.f;
            if (j < qb) { const float* kj = km + j * 512 + hi * 8;
#pragma unroll
                for (int d0 = 0; d0 < ND0; ++d0) { const f32x4 k0 = *(const f32x4*)(kj + d0 * 16), k1 = *(const f32x4*)(kj + d0 * 16 + 4);
                    a += bf2f((unsigned short)qr[d0][0]) * k0.x + bf2f((unsigned short)qr[d0][1]) * k0.y + bf2f((unsigned short)qr[d0][2]) * k0.z + bf2f((unsigned short)qr[d0][3]) * k0.w
                       + bf2f((unsigned short)qr[d0][4]) * k1.x + bf2f((unsigned short)qr[d0][5]) * k1.y + bf2f((unsigned short)qr[d0][6]) * k1.z + bf2f((unsigned short)qr[d0][7]) * k1.w; } }
            a = swap_sum(a); gate[j] = (j < qb) ? a : -INFINITY; }
        gate[7] = -INFINITY;
#pragma unroll
        for (int r = 0; r < 3; ++r) { int best = -1; float bv = -INFINITY;
#pragma unroll
            for (int j = 0; j < 8; ++j) if (!((sel >> j) & 1u) && gate[j] > bv) { bv = gate[j]; best = j; }
            if (best >= 0) sel |= 1u << best; }
    }
    __builtin_amdgcn_sched_barrier(0);
    float mhat = 0.f, l = 0.f; f32x16 o[2]; o[0] = f32x16{}; o[1] = f32x16{};
    const int qrel = wid * 32 + r32;
    const int vbl = ((lane >> 4) & 1) * 32 + (lane & 3) * 8 + (4 * hi + ((lane & 15) >> 2)) * 64;
#define AT_GROUP(u) do { asm volatile("s_waitcnt vmcnt(0) lgkmcnt(0)\n\ts_barrier" ::: "memory"); \
        if ((u) + G < NT) { _Pragma("unroll") for (int i_ = 0; i_ < G; ++i_) { const int tt_ = (u) + G + i_; AT_DMA(tt_, tt_ % NSLOT); } } } while (0)
#define AT_KLOAD(sl) do { const AT_LAS unsigned char* kb = lds + (sl) * SLOTB + hi * 1024 + r32 * 16; \
        _Pragma("unroll") for (int d0 = 0; d0 < ND0; ++d0) { kf[2 * d0] = *(const AT_LAS bf16x8*)(kb + d0 * 2048); kf[2 * d0 + 1] = *(const AT_LAS bf16x8*)(kb + d0 * 2048 + 512); } } while (0)
    bf16x8 kf[2 * ND0]; s16x4 vlo[8], vhi[8];
    AT_GROUP(0);
    AT_KLOAD(0);
    int slot = 0;
    for (int t = 0; t < NT; ++t) {
        __builtin_amdgcn_sched_barrier(0);
        { const AT_LAS unsigned char* vp = lds + slot * SLOTB + NKP * 1024 + vbl;
#pragma unroll
          for (int i = 0; i < 8; ++i) { vlo[i] = vtr(vp + (i >> 2) * 4096 + (i & 3) * 1024); vhi[i] = vtr(vp + (i >> 2) * 4096 + (i & 3) * 1024 + 512); } }
        __builtin_amdgcn_sched_barrier(0);
        f32x16 p0, p1;
#pragma unroll
        for (int d0 = 0; d0 < ND0; ++d0) {
            if (d0 == 0) { p0 = __builtin_amdgcn_mfma_f32_32x32x16_bf16(kf[0], qr[0], f32x16{}, 0, 0, 0); p1 = __builtin_amdgcn_mfma_f32_32x32x16_bf16(kf[1], qr[0], f32x16{}, 0, 0, 0); }
            else { p0 = __builtin_amdgcn_mfma_f32_32x32x16_bf16(kf[2 * d0], qr[d0], p0, 0, 0, 0); p1 = __builtin_amdgcn_mfma_f32_32x32x16_bf16(kf[2 * d0 + 1], qr[d0], p1, 0, 0, 0); } }
        __builtin_amdgcn_sched_barrier(0);
        const int nslot = (slot == NSLOT - 1) ? 0 : slot + 1;
        if (t + 1 < NT) { if (((t + 1) % G) == 0) AT_GROUP(t + 1); AT_KLOAD(nslot); }
        __builtin_amdgcn_sched_barrier(0);
        const int jb = t - (NT - 4);
        if (jb >= 0) { const int kb0 = 64 * jb + 4 * hi;
#pragma unroll
            for (int r = 0; r < 16; ++r) { const int kv = kb0 + (r & 3) + 8 * (r >> 2); if (kv > qrel) p0[r] = NEGM; if (kv + 32 > qrel) p1[r] = NEGM; } }
        else if (MOBA) { const bool keep = ((sel >> (t >> 2)) & 1u) != 0u;
            if (!__all(keep)) { if (!keep) {
#pragma unroll
                for (int r = 0; r < 16; ++r) { p0[r] = NEGM; p1[r] = NEGM; } } } }
        float rm;
        { float a_ = fmaxf(fmaxf(p0[0], p0[1]), p1[0]), b_ = fmaxf(fmaxf(p0[2], p0[3]), p1[1]); a_ = fmaxf(fmaxf(a_, p1[2]), p1[3]);
#pragma unroll
          for (int r = 4; r < 16; r += 4) { a_ = fmaxf(fmaxf(a_, p0[r]), p0[r + 1]); b_ = fmaxf(fmaxf(b_, p0[r + 2]), p0[r + 3]); a_ = fmaxf(fmaxf(a_, p1[r]), p1[r + 1]); b_ = fmaxf(fmaxf(b_, p1[r + 2]), p1[r + 3]); }
          rm = swap_max(fmaxf(a_, b_)) - mhat; }
        if (__any(rm > THR)) {
            const float dl = fmaxf(rm, 0.f); mhat += dl;
            const float alpha = __builtin_amdgcn_exp2f(-dl); l *= alpha;
            if (hi == 0) wsf[r32] = alpha;
            asm volatile("s_waitcnt lgkmcnt(0)" ::: "memory");
#pragma unroll
            for (int r = 0; r < 16; ++r) { const float f = wsf[crow(r, hi)]; o[0][r] *= f; o[1][r] *= f; }
        }
        float sacc = 0.f;
#pragma unroll
        for (int r = 0; r < 16; ++r) { p0[r] = __builtin_amdgcn_exp2f(p0[r] - mhat); p1[r] = __builtin_amdgcn_exp2f(p1[r] - mhat); sacc += p0[r] + p1[r]; }
        l += sacc;
        u32x4 pw[4];
        pw[0] = (u32x4){cvtpk(p0[0], p0[1]), cvtpk(p0[2], p0[3]), cvtpk(p0[4], p0[5]), cvtpk(p0[6], p0[7])};
        pw[1] = (u32x4){cvtpk(p0[8], p0[9]), cvtpk(p0[10], p0[11]), cvtpk(p0[12], p0[13]), cvtpk(p0[14], p0[15])};
        pw[2] = (u32x4){cvtpk(p1[0], p1[1]), cvtpk(p1[2], p1[3]), cvtpk(p1[4], p1[5]), cvtpk(p1[6], p1[7])};
        pw[3] = (u32x4){cvtpk(p1[8], p1[9]), cvtpk(p1[10], p1[11]), cvtpk(p1[12], p1[13]), cvtpk(p1[14], p1[15])};
        __builtin_amdgcn_sched_barrier(0);
#pragma unroll
        for (int d0 = 0; d0 < 2; ++d0)
#pragma unroll
            for (int ks = 0; ks < 4; ++ks) { const int i = d0 * 4 + ks;
                o[d0] = __builtin_amdgcn_mfma_f32_32x32x16_bf16(__builtin_bit_cast(bf16x8, pw[ks]), (bf16x8){vlo[i][0], vlo[i][1], vlo[i][2], vlo[i][3], vhi[i][0], vhi[i][1], vhi[i][2], vhi[i][3]}, o[d0], 0, 0, 0); }
        slot = nslot;
    }
#undef AT_GROUP
#undef AT_KLOAD
#undef AT_DMA
    asm volatile("s_waitcnt lgkmcnt(0)\n\ts_barrier" ::: "memory");
    l = swap_sum(l);
    if (hi == 0) wsf[32 + r32] = l;
    asm volatile("s_waitcnt lgkmcnt(0)" ::: "memory");
    float rli[16];
#pragma unroll
    for (int r = 0; r < 16; ++r) rli[r] = __builtin_amdgcn_rcpf(wsf[32 + crow(r, hi)]);
    unsigned short* Ow = T.O + (rowbase + q0 + wid * 32) * T.po;
    { AT_LAS unsigned short* stg = (AT_LAS unsigned short*)(lds + LDS_OST) + wid * 2048;
#pragma unroll
      for (int r = 0; r < 16; ++r) { const int orow = crow(r, hi);
#pragma unroll
          for (int d0 = 0; d0 < 2; ++d0) stg[orow * 64 + d0 * 32 + r32] = (unsigned short)f2bf(o[d0][r] * rli[r]); }
      asm volatile("s_waitcnt lgkmcnt(0)" ::: "memory");
#pragma unroll
      for (int i = 0; i < 4; ++i) { const int row = i * 8 + (lane >> 3), ch = lane & 7; const u32x4 v = *(const AT_LAS u32x4*)(stg + row * 64 + ch * 8); *(u32x4*)(Ow + (long)row * T.po + ch * 8) = v; } }
    asm volatile("s_waitcnt lgkmcnt(0)\n\ts_barrier" ::: "memory");
}
template <int DQ, bool MOBA, bool QNORM, int G>
__device__ __forceinline__ void attn_unit_p(AT_LAS unsigned char* lds, const Tensors& T, long rowbase, int qb, const float* km, const float* qg, const float* tab, float kbound) {
    constexpr int NKP = DQ / 8, NP = NKP + 8, SLOTB = NKP * 1024 + 8192, ND0 = DQ / 16;
    constexpr int NSLOT = 3 * G, LDS_WS = NSLOT * SLOTB, LDS_OST = 0;
    int tid_ = threadIdx.x; asm volatile("" : "+v"(tid_));
    const int tid = tid_, lane = tid & 63, r32 = lane & 31, hi = lane >> 5; const int wid = __builtin_amdgcn_readfirstlane(tid >> 6);
    const int q0 = qb * 256, NT = 4 * (qb + 1);
    const unsigned lds0 = (unsigned)(size_t)lds;
    AT_LAS float* wsf = (AT_LAS float*)(lds + LDS_WS) + wid * 64;
    asm volatile("s_waitcnt vmcnt(0)" ::: "memory");
    const unsigned short* src[3]; unsigned dsto[3];
#pragma unroll
    for (int k = 0; k < 3; ++k) { const int pi = wid + 8 * k;
        if (pi < NKP) { src[k] = (T.pk == 0) ? T.K + pi * 512 + lane * 8 : T.K + (rowbase + lane) * T.pk + 8 * pi; dsto[k] = pi * 1024; }
        else { const int v = pi - NKP; src[k] = (T.pv == 0) ? T.V + v * 512 + lane * 8 : T.V + (rowbase + 16 * (v & 3) + (lane >> 2)) * T.pv + 32 * (v >> 2) + 8 * (lane & 3); dsto[k] = NKP * 1024 + v * 1024; } }
    const long kstep = (T.pk == 0) ? (long)NKP * 512 : (long)64 * T.pk, vstep = (T.pv == 0) ? (long)4096 : (long)64 * T.pv;
#define AT_DMA(t, slot) do { _Pragma("unroll") for (int k_ = 0; k_ < 3; ++k_) { const int pi_ = wid + 8 * k_; if (pi_ < NP) { \
        const unsigned short* s_ = src[k_] + (long)(t) * ((pi_ < NKP) ? kstep : vstep); glds16(s_, (unsigned)__builtin_amdgcn_readfirstlane(lds0 + (slot) * SLOTB + dsto[k_])); } } } while (0)
    _Pragma("unroll") for (int i_ = 0; i_ < G; ++i_) AT_DMA(i_, i_);
    __builtin_amdgcn_sched_barrier(0);
    bf16x8 qr[ND0];
    { const unsigned short* Qw = T.Q + (rowbase + q0 + wid * 32 + r32) * T.pq + hi * 8;
#pragma unroll
      for (int d0 = 0; d0 < ND0; ++d0) qr[d0] = *(const bf16x8*)(Qw + d0 * 16); }
    __builtin_amdgcn_sched_barrier(0);
    if constexpr (QNORM) {
        float s = 0.f;
#pragma unroll
        for (int d0 = 0; d0 < ND0; ++d0)
#pragma unroll
            for (int j = 0; j < 8; ++j) { const float x = bf2f((unsigned short)qr[d0][j]); s += x * x; }
        s = swap_sum(s);
        const float rstd = 0.14724445073472677f / sqrtf(s * (1.f / 96.f) + 1e-6f);
#pragma unroll
        for (int d0 = 0; d0 < 4; ++d0) { const f32x4 g0 = *(const f32x4*)(qg + d0 * 16 + hi * 8), g1 = *(const f32x4*)(qg + d0 * 16 + hi * 8 + 4); u32x4 w;
            w.x = cvtpk(bf2f((unsigned short)qr[d0][0]) * rstd * g0.x, bf2f((unsigned short)qr[d0][1]) * rstd * g0.y); w.y = cvtpk(bf2f((unsigned short)qr[d0][2]) * rstd * g0.z, bf2f((unsigned short)qr[d0][3]) * rstd * g0.w);
            w.z = cvtpk(bf2f((unsigned short)qr[d0][4]) * rstd * g1.x, bf2f((unsigned short)qr[d0][5]) * rstd * g1.y); w.w = cvtpk(bf2f((unsigned short)qr[d0][6]) * rstd * g1.z, bf2f((unsigned short)qr[d0][7]) * rstd * g1.w);
            qr[d0] = __builtin_bit_cast(bf16x8, w); asm volatile("" : "+v"(qr[d0])); }
        { const int pos = q0 + wid * 32 + r32; const float* tb = tab + (pos * 16 + hi * 8) * 2; const float* ga = qg + 64 + hi * 8; const float* gb = qg + 80 + hi * 8; float oa[8], ob[8];
#pragma unroll
          for (int j = 0; j < 8; ++j) { const float x1 = bf2f((unsigned short)qr[4][j]) * rstd * ga[j], x2 = bf2f((unsigned short)qr[5][j]) * rstd * gb[j]; const float c = tb[2 * j], sn = tb[2 * j + 1]; oa[j] = x1 * c - x2 * sn; ob[j] = x1 * sn + x2 * c; }
          u32x4 w; w.x = cvtpk(oa[0], oa[1]); w.y = cvtpk(oa[2], oa[3]); w.z = cvtpk(oa[4], oa[5]); w.w = cvtpk(oa[6], oa[7]); qr[4] = __builtin_bit_cast(bf16x8, w);
          w.x = cvtpk(ob[0], ob[1]); w.y = cvtpk(ob[2], ob[3]); w.z = cvtpk(ob[4], ob[5]); w.w = cvtpk(ob[6], ob[7]); qr[5] = __builtin_bit_cast(bf16x8, w); }
    }
    __builtin_amdgcn_sched_barrier(0);
    unsigned sel = 0xffffffffu;
    if (MOBA) {
        sel = 0u; float gate[8];
#pragma unroll
        for (int j = 0; j < 7; ++j) { float a = 0.f;
            if (j < qb) { const float* kj = km + j * 512 + hi * 8;
#pragma unroll
                for (int d0 = 0; d0 < ND0; ++d0) { const f32x4 k0 = *(const f32x4*)(kj + d0 * 16), k1 = *(const f32x4*)(kj + d0 * 16 + 4);
                    a += bf2f((unsigned short)qr[d0][0]) * k0.x + bf2f((unsigned short)qr[d0][1]) * k0.y + bf2f((unsigned short)qr[d0][2]) * k0.z + bf2f((unsigned short)qr[d0][3]) * k0.w
                       + bf2f((unsigned short)qr[d0][4]) * k1.x + bf2f((unsigned short)qr[d0][5]) * k1.y + bf2f((unsigned short)qr[d0][6]) * k1.z + bf2f((unsigned short)qr[d0][7]) * k1.w; } }
            a = swap_sum(a); gate[j] = (j < qb) ? a : -INFINITY; }
        gate[7] = -INFINITY;
#pragma unroll
        for (int r = 0; r < 3; ++r) { int best = -1; float bv = -INFINITY;
#pragma unroll
            for (int j = 0; j < 8; ++j) if (!((sel >> j) & 1u) && gate[j] > bv) { bv = gate[j]; best = j; }
            if (best >= 0) sel |= 1u << best; }
    }
    __builtin_amdgcn_sched_barrier(0);
    float l = 0.f; f32x16 o[2]; o[0] = f32x16{}; o[1] = f32x16{};
    f32x16 negm;
    { float qss = 0.f;
#pragma unroll
      for (int d0 = 0; d0 < ND0; ++d0)
#pragma unroll
          for (int j = 0; j < 8; ++j) { const float x = bf2f((unsigned short)qr[d0][j]); qss += x * x; }
      qss = swap_sum(qss); const float mrow = sqrtf(qss) * kbound;
#pragma unroll
      for (int r = 0; r < 16; ++r) negm[r] = -mrow;
      asm volatile("" : "+v"(negm)); }

    const int qrel = wid * 32 + r32;
    const int vbl = ((lane >> 4) & 1) * 32 + (lane & 3) * 8 + (4 * hi + ((lane & 15) >> 2)) * 64;
#define AT_GROUP(u) do { asm volatile("s_waitcnt vmcnt(0) lgkmcnt(0)\n\ts_barrier" ::: "memory"); \
        if ((u) + G < NT) { _Pragma("unroll") for (int i_ = 0; i_ < G; ++i_) { const int tt_ = (u) + G + i_; AT_DMA(tt_, tt_ % NSLOT); } } } while (0)
#define AT_KLOAD(sl) do { const AT_LAS unsigned char* kb = lds + (sl) * SLOTB + hi * 1024 + r32 * 16; \
        _Pragma("unroll") for (int d0 = 0; d0 < ND0; ++d0) { kf[2 * d0] = *(const AT_LAS bf16x8*)(kb + d0 * 2048); kf[2 * d0 + 1] = *(const AT_LAS bf16x8*)(kb + d0 * 2048 + 512); } } while (0)
#define AT_VLOAD(sl) do { const AT_LAS unsigned char* vp = lds + (sl) * SLOTB + NKP * 1024 + vbl; \
        _Pragma("unroll") for (int i = 0; i < 8; ++i) { vlo[i] = vtr(vp + (i >> 2) * 4096 + (i & 3) * 1024); vhi[i] = vtr(vp + (i >> 2) * 4096 + (i & 3) * 1024 + 512); } } while (0)
#define AT_SUMPACK() do { float sacc = 0.f; \
        _Pragma("unroll") for (int r = 0; r < 16; ++r) sacc += c0[r] + c1[r]; \
        l += sacc; \
        pw[0] = (u32x4){cvtpk(c0[0], c0[1]), cvtpk(c0[2], c0[3]), cvtpk(c0[4], c0[5]), cvtpk(c0[6], c0[7])}; \
        pw[1] = (u32x4){cvtpk(c0[8], c0[9]), cvtpk(c0[10], c0[11]), cvtpk(c0[12], c0[13]), cvtpk(c0[14], c0[15])}; \
        pw[2] = (u32x4){cvtpk(c1[0], c1[1]), cvtpk(c1[2], c1[3]), cvtpk(c1[4], c1[5]), cvtpk(c1[6], c1[7])}; \
        pw[3] = (u32x4){cvtpk(c1[8], c1[9]), cvtpk(c1[10], c1[11]), cvtpk(c1[12], c1[13]), cvtpk(c1[14], c1[15])}; } while (0)
#define AT_QKT(N0, N1) do { _Pragma("unroll") for (int d0 = 0; d0 < ND0; ++d0) { \
            if (d0 == 0) { N0 = __builtin_amdgcn_mfma_f32_32x32x16_bf16(kf[0], qr[0], negm, 0, 0, 0); N1 = __builtin_amdgcn_mfma_f32_32x32x16_bf16(kf[1], qr[0], negm, 0, 0, 0); } \
            else { N0 = __builtin_amdgcn_mfma_f32_32x32x16_bf16(kf[2 * d0], qr[d0], N0, 0, 0, 0); N1 = __builtin_amdgcn_mfma_f32_32x32x16_bf16(kf[2 * d0 + 1], qr[d0], N1, 0, 0, 0); } } } while (0)
#define AT_DECIDE(tt) do { \
        { const int jb = (tt) - (NT - 4); \
          if (jb >= 0) { const int kb0 = 64 * jb + 4 * hi; \
              _Pragma("unroll") for (int r = 0; r < 16; ++r) { const int kv = kb0 + (r & 3) + 8 * (r >> 2); if (kv > qrel) c0[r] = NEGM; if (kv + 32 > qrel) c1[r] = NEGM; } } \
          else if (MOBA) { const bool keep = ((sel >> ((tt) >> 2)) & 1u) != 0u; \
              if (!__all(keep)) { if (!keep) { _Pragma("unroll") for (int r = 0; r < 16; ++r) { c0[r] = NEGM; c1[r] = NEGM; } } } } } \
        } while (0)
#define AT_EXPS() do { _Pragma("unroll") for (int r = 0; r < 16; ++r) { c0[r] = __builtin_amdgcn_exp2f(c0[r]); c1[r] = __builtin_amdgcn_exp2f(c1[r]); } } while (0)
#define AT_PV() do { _Pragma("unroll") for (int d0 = 0; d0 < 2; ++d0) _Pragma("unroll") for (int ks = 0; ks < 4; ++ks) { const int i = d0 * 4 + ks; \
            o[d0] = __builtin_amdgcn_mfma_f32_32x32x16_bf16(__builtin_bit_cast(bf16x8, pw[ks]), (bf16x8){vlo[i][0], vlo[i][1], vlo[i][2], vlo[i][3], vhi[i][0], vhi[i][1], vhi[i][2], vhi[i][3]}, o[d0], 0, 0, 0); } } while (0)
#define AT_SGB(mask, n) __builtin_amdgcn_sched_group_barrier(mask, n, 0)
    constexpr int NG = 2 * ND0;
    bf16x8 kf[2 * ND0]; s16x4 vlo[8], vhi[8]; u32x4 pw[4]; f32x16 c0, c1;
    AT_GROUP(0);
    AT_KLOAD(0);
    AT_QKT(c0, c1);
    AT_DECIDE(0);
    AT_KLOAD(1 % NSLOT);
    AT_EXPS();
    int slot = 1 % NSLOT, pslot = 0;
    for (int t = 1; t < NT; ++t) {
        const int nslot = (t + 1 < NT) ? ((slot == NSLOT - 1) ? 0 : slot + 1) : slot;
        if (t + 1 < NT && ((t + 1) % G) == 0) AT_GROUP(t + 1);
        __builtin_amdgcn_sched_barrier(0);
        { f32x16 n0, n1; float sacc = 0.f;
          const AT_LAS unsigned char* vp = lds + pslot * SLOTB + NKP * 1024 + vbl; const AT_LAS unsigned char* kbn = lds + nslot * SLOTB + hi * 1024 + r32 * 16;
#pragma unroll
          for (int i = 0; i < NG; ++i) {
              if (i >= 1) kf[i - 1] = *(const AT_LAS bf16x8*)(kbn + ((i - 1) >> 1) * 2048 + ((i - 1) & 1) * 512);
              if (i >= NG - 2) { const int vi = i - (NG - 2); vlo[vi] = vtr(vp + (vi >> 2) * 4096 + (vi & 3) * 1024); vhi[vi] = vtr(vp + (vi >> 2) * 4096 + (vi & 3) * 1024 + 512); }
              const int d0 = i >> 1;
              if (i & 1) n1 = (d0 == 0) ? __builtin_amdgcn_mfma_f32_32x32x16_bf16(kf[i], qr[d0], negm, 0, 0, 0) : __builtin_amdgcn_mfma_f32_32x32x16_bf16(kf[i], qr[d0], n1, 0, 0, 0);
              else n0 = (d0 == 0) ? __builtin_amdgcn_mfma_f32_32x32x16_bf16(kf[i], qr[d0], negm, 0, 0, 0) : __builtin_amdgcn_mfma_f32_32x32x16_bf16(kf[i], qr[d0], n0, 0, 0, 0);
#pragma unroll
              for (int rr = (i * 32) / NG; rr < ((i + 1) * 32) / NG; ++rr) sacc += (rr < 16) ? c0[rr] : c1[rr - 16];
#pragma unroll
              for (int ww = (i * 16) / NG; ww < ((i + 1) * 16) / NG; ++ww) { const int e = 2 * ww; pw[ww >> 2][ww & 3] = (e < 16) ? cvtpk(c0[e], c0[e + 1]) : cvtpk(c1[e - 16], c1[e - 15]); }
              __builtin_amdgcn_sched_barrier(0); }
          kf[NG - 1] = *(const AT_LAS bf16x8*)(kbn + ((NG - 1) >> 1) * 2048 + ((NG - 1) & 1) * 512);
          l += sacc; c0 = n0; c1 = n1; }
        AT_DECIDE(t);
        __builtin_amdgcn_sched_barrier(0);
        { const AT_LAS unsigned char* vpB = lds + pslot * SLOTB + NKP * 1024 + vbl;
#pragma unroll
          for (int i = 0; i < 8; ++i) {
              if (i + 2 < 8) { const int vi = i + 2; vlo[vi] = vtr(vpB + (vi >> 2) * 4096 + (vi & 3) * 1024); vhi[vi] = vtr(vpB + (vi >> 2) * 4096 + (vi & 3) * 1024 + 512); }
              o[i >> 2] = __builtin_amdgcn_mfma_f32_32x32x16_bf16(__builtin_bit_cast(bf16x8, pw[i & 3]), (bf16x8){vlo[i][0], vlo[i][1], vlo[i][2], vlo[i][3], vhi[i][0], vhi[i][1], vhi[i][2], vhi[i][3]}, o[i >> 2], 0, 0, 0);
#pragma unroll
              for (int rr = 4 * i; rr < 4 * i + 4; ++rr) { if (rr < 16) c0[rr] = __builtin_amdgcn_exp2f(c0[rr]); else c1[rr - 16] = __builtin_amdgcn_exp2f(c1[rr - 16]); }
              __builtin_amdgcn_sched_barrier(0); } }
        pslot = slot; slot = nslot;
    }
    AT_VLOAD(pslot);
    AT_SUMPACK();
    AT_PV();
#undef AT_GROUP
#undef AT_KLOAD
#undef AT_VLOAD
#undef AT_SUMPACK
#undef AT_QKT
#undef AT_DECIDE
#undef AT_EXPS
#undef AT_PV
#undef AT_SGB
#undef AT_DMA
    asm volatile("s_waitcnt lgkmcnt(0)\n\ts_barrier" ::: "memory");
    l = swap_sum(l);
    if (hi == 0) wsf[32 + r32] = l;
    asm volatile("s_waitcnt lgkmcnt(0)" ::: "memory");
    float rli[16];
#pragma unroll
    for (int r = 0; r < 16; ++r) rli[r] = __builtin_amdgcn_rcpf(wsf[32 + crow(r, hi)]);
    unsigned short* Ow = T.O + (rowbase + q0 + wid * 32) * T.po;
    { AT_LAS unsigned short* stg = (AT_LAS unsigned short*)(lds + LDS_OST) + wid * 2048;
#pragma unroll
      for (int r = 0; r < 16; ++r) { const int orow = crow(r, hi);
#pragma unroll
          for (int d0 = 0; d0 < 2; ++d0) stg[orow * 64 + d0 * 32 + r32] = (unsigned short)f2bf(o[d0][r] * rli[r]); }
      asm volatile("s_waitcnt lgkmcnt(0)" ::: "memory");
#pragma unroll
      for (int i = 0; i < 4; ++i) { const int row = i * 8 + (lane >> 3), ch = lane & 7; const u32x4 v = *(const AT_LAS u32x4*)(stg + row * 64 + ch * 8); *(u32x4*)(Ow + (long)row * T.po + ch * 8) = v; } }
    asm volatile("s_waitcnt lgkmcnt(0)\n\ts_barrier" ::: "memory");
}
#undef AT_LAS
}

namespace ssd {
typedef short bf16x8 __attribute__((ext_vector_type(8)));
typedef short v4i16_t __attribute__((ext_vector_type(4)));
typedef float f32x16 __attribute__((ext_vector_type(16)));
typedef unsigned u32x4 __attribute__((ext_vector_type(4)));
#define SS_LAS __attribute__((address_space(3)))
__device__ __forceinline__ int crow(int r, int hi) { return (r & 3) + 8 * (r >> 2) + 4 * hi; }
__device__ __forceinline__ v4i16_t vtr(const SS_LAS unsigned char* p) { return __builtin_amdgcn_ds_read_tr16_b64_v4i16((SS_LAS v4i16_t*)p); }
__device__ __forceinline__ bf16x8 tr_frag(const SS_LAS unsigned char* img, int pitch, int k0, int c0, int lane) {
    const int g4 = lane >> 4, q = (lane & 15) >> 2, p4 = lane & 3;
    const SS_LAS unsigned char* a = img + (k0 + 8 * (g4 >> 1) + q) * pitch + (c0 + 16 * (g4 & 1) + 4 * p4) * 2;
    const v4i16_t lo = vtr(a), hi4 = vtr(a + 4 * pitch);
    return (bf16x8){lo[0], lo[1], lo[2], lo[3], hi4[0], hi4[1], hi4[2], hi4[3]};
}
__device__ __forceinline__ bf16x8 row_frag(const SS_LAS unsigned char* img, int pitch, int r0, int k0, int lane) {
    return *(const SS_LAS bf16x8*)(img + (r0 + (lane & 31)) * pitch + (k0 + 8 * (lane >> 5)) * 2);
}

constexpr int PX4 = 576;
constexpr int PB_T = 320;
constexpr int PR = 272;
constexpr int PX1 = 192;

__device__ __forceinline__ void dt_cs(int t0, int g, const float* DTR, const float* dtb, const float* alog, SS_LAS float* csl, SS_LAS float* dtl, SS_LAS float* wtot, int tid, int lane, int wid) {
    const int l = tid >> 2, hh = tid & 3, h = 4 * g + hh;
    const float r = DTR[(size_t)(t0 + l) * 8 + h] + dtb[h]; const float ex = __expf(fminf(r, 20.f)); const float dt = (r > 20.f) ? r : ((ex < 0.01f) ? ex * (1.f - ex * (0.5f - ex * 0.33333333f)) : __logf(1.f + ex));
    float v = dt * (-expf(alog[h]));
#pragma unroll
    for (int off = 4; off < 64; off <<= 1) { const float t = __shfl_up(v, off); if (lane >= off) v += t; }
    if (lane >= 60) wtot[wid * 4 + hh] = v;
    __syncthreads();
    float base = 0.f;
    for (int w = 0; w < wid; ++w) base += wtot[w * 4 + hh];
    csl[tid] = v + base; dtl[tid] = dt;
    __syncthreads();
}
__device__ __forceinline__ void conv_load(u32x4 (&x)[19], const unsigned short* raw, int t0, int l0, int col) {
    const int pos0 = t0 & 2047;
#pragma unroll
    for (int i = 0; i < 19; ++i) { const int l = l0 - 3 + i; x[i] = (u32x4){0u, 0u, 0u, 0u}; if (pos0 + l >= 0) x[i] = *(const u32x4*)(raw + (size_t)(t0 + l) * 1024 + col); }
}
template <bool SCALED> __device__ __forceinline__ void conv_compute(const u32x4 (&x)[19], int l0, int col, const float* cw, const float* cb, SS_LAS unsigned char* img, int pitch, const SS_LAS float* sc) {
    float w[4][8], b[8];
#pragma unroll
    for (int k = 0; k < 4; ++k) { const f32x4 a = *(const f32x4*)(cw + k * 1024 + col), c = *(const f32x4*)(cw + k * 1024 + col + 4); w[k][0] = a.x; w[k][1] = a.y; w[k][2] = a.z; w[k][3] = a.w; w[k][4] = c.x; w[k][5] = c.y; w[k][6] = c.z; w[k][7] = c.w; }
    { const f32x4 a = *(const f32x4*)(cb + col), c = *(const f32x4*)(cb + col + 4); b[0] = a.x; b[1] = a.y; b[2] = a.z; b[3] = a.w; b[4] = c.x; b[5] = c.y; b[6] = c.z; b[7] = c.w; }
#pragma unroll
    for (int i = 0; i < 16; ++i) { const int l = l0 + i; float o[8]; const float s = SCALED ? sc[l * 4] : 1.f;
#pragma unroll
        for (int j = 0; j < 8; ++j) { float a = b[j];
#pragma unroll
            for (int k = 0; k < 4; ++k) { const unsigned wd = (j < 2) ? x[i + k].x : (j < 4) ? x[i + k].y : (j < 6) ? x[i + k].z : x[i + k].w; a += w[k][j] * ((j & 1) ? bfhi(wd) : bflo(wd)); }
            o[j] = a * __builtin_amdgcn_rcpf(1.f + __expf(-a)) * s; }
        u32x4 p; p.x = pk2(o[0], o[1]); p.y = pk2(o[2], o[3]); p.z = pk2(o[4], o[5]); p.w = pk2(o[6], o[7]);
        *(SS_LAS u32x4*)(img + l * pitch) = p; }
}

__device__ __forceinline__ void states_unit(SS_LAS unsigned char* lds, int bc, int g, const unsigned short* XBC, const float* DTR, const float* cw, const float* cb, const float* dtb, const float* alog, float* ST, float* CEND) {
    int tid_ = threadIdx.x; asm volatile("" : "+v"(tid_));
    const int tid = tid_, lane = tid & 63, r32 = lane & 31, hi = lane >> 5; const int wid = __builtin_amdgcn_readfirstlane(tid >> 6);
    const int t0 = bc * 128;
    SS_LAS unsigned char* XD = lds; SS_LAS unsigned char* BI = lds + 128 * PX4;
    SS_LAS float* csl = (SS_LAS float*)(lds + 128 * PX4 + 128 * PB_T); SS_LAS float* dtl = csl + 512; SS_LAS float* wtot = dtl + 512; SS_LAS float* scl = wtot + 32;
    const int ch = tid % 48, l0 = (tid / 48) * 16; const int col = (ch < 32) ? g * 256 + ch * 8 : 512 + g * 128 + (ch - 32) * 8;
    u32x4 xr[19];
    if (tid < 384) conv_load(xr, XBC, t0, l0, col);
    dt_cs(t0, g, DTR, dtb, alog, csl, dtl, wtot, tid, lane, wid);
    scl[tid] = dtl[tid] * __expf(csl[508 + (tid & 3)] - csl[tid]);
    if (tid < 4) CEND[bc * 8 + g * 4 + tid] = csl[508 + tid];
    __syncthreads();
    if (tid < 384) {
        if (ch < 32) conv_compute<true>(xr, l0, col, cw, cb, XD + ch * 16, PX4, scl + (ch >> 3));
        else conv_compute<false>(xr, l0, col, cw, cb, BI + (ch - 32) * 16, PB_T, nullptr); }
    __syncthreads();
    const int pt = wid >> 2, nt = wid & 3;
#pragma unroll 1
    for (int hh = 0; hh < 4; ++hh) {
        f32x16 acc = f32x16{};
#pragma unroll
        for (int ks = 0; ks < 8; ++ks) {
            const bf16x8 a = tr_frag(XD, PX4, 16 * ks, hh * 64 + 32 * pt, lane);
            const bf16x8 b = tr_frag(BI, PB_T, 16 * ks, 32 * nt, lane);
            acc = __builtin_amdgcn_mfma_f32_32x32x16_bf16(a, b, acc, 0, 0, 0); }
        float* o = ST + (((size_t)(bc * 8 + g * 4 + hh) * 64 + 32 * pt) << 7) + 32 * nt + r32;
#pragma unroll
        for (int r = 0; r < 16; ++r) o[(size_t)crow(r, hi) << 7] = acc[r];
    }
    __syncthreads();
}

__device__ __forceinline__ void out_unit(SS_LAS unsigned char* lds, int bc, int g, const unsigned short* XBC, const unsigned short* VZ, const float* DTR, const float* cw, const float* cb, const float* dtb, const float* alog,
                                         const unsigned short* HIN, const float* Dsk, const float* gn, unsigned short* MIX) {
    int tid_ = threadIdx.x; asm volatile("" : "+v"(tid_));
    const int tid = tid_, lane = tid & 63, r32 = lane & 31, hi = lane >> 5; const int wid = __builtin_amdgcn_readfirstlane(tid >> 6);
    const int t0 = bc * 128;
    SS_LAS unsigned char* CI = lds; SS_LAS unsigned char* BI = lds + 128 * PR; SS_LAS unsigned char* XS = lds + 2 * 128 * PR;
    SS_LAS float* csl = (SS_LAS float*)(lds + 2 * 128 * PR + 128 * PX4); SS_LAS float* dtl = csl + 512; SS_LAS float* wtot = dtl + 512;
    const int ch = tid & 63, l0 = (tid >> 6) * 16; const int col = (ch < 32) ? g * 256 + ch * 8 : (ch < 48) ? 512 + g * 128 + (ch - 32) * 8 : 768 + g * 128 + (ch - 48) * 8;
    u32x4 xr[19];
    conv_load(xr, XBC, t0, l0, col);
    u32x4 zr[8];
    { const unsigned short* zp = VZ + (size_t)(t0 + (tid >> 2)) * 1024 + 512 + g * 256 + (tid & 3) * 64;
#pragma unroll
      for (int c = 0; c < 8; ++c) zr[c] = *(const u32x4*)(zp + c * 8); }
    dt_cs(t0, g, DTR, dtb, alog, csl, dtl, wtot, tid, lane, wid);
    if (ch < 32) conv_compute<false>(xr, l0, col, cw, cb, XS + ch * 16, PX4, nullptr);
    else if (ch < 48) conv_compute<false>(xr, l0, col, cw, cb, BI + (ch - 32) * 16, PR, nullptr);
    else conv_compute<false>(xr, l0, col, cw, cb, CI + (ch - 48) * 16, PR, nullptr);
    __syncthreads();
    const int lt = wid >> 1, st0 = 2 * (wid & 1), pt = wid & 1;
    f32x16 cb2[2]; cb2[0] = f32x16{}; cb2[1] = f32x16{};
#pragma unroll
    for (int ks = 0; ks < 8; ++ks) {
        const bf16x8 a = row_frag(CI, PR, 32 * lt, 16 * ks, lane);
        const bf16x8 b0 = row_frag(BI, PR, 32 * st0, 16 * ks, lane), b1 = row_frag(BI, PR, 32 * st0 + 32, 16 * ks, lane);
        cb2[0] = __builtin_amdgcn_mfma_f32_32x32x16_bf16(a, b0, cb2[0], 0, 0, 0);
        cb2[1] = __builtin_amdgcn_mfma_f32_32x32x16_bf16(a, b1, cb2[1], 0, 0, 0); }
    f32x16 yo[4];
    { bf16x8 hb[2][8];
      const unsigned short* hin0 = HIN + (((size_t)(bc * 8 + g * 4) * 64 + 32 * pt + r32) << 7) + 8 * hi;
#pragma unroll
      for (int ks = 0; ks < 8; ++ks) hb[0][ks] = *(const bf16x8*)(hin0 + 16 * ks);
#pragma unroll
      for (int hh = 0; hh < 4; ++hh) { yo[hh] = f32x16{};
          if (hh < 3) {
#pragma unroll
              for (int ks = 0; ks < 8; ++ks) hb[(hh + 1) & 1][ks] = *(const bf16x8*)(hin0 + ((size_t)(hh + 1) << 13) + 16 * ks); }
          __builtin_amdgcn_sched_barrier(0);
#pragma unroll
          for (int ks = 0; ks < 8; ++ks) yo[hh] = __builtin_amdgcn_mfma_f32_32x32x16_bf16(row_frag(CI, PR, 32 * lt, 16 * ks, lane), hb[hh & 1][ks], yo[hh], 0, 0, 0);
          __builtin_amdgcn_sched_barrier(0); } }
    __syncthreads();
    SS_LAS unsigned char* MI = BI;
#pragma unroll
    for (int hh = 0; hh < 4; ++hh) {
        const int h = g * 4 + hh;
#pragma unroll
        for (int j = 0; j < 2; ++j) { const int s = 32 * (st0 + j) + r32; const float css = csl[s * 4 + hh], dts = dtl[s * 4 + hh];
#pragma unroll
            for (int r = 0; r < 16; ++r) { const int l = 32 * lt + crow(r, hi); const float cl = csl[l * 4 + hh];
                float pr_ = cb2[j][r] * __builtin_amdgcn_exp2f(fminf(cl - css, 0.f) * 1.4426950408889634f) * dts; asm volatile("" : "+v"(pr_)); const float v = (s <= l) ? pr_ : 0.f;
                *(SS_LAS unsigned short*)(MI + l * PR + s * 2) = (unsigned short)f2bf(v); if ((r & 3) == 3) asm volatile("" ::: "memory"); } }
        __syncthreads();
        f32x16 yd = f32x16{};
#pragma unroll
        for (int ks = 0; ks < 8; ++ks) yd = __builtin_amdgcn_mfma_f32_32x32x16_bf16(row_frag(MI, PR, 32 * lt, 16 * ks, lane), tr_frag(XS, PX4, 16 * ks, hh * 64 + 32 * pt, lane), yd, 0, 0, 0);
        __syncthreads();
        const float dsk = Dsk[h]; const int p = 32 * pt + r32;
#pragma unroll
        for (int r = 0; r < 16; ++r) { const int l = 32 * lt + crow(r, hi);
            SS_LAS unsigned short* xp = (SS_LAS unsigned short*)(XS + l * PX4 + (hh * 64 + p) * 2);
            const float y = yd[r] + yo[hh][r] * __expf(csl[l * 4 + hh]) + dsk * bf2f(*xp);
            *xp = (unsigned short)f2bf(y); }
    }
    __syncthreads();
    { const int l = tid >> 2, q = tid & 3; const SS_LAS unsigned char* rowp = XS + l * PX4 + q * 128; float yv[8][8]; float s = 0.f;
#pragma unroll
      for (int c = 0; c < 8; ++c) { const u32x4 v = *(const SS_LAS u32x4*)(rowp + c * 16); const u32x4 z = zr[c];
          yv[c][0] = bflo(v.x) * silu_f(bflo(z.x)); yv[c][1] = bfhi(v.x) * silu_f(bfhi(z.x)); yv[c][2] = bflo(v.y) * silu_f(bflo(z.y)); yv[c][3] = bfhi(v.y) * silu_f(bfhi(z.y));
          yv[c][4] = bflo(v.z) * silu_f(bflo(z.z)); yv[c][5] = bfhi(v.z) * silu_f(bfhi(z.z)); yv[c][6] = bflo(v.w) * silu_f(bflo(z.w)); yv[c][7] = bfhi(v.w) * silu_f(bfhi(z.w));
#pragma unroll
          for (int j = 0; j < 8; ++j) s += yv[c][j] * yv[c][j]; }
      s += __shfl_xor(s, 1); s += __shfl_xor(s, 2);
      const float rstd = 1.f / sqrtf(s * (1.f / 256.f) + 1e-6f); const float* gq = gn + g * 256 + q * 64; unsigned short* op = MIX + (size_t)(t0 + l) * 1024 + 512 + g * 256 + q * 64;
#pragma unroll
      for (int c = 0; c < 8; ++c) { const f32x4 g0 = *(const f32x4*)(gq + c * 8), g1 = *(const f32x4*)(gq + c * 8 + 4); u32x4 o;
          o.x = pk2(yv[c][0] * rstd * g0.x, yv[c][1] * rstd * g0.y); o.y = pk2(yv[c][2] * rstd * g0.z, yv[c][3] * rstd * g0.w);
          o.z = pk2(yv[c][4] * rstd * g1.x, yv[c][5] * rstd * g1.y); o.w = pk2(yv[c][6] * rstd * g1.z, yv[c][7] * rstd * g1.w);
          *(u32x4*)(op + c * 8) = o; } }
    __syncthreads();
}
#undef SS_LAS
}

constexpr int NWAVES = 8, NTHR = 512;
constexpr int T_ = 32768, S_ = 2048, NB_ = 16, D_ = 1024;
constexpr int DFF = 2816, DFF2 = 5632;
constexpr float EPS = 1e-6f;
constexpr size_t MiB = 1u << 20;
constexpr size_t WS_CTL = 0, CTL_ZERO_BYTES = 3 * MiB;
constexpr size_t WS_SSQA = 1 * MiB, WS_SSQB = WS_SSQA + 256 * 1024, WS_SSQC = WS_SSQB + 256 * 1024, WS_SSQQ = WS_SSQC + 256 * 1024, WS_SSQKV = WS_SSQQ + 256 * 1024;
constexpr size_t WS_KMEAN = WS_SSQKV + 256 * 1024;
constexpr size_t WS_DTR = 55 * MiB;
constexpr size_t WS_W_IN0 = 3 * MiB;
constexpr size_t WS_W_OUT0 = WS_W_IN0 + 6656 * 1024;
constexpr size_t WS_W_IN1 = WS_W_OUT0 + 2 * MiB;
constexpr size_t WS_W_UQ = WS_W_IN1 + 2 * MiB;
constexpr size_t WS_W_UKV = WS_W_UQ + 1536 * 1024;
constexpr size_t WS_W_OUT1 = WS_W_UKV + 1 * MiB;
constexpr size_t WS_W_UP = WS_W_OUT1 + 2 * MiB;
constexpr size_t WS_W_DN = WS_W_UP + 22 * MiB;
constexpr size_t WS_TAB64 = 51 * MiB;
constexpr size_t WS_TAB32 = WS_TAB64 + 512 * 1024;
constexpr size_t WS_DT = 53 * MiB;
constexpr size_t WS_CS = 54 * MiB;
constexpr size_t WS_XN = 56 * MiB;
constexpr size_t WS_BIG = 120 * MiB;
static_assert(WS_W_DN + 11 * MiB <= WS_TAB64, "weights fit");
constexpr size_t L0_QK = WS_BIG, L0_VZ = WS_BIG + 64 * MiB, L0_XBC = WS_BIG + 128 * MiB, L0_DTR = WS_BIG + 192 * MiB, L0_XBCA = WS_BIG + 256 * MiB, L0_MIX = WS_BIG + 320 * MiB;
constexpr size_t L0_ST = WS_BIG + 192 * MiB;
constexpr size_t L0_KC = WS_BIG + 288 * MiB;
constexpr size_t L0_HIN = WS_BIG + 256 * MiB;
constexpr size_t WS_CEND = 53 * MiB;
constexpr size_t L0_CB = L0_DTR;
constexpr size_t L0_YG = L0_QK;
constexpr size_t FF_ACT = WS_BIG + 64 * MiB, FF_UB = WS_BIG + 240 * MiB;
constexpr size_t L1_C1 = WS_BIG, L1_QR = WS_BIG + 64 * MiB, L1_V2 = WS_BIG + 160 * MiB;
constexpr size_t WS_RG = WS_BIG + 384 * MiB;
constexpr size_t WS_SSQPE = 53 * MiB + 64 * 1024;
constexpr size_t L1_K2 = WS_BIG + 288 * MiB;
constexpr size_t L1_O = WS_BIG + 224 * MiB;
constexpr size_t WS_END = 512 * MiB;
constexpr int CW_BAR = 4096;

constexpr int RING_OFF = 0, RING_BYTES = 162816;
constexpr int LDSCTL_OFF = RING_BYTES, MISC_OFF = LDSCTL_OFF + 320;
constexpr int LDS_BYTES = 163840;

struct Args { const float* in[25]; float* out; unsigned char* ws; int ph_lo, ph_hi; };
typedef const __attribute__((address_space(4))) Args* KArgs;
__device__ __forceinline__ KArgs kargs() { KArgs p = (KArgs)__builtin_amdgcn_kernarg_segment_ptr(); asm volatile("" : "+s"(p)); return p; }
#define PH_VARS KArgs A_ = kargs(); unsigned char* ws = A_->ws; float* out = A_->out; const float* x = A_->in[0]; bf16* XN = (bf16*)(ws + WS_XN); const float* TAB64 = (const float*)(ws + WS_TAB64); const float* TAB32 = (const float*)(ws + WS_TAB32); \
    int tid_ = threadIdx.x; asm volatile("" : "+v"(tid_)); const int tid = tid_, lane = tid & 63, wave = __builtin_amdgcn_readfirstlane(tid >> 6); int G = gridDim.x; asm volatile("" : "+s"(G)); const int gw = blockIdx.x * NWAVES + wave, NGW = G * NWAVES; const int gt = blockIdx.x * NTHR + tid, NGT = G * NTHR; \
    (void)out; (void)x; (void)XN; (void)TAB64; (void)TAB32; (void)lane; (void)gw; (void)NGW; (void)gt; (void)NGT;

template <int MAP> __device__ __forceinline__ int src_col(int n0) {
    if (MAP == 1) { const int pn = n0 >> 8, bj = (n0 >> 7) & 1, wc = (n0 >> 5) & 3; return bj * DFF + pn * 128 + wc * 32; }
    if (MAP == 2) { const int pn = n0 >> 8, bj = (n0 >> 7) & 1, wc = (n0 >> 5) & 3; return (pn < 4) ? pn * 256 + wc * 64 + bj * 32 : n0; }
    if (MAP == 3) { const int pn = n0 >> 8, bj = (n0 >> 7) & 1, wc = (n0 >> 5) & 3; if (pn < 4) return (4 * pn + wc) * 128 + bj * 32; const int col = (pn - 4) * 256 + bj * 128 + wc * 32; return (col >> 6) * 128 + 64 + (col & 63); }
    return n0;
}
template <int MAP> __device__ __forceinline__ void tr_load(f32x4 (&v)[8], const float* W, int Nsrc, int item, int nblk, int lane, const float* gain) {
    const int kb = item / nblk, nb = item % nblk, k0 = 64 * kb, n0 = 32 * nb;
    const int nn = src_col<MAP>(n0) + (lane & 7) * 4; const bool ok = (nn >= 0 && nn < Nsrc);
#pragma unroll
    for (int i = 0; i < 8; ++i) { const int kk = 8 * i + (lane >> 3); v[i] = ok ? *(const f32x4*)(W + (size_t)(k0 + kk) * Nsrc + nn) : (f32x4){0.f, 0.f, 0.f, 0.f}; if (gain) v[i] = v[i] * gain[k0 + kk]; }
}
__device__ __forceinline__ void tr_store(const f32x4 (&v)[8], int K, bf16* WT, LAS float* scr, int item, int nblk, int lane) {
    const int kb = item / nblk, nb = item % nblk, k0 = 64 * kb, n0 = 32 * nb;
#pragma unroll
    for (int i = 0; i < 8; ++i) { const int kk = 8 * i + (lane >> 3); LAS float* d = scr + kk * 33 + (lane & 7) * 4; d[0] = v[i].x; d[1] = v[i].y; d[2] = v[i].z; d[3] = v[i].w; }
    LDS_WAIT(); asm volatile("" ::: "memory");
    const int c = lane & 7;
#pragma unroll
    for (int j = 0; j < 4; ++j) { const int n = (lane >> 3) + 8 * j; const LAS float* s = scr + (8 * c) * 33 + n;
        v4u o; o.x = pk2(s[0 * 33], s[1 * 33]); o.y = pk2(s[2 * 33], s[3 * 33]); o.z = pk2(s[4 * 33], s[5 * 33]); o.w = pk2(s[6 * 33], s[7 * 33]);
        *(GAS v4u*)(WT + (size_t)(n0 + n) * K + k0 + 8 * c) = o; }
    LDS_WAIT(); asm volatile("" ::: "memory");
}
template <int MAP = 0> __device__ __forceinline__ void transpose_mat(const float* W, int K, int Nsrc, int Npad, bf16* WT, LAS float* scr, int gw, int NGW, int lane, const float* gain = nullptr) {
    const int nblk = Npad / 32, nitems = (K / 64) * nblk;
    f32x4 cur[8], nxt[8];
    if (gw < nitems) tr_load<MAP>(cur, W, Nsrc, gw, nblk, lane, gain);
    for (int it = gw; it < nitems; it += NGW) {
        const bool more = it + NGW < nitems;
        if (more) tr_load<MAP>(nxt, W, Nsrc, it + NGW, nblk, lane, gain);
        tr_store(cur, K, WT, scr, it, nblk, lane);
        if (more) {
#pragma unroll
            for (int i = 0; i < 8; ++i) cur[i] = nxt[i]; }
    }
}

struct MatDesc { const float* W; bf16* WT; const float* gain; int K, Nsrc, nblk, map; };
__device__ __forceinline__ int src_col_rt(int map, int n0) { return map == 1 ? src_col<1>(n0) : map == 2 ? src_col<2>(n0) : map == 3 ? src_col<3>(n0) : n0; }
__device__ __forceinline__ void trl_load(f32x4 (&v)[8], const MatDesc& d, int item, int lane) {
    const int kb = item / d.nblk, nb = item % d.nblk, k0 = 64 * kb, n0 = 32 * nb;
    const int nn = src_col_rt(d.map, n0) + (lane & 7) * 4; const bool ok = (nn >= 0 && nn < d.Nsrc);
#pragma unroll
    for (int i = 0; i < 8; ++i) { const int kk = 8 * i + (lane >> 3); v[i] = ok ? __builtin_nontemporal_load((const f32x4*)(d.W + (size_t)(k0 + kk) * d.Nsrc + nn)) : (f32x4){0.f, 0.f, 0.f, 0.f}; if (d.gain) v[i] = v[i] * d.gain[k0 + kk]; }
}
constexpr int NIT_W = 1536 + 512 + 512 + 384 + 256 + 512 + 2 * 2816 + 2 * 1408;
__device__ __forceinline__ MatDesc mat_of(KArgs A_, unsigned char* ws, int item, int& local) {
    MatDesc d; int r = item;
    if (r < 1536) { d = MatDesc{A_->in[3], (bf16*)(ws + WS_W_IN0), nullptr, 1024, 3080, 96, 2}; local = r; return d; } r -= 1536;
    if (r < 512) { d = MatDesc{A_->in[12], (bf16*)(ws + WS_W_OUT0), nullptr, 1024, 1024, 32, 0}; local = r; return d; } r -= 512;
    if (r < 512) { d = MatDesc{A_->in[13], (bf16*)(ws + WS_W_IN1), A_->in[1] + 1024, 1024, 800, 32, 0}; local = r; return d; } r -= 512;
    if (r < 384) { d = MatDesc{A_->in[15], (bf16*)(ws + WS_W_UQ), A_->in[14], 512, 1536, 48, 0}; local = r; return d; } r -= 384;
    if (r < 256) { d = MatDesc{A_->in[17], (bf16*)(ws + WS_W_UKV), A_->in[16], 256, 2048, 64, 3}; local = r; return d; } r -= 256;
    if (r < 512) { d = MatDesc{A_->in[20], (bf16*)(ws + WS_W_OUT1), nullptr, 1024, 1024, 32, 0}; local = r; return d; } r -= 512;
    if (r < 5632) { const int l = r / 2816; d = MatDesc{A_->in[21] + (size_t)l * 1024 * DFF2, (bf16*)(ws + WS_W_UP) + (size_t)l * DFF2 * 1024, A_->in[2] + l * 1024, 1024, DFF2, 176, 1}; local = r - l * 2816; return d; } r -= 5632;
    { const int l = r / 1408; d = MatDesc{A_->in[24] + (size_t)l * DFF * 1024, (bf16*)(ws + WS_W_DN) + (size_t)l * 1024 * DFF, nullptr, DFF, 1024, 32, 0}; local = r - l * 1408; return d; }
}

__device__ __forceinline__ void rms_rows_1024(const float* x, const float* g, bf16* o, int gw, int NGW, int lane) {
    f32x4 v[4], nx[4];
    if (gw < T_) {
#pragma unroll
        for (int j = 0; j < 4; ++j) v[j] = __builtin_nontemporal_load((const f32x4*)(x + (size_t)gw * D_) + lane + 64 * j); }
    for (int m = gw; m < T_; m += NGW) {
        const bool more = m + NGW < T_;
        if (more) {
#pragma unroll
            for (int j = 0; j < 4; ++j) nx[j] = __builtin_nontemporal_load((const f32x4*)(x + (size_t)(m + NGW) * D_) + lane + 64 * j); }
        float s = 0.f;
#pragma unroll
        for (int j = 0; j < 4; ++j) s += (v[j].x * v[j].x + v[j].y * v[j].y) + (v[j].z * v[j].z + v[j].w * v[j].w);
        const float rstd = 1.f / sqrtf(wave_sum(s) * (1.f / D_) + EPS);
        unsigned long long* o8 = (unsigned long long*)(o + (size_t)m * D_) + lane;
#pragma unroll
        for (int j = 0; j < 4; ++j) { const f32x4 gg = ((const f32x4*)g)[lane + 64 * j];
            o8[64 * j] = (unsigned long long)pk2(v[j].x * rstd * gg.x, v[j].y * rstd * gg.y) | ((unsigned long long)pk2(v[j].z * rstd * gg.z, v[j].w * rstd * gg.w) << 32); }
        if (more) {
#pragma unroll
            for (int j = 0; j < 4; ++j) v[j] = nx[j]; }
    }
}

__device__ __forceinline__ void rms_rows_dt(const float* x, const float* g, bf16* o, float* DTR, const LAS f32x4* W2, int gw, int NGW, int lane) {
    constexpr int PD = 3;
    f32x4 q[PD + 1][4];
#pragma unroll
    for (int p = 0; p < PD; ++p) { const int r = gw + p * NGW; if (r < T_) {
#pragma unroll
            for (int j = 0; j < 4; ++j) q[p][j] = __builtin_nontemporal_load((const f32x4*)(x + (size_t)r * D_) + lane + 64 * j); } }
    for (int m = gw; m < T_; m += NGW) {
        { const int r = m + PD * NGW; if (r < T_) {
#pragma unroll
            for (int j = 0; j < 4; ++j) q[PD][j] = __builtin_nontemporal_load((const f32x4*)(x + (size_t)r * D_) + lane + 64 * j); } }
        f32x4 v[4];
#pragma unroll
        for (int j = 0; j < 4; ++j) v[j] = q[0][j];
        float s = 0.f; f32x4 d0 = {0.f, 0.f, 0.f, 0.f}, d1 = d0;
#pragma unroll
        for (int j = 0; j < 4; ++j) { s += (v[j].x * v[j].x + v[j].y * v[j].y) + (v[j].z * v[j].z + v[j].w * v[j].w);
#pragma unroll
            for (int e2 = 0; e2 < 4; ++e2) { const int sl = j * 4 + e2; const float xk = v[j][e2]; d0 += W2[(sl * 2) * 64 + lane] * xk; d1 += W2[(sl * 2 + 1) * 64 + lane] * xk; } }
        const float rstd = 1.f / sqrtf(wave_sum(s) * (1.f / D_) + EPS);
#pragma unroll
        for (int e2 = 0; e2 < 4; ++e2) { d0[e2] = wave_sum(d0[e2]); d1[e2] = wave_sum(d1[e2]); }
        if (lane == 0) { *(f32x4*)(DTR + (size_t)m * 8) = d0 * rstd; *(f32x4*)(DTR + (size_t)m * 8 + 4) = d1 * rstd; }
        unsigned long long* o8 = (unsigned long long*)(o + (size_t)m * D_) + lane;
#pragma unroll
        for (int j = 0; j < 4; ++j) { const f32x4 gg = ((const f32x4*)g)[lane + 64 * j];
            o8[64 * j] = (unsigned long long)pk2(v[j].x * rstd * gg.x, v[j].y * rstd * gg.y) | ((unsigned long long)pk2(v[j].z * rstd * gg.z, v[j].w * rstd * gg.w) << 32); }
#pragma unroll
        for (int p = 0; p < PD; ++p)
#pragma unroll
            for (int j = 0; j < 4; ++j) q[p][j] = q[p + 1][j];
    }
}

struct EpiF32Res {
    static constexpr bool PERM = false, AFTER_DRAIN = false;
    float* C; const float* R; int ldc;
    __device__ __forceinline__ void operator()(const pg8::f32x4 (&acc)[2][2][4][2], const pg8::Unit& u, int wr, int wc, int fr, int fq) const {
        const int row0 = u.pm * pg8::BM + wr * 64 + fr, col0 = u.pn * pg8::BM + wc * 32 + 4 * fq;
#pragma unroll
        for (int ai = 0; ai < 2; ++ai)
#pragma unroll
            for (int m = 0; m < 4; ++m) { const size_t off = (size_t)(row0 + ai * pg8::HALF + m * 16) * ldc + col0;
                f32x4 r[2][2];
#pragma unroll
                for (int bj = 0; bj < 2; ++bj)
#pragma unroll
                    for (int n = 0; n < 2; ++n) r[bj][n] = *(const f32x4*)(R + off + bj * pg8::HALF + n * 16);
#pragma unroll
                for (int bj = 0; bj < 2; ++bj)
#pragma unroll
                    for (int n = 0; n < 2; ++n) *(f32x4*)(C + off + bj * pg8::HALF + n * 16) = acc[ai][bj][m][n] + r[bj][n];
                asm volatile("" ::: "memory"); }
    }
};

template <bool RB16, bool OUTF, bool OUTB> struct EpiRes {
    static constexpr bool PERM = false, AFTER_DRAIN = false;
    float* C; const void* R; bf16* XB; unsigned long long* SSQ;
    __device__ __forceinline__ void operator()(const pg8::f32x4 (&acc)[2][2][4][2], const pg8::Unit& u, int wr, int wc, int fr, int fq) const {
        const int row0 = u.pm * pg8::BM + wr * 64 + fr, col0 = u.pn * pg8::BM + wc * 32 + 4 * fq;
#pragma unroll
        for (int ai = 0; ai < 2; ++ai)
#pragma unroll
            for (int m = 0; m < 4; ++m) { const int row = row0 + ai * pg8::HALF + m * 16; const size_t off = (size_t)row * 1024 + col0;
                f32x4 r[2][2];
#pragma unroll
                for (int bj = 0; bj < 2; ++bj)
#pragma unroll
                    for (int n = 0; n < 2; ++n) {
                        if (RB16) { const unsigned long long w = *(const unsigned long long*)((const bf16*)R + off + bj * pg8::HALF + n * 16); r[bj][n] = (f32x4){bflo((unsigned)w), bfhi((unsigned)w), bflo((unsigned)(w >> 32)), bfhi((unsigned)(w >> 32))}; }
                        else r[bj][n] = *(const f32x4*)((const float*)R + off + bj * pg8::HALF + n * 16); }
                float s = 0.f;
#pragma unroll
                for (int bj = 0; bj < 2; ++bj)
#pragma unroll
                    for (int n = 0; n < 2; ++n) { const f32x4 v = acc[ai][bj][m][n] + r[bj][n];
                        if (OUTF) *(f32x4*)(C + off + bj * pg8::HALF + n * 16) = v;
                        if (OUTB) { s += (v.x * v.x + v.y * v.y) + (v.z * v.z + v.w * v.w);
                            *(unsigned long long*)(XB + off + bj * pg8::HALF + n * 16) = (unsigned long long)pk2(v.x, v.y) | ((unsigned long long)pk2(v.z, v.w) << 32); } }
                if (OUTB) { s += __shfl_xor(s, 16); s += __shfl_xor(s, 32); if (fq == 0) atomicAdd(SSQ + row, (unsigned long long)(s * 1073741824.0f)); }
                asm volatile("" ::: "memory"); }
    }
};
__device__ __forceinline__ float rstd_of(const unsigned long long* SSQ, int row, float inv_n) { return __builtin_amdgcn_rsqf((float)SSQ[row] * (1.0f / 1073741824.0f) * inv_n + EPS); }
template <int N> __device__ __forceinline__ float dpp_shr_old(float old, float v) { return __builtin_bit_cast(float, __builtin_amdgcn_update_dpp(__builtin_bit_cast(int, old), __builtin_bit_cast(int, v), 0x110 + N, 0xf, 0xf, false)); }
template <int N> __device__ __forceinline__ float dpp_ror(float v) { return __builtin_bit_cast(float, __builtin_amdgcn_update_dpp(0, __builtin_bit_cast(int, v), 0x120 + N, 0xf, 0xf, false)); }
struct EpiFfnUp {
    static constexpr bool PERM = true, AFTER_DRAIN = false;
    bf16* ACT; bf16* UB; const unsigned long long* SSQ; const float* cw; const float* cb;
    __device__ __forceinline__ void operator()(const pg8::f32x4 (&acc)[2][2][4][2], const pg8::Unit& u, int wr, int wc, int fr, int fq) const {
        const int ch0 = u.pn * 128 + wc * 32 + 8 * fq;
        float rs[2][4];
#pragma unroll
        for (int ai = 0; ai < 2; ++ai)
#pragma unroll
            for (int m = 0; m < 4; ++m) rs[ai][m] = rstd_of(SSQ, u.pm * pg8::BM + ai * pg8::HALF + wr * 64 + 4 * fr + m, 1.0f / 1024.0f);
        unsigned long long keep[2][4];
#pragma unroll
        for (int n = 0; n < 2; ++n) {
            __builtin_amdgcn_sched_barrier(0);
            const int ch = ch0 + 4 * n;
            const f32x4 wg0 = *(const f32x4*)(cw + ch), wg1 = *(const f32x4*)(cw + DFF2 + ch), wg2 = *(const f32x4*)(cw + 2 * DFF2 + ch), bg = *(const f32x4*)(cb + ch);
            const f32x4 wu0 = *(const f32x4*)(cw + DFF + ch), wu1 = *(const f32x4*)(cw + DFF2 + DFF + ch), wu2 = *(const f32x4*)(cw + 2 * DFF2 + DFF + ch), bu = *(const f32x4*)(cb + DFF + ch);
#pragma unroll
            for (int ai = 0; ai < 2; ++ai) {
                const int rowc = u.pm * pg8::BM + ai * pg8::HALF + wr * 64;
                f32x4 g[4], uu[4];
#pragma unroll
                for (int m = 0; m < 4; ++m) { g[m] = acc[ai][0][m][n] * rs[ai][m]; uu[m] = acc[ai][1][m][n] * rs[ai][m]; }
                f32x4 g2p, g3p, u2p, u3p;
#pragma unroll
                for (int j = 0; j < 4; ++j) { g2p[j] = dpp_shr_old<1>(0.f, g[2][j]); g3p[j] = dpp_shr_old<1>(0.f, g[3][j]); u2p[j] = dpp_shr_old<1>(0.f, uu[2][j]); u3p[j] = dpp_shr_old<1>(0.f, uu[3][j]); }
#pragma unroll
                for (int m = 0; m < 4; ++m) {
                    const f32x4 sg1 = (m == 0) ? g3p : g[m - 1], sg2 = (m == 0) ? g2p : (m == 1) ? g3p : g[m - 2];
                    const f32x4 su1 = (m == 0) ? u3p : uu[m - 1], su2 = (m == 0) ? u2p : (m == 1) ? u3p : uu[m - 2];
                    const f32x4 cg = bg + wg0 * sg2 + wg1 * sg1 + wg2 * g[m], cu = bu + wu0 * su2 + wu1 * su1 + wu2 * uu[m];
                    f32x4 a;
#pragma unroll
                    for (int j = 0; j < 4; ++j) a[j] = cg[j] * __builtin_amdgcn_rcpf(1.f + __expf(-cg[j])) * cu[j];
                    const int row = rowc + 4 * fr + m;
                    const unsigned long long pk_ = (unsigned long long)pk2(a[0], a[1]) | ((unsigned long long)pk2(a[2], a[3]) << 32);
                    if (n == 0) { keep[ai][m] = pk_; asm volatile("" : "+v"(keep[ai][m])); }
                    else if (!(fr == 0 && m < 2)) { v4u w; w.x = (unsigned)keep[ai][m]; w.y = (unsigned)(keep[ai][m] >> 32); w.z = (unsigned)pk_; w.w = (unsigned)(pk_ >> 32); *(v4u*)(ACT + (size_t)row * DFF + ch0) = w; }
                    if ((fr == 0 && m < 2) || (fr == 15 && m >= 2)) { const int slot = m; bf16* ub = UB + ((size_t)(rowc >> 6) * 4 + slot) * DFF2 + ch;
                        *(unsigned long long*)ub = (unsigned long long)pk2(g[m][0], g[m][1]) | ((unsigned long long)pk2(g[m][2], g[m][3]) << 32);
                        *(unsigned long long*)(ub + DFF) = (unsigned long long)pk2(uu[m][0], uu[m][1]) | ((unsigned long long)pk2(uu[m][2], uu[m][3]) << 32); }
                }
            }
        }
    }
};


struct EpiScale {
    static constexpr bool PERM = true, AFTER_DRAIN = false;
    bf16* O; int ldc; const unsigned long long* SSQ; float inv_n;
    __device__ __forceinline__ void operator()(const pg8::f32x4 (&acc)[2][2][4][2], const pg8::Unit& u, int wr, int wc, int fr, int fq) const {
        const int row0 = u.pm * pg8::BM + wr * 64 + fr, col0 = u.pn * pg8::BM + wc * 32 + 8 * fq;
#pragma unroll
        for (int ai = 0; ai < 2; ++ai)
#pragma unroll
            for (int m = 0; m < 4; ++m) { const int row = row0 + ai * pg8::HALF + m * 16; const float rs = rstd_of(SSQ, row, inv_n); bf16* rowp = O + (size_t)row * ldc + col0;
#pragma unroll
                for (int bj = 0; bj < 2; ++bj) { const f32x4 v0 = acc[ai][bj][m][0] * rs, v1 = acc[ai][bj][m][1] * rs;
                    v4u w; w.x = pk2(v0[0], v0[1]); w.y = pk2(v0[2], v0[3]); w.z = pk2(v1[0], v1[1]); w.w = pk2(v1[2], v1[3]); *(v4u*)(rowp + bj * pg8::HALF) = w; } }
    }
};
struct EpiMlaIn {
    static constexpr bool PERM = true, AFTER_DRAIN = false;
    bf16* O; const unsigned long long* SSQ; unsigned long long* SSQ_Q; unsigned long long* SSQ_KV; float* SSQPE; float* RG; const float* kg; const float* TAB;
    __device__ __forceinline__ void operator()(const pg8::f32x4 (&acc)[2][2][4][2], const pg8::Unit& u, int wr, int wc, int fr, int fq) const {
        const int row0 = u.pm * pg8::BM + wr * 64 + fr, col0 = u.pn * pg8::BM + wc * 32 + 8 * fq;
        unsigned long long* tgt = (u.pn < 2) ? SSQ_Q : SSQ_KV;
        if (u.pn < 3) {
#pragma unroll
        for (int ai = 0; ai < 2; ++ai)
#pragma unroll
            for (int m = 0; m < 4; ++m) { const int row = row0 + ai * pg8::HALF + m * 16; const float rs = rstd_of(SSQ, row, 1.0f / 1024.0f); bf16* rowp = O + (size_t)row * 1024 + col0; float s = 0.f;
#pragma unroll
                for (int bj = 0; bj < 2; ++bj) { const f32x4 v0 = acc[ai][bj][m][0] * rs, v1 = acc[ai][bj][m][1] * rs;
                    s += (v0[0] * v0[0] + v0[1] * v0[1]) + (v0[2] * v0[2] + v0[3] * v0[3]) + (v1[0] * v1[0] + v1[1] * v1[1]) + (v1[2] * v1[2] + v1[3] * v1[3]);
                    v4u w; w.x = pk2(v0[0], v0[1]); w.y = pk2(v0[2], v0[3]); w.z = pk2(v1[0], v1[1]); w.w = pk2(v1[2], v1[3]); *(v4u*)(rowp + bj * pg8::HALF) = w; }
                s += __shfl_xor(s, 16); s += __shfl_xor(s, 32); if (fq == 0) atomicAdd(tgt + row, (unsigned long long)(s * 1073741824.0f)); asm volatile("" ::: "memory"); }
        } else if (wc == 0) {
            const f32x4 g0 = *(const f32x4*)(kg + 64 + 8 * fq), g1 = *(const f32x4*)(kg + 64 + 8 * fq + 4);
#pragma unroll
            for (int ai = 0; ai < 2; ++ai)
#pragma unroll
                for (int m = 0; m < 4; ++m) { const int row = row0 + ai * pg8::HALF + m * 16, pos = row & 2047; const float rs = rstd_of(SSQ, row, 1.0f / 1024.0f);
                    const f32x4 v0 = acc[ai][0][m][0] * rs, v1 = acc[ai][0][m][1] * rs;
                    float s = (v0[0] * v0[0] + v0[1] * v0[1]) + (v0[2] * v0[2] + v0[3] * v0[3]) + (v1[0] * v1[0] + v1[1] * v1[1]) + (v1[2] * v1[2] + v1[3] * v1[3]);
                    s += __shfl_xor(s, 16); s += __shfl_xor(s, 32); if (fq == 0) SSQPE[row] = s;
                    const f32x4 y0 = v0 * g0, y1 = v1 * g1;
                    f32x4 p0, p1;
#pragma unroll
                    for (int j = 0; j < 4; ++j) { p0[j] = __shfl_xor(y0[j], 32); p1[j] = __shfl_xor(y1[j], 32); }
                    const float* tb = TAB + (pos * 16 + 8 * (fq & 1)) * 2; const f32x4 ta = *(const f32x4*)tb, tb4 = *(const f32x4*)(tb + 4), tc = *(const f32x4*)(tb + 8), td = *(const f32x4*)(tb + 12);
                    const f32x4 c0 = {ta[0], ta[2], tb4[0], tb4[2]}, s0 = {ta[1], ta[3], tb4[1], tb4[3]}, c1 = {tc[0], tc[2], td[0], td[2]}, s1 = {tc[1], tc[3], td[1], td[3]};
                    f32x4 o0, o1;
                    if (fq < 2) { o0 = y0 * c0 - p0 * s0; o1 = y1 * c1 - p1 * s1; } else { o0 = p0 * s0 + y0 * c0; o1 = p1 * s1 + y1 * c1; }
                    float* rg = RG + (size_t)row * 32 + 8 * fq; *(f32x4*)rg = o0; *(f32x4*)(rg + 4) = o1; asm volatile("" ::: "memory"); }
        }
    }
};
struct EpiUkv {
    static constexpr bool PERM = true, AFTER_DRAIN = false;
    bf16* K2; bf16* V2; const unsigned long long* SSQ; const float* SSQPE; const float* RG; const float* kg;
    __device__ __forceinline__ void operator()(const pg8::f32x4 (&acc)[2][2][4][2], const pg8::Unit& u, int wr, int wc, int fr, int fq) const {
        const int row0 = u.pm * pg8::BM + wr * 64 + fr;
        if (u.pn < 4) {
            const int head = 4 * u.pn + wc;
            f32x4 g1[2], g2[2];
#pragma unroll
            for (int n = 0; n < 2; ++n) { g1[n] = *(const f32x4*)(kg + 8 * fq + 4 * n); g2[n] = *(const f32x4*)(kg + 32 + 8 * fq + 4 * n); }
#pragma unroll
            for (int ai = 0; ai < 2; ++ai)
#pragma unroll
                for (int m = 0; m < 4; ++m) { const int row = row0 + ai * pg8::HALF + m * 16; const float rs = rstd_of(SSQ, row, 1.0f / 256.0f);
                    f32x4 a[2], b[2]; float s = 0.f;
#pragma unroll
                    for (int n = 0; n < 2; ++n) { a[n] = acc[ai][0][m][n] * rs; b[n] = acc[ai][1][m][n] * rs; s += (a[n][0] * a[n][0] + a[n][1] * a[n][1]) + (a[n][2] * a[n][2] + a[n][3] * a[n][3]) + (b[n][0] * b[n][0] + b[n][1] * b[n][1]) + (b[n][2] * b[n][2] + b[n][3] * b[n][3]); }
                    s += __shfl_xor(s, 16); s += __shfl_xor(s, 32);
                    const float rh = 1.f / sqrtf((s + SSQPE[row]) * (1.f / 96.f) + EPS);
                    const int pos = row & 2047; bf16* rp = K2 + ((((size_t)(row >> 11) * 16 + head) * 32 + (pos >> 6)) * 12 + fq) * 512 + (pos & 63) * 8;
                    { const f32x4 o0 = a[0] * rh * g1[0], o1 = a[1] * rh * g1[1]; v4u w; w.x = pk2(o0[0], o0[1]); w.y = pk2(o0[2], o0[3]); w.z = pk2(o1[0], o1[1]); w.w = pk2(o1[2], o1[3]); *(v4u*)rp = w; }
                    { const f32x4 o0 = b[0] * rh * g2[0], o1 = b[1] * rh * g2[1]; v4u w; w.x = pk2(o0[0], o0[1]); w.y = pk2(o0[2], o0[3]); w.z = pk2(o1[0], o1[1]); w.w = pk2(o1[2], o1[3]); *(v4u*)(rp + 4 * 512) = w; }
                    { const float* rg = RG + (size_t)row * 32 + 8 * fq; const f32x4 o0 = *(const f32x4*)rg * rh, o1 = *(const f32x4*)(rg + 4) * rh; v4u w; w.x = pk2(o0[0], o0[1]); w.y = pk2(o0[2], o0[3]); w.z = pk2(o1[0], o1[1]); w.w = pk2(o1[2], o1[3]); *(v4u*)(rp + 8 * 512) = w; }
                    asm volatile("" ::: "memory"); }
        } else {
            bf16* dst = V2 + (u.pn - 4) * 256 + wc * 32 + 8 * fq;
#pragma unroll
            for (int ai = 0; ai < 2; ++ai)
#pragma unroll
                for (int m = 0; m < 4; ++m) { const int row = row0 + ai * pg8::HALF + m * 16; const float rs = rstd_of(SSQ, row, 1.0f / 256.0f); bf16* rp = dst + (size_t)row * 1024;
#pragma unroll
                    for (int bj = 0; bj < 2; ++bj) { const f32x4 v0 = acc[ai][bj][m][0] * rs, v1 = acc[ai][bj][m][1] * rs;
                        v4u w; w.x = pk2(v0[0], v0[1]); w.y = pk2(v0[2], v0[3]); w.z = pk2(v1[0], v1[1]); w.w = pk2(v1[2], v1[3]); *(v4u*)(rp + bj * pg8::HALF) = w; } }
        }
    }
};

struct EpiIn0 {
    static constexpr bool PERM = true, AFTER_DRAIN = false;
    bf16* QK; bf16* KC; const float* TAB; const float* qn; const float* kn; float* KM; float* DTR;
    __device__ __forceinline__ void operator()(const pg8::f32x4 (&acc)[2][2][4][2], const pg8::Unit& u, int wr, int wc, int fr, int fq) const {
        const int row0 = u.pm * pg8::BM + wr * 64 + fr;
        if (u.pn < 4) {
            const bool isq = u.pn < 2; const float* gn = isq ? qn : kn; const int head = 4 * (u.pn & 1) + wc;
            bf16* dst = QK + (isq ? 0 : 512) + head * 64 + 8 * fq;
            f32x4 g1[2], g2[2], ks1[2], ks2[2];
#pragma unroll
            for (int n = 0; n < 2; ++n) { g1[n] = *(const f32x4*)(gn + 8 * fq + 4 * n); g2[n] = *(const f32x4*)(gn + 32 + 8 * fq + 4 * n); ks1[n] = (f32x4){0.f, 0.f, 0.f, 0.f}; ks2[n] = ks1[n]; }
#pragma unroll
            for (int ai = 0; ai < 2; ++ai)
#pragma unroll
                for (int m = 0; m < 4; ++m) { const int row = row0 + ai * pg8::HALF + m * 16, pos = row & 2047;
                    float s = 0.f;
#pragma unroll
                    for (int n = 0; n < 2; ++n) { const f32x4 a = acc[ai][0][m][n], b = acc[ai][1][m][n]; s += (a[0] * a[0] + a[1] * a[1]) + (a[2] * a[2] + a[3] * a[3]) + (b[0] * b[0] + b[1] * b[1]) + (b[2] * b[2] + b[3] * b[3]); }
                    s += __shfl_xor(s, 16); s += __shfl_xor(s, 32);
                    float rstd = 1.f / sqrtf(s * (1.f / 64.f) + EPS); if (isq) rstd *= 0.18033688011112042f;
                    f32x4 o1[2], o2[2];
#pragma unroll
                    for (int n = 0; n < 2; ++n) { const float* tb = TAB + (pos * 32 + 8 * fq + 4 * n) * 2; const f32x4 t0 = *(const f32x4*)tb, t1 = *(const f32x4*)(tb + 4);
                        const f32x4 cs_ = {t0[0], t0[2], t1[0], t1[2]}, sn = {t0[1], t0[3], t1[1], t1[3]};
                        const f32x4 y1 = acc[ai][0][m][n] * rstd * g1[n], y2 = acc[ai][1][m][n] * rstd * g2[n];
                        o1[n] = y1 * cs_ - y2 * sn; o2[n] = y1 * sn + y2 * cs_; ks1[n] += o1[n]; ks2[n] += o2[n]; }
                    bf16* rp = dst + (size_t)row * 1024; int st2 = 32;
                    if (!isq) { rp = KC + ((((size_t)(row >> 11) * 8 + head) * 32 + (pos >> 6)) * 8 + fq) * 512 + (pos & 63) * 8; st2 = 4 * 512; }
                    { v4u w; w.x = pk2(o1[0][0], o1[0][1]); w.y = pk2(o1[0][2], o1[0][3]); w.z = pk2(o1[1][0], o1[1][1]); w.w = pk2(o1[1][2], o1[1][3]); *(v4u*)rp = w; }
                    { v4u w; w.x = pk2(o2[0][0], o2[0][1]); w.y = pk2(o2[0][2], o2[0][3]); w.z = pk2(o2[1][0], o2[1][1]); w.w = pk2(o2[1][2], o2[1][3]); *(v4u*)(rp + st2) = w; }
                    asm volatile("" ::: "memory"); }
            if (!isq) {
                float* km = KM + (((size_t)(u.pm >> 3) * 8 + (u.pm & 7)) * 8 + head) * 64 + 8 * fq;
#pragma unroll
                for (int n = 0; n < 2; ++n)
#pragma unroll
                    for (int j = 0; j < 4; ++j) { float a = ks1[n][j], b = ks2[n][j];
#pragma unroll
                        for (int o = 1; o < 16; o <<= 1) { a += __shfl_xor(a, o); b += __shfl_xor(b, o); }
                        if (fr == 0) { atomicAdd(km + 4 * n + j, a * (1.f / 256.f)); atomicAdd(km + 32 + 4 * n + j, b * (1.f / 256.f)); } } }
        } else if (u.pn < 12) {
            bf16* dst = QK + (size_t)(u.pn >> 2) * ((size_t)T_ * 1024) + (u.pn & 3) * 256 + wc * 32 + 8 * fq;
#pragma unroll
            for (int ai = 0; ai < 2; ++ai)
#pragma unroll
                for (int m = 0; m < 4; ++m) { bf16* rp = dst + (size_t)(row0 + ai * pg8::HALF + m * 16) * 1024;
#pragma unroll
                    for (int bj = 0; bj < 2; ++bj) { const f32x4 v0 = acc[ai][bj][m][0], v1 = acc[ai][bj][m][1];
                        v4u w; w.x = pk2(v0[0], v0[1]); w.y = pk2(v0[2], v0[3]); w.z = pk2(v1[0], v1[1]); w.w = pk2(v1[2], v1[3]); *(v4u*)(rp + bj * pg8::HALF) = w; } }
        } else if (wc == 0 && fq == 0) {
#pragma unroll
            for (int ai = 0; ai < 2; ++ai)
#pragma unroll
                for (int m = 0; m < 4; ++m) { float* rp = DTR + (size_t)(row0 + ai * pg8::HALF + m * 16) * 8; *(f32x4*)rp = acc[ai][0][m][0]; *(f32x4*)(rp + 4) = acc[ai][0][m][1]; }
        }
    }
};

template <class Epi, int AROW = 0> __device__ __forceinline__ void run_gemm(LAS unsigned char* lds, const bf16* A, const bf16* Bt, int M, int N, int K, const Epi& E, int lda = 0) {
    pg8::Gemm g{A, Bt, M, N, K, lda ? lda : K}; pg8::StaticOrder S; S.init(M, N, (int)gridDim.x, (int)blockIdx.x);
    pg8::gemm_phase<Epi, pg8::StaticOrder, PG8_ALIGN, PG8_SP2, AROW>(lds + RING_OFF, g, S, E);
}

#define NPHASES 40
__global__ void __launch_bounds__(NTHR, 2) fwd(Args args) {
    extern __shared__ __attribute__((aligned(16))) unsigned char lds_raw[];
    LAS unsigned char* lds = (LAS unsigned char*)lds_raw;
    volatile LAS unsigned* MISC = (volatile LAS unsigned*)(lds + MISC_OFF);
    {
        const int tid0 = threadIdx.x;
        for (int u = tid0; u < (LDS_BYTES - LDSCTL_OFF) / 4; u += NTHR) ((LAS unsigned*)(lds + LDSCTL_OFF))[u] = 0u;
    }
    __syncthreads();
    int lo, hi; { KArgs A0 = kargs(); lo = A0->ph_lo; hi = A0->ph_hi; }
    const bool multi = (hi - lo) > 1;
    XcdBarrier bar; bar.bar = nullptr; bar.x = 0; bar.st = nullptr;
    if (multi) { KArgs A0 = kargs(); bar = xcd_barrier_post((unsigned*)((gu32*)(A0->ws + WS_CTL) + CW_BAR), MISC + 8); }
#define IN(k) (lo <= (k) && (k) < hi)
#ifndef PROBE_MASK
#define PROBE_MASK 0u
#endif
    unsigned long long pr_acc = 0ull, pr_t = 0ull;
    if (PROBE_MASK) pr_t = __builtin_amdgcn_s_memrealtime();
#define SEAM(k) do { if (IN(k) && IN((k) + 1)) xcd_barrier(bar); \
        if (PROBE_MASK) { const unsigned long long now_ = __builtin_amdgcn_s_memrealtime(); if ((PROBE_MASK >> (k)) & 1u) pr_acc += now_ - pr_t; pr_t = now_; } } while (0)

    if (IN(0)) { PH_VARS
        LAS float* scr = (LAS float*)(lds + RING_OFF + wave * 16384);
        { f32x4 cur[8], nxt[8]; int it = gw, li = 0, ln = 0; MatDesc d{}, dn{};
          if (it < NIT_W) { d = mat_of(A_, ws, it, li); trl_load(cur, d, li, lane); }
          while (it < NIT_W) { const int nit = it + NGW; const bool more = nit < NIT_W;
              if (more) { dn = mat_of(A_, ws, nit, ln); trl_load(nxt, dn, ln, lane); }
              tr_store(cur, d.K, d.WT, scr, li, d.nblk, lane);
              if (more) {
#pragma unroll
                  for (int i = 0; i < 8; ++i) cur[i] = nxt[i];
                  d = dn; li = ln; }
              it = nit; } }
        float* t64 = (float*)(ws + WS_TAB64); float* t32 = (float*)(ws + WS_TAB32);
        for (int i = gt; i < 2048 * 32; i += NGT) { const int pos = i >> 5, f = i & 31; const float inv = 1.0f / powf(10000.0f, (float)(2 * f) / 64.0f); const float ang = (float)pos * inv; t64[2 * i] = cosf(ang); t64[2 * i + 1] = sinf(ang); }
        for (int i = gt; i < 2048 * 16; i += NGT) { const int pos = i >> 4, f = i & 15; const float inv = 1.0f / powf(10000.0f, (float)(2 * f) / 32.0f); const float ang = (float)pos * inv; t32[2 * i] = cosf(ang); t32[2 * i + 1] = sinf(ang); }
        asm volatile("s_waitcnt vmcnt(0) lgkmcnt(0)" ::: "memory"); __syncthreads();
        { LAS f32x4* W2 = (LAS f32x4*)(lds + RING_OFF); const float* Wi = A_->in[3]; const float* gg = A_->in[1];
          for (int i = tid; i < 2048; i += NTHR) { const int ln = i & 63, sh = i >> 6, sl = sh >> 1, half = sh & 1, k = 4 * ln + 256 * (sl >> 2) + (sl & 3);
              W2[i] = *(const f32x4*)(Wi + (size_t)k * 3080 + 3072 + 4 * half) * gg[k]; }
          asm volatile("s_waitcnt vmcnt(0) lgkmcnt(0)" ::: "memory"); __syncthreads();
          rms_rows_dt(x, A_->in[1], XN, (float*)(ws + WS_DTR), W2, gw, NGW, lane); }
    }
    SEAM(0);
    if (IN(1)) { PH_VARS EpiIn0 E{(bf16*)(ws + L0_QK), (bf16*)(ws + L0_KC), TAB64, A_->in[10], A_->in[11], (float*)(ws + WS_KMEAN), (float*)(ws + WS_DTR)}; run_gemm(lds, XN, (const bf16*)(ws + WS_W_IN0), T_, 3072, 1024, E); }
    SEAM(1);
    if (IN(2)) { PH_VARS
        for (int u = blockIdx.x; u < 512; u += G) ssd::states_unit(lds, u >> 1, u & 1, (const bf16*)(ws + L0_XBC), (const float*)(ws + WS_DTR), A_->in[4], A_->in[5], A_->in[6], A_->in[7], (float*)(ws + L0_ST), (float*)(ws + WS_CEND));
    }
    SEAM(2);
    if (IN(3)) { PH_VARS
        const float* ST = (const float*)(ws + L0_ST); const float* CEND = (const float*)(ws + WS_CEND); bf16* HIN = (bf16*)(ws + L0_HIN);
        for (int i = gt; i < 16 * 8 * 64 * 128 / 4; i += NGT) {
            const int pn = (i & 2047) * 4, h = (i >> 11) & 7, b = i >> 14; f32x4 hst = {0.f, 0.f, 0.f, 0.f}; f32x4 tmp[16]; float dec[16];
#pragma unroll
            for (int c = 0; c < 16; ++c) { tmp[c] = *(const f32x4*)(ST + (((size_t)((b * 16 + c) * 8 + h) << 13) + pn)); dec[c] = CEND[(b * 16 + c) * 8 + h]; }
#pragma unroll
            for (int c = 0; c < 16; ++c) { const size_t idx = ((size_t)((b * 16 + c) * 8 + h) << 13) + pn;
                *(unsigned long long*)(HIN + idx) = (unsigned long long)pk2(hst.x, hst.y) | ((unsigned long long)pk2(hst.z, hst.w) << 32);
                hst = hst * __expf(dec[c]) + tmp[c]; }
        }
        const bf16* QK = (const bf16*)(ws + L0_QK); const bf16* VZ = (const bf16*)(ws + L0_VZ); const float* KM = (const float*)(ws + WS_KMEAN); bf16* MIX = (bf16*)(ws + L0_MIX);
        asm volatile("s_waitcnt vmcnt(0) lgkmcnt(0)" ::: "memory"); __syncthreads();
        float kb0; { float gm = fabsf(A_->in[11][lane]);
#pragma unroll
          for (int o_ = 1; o_ < 64; o_ <<= 1) gm = fmaxf(gm, __shfl_xor(gm, o_));
          kb0 = 8.0f * 1.02f * gm; }
        for (int i = blockIdx.x; i < 1024; i += G) {
            const int s_ = i >> 8, c = i & 255, bh = c >> 1, half = c & 1, qb = (s_ & 1) ? (s_ - 1 + half) : (7 - half - s_), b = bh >> 3, h = bh & 7;
            at2::Tensors TT{QK + h * 64, (const bf16*)(ws + L0_KC) + (size_t)(b * 8 + h) * (32 * 8 * 512), VZ + h * 64, MIX + h * 64, 1024, 0, 1024, 1024};
            at2::attn_unit_p<64, true, false, 2>(lds, TT, (long)b * 2048, qb, KM + b * 4096 + h * 64, nullptr, nullptr, kb0);
        }
    }
    SEAM(3);
    if (IN(4)) { PH_VARS
        for (int u = blockIdx.x; u < 512; u += G) ssd::out_unit(lds, u >> 1, u & 1, (const bf16*)(ws + L0_XBC), (const bf16*)(ws + L0_VZ), (const float*)(ws + WS_DTR), A_->in[4], A_->in[5], A_->in[6], A_->in[7],
                                                               (const bf16*)(ws + L0_HIN), A_->in[8], A_->in[9], (bf16*)(ws + L0_MIX));
    }
    SEAM(4);
    if (IN(5)) { PH_VARS EpiRes<false, false, true> E{nullptr, x, XN, (unsigned long long*)(ws + WS_SSQA)}; run_gemm(lds, (const bf16*)(ws + L0_MIX), (const bf16*)(ws + WS_W_OUT0), T_, 1024, 1024, E); }
    SEAM(5);
#define FFN_PHASES(P, L, AIN, SSQ_IN, LASTL, SSQ_OUT) \
    if (IN(P)) { PH_VARS EpiFfnUp E{(bf16*)(ws + FF_ACT), (bf16*)(ws + FF_UB), (const unsigned long long*)(ws + (SSQ_IN)), A_->in[22] + (size_t)(L) * 3 * DFF2, A_->in[23] + (size_t)(L) * DFF2}; \
        run_gemm<EpiFfnUp, 1>(lds, (const bf16*)(ws + (AIN)), (const bf16*)(ws + WS_W_UP) + (size_t)(L) * DFF2 * 1024, T_, DFF2, 1024, E); } \
    SEAM(P); \
    if (IN((P) + 1)) { PH_VARS \
        const bf16* UB = (const bf16*)(ws + FF_UB); bf16* ACT = (bf16*)(ws + FF_ACT); const float* cw = A_->in[22] + (size_t)(L) * 3 * DFF2; const float* cb = A_->in[23] + (size_t)(L) * DFF2; \
        for (int i = gt; i < 512 * 2 * (DFF / 8); i += NGT) {          \
            const int c0 = (i % (DFF / 8)) * 8, rr = (i / (DFF / 8)) & 1, ck = i / (2 * (DFF / 8)); const bool first = (ck & 31) == 0;     \
            float ag[8], au[8]; \
            _Pragma("unroll") for (int j = 0; j < 8; ++j) { ag[j] = cb[c0 + j]; au[j] = cb[DFF + c0 + j]; } \
            _Pragma("unroll") for (int k = 0; k < 3; ++k) { const int rel = rr - 2 + k;     \
                if (rel >= 0 || !first) { const bf16* src = (rel >= 0) ? UB + ((size_t)ck * 4 + rel) * DFF2 : UB + ((size_t)(ck - 1) * 4 + 4 + rel) * DFF2; \
                    const v4u wg = *(const v4u*)(src + c0); const v4u wu = *(const v4u*)(src + DFF + c0); const float* kg = cw + k * DFF2 + c0; const float* ku = kg + DFF; \
                    ag[0] += kg[0] * bflo(wg.x); ag[1] += kg[1] * bfhi(wg.x); ag[2] += kg[2] * bflo(wg.y); ag[3] += kg[3] * bfhi(wg.y); ag[4] += kg[4] * bflo(wg.z); ag[5] += kg[5] * bfhi(wg.z); ag[6] += kg[6] * bflo(wg.w); ag[7] += kg[7] * bfhi(wg.w); \
                    au[0] += ku[0] * bflo(wu.x); au[1] += ku[1] * bfhi(wu.x); au[2] += ku[2] * bflo(wu.y); au[3] += ku[3] * bfhi(wu.y); au[4] += ku[4] * bflo(wu.z); au[5] += ku[5] * bfhi(wu.z); au[6] += ku[6] * bflo(wu.w); au[7] += ku[7] * bfhi(wu.w); } } \
            v4u o; o.x = pk2(silu_f(ag[0]) * au[0], silu_f(ag[1]) * au[1]); o.y = pk2(silu_f(ag[2]) * au[2], silu_f(ag[3]) * au[3]); o.z = pk2(silu_f(ag[4]) * au[4], silu_f(ag[5]) * au[5]); o.w = pk2(silu_f(ag[6]) * au[6], silu_f(ag[7]) * au[7]); \
            *(v4u*)(ACT + ((size_t)ck * 64 + rr) * DFF + c0) = o; } } \
    SEAM((P) + 1); \
    if (IN((P) + 2)) { PH_VARS EpiRes<true, LASTL, !LASTL> E{out, (const bf16*)(ws + (AIN)), (bf16*)(ws + (AIN)), (unsigned long long*)(ws + (SSQ_OUT))}; run_gemm(lds, (const bf16*)(ws + FF_ACT), (const bf16*)(ws + WS_W_DN) + (size_t)(L) * 1024 * DFF, T_, 1024, DFF, E); } \
    SEAM((P) + 2);
    FFN_PHASES(6, 0, WS_XN, WS_SSQA, false, WS_SSQB)
    if (IN(9)) { PH_VARS EpiMlaIn E{(bf16*)(ws + L1_C1), (const unsigned long long*)(ws + WS_SSQB), (unsigned long long*)(ws + WS_SSQQ), (unsigned long long*)(ws + WS_SSQKV), (float*)(ws + WS_SSQPE), (float*)(ws + WS_RG), A_->in[19], TAB32}; run_gemm(lds, XN, (const bf16*)(ws + WS_W_IN1), T_, 1024, 1024, E); }
    SEAM(9);
    if (IN(10)) { PH_VARS const bf16* C1 = (const bf16*)(ws + L1_C1);
        { EpiScale E{(bf16*)(ws + L1_QR), 1536, (const unsigned long long*)(ws + WS_SSQQ), 1.0f / 512.0f}; run_gemm(lds, C1, (const bf16*)(ws + WS_W_UQ), T_, 1536, 512, E, 1024); }
        { EpiUkv E{(bf16*)(ws + L1_K2), (bf16*)(ws + L1_V2), (const unsigned long long*)(ws + WS_SSQKV), (const float*)(ws + WS_SSQPE), (const float*)(ws + WS_RG), A_->in[19]}; run_gemm(lds, C1 + 512, (const bf16*)(ws + WS_W_UKV), T_, 2048, 256, E, 1024); } }
    SEAM(10);
    if (IN(11)) { PH_VARS
        const bf16* Q2 = (const bf16*)(ws + L1_QR); const bf16* K2 = (const bf16*)(ws + L1_K2); const bf16* V2 = (const bf16*)(ws + L1_V2); bf16* O = (bf16*)(ws + L1_O);
        float kb1; { float gm = fmaxf(fabsf(A_->in[19][lane]), (lane < 32) ? fabsf(A_->in[19][64 + lane]) : 0.f);
#pragma unroll
          for (int o_ = 1; o_ < 64; o_ <<= 1) gm = fmaxf(gm, __shfl_xor(gm, o_));
          kb1 = 9.797958971f * 1.02f * gm; }
        for (int i = blockIdx.x; i < 2048; i += G) {
            const int s_ = i >> 8, bh = i & 255, qb = 7 - s_, b = bh >> 4, h = bh & 15;
            at2::Tensors TT{Q2 + h * 96, K2 + (size_t)(b * 16 + h) * (32 * 12 * 512), V2 + h * 64, O + h * 64, 1536, 0, 1024, 1024};
            at2::attn_unit_p<96, false, true, 2>(lds, TT, (long)b * 2048, qb, nullptr, A_->in[18], TAB32, kb1);
        }
    }
    SEAM(11);
    if (IN(12)) { PH_VARS EpiRes<true, false, true> E{nullptr, XN, (bf16*)(ws + WS_BIG), (unsigned long long*)(ws + WS_SSQC)}; run_gemm(lds, (const bf16*)(ws + L1_O), (const bf16*)(ws + WS_W_OUT1), T_, 1024, 1024, E); }
    SEAM(12);
    FFN_PHASES(13, 1, WS_BIG, WS_SSQC, true, WS_SSQB)
    if (PROBE_MASK) { if (blockIdx.x == 0 && threadIdx.x == 0) { const unsigned long long t0 = __builtin_amdgcn_s_memrealtime(); while (__builtin_amdgcn_s_memrealtime() - t0 < pr_acc) __builtin_amdgcn_s_sleep(8); } }
#undef IN
#undef SEAM
}
constexpr int LAST_PHASE = 16;

#ifndef MK_ONE_LAUNCH
#define MK_ONE_LAUNCH 1
#endif
extern "C" void kernel_launch(void* const* d_in, const int* in_sizes, int n_in, void* d_out, int out_size, void* d_ws, size_t ws_size, hipStream_t stream) {
    static int grid = 0;
    if (grid == 0) {
        if (n_in != 25 || out_size != T_ * D_ || ws_size < WS_END) { fprintf(stderr, "kernel_launch: unexpected shapes: n_in %d out %d ws %zu\n", n_in, out_size, ws_size); grid = -1; return; }
        if (hipFuncSetAttribute((const void*)fwd, hipFuncAttributeMaxDynamicSharedMemorySize, LDS_BYTES) != hipSuccess) { fprintf(stderr, "kernel_launch: hipFuncSetAttribute failed\n"); grid = -1; return; }
        int dev = 0, cus = 0, per_cu = 0;
        hipGetDevice(&dev); hipDeviceGetAttribute(&cus, hipDeviceAttributeMultiprocessorCount, dev);
        hipOccupancyMaxActiveBlocksPerMultiprocessor(&per_cu, (const void*)fwd, NTHR, LDS_BYTES);
        (void)hipGetLastError();
        grid = (per_cu >= 1) ? cus : -1;
        if (grid < 0) { fprintf(stderr, "kernel_launch: occupancy query says 0 blocks per CU\n"); return; }
    }
    if (grid < 0) return;
    hipMemsetAsync((char*)d_ws + WS_CTL, 0, CTL_ZERO_BYTES, stream);
    Args a{};
    for (int i = 0; i < 25; ++i) a.in[i] = (const float*)d_in[i];
    a.out = (float*)d_out; a.ws = (unsigned char*)d_ws;
#if MK_ONE_LAUNCH
    a.ph_lo = 0; a.ph_hi = LAST_PHASE;
    hipLaunchKernelGGL(fwd, dim3(grid), dim3(NTHR), LDS_BYTES, stream, a);
#else
    for (int p = 0; p < LAST_PHASE; ++p) { a.ph_lo = p; a.ph_hi = p + 1; hipLaunchKernelGGL(fwd, dim3(grid), dim3(NTHR), LDS_BYTES, stream, a); }
#endif
}
```

```cpp
#include <hip/hip_runtime.h>
#include <cstdio>
#include <cstdint>
namespace pg8 {
#define PG8_LAS __attribute__((address_space(3)))
typedef unsigned short bf16_t;
typedef short bf16x8 __attribute__((ext_vector_type(8)));
typedef float f32x4 __attribute__((ext_vector_type(4)));
typedef unsigned u32x4 __attribute__((ext_vector_type(4)));
constexpr int BM = 256, BK = 64, HALF = 128, HTB = HALF * BK * 2  , STAGE_BYTES = 8 * HTB, NXCD = 8, WGM = 8;

__host__ __device__ __forceinline__ int lds_byte(int r, int c) { const int st = (r >> 4) * 2 + (c >> 5), rr = r & 15, cc = c & 31, ob = rr * 64 + cc * 2; return st * 1024 + (ob ^ (((ob >> 9) & 1) << 5)); }
__host__ __device__ __forceinline__ void stage_rc(int b, int& R, int& C) { const int st = b / 1024, sb = b % 1024, swz = sb ^ (((sb >> 9) & 1) << 5); R = (st >> 1) * 16 + swz / 64; C = (st & 1) * 32 + (swz % 64) / 2; }
__host__ __device__ __forceinline__ int perm32(int rho) { const int n = rho >> 4, i = rho & 15; return 8 * (i >> 2) + 4 * n + (i & 3); }

struct Unit { int pm, pn; };
struct Gemm { const bf16_t* A; const bf16_t* Bt; int M, N, K, lda; };

struct StaticOrder {
    int nM, nN, nwg, G, c;
    __host__ __device__ void init(int M, int N, int G_, int c_) { nM = M / BM; nN = N / BM; nwg = nM * nN; G = G_; c = c_; }
    __host__ __device__ bool next(int i, Unit& u) const {
        const long L = (long)i * G + c; if (L >= nwg) return false;
        int wgid = (int)L; { const int q = nwg / NXCD, r = nwg % NXCD, xcd = wgid % NXCD, off = wgid / NXCD; wgid = (xcd < r ? xcd * (q + 1) : r * (q + 1) + (xcd - r) * q) + off; }
        const int nig = WGM * nN, gid = wgid / nig, fm = gid * WGM, gsz = (nM - fm) < WGM ? (nM - fm) : WGM;
        u.pm = fm + ((wgid % nig) % gsz); u.pn = (wgid % nig) / gsz; return true;
    }
    __device__ __forceinline__ void a_ready(const Unit&) const {}
    __device__ __forceinline__ void done(const Unit&) const {}
};

__device__ __forceinline__ unsigned cvt_pk_bf16(float lo, float hi) { unsigned r; asm volatile("v_cvt_pk_bf16_f32 %0, %1, %2" : "=v"(r) : "v"(lo), "v"(hi)); return r; }
typedef float f32x2 __attribute__((ext_vector_type(2)));
__device__ __forceinline__ f32x2 gelu_pk(f32x2 v) {
    const f32x2 av = __builtin_elementwise_abs(v), d = av * 0.2316418882f + 1.0f;
    f32x2 t; t.x = __builtin_amdgcn_rcpf(d.x); t.y = __builtin_amdgcn_rcpf(d.y);
    f32x2 q = t * 0.5307027145f + (-0.7265760135f); q = q * t + 0.7107068705f; q = q * t + (-0.142248368f); q = q * t + 0.127414796f; q = q * t;
    const f32x2 s = (v * v) * (-0.72134752044f);
    f32x2 e; e.x = __builtin_amdgcn_exp2f(s.x); e.y = __builtin_amdgcn_exp2f(s.y);
    const f32x2 m = v * (q * e), r = v - m;
    f32x2 o; o.x = v.x < 0.f ? m.x : r.x; o.y = v.y < 0.f ? m.y : r.y; return o;
}

template <int ACT  > struct EpiBf16 {
    static constexpr bool PERM = true, AFTER_DRAIN = false; static_assert(ACT == 0 || ACT == 1, "EpiBf16: ACT is 0 (none) or 1 (gelu_pk)");
    bf16_t* O; int ldc; const float* bias; int split_cols; size_t split_stride; float scale0;
    __device__ __forceinline__ void operator()(const f32x4 (&acc)[2][2][4][2], const Unit& u, int wr, int wc, int fr, int fq) const {
        const int row0 = u.pm * BM + wr * 64 + fr; int colt = u.pn * BM; bf16_t* base = O;
        float sc = 1.f; if (split_cols) { const int t = colt / split_cols; base += (size_t)t * split_stride; colt -= t * split_cols; if (t == 0) sc = scale0; }
        const int col0 = colt + wc * 32 + 8 * fq, bcol0 = u.pn * BM + wc * 32 + 8 * fq;
        f32x4 bv[2][2];
#pragma unroll
        for (int bj = 0; bj < 2; ++bj)
#pragma unroll
            for (int n = 0; n < 2; ++n) bv[bj][n] = bias ? *(const f32x4*)(bias + bcol0 + bj * HALF + 4 * n) : (f32x4){0.f, 0.f, 0.f, 0.f};
#pragma unroll
        for (int ai = 0; ai < 2; ++ai)
#pragma unroll
            for (int m = 0; m < 4; ++m) { bf16_t* rowp = base + (size_t)(row0 + ai * HALF + m * 16) * ldc + col0;
#pragma unroll
                for (int bj = 0; bj < 2; ++bj) { f32x4 v0 = acc[ai][bj][m][0] + bv[bj][0], v1 = acc[ai][bj][m][1] + bv[bj][1];
                    if (ACT == 1) { f32x2 a = gelu_pk((f32x2){v0[0], v0[1]}), b = gelu_pk((f32x2){v0[2], v0[3]}), c = gelu_pk((f32x2){v1[0], v1[1]}), d = gelu_pk((f32x2){v1[2], v1[3]});
                        v0 = (f32x4){a.x, a.y, b.x, b.y}; v1 = (f32x4){c.x, c.y, d.x, d.y}; }
                    v0 = v0 * sc; v1 = v1 * sc; u32x4 w; w.x = cvt_pk_bf16(v0[0], v0[1]); w.y = cvt_pk_bf16(v0[2], v0[3]); w.z = cvt_pk_bf16(v1[0], v1[1]); w.w = cvt_pk_bf16(v1[2], v1[3]);
                    *(u32x4*)(rowp + bj * HALF) = w; } }
    }
};

struct PanelStats {
    unsigned* xbuf;
    unsigned* cnt;
    unsigned* tmo;
    int ntn; float eps;
    unsigned code;
    __device__ __forceinline__ bool run(const f32x4 (&v)[2][2][4][2], const Unit& u, int wr, int wc, int fr, int fq, PG8_LAS unsigned char* lds, int wid, int lane) const {
        typedef float f32x2v __attribute__((ext_vector_type(2)));
        PG8_LAS f32x2v* P = (PG8_LAS f32x2v*)lds;
        PG8_LAS f32x2v* S = (PG8_LAS f32x2v*)(lds + 8192);
        PG8_LAS unsigned* flag = (PG8_LAS unsigned*)(lds + 8192 + 2048);
#pragma unroll
        for (int ai = 0; ai < 2; ++ai)
#pragma unroll
            for (int m = 0; m < 4; ++m) {
                float s = 0.f;
#pragma unroll
                for (int bj = 0; bj < 2; ++bj)
#pragma unroll
                    for (int n = 0; n < 2; ++n) { const f32x4 x = v[ai][bj][m][n]; s += (x[0] + x[1]) + (x[2] + x[3]); }
                s += __shfl_xor(s, 16); s += __shfl_xor(s, 32);
                const float mw = s * (1.0f / 64.0f); float q = 0.f;
#pragma unroll
                for (int bj = 0; bj < 2; ++bj)
#pragma unroll
                    for (int n = 0; n < 2; ++n) { const f32x4 d = v[ai][bj][m][n] - mw; q += (d[0] * d[0] + d[1] * d[1]) + (d[2] * d[2] + d[3] * d[3]); }
                q += __shfl_xor(q, 16); q += __shfl_xor(q, 32);
                if (fq == 0) P[(ai * HALF + wr * 64 + m * 16 + fr) * 4 + wc] = (f32x2v){mw, q};
            }
        asm volatile("s_waitcnt lgkmcnt(0)" ::: "memory"); __builtin_amdgcn_s_barrier(); asm volatile("" ::: "memory");
#if defined(BROKEN_EXCHANGE_NO_WAIT)
#warning BROKEN CONTROL BUILD: the row-statistics exchange does not wait; results are wrong by design
        if (blockIdx.x >= 64) { const long long t0_ = clock64(); while (clock64() - t0_ < 60000) __builtin_amdgcn_s_sleep(8); }
#endif
        const int row = wid * 32 + (lane & 31);
        if (lane < 32) {
            const f32x2v a = P[row * 4 + 0], b = P[row * 4 + 1], c = P[row * 4 + 2], d = P[row * 4 + 3];
            const float mt = (a.x + b.x + c.x + d.x) * 0.25f;
            const float da = a.x - mt, db = b.x - mt, dc = c.x - mt, dd = d.x - mt;
            const float m2 = (a.y + b.y) + (c.y + d.y) + 64.0f * ((da * da + db * db) + (dc * dc + dd * dd));
            unsigned long long* slot = (unsigned long long*)xbuf + ((size_t)(u.pm * BM + row) * 4 + u.pn);
            __hip_atomic_store(slot, ((unsigned long long)__float_as_uint(m2) << 32) | __float_as_uint(mt), __ATOMIC_RELAXED, __HIP_MEMORY_SCOPE_AGENT);
        }
        asm volatile("s_waitcnt vmcnt(0)" ::: "memory");
        if (lane == 0) __hip_atomic_fetch_add(cnt + 64 * u.pm, 1u, __ATOMIC_RELAXED, __HIP_MEMORY_SCOPE_AGENT);
        if (wid == 0) {
            bool dead = false; const unsigned long long t0 = __builtin_amdgcn_s_memrealtime(); const unsigned want = 8u * (unsigned)ntn;
            for (;;) {
#if defined(BROKEN_EXCHANGE_NO_WAIT)
                break;
#endif
                if ((unsigned)__builtin_amdgcn_readfirstlane(__hip_atomic_load(cnt + 64 * u.pm, __ATOMIC_RELAXED, __HIP_MEMORY_SCOPE_AGENT)) >= want) break;
                if (__builtin_amdgcn_s_memrealtime() - t0 > 2000000ull) {
                    if (lane == 0) { unsigned expect = 0u; __hip_atomic_compare_exchange_strong(tmo + 1, &expect, code | (unsigned)(u.pm & 0xff), __ATOMIC_RELAXED, __ATOMIC_RELAXED, __HIP_MEMORY_SCOPE_AGENT);
                                     __hip_atomic_store(tmo, 1u, __ATOMIC_RELAXED, __HIP_MEMORY_SCOPE_AGENT); }
                    dead = true; break; }
                __builtin_amdgcn_s_sleep(2);
            }
            __builtin_amdgcn_fence(__ATOMIC_ACQUIRE, "agent");
            if (lane == 0) flag[0] = dead ? 1u : 0u;
        }
        asm volatile("s_waitcnt vmcnt(0) lgkmcnt(0)" ::: "memory"); __builtin_amdgcn_s_barrier(); asm volatile("" ::: "memory");
        const bool bad = flag[0] != 0u;
        if (lane < 32) {
            const unsigned long long* slot = (const unsigned long long*)xbuf + (size_t)(u.pm * BM + row) * 4; float mt[4], m2[4]; float ms = 0.f;
#pragma unroll
            for (int t = 0; t < 4; ++t) { if (t < ntn) { const unsigned long long w = __hip_atomic_load(slot + t, __ATOMIC_RELAXED, __HIP_MEMORY_SCOPE_AGENT); mt[t] = __uint_as_float((unsigned)w); m2[t] = __uint_as_float((unsigned)(w >> 32)); } else { mt[t] = 0.f; m2[t] = 0.f; } ms += mt[t]; }
            const float mean = ms / (float)ntn; float q = 0.f;
#pragma unroll
            for (int t = 0; t < 4; ++t) if (t < ntn) { const float dm = mt[t] - mean; q += m2[t] + 256.0f * dm * dm; }
            S[row] = (f32x2v){mean, 1.0f / sqrtf(q / (256.0f * (float)ntn) + eps)};
        }
        asm volatile("s_waitcnt lgkmcnt(0)" ::: "memory"); __builtin_amdgcn_s_barrier(); asm volatile("" ::: "memory");
        return bad;
    }
};
struct EpiLnRes {
    static constexpr bool PERM = false, AFTER_DRAIN = true;
    const float* base; float* out; int ldc; const float* bias; PanelStats st; unsigned poison;
    __device__ __forceinline__ void fused(f32x4 (&acc)[2][2][4][2], const Unit& u, int wr, int wc, int fr, int fq, PG8_LAS unsigned char* lds, int wid, int lane) const {
        typedef float f32x2v __attribute__((ext_vector_type(2)));
        const PG8_LAS f32x2v* S = (const PG8_LAS f32x2v*)(lds + 8192);
        const int col0 = u.pn * BM + wc * 32 + 4 * fq;
#pragma unroll
        for (int bj = 0; bj < 2; ++bj)
#pragma unroll
            for (int n = 0; n < 2; ++n) { const f32x4 bv = bias ? *(const f32x4*)(bias + col0 + bj * HALF + n * 16) : (f32x4){0.f, 0.f, 0.f, 0.f};
#pragma unroll
                for (int ai = 0; ai < 2; ++ai)
#pragma unroll
                    for (int m = 0; m < 4; ++m) acc[ai][bj][m][n] += bv; }
        f32x4 pre[4][2][2];
#pragma unroll
        for (int m = 0; m < 4; ++m) { const size_t off = (size_t)(u.pm * BM + wr * 64 + m * 16 + fr) * ldc + col0;
#pragma unroll
            for (int bj = 0; bj < 2; ++bj)
#pragma unroll
                for (int n = 0; n < 2; ++n) pre[m][bj][n] = *(const f32x4*)(base + off + bj * HALF + n * 16); }
        const bool bad = st.run(acc, u, wr, wc, fr, fq, lds, wid, lane) || poison != 0u;
        const float qnan = __builtin_nanf("");
#pragma unroll
        for (int ai = 0; ai < 2; ++ai)
#pragma unroll
            for (int m = 0; m < 4; ++m) { const int r = ai * HALF + wr * 64 + m * 16 + fr; const f32x2v sr = S[r]; const size_t off = (size_t)(u.pm * BM + r) * ldc + col0;
#pragma unroll
                for (int bj = 0; bj < 2; ++bj)
#pragma unroll
                    for (int n = 0; n < 2; ++n) { const f32x4 bs = ai == 0 ? pre[m][bj][n] : *(const f32x4*)(base + off + bj * HALF + n * 16); f32x4 o = bs + (acc[ai][bj][m][n] - sr.x) * sr.y;
                        if (bad) o = (f32x4){qnan, qnan, qnan, qnan}; *(f32x4*)(out + off + bj * HALF + n * 16) = o; }
                if (m & 1) asm volatile("" ::: "memory"); }
    }
};
struct EpiLnResLn {
    static constexpr bool PERM = false, AFTER_DRAIN = true;
    const float* base; float* out; bf16_t* xn; int ldc; const float* bias; PanelStats st1, st2; unsigned poison;
    __device__ __forceinline__ void fused(f32x4 (&acc)[2][2][4][2], const Unit& u, int wr, int wc, int fr, int fq, PG8_LAS unsigned char* lds, int wid, int lane) const {
        typedef float f32x2v __attribute__((ext_vector_type(2))); typedef unsigned u32x2v __attribute__((ext_vector_type(2)));
        const PG8_LAS f32x2v* S = (const PG8_LAS f32x2v*)(lds + 8192);
        const int col0 = u.pn * BM + wc * 32 + 4 * fq;
#pragma unroll
        for (int bj = 0; bj < 2; ++bj)
#pragma unroll
            for (int n = 0; n < 2; ++n) { const f32x4 bv = bias ? *(const f32x4*)(bias + col0 + bj * HALF + n * 16) : (f32x4){0.f, 0.f, 0.f, 0.f};
#pragma unroll
                for (int ai = 0; ai < 2; ++ai)
#pragma unroll
                    for (int m = 0; m < 4; ++m) acc[ai][bj][m][n] += bv; }
        bool bad = st1.run(acc, u, wr, wc, fr, fq, lds, wid, lane) || poison != 0u;
        const float qnan = __builtin_nanf("");
#pragma unroll
        for (int ai = 0; ai < 2; ++ai)
#pragma unroll
            for (int m = 0; m < 4; ++m) { const int r = ai * HALF + wr * 64 + m * 16 + fr; const f32x2v sr = S[r]; const size_t off = (size_t)(u.pm * BM + r) * ldc + col0;
#pragma unroll
                for (int bj = 0; bj < 2; ++bj)
#pragma unroll
                    for (int n = 0; n < 2; ++n) { const f32x4 bs = *(const f32x4*)(base + off + bj * HALF + n * 16); acc[ai][bj][m][n] = bs + (acc[ai][bj][m][n] - sr.x) * sr.y; }
                asm volatile("" : "+v"(acc[ai][0][m][0]), "+v"(acc[ai][0][m][1]), "+v"(acc[ai][1][m][0]), "+v"(acc[ai][1][m][1]));
                if (m & 1) asm volatile("" ::: "memory"); }
        const bool bad1 = bad;
        bad = st2.run(acc, u, wr, wc, fr, fq, lds, wid, lane) || bad;
#pragma unroll
        for (int ai = 0; ai < 2; ++ai)
#pragma unroll
            for (int m = 0; m < 4; ++m) { const int r = ai * HALF + wr * 64 + m * 16 + fr; const f32x2v sr = S[r]; const size_t off = (size_t)(u.pm * BM + r) * ldc + col0;
#pragma unroll
                for (int bj = 0; bj < 2; ++bj)
#pragma unroll
                    for (int n = 0; n < 2; ++n) { const f32x4 x1 = acc[ai][bj][m][n]; *(f32x4*)(out + off + bj * HALF + n * 16) = bad1 ? (f32x4){qnan, qnan, qnan, qnan} : x1;
                        const f32x4 o = (x1 - sr.x) * sr.y; u32x2v w; w.x = cvt_pk_bf16(o[0], o[1]); w.y = cvt_pk_bf16(o[2], o[3]);
                        if (bad) { w.x = 0x7fc07fc0u; w.y = 0x7fc07fc0u; } *(u32x2v*)(xn + off + bj * HALF + n * 16) = w; }
                asm volatile("" ::: "memory"); }
    }
};

template <class Epi, class Sched, bool ALIGN_EPI = false, bool SP2 = false, int AROW = 0>
__device__ __forceinline__ void gemm_phase(PG8_LAS unsigned char* lds, const Gemm g, const Sched& S, const Epi& E) {
    int tid_ = threadIdx.x; asm volatile("" : "+v"(tid_));
    const int tid = tid_, wid = __builtin_amdgcn_readfirstlane(tid >> 6), lane = tid & 63, wr = wid >> 2, wc = wid & 3, fr = lane & 15, fq = lane >> 4;
    const int K = g.K, nt = K / BK;
    unsigned voffA[2], voffB[2];
#pragma unroll
    for (int i = 0; i < 2; ++i) { int R, C; stage_rc(tid * 16 + i * 8192, R, C); const int Rb = Epi::PERM ? ((R & ~31) + perm32(R & 31)) : R;
        const int Ra = (AROW == 1) ? ((R & ~63) + 4 * (R & 15) + ((R >> 4) & 3)) : R;
        voffA[i] = (unsigned)(Ra * g.lda + C) * 2u; voffB[i] = (unsigned)(Rb * K + C) * 2u;
        if (AROW == 2) { const int tp = 4 * ((lane >> 2) & 3) + (lane >> 4), c = lane & 3;
            voffA[i] = (unsigned)((64 * i + 16 * (wid & 3) + tp) * g.lda + 32 * (wid >> 2) + 8 * c) * 2u; } }
    const size_t kstep = (size_t)(BK * 2);
    const size_t hstep = (size_t)HALF * K * 2;
    const size_t tstep = 2 * hstep;
    const size_t hstepA = (size_t)HALF * g.lda * 2, tstepA = 2 * hstepA;
    const unsigned ldsw = (unsigned)wid * 1024u;
    constexpr int PSTR = 1056, HTBA = (AROW == 2) ? 16 * PSTR : HTB;
    const int aoff = (AROW == 2) ? (wr * 8 + (fr >> 2)) * PSTR + 64 * (fr & 3) + 16 * fq : lds_byte(wr * 64 + fr, fq * 8), boff = lds_byte(wc * 32 + fr, fq * 8);
    constexpr int AM = (AROW == 2) ? 256 : 2048, AK = (AROW == 2) ? 4 * PSTR : 1024;
    const unsigned ldswA = (AROW == 2) ? (unsigned)wid * PSTR : (unsigned)wid * 1024u; constexpr unsigned ISTRA = (AROW == 2) ? 8u * PSTR : 8192u;
#define PG8_SA(b, h) (((b) * 2 + (h)) * HTBA)
#define PG8_SB(b, h) (4 * HTBA + ((b) * 2 + (h)) * HTB)
#define PG8_STAGEA(bufoff, gbase, voff) do { _Pragma("unroll") for (int _i = 0; _i < 2; ++_i) \
        __builtin_amdgcn_global_load_lds((const unsigned*)((const char*)(gbase) + (voff)[_i]), (PG8_LAS unsigned*)(lds + (bufoff) + ldswA + _i * ISTRA), 16, 0, 0); } while (0)
#define PG8_STAGE(bufoff, gbase, voff) do { _Pragma("unroll") for (int _i = 0; _i < 2; ++_i) \
        __builtin_amdgcn_global_load_lds((const unsigned*)((const char*)(gbase) + (voff)[_i]), (PG8_LAS unsigned*)(lds + (bufoff) + ldsw + _i * 8192), 16, 0, 0); } while (0)
#define PG8_LDA(dst, b, h) do { _Pragma("unroll") for (int m = 0; m < 4; ++m) _Pragma("unroll") for (int k = 0; k < 2; ++k) dst[m][k] = *(const PG8_LAS bf16x8*)(lds + PG8_SA(b, h) + aoff + m * AM + k * AK); } while (0)
#define PG8_LDB(dst, b, h) do { _Pragma("unroll") for (int n = 0; n < 2; ++n) _Pragma("unroll") for (int k = 0; k < 2; ++k) dst[n][k] = *(const PG8_LAS bf16x8*)(lds + PG8_SB(b, h) + boff + n * 2048 + k * 1024); } while (0)
#define PG8_MMA(ai, bj, At, Bt) do { __builtin_amdgcn_s_setprio(1); _Pragma("unroll") for (int m = 0; m < 4; ++m) _Pragma("unroll") for (int n = 0; n < 2; ++n) _Pragma("unroll") for (int k = 0; k < 2; ++k) \
        acc[ai][bj][m][n] = __builtin_amdgcn_mfma_f32_16x16x32_bf16(Bt[n][k], At[m][k], acc[ai][bj][m][n], 0, 0, 0); __builtin_amdgcn_s_setprio(0); } while (0)
#define PG8_WAIT_V(n) asm volatile("s_waitcnt vmcnt(" #n ")" ::: "memory")
#define PG8_WAIT_L(n) asm volatile("s_waitcnt lgkmcnt(" #n ")" ::: "memory")
#define PG8_BAR __builtin_amdgcn_s_barrier()
#define PG8_SCHED __builtin_amdgcn_sched_barrier(0)
    Unit cur, nxt; int ui = 0;
    if (!S.next(0, cur)) return;
    f32x4 acc[2][2][4][2];
#pragma unroll
    for (int a = 0; a < 2; ++a)
#pragma unroll
        for (int b = 0; b < 2; ++b)
#pragma unroll
            for (int m = 0; m < 4; ++m)
#pragma unroll
                for (int n = 0; n < 2; ++n) acc[a][b][m][n] = (f32x4){0.f, 0.f, 0.f, 0.f};
    bf16x8 At[4][2], B0[2][2], B1[2][2];
    const char* cA = (const char*)g.A + (size_t)cur.pm * tstepA; const char* cB = (const char*)g.Bt + (size_t)cur.pn * tstep;
    S.a_ready(cur);
    if constexpr (SP2) {
        PG8_STAGE(PG8_SB(0, 0), cB, voffB); PG8_STAGE(PG8_SB(0, 1), cB + hstep, voffB); PG8_STAGEA(PG8_SA(0, 0), cA, voffA); PG8_STAGEA(PG8_SA(0, 1), cA + hstepA, voffA);
        if (wr == 1) PG8_BAR;
        PG8_WAIT_V(2); PG8_BAR;
        PG8_STAGE(PG8_SB(1, 0), cB + kstep, voffB); PG8_STAGEA(PG8_SA(1, 0), cA + kstep, voffA); PG8_STAGE(PG8_SB(1, 1), cB + hstep + kstep, voffB);
        PG8_WAIT_V(6); PG8_BAR;
    } else {
        PG8_STAGE(PG8_SB(0, 0), cB, voffB); PG8_STAGEA(PG8_SA(0, 0), cA, voffA); PG8_STAGE(PG8_SB(0, 1), cB + hstep, voffB); PG8_STAGEA(PG8_SA(0, 1), cA + hstepA, voffA);
        if (wr == 1) PG8_BAR;
        PG8_WAIT_V(4); PG8_BAR;
        PG8_STAGE(PG8_SB(1, 0), cB + kstep, voffB); PG8_STAGEA(PG8_SA(1, 0), cA + kstep, voffA); PG8_STAGE(PG8_SB(1, 1), cB + hstep + kstep, voffB);
        PG8_WAIT_V(6); PG8_BAR;
    }
    for (;;) {
        const bool has_next = S.next(ui + 1, nxt);
        const char* nA = has_next ? (const char*)g.A + (size_t)nxt.pm * tstepA : cA; const char* nB = has_next ? (const char*)g.Bt + (size_t)nxt.pn * tstep : cB;
#pragma unroll 1
        for (int t = 0; t < nt; t += 2) {
            const bool last = (t == nt - 2);
            const char* a1 = cA + (size_t)(t + 1) * kstep;
            const char* a2 = last ? nA : cA + (size_t)(t + 2) * kstep; const char* b2 = last ? nB : cB + (size_t)(t + 2) * kstep;
            const char* a3 = a2 + kstep; const char* b3 = b2 + kstep;
            if (last && has_next) S.a_ready(nxt);
            if constexpr (SP2) {
            PG8_LDB(B0, 0, 0); PG8_LDB(B1, 0, 1); PG8_SCHED; PG8_LDA(At, 0, 0); PG8_STAGEA(PG8_SA(1, 1), a1 + hstepA, voffA);
            PG8_WAIT_V(8); PG8_WAIT_L(0); PG8_BAR; PG8_MMA(0, 0, At, B0); PG8_MMA(0, 1, At, B1); PG8_BAR; PG8_SCHED;
            PG8_LDA(At, 0, 1); PG8_STAGE(PG8_SB(0, 0), b2, voffB); PG8_STAGE(PG8_SB(0, 1), b2 + hstep, voffB); PG8_STAGEA(PG8_SA(0, 0), a2, voffA);
            PG8_WAIT_V(8); PG8_WAIT_L(0); PG8_BAR; PG8_MMA(1, 0, At, B0); PG8_MMA(1, 1, At, B1); PG8_BAR; PG8_SCHED;
            PG8_LDB(B0, 1, 0); PG8_LDB(B1, 1, 1); PG8_SCHED; PG8_LDA(At, 1, 0); PG8_STAGEA(PG8_SA(0, 1), a2 + hstepA, voffA);
            PG8_WAIT_V(8); PG8_WAIT_L(0); PG8_BAR; PG8_MMA(0, 0, At, B0); PG8_MMA(0, 1, At, B1); PG8_BAR; PG8_SCHED;
            PG8_LDA(At, 1, 1); PG8_STAGE(PG8_SB(1, 0), b3, voffB); PG8_STAGE(PG8_SB(1, 1), b3 + hstep, voffB); PG8_STAGEA(PG8_SA(1, 0), a3, voffA);
            PG8_WAIT_V(8); PG8_WAIT_L(0); PG8_BAR; PG8_MMA(1, 0, At, B0); PG8_MMA(1, 1, At, B1); PG8_BAR; PG8_SCHED;
            } else {
            PG8_LDB(B0, 0, 0); PG8_SCHED; PG8_LDA(At, 0, 0); PG8_STAGEA(PG8_SA(1, 1), a1 + hstepA, voffA);
            PG8_WAIT_L(8); PG8_BAR; PG8_WAIT_L(0); PG8_MMA(0, 0, At, B0); PG8_BAR; PG8_SCHED;
            PG8_LDB(B1, 0, 1); PG8_STAGE(PG8_SB(0, 0), b2, voffB);
            PG8_BAR; PG8_WAIT_L(0); PG8_MMA(0, 1, At, B1); PG8_BAR;
            PG8_LDA(At, 0, 1); PG8_STAGEA(PG8_SA(0, 0), a2, voffA);
            PG8_BAR; PG8_WAIT_L(0); PG8_MMA(1, 0, At, B0); PG8_BAR; PG8_SCHED;
            PG8_STAGE(PG8_SB(0, 1), b2 + hstep, voffB);
            PG8_WAIT_V(6); PG8_BAR; PG8_MMA(1, 1, At, B1); PG8_BAR;
            PG8_LDB(B0, 1, 0); PG8_SCHED; PG8_LDA(At, 1, 0); PG8_STAGEA(PG8_SA(0, 1), a2 + hstepA, voffA);
            PG8_WAIT_L(8); PG8_BAR; PG8_WAIT_L(0); PG8_MMA(0, 0, At, B0); PG8_BAR; PG8_SCHED;
            PG8_LDB(B1, 1, 1); PG8_STAGE(PG8_SB(1, 0), b3, voffB);
            PG8_BAR; PG8_WAIT_L(0); PG8_MMA(0, 1, At, B1); PG8_BAR;
            PG8_LDA(At, 1, 1); PG8_STAGEA(PG8_SA(1, 0), a3, voffA);
            PG8_BAR; PG8_WAIT_L(0); PG8_MMA(1, 0, At, B0); PG8_BAR; PG8_SCHED;
            PG8_STAGE(PG8_SB(1, 1), b3 + hstep, voffB);
            PG8_WAIT_V(6); PG8_BAR; PG8_MMA(1, 1, At, B1); PG8_BAR;
            }
        }
        if constexpr (ALIGN_EPI) { if (wr == 0) PG8_BAR; }
        if constexpr (!Epi::AFTER_DRAIN) { E(acc, cur, wr, wc, fr, fq); S.done(cur); }
        if (!has_next) break;
#pragma unroll
        for (int a = 0; a < 2; ++a)
#pragma unroll
            for (int b = 0; b < 2; ++b)
#pragma unroll
                for (int m = 0; m < 4; ++m)
#pragma unroll
                    for (int n = 0; n < 2; ++n) acc[a][b][m][n] = (f32x4){0.f, 0.f, 0.f, 0.f};
        cur = nxt; cA = nA; cB = nB; ++ui;
        if constexpr (ALIGN_EPI) { if (wr == 1) PG8_BAR; }
    }
    PG8_WAIT_V(0);
    if constexpr (!ALIGN_EPI) { if (wr == 0) PG8_BAR; }
    PG8_BAR;
    if constexpr (Epi::AFTER_DRAIN) { E.fused(acc, cur, wr, wc, fr, fq, lds, wid, lane); S.done(cur); }
#undef PG8_SA
#undef PG8_SB
#undef PG8_STAGE
#undef PG8_STAGEA
#undef PG8_LDA
#undef PG8_LDB
#undef PG8_MMA
#undef PG8_WAIT_V
#undef PG8_WAIT_L
#undef PG8_BAR
#undef PG8_SCHED
}
}

#ifndef PG8_SP2
#define PG8_SP2 true
#endif
#ifndef PG8_ALIGN
#define PG8_ALIGN true
#endif
#define GAS __attribute__((address_space(1)))
#define LAS __attribute__((address_space(3)))
typedef unsigned short bf16;
typedef unsigned v4u __attribute__((ext_vector_type(4)));
typedef float f32x4 __attribute__((ext_vector_type(4)));
typedef short bf16x8 __attribute__((ext_vector_type(8)));
typedef GAS unsigned gu32;
typedef GAS unsigned long long gu64;
#define RLX_AGENT __ATOMIC_RELAXED, __HIP_MEMORY_SCOPE_AGENT
#define LDS_WAIT() asm volatile("s_waitcnt lgkmcnt(0)" ::: "memory")
#define VM_WAIT() asm volatile("s_waitcnt vmcnt(0)" ::: "memory")
__device__ __forceinline__ unsigned long long rt() { return __builtin_amdgcn_s_memrealtime(); }
__device__ __forceinline__ unsigned f2bf(float f) { unsigned u = __builtin_bit_cast(unsigned, f); return (u + 0x7fffu + ((u >> 16) & 1u)) >> 16; }
typedef float pk_f32x2_t __attribute__((ext_vector_type(2))); typedef __bf16 pk_bf16x2_t __attribute__((ext_vector_type(2)));
__device__ __forceinline__ unsigned pk2(float lo, float hi) { pk_f32x2_t v = {lo, hi}; pk_bf16x2_t b = __builtin_convertvector(v, pk_bf16x2_t); return __builtin_bit_cast(unsigned, b); }

#define XB_TMO      128
#define XB_XCNT(j)  (256  + 64 * (j))
#define XB_XSUB(j)  (1280 + 64 * (j))
#define XB_XGEN(j)  (2304 + 64 * (j))
#define XB_TOP      3328
#define XB_TOPGEN   3392
#define XCD_BAR_WORDS 3456
#define XB_SPIN_CAP (1u << 18)

__device__ __forceinline__ unsigned xb_ld(unsigned* p)              { return __hip_atomic_load(p, __ATOMIC_RELAXED, __HIP_MEMORY_SCOPE_AGENT); }
__device__ __forceinline__ unsigned xb_add(unsigned* p, unsigned v) { return __hip_atomic_fetch_add(p, v, __ATOMIC_RELAXED, __HIP_MEMORY_SCOPE_AGENT); }
__device__ __forceinline__ unsigned xb_xcc_id() { return (unsigned)__builtin_amdgcn_s_getreg((3 << 11) | 20) & 0xFu; }
#define XB_SPIN(cond, bar) do { unsigned _sp = 0; while (cond) { __builtin_amdgcn_s_sleep(1); \
    if ((++_sp & 255u) == 0u) { if (xb_ld(&(bar)[XB_TMO])) break; if (_sp > XB_SPIN_CAP) { atomicAdd(&(bar)[XB_TMO], 1u); break; } } } } while (0)

struct XcdBarrier {
    unsigned* bar; unsigned x;
    volatile LAS unsigned* st;
};

__device__ __forceinline__ XcdBarrier xcd_barrier_post(unsigned* bar, volatile LAS unsigned* st) {
    XcdBarrier b; b.bar = bar; b.x = xb_xcc_id(); b.st = st;
    if (threadIdx.x == 0) (void)xb_add(&bar[XB_XCNT(b.x)], 1u);
    return b;
}
__device__ __forceinline__ void xcd_barrier_complete(unsigned* bar, unsigned x, unsigned& nloc, unsigned& nx) {
    const unsigned G = gridDim.x * gridDim.y * gridDim.z;
    unsigned sum, cnt, mine, sp = 0u;
    for (;;) {
        sum = 0u; cnt = 0u; mine = 0u;
#pragma unroll
        for (unsigned j = 0; j < 16; ++j) { const unsigned c = xb_ld(&bar[XB_XCNT(j)]); sum += c; cnt += (c > 0u) ? 1u : 0u; mine = (j == x) ? c : mine; }
        if (sum == G) break;
        __builtin_amdgcn_s_sleep(1);
        if ((++sp & 255u) == 0u) { if (xb_ld(&bar[XB_TMO])) break; if (sp > XB_SPIN_CAP) { atomicAdd(&bar[XB_TMO], 1u); break; } }
    }
    nloc = mine > 0u ? mine : 1u; nx = cnt > 0u ? cnt : 1u;
}

__device__ __forceinline__ void xcd_barrier(const XcdBarrier& b) {
    asm volatile("s_waitcnt vmcnt(0)" ::: "memory");
    __syncthreads();
    if (threadIdx.x == 0) {
        unsigned* bar = b.bar;
        __builtin_amdgcn_s_waitcnt(0);
        unsigned nloc = b.st[0], nx = b.st[1];
        if (nloc == 0u) { xcd_barrier_complete(bar, b.x, nloc, nx); b.st[0] = nloc; b.st[1] = nx; }
        const unsigned old = xb_add(&bar[XB_XSUB(b.x)], 1u);
        const unsigned gen = old / nloc;
        if (old + 1u == (gen + 1u) * nloc) {
            __builtin_amdgcn_fence(__ATOMIC_RELEASE, "agent");
            asm volatile("s_waitcnt vmcnt(0)" ::: "memory");
            const unsigned og = xb_add(&bar[XB_TOP], 1u);
            const unsigned tg = og / nx;
            if (og + 1u == (tg + 1u) * nx) xb_add(&bar[XB_TOPGEN], 1u);
            else XB_SPIN(xb_ld(&bar[XB_TOPGEN]) == tg, bar);
            __builtin_amdgcn_fence(__ATOMIC_ACQUIRE, "agent");
            xb_add(&bar[XB_XGEN(b.x)], 1u);
            asm volatile("s_waitcnt vmcnt(0)" ::: "memory");
        } else {
            XB_SPIN(xb_ld(&bar[XB_XGEN(b.x)]) == gen, bar);
            __builtin_amdgcn_fence(__ATOMIC_ACQUIRE, "agent");
            asm volatile("s_waitcnt vmcnt(0)" ::: "memory");
        }
    }
    __syncthreads();
}
__device__ __forceinline__ float bf2f(bf16 v) { return __builtin_bit_cast(float, (unsigned)v << 16); }
__device__ __forceinline__ float bflo(unsigned w) { return __builtin_bit_cast(float, w << 16); }
__device__ __forceinline__ float bfhi(unsigned w) { return __builtin_bit_cast(float, w & 0xffff0000u); }
__device__ __forceinline__ float silu_f(float v) { return v / (1.f + __expf(-v)); }
__device__ __forceinline__ float wave_sum(float v) {
#pragma unroll
    for (int o = 1; o < 64; o <<= 1) v += __shfl_xor(v, o);
    return v;
}


namespace at2 {
typedef short bf16x8 __attribute__((ext_vector_type(8)));
typedef short s16x4 __attribute__((ext_vector_type(4)));
typedef float f32x16 __attribute__((ext_vector_type(16)));
typedef unsigned u32x4 __attribute__((ext_vector_type(4)));
typedef float f32x2_t __attribute__((ext_vector_type(2))); typedef __bf16 bf16x2_t __attribute__((ext_vector_type(2)));
#define AT_LAS __attribute__((address_space(3)))
__device__ __forceinline__ int crow(int r, int hi) { return (r & 3) + 8 * (r >> 2) + 4 * hi; }
__device__ __forceinline__ void glds16(const void* gsrc, unsigned lds_dst) { unsigned keep;
    asm volatile("s_mov_b32 %0, m0\n\ts_mov_b32 m0, %2\n\ts_nop 0\n\tglobal_load_lds_dwordx4 %1, off\n\ts_mov_b32 m0, %0" : "=&s"(keep) : "v"(gsrc), "s"(lds_dst) : "memory"); }
__device__ __forceinline__ unsigned cvtpk(float lo, float hi) { f32x2_t v = {lo, hi}; bf16x2_t b = __builtin_convertvector(v, bf16x2_t); return __builtin_bit_cast(unsigned, b); }
__device__ __forceinline__ float swap_max(float m) { auto rr = __builtin_amdgcn_permlane32_swap(__float_as_uint(m), __float_as_uint(m), false, false); float r; asm("v_max_f32_e32 %0, %1, %2" : "=v"(r) : "v"(__uint_as_float(rr[0])), "v"(__uint_as_float(rr[1]))); return r; }
__device__ __forceinline__ float swap_sum(float m) { auto rr = __builtin_amdgcn_permlane32_swap(__float_as_uint(m), __float_as_uint(m), false, false); return __uint_as_float(rr[0]) + __uint_as_float(rr[1]); }

__device__ __forceinline__ float max3f(float a, float b, float c) { float r; asm("v_max3_f32 %0, %1, %2, %3" : "=v"(r) : "v"(a), "v"(b), "v"(c)); return r; }
__device__ __forceinline__ float max2f(float a, float b) { float r; asm("v_max_f32_e32 %0, %1, %2" : "=v"(r) : "v"(a), "v"(b)); return r; }
constexpr float NEGM = -1e30f;
constexpr float THR = 8.0f;

struct Tensors { const unsigned short* Q; const unsigned short* K; const unsigned short* V; unsigned short* O; int pq, pk, pv, po; };

__device__ __forceinline__ void pv(f32x16* o, int vb, bf16x8 pa0, bf16x8 pa1, bf16x8 pa2, bf16x8 pa3) {
#pragma unroll
    for (int d0 = 0; d0 < 2; ++d0) { s16x4 lo[4], hi[4];
#pragma unroll
        for (int ks = 0; ks < 4; ++ks) {
            asm volatile("ds_read_b64_tr_b16 %0,%1 offset:%c2" : "=&v"(lo[ks]) : "v"(vb), "i"(d0 * 4096 + ks * 1024) : "memory");
            asm volatile("ds_read_b64_tr_b16 %0,%1 offset:%c2" : "=&v"(hi[ks]) : "v"(vb), "i"(d0 * 4096 + ks * 1024 + 512) : "memory"); }
        asm volatile("s_waitcnt lgkmcnt(0)" ::: "memory"); __builtin_amdgcn_sched_barrier(0);
#define AT_PK(k) (bf16x8){lo[k][0], lo[k][1], lo[k][2], lo[k][3], hi[k][0], hi[k][1], hi[k][2], hi[k][3]}
        o[d0] = __builtin_amdgcn_mfma_f32_32x32x16_bf16(pa0, AT_PK(0), o[d0], 0, 0, 0);
        o[d0] = __builtin_amdgcn_mfma_f32_32x32x16_bf16(pa1, AT_PK(1), o[d0], 0, 0, 0);
        o[d0] = __builtin_amdgcn_mfma_f32_32x32x16_bf16(pa2, AT_PK(2), o[d0], 0, 0, 0);
        o[d0] = __builtin_amdgcn_mfma_f32_32x32x16_bf16(pa3, AT_PK(3), o[d0], 0, 0, 0);
#undef AT_PK
    }
}

typedef short v4i16_t __attribute__((ext_vector_type(4)));
__device__ __forceinline__ s16x4 vtr(const AT_LAS unsigned char* p) { return __builtin_bit_cast(s16x4, __builtin_amdgcn_ds_read_tr16_b64_v4i16((AT_LAS v4i16_t*)p)); }
__device__ __forceinline__ void pv2(f32x16* o, const AT_LAS unsigned char* vp, bf16x8 pa0, bf16x8 pa1, bf16x8 pa2, bf16x8 pa3) {
#pragma unroll
    for (int d0 = 0; d0 < 2; ++d0) { s16x4 lo[4], hi[4];
#pragma unroll
        for (int ks = 0; ks < 4; ++ks) { lo[ks] = vtr(vp + d0 * 4096 + ks * 1024); hi[ks] = vtr(vp + d0 * 4096 + ks * 1024 + 512); }
#define AT_PK(k) (bf16x8){lo[k][0], lo[k][1], lo[k][2], lo[k][3], hi[k][0], hi[k][1], hi[k][2], hi[k][3]}
        o[d0] = __builtin_amdgcn_mfma_f32_32x32x16_bf16(pa0, AT_PK(0), o[d0], 0, 0, 0);
        o[d0] = __builtin_amdgcn_mfma_f32_32x32x16_bf16(pa1, AT_PK(1), o[d0], 0, 0, 0);
        o[d0] = __builtin_amdgcn_mfma_f32_32x32x16_bf16(pa2, AT_PK(2), o[d0], 0, 0, 0);
        o[d0] = __builtin_amdgcn_mfma_f32_32x32x16_bf16(pa3, AT_PK(3), o[d0], 0, 0, 0);
#undef AT_PK
    }
}

template <int DQ, bool MOBA, bool QNORM, int G>
__device__ __forceinline__ void attn_unit(AT_LAS unsigned char* lds, const Tensors& T, long rowbase, int qb, const float* km, const float* qg, const float* tab) {
    constexpr int NKP = DQ / 8, NP = NKP + 8, SLOTB = NKP * 1024 + 8192, ND0 = DQ / 16;
    constexpr int NSLOT = 3 * G, LDS_WS = NSLOT * SLOTB, LDS_OST = 0;
    int tid_ = threadIdx.x; asm volatile("" : "+v"(tid_));
    const int tid = tid_, lane = tid & 63, r32 = lane & 31, hi = lane >> 5; const int wid = __builtin_amdgcn_readfirstlane(tid >> 6);
    const int q0 = qb * 256, NT = 4 * (qb + 1);
    const unsigned lds0 = (unsigned)(size_t)lds;
    AT_LAS float* wsf = (AT_LAS float*)(lds + LDS_WS) + wid * 64;
    asm volatile("s_waitcnt vmcnt(0)" ::: "memory");
    const unsigned short* src[3]; unsigned dsto[3];
#pragma unroll
    for (int k = 0; k < 3; ++k) { const int pi = wid + 8 * k;
        if (pi < NKP) { src[k] = (T.pk == 0) ? T.K + pi * 512 + lane * 8 : T.K + (rowbase + lane) * T.pk + 8 * pi; dsto[k] = pi * 1024; }
        else { const int v = pi - NKP; src[k] = (T.pv == 0) ? T.V + v * 512 + lane * 8 : T.V + (rowbase + 16 * (v & 3) + (lane >> 2)) * T.pv + 32 * (v >> 2) + 8 * (lane & 3); dsto[k] = NKP * 1024 + v * 1024; } }
    const long kstep = (T.pk == 0) ? (long)NKP * 512 : (long)64 * T.pk, vstep = (T.pv == 0) ? (long)4096 : (long)64 * T.pv;
#define AT_DMA(t, slot) do { _Pragma("unroll") for (int k_ = 0; k_ < 3; ++k_) { const int pi_ = wid + 8 * k_; if (pi_ < NP) { \
        const unsigned short* s_ = src[k_] + (long)(t) * ((pi_ < NKP) ? kstep : vstep); glds16(s_, (unsigned)__builtin_amdgcn_readfirstlane(lds0 + (slot) * SLOTB + dsto[k_])); } } } while (0)
    _Pragma("unroll") for (int i_ = 0; i_ < G; ++i_) AT_DMA(i_, i_);
    __builtin_amdgcn_sched_barrier(0);
    bf16x8 qr[ND0];
    { const unsigned short* Qw = T.Q + (rowbase + q0 + wid * 32 + r32) * T.pq + hi * 8;
#pragma unroll
      for (int d0 = 0; d0 < ND0; ++d0) qr[d0] = *(const bf16x8*)(Qw + d0 * 16); }
    __builtin_amdgcn_sched_barrier(0);
    if constexpr (QNORM) {
        float s = 0.f;
#pragma unroll
        for (int d0 = 0; d0 < ND0; ++d0)
#pragma unroll
            for (int j = 0; j < 8; ++j) { const float x = bf2f((unsigned short)qr[d0][j]); s += x * x; }
        s = swap_sum(s);
        const float rstd = 0.14724445073472677f / sqrtf(s * (1.f / 96.f) + 1e-6f);
#pragma unroll
        for (int d0 = 0; d0 < 4; ++d0) { const f32x4 g0 = *(const f32x4*)(qg + d0 * 16 + hi * 8), g1 = *(const f32x4*)(qg + d0 * 16 + hi * 8 + 4); u32x4 w;
            w.x = cvtpk(bf2f((unsigned short)qr[d0][0]) * rstd * g0.x, bf2f((unsigned short)qr[d0][1]) * rstd * g0.y); w.y = cvtpk(bf2f((unsigned short)qr[d0][2]) * rstd * g0.z, bf2f((unsigned short)qr[d0][3]) * rstd * g0.w);
            w.z = cvtpk(bf2f((unsigned short)qr[d0][4]) * rstd * g1.x, bf2f((unsigned short)qr[d0][5]) * rstd * g1.y); w.w = cvtpk(bf2f((unsigned short)qr[d0][6]) * rstd * g1.z, bf2f((unsigned short)qr[d0][7]) * rstd * g1.w);
            qr[d0] = __builtin_bit_cast(bf16x8, w); asm volatile("" : "+v"(qr[d0])); }
        { const int pos = q0 + wid * 32 + r32; const float* tb = tab + (pos * 16 + hi * 8) * 2; const float* ga = qg + 64 + hi * 8; const float* gb = qg + 80 + hi * 8; float oa[8], ob[8];
#pragma unroll
          for (int j = 0; j < 8; ++j) { const float x1 = bf2f((unsigned short)qr[4][j]) * rstd * ga[j], x2 = bf2f((unsigned short)qr[5][j]) * rstd * gb[j]; const float c = tb[2 * j], sn = tb[2 * j + 1]; oa[j] = x1 * c - x2 * sn; ob[j] = x1 * sn + x2 * c; }
          u32x4 w; w.x = cvtpk(oa[0], oa[1]); w.y = cvtpk(oa[2], oa[3]); w.z = cvtpk(oa[4], oa[5]); w.w = cvtpk(oa[6], oa[7]); qr[4] = __builtin_bit_cast(bf16x8, w);
          w.x = cvtpk(ob[0], ob[1]); w.y = cvtpk(ob[2], ob[3]); w.z = cvtpk(ob[4], ob[5]); w.w = cvtpk(ob[6], ob[7]); qr[5] = __builtin_bit_cast(bf16x8, w); }
    }
    __builtin_amdgcn_sched_barrier(0);
    unsigned sel = 0xffffffffu;
    if (MOBA) {
        sel = 0u; float gate[8];
#pragma unroll
        for (int j = 0; j < 7; ++j) { float a = 0.f;
            if (j < qb) { const float* kj = km + j * 512 + hi * 8;
#pragma unroll
                for (int d0 = 0; d0 < ND0; ++d0) { const f32x4 k0 = *(const f32x4*)(kj + d0 * 16), k1 = *(const f32x4*)(kj + d0 * 16 + 4);
                    a += bf2f((unsigned short)qr[d0][0]) * k0.x + bf2f((unsigned short)qr[d0][1]) * k0.y + bf2f((unsigned short)qr[d0][2]) * k0.z + bf2f((unsigned short)qr[d0][3]) * k0.w
                       + bf2f((unsigned short)qr[d0][4]) * k1.x + bf2f((unsigned short)qr[d0][5]) * k1.y + bf2f((unsigned short)qr[d0][6]) * k1.z + bf2f((unsigned short)qr[d0][7]) * k1.w; } }
            a = swap_sum(a); gate[j] = (j < qb) ? a : -INFINITY; }
        gate[7] = -INFINITY;
#pragma unroll
        for (int r = 0; r < 3; ++r) { int best = -1; float bv = -INFINITY;
#pragma unroll
            for (int j = 0; j < 8; ++j) if (!((sel >> j) & 1u) && gate[j] > bv) { bv = gate[j]; best = j; }
            if (best >= 0) sel |= 1u << best; }
    }
    __builtin_amdgcn_sched_barrier(0);
    float mhat = 0.f, l = 0.f; f32x16 o[2]; o[0] = f32x16{}; o[1] = f32x16{};
    const int qrel = wid * 32 + r32;
    const int vbl = ((lane >> 4) & 1) * 32 + (lane & 3) * 8 + (4 * hi + ((lane & 15) >> 2)) * 64;
#define AT_GROUP(u) do { asm volatile("s_waitcnt vmcnt(0) lgkmcnt(0)\n\ts_barrier" ::: "memory"); \
        if ((u) + G < NT) { _Pragma("unroll") for (int i_ = 0; i_ < G; ++i_) { const int tt_ = (u) + G + i_; AT_DMA(tt_, tt_ % NSLOT); } } } while (0)
#define AT_KLOAD(sl) do { const AT_LAS unsigned char* kb = lds + (sl) * SLOTB + hi * 1024 + r32 * 16; \
        _Pragma("unroll") for (int d0 = 0; d0 < ND0; ++d0) { kf[2 * d0] = *(const AT_LAS bf16x8*)(kb + d0 * 2048); kf[2 * d0 + 1] = *(const AT_LAS bf16x8*)(kb + d0 * 2048 + 512); } } while (0)
    bf16x8 kf[2 * ND0]; s16x4 vlo[8], vhi[8];
    AT_GROUP(0);
    AT_KLOAD(0);
    int slot = 0;
    for (int t = 0; t < NT; ++t) {
        __builtin_amdgcn_sched_barrier(0);
        { const AT_LAS unsigned char* vp = lds + slot * SLOTB + NKP * 1024 + vbl;
#pragma unroll
          for (int i = 0; i < 8; ++i) { vlo[i] = vtr(vp + (i >> 2) * 4096 + (i & 3) * 1024); vhi[i] = vtr(vp + (i >> 2) * 4096 + (i & 3) * 1024 + 512); } }
        __builtin_amdgcn_sched_barrier(0);
        f32x16 p0, p1;
#pragma unroll
        for (int d0 = 0; d0 < ND0; ++d0) {
            if (d0 == 0) { p0 = __builtin_amdgcn_mfma_f32_32x32x16_bf16(kf[0], qr[0], f32x16{}, 0, 0, 0); p1 = __builtin_amdgcn_mfma_f32_32x32x16_bf16(kf[1], qr[0], f32x16{}, 0, 0, 0); }
            else { p0 = __builtin_amdgcn_mfma_f32_32x32x16_bf16(kf[2 * d0], qr[d0], p0, 0, 0, 0); p1 = __builtin_amdgcn_mfma_f32_32x32x16_bf16(kf[2 * d0 + 1], qr[d0], p1, 0, 0, 0); } }
        __builtin_amdgcn_sched_barrier(0);
        const int nslot = (slot == NSLOT - 1) ? 0 : slot + 1;
        if (t + 1 < NT) { if (((t + 1) % G) == 0) AT_GROUP(t + 1); AT_KLOAD(nslot); }
        __builtin_amdgcn_sched_barrier(0);
        const int jb = t - (NT - 4);
        if (jb >= 0) { const int kb0 = 64 * jb + 4 * hi;
#pragma unroll
            for (int r = 0; r < 16; ++r) { const int kv = kb0 + (r & 3) + 8 * (r >> 2); if (kv > qrel) p0[r] = NEGM; if (kv + 32 > qrel) p1[r] = NEGM; } }
        else if (MOBA) { const bool keep = ((sel >> (t >> 2)) & 1u) != 0u;
            if (!__all(keep)) { if (!keep) {
#pragma unroll
                for (int r = 0; r < 16; ++r) { p0[r] = NEGM; p1[r] = NEGM; } } } }
        float rm;
        { float a_ = fmaxf(fmaxf(p0[0], p0[1]), p1[0]), b_ = fmaxf(fmaxf(p0[2], p0[3]), p1[1]); a_ = fmaxf(fmaxf(a_, p1[2]), p1[3]);
#pragma unroll
          for (int r = 4; r < 16; r += 4) { a_ = fmaxf(fmaxf(a_, p0[r]), p0[r + 1]); b_ = fmaxf(fmaxf(b_, p0[r + 2]), p0[r + 3]); a_ = fmaxf(fmaxf(a_, p1[r]), p1[r + 1]); b_ = fmaxf(fmaxf(b_, p1[r + 2]), p1[r + 3]); }
          rm = swap_max(fmaxf(a_, b_)) - mhat; }
        if (__any(rm > THR)) {
            const float dl = fmaxf(rm, 0.f); mhat += dl;
            const float alpha = __builtin_amdgcn_exp2f(-dl); l *= alpha;
            if (hi == 0) wsf[r32] = alpha;
            asm volatile("s_waitcnt lgkmcnt(0)" ::: "memory");
#pragma unroll
            for (int r = 0; r < 16; ++r) { const float f = wsf[crow(r, hi)]; o[0][r] *= f; o[1][r] *= f; }
        }
        float sacc = 0.f;
#pragma unroll
        for (int r = 0; r < 16; ++r) { p0[r] = __builtin_amdgcn_exp2f(p0[r] - mhat); p1[r] = __builtin_amdgcn_exp2f(p1[r] - mhat); sacc += p0[r] + p1[r]; }
        l += sacc;
        u32x4 pw[4];
        pw[0] = (u32x4){cvtpk(p0[0], p0[1]), cvtpk(p0[2], p0[3]), cvtpk(p0[4], p0[5]), cvtpk(p0[6], p0[7])};
        pw[1] = (u32x4){cvtpk(p0[8], p0[9]), cvtpk(p0[10], p0[11]), cvtpk(p0[12], p0[13]), cvtpk(p0[14], p0[15])};
        pw[2] = (u32x4){cvtpk(p1[0], p1[1]), cvtpk(p1[2], p1[3]), cvtpk(p1[4], p1[5]), cvtpk(p1[6], p1[7])};
        pw[3] = (u32x4){cvtpk(p1[8], p1[9]), cvtpk(p1[10], p1[11]), cvtpk(p1[12], p1[13]), cvtpk(p1[14], p1[15])};
        __builtin_amdgcn_sched_barrier(0);
#pragma unroll
        for (int d0 = 0; d0 < 2; ++d0)
#pragma unroll
            for (int ks = 0; ks < 4; ++ks) { const int i = d0 * 4 + ks;
                o[d0] = __builtin_amdgcn_mfma_f32_32x32x16_bf16(__builtin_bit_cast(bf16x8, pw[ks]), (bf16x8){vlo[i][0], vlo[i][1], vlo[i][2], vlo[i][3], vhi[i][0], vhi[i][1], vhi[i][2], vhi[i][3]}, o[d0], 0, 0, 0); }
        slot = nslot;
    }
#undef AT_GROUP
#undef AT_KLOAD
#undef AT_DMA
    asm volatile("s_waitcnt lgkmcnt(0)\n\ts_barrier" ::: "memory");
    l = swap_sum(l);
    if (hi == 0) wsf[32 + r32] = l;
    asm volatile("s_waitcnt lgkmcnt(0)" ::: "memory");
    float rli[16];
#pragma unroll
    for (int r = 0; r < 16; ++r) rli[r] = __builtin_amdgcn_rcpf(wsf[32 + crow(r, hi)]);
    unsigned short* Ow = T.O + (rowbase + q0 + wid * 32) * T.po;
    { AT_LAS unsigned short* stg = (AT_LAS unsigned short*)(lds + LDS_OST) + wid * 2048;
#pragma unroll
      for (int r = 0; r < 16; ++r) { const int orow = crow(r, hi);
#pragma unroll
          for (int d0 = 0; d0 < 2; ++d0) stg[orow * 64 + d0 * 32 + r32] = (unsigned short)f2bf(o[d0][r] * rli[r]); }
      asm volatile("s_waitcnt lgkmcnt(0)" ::: "memory");
#pragma unroll
      for (int i = 0; i < 4; ++i) { const int row = i * 8 + (lane >> 3), ch = lane & 7; const u32x4 v = *(const AT_LAS u32x4*)(stg + row * 64 + ch * 8); *(u32x4*)(Ow + (long)row * T.po + ch * 8) = v; } }
    asm volatile("s_waitcnt lgkmcnt(0)\n\ts_barrier" ::: "memory");
}
template <int DQ, bool MOBA, bool QNORM, int G>
__device__ __forceinline__ void attn_unit_p(AT_LAS unsigned char* lds, const Tensors& T, long rowbase, int qb, const float* km, const float* qg, const float* tab, float kbound, int tbase, bool prefetched, bool has_next) {
    constexpr int NKP = DQ / 8, NP = NKP + 8, SLOTB = NKP * 1024 + 8192, ND0 = DQ / 16;
    constexpr int NSLOT = 3 * G, LDS_WS = NSLOT * SLOTB, LDS_OST = LDS_WS + 2048;
    int tid_ = threadIdx.x; asm volatile("" : "+v"(tid_));
    const int tid = tid_, lane = tid & 63, r32 = lane & 31, hi = lane >> 5; const int wid = __builtin_amdgcn_readfirstlane(tid >> 6);
    const int q0 = qb * 256, NT = 4 * (qb + 1);
    const unsigned lds0 = (unsigned)(size_t)lds;
    AT_LAS float* wsf = (AT_LAS float*)(lds + LDS_WS) + wid * 64;
    asm volatile("s_waitcnt vmcnt(0)" ::: "memory");
    unsigned soff[3], dsto[3];
#pragma unroll
    for (int k = 0; k < 3; ++k) { const int pi = wid + 8 * k;
        if (pi < NKP) { soff[k] = (T.pk == 0) ? (unsigned)(pi * 512 + lane * 8) : (unsigned)((rowbase + lane) * T.pk + 8 * pi); dsto[k] = pi * 1024; }
        else { const int v = pi - NKP; soff[k] = (T.pv == 0) ? (unsigned)(v * 512 + lane * 8) : (unsigned)((rowbase + 16 * (v & 3) + (lane >> 2)) * T.pv + 32 * (v >> 2) + 8 * (lane & 3)); dsto[k] = NKP * 1024 + v * 1024; } }
    const unsigned kstep = (T.pk == 0) ? (unsigned)NKP * 512u : 64u * (unsigned)T.pk, vstep = (T.pv == 0) ? 4096u : 64u * (unsigned)T.pv;
#define AT_DMA(t, slot) do { _Pragma("unroll") for (int k_ = 0; k_ < 3; ++k_) { const int pi_ = wid + 8 * k_; if (pi_ < NP) { \
        const unsigned short* s_ = ((pi_ < NKP) ? T.K : T.V) + (size_t)(soff[k_] + (unsigned)(t) * ((pi_ < NKP) ? kstep : vstep)); glds16(s_, (unsigned)__builtin_amdgcn_readfirstlane(lds0 + (slot) * SLOTB + dsto[k_])); } } } while (0)
    if (!prefetched) { _Pragma("unroll") for (int i_ = 0; i_ < G; ++i_) AT_DMA(i_, (tbase + i_) % NSLOT); }
    __builtin_amdgcn_sched_barrier(0);
    bf16x8 qr[ND0];
    { const unsigned short* Qw = T.Q + (rowbase + q0 + wid * 32 + r32) * T.pq + hi * 8;
#pragma unroll
      for (int d0 = 0; d0 < ND0; ++d0) qr[d0] = *(const bf16x8*)(Qw + d0 * 16); }
    __builtin_amdgcn_sched_barrier(0);
    if constexpr (QNORM) {
        float s = 0.f;
#pragma unroll
        for (int d0 = 0; d0 < ND0; ++d0)
#pragma unroll
            for (int j = 0; j < 8; ++j) { const float x = bf2f((unsigned short)qr[d0][j]); s += x * x; }
        s = swap_sum(s);
        const float rstd = 0.14724445073472677f / sqrtf(s * (1.f / 96.f) + 1e-6f);
#pragma unroll
        for (int d0 = 0; d0 < 4; ++d0) { const f32x4 g0 = *(const f32x4*)(qg + d0 * 16 + hi * 8), g1 = *(const f32x4*)(qg + d0 * 16 + hi * 8 + 4); u32x4 w;
            w.x = cvtpk(bf2f((unsigned short)qr[d0][0]) * rstd * g0.x, bf2f((unsigned short)qr[d0][1]) * rstd * g0.y); w.y = cvtpk(bf2f((unsigned short)qr[d0][2]) * rstd * g0.z, bf2f((unsigned short)qr[d0][3]) * rstd * g0.w);
            w.z = cvtpk(bf2f((unsigned short)qr[d0][4]) * rstd * g1.x, bf2f((unsigned short)qr[d0][5]) * rstd * g1.y); w.w = cvtpk(bf2f((unsigned short)qr[d0][6]) * rstd * g1.z, bf2f((unsigned short)qr[d0][7]) * rstd * g1.w);
            qr[d0] = __builtin_bit_cast(bf16x8, w); asm volatile("" : "+v"(qr[d0])); }
        { const int pos = q0 + wid * 32 + r32; const float* tb = tab + (pos * 16 + hi * 8) * 2; const float* ga = qg + 64 + hi * 8; const float* gb = qg + 80 + hi * 8; float oa[8], ob[8];
#pragma unroll
          for (int j = 0; j < 8; ++j) { const float x1 = bf2f((unsigned short)qr[4][j]) * rstd * ga[j], x2 = bf2f((unsigned short)qr[5][j]) * rstd * gb[j]; const float c = tb[2 * j], sn = tb[2 * j + 1]; oa[j] = x1 * c - x2 * sn; ob[j] = x1 * sn + x2 * c; }
          u32x4 w; w.x = cvtpk(oa[0], oa[1]); w.y = cvtpk(oa[2], oa[3]); w.z = cvtpk(oa[4], oa[5]); w.w = cvtpk(oa[6], oa[7]); qr[4] = __builtin_bit_cast(bf16x8, w);
          w.x = cvtpk(ob[0], ob[1]); w.y = cvtpk(ob[2], ob[3]); w.z = cvtpk(ob[4], ob[5]); w.w = cvtpk(ob[6], ob[7]); qr[5] = __builtin_bit_cast(bf16x8, w); }
    }
    __builtin_amdgcn_sched_barrier(0);
    unsigned sel = 0xffffffffu;
    if (MOBA) {
        sel = 0u; float gate[8];
#pragma unroll
        for (int j = 0; j < 7; ++j) { float a = 0.f;
            if (j < qb) { const float* kj = km + j * 512 + hi * 8;
#pragma unroll
                for (int d0 = 0; d0 < ND0; ++d0) { const f32x4 k0 = *(const f32x4*)(kj + d0 * 16), k1 = *(const f32x4*)(kj + d0 * 16 + 4);
                    a += bf2f((unsigned short)qr[d0][0]) * k0.x + bf2f((unsigned short)qr[d0][1]) * k0.y + bf2f((unsigned short)qr[d0][2]) * k0.z + bf2f((unsigned short)qr[d0][3]) * k0.w
                       + bf2f((unsigned short)qr[d0][4]) * k1.x + bf2f((unsigned short)qr[d0][5]) * k1.y + bf2f((unsigned short)qr[d0][6]) * k1.z + bf2f((unsigned short)qr[d0][7]) * k1.w; } }
            a = swap_sum(a); gate[j] = (j < qb) ? a : -INFINITY; }
        gate[7] = -INFINITY;
#pragma unroll
        for (int r = 0; r < 3; ++r) { int best = -1; float bv = -INFINITY;
#pragma unroll
            for (int j = 0; j < 8; ++j) if (!((sel >> j) & 1u) && gate[j] > bv) { bv = gate[j]; best = j; }
            if (best >= 0) sel |= 1u << best; }
    }
    __builtin_amdgcn_sched_barrier(0);
    float l = 0.f; f32x16 o[2]; o[0] = f32x16{}; o[1] = f32x16{};
    f32x16 negm;
    { float qss = 0.f;
#pragma unroll
      for (int d0 = 0; d0 < ND0; ++d0)
#pragma unroll
          for (int j = 0; j < 8; ++j) { const float x = bf2f((unsigned short)qr[d0][j]); qss += x * x; }
      qss = swap_sum(qss); const float mrow = sqrtf(qss) * kbound;
#pragma unroll
      for (int r = 0; r < 16; ++r) negm[r] = -mrow;
      asm volatile("" : "+v"(negm)); }

    const int qrel = wid * 32 + r32;
    const int vbl = ((lane >> 4) & 1) * 32 + (lane & 3) * 8 + (4 * hi + ((lane & 15) >> 2)) * 64;
#define AT_GROUP(u) do { asm volatile("s_waitcnt vmcnt(0) lgkmcnt(0)\n\ts_barrier" ::: "memory"); \
        if ((u) + G < NT) { _Pragma("unroll") for (int i_ = 0; i_ < G; ++i_) { const int tt_ = (u) + G + i_; AT_DMA(tt_, (tbase + tt_) % NSLOT); } } \
        else if (has_next) { _Pragma("unroll") for (int i_ = 0; i_ < G; ++i_) AT_DMA(i_, (tbase + NT + i_) % NSLOT); } } while (0)
#define AT_KLOAD(sl) do { const AT_LAS unsigned char* kb = lds + (sl) * SLOTB + hi * 1024 + r32 * 16; \
        _Pragma("unroll") for (int d0 = 0; d0 < ND0; ++d0) { kf[2 * d0] = *(const AT_LAS bf16x8*)(kb + d0 * 2048); kf[2 * d0 + 1] = *(const AT_LAS bf16x8*)(kb + d0 * 2048 + 512); } } while (0)
#define AT_VLOAD(sl) do { const AT_LAS unsigned char* vp = lds + (sl) * SLOTB + NKP * 1024 + vbl; \
        _Pragma("unroll") for (int i = 0; i < 8; ++i) { vlo[i] = vtr(vp + (i >> 2) * 4096 + (i & 3) * 1024); vhi[i] = vtr(vp + (i >> 2) * 4096 + (i & 3) * 1024 + 512); } } while (0)
#define AT_SUMPACK() do { float sacc = 0.f; \
        _Pragma("unroll") for (int r = 0; r < 16; ++r) sacc += c0[r] + c1[r]; \
        l += sacc; \
        pw[0] = (u32x4){cvtpk(c0[0], c0[1]), cvtpk(c0[2], c0[3]), cvtpk(c0[4], c0[5]), cvtpk(c0[6], c0[7])}; \
        pw[1] = (u32x4){cvtpk(c0[8], c0[9]), cvtpk(c0[10], c0[11]), cvtpk(c0[12], c0[13]), cvtpk(c0[14], c0[15])}; \
        pw[2] = (u32x4){cvtpk(c1[0], c1[1]), cvtpk(c1[2], c1[3]), cvtpk(c1[4], c1[5]), cvtpk(c1[6], c1[7])}; \
        pw[3] = (u32x4){cvtpk(c1[8], c1[9]), cvtpk(c1[10], c1[11]), cvtpk(c1[12], c1[13]), cvtpk(c1[14], c1[15])}; } while (0)
#define AT_QKT(N0, N1) do { _Pragma("unroll") for (int d0 = 0; d0 < ND0; ++d0) { \
            if (d0 == 0) { N0 = __builtin_amdgcn_mfma_f32_32x32x16_bf16(kf[0], qr[0], negm, 0, 0, 0); N1 = __builtin_amdgcn_mfma_f32_32x32x16_bf16(kf[1], qr[0], negm, 0, 0, 0); } \
            else { N0 = __builtin_amdgcn_mfma_f32_32x32x16_bf16(kf[2 * d0], qr[d0], N0, 0, 0, 0); N1 = __builtin_amdgcn_mfma_f32_32x32x16_bf16(kf[2 * d0 + 1], qr[d0], N1, 0, 0, 0); } } } while (0)
#define AT_DECIDE(tt) do { \
        { const int jb = (tt) - (NT - 4); \
          if (jb >= 0) { const int kb0 = 64 * jb + 4 * hi; \
              _Pragma("unroll") for (int r = 0; r < 16; ++r) { const int kv = kb0 + (r & 3) + 8 * (r >> 2); if (kv > qrel) c0[r] = NEGM; if (kv + 32 > qrel) c1[r] = NEGM; } } \
          else if (MOBA) { const bool keep = ((sel >> ((tt) >> 2)) & 1u) != 0u; \
              if (!__all(keep)) { if (!keep) { _Pragma("unroll") for (int r = 0; r < 16; ++r) { c0[r] = NEGM; c1[r] = NEGM; } } } } } \
        if ((tt) + 1 < NT && (((tt) + 1) % G) == 0) AT_GROUP((tt) + 1); } while (0)
#define AT_EXPS() do { _Pragma("unroll") for (int r = 0; r < 16; ++r) { c0[r] = __builtin_amdgcn_exp2f(c0[r]); c1[r] = __builtin_amdgcn_exp2f(c1[r]); } } while (0)
#define AT_PV() do { _Pragma("unroll") for (int d0 = 0; d0 < 2; ++d0) _Pragma("unroll") for (int ks = 0; ks < 4; ++ks) { const int i = d0 * 4 + ks; \
            o[d0] = __builtin_amdgcn_mfma_f32_32x32x16_bf16(__builtin_bit_cast(bf16x8, pw[ks]), (bf16x8){vlo[i][0], vlo[i][1], vlo[i][2], vlo[i][3], vhi[i][0], vhi[i][1], vhi[i][2], vhi[i][3]}, o[d0], 0, 0, 0); } } while (0)
#define AT_SGB(mask, n) __builtin_amdgcn_sched_group_barrier(mask, n, 0)
    constexpr int NG = 2 * ND0;
    bf16x8 kf[2 * ND0]; s16x4 vlo[8], vhi[8]; u32x4 pw[4]; f32x16 c0, c1;
    AT_GROUP(0);
    AT_KLOAD(tbase % NSLOT);
    AT_QKT(c0, c1);
    AT_DECIDE(0);
    AT_KLOAD((tbase + 1) % NSLOT);
    AT_EXPS();
    int slot = (tbase + 1) % NSLOT, pslot = tbase % NSLOT;
    for (int t = 1; t < NT; ++t) {
        const int nslot = (t + 1 < NT) ? ((slot == NSLOT - 1) ? 0 : slot + 1) : slot;
        __builtin_amdgcn_sched_barrier(0);
        { f32x16 n0, n1; float sacc = 0.f;
          const AT_LAS unsigned char* vp = lds + pslot * SLOTB + NKP * 1024 + vbl;
#pragma unroll
          for (int i = 0; i < NG; ++i) {
              if (i >= NG - 2) { const int vi = i - (NG - 2); vlo[vi] = vtr(vp + (vi >> 2) * 4096 + (vi & 3) * 1024); vhi[vi] = vtr(vp + (vi >> 2) * 4096 + (vi & 3) * 1024 + 512); }
              const int d0 = i >> 1;
              if (i & 1) n1 = (d0 == 0) ? __builtin_amdgcn_mfma_f32_32x32x16_bf16(kf[i], qr[d0], negm, 0, 0, 0) : __builtin_amdgcn_mfma_f32_32x32x16_bf16(kf[i], qr[d0], n1, 0, 0, 0);
              else n0 = (d0 == 0) ? __builtin_amdgcn_mfma_f32_32x32x16_bf16(kf[i], qr[d0], negm, 0, 0, 0) : __builtin_amdgcn_mfma_f32_32x32x16_bf16(kf[i], qr[d0], n0, 0, 0, 0);
#pragma unroll
              for (int rr = (i * 32) / NG; rr < ((i + 1) * 32) / NG; ++rr) sacc += (rr < 16) ? c0[rr] : c1[rr - 16];
#pragma unroll
              for (int ww = (i * 16) / NG; ww < ((i + 1) * 16) / NG; ++ww) { const int e = 2 * ww; pw[ww >> 2][ww & 3] = (e < 16) ? cvtpk(c0[e], c0[e + 1]) : cvtpk(c1[e - 16], c1[e - 15]); }
              __builtin_amdgcn_sched_barrier(0); }
          l += sacc; c0 = n0; c1 = n1; }
        AT_DECIDE(t);
        __builtin_amdgcn_sched_barrier(0);
        { const AT_LAS unsigned char* kb = lds + nslot * SLOTB + hi * 1024 + r32 * 16; const AT_LAS unsigned char* vpB = lds + pslot * SLOTB + NKP * 1024 + vbl;
#pragma unroll
          for (int i = 0; i < 8; ++i) {
              if (i + 2 < 8) { const int vi = i + 2; vlo[vi] = vtr(vpB + (vi >> 2) * 4096 + (vi & 3) * 1024); vhi[vi] = vtr(vpB + (vi >> 2) * 4096 + (vi & 3) * 1024 + 512); }
              if (i >= 2 && i < 6) {
#pragma unroll
                  for (int q = (i - 2) * NG / 4; q < (i - 1) * NG / 4; ++q) kf[q] = *(const AT_LAS bf16x8*)(kb + (q >> 1) * 2048 + (q & 1) * 512); }
              o[i >> 2] = __builtin_amdgcn_mfma_f32_32x32x16_bf16(__builtin_bit_cast(bf16x8, pw[i & 3]), (bf16x8){vlo[i][0], vlo[i][1], vlo[i][2], vlo[i][3], vhi[i][0], vhi[i][1], vhi[i][2], vhi[i][3]}, o[i >> 2], 0, 0, 0);
#pragma unroll
              for (int rr = 4 * i; rr < 4 * i + 4; ++rr) { if (rr < 16) c0[rr] = __builtin_amdgcn_exp2f(c0[rr]); else c1[rr - 16] = __builtin_amdgcn_exp2f(c1[rr - 16]); }
              __builtin_amdgcn_sched_barrier(0); } }
        pslot = slot; slot = nslot;
    }
    AT_VLOAD(pslot);
    AT_SUMPACK();
    AT_PV();
#undef AT_GROUP
#undef AT_KLOAD
#undef AT_VLOAD
#undef AT_SUMPACK
#undef AT_QKT
#undef AT_DECIDE
#undef AT_EXPS
#undef AT_PV
#undef AT_SGB
#undef AT_DMA
    asm volatile("s_waitcnt lgkmcnt(0)\n\ts_barrier" ::: "memory");
    l = swap_sum(l);
    if (hi == 0) wsf[32 + r32] = l;
    asm volatile("s_waitcnt lgkmcnt(0)" ::: "memory");
    float rli[16];
#pragma unroll
    for (int r = 0; r < 16; ++r) rli[r] = __builtin_amdgcn_rcpf(wsf[32 + crow(r, hi)]);
    unsigned short* Ow = T.O + (rowbase + q0 + wid * 32) * T.po;
    { AT_LAS unsigned short* stg = (AT_LAS unsigned short*)(lds + LDS_OST) + wid * 2048;
#pragma unroll
      for (int r = 0; r < 16; ++r) { const int orow = crow(r, hi);
#pragma unroll
          for (int d0 = 0; d0 < 2; ++d0) stg[orow * 64 + d0 * 32 + r32] = (unsigned short)f2bf(o[d0][r] * rli[r]); }
      asm volatile("s_waitcnt lgkmcnt(0)" ::: "memory");
#pragma unroll
      for (int i = 0; i < 4; ++i) { const int row = i * 8 + (lane >> 3), ch = lane & 7; const u32x4 v = *(const AT_LAS u32x4*)(stg + row * 64 + ch * 8); *(u32x4*)(Ow + (long)row * T.po + ch * 8) = v; } }
    asm volatile("s_waitcnt lgkmcnt(0)\n\ts_barrier" ::: "memory");
}
#undef AT_LAS
}

namespace ssd {
typedef short bf16x8 __attribute__((ext_vector_type(8)));
typedef short v4i16_t __attribute__((ext_vector_type(4)));
typedef float f32x16 __attribute__((ext_vector_type(16)));
typedef unsigned u32x4 __attribute__((ext_vector_type(4)));
#define SS_LAS __attribute__((address_space(3)))
__device__ __forceinline__ int crow(int r, int hi) { return (r & 3) + 8 * (r >> 2) + 4 * hi; }
__device__ __forceinline__ v4i16_t vtr(const SS_LAS unsigned char* p) { return __builtin_amdgcn_ds_read_tr16_b64_v4i16((SS_LAS v4i16_t*)p); }
__device__ __forceinline__ bf16x8 tr_frag(const SS_LAS unsigned char* img, int pitch, int k0, int c0, int lane) {
    const int g4 = lane >> 4, q = (lane & 15) >> 2, p4 = lane & 3;
    const SS_LAS unsigned char* a = img + (k0 + 8 * (g4 >> 1) + q) * pitch + (c0 + 16 * (g4 & 1) + 4 * p4) * 2;
    const v4i16_t lo = vtr(a), hi4 = vtr(a + 4 * pitch);
    return (bf16x8){lo[0], lo[1], lo[2], lo[3], hi4[0], hi4[1], hi4[2], hi4[3]};
}
__device__ __forceinline__ bf16x8 row_frag(const SS_LAS unsigned char* img, int pitch, int r0, int k0, int lane) {
    return *(const SS_LAS bf16x8*)(img + (r0 + (lane & 31)) * pitch + (k0 + 8 * (lane >> 5)) * 2);
}

constexpr int PX4 = 576;
constexpr int PB_T = 320;
constexpr int PR = 272;
constexpr int PX1 = 192;

__device__ __forceinline__ void dt_cs(int t0, int g, const float* DTR, const float* dtb, const float* alog, SS_LAS float* csl, SS_LAS float* dtl, SS_LAS float* wtot, int tid, int lane, int wid) {
    const int l = tid >> 2, hh = tid & 3, h = 4 * g + hh;
    const float r = DTR[(size_t)(t0 + l) * 8 + h] + dtb[h]; const float ex = __expf(fminf(r, 20.f)); const float dt = (r > 20.f) ? r : ((ex < 0.01f) ? ex * (1.f - ex * (0.5f - ex * 0.33333333f)) : __logf(1.f + ex));
    float v = dt * (-expf(alog[h]));
#pragma unroll
    for (int off = 4; off < 64; off <<= 1) { const float t = __shfl_up(v, off); if (lane >= off) v += t; }
    if (lane >= 60) wtot[wid * 4 + hh] = v;
    __syncthreads();
    float base = 0.f;
    for (int w = 0; w < wid; ++w) base += wtot[w * 4 + hh];
    csl[tid] = v + base; dtl[tid] = dt;
    __syncthreads();
}
__device__ __forceinline__ void conv_load(u32x4 (&x)[19], const unsigned short* raw, int t0, int l0, int col) {
    const int pos0 = t0 & 2047;
#pragma unroll
    for (int i = 0; i < 19; ++i) { const int l = l0 - 3 + i; x[i] = (u32x4){0u, 0u, 0u, 0u}; if (pos0 + l >= 0) x[i] = *(const u32x4*)(raw + (size_t)(t0 + l) * 1024 + col); }
}
template <bool SCALED> __device__ __forceinline__ void conv_compute(const u32x4 (&x)[19], int l0, int col, const float* cw, const float* cb, SS_LAS unsigned char* img, int pitch, const SS_LAS float* sc) {
    float w[4][8], b[8];
#pragma unroll
    for (int k = 0; k < 4; ++k) { const f32x4 a = *(const f32x4*)(cw + k * 1024 + col), c = *(const f32x4*)(cw + k * 1024 + col + 4); w[k][0] = a.x; w[k][1] = a.y; w[k][2] = a.z; w[k][3] = a.w; w[k][4] = c.x; w[k][5] = c.y; w[k][6] = c.z; w[k][7] = c.w; }
    { const f32x4 a = *(const f32x4*)(cb + col), c = *(const f32x4*)(cb + col + 4); b[0] = a.x; b[1] = a.y; b[2] = a.z; b[3] = a.w; b[4] = c.x; b[5] = c.y; b[6] = c.z; b[7] = c.w; }
#pragma unroll
    for (int i = 0; i < 16; ++i) { const int l = l0 + i; float o[8]; const float s = SCALED ? sc[l * 4] : 1.f;
#pragma unroll
        for (int j = 0; j < 8; ++j) { float a = b[j];
#pragma unroll
            for (int k = 0; k < 4; ++k) { const unsigned wd = (j < 2) ? x[i + k].x : (j < 4) ? x[i + k].y : (j < 6) ? x[i + k].z : x[i + k].w; a += w[k][j] * ((j & 1) ? bfhi(wd) : bflo(wd)); }
            o[j] = a * __builtin_amdgcn_rcpf(1.f + __expf(-a)) * s; }
        u32x4 p; p.x = pk2(o[0], o[1]); p.y = pk2(o[2], o[3]); p.z = pk2(o[4], o[5]); p.w = pk2(o[6], o[7]);
        *(SS_LAS u32x4*)(img + l * pitch) = p; }
}

__device__ __forceinline__ void states_unit(SS_LAS unsigned char* lds, int bc, int g, const unsigned short* XBC, const float* DTR, const float* cw, const float* cb, const float* dtb, const float* alog, float* ST, float* CEND) {
    int tid_ = threadIdx.x; asm volatile("" : "+v"(tid_));
    const int tid = tid_, lane = tid & 63, r32 = lane & 31, hi = lane >> 5; const int wid = __builtin_amdgcn_readfirstlane(tid >> 6);
    const int t0 = bc * 128;
    SS_LAS unsigned char* XD = lds; SS_LAS unsigned char* BI = lds + 128 * PX4;
    SS_LAS float* csl = (SS_LAS float*)(lds + 128 * PX4 + 128 * PB_T); SS_LAS float* dtl = csl + 512; SS_LAS float* wtot = dtl + 512; SS_LAS float* scl = wtot + 32;
    const int ch = tid % 48, l0 = (tid / 48) * 16; const int col = (ch < 32) ? g * 256 + ch * 8 : 512 + g * 128 + (ch - 32) * 8;
    u32x4 xr[19];
    if (tid < 384) conv_load(xr, XBC, t0, l0, col);
    dt_cs(t0, g, DTR, dtb, alog, csl, dtl, wtot, tid, lane, wid);
    scl[tid] = dtl[tid] * __expf(csl[508 + (tid & 3)] - csl[tid]);
    if (tid < 4) CEND[bc * 8 + g * 4 + tid] = csl[508 + tid];
    __syncthreads();
    if (tid < 384) {
        if (ch < 32) conv_compute<true>(xr, l0, col, cw, cb, XD + ch * 16, PX4, scl + (ch >> 3));
        else conv_compute<false>(xr, l0, col, cw, cb, BI + (ch - 32) * 16, PB_T, nullptr); }
    __syncthreads();
    const int pt = wid >> 2, nt = wid & 3;
#pragma unroll 1
    for (int hh = 0; hh < 4; ++hh) {
        f32x16 acc = f32x16{};
#pragma unroll
        for (int ks = 0; ks < 8; ++ks) {
            const bf16x8 a = tr_frag(XD, PX4, 16 * ks, hh * 64 + 32 * pt, lane);
            const bf16x8 b = tr_frag(BI, PB_T, 16 * ks, 32 * nt, lane);
            acc = __builtin_amdgcn_mfma_f32_32x32x16_bf16(a, b, acc, 0, 0, 0); }
        float* o = ST + (((size_t)(bc * 8 + g * 4 + hh) * 64 + 32 * pt) << 7) + 32 * nt + r32;
#pragma unroll
        for (int r = 0; r < 16; ++r) o[(size_t)crow(r, hi) << 7] = acc[r];
    }
    __syncthreads();
}

__device__ __forceinline__ void out_unit(SS_LAS unsigned char* lds, int bc, int g, const unsigned short* XBC, const unsigned short* VZ, const float* DTR, const float* cw, const float* cb, const float* dtb, const float* alog,
                                         const unsigned short* HIN, const float* Dsk, const float* gn, unsigned short* MIX) {
    int tid_ = threadIdx.x; asm volatile("" : "+v"(tid_));
    const int tid = tid_, lane = tid & 63, r32 = lane & 31, hi = lane >> 5; const int wid = __builtin_amdgcn_readfirstlane(tid >> 6);
    const int t0 = bc * 128;
    SS_LAS unsigned char* CI = lds; SS_LAS unsigned char* BI = lds + 128 * PR; SS_LAS unsigned char* XS = lds + 2 * 128 * PR;
    SS_LAS float* csl = (SS_LAS float*)(lds + 2 * 128 * PR + 128 * PX4); SS_LAS float* dtl = csl + 512; SS_LAS float* wtot = dtl + 512;
    const int ch = tid & 63, l0 = (tid >> 6) * 16; const int col = (ch < 32) ? g * 256 + ch * 8 : (ch < 48) ? 512 + g * 128 + (ch - 32) * 8 : 768 + g * 128 + (ch - 48) * 8;
    u32x4 xr[19];
    conv_load(xr, XBC, t0, l0, col);
    u32x4 zr[8];
    { const unsigned short* zp = VZ + (size_t)(t0 + (tid >> 2)) * 1024 + 512 + g * 256 + (tid & 3) * 64;
#pragma unroll
      for (int c = 0; c < 8; ++c) zr[c] = *(const u32x4*)(zp + c * 8); }
    dt_cs(t0, g, DTR, dtb, alog, csl, dtl, wtot, tid, lane, wid);
    if (ch < 32) conv_compute<false>(xr, l0, col, cw, cb, XS + ch * 16, PX4, nullptr);
    else if (ch < 48) conv_compute<false>(xr, l0, col, cw, cb, BI + (ch - 32) * 16, PR, nullptr);
    else conv_compute<false>(xr, l0, col, cw, cb, CI + (ch - 48) * 16, PR, nullptr);
    __syncthreads();
    const int lt = wid >> 1, st0 = 2 * (wid & 1), pt = wid & 1;
    f32x16 cb2[2]; cb2[0] = f32x16{}; cb2[1] = f32x16{};
#pragma unroll
    for (int ks = 0; ks < 8; ++ks) {
        const bf16x8 a = row_frag(CI, PR, 32 * lt, 16 * ks, lane);
        const bf16x8 b0 = row_frag(BI, PR, 32 * st0, 16 * ks, lane), b1 = row_frag(BI, PR, 32 * st0 + 32, 16 * ks, lane);
        cb2[0] = __builtin_amdgcn_mfma_f32_32x32x16_bf16(a, b0, cb2[0], 0, 0, 0);
        cb2[1] = __builtin_amdgcn_mfma_f32_32x32x16_bf16(a, b1, cb2[1], 0, 0, 0); }
    f32x16 yo[4];
    { bf16x8 hb[2][8];
      const unsigned short* hin0 = HIN + (((size_t)(bc * 8 + g * 4) * 64 + 32 * pt + r32) << 7) + 8 * hi;
#pragma unroll
      for (int ks = 0; ks < 8; ++ks) hb[0][ks] = *(const bf16x8*)(hin0 + 16 * ks);
#pragma unroll
      for (int hh = 0; hh < 4; ++hh) { yo[hh] = f32x16{};
          if (hh < 3) {
#pragma unroll
              for (int ks = 0; ks < 8; ++ks) hb[(hh + 1) & 1][ks] = *(const bf16x8*)(hin0 + ((size_t)(hh + 1) << 13) + 16 * ks); }
          __builtin_amdgcn_sched_barrier(0);
#pragma unroll
          for (int ks = 0; ks < 8; ++ks) yo[hh] = __builtin_amdgcn_mfma_f32_32x32x16_bf16(row_frag(CI, PR, 32 * lt, 16 * ks, lane), hb[hh & 1][ks], yo[hh], 0, 0, 0);
          __builtin_amdgcn_sched_barrier(0); } }
    __syncthreads();
    SS_LAS unsigned char* MI = BI;
#pragma unroll
    for (int hh = 0; hh < 4; ++hh) {
        const int h = g * 4 + hh;
#pragma unroll
        for (int j = 0; j < 2; ++j) { const int s = 32 * (st0 + j) + r32; const float css = csl[s * 4 + hh], dts = dtl[s * 4 + hh];
#pragma unroll
            for (int r = 0; r < 16; ++r) { const int l = 32 * lt + crow(r, hi); const float cl = csl[l * 4 + hh];
                float pr_ = cb2[j][r] * __builtin_amdgcn_exp2f(fminf(cl - css, 0.f) * 1.4426950408889634f) * dts; asm volatile("" : "+v"(pr_)); const float v = (s <= l) ? pr_ : 0.f;
                *(SS_LAS unsigned short*)(MI + l * PR + s * 2) = (unsigned short)f2bf(v); if ((r & 3) == 3) asm volatile("" ::: "memory"); } }
        __syncthreads();
        f32x16 yd = f32x16{};
#pragma unroll
        for (int ks = 0; ks < 8; ++ks) yd = __builtin_amdgcn_mfma_f32_32x32x16_bf16(row_frag(MI, PR, 32 * lt, 16 * ks, lane), tr_frag(XS, PX4, 16 * ks, hh * 64 + 32 * pt, lane), yd, 0, 0, 0);
        __syncthreads();
        const float dsk = Dsk[h]; const int p = 32 * pt + r32;
#pragma unroll
        for (int r = 0; r < 16; ++r) { const int l = 32 * lt + crow(r, hi);
            SS_LAS unsigned short* xp = (SS_LAS unsigned short*)(XS + l * PX4 + (hh * 64 + p) * 2);
            const float y = yd[r] + yo[hh][r] * __expf(csl[l * 4 + hh]) + dsk * bf2f(*xp);
            *xp = (unsigned short)f2bf(y); }
    }
    __syncthreads();
    { const int l = tid >> 2, q = tid & 3; const SS_LAS unsigned char* rowp = XS + l * PX4 + q * 128; float yv[8][8]; float s = 0.f;
#pragma unroll
      for (int c = 0; c < 8; ++c) { const u32x4 v = *(const SS_LAS u32x4*)(rowp + c * 16); const u32x4 z = zr[c];
          yv[c][0] = bflo(v.x) * silu_f(bflo(z.x)); yv[c][1] = bfhi(v.x) * silu_f(bfhi(z.x)); yv[c][2] = bflo(v.y) * silu_f(bflo(z.y)); yv[c][3] = bfhi(v.y) * silu_f(bfhi(z.y));
          yv[c][4] = bflo(v.z) * silu_f(bflo(z.z)); yv[c][5] = bfhi(v.z) * silu_f(bfhi(z.z)); yv[c][6] = bflo(v.w) * silu_f(bflo(z.w)); yv[c][7] = bfhi(v.w) * silu_f(bfhi(z.w));
#pragma unroll
          for (int j = 0; j < 8; ++j) s += yv[c][j] * yv[c][j]; }
      s += __shfl_xor(s, 1); s += __shfl_xor(s, 2);
      const float rstd = 1.f / sqrtf(s * (1.f / 256.f) + 1e-6f); const float* gq = gn + g * 256 + q * 64; unsigned short* op = MIX + (size_t)(t0 + l) * 1024 + 512 + g * 256 + q * 64;
#pragma unroll
      for (int c = 0; c < 8; ++c) { const f32x4 g0 = *(const f32x4*)(gq + c * 8), g1 = *(const f32x4*)(gq + c * 8 + 4); u32x4 o;
          o.x = pk2(yv[c][0] * rstd * g0.x, yv[c][1] * rstd * g0.y); o.y = pk2(yv[c][2] * rstd * g0.z, yv[c][3] * rstd * g0.w);
          o.z = pk2(yv[c][4] * rstd * g1.x, yv[c][5] * rstd * g1.y); o.w = pk2(yv[c][6] * rstd * g1.z, yv[c][7] * rstd * g1.w);
          *(u32x4*)(op + c * 8) = o; } }
    __syncthreads();
}
#undef SS_LAS
}

constexpr int NWAVES = 8, NTHR = 512;
constexpr int T_ = 32768, S_ = 2048, NB_ = 16, D_ = 1024;
constexpr int DFF = 2816, DFF2 = 5632;
constexpr float EPS = 1e-6f;
constexpr size_t MiB = 1u << 20;
constexpr size_t WS_CTL = 0, CTL_ZERO_BYTES = 3 * MiB;
constexpr size_t WS_SSQA = 1 * MiB, WS_SSQB = WS_SSQA + 256 * 1024, WS_SSQC = WS_SSQB + 256 * 1024, WS_SSQQ = WS_SSQC + 256 * 1024, WS_SSQKV = WS_SSQQ + 256 * 1024;
constexpr size_t WS_KMEAN = WS_SSQKV + 256 * 1024;
constexpr size_t WS_DTR = 55 * MiB;
constexpr size_t WS_W_IN0 = 3 * MiB;
constexpr size_t WS_W_OUT0 = WS_W_IN0 + 6656 * 1024;
constexpr size_t WS_W_IN1 = WS_W_OUT0 + 2 * MiB;
constexpr size_t WS_W_UQ = WS_W_IN1 + 2 * MiB;
constexpr size_t WS_W_UKV = WS_W_UQ + 1536 * 1024;
constexpr size_t WS_W_OUT1 = WS_W_UKV + 1 * MiB;
constexpr size_t WS_W_UP = WS_W_OUT1 + 2 * MiB;
constexpr size_t WS_W_DN = WS_W_UP + 22 * MiB;
constexpr size_t WS_TAB64 = 51 * MiB;
constexpr size_t WS_TAB32 = WS_TAB64 + 512 * 1024;
constexpr size_t WS_DT = 53 * MiB;
constexpr size_t WS_CS = 54 * MiB;
constexpr size_t WS_XN = 56 * MiB;
constexpr size_t WS_BIG = 120 * MiB;
static_assert(WS_W_DN + 11 * MiB <= WS_TAB64, "weights fit");
constexpr size_t L0_QK = WS_BIG, L0_VZ = WS_BIG + 64 * MiB, L0_XBC = WS_BIG + 128 * MiB, L0_DTR = WS_BIG + 192 * MiB, L0_XBCA = WS_BIG + 256 * MiB, L0_MIX = WS_BIG + 320 * MiB;
constexpr size_t L0_ST = WS_BIG + 192 * MiB;
constexpr size_t L0_KC = WS_BIG + 288 * MiB;
constexpr size_t L0_HIN = WS_BIG + 256 * MiB;
constexpr size_t WS_CEND = 53 * MiB;
constexpr size_t L0_CB = L0_DTR;
constexpr size_t L0_YG = L0_QK;
constexpr size_t FF_ACT = WS_BIG + 64 * MiB, FF_UB = WS_BIG + 240 * MiB;
constexpr size_t L1_C1 = WS_BIG, L1_QR = WS_BIG + 64 * MiB, L1_V2 = WS_BIG + 160 * MiB;
constexpr size_t WS_RG = WS_BIG + 384 * MiB;
constexpr size_t WS_SSQPE = 53 * MiB + 64 * 1024;
constexpr size_t L1_K2 = WS_BIG + 288 * MiB;
constexpr size_t L1_O = WS_BIG + 224 * MiB;
constexpr size_t WS_END = 512 * MiB;
constexpr int CW_BAR = 4096;

constexpr int RING_OFF = 0, RING_BYTES = 162816;
constexpr int LDSCTL_OFF = RING_BYTES, MISC_OFF = LDSCTL_OFF + 320;
constexpr int LDS_BYTES = 163840;

struct Args { const float* in[25]; float* out; unsigned char* ws; int ph_lo, ph_hi; };
typedef const __attribute__((address_space(4))) Args* KArgs;
__device__ __forceinline__ KArgs kargs() { KArgs p = (KArgs)__builtin_amdgcn_kernarg_segment_ptr(); asm volatile("" : "+s"(p)); return p; }
#define PH_VARS KArgs A_ = kargs(); unsigned char* ws = A_->ws; float* out = A_->out; const float* x = A_->in[0]; bf16* XN = (bf16*)(ws + WS_XN); const float* TAB64 = (const float*)(ws + WS_TAB64); const float* TAB32 = (const float*)(ws + WS_TAB32); \
    int tid_ = threadIdx.x; asm volatile("" : "+v"(tid_)); const int tid = tid_, lane = tid & 63, wave = __builtin_amdgcn_readfirstlane(tid >> 6); int G = gridDim.x; asm volatile("" : "+s"(G)); const int gw = blockIdx.x * NWAVES + wave, NGW = G * NWAVES; const int gt = blockIdx.x * NTHR + tid, NGT = G * NTHR; \
    (void)out; (void)x; (void)XN; (void)TAB64; (void)TAB32; (void)lane; (void)gw; (void)NGW; (void)gt; (void)NGT;

template <int MAP> __device__ __forceinline__ int src_col(int n0) {
    if (MAP == 1) { const int pn = n0 >> 8, bj = (n0 >> 7) & 1, wc = (n0 >> 5) & 3; return bj * DFF + pn * 128 + wc * 32; }
    if (MAP == 2) { const int pn = n0 >> 8, bj = (n0 >> 7) & 1, wc = (n0 >> 5) & 3; return (pn < 4) ? pn * 256 + wc * 64 + bj * 32 : n0; }
    if (MAP == 3) { const int pn = n0 >> 8, bj = (n0 >> 7) & 1, wc = (n0 >> 5) & 3; if (pn < 4) return (4 * pn + wc) * 128 + bj * 32; const int col = (pn - 4) * 256 + bj * 128 + wc * 32; return (col >> 6) * 128 + 64 + (col & 63); }
    return n0;
}
template <int MAP> __device__ __forceinline__ void tr_load(f32x4 (&v)[8], const float* W, int Nsrc, int item, int nblk, int lane, const float* gain) {
    const int kb = item / nblk, nb = item % nblk, k0 = 64 * kb, n0 = 32 * nb;
    const int nn = src_col<MAP>(n0) + (lane & 7) * 4; const bool ok = (nn >= 0 && nn < Nsrc);
#pragma unroll
    for (int i = 0; i < 8; ++i) { const int kk = 8 * i + (lane >> 3); v[i] = ok ? *(const f32x4*)(W + (size_t)(k0 + kk) * Nsrc + nn) : (f32x4){0.f, 0.f, 0.f, 0.f}; if (gain) v[i] = v[i] * gain[k0 + kk]; }
}
__device__ __forceinline__ void tr_store(const f32x4 (&v)[8], int K, bf16* WT, LAS float* scr, int item, int nblk, int lane) {
    const int kb = item / nblk, nb = item % nblk, k0 = 64 * kb, n0 = 32 * nb;
#pragma unroll
    for (int i = 0; i < 8; ++i) { const int kk = 8 * i + (lane >> 3); LAS float* d = scr + kk * 33 + (lane & 7) * 4; d[0] = v[i].x; d[1] = v[i].y; d[2] = v[i].z; d[3] = v[i].w; }
    LDS_WAIT(); asm volatile("" ::: "memory");
    const int c = lane & 7;
#pragma unroll
    for (int j = 0; j < 4; ++j) { const int n = (lane >> 3) + 8 * j; const LAS float* s = scr + (8 * c) * 33 + n;
        v4u o; o.x = pk2(s[0 * 33], s[1 * 33]); o.y = pk2(s[2 * 33], s[3 * 33]); o.z = pk2(s[4 * 33], s[5 * 33]); o.w = pk2(s[6 * 33], s[7 * 33]);
        *(GAS v4u*)(WT + (size_t)(n0 + n) * K + k0 + 8 * c) = o; }
    LDS_WAIT(); asm volatile("" ::: "memory");
}
template <int MAP = 0> __device__ __forceinline__ void transpose_mat(const float* W, int K, int Nsrc, int Npad, bf16* WT, LAS float* scr, int gw, int NGW, int lane, const float* gain = nullptr) {
    const int nblk = Npad / 32, nitems = (K / 64) * nblk;
    f32x4 cur[8], nxt[8];
    if (gw < nitems) tr_load<MAP>(cur, W, Nsrc, gw, nblk, lane, gain);
    for (int it = gw; it < nitems; it += NGW) {
        const bool more = it + NGW < nitems;
        if (more) tr_load<MAP>(nxt, W, Nsrc, it + NGW, nblk, lane, gain);
        tr_store(cur, K, WT, scr, it, nblk, lane);
        if (more) {
#pragma unroll
            for (int i = 0; i < 8; ++i) cur[i] = nxt[i]; }
    }
}

struct MatDesc { const float* W; bf16* WT; const float* gain; int K, Nsrc, nblk, map; };
__device__ __forceinline__ int src_col_rt(int map, int n0) { return map == 1 ? src_col<1>(n0) : map == 2 ? src_col<2>(n0) : map == 3 ? src_col<3>(n0) : n0; }
__device__ __forceinline__ void trl_load(f32x4 (&v)[8], const MatDesc& d, int item, int lane) {
    const int kb = item / d.nblk, nb = item % d.nblk, k0 = 64 * kb, n0 = 32 * nb;
    const int nn = src_col_rt(d.map, n0) + (lane & 7) * 4; const bool ok = (nn >= 0 && nn < d.Nsrc);
#pragma unroll
    for (int i = 0; i < 8; ++i) { const int kk = 8 * i + (lane >> 3); v[i] = ok ? __builtin_nontemporal_load((const f32x4*)(d.W + (size_t)(k0 + kk) * d.Nsrc + nn)) : (f32x4){0.f, 0.f, 0.f, 0.f}; if (d.gain) v[i] = v[i] * d.gain[k0 + kk]; }
}
constexpr int NIT_W = 1536 + 512 + 512 + 384 + 256 + 512 + 2 * 2816 + 2 * 1408;
__device__ __forceinline__ MatDesc mat_of(KArgs A_, unsigned char* ws, int item, int& local) {
    MatDesc d; int r = item;
    if (r < 1536) { d = MatDesc{A_->in[3], (bf16*)(ws + WS_W_IN0), nullptr, 1024, 3080, 96, 2}; local = r; return d; } r -= 1536;
    if (r < 512) { d = MatDesc{A_->in[12], (bf16*)(ws + WS_W_OUT0), nullptr, 1024, 1024, 32, 0}; local = r; return d; } r -= 512;
    if (r < 512) { d = MatDesc{A_->in[13], (bf16*)(ws + WS_W_IN1), A_->in[1] + 1024, 1024, 800, 32, 0}; local = r; return d; } r -= 512;
    if (r < 384) { d = MatDesc{A_->in[15], (bf16*)(ws + WS_W_UQ), A_->in[14], 512, 1536, 48, 0}; local = r; return d; } r -= 384;
    if (r < 256) { d = MatDesc{A_->in[17], (bf16*)(ws + WS_W_UKV), A_->in[16], 256, 2048, 64, 3}; local = r; return d; } r -= 256;
    if (r < 512) { d = MatDesc{A_->in[20], (bf16*)(ws + WS_W_OUT1), nullptr, 1024, 1024, 32, 0}; local = r; return d; } r -= 512;
    if (r < 5632) { const int l = r / 2816; d = MatDesc{A_->in[21] + (size_t)l * 1024 * DFF2, (bf16*)(ws + WS_W_UP) + (size_t)l * DFF2 * 1024, A_->in[2] + l * 1024, 1024, DFF2, 176, 1}; local = r - l * 2816; return d; } r -= 5632;
    { const int l = r / 1408; d = MatDesc{A_->in[24] + (size_t)l * DFF * 1024, (bf16*)(ws + WS_W_DN) + (size_t)l * 1024 * DFF, nullptr, DFF, 1024, 32, 0}; local = r - l * 1408; return d; }
}

__device__ __forceinline__ void rms_rows_1024(const float* x, const float* g, bf16* o, int gw, int NGW, int lane) {
    f32x4 v[4], nx[4];
    if (gw < T_) {
#pragma unroll
        for (int j = 0; j < 4; ++j) v[j] = __builtin_nontemporal_load((const f32x4*)(x + (size_t)gw * D_) + lane + 64 * j); }
    for (int m = gw; m < T_; m += NGW) {
        const bool more = m + NGW < T_;
        if (more) {
#pragma unroll
            for (int j = 0; j < 4; ++j) nx[j] = __builtin_nontemporal_load((const f32x4*)(x + (size_t)(m + NGW) * D_) + lane + 64 * j); }
        float s = 0.f;
#pragma unroll
        for (int j = 0; j < 4; ++j) s += (v[j].x * v[j].x + v[j].y * v[j].y) + (v[j].z * v[j].z + v[j].w * v[j].w);
        const float rstd = 1.f / sqrtf(wave_sum(s) * (1.f / D_) + EPS);
        unsigned long long* o8 = (unsigned long long*)(o + (size_t)m * D_) + lane;
#pragma unroll
        for (int j = 0; j < 4; ++j) { const f32x4 gg = ((const f32x4*)g)[lane + 64 * j];
            o8[64 * j] = (unsigned long long)pk2(v[j].x * rstd * gg.x, v[j].y * rstd * gg.y) | ((unsigned long long)pk2(v[j].z * rstd * gg.z, v[j].w * rstd * gg.w) << 32); }
        if (more) {
#pragma unroll
            for (int j = 0; j < 4; ++j) v[j] = nx[j]; }
    }
}

__device__ __forceinline__ void rms_rows_dt(const float* x, const float* g, bf16* o, float* DTR, const LAS f32x4* W2, int gw, int NGW, int lane) {
    constexpr int PD = 3;
    f32x4 q[PD + 1][4];
#pragma unroll
    for (int p = 0; p < PD; ++p) { const int r = gw + p * NGW; if (r < T_) {
#pragma unroll
            for (int j = 0; j < 4; ++j) q[p][j] = __builtin_nontemporal_load((const f32x4*)(x + (size_t)r * D_) + lane + 64 * j); } }
    for (int m = gw; m < T_; m += NGW) {
        { const int r = m + PD * NGW; if (r < T_) {
#pragma unroll
            for (int j = 0; j < 4; ++j) q[PD][j] = __builtin_nontemporal_load((const f32x4*)(x + (size_t)r * D_) + lane + 64 * j); } }
        f32x4 v[4];
#pragma unroll
        for (int j = 0; j < 4; ++j) v[j] = q[0][j];
        float s = 0.f; f32x4 d0 = {0.f, 0.f, 0.f, 0.f}, d1 = d0;
#pragma unroll
        for (int j = 0; j < 4; ++j) { s += (v[j].x * v[j].x + v[j].y * v[j].y) + (v[j].z * v[j].z + v[j].w * v[j].w);
#pragma unroll
            for (int e2 = 0; e2 < 4; ++e2) { const int sl = j * 4 + e2; const float xk = v[j][e2]; d0 += W2[(sl * 2) * 64 + lane] * xk; d1 += W2[(sl * 2 + 1) * 64 + lane] * xk; } }
        const float rstd = 1.f / sqrtf(wave_sum(s) * (1.f / D_) + EPS);
#pragma unroll
        for (int e2 = 0; e2 < 4; ++e2) { d0[e2] = wave_sum(d0[e2]); d1[e2] = wave_sum(d1[e2]); }
        if (lane == 0) { *(f32x4*)(DTR + (size_t)m * 8) = d0 * rstd; *(f32x4*)(DTR + (size_t)m * 8 + 4) = d1 * rstd; }
        unsigned long long* o8 = (unsigned long long*)(o + (size_t)m * D_) + lane;
#pragma unroll
        for (int j = 0; j < 4; ++j) { const f32x4 gg = ((const f32x4*)g)[lane + 64 * j];
            o8[64 * j] = (unsigned long long)pk2(v[j].x * rstd * gg.x, v[j].y * rstd * gg.y) | ((unsigned long long)pk2(v[j].z * rstd * gg.z, v[j].w * rstd * gg.w) << 32); }
#pragma unroll
        for (int p = 0; p < PD; ++p)
#pragma unroll
            for (int j = 0; j < 4; ++j) q[p][j] = q[p + 1][j];
    }
}

struct EpiF32Res {
    static constexpr bool PERM = false, AFTER_DRAIN = false;
    float* C; const float* R; int ldc;
    __device__ __forceinline__ void operator()(const pg8::f32x4 (&acc)[2][2][4][2], const pg8::Unit& u, int wr, int wc, int fr, int fq) const {
        const int row0 = u.pm * pg8::BM + wr * 64 + fr, col0 = u.pn * pg8::BM + wc * 32 + 4 * fq;
#pragma unroll
        for (int ai = 0; ai < 2; ++ai)
#pragma unroll
            for (int m = 0; m < 4; ++m) { const size_t off = (size_t)(row0 + ai * pg8::HALF + m * 16) * ldc + col0;
                f32x4 r[2][2];
#pragma unroll
                for (int bj = 0; bj < 2; ++bj)
#pragma unroll
                    for (int n = 0; n < 2; ++n) r[bj][n] = *(const f32x4*)(R + off + bj * pg8::HALF + n * 16);
#pragma unroll
                for (int bj = 0; bj < 2; ++bj)
#pragma unroll
                    for (int n = 0; n < 2; ++n) *(f32x4*)(C + off + bj * pg8::HALF + n * 16) = acc[ai][bj][m][n] + r[bj][n];
                asm volatile("" ::: "memory"); }
    }
};

template <bool RB16, bool OUTF, bool OUTB> struct EpiRes {
    static constexpr bool PERM = false, AFTER_DRAIN = false;
    float* C; const void* R; bf16* XB; unsigned long long* SSQ;
    struct Raw { f32x4 f[2][2]; unsigned long long h[2][2]; };
    __device__ __forceinline__ void load_raw(Raw& q, size_t off) const {
#pragma unroll
        for (int bj = 0; bj < 2; ++bj)
#pragma unroll
            for (int n = 0; n < 2; ++n) {
                if (RB16) q.h[bj][n] = *(const unsigned long long*)((const bf16*)R + off + bj * pg8::HALF + n * 16);
                else q.f[bj][n] = *(const f32x4*)((const float*)R + off + bj * pg8::HALF + n * 16); }
    }
    __device__ __forceinline__ void operator()(const pg8::f32x4 (&acc)[2][2][4][2], const pg8::Unit& u, int wr, int wc, int fr, int fq) const {
        const int row0 = u.pm * pg8::BM + wr * 64 + fr, col0 = u.pn * pg8::BM + wc * 32 + 4 * fq;
        Raw cur, nxt;
        load_raw(cur, (size_t)row0 * 1024 + col0);
#pragma unroll
        for (int it = 0; it < 8; ++it) { const int ai = it >> 2, mm = it & 3; const int row = row0 + ai * pg8::HALF + mm * 16; const size_t off = (size_t)row * 1024 + col0;
            if (it < 7) { const int ai2 = (it + 1) >> 2, m2 = (it + 1) & 3; load_raw(nxt, (size_t)(row0 + ai2 * pg8::HALF + m2 * 16) * 1024 + col0); }
            float s = 0.f;
#pragma unroll
            for (int bj = 0; bj < 2; ++bj)
#pragma unroll
                for (int n = 0; n < 2; ++n) {
                    f32x4 r; if (RB16) { const unsigned long long w = cur.h[bj][n]; r = (f32x4){bflo((unsigned)w), bfhi((unsigned)w), bflo((unsigned)(w >> 32)), bfhi((unsigned)(w >> 32))}; } else r = cur.f[bj][n];
                    const f32x4 v = acc[ai][bj][mm][n] + r;
                    if (OUTF) *(f32x4*)(C + off + bj * pg8::HALF + n * 16) = v;
                    if (OUTB) { s += (v.x * v.x + v.y * v.y) + (v.z * v.z + v.w * v.w);
                        *(unsigned long long*)(XB + off + bj * pg8::HALF + n * 16) = (unsigned long long)pk2(v.x, v.y) | ((unsigned long long)pk2(v.z, v.w) << 32); } }
            if (OUTB) { s += __shfl_xor(s, 16); s += __shfl_xor(s, 32); if (fq == 0) atomicAdd(SSQ + row, (unsigned long long)(s * 1073741824.0f)); }
            cur = nxt;
            asm volatile("" ::: "memory"); }
    }
};
__device__ __forceinline__ float rstd_of(const unsigned long long* SSQ, int row, float inv_n) { return __builtin_amdgcn_rsqf((float)SSQ[row] * (1.0f / 1073741824.0f) * inv_n + EPS); }
template <int N> __device__ __forceinline__ float dpp_shr_old(float old, float v) { return __builtin_bit_cast(float, __builtin_amdgcn_update_dpp(__builtin_bit_cast(int, old), __builtin_bit_cast(int, v), 0x110 + N, 0xf, 0xf, false)); }
template <int N> __device__ __forceinline__ float dpp_ror(float v) { return __builtin_bit_cast(float, __builtin_amdgcn_update_dpp(0, __builtin_bit_cast(int, v), 0x120 + N, 0xf, 0xf, false)); }
struct EpiFfnUp {
    static constexpr bool PERM = true, AFTER_DRAIN = false;
    bf16* ACT; bf16* UB; const unsigned long long* SSQ; const float* cw; const float* cb;
    __device__ __forceinline__ void operator()(const pg8::f32x4 (&acc)[2][2][4][2], const pg8::Unit& u, int wr, int wc, int fr, int fq) const {
        const int ch0 = u.pn * 128 + wc * 32 + 8 * fq;
        float rs[2][4];
#pragma unroll
        for (int ai = 0; ai < 2; ++ai)
#pragma unroll
            for (int m = 0; m < 4; ++m) rs[ai][m] = rstd_of(SSQ, u.pm * pg8::BM + ai * pg8::HALF + wr * 64 + 4 * fr + m, 1.0f / 1024.0f);
        unsigned long long keep[2][4];
#pragma unroll
        for (int n = 0; n < 2; ++n) {
            __builtin_amdgcn_sched_barrier(0);
            const int ch = ch0 + 4 * n;
            const f32x4 wg0 = *(const f32x4*)(cw + ch), wg1 = *(const f32x4*)(cw + DFF2 + ch), wg2 = *(const f32x4*)(cw + 2 * DFF2 + ch), bg = *(const f32x4*)(cb + ch);
            const f32x4 wu0 = *(const f32x4*)(cw + DFF + ch), wu1 = *(const f32x4*)(cw + DFF2 + DFF + ch), wu2 = *(const f32x4*)(cw + 2 * DFF2 + DFF + ch), bu = *(const f32x4*)(cb + DFF + ch);
#pragma unroll
            for (int ai = 0; ai < 2; ++ai) {
                const int rowc = u.pm * pg8::BM + ai * pg8::HALF + wr * 64;
                f32x4 g[4], uu[4];
#pragma unroll
                for (int m = 0; m < 4; ++m) { g[m] = acc[ai][0][m][n] * rs[ai][m]; uu[m] = acc[ai][1][m][n] * rs[ai][m]; }
                f32x4 g2p, g3p, u2p, u3p;
#pragma unroll
                for (int j = 0; j < 4; ++j) { g2p[j] = dpp_shr_old<1>(0.f, g[2][j]); g3p[j] = dpp_shr_old<1>(0.f, g[3][j]); u2p[j] = dpp_shr_old<1>(0.f, uu[2][j]); u3p[j] = dpp_shr_old<1>(0.f, uu[3][j]); }
#pragma unroll
                for (int m = 0; m < 4; ++m) {
                    const f32x4 sg1 = (m == 0) ? g3p : g[m - 1], sg2 = (m == 0) ? g2p : (m == 1) ? g3p : g[m - 2];
                    const f32x4 su1 = (m == 0) ? u3p : uu[m - 1], su2 = (m == 0) ? u2p : (m == 1) ? u3p : uu[m - 2];
                    const f32x4 cg = bg + wg0 * sg2 + wg1 * sg1 + wg2 * g[m], cu = bu + wu0 * su2 + wu1 * su1 + wu2 * uu[m];
                    f32x4 a;
#pragma unroll
                    for (int j = 0; j < 4; ++j) a[j] = cg[j] * __builtin_amdgcn_rcpf(1.f + __expf(-cg[j])) * cu[j];
                    const int row = rowc + 4 * fr + m;
                    const unsigned long long pk_ = (unsigned long long)pk2(a[0], a[1]) | ((unsigned long long)pk2(a[2], a[3]) << 32);
                    if (n == 0) { keep[ai][m] = pk_; asm volatile("" : "+v"(keep[ai][m])); }
                    else if (!(fr == 0 && m < 2)) { v4u w; w.x = (unsigned)keep[ai][m]; w.y = (unsigned)(keep[ai][m] >> 32); w.z = (unsigned)pk_; w.w = (unsigned)(pk_ >> 32); *(v4u*)(ACT + (size_t)row * DFF + ch0) = w; }
                    if ((fr == 0 && m < 2) || (fr == 15 && m >= 2)) { const int slot = m; bf16* ub = UB + ((size_t)(rowc >> 6) * 4 + slot) * DFF2 + ch;
                        *(unsigned long long*)ub = (unsigned long long)pk2(g[m][0], g[m][1]) | ((unsigned long long)pk2(g[m][2], g[m][3]) << 32);
                        *(unsigned long long*)(ub + DFF) = (unsigned long long)pk2(uu[m][0], uu[m][1]) | ((unsigned long long)pk2(uu[m][2], uu[m][3]) << 32); }
                }
            }
        }
    }
};


struct EpiScale {
    static constexpr bool PERM = true, AFTER_DRAIN = false;
    bf16* O; int ldc; const unsigned long long* SSQ; float inv_n;
    __device__ __forceinline__ void operator()(const pg8::f32x4 (&acc)[2][2][4][2], const pg8::Unit& u, int wr, int wc, int fr, int fq) const {
        const int row0 = u.pm * pg8::BM + wr * 64 + fr, col0 = u.pn * pg8::BM + wc * 32 + 8 * fq;
#pragma unroll
        for (int ai = 0; ai < 2; ++ai)
#pragma unroll
            for (int m = 0; m < 4; ++m) { const int row = row0 + ai * pg8::HALF + m * 16; const float rs = rstd_of(SSQ, row, inv_n); bf16* rowp = O + (size_t)row * ldc + col0;
#pragma unroll
                for (int bj = 0; bj < 2; ++bj) { const f32x4 v0 = acc[ai][bj][m][0] * rs, v1 = acc[ai][bj][m][1] * rs;
                    v4u w; w.x = pk2(v0[0], v0[1]); w.y = pk2(v0[2], v0[3]); w.z = pk2(v1[0], v1[1]); w.w = pk2(v1[2], v1[3]); *(v4u*)(rowp + bj * pg8::HALF) = w; } }
    }
};
struct EpiMlaIn {
    static constexpr bool PERM = true, AFTER_DRAIN = false;
    bf16* O; const unsigned long long* SSQ; unsigned long long* SSQ_Q; unsigned long long* SSQ_KV; float* SSQPE; float* RG; const float* kg; const float* TAB;
    __device__ __forceinline__ void operator()(const pg8::f32x4 (&acc)[2][2][4][2], const pg8::Unit& u, int wr, int wc, int fr, int fq) const {
        const int row0 = u.pm * pg8::BM + wr * 64 + fr, col0 = u.pn * pg8::BM + wc * 32 + 8 * fq;
        unsigned long long* tgt = (u.pn < 2) ? SSQ_Q : SSQ_KV;
        if (u.pn < 3) {
#pragma unroll
        for (int ai = 0; ai < 2; ++ai)
#pragma unroll
            for (int m = 0; m < 4; ++m) { const int row = row0 + ai * pg8::HALF + m * 16; const float rs = rstd_of(SSQ, row, 1.0f / 1024.0f); bf16* rowp = O + (size_t)row * 1024 + col0; float s = 0.f;
#pragma unroll
                for (int bj = 0; bj < 2; ++bj) { const f32x4 v0 = acc[ai][bj][m][0] * rs, v1 = acc[ai][bj][m][1] * rs;
                    s += (v0[0] * v0[0] + v0[1] * v0[1]) + (v0[2] * v0[2] + v0[3] * v0[3]) + (v1[0] * v1[0] + v1[1] * v1[1]) + (v1[2] * v1[2] + v1[3] * v1[3]);
                    v4u w; w.x = pk2(v0[0], v0[1]); w.y = pk2(v0[2], v0[3]); w.z = pk2(v1[0], v1[1]); w.w = pk2(v1[2], v1[3]); *(v4u*)(rowp + bj * pg8::HALF) = w; }
                s += __shfl_xor(s, 16); s += __shfl_xor(s, 32); if (fq == 0) atomicAdd(tgt + row, (unsigned long long)(s * 1073741824.0f)); asm volatile("" ::: "memory"); }
        } else if (wc == 0) {
            const f32x4 g0 = *(const f32x4*)(kg + 64 + 8 * fq), g1 = *(const f32x4*)(kg + 64 + 8 * fq + 4);
#pragma unroll
            for (int ai = 0; ai < 2; ++ai)
#pragma unroll
                for (int m = 0; m < 4; ++m) { const int row = row0 + ai * pg8::HALF + m * 16, pos = row & 2047; const float rs = rstd_of(SSQ, row, 1.0f / 1024.0f);
                    const f32x4 v0 = acc[ai][0][m][0] * rs, v1 = acc[ai][0][m][1] * rs;
                    float s = (v0[0] * v0[0] + v0[1] * v0[1]) + (v0[2] * v0[2] + v0[3] * v0[3]) + (v1[0] * v1[0] + v1[1] * v1[1]) + (v1[2] * v1[2] + v1[3] * v1[3]);
                    s += __shfl_xor(s, 16); s += __shfl_xor(s, 32); if (fq == 0) SSQPE[row] = s;
                    const f32x4 y0 = v0 * g0, y1 = v1 * g1;
                    f32x4 p0, p1;
#pragma unroll
                    for (int j = 0; j < 4; ++j) { p0[j] = __shfl_xor(y0[j], 32); p1[j] = __shfl_xor(y1[j], 32); }
                    const float* tb = TAB + (pos * 16 + 8 * (fq & 1)) * 2; const f32x4 ta = *(const f32x4*)tb, tb4 = *(const f32x4*)(tb + 4), tc = *(const f32x4*)(tb + 8), td = *(const f32x4*)(tb + 12);
                    const f32x4 c0 = {ta[0], ta[2], tb4[0], tb4[2]}, s0 = {ta[1], ta[3], tb4[1], tb4[3]}, c1 = {tc[0], tc[2], td[0], td[2]}, s1 = {tc[1], tc[3], td[1], td[3]};
                    f32x4 o0, o1;
                    if (fq < 2) { o0 = y0 * c0 - p0 * s0; o1 = y1 * c1 - p1 * s1; } else { o0 = p0 * s0 + y0 * c0; o1 = p1 * s1 + y1 * c1; }
                    float* rg = RG + (size_t)row * 32 + 8 * fq; *(f32x4*)rg = o0; *(f32x4*)(rg + 4) = o1; asm volatile("" ::: "memory"); }
        }
    }
};
struct EpiUkv {
    static constexpr bool PERM = true, AFTER_DRAIN = false;
    bf16* K2; bf16* V2; const unsigned long long* SSQ; const float* SSQPE; const float* RG; const float* kg;
    __device__ __forceinline__ void operator()(const pg8::f32x4 (&acc)[2][2][4][2], const pg8::Unit& u, int wr, int wc, int fr, int fq) const {
        const int row0 = u.pm * pg8::BM + wr * 64 + fr;
        if (u.pn < 4) {
            const int head = 4 * u.pn + wc;
            f32x4 g1[2], g2[2];
#pragma unroll
            for (int n = 0; n < 2; ++n) { g1[n] = *(const f32x4*)(kg + 8 * fq + 4 * n); g2[n] = *(const f32x4*)(kg + 32 + 8 * fq + 4 * n); }
#pragma unroll
            for (int ai = 0; ai < 2; ++ai)
#pragma unroll
                for (int m = 0; m < 4; ++m) { const int row = row0 + ai * pg8::HALF + m * 16; const float rs = rstd_of(SSQ, row, 1.0f / 256.0f);
                    f32x4 a[2], b[2]; float s = 0.f;
#pragma unroll
                    for (int n = 0; n < 2; ++n) { a[n] = acc[ai][0][m][n] * rs; b[n] = acc[ai][1][m][n] * rs; s += (a[n][0] * a[n][0] + a[n][1] * a[n][1]) + (a[n][2] * a[n][2] + a[n][3] * a[n][3]) + (b[n][0] * b[n][0] + b[n][1] * b[n][1]) + (b[n][2] * b[n][2] + b[n][3] * b[n][3]); }
                    s += __shfl_xor(s, 16); s += __shfl_xor(s, 32);
                    const float rh = 1.f / sqrtf((s + SSQPE[row]) * (1.f / 96.f) + EPS);
                    const int pos = row & 2047; bf16* rp = K2 + ((((size_t)(row >> 11) * 16 + head) * 32 + (pos >> 6)) * 12 + fq) * 512 + (pos & 63) * 8;
                    { const f32x4 o0 = a[0] * rh * g1[0], o1 = a[1] * rh * g1[1]; v4u w; w.x = pk2(o0[0], o0[1]); w.y = pk2(o0[2], o0[3]); w.z = pk2(o1[0], o1[1]); w.w = pk2(o1[2], o1[3]); *(v4u*)rp = w; }
                    { const f32x4 o0 = b[0] * rh * g2[0], o1 = b[1] * rh * g2[1]; v4u w; w.x = pk2(o0[0], o0[1]); w.y = pk2(o0[2], o0[3]); w.z = pk2(o1[0], o1[1]); w.w = pk2(o1[2], o1[3]); *(v4u*)(rp + 4 * 512) = w; }
                    { const float* rg = RG + (size_t)row * 32 + 8 * fq; const f32x4 o0 = *(const f32x4*)rg * rh, o1 = *(const f32x4*)(rg + 4) * rh; v4u w; w.x = pk2(o0[0], o0[1]); w.y = pk2(o0[2], o0[3]); w.z = pk2(o1[0], o1[1]); w.w = pk2(o1[2], o1[3]); *(v4u*)(rp + 8 * 512) = w; }
                    asm volatile("" ::: "memory"); }
        } else {
            bf16* dst = V2 + (u.pn - 4) * 256 + wc * 32 + 8 * fq;
#pragma unroll
            for (int ai = 0; ai < 2; ++ai)
#pragma unroll
                for (int m = 0; m < 4; ++m) { const int row = row0 + ai * pg8::HALF + m * 16; const float rs = rstd_of(SSQ, row, 1.0f / 256.0f); bf16* rp = dst + (size_t)row * 1024;
#pragma unroll
                    for (int bj = 0; bj < 2; ++bj) { const f32x4 v0 = acc[ai][bj][m][0] * rs, v1 = acc[ai][bj][m][1] * rs;
                        v4u w; w.x = pk2(v0[0], v0[1]); w.y = pk2(v0[2], v0[3]); w.z = pk2(v1[0], v1[1]); w.w = pk2(v1[2], v1[3]); *(v4u*)(rp + bj * pg8::HALF) = w; } }
        }
    }
};

struct EpiIn0 {
    static constexpr bool PERM = true, AFTER_DRAIN = false;
    bf16* QK; bf16* KC; const float* TAB; const float* qn; const float* kn; float* KM; float* DTR;
    __device__ __forceinline__ void operator()(const pg8::f32x4 (&acc)[2][2][4][2], const pg8::Unit& u, int wr, int wc, int fr, int fq) const {
        const int row0 = u.pm * pg8::BM + wr * 64 + fr;
        if (u.pn < 4) {
            const bool isq = u.pn < 2; const float* gn = isq ? qn : kn; const int head = 4 * (u.pn & 1) + wc;
            bf16* dst = QK + (isq ? 0 : 512) + head * 64 + 8 * fq;
            f32x4 g1[2], g2[2], ks1[2], ks2[2];
#pragma unroll
            for (int n = 0; n < 2; ++n) { g1[n] = *(const f32x4*)(gn + 8 * fq + 4 * n); g2[n] = *(const f32x4*)(gn + 32 + 8 * fq + 4 * n); ks1[n] = (f32x4){0.f, 0.f, 0.f, 0.f}; ks2[n] = ks1[n]; }
#pragma unroll
            for (int ai = 0; ai < 2; ++ai)
#pragma unroll
                for (int m = 0; m < 4; ++m) { const int row = row0 + ai * pg8::HALF + m * 16, pos = row & 2047;
                    float s = 0.f;
#pragma unroll
                    for (int n = 0; n < 2; ++n) { const f32x4 a = acc[ai][0][m][n], b = acc[ai][1][m][n]; s += (a[0] * a[0] + a[1] * a[1]) + (a[2] * a[2] + a[3] * a[3]) + (b[0] * b[0] + b[1] * b[1]) + (b[2] * b[2] + b[3] * b[3]); }
                    s += __shfl_xor(s, 16); s += __shfl_xor(s, 32);
                    float rstd = 1.f / sqrtf(s * (1.f / 64.f) + EPS); if (isq) rstd *= 0.18033688011112042f;
                    f32x4 o1[2], o2[2];
#pragma unroll
                    for (int n = 0; n < 2; ++n) { const float* tb = TAB + (pos * 32 + 8 * fq + 4 * n) * 2; const f32x4 t0 = *(const f32x4*)tb, t1 = *(const f32x4*)(tb + 4);
                        const f32x4 cs_ = {t0[0], t0[2], t1[0], t1[2]}, sn = {t0[1], t0[3], t1[1], t1[3]};
                        const f32x4 y1 = acc[ai][0][m][n] * rstd * g1[n], y2 = acc[ai][1][m][n] * rstd * g2[n];
                        o1[n] = y1 * cs_ - y2 * sn; o2[n] = y1 * sn + y2 * cs_; ks1[n] += o1[n]; ks2[n] += o2[n]; }
                    bf16* rp = dst + (size_t)row * 1024; int st2 = 32;
                    if (!isq) { rp = KC + ((((size_t)(row >> 11) * 8 + head) * 32 + (pos >> 6)) * 8 + fq) * 512 + (pos & 63) * 8; st2 = 4 * 512; }
                    { v4u w; w.x = pk2(o1[0][0], o1[0][1]); w.y = pk2(o1[0][2], o1[0][3]); w.z = pk2(o1[1][0], o1[1][1]); w.w = pk2(o1[1][2], o1[1][3]); *(v4u*)rp = w; }
                    { v4u w; w.x = pk2(o2[0][0], o2[0][1]); w.y = pk2(o2[0][2], o2[0][3]); w.z = pk2(o2[1][0], o2[1][1]); w.w = pk2(o2[1][2], o2[1][3]); *(v4u*)(rp + st2) = w; }
                    asm volatile("" ::: "memory"); }
            if (!isq) {
                float* km = KM + (((size_t)(u.pm >> 3) * 8 + (u.pm & 7)) * 8 + head) * 64 + 8 * fq;
#pragma unroll
                for (int n = 0; n < 2; ++n)
#pragma unroll
                    for (int j = 0; j < 4; ++j) { float a = ks1[n][j], b = ks2[n][j];
#pragma unroll
                        for (int o = 1; o < 16; o <<= 1) { a += __shfl_xor(a, o); b += __shfl_xor(b, o); }
                        if (fr == 0) { atomicAdd(km + 4 * n + j, a * (1.f / 256.f)); atomicAdd(km + 32 + 4 * n + j, b * (1.f / 256.f)); } } }
        } else if (u.pn < 12) {
            bf16* dst = QK + (size_t)(u.pn >> 2) * ((size_t)T_ * 1024) + (u.pn & 3) * 256 + wc * 32 + 8 * fq;
#pragma unroll
            for (int ai = 0; ai < 2; ++ai)
#pragma unroll
                for (int m = 0; m < 4; ++m) { bf16* rp = dst + (size_t)(row0 + ai * pg8::HALF + m * 16) * 1024;
#pragma unroll
                    for (int bj = 0; bj < 2; ++bj) { const f32x4 v0 = acc[ai][bj][m][0], v1 = acc[ai][bj][m][1];
                        v4u w; w.x = pk2(v0[0], v0[1]); w.y = pk2(v0[2], v0[3]); w.z = pk2(v1[0], v1[1]); w.w = pk2(v1[2], v1[3]); *(v4u*)(rp + bj * pg8::HALF) = w; } }
        } else if (wc == 0 && fq == 0) {
#pragma unroll
            for (int ai = 0; ai < 2; ++ai)
#pragma unroll
                for (int m = 0; m < 4; ++m) { float* rp = DTR + (size_t)(row0 + ai * pg8::HALF + m * 16) * 8; *(f32x4*)rp = acc[ai][0][m][0]; *(f32x4*)(rp + 4) = acc[ai][0][m][1]; }
        }
    }
};

template <class Epi, int AROW = 0> __device__ __forceinline__ void run_gemm(LAS unsigned char* lds, const bf16* A, const bf16* Bt, int M, int N, int K, const Epi& E, int lda = 0) {
    pg8::Gemm g{A, Bt, M, N, K, lda ? lda : K}; pg8::StaticOrder S; S.init(M, N, (int)gridDim.x, (int)blockIdx.x);
    pg8::gemm_phase<Epi, pg8::StaticOrder, PG8_ALIGN, PG8_SP2, AROW>(lds + RING_OFF, g, S, E);
}

#define NPHASES 40
__global__ void __launch_bounds__(NTHR, 2) fwd(Args args) {
    extern __shared__ __attribute__((aligned(16))) unsigned char lds_raw[];
    LAS unsigned char* lds = (LAS unsigned char*)lds_raw;
    volatile LAS unsigned* MISC = (volatile LAS unsigned*)(lds + MISC_OFF);
    {
        const int tid0 = threadIdx.x;
        for (int u = tid0; u < (LDS_BYTES - LDSCTL_OFF) / 4; u += NTHR) ((LAS unsigned*)(lds + LDSCTL_OFF))[u] = 0u;
    }
    __syncthreads();
    int lo, hi; { KArgs A0 = kargs(); lo = A0->ph_lo; hi = A0->ph_hi; }
    const bool multi = (hi - lo) > 1;
    XcdBarrier bar; bar.bar = nullptr; bar.x = 0; bar.st = nullptr;
    if (multi) { KArgs A0 = kargs(); bar = xcd_barrier_post((unsigned*)((gu32*)(A0->ws + WS_CTL) + CW_BAR), MISC + 8); }
#define IN(k) (lo <= (k) && (k) < hi)
#ifndef PROBE_MASK
#define PROBE_MASK 0u
#endif
    unsigned long long pr_acc = 0ull, pr_t = 0ull;
    if (PROBE_MASK) pr_t = __builtin_amdgcn_s_memrealtime();
#define SEAM(k) do { if (IN(k) && IN((k) + 1)) xcd_barrier(bar); \
        if (PROBE_MASK) { const unsigned long long now_ = __builtin_amdgcn_s_memrealtime(); if ((PROBE_MASK >> (k)) & 1u) pr_acc += now_ - pr_t; pr_t = now_; } } while (0)

    if (IN(0)) { PH_VARS
        LAS float* scr = (LAS float*)(lds + RING_OFF + wave * 16384);
        { f32x4 cur[8], nxt[8]; int it = gw, li = 0, ln = 0; MatDesc d{}, dn{};
          if (it < NIT_W) { d = mat_of(A_, ws, it, li); trl_load(cur, d, li, lane); }
          while (it < NIT_W) { const int nit = it + NGW; const bool more = nit < NIT_W;
              if (more) { dn = mat_of(A_, ws, nit, ln); trl_load(nxt, dn, ln, lane); }
              tr_store(cur, d.K, d.WT, scr, li, d.nblk, lane);
              if (more) {
#pragma unroll
                  for (int i = 0; i < 8; ++i) cur[i] = nxt[i];
                  d = dn; li = ln; }
              it = nit; } }
        float* t64 = (float*)(ws + WS_TAB64); float* t32 = (float*)(ws + WS_TAB32);
        for (int i = gt; i < 2048 * 32; i += NGT) { const int pos = i >> 5, f = i & 31; const float inv = 1.0f / powf(10000.0f, (float)(2 * f) / 64.0f); const float ang = (float)pos * inv; t64[2 * i] = cosf(ang); t64[2 * i + 1] = sinf(ang); }
        for (int i = gt; i < 2048 * 16; i += NGT) { const int pos = i >> 4, f = i & 15; const float inv = 1.0f / powf(10000.0f, (float)(2 * f) / 32.0f); const float ang = (float)pos * inv; t32[2 * i] = cosf(ang); t32[2 * i + 1] = sinf(ang); }
        asm volatile("s_waitcnt vmcnt(0) lgkmcnt(0)" ::: "memory"); __syncthreads();
        { LAS f32x4* W2 = (LAS f32x4*)(lds + RING_OFF); const float* Wi = A_->in[3]; const float* gg = A_->in[1];
          for (int i = tid; i < 2048; i += NTHR) { const int ln = i & 63, sh = i >> 6, sl = sh >> 1, half = sh & 1, k = 4 * ln + 256 * (sl >> 2) + (sl & 3);
              W2[i] = *(const f32x4*)(Wi + (size_t)k * 3080 + 3072 + 4 * half) * gg[k]; }
          asm volatile("s_waitcnt vmcnt(0) lgkmcnt(0)" ::: "memory"); __syncthreads();
          rms_rows_dt(x, A_->in[1], XN, (float*)(ws + WS_DTR), W2, gw, NGW, lane); }
    }
    SEAM(0);
    if (IN(1)) { PH_VARS EpiIn0 E{(bf16*)(ws + L0_QK), (bf16*)(ws + L0_KC), TAB64, A_->in[10], A_->in[11], (float*)(ws + WS_KMEAN), (float*)(ws + WS_DTR)}; run_gemm(lds, XN, (const bf16*)(ws + WS_W_IN0), T_, 3072, 1024, E); }
    SEAM(1);
    if (IN(2)) { PH_VARS
        for (int u = blockIdx.x; u < 512; u += G) ssd::states_unit(lds, u >> 1, u & 1, (const bf16*)(ws + L0_XBC), (const float*)(ws + WS_DTR), A_->in[4], A_->in[5], A_->in[6], A_->in[7], (float*)(ws + L0_ST), (float*)(ws + WS_CEND));
    }
    SEAM(2);
    if (IN(3)) { PH_VARS
        const float* ST = (const float*)(ws + L0_ST); const float* CEND = (const float*)(ws + WS_CEND); bf16* HIN = (bf16*)(ws + L0_HIN);
        for (int i = gt; i < 16 * 8 * 64 * 128 / 4; i += NGT) {
            const int pn = (i & 2047) * 4, h = (i >> 11) & 7, b = i >> 14; f32x4 hst = {0.f, 0.f, 0.f, 0.f}; f32x4 tmp[16]; float dec[16];
#pragma unroll
            for (int c = 0; c < 16; ++c) { tmp[c] = *(const f32x4*)(ST + (((size_t)((b * 16 + c) * 8 + h) << 13) + pn)); dec[c] = CEND[(b * 16 + c) * 8 + h]; }
#pragma unroll
            for (int c = 0; c < 16; ++c) { const size_t idx = ((size_t)((b * 16 + c) * 8 + h) << 13) + pn;
                *(unsigned long long*)(HIN + idx) = (unsigned long long)pk2(hst.x, hst.y) | ((unsigned long long)pk2(hst.z, hst.w) << 32);
                hst = hst * __expf(dec[c]) + tmp[c]; }
        }
        const bf16* QK = (const bf16*)(ws + L0_QK); const bf16* VZ = (const bf16*)(ws + L0_VZ); const float* KM = (const float*)(ws + WS_KMEAN); bf16* MIX = (bf16*)(ws + L0_MIX);
        asm volatile("s_waitcnt vmcnt(0) lgkmcnt(0)" ::: "memory"); __syncthreads();
        float kb0; { float gm = fabsf(A_->in[11][lane]);
#pragma unroll
          for (int o_ = 1; o_ < 64; o_ <<= 1) gm = fmaxf(gm, __shfl_xor(gm, o_));
          kb0 = 8.0f * 1.02f * gm; }
        { int tb = 0, pbh = -1;
          for (int i = blockIdx.x; i < 1024; i += G) {
            const int s_ = i >> 8, c = i & 255, bh = c >> 1, half = c & 1, qb = (s_ & 1) ? (s_ - 1 + half) : (7 - half - s_), b = bh >> 3, h = bh & 7;
            const int in_ = i + G; const bool hn = (in_ < 1024) && (((in_ & 255) >> 1) == bh);
            at2::Tensors TT{QK + h * 64, (const bf16*)(ws + L0_KC) + (size_t)(b * 8 + h) * (32 * 8 * 512), VZ + h * 64, MIX + h * 64, 1024, 0, 1024, 1024};
            at2::attn_unit_p<64, true, false, 2>(lds, TT, (long)b * 2048, qb, KM + b * 4096 + h * 64, nullptr, nullptr, kb0, tb, pbh == bh, hn);
            tb = (tb + 4 * (qb + 1)) % 6; pbh = hn ? bh : -1; } }
    }
    SEAM(3);
    if (IN(4)) { PH_VARS
        for (int u = blockIdx.x; u < 512; u += G) ssd::out_unit(lds, u >> 1, u & 1, (const bf16*)(ws + L0_XBC), (const bf16*)(ws + L0_VZ), (const float*)(ws + WS_DTR), A_->in[4], A_->in[5], A_->in[6], A_->in[7],
                                                               (const bf16*)(ws + L0_HIN), A_->in[8], A_->in[9], (bf16*)(ws + L0_MIX));
    }
    SEAM(4);
    if (IN(5)) { PH_VARS EpiRes<false, false, true> E{nullptr, x, XN, (unsigned long long*)(ws + WS_SSQA)}; run_gemm(lds, (const bf16*)(ws + L0_MIX), (const bf16*)(ws + WS_W_OUT0), T_, 1024, 1024, E); }
    SEAM(5);
#define FFN_PHASES(P, L, AIN, SSQ_IN, LASTL, SSQ_OUT) \
    if (IN(P)) { PH_VARS EpiFfnUp E{(bf16*)(ws + FF_ACT), (bf16*)(ws + FF_UB), (const unsigned long long*)(ws + (SSQ_IN)), A_->in[22] + (size_t)(L) * 3 * DFF2, A_->in[23] + (size_t)(L) * DFF2}; \
        run_gemm<EpiFfnUp, 1>(lds, (const bf16*)(ws + (AIN)), (const bf16*)(ws + WS_W_UP) + (size_t)(L) * DFF2 * 1024, T_, DFF2, 1024, E); } \
    SEAM(P); \
    if (IN((P) + 1)) { PH_VARS \
        const bf16* UB = (const bf16*)(ws + FF_UB); bf16* ACT = (bf16*)(ws + FF_ACT); const float* cw = A_->in[22] + (size_t)(L) * 3 * DFF2; const float* cb = A_->in[23] + (size_t)(L) * DFF2; \
        for (int i = gt; i < 512 * 2 * (DFF / 8); i += NGT) {          \
            const int c0 = (i % (DFF / 8)) * 8, rr = (i / (DFF / 8)) & 1, ck = i / (2 * (DFF / 8)); const bool first = (ck & 31) == 0;     \
            float ag[8], au[8]; \
            _Pragma("unroll") for (int j = 0; j < 8; ++j) { ag[j] = cb[c0 + j]; au[j] = cb[DFF + c0 + j]; } \
            _Pragma("unroll") for (int k = 0; k < 3; ++k) { const int rel = rr - 2 + k;     \
                if (rel >= 0 || !first) { const bf16* src = (rel >= 0) ? UB + ((size_t)ck * 4 + rel) * DFF2 : UB + ((size_t)(ck - 1) * 4 + 4 + rel) * DFF2; \
                    const v4u wg = *(const v4u*)(src + c0); const v4u wu = *(const v4u*)(src + DFF + c0); const float* kg = cw + k * DFF2 + c0; const float* ku = kg + DFF; \
                    ag[0] += kg[0] * bflo(wg.x); ag[1] += kg[1] * bfhi(wg.x); ag[2] += kg[2] * bflo(wg.y); ag[3] += kg[3] * bfhi(wg.y); ag[4] += kg[4] * bflo(wg.z); ag[5] += kg[5] * bfhi(wg.z); ag[6] += kg[6] * bflo(wg.w); ag[7] += kg[7] * bfhi(wg.w); \
                    au[0] += ku[0] * bflo(wu.x); au[1] += ku[1] * bfhi(wu.x); au[2] += ku[2] * bflo(wu.y); au[3] += ku[3] * bfhi(wu.y); au[4] += ku[4] * bflo(wu.z); au[5] += ku[5] * bfhi(wu.z); au[6] += ku[6] * bflo(wu.w); au[7] += ku[7] * bfhi(wu.w); } } \
            v4u o; o.x = pk2(silu_f(ag[0]) * au[0], silu_f(ag[1]) * au[1]); o.y = pk2(silu_f(ag[2]) * au[2], silu_f(ag[3]) * au[3]); o.z = pk2(silu_f(ag[4]) * au[4], silu_f(ag[5]) * au[5]); o.w = pk2(silu_f(ag[6]) * au[6], silu_f(ag[7]) * au[7]); \
            *(v4u*)(ACT + ((size_t)ck * 64 + rr) * DFF + c0) = o; } } \
    SEAM((P) + 1); \
    if (IN((P) + 2)) { PH_VARS EpiRes<true, LASTL, !LASTL> E{out, (const bf16*)(ws + (AIN)), (bf16*)(ws + (AIN)), (unsigned long long*)(ws + (SSQ_OUT))}; run_gemm(lds, (const bf16*)(ws + FF_ACT), (const bf16*)(ws + WS_W_DN) + (size_t)(L) * 1024 * DFF, T_, 1024, DFF, E); } \
    SEAM((P) + 2);
    FFN_PHASES(6, 0, WS_XN, WS_SSQA, false, WS_SSQB)
    if (IN(9)) { PH_VARS EpiMlaIn E{(bf16*)(ws + L1_C1), (const unsigned long long*)(ws + WS_SSQB), (unsigned long long*)(ws + WS_SSQQ), (unsigned long long*)(ws + WS_SSQKV), (float*)(ws + WS_SSQPE), (float*)(ws + WS_RG), A_->in[19], TAB32}; run_gemm(lds, XN, (const bf16*)(ws + WS_W_IN1), T_, 1024, 1024, E); }
    SEAM(9);
    if (IN(10)) { PH_VARS const bf16* C1 = (const bf16*)(ws + L1_C1);
        { EpiScale E{(bf16*)(ws + L1_QR), 1536, (const unsigned long long*)(ws + WS_SSQQ), 1.0f / 512.0f}; run_gemm(lds, C1, (const bf16*)(ws + WS_W_UQ), T_, 1536, 512, E, 1024); }
        { EpiUkv E{(bf16*)(ws + L1_K2), (bf16*)(ws + L1_V2), (const unsigned long long*)(ws + WS_SSQKV), (const float*)(ws + WS_SSQPE), (const float*)(ws + WS_RG), A_->in[19]}; run_gemm(lds, C1 + 512, (const bf16*)(ws + WS_W_UKV), T_, 2048, 256, E, 1024); } }
    SEAM(10);
    if (IN(11)) { PH_VARS
        const bf16* Q2 = (const bf16*)(ws + L1_QR); const bf16* K2 = (const bf16*)(ws + L1_K2); const bf16* V2 = (const bf16*)(ws + L1_V2); bf16* O = (bf16*)(ws + L1_O);
        float kb1; { float gm = fmaxf(fabsf(A_->in[19][lane]), (lane < 32) ? fabsf(A_->in[19][64 + lane]) : 0.f);
#pragma unroll
          for (int o_ = 1; o_ < 64; o_ <<= 1) gm = fmaxf(gm, __shfl_xor(gm, o_));
          kb1 = 9.797958971f * 1.02f * gm; }
        { int tb = 0, pbh = -1;
          for (int i = blockIdx.x; i < 2048; i += G) {
            const int s_ = i >> 8, bh = i & 255, qb = 7 - s_, b = bh >> 4, h = bh & 15;
            const int in_ = i + G; const bool hn = (in_ < 2048) && ((in_ & 255) == bh);
            at2::Tensors TT{Q2 + h * 96, K2 + (size_t)(b * 16 + h) * (32 * 12 * 512), V2 + h * 64, O + h * 64, 1536, 0, 1024, 1024};
            at2::attn_unit_p<96, false, true, 2>(lds, TT, (long)b * 2048, qb, nullptr, A_->in[18], TAB32, kb1, tb, pbh == bh, hn);
            tb = (tb + 4 * (qb + 1)) % 6; pbh = hn ? bh : -1; } }
    }
    SEAM(11);
    if (IN(12)) { PH_VARS EpiRes<true, false, true> E{nullptr, XN, (bf16*)(ws + WS_BIG), (unsigned long long*)(ws + WS_SSQC)}; run_gemm(lds, (const bf16*)(ws + L1_O), (const bf16*)(ws + WS_W_OUT1), T_, 1024, 1024, E); }
    SEAM(12);
    FFN_PHASES(13, 1, WS_BIG, WS_SSQC, true, WS_SSQB)
    if (PROBE_MASK) { if (blockIdx.x == 0 && threadIdx.x == 0) { const unsigned long long t0 = __builtin_amdgcn_s_memrealtime(); while (__builtin_amdgcn_s_memrealtime() - t0 < pr_acc) __builtin_amdgcn_s_sleep(8); } }
#undef IN
#undef SEAM
}
constexpr int LAST_PHASE = 16;

#ifndef MK_ONE_LAUNCH
#define MK_ONE_LAUNCH 1
#endif
extern "C" void kernel_launch(void* const* d_in, const int* in_sizes, int n_in, void* d_out, int out_size, void* d_ws, size_t ws_size, hipStream_t stream) {
    static int grid = 0;
    if (grid == 0) {
        if (n_in != 25 || out_size != T_ * D_ || ws_size < WS_END) { fprintf(stderr, "kernel_launch: unexpected shapes: n_in %d out %d ws %zu\n", n_in, out_size, ws_size); grid = -1; return; }
        if (hipFuncSetAttribute((const void*)fwd, hipFuncAttributeMaxDynamicSharedMemorySize, LDS_BYTES) != hipSuccess) { fprintf(stderr, "kernel_launch: hipFuncSetAttribute failed\n"); grid = -1; return; }
        int dev = 0, cus = 0, per_cu = 0;
        hipGetDevice(&dev); hipDeviceGetAttribute(&cus, hipDeviceAttributeMultiprocessorCount, dev);
        hipOccupancyMaxActiveBlocksPerMultiprocessor(&per_cu, (const void*)fwd, NTHR, LDS_BYTES);
        (void)hipGetLastError();
        grid = (per_cu >= 1) ? cus : -1;
        if (grid < 0) { fprintf(stderr, "kernel_launch: occupancy query says 0 blocks per CU\n"); return; }
    }
    if (grid < 0) return;
    hipMemsetAsync((char*)d_ws + WS_CTL, 0, CTL_ZERO_BYTES, stream);
    Args a{};
    for (int i = 0; i < 25; ++i) a.in[i] = (const float*)d_in[i];
    a.out = (float*)d_out; a.ws = (unsigned char*)d_ws;
#if MK_ONE_LAUNCH
    a.ph_lo = 0; a.ph_hi = LAST_PHASE;
    hipLaunchKernelGGL(fwd, dim3(grid), dim3(NTHR), LDS_BYTES, stream, a);
#else
    for (int p = 0; p < LAST_PHASE; ++p) { a.ph_lo = p; a.ph_hi = p + 1; hipLaunchKernelGGL(fwd, dim3(grid), dim3(NTHR), LDS_BYTES, stream, a); }
#endif
}
```

```cpp
#include <hip/hip_runtime.h>
#include <cstdio>
#include <cstdint>
namespace pg8 {
#define PG8_LAS __attribute__((address_space(3)))
typedef unsigned short bf16_t;
typedef short bf16x8 __attribute__((ext_vector_type(8)));
typedef float f32x4 __attribute__((ext_vector_type(4)));
typedef unsigned u32x4 __attribute__((ext_vector_type(4)));
constexpr int BM = 256, BK = 64, HALF = 128, HTB = HALF * BK * 2  , STAGE_BYTES = 8 * HTB, NXCD = 8, WGM = 8;

__host__ __device__ __forceinline__ int lds_byte(int r, int c) { const int st = (r >> 4) * 2 + (c >> 5), rr = r & 15, cc = c & 31, ob = rr * 64 + cc * 2; return st * 1024 + (ob ^ (((ob >> 9) & 1) << 5)); }
__host__ __device__ __forceinline__ void stage_rc(int b, int& R, int& C) { const int st = b / 1024, sb = b % 1024, swz = sb ^ (((sb >> 9) & 1) << 5); R = (st >> 1) * 16 + swz / 64; C = (st & 1) * 32 + (swz % 64) / 2; }
__host__ __device__ __forceinline__ int perm32(int rho) { const int n = rho >> 4, i = rho & 15; return 8 * (i >> 2) + 4 * n + (i & 3); }

struct Unit { int pm, pn; };
struct Gemm { const bf16_t* A; const bf16_t* Bt; int M, N, K, lda; };

struct StaticOrder {
    int nM, nN, nwg, G, c;
    __host__ __device__ void init(int M, int N, int G_, int c_) { nM = M / BM; nN = N / BM; nwg = nM * nN; G = G_; c = c_; }
    __host__ __device__ bool next(int i, Unit& u) const {
        const long L = (long)i * G + c; if (L >= nwg) return false;
        int wgid = (int)L; { const int q = nwg / NXCD, r = nwg % NXCD, xcd = wgid % NXCD, off = wgid / NXCD; wgid = (xcd < r ? xcd * (q + 1) : r * (q + 1) + (xcd - r) * q) + off; }
        const int nig = WGM * nN, gid = wgid / nig, fm = gid * WGM, gsz = (nM - fm) < WGM ? (nM - fm) : WGM;
        u.pm = fm + ((wgid % nig) % gsz); u.pn = (wgid % nig) / gsz; return true;
    }
    __device__ __forceinline__ void a_ready(const Unit&) const {}
    __device__ __forceinline__ void done(const Unit&) const {}
};

__device__ __forceinline__ unsigned cvt_pk_bf16(float lo, float hi) { unsigned r; asm volatile("v_cvt_pk_bf16_f32 %0, %1, %2" : "=v"(r) : "v"(lo), "v"(hi)); return r; }
typedef float f32x2 __attribute__((ext_vector_type(2)));
__device__ __forceinline__ f32x2 gelu_pk(f32x2 v) {
    const f32x2 av = __builtin_elementwise_abs(v), d = av * 0.2316418882f + 1.0f;
    f32x2 t; t.x = __builtin_amdgcn_rcpf(d.x); t.y = __builtin_amdgcn_rcpf(d.y);
    f32x2 q = t * 0.5307027145f + (-0.7265760135f); q = q * t + 0.7107068705f; q = q * t + (-0.142248368f); q = q * t + 0.127414796f; q = q * t;
    const f32x2 s = (v * v) * (-0.72134752044f);
    f32x2 e; e.x = __builtin_amdgcn_exp2f(s.x); e.y = __builtin_amdgcn_exp2f(s.y);
    const f32x2 m = v * (q * e), r = v - m;
    f32x2 o; o.x = v.x < 0.f ? m.x : r.x; o.y = v.y < 0.f ? m.y : r.y; return o;
}

template <int ACT  > struct EpiBf16 {
    static constexpr bool PERM = true, AFTER_DRAIN = false; static_assert(ACT == 0 || ACT == 1, "EpiBf16: ACT is 0 (none) or 1 (gelu_pk)");
    bf16_t* O; int ldc; const float* bias; int split_cols; size_t split_stride; float scale0;
    __device__ __forceinline__ void operator()(const f32x4 (&acc)[2][2][4][2], const Unit& u, int wr, int wc, int fr, int fq) const {
        const int row0 = u.pm * BM + wr * 64 + fr; int colt = u.pn * BM; bf16_t* base = O;
        float sc = 1.f; if (split_cols) { const int t = colt / split_cols; base += (size_t)t * split_stride; colt -= t * split_cols; if (t == 0) sc = scale0; }
        const int col0 = colt + wc * 32 + 8 * fq, bcol0 = u.pn * BM + wc * 32 + 8 * fq;
        f32x4 bv[2][2];
#pragma unroll
        for (int bj = 0; bj < 2; ++bj)
#pragma unroll
            for (int n = 0; n < 2; ++n) bv[bj][n] = bias ? *(const f32x4*)(bias + bcol0 + bj * HALF + 4 * n) : (f32x4){0.f, 0.f, 0.f, 0.f};
#pragma unroll
        for (int ai = 0; ai < 2; ++ai)
#pragma unroll
            for (int m = 0; m < 4; ++m) { bf16_t* rowp = base + (size_t)(row0 + ai * HALF + m * 16) * ldc + col0;
#pragma unroll
                for (int bj = 0; bj < 2; ++bj) { f32x4 v0 = acc[ai][bj][m][0] + bv[bj][0], v1 = acc[ai][bj][m][1] + bv[bj][1];
                    if (ACT == 1) { f32x2 a = gelu_pk((f32x2){v0[0], v0[1]}), b = gelu_pk((f32x2){v0[2], v0[3]}), c = gelu_pk((f32x2){v1[0], v1[1]}), d = gelu_pk((f32x2){v1[2], v1[3]});
                        v0 = (f32x4){a.x, a.y, b.x, b.y}; v1 = (f32x4){c.x, c.y, d.x, d.y}; }
                    v0 = v0 * sc; v1 = v1 * sc; u32x4 w; w.x = cvt_pk_bf16(v0[0], v0[1]); w.y = cvt_pk_bf16(v0[2], v0[3]); w.z = cvt_pk_bf16(v1[0], v1[1]); w.w = cvt_pk_bf16(v1[2], v1[3]);
                    *(u32x4*)(rowp + bj * HALF) = w; } }
    }
};

struct PanelStats {
    unsigned* xbuf;
    unsigned* cnt;
    unsigned* tmo;
    int ntn; float eps;
    unsigned code;
    __device__ __forceinline__ bool run(const f32x4 (&v)[2][2][4][2], const Unit& u, int wr, int wc, int fr, int fq, PG8_LAS unsigned char* lds, int wid, int lane) const {
        typedef float f32x2v __attribute__((ext_vector_type(2)));
        PG8_LAS f32x2v* P = (PG8_LAS f32x2v*)lds;
        PG8_LAS f32x2v* S = (PG8_LAS f32x2v*)(lds + 8192);
        PG8_LAS unsigned* flag = (PG8_LAS unsigned*)(lds + 8192 + 2048);
#pragma unroll
        for (int ai = 0; ai < 2; ++ai)
#pragma unroll
            for (int m = 0; m < 4; ++m) {
                float s = 0.f;
#pragma unroll
                for (int bj = 0; bj < 2; ++bj)
#pragma unroll
                    for (int n = 0; n < 2; ++n) { const f32x4 x = v[ai][bj][m][n]; s += (x[0] + x[1]) + (x[2] + x[3]); }
                s += __shfl_xor(s, 16); s += __shfl_xor(s, 32);
                const float mw = s * (1.0f / 64.0f); float q = 0.f;
#pragma unroll
                for (int bj = 0; bj < 2; ++bj)
#pragma unroll
                    for (int n = 0; n < 2; ++n) { const f32x4 d = v[ai][bj][m][n] - mw; q += (d[0] * d[0] + d[1] * d[1]) + (d[2] * d[2] + d[3] * d[3]); }
                q += __shfl_xor(q, 16); q += __shfl_xor(q, 32);
                if (fq == 0) P[(ai * HALF + wr * 64 + m * 16 + fr) * 4 + wc] = (f32x2v){mw, q};
            }
        asm volatile("s_waitcnt lgkmcnt(0)" ::: "memory"); __builtin_amdgcn_s_barrier(); asm volatile("" ::: "memory");
#if defined(BROKEN_EXCHANGE_NO_WAIT)
#warning BROKEN CONTROL BUILD: the row-statistics exchange does not wait; results are wrong by design
        if (blockIdx.x >= 64) { const long long t0_ = clock64(); while (clock64() - t0_ < 60000) __builtin_amdgcn_s_sleep(8); }
#endif
        const int row = wid * 32 + (lane & 31);
        if (lane < 32) {
            const f32x2v a = P[row * 4 + 0], b = P[row * 4 + 1], c = P[row * 4 + 2], d = P[row * 4 + 3];
            const float mt = (a.x + b.x + c.x + d.x) * 0.25f;
            const float da = a.x - mt, db = b.x - mt, dc = c.x - mt, dd = d.x - mt;
            const float m2 = (a.y + b.y) + (c.y + d.y) + 64.0f * ((da * da + db * db) + (dc * dc + dd * dd));
            unsigned long long* slot = (unsigned long long*)xbuf + ((size_t)(u.pm * BM + row) * 4 + u.pn);
            __hip_atomic_store(slot, ((unsigned long long)__float_as_uint(m2) << 32) | __float_as_uint(mt), __ATOMIC_RELAXED, __HIP_MEMORY_SCOPE_AGENT);
        }
        asm volatile("s_waitcnt vmcnt(0)" ::: "memory");
        if (lane == 0) __hip_atomic_fetch_add(cnt + 64 * u.pm, 1u, __ATOMIC_RELAXED, __HIP_MEMORY_SCOPE_AGENT);
        if (wid == 0) {
            bool dead = false; const unsigned long long t0 = __builtin_amdgcn_s_memrealtime(); const unsigned want = 8u * (unsigned)ntn;
            for (;;) {
#if defined(BROKEN_EXCHANGE_NO_WAIT)
                break;
#endif
                if ((unsigned)__builtin_amdgcn_readfirstlane(__hip_atomic_load(cnt + 64 * u.pm, __ATOMIC_RELAXED, __HIP_MEMORY_SCOPE_AGENT)) >= want) break;
                if (__builtin_amdgcn_s_memrealtime() - t0 > 2000000ull) {
                    if (lane == 0) { unsigned expect = 0u; __hip_atomic_compare_exchange_strong(tmo + 1, &expect, code | (unsigned)(u.pm & 0xff), __ATOMIC_RELAXED, __ATOMIC_RELAXED, __HIP_MEMORY_SCOPE_AGENT);
                                     __hip_atomic_store(tmo, 1u, __ATOMIC_RELAXED, __HIP_MEMORY_SCOPE_AGENT); }
                    dead = true; break; }
                __builtin_amdgcn_s_sleep(2);
            }
            __builtin_amdgcn_fence(__ATOMIC_ACQUIRE, "agent");
            if (lane == 0) flag[0] = dead ? 1u : 0u;
        }
        asm volatile("s_waitcnt vmcnt(0) lgkmcnt(0)" ::: "memory"); __builtin_amdgcn_s_barrier(); asm volatile("" ::: "memory");
        const bool bad = flag[0] != 0u;
        if (lane < 32) {
            const unsigned long long* slot = (const unsigned long long*)xbuf + (size_t)(u.pm * BM + row) * 4; float mt[4], m2[4]; float ms = 0.f;
#pragma unroll
            for (int t = 0; t < 4; ++t) { if (t < ntn) { const unsigned long long w = __hip_atomic_load(slot + t, __ATOMIC_RELAXED, __HIP_MEMORY_SCOPE_AGENT); mt[t] = __uint_as_float((unsigned)w); m2[t] = __uint_as_float((unsigned)(w >> 32)); } else { mt[t] = 0.f; m2[t] = 0.f; } ms += mt[t]; }
            const float mean = ms / (float)ntn; float q = 0.f;
#pragma unroll
            for (int t = 0; t < 4; ++t) if (t < ntn) { const float dm = mt[t] - mean; q += m2[t] + 256.0f * dm * dm; }
            S[row] = (f32x2v){mean, 1.0f / sqrtf(q / (256.0f * (float)ntn) + eps)};
        }
        asm volatile("s_waitcnt lgkmcnt(0)" ::: "memory"); __builtin_amdgcn_s_barrier(); asm volatile("" ::: "memory");
        return bad;
    }
};
struct EpiLnRes {
    static constexpr bool PERM = false, AFTER_DRAIN = true;
    const float* base; float* out; int ldc; const float* bias; PanelStats st; unsigned poison;
    __device__ __forceinline__ void fused(f32x4 (&acc)[2][2][4][2], const Unit& u, int wr, int wc, int fr, int fq, PG8_LAS unsigned char* lds, int wid, int lane) const {
        typedef float f32x2v __attribute__((ext_vector_type(2)));
        const PG8_LAS f32x2v* S = (const PG8_LAS f32x2v*)(lds + 8192);
        const int col0 = u.pn * BM + wc * 32 + 4 * fq;
#pragma unroll
        for (int bj = 0; bj < 2; ++bj)
#pragma unroll
            for (int n = 0; n < 2; ++n) { const f32x4 bv = bias ? *(const f32x4*)(bias + col0 + bj * HALF + n * 16) : (f32x4){0.f, 0.f, 0.f, 0.f};
#pragma unroll
                for (int ai = 0; ai < 2; ++ai)
#pragma unroll
                    for (int m = 0; m < 4; ++m) acc[ai][bj][m][n] += bv; }
        f32x4 pre[4][2][2];
#pragma unroll
        for (int m = 0; m < 4; ++m) { const size_t off = (size_t)(u.pm * BM + wr * 64 + m * 16 + fr) * ldc + col0;
#pragma unroll
            for (int bj = 0; bj < 2; ++bj)
#pragma unroll
                for (int n = 0; n < 2; ++n) pre[m][bj][n] = *(const f32x4*)(base + off + bj * HALF + n * 16); }
        const bool bad = st.run(acc, u, wr, wc, fr, fq, lds, wid, lane) || poison != 0u;
        const float qnan = __builtin_nanf("");
#pragma unroll
        for (int ai = 0; ai < 2; ++ai)
#pragma unroll
            for (int m = 0; m < 4; ++m) { const int r = ai * HALF + wr * 64 + m * 16 + fr; const f32x2v sr = S[r]; const size_t off = (size_t)(u.pm * BM + r) * ldc + col0;
#pragma unroll
                for (int bj = 0; bj < 2; ++bj)
#pragma unroll
                    for (int n = 0; n < 2; ++n) { const f32x4 bs = ai == 0 ? pre[m][bj][n] : *(const f32x4*)(base + off + bj * HALF + n * 16); f32x4 o = bs + (acc[ai][bj][m][n] - sr.x) * sr.y;
                        if (bad) o = (f32x4){qnan, qnan, qnan, qnan}; *(f32x4*)(out + off + bj * HALF + n * 16) = o; }
                if (m & 1) asm volatile("" ::: "memory"); }
    }
};
struct EpiLnResLn {
    static constexpr bool PERM = false, AFTER_DRAIN = true;
    const float* base; float* out; bf16_t* xn; int ldc; const float* bias; PanelStats st1, st2; unsigned poison;
    __device__ __forceinline__ void fused(f32x4 (&acc)[2][2][4][2], const Unit& u, int wr, int wc, int fr, int fq, PG8_LAS unsigned char* lds, int wid, int lane) const {
        typedef float f32x2v __attribute__((ext_vector_type(2))); typedef unsigned u32x2v __attribute__((ext_vector_type(2)));
        const PG8_LAS f32x2v* S = (const PG8_LAS f32x2v*)(lds + 8192);
        const int col0 = u.pn * BM + wc * 32 + 4 * fq;
#pragma unroll
        for (int bj = 0; bj < 2; ++bj)
#pragma unroll
            for (int n = 0; n < 2; ++n) { const f32x4 bv = bias ? *(const f32x4*)(bias + col0 + bj * HALF + n * 16) : (f32x4){0.f, 0.f, 0.f, 0.f};
#pragma unroll
                for (int ai = 0; ai < 2; ++ai)
#pragma unroll
                    for (int m = 0; m < 4; ++m) acc[ai][bj][m][n] += bv; }
        bool bad = st1.run(acc, u, wr, wc, fr, fq, lds, wid, lane) || poison != 0u;
        const float qnan = __builtin_nanf("");
#pragma unroll
        for (int ai = 0; ai < 2; ++ai)
#pragma unroll
            for (int m = 0; m < 4; ++m) { const int r = ai * HALF + wr * 64 + m * 16 + fr; const f32x2v sr = S[r]; const size_t off = (size_t)(u.pm * BM + r) * ldc + col0;
#pragma unroll
                for (int bj = 0; bj < 2; ++bj)
#pragma unroll
                    for (int n = 0; n < 2; ++n) { const f32x4 bs = *(const f32x4*)(base + off + bj * HALF + n * 16); acc[ai][bj][m][n] = bs + (acc[ai][bj][m][n] - sr.x) * sr.y; }
                asm volatile("" : "+v"(acc[ai][0][m][0]), "+v"(acc[ai][0][m][1]), "+v"(acc[ai][1][m][0]), "+v"(acc[ai][1][m][1]));
                if (m & 1) asm volatile("" ::: "memory"); }
        const bool bad1 = bad;
        bad = st2.run(acc, u, wr, wc, fr, fq, lds, wid, lane) || bad;
#pragma unroll
        for (int ai = 0; ai < 2; ++ai)
#pragma unroll
            for (int m = 0; m < 4; ++m) { const int r = ai * HALF + wr * 64 + m * 16 + fr; const f32x2v sr = S[r]; const size_t off = (size_t)(u.pm * BM + r) * ldc + col0;
#pragma unroll
                for (int bj = 0; bj < 2; ++bj)
#pragma unroll
                    for (int n = 0; n < 2; ++n) { const f32x4 x1 = acc[ai][bj][m][n]; *(f32x4*)(out + off + bj * HALF + n * 16) = bad1 ? (f32x4){qnan, qnan, qnan, qnan} : x1;
                        const f32x4 o = (x1 - sr.x) * sr.y; u32x2v w; w.x = cvt_pk_bf16(o[0], o[1]); w.y = cvt_pk_bf16(o[2], o[3]);
                        if (bad) { w.x = 0x7fc07fc0u; w.y = 0x7fc07fc0u; } *(u32x2v*)(xn + off + bj * HALF + n * 16) = w; }
                asm volatile("" ::: "memory"); }
    }
};

template <class Epi, class Sched, bool ALIGN_EPI = false, bool SP2 = false, int AROW = 0>
__device__ __forceinline__ void gemm_phase(PG8_LAS unsigned char* lds, const Gemm g, const Sched& S, const Epi& E) {
    int tid_ = threadIdx.x; asm volatile("" : "+v"(tid_));
    const int tid = tid_, wid = __builtin_amdgcn_readfirstlane(tid >> 6), lane = tid & 63, wr = wid >> 2, wc = wid & 3, fr = lane & 15, fq = lane >> 4;
    const int K = g.K, nt = K / BK;
    unsigned voffA[2], voffB[2];
#pragma unroll
    for (int i = 0; i < 2; ++i) { int R, C; stage_rc(tid * 16 + i * 8192, R, C); const int Rb = Epi::PERM ? ((R & ~31) + perm32(R & 31)) : R;
        const int Ra = (AROW == 1) ? ((R & ~63) + 4 * (R & 15) + ((R >> 4) & 3)) : R;
        voffA[i] = (unsigned)(Ra * g.lda + C) * 2u; voffB[i] = (unsigned)(Rb * K + C) * 2u;
        if (AROW == 2) { const int tp = 4 * ((lane >> 2) & 3) + (lane >> 4), c = lane & 3;
            voffA[i] = (unsigned)((64 * i + 16 * (wid & 3) + tp) * g.lda + 32 * (wid >> 2) + 8 * c) * 2u; } }
    const size_t kstep = (size_t)(BK * 2);
    const size_t hstep = (size_t)HALF * K * 2;
    const size_t tstep = 2 * hstep;
    const size_t hstepA = (size_t)HALF * g.lda * 2, tstepA = 2 * hstepA;
    const unsigned ldsw = (unsigned)wid * 1024u;
    constexpr int PSTR = 1056, HTBA = (AROW == 2) ? 16 * PSTR : HTB;
    const int aoff = (AROW == 2) ? (wr * 8 + (fr >> 2)) * PSTR + 64 * (fr & 3) + 16 * fq : lds_byte(wr * 64 + fr, fq * 8), boff = lds_byte(wc * 32 + fr, fq * 8);
    constexpr int AM = (AROW == 2) ? 256 : 2048, AK = (AROW == 2) ? 4 * PSTR : 1024;
    const unsigned ldswA = (AROW == 2) ? (unsigned)wid * PSTR : (unsigned)wid * 1024u; constexpr unsigned ISTRA = (AROW == 2) ? 8u * PSTR : 8192u;
#define PG8_SA(b, h) (((b) * 2 + (h)) * HTBA)
#define PG8_SB(b, h) (4 * HTBA + ((b) * 2 + (h)) * HTB)
#define PG8_STAGEA(bufoff, gbase, voff) do { _Pragma("unroll") for (int _i = 0; _i < 2; ++_i) \
        __builtin_amdgcn_global_load_lds((const unsigned*)((const char*)(gbase) + (voff)[_i]), (PG8_LAS unsigned*)(lds + (bufoff) + ldswA + _i * ISTRA), 16, 0, 0); } while (0)
#define PG8_STAGE(bufoff, gbase, voff) do { _Pragma("unroll") for (int _i = 0; _i < 2; ++_i) \
        __builtin_amdgcn_global_load_lds((const unsigned*)((const char*)(gbase) + (voff)[_i]), (PG8_LAS unsigned*)(lds + (bufoff) + ldsw + _i * 8192), 16, 0, 0); } while (0)
#define PG8_LDA(dst, b, h) do { _Pragma("unroll") for (int m = 0; m < 4; ++m) _Pragma("unroll") for (int k = 0; k < 2; ++k) dst[m][k] = *(const PG8_LAS bf16x8*)(lds + PG8_SA(b, h) + aoff + m * AM + k * AK); } while (0)
#define PG8_LDB(dst, b, h) do { _Pragma("unroll") for (int n = 0; n < 2; ++n) _Pragma("unroll") for (int k = 0; k < 2; ++k) dst[n][k] = *(const PG8_LAS bf16x8*)(lds + PG8_SB(b, h) + boff + n * 2048 + k * 1024); } while (0)
#define PG8_MMA(ai, bj, At, Bt) do { __builtin_amdgcn_s_setprio(1); _Pragma("unroll") for (int m = 0; m < 4; ++m) _Pragma("unroll") for (int n = 0; n < 2; ++n) _Pragma("unroll") for (int k = 0; k < 2; ++k) \
        acc[ai][bj][m][n] = __builtin_amdgcn_mfma_f32_16x16x32_bf16(Bt[n][k], At[m][k], acc[ai][bj][m][n], 0, 0, 0); __builtin_amdgcn_s_setprio(0); } while (0)
#define PG8_WAIT_V(n) asm volatile("s_waitcnt vmcnt(" #n ")" ::: "memory")
#define PG8_WAIT_L(n) asm volatile("s_waitcnt lgkmcnt(" #n ")" ::: "memory")
#define PG8_BAR __builtin_amdgcn_s_barrier()
#define PG8_SCHED __builtin_amdgcn_sched_barrier(0)
    Unit cur, nxt; int ui = 0;
    if (!S.next(0, cur)) return;
    f32x4 acc[2][2][4][2];
#pragma unroll
    for (int a = 0; a < 2; ++a)
#pragma unroll
        for (int b = 0; b < 2; ++b)
#pragma unroll
            for (int m = 0; m < 4; ++m)
#pragma unroll
                for (int n = 0; n < 2; ++n) acc[a][b][m][n] = (f32x4){0.f, 0.f, 0.f, 0.f};
    bf16x8 At[4][2], B0[2][2], B1[2][2];
    const char* cA = (const char*)g.A + (size_t)cur.pm * tstepA; const char* cB = (const char*)g.Bt + (size_t)cur.pn * tstep;
    S.a_ready(cur);
    if constexpr (SP2) {
        PG8_STAGE(PG8_SB(0, 0), cB, voffB); PG8_STAGE(PG8_SB(0, 1), cB + hstep, voffB); PG8_STAGEA(PG8_SA(0, 0), cA, voffA); PG8_STAGEA(PG8_SA(0, 1), cA + hstepA, voffA);
        if (wr == 1) PG8_BAR;
        PG8_WAIT_V(2); PG8_BAR;
        PG8_STAGE(PG8_SB(1, 0), cB + kstep, voffB); PG8_STAGEA(PG8_SA(1, 0), cA + kstep, voffA); PG8_STAGE(PG8_SB(1, 1), cB + hstep + kstep, voffB);
        PG8_WAIT_V(6); PG8_BAR;
    } else {
        PG8_STAGE(PG8_SB(0, 0), cB, voffB); PG8_STAGEA(PG8_SA(0, 0), cA, voffA); PG8_STAGE(PG8_SB(0, 1), cB + hstep, voffB); PG8_STAGEA(PG8_SA(0, 1), cA + hstepA, voffA);
        if (wr == 1) PG8_BAR;
        PG8_WAIT_V(4); PG8_BAR;
        PG8_STAGE(PG8_SB(1, 0), cB + kstep, voffB); PG8_STAGEA(PG8_SA(1, 0), cA + kstep, voffA); PG8_STAGE(PG8_SB(1, 1), cB + hstep + kstep, voffB);
        PG8_WAIT_V(6); PG8_BAR;
    }
    for (;;) {
        const bool has_next = S.next(ui + 1, nxt);
        const char* nA = has_next ? (const char*)g.A + (size_t)nxt.pm * tstepA : cA; const char* nB = has_next ? (const char*)g.Bt + (size_t)nxt.pn * tstep : cB;
#pragma unroll 1
        for (int t = 0; t < nt; t += 2) {
            const bool last = (t == nt - 2);
            const char* a1 = cA + (size_t)(t + 1) * kstep;
            const char* a2 = last ? nA : cA + (size_t)(t + 2) * kstep; const char* b2 = last ? nB : cB + (size_t)(t + 2) * kstep;
            const char* a3 = a2 + kstep; const char* b3 = b2 + kstep;
            if (last && has_next) S.a_ready(nxt);
            if constexpr (SP2) {
            PG8_LDB(B0, 0, 0); PG8_LDB(B1, 0, 1); PG8_SCHED; PG8_LDA(At, 0, 0); PG8_STAGEA(PG8_SA(1, 1), a1 + hstepA, voffA);
            PG8_WAIT_V(8); PG8_WAIT_L(0); PG8_BAR; PG8_MMA(0, 0, At, B0); PG8_MMA(0, 1, At, B1); PG8_BAR; PG8_SCHED;
            PG8_LDA(At, 0, 1); PG8_STAGE(PG8_SB(0, 0), b2, voffB); PG8_STAGE(PG8_SB(0, 1), b2 + hstep, voffB); PG8_STAGEA(PG8_SA(0, 0), a2, voffA);
            PG8_WAIT_V(8); PG8_WAIT_L(0); PG8_BAR; PG8_MMA(1, 0, At, B0); PG8_MMA(1, 1, At, B1); PG8_BAR; PG8_SCHED;
            PG8_LDB(B0, 1, 0); PG8_LDB(B1, 1, 1); PG8_SCHED; PG8_LDA(At, 1, 0); PG8_STAGEA(PG8_SA(0, 1), a2 + hstepA, voffA);
            PG8_WAIT_V(8); PG8_WAIT_L(0); PG8_BAR; PG8_MMA(0, 0, At, B0); PG8_MMA(0, 1, At, B1); PG8_BAR; PG8_SCHED;
            PG8_LDA(At, 1, 1); PG8_STAGE(PG8_SB(1, 0), b3, voffB); PG8_STAGE(PG8_SB(1, 1), b3 + hstep, voffB); PG8_STAGEA(PG8_SA(1, 0), a3, voffA);
            PG8_WAIT_V(8); PG8_WAIT_L(0); PG8_BAR; PG8_MMA(1, 0, At, B0); PG8_MMA(1, 1, At, B1); PG8_BAR; PG8_SCHED;
            } else {
            PG8_LDB(B0, 0, 0); PG8_SCHED; PG8_LDA(At, 0, 0); PG8_STAGEA(PG8_SA(1, 1), a1 + hstepA, voffA);
            PG8_WAIT_L(8); PG8_BAR; PG8_WAIT_L(0); PG8_MMA(0, 0, At, B0); PG8_BAR; PG8_SCHED;
            PG8_LDB(B1, 0, 1); PG8_STAGE(PG8_SB(0, 0), b2, voffB);
            PG8_BAR; PG8_WAIT_L(0); PG8_MMA(0, 1, At, B1); PG8_BAR;
            PG8_LDA(At, 0, 1); PG8_STAGEA(PG8_SA(0, 0), a2, voffA);
            PG8_BAR; PG8_WAIT_L(0); PG8_MMA(1, 0, At, B0); PG8_BAR; PG8_SCHED;
            PG8_STAGE(PG8_SB(0, 1), b2 + hstep, voffB);
            PG8_WAIT_V(6); PG8_BAR; PG8_MMA(1, 1, At, B1); PG8_BAR;
            PG8_LDB(B0, 1, 0); PG8_SCHED; PG8_LDA(At, 1, 0); PG8_STAGEA(PG8_SA(0, 1), a2 + hstepA, voffA);
            PG8_WAIT_L(8); PG8_BAR; PG8_WAIT_L(0); PG8_MMA(0, 0, At, B0); PG8_BAR; PG8_SCHED;
            PG8_LDB(B1, 1, 1); PG8_STAGE(PG8_SB(1, 0), b3, voffB);
            PG8_BAR; PG8_WAIT_L(0); PG8_MMA(0, 1, At, B1); PG8_BAR;
            PG8_LDA(At, 1, 1); PG8_STAGEA(PG8_SA(1, 0), a3, voffA);
            PG8_BAR; PG8_WAIT_L(0); PG8_MMA(1, 0, At, B0); PG8_BAR; PG8_SCHED;
            PG8_STAGE(PG8_SB(1, 1), b3 + hstep, voffB);
            PG8_WAIT_V(6); PG8_BAR; PG8_MMA(1, 1, At, B1); PG8_BAR;
            }
        }
        if constexpr (ALIGN_EPI) { if (wr == 0) PG8_BAR; }
        if constexpr (!Epi::AFTER_DRAIN) { E(acc, cur, wr, wc, fr, fq); S.done(cur); }
        if (!has_next) break;
#pragma unroll
        for (int a = 0; a < 2; ++a)
#pragma unroll
            for (int b = 0; b < 2; ++b)
#pragma unroll
                for (int m = 0; m < 4; ++m)
#pragma unroll
                    for (int n = 0; n < 2; ++n) acc[a][b][m][n] = (f32x4){0.f, 0.f, 0.f, 0.f};
        cur = nxt; cA = nA; cB = nB; ++ui;
        if constexpr (ALIGN_EPI) { if (wr == 1) PG8_BAR; }
    }
    PG8_WAIT_V(0);
    if constexpr (!ALIGN_EPI) { if (wr == 0) PG8_BAR; }
    PG8_BAR;
    if constexpr (Epi::AFTER_DRAIN) { E.fused(acc, cur, wr, wc, fr, fq, lds, wid, lane); S.done(cur); }
#undef PG8_SA
#undef PG8_SB
#undef PG8_STAGE
#undef PG8_STAGEA
#undef PG8_LDA
#undef PG8_LDB
#undef PG8_MMA
#undef PG8_WAIT_V
#undef PG8_WAIT_L
#undef PG8_BAR
#undef PG8_SCHED
}
}

#ifndef PG8_SP2
#define PG8_SP2 true
#endif
#ifndef PG8_ALIGN
#define PG8_ALIGN true
#endif
#define GAS __attribute__((address_space(1)))
#define LAS __attribute__((address_space(3)))
typedef unsigned short bf16;
typedef unsigned v4u __attribute__((ext_vector_type(4)));
typedef float f32x4 __attribute__((ext_vector_type(4)));
typedef short bf16x8 __attribute__((ext_vector_type(8)));
typedef GAS unsigned gu32;
typedef GAS unsigned long long gu64;
#define RLX_AGENT __ATOMIC_RELAXED, __HIP_MEMORY_SCOPE_AGENT
#define LDS_WAIT() asm volatile("s_waitcnt lgkmcnt(0)" ::: "memory")
#define VM_WAIT() asm volatile("s_waitcnt vmcnt(0)" ::: "memory")
__device__ __forceinline__ unsigned long long rt() { return __builtin_amdgcn_s_memrealtime(); }
__device__ __forceinline__ unsigned f2bf(float f) { unsigned u = __builtin_bit_cast(unsigned, f); return (u + 0x7fffu + ((u >> 16) & 1u)) >> 16; }
typedef float pk_f32x2_t __attribute__((ext_vector_type(2))); typedef __bf16 pk_bf16x2_t __attribute__((ext_vector_type(2)));
__device__ __forceinline__ unsigned pk2(float lo, float hi) { pk_f32x2_t v = {lo, hi}; pk_bf16x2_t b = __builtin_convertvector(v, pk_bf16x2_t); return __builtin_bit_cast(unsigned, b); }

#define XB_TMO      128
#define XB_XCNT(j)  (256  + 64 * (j))
#define XB_XSUB(j)  (1280 + 64 * (j))
#define XB_XGEN(j)  (2304 + 64 * (j))
#define XB_TOP      3328
#define XB_TOPGEN   3392
#define XCD_BAR_WORDS 3456
#define XB_SPIN_CAP (1u << 18)

__device__ __forceinline__ unsigned xb_ld(unsigned* p)              { return __hip_atomic_load(p, __ATOMIC_RELAXED, __HIP_MEMORY_SCOPE_AGENT); }
__device__ __forceinline__ unsigned xb_add(unsigned* p, unsigned v) { return __hip_atomic_fetch_add(p, v, __ATOMIC_RELAXED, __HIP_MEMORY_SCOPE_AGENT); }
__device__ __forceinline__ unsigned xb_xcc_id() { return (unsigned)__builtin_amdgcn_s_getreg((3 << 11) | 20) & 0xFu; }
#define XB_SPIN(cond, bar) do { unsigned _sp = 0; while (cond) { __builtin_amdgcn_s_sleep(1); \
    if ((++_sp & 255u) == 0u) { if (xb_ld(&(bar)[XB_TMO])) break; if (_sp > XB_SPIN_CAP) { atomicAdd(&(bar)[XB_TMO], 1u); break; } } } } while (0)

struct XcdBarrier {
    unsigned* bar; unsigned x;
    volatile LAS unsigned* st;
};

__device__ __forceinline__ XcdBarrier xcd_barrier_post(unsigned* bar, volatile LAS unsigned* st) {
    XcdBarrier b; b.bar = bar; b.x = xb_xcc_id(); b.st = st;
    if (threadIdx.x == 0) (void)xb_add(&bar[XB_XCNT(b.x)], 1u);
    return b;
}
__device__ __forceinline__ void xcd_barrier_complete(unsigned* bar, unsigned x, unsigned& nloc, unsigned& nx) {
    const unsigned G = gridDim.x * gridDim.y * gridDim.z;
    unsigned sum, cnt, mine, sp = 0u;
    for (;;) {
        sum = 0u; cnt = 0u; mine = 0u;
#pragma unroll
        for (unsigned j = 0; j < 16; ++j) { const unsigned c = xb_ld(&bar[XB_XCNT(j)]); sum += c; cnt += (c > 0u) ? 1u : 0u; mine = (j == x) ? c : mine; }
        if (sum == G) break;
        __builtin_amdgcn_s_sleep(1);
        if ((++sp & 255u) == 0u) { if (xb_ld(&bar[XB_TMO])) break; if (sp > XB_SPIN_CAP) { atomicAdd(&bar[XB_TMO], 1u); break; } }
    }
    nloc = mine > 0u ? mine : 1u; nx = cnt > 0u ? cnt : 1u;
}

__device__ __forceinline__ void xcd_barrier(const XcdBarrier& b) {
    asm volatile("s_waitcnt vmcnt(0)" ::: "memory");
    __syncthreads();
    if (threadIdx.x == 0) {
        unsigned* bar = b.bar;
        __builtin_amdgcn_s_waitcnt(0);
        unsigned nloc = b.st[0], nx = b.st[1];
        if (nloc == 0u) { xcd_barrier_complete(bar, b.x, nloc, nx); b.st[0] = nloc; b.st[1] = nx; }
        const unsigned old = xb_add(&bar[XB_XSUB(b.x)], 1u);
        const unsigned gen = old / nloc;
        if (old + 1u == (gen + 1u) * nloc) {
            __builtin_amdgcn_fence(__ATOMIC_RELEASE, "agent");
            asm volatile("s_waitcnt vmcnt(0)" ::: "memory");
            const unsigned og = xb_add(&bar[XB_TOP], 1u);
            const unsigned tg = og / nx;
            if (og + 1u == (tg + 1u) * nx) xb_add(&bar[XB_TOPGEN], 1u);
            else XB_SPIN(xb_ld(&bar[XB_TOPGEN]) == tg, bar);
            __builtin_amdgcn_fence(__ATOMIC_ACQUIRE, "agent");
            xb_add(&bar[XB_XGEN(b.x)], 1u);
            asm volatile("s_waitcnt vmcnt(0)" ::: "memory");
        } else {
            XB_SPIN(xb_ld(&bar[XB_XGEN(b.x)]) == gen, bar);
            __builtin_amdgcn_fence(__ATOMIC_ACQUIRE, "agent");
            asm volatile("s_waitcnt vmcnt(0)" ::: "memory");
        }
    }
    __syncthreads();
}
__device__ __forceinline__ float bf2f(bf16 v) { return __builtin_bit_cast(float, (unsigned)v << 16); }
__device__ __forceinline__ float bflo(unsigned w) { return __builtin_bit_cast(float, w << 16); }
__device__ __forceinline__ float bfhi(unsigned w) { return __builtin_bit_cast(float, w & 0xffff0000u); }
__device__ __forceinline__ float silu_f(float v) { return v / (1.f + __expf(-v)); }
__device__ __forceinline__ float wave_sum(float v) {
#pragma unroll
    for (int o = 1; o < 64; o <<= 1) v += __shfl_xor(v, o);
    return v;
}


namespace at2 {
typedef short bf16x8 __attribute__((ext_vector_type(8)));
typedef short s16x4 __attribute__((ext_vector_type(4)));
typedef float f32x16 __attribute__((ext_vector_type(16)));
typedef unsigned u32x4 __attribute__((ext_vector_type(4)));
typedef float f32x2_t __attribute__((ext_vector_type(2))); typedef __bf16 bf16x2_t __attribute__((ext_vector_type(2)));
#define AT_LAS __attribute__((address_space(3)))
__device__ __forceinline__ int crow(int r, int hi) { return (r & 3) + 8 * (r >> 2) + 4 * hi; }
__device__ __forceinline__ void glds16(const void* gsrc, unsigned lds_dst) { unsigned keep;
    asm volatile("s_mov_b32 %0, m0\n\ts_mov_b32 m0, %2\n\ts_nop 0\n\tglobal_load_lds_dwordx4 %1, off\n\ts_mov_b32 m0, %0" : "=&s"(keep) : "v"(gsrc), "s"(lds_dst) : "memory"); }
__device__ __forceinline__ unsigned cvtpk(float lo, float hi) { f32x2_t v = {lo, hi}; bf16x2_t b = __builtin_convertvector(v, bf16x2_t); return __builtin_bit_cast(unsigned, b); }
__device__ __forceinline__ float swap_max(float m) { auto rr = __builtin_amdgcn_permlane32_swap(__float_as_uint(m), __float_as_uint(m), false, false); float r; asm("v_max_f32_e32 %0, %1, %2" : "=v"(r) : "v"(__uint_as_float(rr[0])), "v"(__uint_as_float(rr[1]))); return r; }
__device__ __forceinline__ float swap_sum(float m) { auto rr = __builtin_amdgcn_permlane32_swap(__float_as_uint(m), __float_as_uint(m), false, false); return __uint_as_float(rr[0]) + __uint_as_float(rr[1]); }

__device__ __forceinline__ float max3f(float a, float b, float c) { float r; asm("v_max3_f32 %0, %1, %2, %3" : "=v"(r) : "v"(a), "v"(b), "v"(c)); return r; }
__device__ __forceinline__ float max2f(float a, float b) { float r; asm("v_max_f32_e32 %0, %1, %2" : "=v"(r) : "v"(a), "v"(b)); return r; }
constexpr float NEGM = -1e30f;
constexpr float THR = 8.0f;

struct Tensors { const unsigned short* Q; const unsigned short* K; const unsigned short* V; unsigned short* O; int pq, pk, pv, po; };

__device__ __forceinline__ void pv(f32x16* o, int vb, bf16x8 pa0, bf16x8 pa1, bf16x8 pa2, bf16x8 pa3) {
#pragma unroll
    for (int d0 = 0; d0 < 2; ++d0) { s16x4 lo[4], hi[4];
#pragma unroll
        for (int ks = 0; ks < 4; ++ks) {
            asm volatile("ds_read_b64_tr_b16 %0,%1 offset:%c2" : "=&v"(lo[ks]) : "v"(vb), "i"(d0 * 4096 + ks * 1024) : "memory");
            asm volatile("ds_read_b64_tr_b16 %0,%1 offset:%c2" : "=&v"(hi[ks]) : "v"(vb), "i"(d0 * 4096 + ks * 1024 + 512) : "memory"); }
        asm volatile("s_waitcnt lgkmcnt(0)" ::: "memory"); __builtin_amdgcn_sched_barrier(0);
#define AT_PK(k) (bf16x8){lo[k][0], lo[k][1], lo[k][2], lo[k][3], hi[k][0], hi[k][1], hi[k][2], hi[k][3]}
        o[d0] = __builtin_amdgcn_mfma_f32_32x32x16_bf16(pa0, AT_PK(0), o[d0], 0, 0, 0);
        o[d0] = __builtin_amdgcn_mfma_f32_32x32x16_bf16(pa1, AT_PK(1), o[d0], 0, 0, 0);
        o[d0] = __builtin_amdgcn_mfma_f32_32x32x16_bf16(pa2, AT_PK(2), o[d0], 0, 0, 0);
        o[d0] = __builtin_amdgcn_mfma_f32_32x32x16_bf16(pa3, AT_PK(3), o[d0], 0, 0, 0);
#undef AT_PK
    }
}

typedef short v4i16_t __attribute__((ext_vector_type(4)));
__device__ __forceinline__ s16x4 vtr(const AT_LAS unsigned char* p) { return __builtin_bit_cast(s16x4, __builtin_amdgcn_ds_read_tr16_b64_v4i16((AT_LAS v4i16_t*)p)); }
__device__ __forceinline__ void pv2(f32x16* o, const AT_LAS unsigned char* vp, bf16x8 pa0, bf16x8 pa1, bf16x8 pa2, bf16x8 pa3) {
#pragma unroll
    for (int d0 = 0; d0 < 2; ++d0) { s16x4 lo[4], hi[4];
#pragma unroll
        for (int ks = 0; ks < 4; ++ks) { lo[ks] = vtr(vp + d0 * 4096 + ks * 1024); hi[ks] = vtr(vp + d0 * 4096 + ks * 1024 + 512); }
#define AT_PK(k) (bf16x8){lo[k][0], lo[k][1], lo[k][2], lo[k][3], hi[k][0], hi[k][1], hi[k][2], hi[k][3]}
        o[d0] = __builtin_amdgcn_mfma_f32_32x32x16_bf16(pa0, AT_PK(0), o[d0], 0, 0, 0);
        o[d0] = __builtin_amdgcn_mfma_f32_32x32x16_bf16(pa1, AT_PK(1), o[d0], 0, 0, 0);
        o[d0] = __builtin_amdgcn_mfma_f32_32x32x16_bf16(pa2, AT_PK(2), o[d0], 0, 0, 0);
        o[d0] = __builtin_amdgcn_mfma_f32_32x32x16_bf16(pa3, AT_PK(3), o[d0], 0, 0, 0);
#undef AT_PK
    }
}

template <int DQ, bool MOBA, bool QNORM, int G>
__device__ __forceinline__ void attn_unit(AT_LAS unsigned char* lds, const Tensors& T, long rowbase, int qb, const float* km, const float* qg, const float* tab) {
    constexpr int NKP = DQ / 8, NP = NKP + 8, SLOTB = NKP * 1024 + 8192, ND0 = DQ / 16;
    constexpr int NSLOT = 3 * G, LDS_WS = NSLOT * SLOTB, LDS_OST = 0;
    int tid_ = threadIdx.x; asm volatile("" : "+v"(tid_));
    const int tid = tid_, lane = tid & 63, r32 = lane & 31, hi = lane >> 5; const int wid = __builtin_amdgcn_readfirstlane(tid >> 6);
    const int q0 = qb * 256, NT = 4 * (qb + 1);
    const unsigned lds0 = (unsigned)(size_t)lds;
    AT_LAS float* wsf = (AT_LAS float*)(lds + LDS_WS) + wid * 64;
    asm volatile("s_waitcnt vmcnt(0)" ::: "memory");
    const unsigned short* src[3]; unsigned dsto[3];
#pragma unroll
    for (int k = 0; k < 3; ++k) { const int pi = wid + 8 * k;
        if (pi < NKP) { src[k] = (T.pk == 0) ? T.K + pi * 512 + lane * 8 : T.K + (rowbase + lane) * T.pk + 8 * pi; dsto[k] = pi * 1024; }
        else { const int v = pi - NKP; src[k] = (T.pv == 0) ? T.V + v * 512 + lane * 8 : T.V + (rowbase + 16 * (v & 3) + (lane >> 2)) * T.pv + 32 * (v >> 2) + 8 * (lane & 3); dsto[k] = NKP * 1024 + v * 1024; } }
    const long kstep = (T.pk == 0) ? (long)NKP * 512 : (long)64 * T.pk, vstep = (T.pv == 0) ? (long)4096 : (long)64 * T.pv;
#define AT_DMA(t, slot) do { _Pragma("unroll") for (int k_ = 0; k_ < 3; ++k_) { const int pi_ = wid + 8 * k_; if (pi_ < NP) { \
        const unsigned short* s_ = src[k_] + (long)(t) * ((pi_ < NKP) ? kstep : vstep); glds16(s_, (unsigned)__builtin_amdgcn_readfirstlane(lds0 + (slot) * SLOTB + dsto[k_])); } } } while (0)
    _Pragma("unroll") for (int i_ = 0; i_ < G; ++i_) AT_DMA(i_, i_);
    __builtin_amdgcn_sched_barrier(0);
    bf16x8 qr[ND0];
    { const unsigned short* Qw = T.Q + (rowbase + q0 + wid * 32 + r32) * T.pq + hi * 8;
#pragma unroll
      for (int d0 = 0; d0 < ND0; ++d0) qr[d0] = *(const bf16x8*)(Qw + d0 * 16); }
    __builtin_amdgcn_sched_barrier(0);
    if constexpr (QNORM) {
        float s = 0.f;
#pragma unroll
        for (int d0 = 0; d0 < ND0; ++d0)
#pragma unroll
            for (int j = 0; j < 8; ++j) { const float x = bf2f((unsigned short)qr[d0][j]); s += x * x; }
        s = swap_sum(s);
        const float rstd = 0.14724445073472677f / sqrtf(s * (1.f / 96.f) + 1e-6f);
#pragma unroll
        for (int d0 = 0; d0 < 4; ++d0) { const f32x4 g0 = *(const f32x4*)(qg + d0 * 16 + hi * 8), g1 = *(const f32x4*)(qg + d0 * 16 + hi * 8 + 4); u32x4 w;
            w.x = cvtpk(bf2f((unsigned short)qr[d0][0]) * rstd * g0.x, bf2f((unsigned short)qr[d0][1]) * rstd * g0.y); w.y = cvtpk(bf2f((unsigned short)qr[d0][2]) * rstd * g0.z, bf2f((unsigned short)qr[d0][3]) * rstd * g0.w);
            w.z = cvtpk(bf2f((unsigned short)qr[d0][4]) * rstd * g1.x, bf2f((unsigned short)qr[d0][5]) * rstd * g1.y); w.w = cvtpk(bf2f((unsigned short)qr[d0][6]) * rstd * g1.z, bf2f((unsigned short)qr[d0][7]) * rstd * g1.w);
            qr[d0] = __builtin_bit_cast(bf16x8, w); asm volatile("" : "+v"(qr[d0])); }
        { const int pos = q0 + wid * 32 + r32; const float* tb = tab + (pos * 16 + hi * 8) * 2; const float* ga = qg + 64 + hi * 8; const float* gb = qg + 80 + hi * 8; float oa[8], ob[8];
#pragma unroll
          for (int j = 0; j < 8; ++j) { const float x1 = bf2f((unsigned short)qr[4][j]) * rstd * ga[j], x2 = bf2f((unsigned short)qr[5][j]) * rstd * gb[j]; const float c = tb[2 * j], sn = tb[2 * j + 1]; oa[j] = x1 * c - x2 * sn; ob[j] = x1 * sn + x2 * c; }
          u32x4 w; w.x = cvtpk(oa[0], oa[1]); w.y = cvtpk(oa[2], oa[3]); w.z = cvtpk(oa[4], oa[5]); w.w = cvtpk(oa[6], oa[7]); qr[4] = __builtin_bit_cast(bf16x8, w);
          w.x = cvtpk(ob[0], ob[1]); w.y = cvtpk(ob[2], ob[3]); w.z = cvtpk(ob[4], ob[5]); w.w = cvtpk(ob[6], ob[7]); qr[5] = __builtin_bit_cast(bf16x8, w); }
    }
    __builtin_amdgcn_sched_barrier(0);
    unsigned sel = 0xffffffffu;
    if (MOBA) {
        sel = 0u; float gate[8];
#pragma unroll
        for (int j = 0; j < 7; ++j) { float a = 0.f;
            if (j < qb) { const float* kj = km + j * 512 + hi * 8;
#pragma unroll
                for (int d0 = 0; d0 < ND0; ++d0) { const f32x4 k0 = *(const f32x4*)(kj + d0 * 16), k1 = *(const f32x4*)(kj + d0 * 16 + 4);
                    a += bf2f((unsigned short)qr[d0][0]) * k0.x + bf2f((unsigned short)qr[d0][1]) * k0.y + bf2f((unsigned short)qr[d0][2]) * k0.z + bf2f((unsigned short)qr[d0][3]) * k0.w
                       + bf2f((unsigned short)qr[d0][4]) * k1.x + bf2f((unsigned short)qr[d0][5]) * k1.y + bf2f((unsigned short)qr[d0][6]) * k1.z + bf2f((unsigned short)qr[d0][7]) * k1.w; } }
            a = swap_sum(a); gate[j] = (j < qb) ? a : -INFINITY; }
        gate[7] = -INFINITY;
#pragma unroll
        for (int r = 0; r < 3; ++r) { int best = -1; float bv = -INFINITY;
#pragma unroll
            for (int j = 0; j < 8; ++j) if (!((sel >> j) & 1u) && gate[j] > bv) { bv = gate[j]; best = j; }
            if (best >= 0) sel |= 1u << best; }
    }
    __builtin_amdgcn_sched_barrier(0);
    float mhat = 0.f, l = 0.f; f32x16 o[2]; o[0] = f32x16{}; o[1] = f32x16{};
    const int qrel = wid * 32 + r32;
    const int vbl = ((lane >> 4) & 1) * 32 + (lane & 3) * 8 + (4 * hi + ((lane & 15) >> 2)) * 64;
#define AT_GROUP(u) do { asm volatile("s_waitcnt vmcnt(0) lgkmcnt(0)\n\ts_barrier" ::: "memory"); \
        if ((u) + G < NT) { _Pragma("unroll") for (int i_ = 0; i_ < G; ++i_) { const int tt_ = (u) + G + i_; AT_DMA(tt_, tt_ % NSLOT); } } } while (0)
#define AT_KLOAD(sl) do { const AT_LAS unsigned char* kb = lds + (sl) * SLOTB + hi * 1024 + r32 * 16; \
        _Pragma("unroll") for (int d0 = 0; d0 < ND0; ++d0) { kf[2 * d0] = *(const AT_LAS bf16x8*)(kb + d0 * 2048); kf[2 * d0 + 1] = *(const AT_LAS bf16x8*)(kb + d0 * 2048 + 512); } } while (0)
    bf16x8 kf[2 * ND0]; s16x4 vlo[8], vhi[8];
    AT_GROUP(0);
    AT_KLOAD(0);
    int slot = 0;
    for (int t = 0; t < NT; ++t) {
        __builtin_amdgcn_sched_barrier(0);
        { const AT_LAS unsigned char* vp = lds + slot * SLOTB + NKP * 1024 + vbl;
#pragma unroll
          for (int i = 0; i < 8; ++i) { vlo[i] = vtr(vp + (i >> 2) * 4096 + (i & 3) * 1024); vhi[i] = vtr(vp + (i >> 2) * 4096 + (i & 3) * 1024 + 512); } }
        __builtin_amdgcn_sched_barrier(0);
        f32x16 p0, p1;
#pragma unroll
        for (int d0 = 0; d0 < ND0; ++d0) {
            if (d0 == 0) { p0 = __builtin_amdgcn_mfma_f32_32x32x16_bf16(kf[0], qr[0], f32x16{}, 0, 0, 0); p1 = __builtin_amdgcn_mfma_f32_32x32x16_bf16(kf[1], qr[0], f32x16{}, 0, 0, 0); }
            else { p0 = __builtin_amdgcn_mfma_f32_32x32x16_bf16(kf[2 * d0], qr[d0], p0, 0, 0, 0); p1 = __builtin_amdgcn_mfma_f32_32x32x16_bf16(kf[2 * d0 + 1], qr[d0], p1, 0, 0, 0); } }
        __builtin_amdgcn_sched_barrier(0);
        const int nslot = (slot == NSLOT - 1) ? 0 : slot + 1;
        if (t + 1 < NT) { if (((t + 1) % G) == 0) AT_GROUP(t + 1); AT_KLOAD(nslot); }
        __builtin_amdgcn_sched_barrier(0);
        const int jb = t - (NT - 4);
        if (jb >= 0) { const int kb0 = 64 * jb + 4 * hi;
#pragma unroll
            for (int r = 0; r < 16; ++r) { const int kv = kb0 + (r & 3) + 8 * (r >> 2); if (kv > qrel) p0[r] = NEGM; if (kv + 32 > qrel) p1[r] = NEGM; } }
        else if (MOBA) { const bool keep = ((sel >> (t >> 2)) & 1u) != 0u;
            if (!__all(keep)) { if (!keep) {
#pragma unroll
                for (int r = 0; r < 16; ++r) { p0[r] = NEGM; p1[r] = NEGM; } } } }
        float rm;
        { float a_ = fmaxf(fmaxf(p0[0], p0[1]), p1[0]), b_ = fmaxf(fmaxf(p0[2], p0[3]), p1[1]); a_ = fmaxf(fmaxf(a_, p1[2]), p1[3]);
#pragma unroll
          for (int r = 4; r < 16; r += 4) { a_ = fmaxf(fmaxf(a_, p0[r]), p0[r + 1]); b_ = fmaxf(fmaxf(b_, p0[r + 2]), p0[r + 3]); a_ = fmaxf(fmaxf(a_, p1[r]), p1[r + 1]); b_ = fmaxf(fmaxf(b_, p1[r + 2]), p1[r + 3]); }
          rm = swap_max(fmaxf(a_, b_)) - mhat; }
        if (__any(rm > THR)) {
            const float dl = fmaxf(rm, 0.f); mhat += dl;
            const float alpha = __builtin_amdgcn_exp2f(-dl); l *= alpha;
            if (hi == 0) wsf[r32] = alpha;
            asm volatile("s_waitcnt lgkmcnt(0)" ::: "memory");
#pragma unroll
            for (int r = 0; r < 16; ++r) { const float f = wsf[crow(r, hi)]; o[0][r] *= f; o[1][r] *= f; }
        }
        float sacc = 0.f;
#pragma unroll
        for (int r = 0; r < 16; ++r) { p0[r] = __builtin_amdgcn_exp2f(p0[r] - mhat); p1[r] = __builtin_amdgcn_exp2f(p1[r] - mhat); sacc += p0[r] + p1[r]; }
        l += sacc;
        u32x4 pw[4];
        pw[0] = (u32x4){cvtpk(p0[0], p0[1]), cvtpk(p0[2], p0[3]), cvtpk(p0[4], p0[5]), cvtpk(p0[6], p0[7])};
        pw[1] = (u32x4){cvtpk(p0[8], p0[9]), cvtpk(p0[10], p0[11]), cvtpk(p0[12], p0[13]), cvtpk(p0[14], p0[15])};
        pw[2] = (u32x4){cvtpk(p1[0], p1[1]), cvtpk(p1[2], p1[3]), cvtpk(p1[4], p1[5]), cvtpk(p1[6], p1[7])};
        pw[3] = (u32x4){cvtpk(p1[8], p1[9]), cvtpk(p1[10], p1[11]), cvtpk(p1[12], p1[13]), cvtpk(p1[14], p1[15])};
        __builtin_amdgcn_sched_barrier(0);
#pragma unroll
        for (int d0 = 0; d0 < 2; ++d0)
#pragma unroll
            for (int ks = 0; ks < 4; ++ks) { const int i = d0 * 4 + ks;
                o[d0] = __builtin_amdgcn_mfma_f32_32x32x16_bf16(__builtin_bit_cast(bf16x8, pw[ks]), (bf16x8){vlo[i][0], vlo[i][1], vlo[i][2], vlo[i][3], vhi[i][0], vhi[i][1], vhi[i][2], vhi[i][3]}, o[d0], 0, 0, 0); }
        slot = nslot;
    }
#undef AT_GROUP
#undef AT_KLOAD
#undef AT_DMA
    asm volatile("s_waitcnt lgkmcnt(0)\n\ts_barrier" ::: "memory");
    l = swap_sum(l);
    if (hi == 0) wsf[32 + r32] = l;
    asm volatile("s_waitcnt lgkmcnt(0)" ::: "memory");
    float rli[16];
#pragma unroll
    for (int r = 0; r < 16; ++r) rli[r] = __builtin_amdgcn_rcpf(wsf[32 + crow(r, hi)]);
    unsigned short* Ow = T.O + (rowbase + q0 + wid * 32) * T.po;
    { AT_LAS unsigned short* stg = (AT_LAS unsigned short*)(lds + LDS_OST) + wid * 2048;
#pragma unroll
      for (int r = 0; r < 16; ++r) { const int orow = crow(r, hi);
#pragma unroll
          for (int d0 = 0; d0 < 2; ++d0) stg[orow * 64 + d0 * 32 + r32] = (unsigned short)f2bf(o[d0][r] * rli[r]); }
      asm volatile("s_waitcnt lgkmcnt(0)" ::: "memory");
#pragma unroll
      for (int i = 0; i < 4; ++i) { const int row = i * 8 + (lane >> 3), ch = lane & 7; const u32x4 v = *(const AT_LAS u32x4*)(stg + row * 64 + ch * 8); *(u32x4*)(Ow + (long)row * T.po + ch * 8) = v; } }
    asm volatile("s_waitcnt lgkmcnt(0)\n\ts_barrier" ::: "memory");
}
template <int DQ, bool MOBA, bool QNORM, int G>
__device__ __forceinline__ void attn_unit_p(AT_LAS unsigned char* lds, const Tensors& T, long rowbase, int qb, const float* km, const float* qg, const float* tab, float kbound, int tbase, bool prefetched, bool has_next) {
    constexpr int NKP = DQ / 8, NP = NKP + 8, SLOTB = NKP * 1024 + 8192, ND0 = DQ / 16;
    constexpr int NSLOT = 3 * G, LDS_WS = NSLOT * SLOTB, LDS_OST = LDS_WS + 2048;
    int tid_ = threadIdx.x; asm volatile("" : "+v"(tid_));
    const int tid = tid_, lane = tid & 63, r32 = lane & 31, hi = lane >> 5; const int wid = __builtin_amdgcn_readfirstlane(tid >> 6);
    const int q0 = qb * 256, NT = 4 * (qb + 1);
    const unsigned lds0 = (unsigned)(size_t)lds;
    AT_LAS float* wsf = (AT_LAS float*)(lds + LDS_WS) + wid * 64;
    asm volatile("s_waitcnt vmcnt(0)" ::: "memory");
    unsigned soff[3], dsto[3];
#pragma unroll
    for (int k = 0; k < 3; ++k) { const int pi = wid + 8 * k;
        if (pi < NKP) { soff[k] = (T.pk == 0) ? (unsigned)(pi * 512 + lane * 8) : (unsigned)((rowbase + lane) * T.pk + 8 * pi); dsto[k] = pi * 1024; }
        else { const int v = pi - NKP; soff[k] = (T.pv == 0) ? (unsigned)(v * 512 + lane * 8) : (unsigned)((rowbase + 16 * (v & 3) + (lane >> 2)) * T.pv + 32 * (v >> 2) + 8 * (lane & 3)); dsto[k] = NKP * 1024 + v * 1024; } }
    const unsigned kstep = (T.pk == 0) ? (unsigned)NKP * 512u : 64u * (unsigned)T.pk, vstep = (T.pv == 0) ? 4096u : 64u * (unsigned)T.pv;
#define AT_DMA(t, slot) do { _Pragma("unroll") for (int k_ = 0; k_ < 3; ++k_) { const int pi_ = wid + 8 * k_; if (pi_ < NP) { \
        const unsigned short* s_ = ((pi_ < NKP) ? T.K : T.V) + (size_t)(soff[k_] + (unsigned)(t) * ((pi_ < NKP) ? kstep : vstep)); glds16(s_, (unsigned)__builtin_amdgcn_readfirstlane(lds0 + (slot) * SLOTB + dsto[k_])); } } } while (0)
    if (!prefetched) { _Pragma("unroll") for (int i_ = 0; i_ < G; ++i_) AT_DMA(i_, (tbase + i_) % NSLOT); }
    __builtin_amdgcn_sched_barrier(0);
    bf16x8 qr[ND0];
    { const unsigned short* Qw = T.Q + (rowbase + q0 + wid * 32 + r32) * T.pq + hi * 8;
#pragma unroll
      for (int d0 = 0; d0 < ND0; ++d0) qr[d0] = *(const bf16x8*)(Qw + d0 * 16); }
    __builtin_amdgcn_sched_barrier(0);
    if constexpr (QNORM) {
        float s = 0.f;
#pragma unroll
        for (int d0 = 0; d0 < ND0; ++d0)
#pragma unroll
            for (int j = 0; j < 8; ++j) { const float x = bf2f((unsigned short)qr[d0][j]); s += x * x; }
        s = swap_sum(s);
        const float rstd = 0.14724445073472677f / sqrtf(s * (1.f / 96.f) + 1e-6f);
#pragma unroll
        for (int d0 = 0; d0 < 4; ++d0) { const f32x4 g0 = *(const f32x4*)(qg + d0 * 16 + hi * 8), g1 = *(const f32x4*)(qg + d0 * 16 + hi * 8 + 4); u32x4 w;
            w.x = cvtpk(bf2f((unsigned short)qr[d0][0]) * rstd * g0.x, bf2f((unsigned short)qr[d0][1]) * rstd * g0.y); w.y = cvtpk(bf2f((unsigned short)qr[d0][2]) * rstd * g0.z, bf2f((unsigned short)qr[d0][3]) * rstd * g0.w);
            w.z = cvtpk(bf2f((unsigned short)qr[d0][4]) * rstd * g1.x, bf2f((unsigned short)qr[d0][5]) * rstd * g1.y); w.w = cvtpk(bf2f((unsigned short)qr[d0][6]) * rstd * g1.z, bf2f((unsigned short)qr[d0][7]) * rstd * g1.w);
            qr[d0] = __builtin_bit_cast(bf16x8, w); asm volatile("" : "+v"(qr[d0])); }
        { const int pos = q0 + wid * 32 + r32; const float* tb = tab + (pos * 16 + hi * 8) * 2; const float* ga = qg + 64 + hi * 8; const float* gb = qg + 80 + hi * 8; float oa[8], ob[8];
#pragma unroll
          for (int j = 0; j < 8; ++j) { const float x1 = bf2f((unsigned short)qr[4][j]) * rstd * ga[j], x2 = bf2f((unsigned short)qr[5][j]) * rstd * gb[j]; const float c = tb[2 * j], sn = tb[2 * j + 1]; oa[j] = x1 * c - x2 * sn; ob[j] = x1 * sn + x2 * c; }
          u32x4 w; w.x = cvtpk(oa[0], oa[1]); w.y = cvtpk(oa[2], oa[3]); w.z = cvtpk(oa[4], oa[5]); w.w = cvtpk(oa[6], oa[7]); qr[4] = __builtin_bit_cast(bf16x8, w);
          w.x = cvtpk(ob[0], ob[1]); w.y = cvtpk(ob[2], ob[3]); w.z = cvtpk(ob[4], ob[5]); w.w = cvtpk(ob[6], ob[7]); qr[5] = __builtin_bit_cast(bf16x8, w); }
    }
    __builtin_amdgcn_sched_barrier(0);
    unsigned sel = 0xffffffffu;
    if (MOBA) {
        sel = 0u; float gate[8];
#pragma unroll
        for (int j = 0; j < 7; ++j) { float a = 0.f;
            if (j < qb) { const float* kj = km + j * 512 + hi * 8;
#pragma unroll
                for (int d0 = 0; d0 < ND0; ++d0) { const f32x4 k0 = *(const f32x4*)(kj + d0 * 16), k1 = *(const f32x4*)(kj + d0 * 16 + 4);
                    a += bf2f((unsigned short)qr[d0][0]) * k0.x + bf2f((unsigned short)qr[d0][1]) * k0.y + bf2f((unsigned short)qr[d0][2]) * k0.z + bf2f((unsigned short)qr[d0][3]) * k0.w
                       + bf2f((unsigned short)qr[d0][4]) * k1.x + bf2f((unsigned short)qr[d0][5]) * k1.y + bf2f((unsigned short)qr[d0][6]) * k1.z + bf2f((unsigned short)qr[d0][7]) * k1.w; } }
            a = swap_sum(a); gate[j] = (j < qb) ? a : -INFINITY; }
        gate[7] = -INFINITY;
#pragma unroll
        for (int r = 0; r < 3; ++r) { int best = -1; float bv = -INFINITY;
#pragma unroll
            for (int j = 0; j < 8; ++j) if (!((sel >> j) & 1u) && gate[j] > bv) { bv = gate[j]; best = j; }
            if (best >= 0) sel |= 1u << best; }
    }
    __builtin_amdgcn_sched_barrier(0);
    float l = 0.f; f32x16 o[2]; o[0] = f32x16{}; o[1] = f32x16{};
    f32x16 negm;
    { float qss = 0.f;
#pragma unroll
      for (int d0 = 0; d0 < ND0; ++d0)
#pragma unroll
          for (int j = 0; j < 8; ++j) { const float x = bf2f((unsigned short)qr[d0][j]); qss += x * x; }
      qss = swap_sum(qss); const float mrow = sqrtf(qss) * kbound;
#pragma unroll
      for (int r = 0; r < 16; ++r) negm[r] = -mrow;
      asm volatile("" : "+v"(negm)); }

    const int qrel = wid * 32 + r32;
    const int vbl = ((lane >> 4) & 1) * 32 + (lane & 3) * 8 + (4 * hi + ((lane & 15) >> 2)) * 64;
#define AT_GROUP(u) do { asm volatile("s_waitcnt vmcnt(0) lgkmcnt(0)\n\ts_barrier" ::: "memory"); \
        if ((u) + G < NT) { _Pragma("unroll") for (int i_ = 0; i_ < G; ++i_) { const int tt_ = (u) + G + i_; AT_DMA(tt_, (tbase + tt_) % NSLOT); } } \
        else if (has_next) { _Pragma("unroll") for (int i_ = 0; i_ < G; ++i_) AT_DMA(i_, (tbase + NT + i_) % NSLOT); } } while (0)
#define AT_KLOAD(sl) do { const AT_LAS unsigned char* kb = lds + (sl) * SLOTB + hi * 1024 + r32 * 16; \
        _Pragma("unroll") for (int d0 = 0; d0 < ND0; ++d0) { kf[2 * d0] = *(const AT_LAS bf16x8*)(kb + d0 * 2048); kf[2 * d0 + 1] = *(const AT_LAS bf16x8*)(kb + d0 * 2048 + 512); } } while (0)
#define AT_VLOAD(sl) do { const AT_LAS unsigned char* vp = lds + (sl) * SLOTB + NKP * 1024 + vbl; \
        _Pragma("unroll") for (int i = 0; i < 8; ++i) { vlo[i] = vtr(vp + (i >> 2) * 4096 + (i & 3) * 1024); vhi[i] = vtr(vp + (i >> 2) * 4096 + (i & 3) * 1024 + 512); } } while (0)
#define AT_SUMPACK() do { float sacc = 0.f; \
        _Pragma("unroll") for (int r = 0; r < 16; ++r) sacc += c0[r] + c1[r]; \
        l += sacc; \
        pw[0] = (u32x4){cvtpk(c0[0], c0[1]), cvtpk(c0[2], c0[3]), cvtpk(c0[4], c0[5]), cvtpk(c0[6], c0[7])}; \
        pw[1] = (u32x4){cvtpk(c0[8], c0[9]), cvtpk(c0[10], c0[11]), cvtpk(c0[12], c0[13]), cvtpk(c0[14], c0[15])}; \
        pw[2] = (u32x4){cvtpk(c1[0], c1[1]), cvtpk(c1[2], c1[3]), cvtpk(c1[4], c1[5]), cvtpk(c1[6], c1[7])}; \
        pw[3] = (u32x4){cvtpk(c1[8], c1[9]), cvtpk(c1[10], c1[11]), cvtpk(c1[12], c1[13]), cvtpk(c1[14], c1[15])}; } while (0)
#define AT_QKT(N0, N1) do { _Pragma("unroll") for (int d0 = 0; d0 < ND0; ++d0) { \
            if (d0 == 0) { N0 = __builtin_amdgcn_mfma_f32_32x32x16_bf16(kf[0], qr[0], negm, 0, 0, 0); N1 = __builtin_amdgcn_mfma_f32_32x32x16_bf16(kf[1], qr[0], negm, 0, 0, 0); } \
            else { N0 = __builtin_amdgcn_mfma_f32_32x32x16_bf16(kf[2 * d0], qr[d0], N0, 0, 0, 0); N1 = __builtin_amdgcn_mfma_f32_32x32x16_bf16(kf[2 * d0 + 1], qr[d0], N1, 0, 0, 0); } } } while (0)
#define AT_DECIDE(tt) do { \
        { const int jb = (tt) - (NT - 4); \
          if (jb >= 0) { const int kb0 = 64 * jb + 4 * hi; \
              _Pragma("unroll") for (int r = 0; r < 16; ++r) { const int kv = kb0 + (r & 3) + 8 * (r >> 2); if (kv > qrel) c0[r] = NEGM; if (kv + 32 > qrel) c1[r] = NEGM; } } \
          else if (MOBA) { const bool keep = ((sel >> ((tt) >> 2)) & 1u) != 0u; \
              if (!__all(keep)) { if (!keep) { _Pragma("unroll") for (int r = 0; r < 16; ++r) { c0[r] = NEGM; c1[r] = NEGM; } } } } } \
        if ((tt) + 1 < NT && (((tt) + 1) % G) == 0) AT_GROUP((tt) + 1); } while (0)
#define AT_EXPS() do { _Pragma("unroll") for (int r = 0; r < 16; ++r) { c0[r] = __builtin_amdgcn_exp2f(c0[r]); c1[r] = __builtin_amdgcn_exp2f(c1[r]); } } while (0)
#define AT_PV() do { _Pragma("unroll") for (int d0 = 0; d0 < 2; ++d0) _Pragma("unroll") for (int ks = 0; ks < 4; ++ks) { const int i = d0 * 4 + ks; \
            o[d0] = __builtin_amdgcn_mfma_f32_32x32x16_bf16(__builtin_bit_cast(bf16x8, pw[ks]), (bf16x8){vlo[i][0], vlo[i][1], vlo[i][2], vlo[i][3], vhi[i][0], vhi[i][1], vhi[i][2], vhi[i][3]}, o[d0], 0, 0, 0); } } while (0)
#define AT_SGB(mask, n) __builtin_amdgcn_sched_group_barrier(mask, n, 0)
    constexpr int NG = 2 * ND0;
    bf16x8 kf[2 * ND0]; s16x4 vlo[8], vhi[8]; u32x4 pw[4]; f32x16 c0, c1;
    AT_GROUP(0);
    AT_KLOAD(tbase % NSLOT);
    AT_QKT(c0, c1);
    AT_DECIDE(0);
    AT_KLOAD((tbase + 1) % NSLOT);
    AT_EXPS();
    int slot = (tbase + 1) % NSLOT, pslot = tbase % NSLOT;
    for (int t = 1; t < NT; ++t) {
        const int nslot = (t + 1 < NT) ? ((slot == NSLOT - 1) ? 0 : slot + 1) : slot;
        __builtin_amdgcn_sched_barrier(0);
        { f32x16 n0, n1; float sacc = 0.f;
          const AT_LAS unsigned char* vp = lds + pslot * SLOTB + NKP * 1024 + vbl;
#pragma unroll
          for (int i = 0; i < NG; ++i) {
              if (i >= NG - 2) { const int vi = i - (NG - 2); vlo[vi] = vtr(vp + (vi >> 2) * 4096 + (vi & 3) * 1024); vhi[vi] = vtr(vp + (vi >> 2) * 4096 + (vi & 3) * 1024 + 512); }
              const int d0 = i >> 1;
              if (i & 1) n1 = (d0 == 0) ? __builtin_amdgcn_mfma_f32_32x32x16_bf16(kf[i], qr[d0], negm, 0, 0, 0) : __builtin_amdgcn_mfma_f32_32x32x16_bf16(kf[i], qr[d0], n1, 0, 0, 0);
              else n0 = (d0 == 0) ? __builtin_amdgcn_mfma_f32_32x32x16_bf16(kf[i], qr[d0], negm, 0, 0, 0) : __builtin_amdgcn_mfma_f32_32x32x16_bf16(kf[i], qr[d0], n0, 0, 0, 0);
#pragma unroll
              for (int rr = (i * 32) / NG; rr < ((i + 1) * 32) / NG; ++rr) sacc += (rr < 16) ? c0[rr] : c1[rr - 16];
#pragma unroll
              for (int ww = (i * 16) / NG; ww < ((i + 1) * 16) / NG; ++ww) { const int e = 2 * ww; pw[ww >> 2][ww & 3] = (e < 16) ? cvtpk(c0[e], c0[e + 1]) : cvtpk(c1[e - 16], c1[e - 15]); }
              __builtin_amdgcn_sched_barrier(0); }
          l += sacc; c0 = n0; c1 = n1; }
        AT_DECIDE(t);
        __builtin_amdgcn_sched_barrier(0);
        { const AT_LAS unsigned char* kb = lds + nslot * SLOTB + hi * 1024 + r32 * 16; const AT_LAS unsigned char* vpB = lds + pslot * SLOTB + NKP * 1024 + vbl;
#pragma unroll
          for (int i = 0; i < 8; ++i) {
              if (i + 2 < 8) { const int vi = i + 2; vlo[vi] = vtr(vpB + (vi >> 2) * 4096 + (vi & 3) * 1024); vhi[vi] = vtr(vpB + (vi >> 2) * 4096 + (vi & 3) * 1024 + 512); }
              if (i >= 2 && i < 6) {
#pragma unroll
                  for (int q = (i - 2) * NG / 4; q < (i - 1) * NG / 4; ++q) kf[q] = *(const AT_LAS bf16x8*)(kb + (q >> 1) * 2048 + (q & 1) * 512); }
              o[i >> 2] = __builtin_amdgcn_mfma_f32_32x32x16_bf16(__builtin_bit_cast(bf16x8, pw[i & 3]), (bf16x8){vlo[i][0], vlo[i][1], vlo[i][2], vlo[i][3], vhi[i][0], vhi[i][1], vhi[i][2], vhi[i][3]}, o[i >> 2], 0, 0, 0);
#pragma unroll
              for (int rr = 4 * i; rr < 4 * i + 4; ++rr) { if (rr < 16) c0[rr] = __builtin_amdgcn_exp2f(c0[rr]); else c1[rr - 16] = __builtin_amdgcn_exp2f(c1[rr - 16]); }
              __builtin_amdgcn_sched_barrier(0); } }
        pslot = slot; slot = nslot;
    }
    AT_VLOAD(pslot);
    AT_SUMPACK();
    AT_PV();
#undef AT_GROUP
#undef AT_KLOAD
#undef AT_VLOAD
#undef AT_SUMPACK
#undef AT_QKT
#undef AT_DECIDE
#undef AT_EXPS
#undef AT_PV
#undef AT_SGB
#undef AT_DMA
    asm volatile("s_waitcnt lgkmcnt(0)\n\ts_barrier" ::: "memory");
    l = swap_sum(l);
    if (hi == 0) wsf[32 + r32] = l;
    asm volatile("s_waitcnt lgkmcnt(0)" ::: "memory");
    float rli[16];
#pragma unroll
    for (int r = 0; r < 16; ++r) rli[r] = __builtin_amdgcn_rcpf(wsf[32 + crow(r, hi)]);
    unsigned short* Ow = T.O + (rowbase + q0 + wid * 32) * T.po;
    { AT_LAS unsigned short* stg = (AT_LAS unsigned short*)(lds + LDS_OST) + wid * 2048;
#pragma unroll
      for (int r = 0; r < 16; ++r) { const int orow = crow(r, hi);
#pragma unroll
          for (int d0 = 0; d0 < 2; ++d0) stg[orow * 64 + d0 * 32 + r32] = (unsigned short)f2bf(o[d0][r] * rli[r]); }
      asm volatile("s_waitcnt lgkmcnt(0)" ::: "memory");
#pragma unroll
      for (int i = 0; i < 4; ++i) { const int row = i * 8 + (lane >> 3), ch = lane & 7; const u32x4 v = *(const AT_LAS u32x4*)(stg + row * 64 + ch * 8); *(u32x4*)(Ow + (long)row * T.po + ch * 8) = v; } }
    asm volatile("s_waitcnt lgkmcnt(0)\n\ts_barrier" ::: "memory");
}
#undef AT_LAS
}

namespace ssd {
typedef short bf16x8 __attribute__((ext_vector_type(8)));
typedef short v4i16_t __attribute__((ext_vector_type(4)));
typedef float f32x16 __attribute__((ext_vector_type(16)));
typedef unsigned u32x4 __attribute__((ext_vector_type(4)));
#define SS_LAS __attribute__((address_space(3)))
__device__ __forceinline__ int crow(int r, int hi) { return (r & 3) + 8 * (r >> 2) + 4 * hi; }
__device__ __forceinline__ v4i16_t vtr(const SS_LAS unsigned char* p) { return __builtin_amdgcn_ds_read_tr16_b64_v4i16((SS_LAS v4i16_t*)p); }
__device__ __forceinline__ bf16x8 tr_frag(const SS_LAS unsigned char* img, int pitch, int k0, int c0, int lane) {
    const int g4 = lane >> 4, q = (lane & 15) >> 2, p4 = lane & 3;
    const SS_LAS unsigned char* a = img + (k0 + 8 * (g4 >> 1) + q) * pitch + (c0 + 16 * (g4 & 1) + 4 * p4) * 2;
    const v4i16_t lo = vtr(a), hi4 = vtr(a + 4 * pitch);
    return (bf16x8){lo[0], lo[1], lo[2], lo[3], hi4[0], hi4[1], hi4[2], hi4[3]};
}
__device__ __forceinline__ bf16x8 row_frag(const SS_LAS unsigned char* img, int pitch, int r0, int k0, int lane) {
    return *(const SS_LAS bf16x8*)(img + (r0 + (lane & 31)) * pitch + (k0 + 8 * (lane >> 5)) * 2);
}

constexpr int PX4 = 576;
constexpr int PB_T = 320;
constexpr int PR = 272;
constexpr int PX1 = 192;

__device__ __forceinline__ void dt_cs(int t0, int g, const float* DTR, const float* dtb, const float* alog, SS_LAS float* csl, SS_LAS float* dtl, SS_LAS float* wtot, int tid, int lane, int wid) {
    const int l = tid >> 2, hh = tid & 3, h = 4 * g + hh;
    const float r = DTR[(size_t)(t0 + l) * 8 + h] + dtb[h]; const float ex = __expf(fminf(r, 20.f)); const float dt = (r > 20.f) ? r : ((ex < 0.01f) ? ex * (1.f - ex * (0.5f - ex * 0.33333333f)) : __logf(1.f + ex));
    float v = dt * (-expf(alog[h]));
#pragma unroll
    for (int off = 4; off < 64; off <<= 1) { const float t = __shfl_up(v, off); if (lane >= off) v += t; }
    if (lane >= 60) wtot[wid * 4 + hh] = v;
    __syncthreads();
    float base = 0.f;
    for (int w = 0; w < wid; ++w) base += wtot[w * 4 + hh];
    csl[tid] = v + base; dtl[tid] = dt;
    __syncthreads();
}
__device__ __forceinline__ void conv_load(u32x4 (&x)[19], const unsigned short* raw, int t0, int l0, int col) {
    const int pos0 = t0 & 2047;
#pragma unroll
    for (int i = 0; i < 19; ++i) { const int l = l0 - 3 + i; x[i] = (u32x4){0u, 0u, 0u, 0u}; if (pos0 + l >= 0) x[i] = *(const u32x4*)(raw + (size_t)(t0 + l) * 1024 + col); }
}
template <bool SCALED> __device__ __forceinline__ void conv_compute(const u32x4 (&x)[19], int l0, int col, const float* cw, const float* cb, SS_LAS unsigned char* img, int pitch, const SS_LAS float* sc) {
    float w[4][8], b[8];
#pragma unroll
    for (int k = 0; k < 4; ++k) { const f32x4 a = *(const f32x4*)(cw + k * 1024 + col), c = *(const f32x4*)(cw + k * 1024 + col + 4); w[k][0] = a.x; w[k][1] = a.y; w[k][2] = a.z; w[k][3] = a.w; w[k][4] = c.x; w[k][5] = c.y; w[k][6] = c.z; w[k][7] = c.w; }
    { const f32x4 a = *(const f32x4*)(cb + col), c = *(const f32x4*)(cb + col + 4); b[0] = a.x; b[1] = a.y; b[2] = a.z; b[3] = a.w; b[4] = c.x; b[5] = c.y; b[6] = c.z; b[7] = c.w; }
#pragma unroll
    for (int i = 0; i < 16; ++i) { const int l = l0 + i; float o[8]; const float s = SCALED ? sc[l * 4] : 1.f;
#pragma unroll
        for (int j = 0; j < 8; ++j) { float a = b[j];
#pragma unroll
            for (int k = 0; k < 4; ++k) { const unsigned wd = (j < 2) ? x[i + k].x : (j < 4) ? x[i + k].y : (j < 6) ? x[i + k].z : x[i + k].w; a += w[k][j] * ((j & 1) ? bfhi(wd) : bflo(wd)); }
            o[j] = a * __builtin_amdgcn_rcpf(1.f + __expf(-a)) * s; }
        u32x4 p; p.x = pk2(o[0], o[1]); p.y = pk2(o[2], o[3]); p.z = pk2(o[4], o[5]); p.w = pk2(o[6], o[7]);
        *(SS_LAS u32x4*)(img + l * pitch) = p; }
}

__device__ __forceinline__ void states_unit(SS_LAS unsigned char* lds, int bc, int g, const unsigned short* XBC, const float* DTR, const float* cw, const float* cb, const float* dtb, const float* alog, float* ST, float* CEND) {
    int tid_ = threadIdx.x; asm volatile("" : "+v"(tid_));
    const int tid = tid_, lane = tid & 63, r32 = lane & 31, hi = lane >> 5; const int wid = __builtin_amdgcn_readfirstlane(tid >> 6);
    const int t0 = bc * 128;
    SS_LAS unsigned char* XD = lds; SS_LAS unsigned char* BI = lds + 128 * PX4;
    SS_LAS float* csl = (SS_LAS float*)(lds + 128 * PX4 + 128 * PB_T); SS_LAS float* dtl = csl + 512; SS_LAS float* wtot = dtl + 512; SS_LAS float* scl = wtot + 32;
    const int ch = tid % 48, l0 = (tid / 48) * 16; const int col = (ch < 32) ? g * 256 + ch * 8 : 512 + g * 128 + (ch - 32) * 8;
    u32x4 xr[19];
    if (tid < 384) conv_load(xr, XBC, t0, l0, col);
    dt_cs(t0, g, DTR, dtb, alog, csl, dtl, wtot, tid, lane, wid);
    scl[tid] = dtl[tid] * __expf(csl[508 + (tid & 3)] - csl[tid]);
    if (tid < 4) CEND[bc * 8 + g * 4 + tid] = csl[508 + tid];
    __syncthreads();
    if (tid < 384) {
        if (ch < 32) conv_compute<true>(xr, l0, col, cw, cb, XD + ch * 16, PX4, scl + (ch >> 3));
        else conv_compute<false>(xr, l0, col, cw, cb, BI + (ch - 32) * 16, PB_T, nullptr); }
    __syncthreads();
    const int pt = wid >> 2, nt = wid & 3;
#pragma unroll 1
    for (int hh = 0; hh < 4; ++hh) {
        f32x16 acc = f32x16{};
#pragma unroll
        for (int ks = 0; ks < 8; ++ks) {
            const bf16x8 a = tr_frag(XD, PX4, 16 * ks, hh * 64 + 32 * pt, lane);
            const bf16x8 b = tr_frag(BI, PB_T, 16 * ks, 32 * nt, lane);
            acc = __builtin_amdgcn_mfma_f32_32x32x16_bf16(a, b, acc, 0, 0, 0); }
        float* o = ST + (((size_t)(bc * 8 + g * 4 + hh) * 64 + 32 * pt) << 7) + 32 * nt + r32;
#pragma unroll
        for (int r = 0; r < 16; ++r) o[(size_t)crow(r, hi) << 7] = acc[r];
    }
    __syncthreads();
}

__device__ __forceinline__ void out_unit(SS_LAS unsigned char* lds, int bc, int g, const unsigned short* XBC, const unsigned short* VZ, const float* DTR, const float* cw, const float* cb, const float* dtb, const float* alog,
                                         const unsigned short* HIN, const float* Dsk, const float* gn, unsigned short* MIX) {
    int tid_ = threadIdx.x; asm volatile("" : "+v"(tid_));
    const int tid = tid_, lane = tid & 63, r32 = lane & 31, hi = lane >> 5; const int wid = __builtin_amdgcn_readfirstlane(tid >> 6);
    const int t0 = bc * 128;
    SS_LAS unsigned char* CI = lds; SS_LAS unsigned char* BI = lds + 128 * PR; SS_LAS unsigned char* XS = lds + 2 * 128 * PR;
    SS_LAS float* csl = (SS_LAS float*)(lds + 2 * 128 * PR + 128 * PX4); SS_LAS float* dtl = csl + 512; SS_LAS float* wtot = dtl + 512;
    const int ch = tid & 63, l0 = (tid >> 6) * 16; const int col = (ch < 32) ? g * 256 + ch * 8 : (ch < 48) ? 512 + g * 128 + (ch - 32) * 8 : 768 + g * 128 + (ch - 48) * 8;
    u32x4 xr[19];
    conv_load(xr, XBC, t0, l0, col);
    u32x4 zr[8];
    { const unsigned short* zp = VZ + (size_t)(t0 + (tid >> 2)) * 1024 + 512 + g * 256 + (tid & 3) * 64;
#pragma unroll
      for (int c = 0; c < 8; ++c) zr[c] = *(const u32x4*)(zp + c * 8); }
    dt_cs(t0, g, DTR, dtb, alog, csl, dtl, wtot, tid, lane, wid);
    if (ch < 32) conv_compute<false>(xr, l0, col, cw, cb, XS + ch * 16, PX4, nullptr);
    else if (ch < 48) conv_compute<false>(xr, l0, col, cw, cb, BI + (ch - 32) * 16, PR, nullptr);
    else conv_compute<false>(xr, l0, col, cw, cb, CI + (ch - 48) * 16, PR, nullptr);
    __syncthreads();
    const int lt = wid >> 1, st0 = 2 * (wid & 1), pt = wid & 1;
    f32x16 cb2[2]; cb2[0] = f32x16{}; cb2[1] = f32x16{};
#pragma unroll
    for (int ks = 0; ks < 8; ++ks) {
        const bf16x8 a = row_frag(CI, PR, 32 * lt, 16 * ks, lane);
        const bf16x8 b0 = row_frag(BI, PR, 32 * st0, 16 * ks, lane), b1 = row_frag(BI, PR, 32 * st0 + 32, 16 * ks, lane);
        cb2[0] = __builtin_amdgcn_mfma_f32_32x32x16_bf16(a, b0, cb2[0], 0, 0, 0);
        cb2[1] = __builtin_amdgcn_mfma_f32_32x32x16_bf16(a, b1, cb2[1], 0, 0, 0); }
    f32x16 yo[4];
    { bf16x8 hb[2][8];
      const unsigned short* hin0 = HIN + (((size_t)(bc * 8 + g * 4) * 64 + 32 * pt + r32) << 7) + 8 * hi;
#pragma unroll
      for (int ks = 0; ks < 8; ++ks) hb[0][ks] = *(const bf16x8*)(hin0 + 16 * ks);
#pragma unroll
      for (int hh = 0; hh < 4; ++hh) { yo[hh] = f32x16{};
          if (hh < 3) {
#pragma unroll
              for (int ks = 0; ks < 8; ++ks) hb[(hh + 1) & 1][ks] = *(const bf16x8*)(hin0 + ((size_t)(hh + 1) << 13) + 16 * ks); }
          __builtin_amdgcn_sched_barrier(0);
#pragma unroll
          for (int ks = 0; ks < 8; ++ks) yo[hh] = __builtin_amdgcn_mfma_f32_32x32x16_bf16(row_frag(CI, PR, 32 * lt, 16 * ks, lane), hb[hh & 1][ks], yo[hh], 0, 0, 0);
          __builtin_amdgcn_sched_barrier(0); } }
    __syncthreads();
    SS_LAS unsigned char* MI = BI;
#pragma unroll
    for (int hh = 0; hh < 4; ++hh) {
        const int h = g * 4 + hh;
#pragma unroll
        for (int j = 0; j < 2; ++j) { const int s = 32 * (st0 + j) + r32; const float css = csl[s * 4 + hh], dts = dtl[s * 4 + hh];
#pragma unroll
            for (int r = 0; r < 16; ++r) { const int l = 32 * lt + crow(r, hi); const float cl = csl[l * 4 + hh];
                float pr_ = cb2[j][r] * __builtin_amdgcn_exp2f(fminf(cl - css, 0.f) * 1.4426950408889634f) * dts; asm volatile("" : "+v"(pr_)); const float v = (s <= l) ? pr_ : 0.f;
                *(SS_LAS unsigned short*)(MI + l * PR + s * 2) = (unsigned short)f2bf(v); if ((r & 3) == 3) asm volatile("" ::: "memory"); } }
        __syncthreads();
        f32x16 yd = f32x16{};
#pragma unroll
        for (int ks = 0; ks < 8; ++ks) yd = __builtin_amdgcn_mfma_f32_32x32x16_bf16(row_frag(MI, PR, 32 * lt, 16 * ks, lane), tr_frag(XS, PX4, 16 * ks, hh * 64 + 32 * pt, lane), yd, 0, 0, 0);
        __syncthreads();
        const float dsk = Dsk[h]; const int p = 32 * pt + r32;
#pragma unroll
        for (int r = 0; r < 16; ++r) { const int l = 32 * lt + crow(r, hi);
            SS_LAS unsigned short* xp = (SS_LAS unsigned short*)(XS + l * PX4 + (hh * 64 + p) * 2);
            const float y = yd[r] + yo[hh][r] * __expf(csl[l * 4 + hh]) + dsk * bf2f(*xp);
            *xp = (unsigned short)f2bf(y); }
    }
    __syncthreads();
    { const int l = tid >> 2, q = tid & 3; const SS_LAS unsigned char* rowp = XS + l * PX4 + q * 128; float yv[8][8]; float s = 0.f;
#pragma unroll
      for (int c = 0; c < 8; ++c) { const u32x4 v = *(const SS_LAS u32x4*)(rowp + c * 16); const u32x4 z = zr[c];
          yv[c][0] = bflo(v.x) * silu_f(bflo(z.x)); yv[c][1] = bfhi(v.x) * silu_f(bfhi(z.x)); yv[c][2] = bflo(v.y) * silu_f(bflo(z.y)); yv[c][3] = bfhi(v.y) * silu_f(bfhi(z.y));
          yv[c][4] = bflo(v.z) * silu_f(bflo(z.z)); yv[c][5] = bfhi(v.z) * silu_f(bfhi(z.z)); yv[c][6] = bflo(v.w) * silu_f(bflo(z.w)); yv[c][7] = bfhi(v.w) * silu_f(bfhi(z.w));
#pragma unroll
          for (int j = 0; j < 8; ++j) s += yv[c][j] * yv[c][j]; }
      s += __shfl_xor(s, 1); s += __shfl_xor(s, 2);
      const float rstd = 1.f / sqrtf(s * (1.f / 256.f) + 1e-6f); const float* gq = gn + g * 256 + q * 64; unsigned short* op = MIX + (size_t)(t0 + l) * 1024 + 512 + g * 256 + q * 64;
#pragma unroll
      for (int c = 0; c < 8; ++c) { const f32x4 g0 = *(const f32x4*)(gq + c * 8), g1 = *(const f32x4*)(gq + c * 8 + 4); u32x4 o;
          o.x = pk2(yv[c][0] * rstd * g0.x, yv[c][1] * rstd * g0.y); o.y = pk2(yv[c][2] * rstd * g0.z, yv[c][3] * rstd * g0.w);
          o.z = pk2(yv[c][4] * rstd * g1.x, yv[c][5] * rstd * g1.y); o.w = pk2(yv[c][6] * rstd * g1.z, yv[c][7] * rstd * g1.w);
          *(u32x4*)(op + c * 8) = o; } }
    __syncthreads();
}
#undef SS_LAS
}

constexpr int NWAVES = 8, NTHR = 512;
constexpr int T_ = 32768, S_ = 2048, NB_ = 16, D_ = 1024;
constexpr int DFF = 2816, DFF2 = 5632;
constexpr float EPS = 1e-6f;
constexpr size_t MiB = 1u << 20;
constexpr size_t WS_CTL = 0, CTL_ZERO_BYTES = 3 * MiB;
constexpr size_t WS_SSQA = 1 * MiB, WS_SSQB = WS_SSQA + 256 * 1024, WS_SSQC = WS_SSQB + 256 * 1024, WS_SSQQ = WS_SSQC + 256 * 1024, WS_SSQKV = WS_SSQQ + 256 * 1024;
constexpr size_t WS_KMEAN = WS_SSQKV + 256 * 1024;
constexpr size_t WS_DTR = 55 * MiB;
constexpr size_t WS_W_IN0 = 3 * MiB;
constexpr size_t WS_W_OUT0 = WS_W_IN0 + 6656 * 1024;
constexpr size_t WS_W_IN1 = WS_W_OUT0 + 2 * MiB;
constexpr size_t WS_W_UQ = WS_W_IN1 + 2 * MiB;
constexpr size_t WS_W_UKV = WS_W_UQ + 1536 * 1024;
constexpr size_t WS_W_OUT1 = WS_W_UKV + 1 * MiB;
constexpr size_t WS_W_UP = WS_W_OUT1 + 2 * MiB;
constexpr size_t WS_W_DN = WS_W_UP + 22 * MiB;
constexpr size_t WS_TAB64 = 51 * MiB;
constexpr size_t WS_TAB32 = WS_TAB64 + 512 * 1024;
constexpr size_t WS_CWS = 52 * MiB;
constexpr size_t WS_DT = 53 * MiB;
constexpr size_t WS_CS = 54 * MiB;
constexpr size_t WS_XN = 56 * MiB;
constexpr size_t WS_BIG = 120 * MiB;
static_assert(WS_W_DN + 11 * MiB <= WS_TAB64, "weights fit");
constexpr size_t L0_QK = WS_BIG, L0_VZ = WS_BIG + 64 * MiB, L0_XBC = WS_BIG + 128 * MiB, L0_DTR = WS_BIG + 192 * MiB, L0_XBCA = WS_BIG + 256 * MiB, L0_MIX = WS_BIG + 320 * MiB;
constexpr size_t L0_ST = WS_BIG + 192 * MiB;
constexpr size_t L0_KC = WS_BIG + 288 * MiB;
constexpr size_t L0_HIN = WS_BIG + 256 * MiB;
constexpr size_t WS_CEND = 53 * MiB;
constexpr size_t L0_CB = L0_DTR;
constexpr size_t L0_YG = L0_QK;
constexpr size_t FF_ACT = WS_BIG + 64 * MiB, FF_UB = WS_BIG + 240 * MiB;
constexpr size_t L1_C1 = WS_BIG, L1_QR = WS_BIG + 64 * MiB, L1_V2 = WS_BIG + 160 * MiB;
constexpr size_t WS_RG = WS_BIG + 384 * MiB;
constexpr size_t WS_SSQPE = 53 * MiB + 64 * 1024;
constexpr size_t L1_K2 = WS_BIG + 288 * MiB;
constexpr size_t L1_O = WS_BIG + 224 * MiB;
constexpr size_t WS_END = 512 * MiB;
constexpr int CW_BAR = 4096;

constexpr int RING_OFF = 0, RING_BYTES = 162816;
constexpr int LDSCTL_OFF = RING_BYTES, MISC_OFF = LDSCTL_OFF + 320;
constexpr int LDS_BYTES = 163840;

struct Args { const float* in[25]; float* out; unsigned char* ws; int ph_lo, ph_hi; };
typedef const __attribute__((address_space(4))) Args* KArgs;
__device__ __forceinline__ KArgs kargs() { KArgs p = (KArgs)__builtin_amdgcn_kernarg_segment_ptr(); asm volatile("" : "+s"(p)); return p; }
#define PH_VARS KArgs A_ = kargs(); unsigned char* ws = A_->ws; float* out = A_->out; const float* x = A_->in[0]; bf16* XN = (bf16*)(ws + WS_XN); const float* TAB64 = (const float*)(ws + WS_TAB64); const float* TAB32 = (const float*)(ws + WS_TAB32); \
    int tid_ = threadIdx.x; asm volatile("" : "+v"(tid_)); const int tid = tid_, lane = tid & 63, wave = __builtin_amdgcn_readfirstlane(tid >> 6); int G = gridDim.x; asm volatile("" : "+s"(G)); const int gw = blockIdx.x * NWAVES + wave, NGW = G * NWAVES; const int gt = blockIdx.x * NTHR + tid, NGT = G * NTHR; \
    (void)out; (void)x; (void)XN; (void)TAB64; (void)TAB32; (void)lane; (void)gw; (void)NGW; (void)gt; (void)NGT;

template <int MAP> __device__ __forceinline__ int src_col(int n0) {
    if (MAP == 1) { const int pn = n0 >> 8, bj = (n0 >> 7) & 1, wc = (n0 >> 5) & 3; return bj * DFF + pn * 128 + wc * 32; }
    if (MAP == 2) { const int pn = n0 >> 8, bj = (n0 >> 7) & 1, wc = (n0 >> 5) & 3; return (pn < 4) ? pn * 256 + wc * 64 + bj * 32 : n0; }
    if (MAP == 3) { const int pn = n0 >> 8, bj = (n0 >> 7) & 1, wc = (n0 >> 5) & 3; if (pn < 4) return (4 * pn + wc) * 128 + bj * 32; const int col = (pn - 4) * 256 + bj * 128 + wc * 32; return (col >> 6) * 128 + 64 + (col & 63); }
    return n0;
}
template <int MAP> __device__ __forceinline__ void tr_load(f32x4 (&v)[8], const float* W, int Nsrc, int item, int nblk, int lane, const float* gain) {
    const int kb = item / nblk, nb = item % nblk, k0 = 64 * kb, n0 = 32 * nb;
    const int nn = src_col<MAP>(n0) + (lane & 7) * 4; const bool ok = (nn >= 0 && nn < Nsrc);
#pragma unroll
    for (int i = 0; i < 8; ++i) { const int kk = 8 * i + (lane >> 3); v[i] = ok ? *(const f32x4*)(W + (size_t)(k0 + kk) * Nsrc + nn) : (f32x4){0.f, 0.f, 0.f, 0.f}; if (gain) v[i] = v[i] * gain[k0 + kk]; }
}
__device__ __forceinline__ void tr_store(const f32x4 (&v)[8], int K, bf16* WT, LAS float* scr, int item, int nblk, int lane) {
    const int kb = item / nblk, nb = item % nblk, k0 = 64 * kb, n0 = 32 * nb;
#pragma unroll
    for (int i = 0; i < 8; ++i) { const int kk = 8 * i + (lane >> 3); LAS float* d = scr + kk * 33 + (lane & 7) * 4; d[0] = v[i].x; d[1] = v[i].y; d[2] = v[i].z; d[3] = v[i].w; }
    LDS_WAIT(); asm volatile("" ::: "memory");
    const int c = lane & 7;
#pragma unroll
    for (int j = 0; j < 4; ++j) { const int n = (lane >> 3) + 8 * j; const LAS float* s = scr + (8 * c) * 33 + n;
        v4u o; o.x = pk2(s[0 * 33], s[1 * 33]); o.y = pk2(s[2 * 33], s[3 * 33]); o.z = pk2(s[4 * 33], s[5 * 33]); o.w = pk2(s[6 * 33], s[7 * 33]);
        *(GAS v4u*)(WT + (size_t)(n0 + n) * K + k0 + 8 * c) = o; }
    LDS_WAIT(); asm volatile("" ::: "memory");
}
template <int MAP = 0> __device__ __forceinline__ void transpose_mat(const float* W, int K, int Nsrc, int Npad, bf16* WT, LAS float* scr, int gw, int NGW, int lane, const float* gain = nullptr) {
    const int nblk = Npad / 32, nitems = (K / 64) * nblk;
    f32x4 cur[8], nxt[8];
    if (gw < nitems) tr_load<MAP>(cur, W, Nsrc, gw, nblk, lane, gain);
    for (int it = gw; it < nitems; it += NGW) {
        const bool more = it + NGW < nitems;
        if (more) tr_load<MAP>(nxt, W, Nsrc, it + NGW, nblk, lane, gain);
        tr_store(cur, K, WT, scr, it, nblk, lane);
        if (more) {
#pragma unroll
            for (int i = 0; i < 8; ++i) cur[i] = nxt[i]; }
    }
}

struct MatDesc { const float* W; bf16* WT; const float* gain; int K, Nsrc, nblk, map; };
__device__ __forceinline__ int src_col_rt(int map, int n0) { return map == 1 ? src_col<1>(n0) : map == 2 ? src_col<2>(n0) : map == 3 ? src_col<3>(n0) : n0; }
__device__ __forceinline__ void trl_load(f32x4 (&v)[8], const MatDesc& d, int item, int lane) {
    const int kb = item / d.nblk, nb = item % d.nblk, k0 = 64 * kb, n0 = 32 * nb;
    const int nn = src_col_rt(d.map, n0) + (lane & 7) * 4; const bool ok = (nn >= 0 && nn < d.Nsrc);
#pragma unroll
    for (int i = 0; i < 8; ++i) { const int kk = 8 * i + (lane >> 3); v[i] = ok ? __builtin_nontemporal_load((const f32x4*)(d.W + (size_t)(k0 + kk) * d.Nsrc + nn)) : (f32x4){0.f, 0.f, 0.f, 0.f}; if (d.gain) v[i] = v[i] * d.gain[k0 + kk]; }
}
constexpr int NIT_W = 1536 + 512 + 512 + 384 + 256 + 512 + 2 * 2816 + 2 * 1408;
__device__ __forceinline__ MatDesc mat_of(KArgs A_, unsigned char* ws, int item, int& local) {
    MatDesc d; int r = item;
    if (r < 1536) { d = MatDesc{A_->in[3], (bf16*)(ws + WS_W_IN0), nullptr, 1024, 3080, 96, 2}; local = r; return d; } r -= 1536;
    if (r < 512) { d = MatDesc{A_->in[12], (bf16*)(ws + WS_W_OUT0), nullptr, 1024, 1024, 32, 0}; local = r; return d; } r -= 512;
    if (r < 512) { d = MatDesc{A_->in[13], (bf16*)(ws + WS_W_IN1), A_->in[1] + 1024, 1024, 800, 32, 0}; local = r; return d; } r -= 512;
    if (r < 384) { d = MatDesc{A_->in[15], (bf16*)(ws + WS_W_UQ), A_->in[14], 512, 1536, 48, 0}; local = r; return d; } r -= 384;
    if (r < 256) { d = MatDesc{A_->in[17], (bf16*)(ws + WS_W_UKV), A_->in[16], 256, 2048, 64, 3}; local = r; return d; } r -= 256;
    if (r < 512) { d = MatDesc{A_->in[20], (bf16*)(ws + WS_W_OUT1), nullptr, 1024, 1024, 32, 0}; local = r; return d; } r -= 512;
    if (r < 5632) { const int l = r / 2816; d = MatDesc{A_->in[21] + (size_t)l * 1024 * DFF2, (bf16*)(ws + WS_W_UP) + (size_t)l * DFF2 * 1024, A_->in[2] + l * 1024, 1024, DFF2, 176, 1}; local = r - l * 2816; return d; } r -= 5632;
    { const int l = r / 1408; d = MatDesc{A_->in[24] + (size_t)l * DFF * 1024, (bf16*)(ws + WS_W_DN) + (size_t)l * 1024 * DFF, nullptr, DFF, 1024, 32, 0}; local = r - l * 1408; return d; }
}

__device__ __forceinline__ void rms_rows_1024(const float* x, const float* g, bf16* o, int gw, int NGW, int lane) {
    f32x4 v[4], nx[4];
    if (gw < T_) {
#pragma unroll
        for (int j = 0; j < 4; ++j) v[j] = __builtin_nontemporal_load((const f32x4*)(x + (size_t)gw * D_) + lane + 64 * j); }
    for (int m = gw; m < T_; m += NGW) {
        const bool more = m + NGW < T_;
        if (more) {
#pragma unroll
            for (int j = 0; j < 4; ++j) nx[j] = __builtin_nontemporal_load((const f32x4*)(x + (size_t)(m + NGW) * D_) + lane + 64 * j); }
        float s = 0.f;
#pragma unroll
        for (int j = 0; j < 4; ++j) s += (v[j].x * v[j].x + v[j].y * v[j].y) + (v[j].z * v[j].z + v[j].w * v[j].w);
        const float rstd = 1.f / sqrtf(wave_sum(s) * (1.f / D_) + EPS);
        unsigned long long* o8 = (unsigned long long*)(o + (size_t)m * D_) + lane;
#pragma unroll
        for (int j = 0; j < 4; ++j) { const f32x4 gg = ((const f32x4*)g)[lane + 64 * j];
            o8[64 * j] = (unsigned long long)pk2(v[j].x * rstd * gg.x, v[j].y * rstd * gg.y) | ((unsigned long long)pk2(v[j].z * rstd * gg.z, v[j].w * rstd * gg.w) << 32); }
        if (more) {
#pragma unroll
            for (int j = 0; j < 4; ++j) v[j] = nx[j]; }
    }
}

__device__ __forceinline__ void rms_rows_dt(const float* x, const float* g, bf16* o, float* DTR, const LAS f32x4* W2, int gw, int NGW, int lane) {
    f32x4 v[4], nx[4];
    if (gw < T_) {
#pragma unroll
        for (int j = 0; j < 4; ++j) v[j] = __builtin_nontemporal_load((const f32x4*)(x + (size_t)gw * D_) + lane + 64 * j); }
    for (int m = gw; m < T_; m += NGW) {
        const bool more = m + NGW < T_;
        if (more) {
#pragma unroll
            for (int j = 0; j < 4; ++j) nx[j] = __builtin_nontemporal_load((const f32x4*)(x + (size_t)(m + NGW) * D_) + lane + 64 * j); }
        float s = 0.f; f32x4 d0 = {0.f, 0.f, 0.f, 0.f}, d1 = d0;
#pragma unroll
        for (int j = 0; j < 4; ++j) { s += (v[j].x * v[j].x + v[j].y * v[j].y) + (v[j].z * v[j].z + v[j].w * v[j].w);
#pragma unroll
            for (int e = 0; e < 4; ++e) { const int sl = j * 4 + e; const float xk = v[j][e]; d0 += W2[(sl * 2) * 64 + lane] * xk; d1 += W2[(sl * 2 + 1) * 64 + lane] * xk; } }
        const float rstd = 1.f / sqrtf(wave_sum(s) * (1.f / D_) + EPS);
#pragma unroll
        for (int e = 0; e < 4; ++e) { d0[e] = wave_sum(d0[e]); d1[e] = wave_sum(d1[e]); }
        if (lane == 0) { *(f32x4*)(DTR + (size_t)m * 8) = d0 * rstd; *(f32x4*)(DTR + (size_t)m * 8 + 4) = d1 * rstd; }
        unsigned long long* o8 = (unsigned long long*)(o + (size_t)m * D_) + lane;
#pragma unroll
        for (int j = 0; j < 4; ++j) { const f32x4 gg = ((const f32x4*)g)[lane + 64 * j];
            o8[64 * j] = (unsigned long long)pk2(v[j].x * rstd * gg.x, v[j].y * rstd * gg.y) | ((unsigned long long)pk2(v[j].z * rstd * gg.z, v[j].w * rstd * gg.w) << 32); }
        if (more) {
#pragma unroll
            for (int j = 0; j < 4; ++j) v[j] = nx[j]; }
    }
}

struct EpiF32Res {
    static constexpr bool PERM = false, AFTER_DRAIN = false;
    float* C; const float* R; int ldc;
    __device__ __forceinline__ void operator()(const pg8::f32x4 (&acc)[2][2][4][2], const pg8::Unit& u, int wr, int wc, int fr, int fq) const {
        const int row0 = u.pm * pg8::BM + wr * 64 + fr, col0 = u.pn * pg8::BM + wc * 32 + 4 * fq;
#pragma unroll
        for (int ai = 0; ai < 2; ++ai)
#pragma unroll
            for (int m = 0; m < 4; ++m) { const size_t off = (size_t)(row0 + ai * pg8::HALF + m * 16) * ldc + col0;
                f32x4 r[2][2];
#pragma unroll
                for (int bj = 0; bj < 2; ++bj)
#pragma unroll
                    for (int n = 0; n < 2; ++n) r[bj][n] = *(const f32x4*)(R + off + bj * pg8::HALF + n * 16);
#pragma unroll
                for (int bj = 0; bj < 2; ++bj)
#pragma unroll
                    for (int n = 0; n < 2; ++n) *(f32x4*)(C + off + bj * pg8::HALF + n * 16) = acc[ai][bj][m][n] + r[bj][n];
                asm volatile("" ::: "memory"); }
    }
};

template <bool RB16, bool OUTF, bool OUTB> struct EpiRes {
    static constexpr bool PERM = false, AFTER_DRAIN = false;
    float* C; const void* R; bf16* XB; unsigned long long* SSQ;
    __device__ __forceinline__ void operator()(const pg8::f32x4 (&acc)[2][2][4][2], const pg8::Unit& u, int wr, int wc, int fr, int fq) const {
        const int row0 = u.pm * pg8::BM + wr * 64 + fr, col0 = u.pn * pg8::BM + wc * 32 + 4 * fq;
#pragma unroll
        for (int ai = 0; ai < 2; ++ai)
#pragma unroll
            for (int m = 0; m < 4; ++m) { const int row = row0 + ai * pg8::HALF + m * 16; const size_t off = (size_t)row * 1024 + col0;
                f32x4 r[2][2];
#pragma unroll
                for (int bj = 0; bj < 2; ++bj)
#pragma unroll
                    for (int n = 0; n < 2; ++n) {
                        if (RB16) { const unsigned long long w = *(const unsigned long long*)((const bf16*)R + off + bj * pg8::HALF + n * 16); r[bj][n] = (f32x4){bflo((unsigned)w), bfhi((unsigned)w), bflo((unsigned)(w >> 32)), bfhi((unsigned)(w >> 32))}; }
                        else r[bj][n] = *(const f32x4*)((const float*)R + off + bj * pg8::HALF + n * 16); }
                float s = 0.f;
#pragma unroll
                for (int bj = 0; bj < 2; ++bj)
#pragma unroll
                    for (int n = 0; n < 2; ++n) { const f32x4 v = acc[ai][bj][m][n] + r[bj][n];
                        if (OUTF) *(f32x4*)(C + off + bj * pg8::HALF + n * 16) = v;
                        if (OUTB) { s += (v.x * v.x + v.y * v.y) + (v.z * v.z + v.w * v.w);
                            *(unsigned long long*)(XB + off + bj * pg8::HALF + n * 16) = (unsigned long long)pk2(v.x, v.y) | ((unsigned long long)pk2(v.z, v.w) << 32); } }
                if (OUTB) { s += __shfl_xor(s, 16); s += __shfl_xor(s, 32); if (fq == 0) atomicAdd(SSQ + row, (unsigned long long)(s * 1073741824.0f)); }
                asm volatile("" ::: "memory"); }
    }
};
typedef unsigned v2u __attribute__((ext_vector_type(2))); typedef float f32x2 __attribute__((ext_vector_type(2)));
__device__ __forceinline__ float rstd_of(const unsigned long long* SSQ, int row, float inv_n) { const v2u s = ((const v2u*)SSQ)[row]; const float c = inv_n * (1.0f / 1073741824.0f);
    return __builtin_amdgcn_rsqf(__builtin_fmaf((float)s.y, 4294967296.0f * c, __builtin_fmaf((float)s.x, c, EPS))); }
__device__ __forceinline__ f32x2 pk_add_one(f32x2 a) { asm("" : "+v"(a)); return a + 1.0f; }
template <int N> __device__ __forceinline__ float dpp_shr0(float v) { return __builtin_bit_cast(float, __builtin_amdgcn_update_dpp(0, __builtin_bit_cast(int, v), 0x110 + N, 0xf, 0xf, true)); }
template <int N> __device__ __forceinline__ float dpp_shr_old(float old, float v) { return __builtin_bit_cast(float, __builtin_amdgcn_update_dpp(__builtin_bit_cast(int, old), __builtin_bit_cast(int, v), 0x110 + N, 0xf, 0xf, false)); }
template <int N> __device__ __forceinline__ float dpp_ror(float v) { return __builtin_bit_cast(float, __builtin_amdgcn_update_dpp(0, __builtin_bit_cast(int, v), 0x120 + N, 0xf, 0xf, false)); }
struct EpiFfnUp {
    static constexpr bool PERM = true, AFTER_DRAIN = false;
    bf16* ACT; bf16* UB; const unsigned long long* SSQ; const float* cw; const float* cb;
    __device__ __forceinline__ void operator()(const pg8::f32x4 (&acc)[2][2][4][2], const pg8::Unit& u, int wr, int wc, int fr, int fq) const {
        const int ch0 = u.pn * 128 + wc * 32 + 8 * fq;
        float rs[2][4];
#pragma unroll
        for (int ai = 0; ai < 2; ++ai)
#pragma unroll
            for (int m = 0; m < 4; ++m) rs[ai][m] = rstd_of(SSQ, u.pm * pg8::BM + ai * pg8::HALF + wr * 64 + 4 * fr + m, 1.0f / 1024.0f);
        unsigned long long keep[2][4];
#pragma unroll
        for (int n = 0; n < 2; ++n) {
            __builtin_amdgcn_sched_barrier(0);
            const int ch = ch0 + 4 * n;
            const f32x4 wg0 = *(const f32x4*)(cw + ch), wg1 = *(const f32x4*)(cw + DFF2 + ch), wg2 = *(const f32x4*)(cw + 2 * DFF2 + ch), bg = *(const f32x4*)(cw + 3 * DFF2 + ch);
            const f32x4 wu0 = *(const f32x4*)(cw + DFF + ch), wu1 = *(const f32x4*)(cw + DFF2 + DFF + ch), wu2 = *(const f32x4*)(cw + 2 * DFF2 + DFF + ch), bu = *(const f32x4*)(cw + 3 * DFF2 + DFF + ch);
#pragma unroll
            for (int ai = 0; ai < 2; ++ai) {
                const int rowc = u.pm * pg8::BM + ai * pg8::HALF + wr * 64;
                f32x4 g[4], uu[4];
#pragma unroll
                for (int m = 0; m < 4; ++m) { g[m] = acc[ai][0][m][n] * rs[ai][m]; uu[m] = acc[ai][1][m][n] * rs[ai][m]; }
                f32x4 g2p, g3p, u2p, u3p;
#pragma unroll
                for (int j = 0; j < 4; ++j) { g2p[j] = dpp_shr0<1>(g[2][j]); g3p[j] = dpp_shr0<1>(g[3][j]); u2p[j] = dpp_shr0<1>(uu[2][j]); u3p[j] = dpp_shr0<1>(uu[3][j]); }
#pragma unroll
                for (int m = 0; m < 4; ++m) {
                    const f32x4 sg1 = (m == 0) ? g3p : g[m - 1], sg2 = (m == 0) ? g2p : (m == 1) ? g3p : g[m - 2];
                    const f32x4 su1 = (m == 0) ? u3p : uu[m - 1], su2 = (m == 0) ? u2p : (m == 1) ? u3p : uu[m - 2];
                    const f32x4 cg = bg + wg0 * sg2 + wg1 * sg1 + wg2 * g[m], cu = bu + wu0 * su2 + wu1 * su1 + wu2 * uu[m];
                    f32x4 r_;
                    { const f32x2 d0 = pk_add_one((f32x2){__builtin_amdgcn_exp2f(cg[0]), __builtin_amdgcn_exp2f(cg[1])}), d1 = pk_add_one((f32x2){__builtin_amdgcn_exp2f(cg[2]), __builtin_amdgcn_exp2f(cg[3])});
                      r_[0] = __builtin_amdgcn_rcpf(d0.x); r_[1] = __builtin_amdgcn_rcpf(d0.y); r_[2] = __builtin_amdgcn_rcpf(d1.x); r_[3] = __builtin_amdgcn_rcpf(d1.y); }
                    const f32x4 a = cg * r_ * cu;
                    const int row = rowc + 4 * fr + m;
                    const unsigned long long pk_ = (unsigned long long)pk2(a[0], a[1]) | ((unsigned long long)pk2(a[2], a[3]) << 32);
                    if (n == 0) { keep[ai][m] = pk_; asm volatile("" : "+v"(keep[ai][m])); }
                    else if (!(fr == 0 && m < 2)) { v4u w; w.x = (unsigned)keep[ai][m]; w.y = (unsigned)(keep[ai][m] >> 32); w.z = (unsigned)pk_; w.w = (unsigned)(pk_ >> 32); *(v4u*)(ACT + (size_t)row * DFF + ch0) = w; }
                    if ((fr == 0 && m < 2) || (fr == 15 && m >= 2)) { const int slot = m; bf16* ub = UB + ((size_t)(rowc >> 6) * 4 + slot) * DFF2 + ch;
                        *(unsigned long long*)ub = (unsigned long long)pk2(g[m][0], g[m][1]) | ((unsigned long long)pk2(g[m][2], g[m][3]) << 32);
                        *(unsigned long long*)(ub + DFF) = (unsigned long long)pk2(uu[m][0], uu[m][1]) | ((unsigned long long)pk2(uu[m][2], uu[m][3]) << 32); }
                }
            }
        }
    }
};


struct EpiScale {
    static constexpr bool PERM = true, AFTER_DRAIN = false;
    bf16* O; int ldc; const unsigned long long* SSQ; float inv_n;
    __device__ __forceinline__ void operator()(const pg8::f32x4 (&acc)[2][2][4][2], const pg8::Unit& u, int wr, int wc, int fr, int fq) const {
        const int row0 = u.pm * pg8::BM + wr * 64 + fr, col0 = u.pn * pg8::BM + wc * 32 + 8 * fq;
#pragma unroll
        for (int ai = 0; ai < 2; ++ai)
#pragma unroll
            for (int m = 0; m < 4; ++m) { const int row = row0 + ai * pg8::HALF + m * 16; const float rs = rstd_of(SSQ, row, inv_n); bf16* rowp = O + (size_t)row * ldc + col0;
#pragma unroll
                for (int bj = 0; bj < 2; ++bj) { const f32x4 v0 = acc[ai][bj][m][0] * rs, v1 = acc[ai][bj][m][1] * rs;
                    v4u w; w.x = pk2(v0[0], v0[1]); w.y = pk2(v0[2], v0[3]); w.z = pk2(v1[0], v1[1]); w.w = pk2(v1[2], v1[3]); *(v4u*)(rowp + bj * pg8::HALF) = w; } }
    }
};
struct EpiMlaIn {
    static constexpr bool PERM = true, AFTER_DRAIN = false;
    bf16* O; const unsigned long long* SSQ; unsigned long long* SSQ_Q; unsigned long long* SSQ_KV; float* SSQPE; float* RG; const float* kg; const float* TAB;
    __device__ __forceinline__ void operator()(const pg8::f32x4 (&acc)[2][2][4][2], const pg8::Unit& u, int wr, int wc, int fr, int fq) const {
        const int row0 = u.pm * pg8::BM + wr * 64 + fr, col0 = u.pn * pg8::BM + wc * 32 + 8 * fq;
        unsigned long long* tgt = (u.pn < 2) ? SSQ_Q : SSQ_KV;
        if (u.pn < 3) {
#pragma unroll
        for (int ai = 0; ai < 2; ++ai)
#pragma unroll
            for (int m = 0; m < 4; ++m) { const int row = row0 + ai * pg8::HALF + m * 16; const float rs = rstd_of(SSQ, row, 1.0f / 1024.0f); bf16* rowp = O + (size_t)row * 1024 + col0; float s = 0.f;
#pragma unroll
                for (int bj = 0; bj < 2; ++bj) { const f32x4 v0 = acc[ai][bj][m][0] * rs, v1 = acc[ai][bj][m][1] * rs;
                    s += (v0[0] * v0[0] + v0[1] * v0[1]) + (v0[2] * v0[2] + v0[3] * v0[3]) + (v1[0] * v1[0] + v1[1] * v1[1]) + (v1[2] * v1[2] + v1[3] * v1[3]);
                    v4u w; w.x = pk2(v0[0], v0[1]); w.y = pk2(v0[2], v0[3]); w.z = pk2(v1[0], v1[1]); w.w = pk2(v1[2], v1[3]); *(v4u*)(rowp + bj * pg8::HALF) = w; }
                s += __shfl_xor(s, 16); s += __shfl_xor(s, 32); if (fq == 0) atomicAdd(tgt + row, (unsigned long long)(s * 1073741824.0f)); asm volatile("" ::: "memory"); }
        } else if (wc == 0) {
            const f32x4 g0 = *(const f32x4*)(kg + 64 + 8 * fq), g1 = *(const f32x4*)(kg + 64 + 8 * fq + 4);
#pragma unroll
            for (int ai = 0; ai < 2; ++ai)
#pragma unroll
                for (int m = 0; m < 4; ++m) { const int row = row0 + ai * pg8::HALF + m * 16, pos = row & 2047; const float rs = rstd_of(SSQ, row, 1.0f / 1024.0f);
                    const f32x4 v0 = acc[ai][0][m][0] * rs, v1 = acc[ai][0][m][1] * rs;
                    float s = (v0[0] * v0[0] + v0[1] * v0[1]) + (v0[2] * v0[2] + v0[3] * v0[3]) + (v1[0] * v1[0] + v1[1] * v1[1]) + (v1[2] * v1[2] + v1[3] * v1[3]);
                    s += __shfl_xor(s, 16); s += __shfl_xor(s, 32); if (fq == 0) SSQPE[row] = s;
                    const f32x4 y0 = v0 * g0, y1 = v1 * g1;
                    f32x4 p0, p1;
#pragma unroll
                    for (int j = 0; j < 4; ++j) { p0[j] = __shfl_xor(y0[j], 32); p1[j] = __shfl_xor(y1[j], 32); }
                    const float* tb = TAB + (pos * 16 + 8 * (fq & 1)) * 2; const f32x4 ta = *(const f32x4*)tb, tb4 = *(const f32x4*)(tb + 4), tc = *(const f32x4*)(tb + 8), td = *(const f32x4*)(tb + 12);
                    const f32x4 c0 = {ta[0], ta[2], tb4[0], tb4[2]}, s0 = {ta[1], ta[3], tb4[1], tb4[3]}, c1 = {tc[0], tc[2], td[0], td[2]}, s1 = {tc[1], tc[3], td[1], td[3]};
                    f32x4 o0, o1;
                    if (fq < 2) { o0 = y0 * c0 - p0 * s0; o1 = y1 * c1 - p1 * s1; } else { o0 = p0 * s0 + y0 * c0; o1 = p1 * s1 + y1 * c1; }
                    float* rg = RG + (size_t)row * 32 + 8 * fq; *(f32x4*)rg = o0; *(f32x4*)(rg + 4) = o1; asm volatile("" ::: "memory"); }
        }
    }
};
struct EpiUkv {
    static constexpr bool PERM = true, AFTER_DRAIN = false;
    bf16* K2; bf16* V2; const unsigned long long* SSQ; const float* SSQPE; const float* RG; const float* kg;
    __device__ __forceinline__ void operator()(const pg8::f32x4 (&acc)[2][2][4][2], const pg8::Unit& u, int wr, int wc, int fr, int fq) const {
        const int row0 = u.pm * pg8::BM + wr * 64 + fr;
        if (u.pn < 4) {
            const int head = 4 * u.pn + wc;
            f32x4 g1[2], g2[2];
#pragma unroll
            for (int n = 0; n < 2; ++n) { g1[n] = *(const f32x4*)(kg + 8 * fq + 4 * n); g2[n] = *(const f32x4*)(kg + 32 + 8 * fq + 4 * n); }
#pragma unroll
            for (int ai = 0; ai < 2; ++ai)
#pragma unroll
                for (int m = 0; m < 4; ++m) { const int row = row0 + ai * pg8::HALF + m * 16; const float rs = rstd_of(SSQ, row, 1.0f / 256.0f);
                    f32x4 a[2], b[2]; float s = 0.f;
#pragma unroll
                    for (int n = 0; n < 2; ++n) { a[n] = acc[ai][0][m][n] * rs; b[n] = acc[ai][1][m][n] * rs; s += (a[n][0] * a[n][0] + a[n][1] * a[n][1]) + (a[n][2] * a[n][2] + a[n][3] * a[n][3]) + (b[n][0] * b[n][0] + b[n][1] * b[n][1]) + (b[n][2] * b[n][2] + b[n][3] * b[n][3]); }
                    s += __shfl_xor(s, 16); s += __shfl_xor(s, 32);
                    const float rh = 1.f / sqrtf((s + SSQPE[row]) * (1.f / 96.f) + EPS);
                    const int pos = row & 2047; bf16* rp = K2 + ((((size_t)(row >> 11) * 16 + head) * 32 + (pos >> 6)) * 12 + fq) * 512 + (pos & 63) * 8;
                    { const f32x4 o0 = a[0] * rh * g1[0], o1 = a[1] * rh * g1[1]; v4u w; w.x = pk2(o0[0], o0[1]); w.y = pk2(o0[2], o0[3]); w.z = pk2(o1[0], o1[1]); w.w = pk2(o1[2], o1[3]); *(v4u*)rp = w; }
                    { const f32x4 o0 = b[0] * rh * g2[0], o1 = b[1] * rh * g2[1]; v4u w; w.x = pk2(o0[0], o0[1]); w.y = pk2(o0[2], o0[3]); w.z = pk2(o1[0], o1[1]); w.w = pk2(o1[2], o1[3]); *(v4u*)(rp + 4 * 512) = w; }
                    { const float* rg = RG + (size_t)row * 32 + 8 * fq; const f32x4 o0 = *(const f32x4*)rg * rh, o1 = *(const f32x4*)(rg + 4) * rh; v4u w; w.x = pk2(o0[0], o0[1]); w.y = pk2(o0[2], o0[3]); w.z = pk2(o1[0], o1[1]); w.w = pk2(o1[2], o1[3]); *(v4u*)(rp + 8 * 512) = w; }
                    asm volatile("" ::: "memory"); }
        } else {
            bf16* dst = V2 + (u.pn - 4) * 256 + wc * 32 + 8 * fq;
#pragma unroll
            for (int ai = 0; ai < 2; ++ai)
#pragma unroll
                for (int m = 0; m < 4; ++m) { const int row = row0 + ai * pg8::HALF + m * 16; const float rs = rstd_of(SSQ, row, 1.0f / 256.0f); bf16* rp = dst + (size_t)row * 1024;
#pragma unroll
                    for (int bj = 0; bj < 2; ++bj) { const f32x4 v0 = acc[ai][bj][m][0] * rs, v1 = acc[ai][bj][m][1] * rs;
                        v4u w; w.x = pk2(v0[0], v0[1]); w.y = pk2(v0[2], v0[3]); w.z = pk2(v1[0], v1[1]); w.w = pk2(v1[2], v1[3]); *(v4u*)(rp + bj * pg8::HALF) = w; } }
        }
    }
};

struct EpiIn0 {
    static constexpr bool PERM = true, AFTER_DRAIN = false;
    bf16* QK; bf16* KC; const float* TAB; const float* qn; const float* kn; float* KM; float* DTR;
    __device__ __forceinline__ void operator()(const pg8::f32x4 (&acc)[2][2][4][2], const pg8::Unit& u, int wr, int wc, int fr, int fq) const {
        const int row0 = u.pm * pg8::BM + wr * 64 + fr;
        if (u.pn < 4) {
            const bool isq = u.pn < 2; const float* gn = isq ? qn : kn; const int head = 4 * (u.pn & 1) + wc;
            bf16* dst = QK + (isq ? 0 : 512) + head * 64 + 8 * fq;
            f32x4 g1[2], g2[2], ks1[2], ks2[2];
#pragma unroll
            for (int n = 0; n < 2; ++n) { g1[n] = *(const f32x4*)(gn + 8 * fq + 4 * n); g2[n] = *(const f32x4*)(gn + 32 + 8 * fq + 4 * n); ks1[n] = (f32x4){0.f, 0.f, 0.f, 0.f}; ks2[n] = ks1[n]; }
#pragma unroll
            for (int ai = 0; ai < 2; ++ai)
#pragma unroll
                for (int m = 0; m < 4; ++m) { const int row = row0 + ai * pg8::HALF + m * 16, pos = row & 2047;
                    float s = 0.f;
#pragma unroll
                    for (int n = 0; n < 2; ++n) { const f32x4 a = acc[ai][0][m][n], b = acc[ai][1][m][n]; s += (a[0] * a[0] + a[1] * a[1]) + (a[2] * a[2] + a[3] * a[3]) + (b[0] * b[0] + b[1] * b[1]) + (b[2] * b[2] + b[3] * b[3]); }
                    s += __shfl_xor(s, 16); s += __shfl_xor(s, 32);
                    float rstd = 1.f / sqrtf(s * (1.f / 64.f) + EPS); if (isq) rstd *= 0.18033688011112042f;
                    f32x4 o1[2], o2[2];
#pragma unroll
                    for (int n = 0; n < 2; ++n) { const float* tb = TAB + (pos * 32 + 8 * fq + 4 * n) * 2; const f32x4 t0 = *(const f32x4*)tb, t1 = *(const f32x4*)(tb + 4);
                        const f32x4 cs_ = {t0[0], t0[2], t1[0], t1[2]}, sn = {t0[1], t0[3], t1[1], t1[3]};
                        const f32x4 y1 = acc[ai][0][m][n] * rstd * g1[n], y2 = acc[ai][1][m][n] * rstd * g2[n];
                        o1[n] = y1 * cs_ - y2 * sn; o2[n] = y1 * sn + y2 * cs_; ks1[n] += o1[n]; ks2[n] += o2[n]; }
                    bf16* rp = dst + (size_t)row * 1024; int st2 = 32;
                    if (!isq) { rp = KC + ((((size_t)(row >> 11) * 8 + head) * 32 + (pos >> 6)) * 8 + fq) * 512 + (pos & 63) * 8; st2 = 4 * 512; }
                    { v4u w; w.x = pk2(o1[0][0], o1[0][1]); w.y = pk2(o1[0][2], o1[0][3]); w.z = pk2(o1[1][0], o1[1][1]); w.w = pk2(o1[1][2], o1[1][3]); *(v4u*)rp = w; }
                    { v4u w; w.x = pk2(o2[0][0], o2[0][1]); w.y = pk2(o2[0][2], o2[0][3]); w.z = pk2(o2[1][0], o2[1][1]); w.w = pk2(o2[1][2], o2[1][3]); *(v4u*)(rp + st2) = w; }
                    asm volatile("" ::: "memory"); }
            if (!isq) {
                float* km = KM + (((size_t)(u.pm >> 3) * 8 + (u.pm & 7)) * 8 + head) * 64 + 8 * fq;
#pragma unroll
                for (int n = 0; n < 2; ++n)
#pragma unroll
                    for (int j = 0; j < 4; ++j) { float a = ks1[n][j], b = ks2[n][j];
#pragma unroll
                        for (int o = 1; o < 16; o <<= 1) { a += __shfl_xor(a, o); b += __shfl_xor(b, o); }
                        if (fr == 0) { atomicAdd(km + 4 * n + j, a * (1.f / 256.f)); atomicAdd(km + 32 + 4 * n + j, b * (1.f / 256.f)); } } }
        } else if (u.pn < 12) {
            bf16* dst = QK + (size_t)(u.pn >> 2) * ((size_t)T_ * 1024) + (u.pn & 3) * 256 + wc * 32 + 8 * fq;
#pragma unroll
            for (int ai = 0; ai < 2; ++ai)
#pragma unroll
                for (int m = 0; m < 4; ++m) { bf16* rp = dst + (size_t)(row0 + ai * pg8::HALF + m * 16) * 1024;
#pragma unroll
                    for (int bj = 0; bj < 2; ++bj) { const f32x4 v0 = acc[ai][bj][m][0], v1 = acc[ai][bj][m][1];
                        v4u w; w.x = pk2(v0[0], v0[1]); w.y = pk2(v0[2], v0[3]); w.z = pk2(v1[0], v1[1]); w.w = pk2(v1[2], v1[3]); *(v4u*)(rp + bj * pg8::HALF) = w; } }
        } else if (wc == 0 && fq == 0) {
#pragma unroll
            for (int ai = 0; ai < 2; ++ai)
#pragma unroll
                for (int m = 0; m < 4; ++m) { float* rp = DTR + (size_t)(row0 + ai * pg8::HALF + m * 16) * 8; *(f32x4*)rp = acc[ai][0][m][0]; *(f32x4*)(rp + 4) = acc[ai][0][m][1]; }
        }
    }
};

template <class Epi, int AROW = 0> __device__ __forceinline__ void run_gemm(LAS unsigned char* lds, const bf16* A, const bf16* Bt, int M, int N, int K, const Epi& E, int lda = 0) {
    pg8::Gemm g{A, Bt, M, N, K, lda ? lda : K}; pg8::StaticOrder S; S.init(M, N, (int)gridDim.x, (int)blockIdx.x);
    pg8::gemm_phase<Epi, pg8::StaticOrder, PG8_ALIGN, PG8_SP2, AROW>(lds + RING_OFF, g, S, E);
}

#define NPHASES 40
__global__ void __launch_bounds__(NTHR, 2) fwd(Args args) {
    extern __shared__ __attribute__((aligned(16))) unsigned char lds_raw[];
    LAS unsigned char* lds = (LAS unsigned char*)lds_raw;
    volatile LAS unsigned* MISC = (volatile LAS unsigned*)(lds + MISC_OFF);
    {
        const int tid0 = threadIdx.x;
        for (int u = tid0; u < (LDS_BYTES - LDSCTL_OFF) / 4; u += NTHR) ((LAS unsigned*)(lds + LDSCTL_OFF))[u] = 0u;
    }
    __syncthreads();
    int lo, hi; { KArgs A0 = kargs(); lo = A0->ph_lo; hi = A0->ph_hi; }
    const bool multi = (hi - lo) > 1;
    XcdBarrier bar; bar.bar = nullptr; bar.x = 0; bar.st = nullptr;
    if (multi) { KArgs A0 = kargs(); bar = xcd_barrier_post((unsigned*)((gu32*)(A0->ws + WS_CTL) + CW_BAR), MISC + 8); }
#define IN(k) (lo <= (k) && (k) < hi)
#ifndef PROBE_MASK
#define PROBE_MASK 0u
#endif
    unsigned long long pr_acc = 0ull, pr_t = 0ull;
    if (PROBE_MASK) pr_t = __builtin_amdgcn_s_memrealtime();
#define SEAM(k) do { if (IN(k) && IN((k) + 1)) xcd_barrier(bar); \
        if (PROBE_MASK) { const unsigned long long now_ = __builtin_amdgcn_s_memrealtime(); if ((PROBE_MASK >> (k)) & 1u) pr_acc += now_ - pr_t; pr_t = now_; } } while (0)

    if (IN(0)) { PH_VARS
        LAS float* scr = (LAS float*)(lds + RING_OFF + wave * 16384);
        { f32x4 cur[8], nxt[8]; int it = gw, li = 0, ln = 0; MatDesc d{}, dn{};
          if (it < NIT_W) { d = mat_of(A_, ws, it, li); trl_load(cur, d, li, lane); }
          while (it < NIT_W) { const int nit = it + NGW; const bool more = nit < NIT_W;
              if (more) { dn = mat_of(A_, ws, nit, ln); trl_load(nxt, dn, ln, lane); }
              tr_store(cur, d.K, d.WT, scr, li, d.nblk, lane);
              if (more) {
#pragma unroll
                  for (int i = 0; i < 8; ++i) cur[i] = nxt[i];
                  d = dn; li = ln; }
              it = nit; } }
        { float* cws = (float*)(ws + WS_CWS); const float* cw_ = A_->in[22]; const float* cb_ = A_->in[23];
          for (int i = gt; i < 2 * 4 * DFF2; i += NGT) { const int l = i / (4 * DFF2), r = i - l * 4 * DFF2, k = r / DFF2, c = r - k * DFF2;
              const float v = (k < 3) ? cw_[((size_t)l * 3 + k) * DFF2 + c] : cb_[(size_t)l * DFF2 + c]; cws[i] = v * (c < DFF ? -1.44269504088896341f : -0.693147180559945309f); } }
        float* t64 = (float*)(ws + WS_TAB64); float* t32 = (float*)(ws + WS_TAB32);
        for (int i = gt; i < 2048 * 32; i += NGT) { const int pos = i >> 5, f = i & 31; const float inv = 1.0f / powf(10000.0f, (float)(2 * f) / 64.0f); const float ang = (float)pos * inv; t64[2 * i] = cosf(ang); t64[2 * i + 1] = sinf(ang); }
        for (int i = gt; i < 2048 * 16; i += NGT) { const int pos = i >> 4, f = i & 15; const float inv = 1.0f / powf(10000.0f, (float)(2 * f) / 32.0f); const float ang = (float)pos * inv; t32[2 * i] = cosf(ang); t32[2 * i + 1] = sinf(ang); }
        asm volatile("s_waitcnt vmcnt(0) lgkmcnt(0)" ::: "memory"); __syncthreads();
        { LAS f32x4* W2 = (LAS f32x4*)(lds + RING_OFF); const float* Wi = A_->in[3]; const float* gg = A_->in[1];
          for (int i = tid; i < 2048; i += NTHR) { const int ln = i & 63, sh = i >> 6, sl = sh >> 1, half = sh & 1, k = 4 * ln + 256 * (sl >> 2) + (sl & 3);
              W2[i] = *(const f32x4*)(Wi + (size_t)k * 3080 + 3072 + 4 * half) * gg[k]; }
          asm volatile("s_waitcnt vmcnt(0) lgkmcnt(0)" ::: "memory"); __syncthreads();
          rms_rows_dt(x, A_->in[1], XN, (float*)(ws + WS_DTR), W2, gw, NGW, lane); }
    }
    SEAM(0);
    if (IN(1)) { PH_VARS EpiIn0 E{(bf16*)(ws + L0_QK), (bf16*)(ws + L0_KC), TAB64, A_->in[10], A_->in[11], (float*)(ws + WS_KMEAN), (float*)(ws + WS_DTR)}; run_gemm(lds, XN, (const bf16*)(ws + WS_W_IN0), T_, 3072, 1024, E); }
    SEAM(1);
    if (IN(2)) { PH_VARS
        for (int u = blockIdx.x; u < 512; u += G) ssd::states_unit(lds, u >> 1, u & 1, (const bf16*)(ws + L0_XBC), (const float*)(ws + WS_DTR), A_->in[4], A_->in[5], A_->in[6], A_->in[7], (float*)(ws + L0_ST), (float*)(ws + WS_CEND));
    }
    SEAM(2);
    if (IN(3)) { PH_VARS
        const float* ST = (const float*)(ws + L0_ST); const float* CEND = (const float*)(ws + WS_CEND); bf16* HIN = (bf16*)(ws + L0_HIN);
        for (int i = gt; i < 16 * 8 * 64 * 128 / 4; i += NGT) {
            const int pn = (i & 2047) * 4, h = (i >> 11) & 7, b = i >> 14; f32x4 hst = {0.f, 0.f, 0.f, 0.f}; f32x4 tmp[16]; float dec[16];
#pragma unroll
            for (int c = 0; c < 16; ++c) { tmp[c] = *(const f32x4*)(ST + (((size_t)((b * 16 + c) * 8 + h) << 13) + pn)); dec[c] = CEND[(b * 16 + c) * 8 + h]; }
#pragma unroll
            for (int c = 0; c < 16; ++c) { const size_t idx = ((size_t)((b * 16 + c) * 8 + h) << 13) + pn;
                *(unsigned long long*)(HIN + idx) = (unsigned long long)pk2(hst.x, hst.y) | ((unsigned long long)pk2(hst.z, hst.w) << 32);
                hst = hst * __expf(dec[c]) + tmp[c]; }
        }
        const bf16* QK = (const bf16*)(ws + L0_QK); const bf16* VZ = (const bf16*)(ws + L0_VZ); const float* KM = (const float*)(ws + WS_KMEAN); bf16* MIX = (bf16*)(ws + L0_MIX);
        asm volatile("s_waitcnt vmcnt(0) lgkmcnt(0)" ::: "memory"); __syncthreads();
        float kb0; { float gm = fabsf(A_->in[11][lane]);
#pragma unroll
          for (int o_ = 1; o_ < 64; o_ <<= 1) gm = fmaxf(gm, __shfl_xor(gm, o_));
          kb0 = 8.0f * 1.02f * gm; }
        { int tb = 0, pbh = -1;
          for (int i = blockIdx.x; i < 1024; i += G) {
            const int s_ = i >> 8, c = i & 255, bh = c >> 1, half = c & 1, qb = (s_ & 1) ? (s_ - 1 + half) : (7 - half - s_), b = bh >> 3, h = bh & 7;
            const int in_ = i + G; const bool hn = (in_ < 1024) && (((in_ & 255) >> 1) == bh);
            at2::Tensors TT{QK + h * 64, (const bf16*)(ws + L0_KC) + (size_t)(b * 8 + h) * (32 * 8 * 512), VZ + h * 64, MIX + h * 64, 1024, 0, 1024, 1024};
            at2::attn_unit_p<64, true, false, 2>(lds, TT, (long)b * 2048, qb, KM + b * 4096 + h * 64, nullptr, nullptr, kb0, tb, pbh == bh, hn);
            tb = (tb + 4 * (qb + 1)) % 6; pbh = hn ? bh : -1; } }
    }
    SEAM(3);
    if (IN(4)) { PH_VARS
        for (int u = blockIdx.x; u < 512; u += G) ssd::out_unit(lds, u >> 1, u & 1, (const bf16*)(ws + L0_XBC), (const bf16*)(ws + L0_VZ), (const float*)(ws + WS_DTR), A_->in[4], A_->in[5], A_->in[6], A_->in[7],
                                                               (const bf16*)(ws + L0_HIN), A_->in[8], A_->in[9], (bf16*)(ws + L0_MIX));
    }
    SEAM(4);
    if (IN(5)) { PH_VARS EpiRes<false, false, true> E{nullptr, x, XN, (unsigned long long*)(ws + WS_SSQA)}; run_gemm(lds, (const bf16*)(ws + L0_MIX), (const bf16*)(ws + WS_W_OUT0), T_, 1024, 1024, E); }
    SEAM(5);
#define FFN_PHASES(P, L, AIN, SSQ_IN, LASTL, SSQ_OUT) \
    if (IN(P)) { PH_VARS EpiFfnUp E{(bf16*)(ws + FF_ACT), (bf16*)(ws + FF_UB), (const unsigned long long*)(ws + (SSQ_IN)), (const float*)(ws + WS_CWS) + (size_t)(L) * 4 * DFF2, nullptr}; \
        run_gemm<EpiFfnUp, 1>(lds, (const bf16*)(ws + (AIN)), (const bf16*)(ws + WS_W_UP) + (size_t)(L) * DFF2 * 1024, T_, DFF2, 1024, E); } \
    SEAM(P); \
    if (IN((P) + 1)) { PH_VARS \
        const bf16* UB = (const bf16*)(ws + FF_UB); bf16* ACT = (bf16*)(ws + FF_ACT); const float* cw = A_->in[22] + (size_t)(L) * 3 * DFF2; const float* cb = A_->in[23] + (size_t)(L) * DFF2; \
        for (int i = gt; i < 512 * 2 * (DFF / 8); i += NGT) {          \
            const int c0 = (i % (DFF / 8)) * 8, rr = (i / (DFF / 8)) & 1, ck = i / (2 * (DFF / 8)); const bool first = (ck & 31) == 0;     \
            float ag[8], au[8]; \
            _Pragma("unroll") for (int j = 0; j < 8; ++j) { ag[j] = cb[c0 + j]; au[j] = cb[DFF + c0 + j]; } \
            _Pragma("unroll") for (int k = 0; k < 3; ++k) { const int rel = rr - 2 + k;     \
                if (rel >= 0 || !first) { const bf16* src = (rel >= 0) ? UB + ((size_t)ck * 4 + rel) * DFF2 : UB + ((size_t)(ck - 1) * 4 + 4 + rel) * DFF2; \
                    const v4u wg = *(const v4u*)(src + c0); const v4u wu = *(const v4u*)(src + DFF + c0); const float* kg = cw + k * DFF2 + c0; const float* ku = kg + DFF; \
                    ag[0] += kg[0] * bflo(wg.x); ag[1] += kg[1] * bfhi(wg.x); ag[2] += kg[2] * bflo(wg.y); ag[3] += kg[3] * bfhi(wg.y); ag[4] += kg[4] * bflo(wg.z); ag[5] += kg[5] * bfhi(wg.z); ag[6] += kg[6] * bflo(wg.w); ag[7] += kg[7] * bfhi(wg.w); \
                    au[0] += ku[0] * bflo(wu.x); au[1] += ku[1] * bfhi(wu.x); au[2] += ku[2] * bflo(wu.y); au[3] += ku[3] * bfhi(wu.y); au[4] += ku[4] * bflo(wu.z); au[5] += ku[5] * bfhi(wu.z); au[6] += ku[6] * bflo(wu.w); au[7] += ku[7] * bfhi(wu.w); } } \
            v4u o; o.x = pk2(silu_f(ag[0]) * au[0], silu_f(ag[1]) * au[1]); o.y = pk2(silu_f(ag[2]) * au[2], silu_f(ag[3]) * au[3]); o.z = pk2(silu_f(ag[4]) * au[4], silu_f(ag[5]) * au[5]); o.w = pk2(silu_f(ag[6]) * au[6], silu_f(ag[7]) * au[7]); \
            *(v4u*)(ACT + ((size_t)ck * 64 + rr) * DFF + c0) = o; } } \
    SEAM((P) + 1); \
    if (IN((P) + 2)) { PH_VARS EpiRes<true, LASTL, !LASTL> E{out, (const bf16*)(ws + (AIN)), (bf16*)(ws + (AIN)), (unsigned long long*)(ws + (SSQ_OUT))}; run_gemm(lds, (const bf16*)(ws + FF_ACT), (const bf16*)(ws + WS_W_DN) + (size_t)(L) * 1024 * DFF, T_, 1024, DFF, E); } \
    SEAM((P) + 2);
    FFN_PHASES(6, 0, WS_XN, WS_SSQA, false, WS_SSQB)
    if (IN(9)) { PH_VARS EpiMlaIn E{(bf16*)(ws + L1_C1), (const unsigned long long*)(ws + WS_SSQB), (unsigned long long*)(ws + WS_SSQQ), (unsigned long long*)(ws + WS_SSQKV), (float*)(ws + WS_SSQPE), (float*)(ws + WS_RG), A_->in[19], TAB32}; run_gemm(lds, XN, (const bf16*)(ws + WS_W_IN1), T_, 1024, 1024, E); }
    SEAM(9);
    if (IN(10)) { PH_VARS const bf16* C1 = (const bf16*)(ws + L1_C1);
        { EpiScale E{(bf16*)(ws + L1_QR), 1536, (const unsigned long long*)(ws + WS_SSQQ), 1.0f / 512.0f}; run_gemm(lds, C1, (const bf16*)(ws + WS_W_UQ), T_, 1536, 512, E, 1024); }
        { EpiUkv E{(bf16*)(ws + L1_K2), (bf16*)(ws + L1_V2), (const unsigned long long*)(ws + WS_SSQKV), (const float*)(ws + WS_SSQPE), (const float*)(ws + WS_RG), A_->in[19]}; run_gemm(lds, C1 + 512, (const bf16*)(ws + WS_W_UKV), T_, 2048, 256, E, 1024); } }
    SEAM(10);
    if (IN(11)) { PH_VARS
        const bf16* Q2 = (const bf16*)(ws + L1_QR); const bf16* K2 = (const bf16*)(ws + L1_K2); const bf16* V2 = (const bf16*)(ws + L1_V2); bf16* O = (bf16*)(ws + L1_O);
        float kb1; { float gm = fmaxf(fabsf(A_->in[19][lane]), (lane < 32) ? fabsf(A_->in[19][64 + lane]) : 0.f);
#pragma unroll
          for (int o_ = 1; o_ < 64; o_ <<= 1) gm = fmaxf(gm, __shfl_xor(gm, o_));
          kb1 = 9.797958971f * 1.02f * gm; }
        { int tb = 0, pbh = -1;
          for (int i = blockIdx.x; i < 2048; i += G) {
            const int s_ = i >> 8, bh = i & 255, qb = 7 - s_, b = bh >> 4, h = bh & 15;
            const int in_ = i + G; const bool hn = (in_ < 2048) && ((in_ & 255) == bh);
            at2::Tensors TT{Q2 + h * 96, K2 + (size_t)(b * 16 + h) * (32 * 12 * 512), V2 + h * 64, O + h * 64, 1536, 0, 1024, 1024};
            at2::attn_unit_p<96, false, true, 2>(lds, TT, (long)b * 2048, qb, nullptr, A_->in[18], TAB32, kb1, tb, pbh == bh, hn);
            tb = (tb + 4 * (qb + 1)) % 6; pbh = hn ? bh : -1; } }
    }
    SEAM(11);
    if (IN(12)) { PH_VARS EpiRes<true, false, true> E{nullptr, XN, (bf16*)(ws + WS_BIG), (unsigned long long*)(ws + WS_SSQC)}; run_gemm(lds, (const bf16*)(ws + L1_O), (const bf16*)(ws + WS_W_OUT1), T_, 1024, 1024, E); }
    SEAM(12);
    FFN_PHASES(13, 1, WS_BIG, WS_SSQC, true, WS_SSQB)
    if (PROBE_MASK) { if (blockIdx.x == 0 && threadIdx.x == 0) { const unsigned long long t0 = __builtin_amdgcn_s_memrealtime(); while (__builtin_amdgcn_s_memrealtime() - t0 < pr_acc) __builtin_amdgcn_s_sleep(8); } }
#undef IN
#undef SEAM
}
constexpr int LAST_PHASE = 16;

#ifndef MK_ONE_LAUNCH
#define MK_ONE_LAUNCH 1
#endif
extern "C" void kernel_launch(void* const* d_in, const int* in_sizes, int n_in, void* d_out, int out_size, void* d_ws, size_t ws_size, hipStream_t stream) {
    static int grid = 0;
    if (grid == 0) {
        if (n_in != 25 || out_size != T_ * D_ || ws_size < WS_END) { fprintf(stderr, "kernel_launch: unexpected shapes: n_in %d out %d ws %zu\n", n_in, out_size, ws_size); grid = -1; return; }
        if (hipFuncSetAttribute((const void*)fwd, hipFuncAttributeMaxDynamicSharedMemorySize, LDS_BYTES) != hipSuccess) { fprintf(stderr, "kernel_launch: hipFuncSetAttribute failed\n"); grid = -1; return; }
        int dev = 0, cus = 0, per_cu = 0;
        hipGetDevice(&dev); hipDeviceGetAttribute(&cus, hipDeviceAttributeMultiprocessorCount, dev);
        hipOccupancyMaxActiveBlocksPerMultiprocessor(&per_cu, (const void*)fwd, NTHR, LDS_BYTES);
        (void)hipGetLastError();
        grid = (per_cu >= 1) ? cus : -1;
        if (grid < 0) { fprintf(stderr, "kernel_launch: occupancy query says 0 blocks per CU\n"); return; }
    }
    if (grid < 0) return;
    hipMemsetAsync((char*)d_ws + WS_CTL, 0, CTL_ZERO_BYTES, stream);
    Args a{};
    for (int i = 0; i < 25; ++i) a.in[i] = (const float*)d_in[i];
    a.out = (float*)d_out; a.ws = (unsigned char*)d_ws;
#if MK_ONE_LAUNCH
    a.ph_lo = 0; a.ph_hi = LAST_PHASE;
    hipLaunchKernelGGL(fwd, dim3(grid), dim3(NTHR), LDS_BYTES, stream, a);
#else
    for (int p = 0; p < LAST_PHASE; ++p) { a.ph_lo = p; a.ph_hi = p + 1; hipLaunchKernelGGL(fwd, dim3(grid), dim3(NTHR), LDS_BYTES, stream, a); }
#endif
}
```

```cpp
#include <hip/hip_runtime.h>
#include <cstdio>
#include <cstdint>
namespace pg8 {
#define PG8_LAS __attribute__((address_space(3)))
typedef unsigned short bf16_t;
typedef short bf16x8 __attribute__((ext_vector_type(8)));
typedef float f32x4 __attribute__((ext_vector_type(4)));
typedef unsigned u32x4 __attribute__((ext_vector_type(4)));
constexpr int BM = 256, BK = 64, HALF = 128, HTB = HALF * BK * 2  , STAGE_BYTES = 8 * HTB, NXCD = 8, WGM = 8;

__host__ __device__ __forceinline__ int lds_byte(int r, int c) { const int st = (r >> 4) * 2 + (c >> 5), rr = r & 15, cc = c & 31, ob = rr * 64 + cc * 2; return st * 1024 + (ob ^ (((ob >> 9) & 1) << 5)); }
__host__ __device__ __forceinline__ void stage_rc(int b, int& R, int& C) { const int st = b / 1024, sb = b % 1024, swz = sb ^ (((sb >> 9) & 1) << 5); R = (st >> 1) * 16 + swz / 64; C = (st & 1) * 32 + (swz % 64) / 2; }
__host__ __device__ __forceinline__ int perm32(int rho) { const int n = rho >> 4, i = rho & 15; return 8 * (i >> 2) + 4 * n + (i & 3); }

struct Unit { int pm, pn; };
struct Gemm { const bf16_t* A; const bf16_t* Bt; int M, N, K, lda; };

struct StaticOrder {
    int nM, nN, nwg, G, c;
    __host__ __device__ void init(int M, int N, int G_, int c_) { nM = M / BM; nN = N / BM; nwg = nM * nN; G = G_; c = c_; }
    __host__ __device__ bool next(int i, Unit& u) const {
        const long L = (long)i * G + c; if (L >= nwg) return false;
        int wgid = (int)L; { const int q = nwg / NXCD, r = nwg % NXCD, xcd = wgid % NXCD, off = wgid / NXCD; wgid = (xcd < r ? xcd * (q + 1) : r * (q + 1) + (xcd - r) * q) + off; }
        const int nig = WGM * nN, gid = wgid / nig, fm = gid * WGM, gsz = (nM - fm) < WGM ? (nM - fm) : WGM;
        u.pm = fm + ((wgid % nig) % gsz); u.pn = (wgid % nig) / gsz; return true;
    }
    __device__ __forceinline__ void a_ready(const Unit&) const {}
    __device__ __forceinline__ void done(const Unit&) const {}
};

__device__ __forceinline__ unsigned cvt_pk_bf16(float lo, float hi) { unsigned r; asm volatile("v_cvt_pk_bf16_f32 %0, %1, %2" : "=v"(r) : "v"(lo), "v"(hi)); return r; }
typedef float f32x2 __attribute__((ext_vector_type(2)));
__device__ __forceinline__ f32x2 gelu_pk(f32x2 v) {
    const f32x2 av = __builtin_elementwise_abs(v), d = av * 0.2316418882f + 1.0f;
    f32x2 t; t.x = __builtin_amdgcn_rcpf(d.x); t.y = __builtin_amdgcn_rcpf(d.y);
    f32x2 q = t * 0.5307027145f + (-0.7265760135f); q = q * t + 0.7107068705f; q = q * t + (-0.142248368f); q = q * t + 0.127414796f; q = q * t;
    const f32x2 s = (v * v) * (-0.72134752044f);
    f32x2 e; e.x = __builtin_amdgcn_exp2f(s.x); e.y = __builtin_amdgcn_exp2f(s.y);
    const f32x2 m = v * (q * e), r = v - m;
    f32x2 o; o.x = v.x < 0.f ? m.x : r.x; o.y = v.y < 0.f ? m.y : r.y; return o;
}

template <int ACT  > struct EpiBf16 {
    static constexpr bool PERM = true, AFTER_DRAIN = false; static_assert(ACT == 0 || ACT == 1, "EpiBf16: ACT is 0 (none) or 1 (gelu_pk)");
    bf16_t* O; int ldc; const float* bias; int split_cols; size_t split_stride; float scale0;
    __device__ __forceinline__ void operator()(const f32x4 (&acc)[2][2][4][2], const Unit& u, int wr, int wc, int fr, int fq) const {
        const int row0 = u.pm * BM + wr * 64 + fr; int colt = u.pn * BM; bf16_t* base = O;
        float sc = 1.f; if (split_cols) { const int t = colt / split_cols; base += (size_t)t * split_stride; colt -= t * split_cols; if (t == 0) sc = scale0; }
        const int col0 = colt + wc * 32 + 8 * fq, bcol0 = u.pn * BM + wc * 32 + 8 * fq;
        f32x4 bv[2][2];
#pragma unroll
        for (int bj = 0; bj < 2; ++bj)
#pragma unroll
            for (int n = 0; n < 2; ++n) bv[bj][n] = bias ? *(const f32x4*)(bias + bcol0 + bj * HALF + 4 * n) : (f32x4){0.f, 0.f, 0.f, 0.f};
#pragma unroll
        for (int ai = 0; ai < 2; ++ai)
#pragma unroll
            for (int m = 0; m < 4; ++m) { bf16_t* rowp = base + (size_t)(row0 + ai * HALF + m * 16) * ldc + col0;
#pragma unroll
                for (int bj = 0; bj < 2; ++bj) { f32x4 v0 = acc[ai][bj][m][0] + bv[bj][0], v1 = acc[ai][bj][m][1] + bv[bj][1];
                    if (ACT == 1) { f32x2 a = gelu_pk((f32x2){v0[0], v0[1]}), b = gelu_pk((f32x2){v0[2], v0[3]}), c = gelu_pk((f32x2){v1[0], v1[1]}), d = gelu_pk((f32x2){v1[2], v1[3]});
                        v0 = (f32x4){a.x, a.y, b.x, b.y}; v1 = (f32x4){c.x, c.y, d.x, d.y}; }
                    v0 = v0 * sc; v1 = v1 * sc; u32x4 w; w.x = cvt_pk_bf16(v0[0], v0[1]); w.y = cvt_pk_bf16(v0[2], v0[3]); w.z = cvt_pk_bf16(v1[0], v1[1]); w.w = cvt_pk_bf16(v1[2], v1[3]);
                    *(u32x4*)(rowp + bj * HALF) = w; } }
    }
};

struct PanelStats {
    unsigned* xbuf;
    unsigned* cnt;
    unsigned* tmo;
    int ntn; float eps;
    unsigned code;
    __device__ __forceinline__ bool run(const f32x4 (&v)[2][2][4][2], const Unit& u, int wr, int wc, int fr, int fq, PG8_LAS unsigned char* lds, int wid, int lane) const {
        typedef float f32x2v __attribute__((ext_vector_type(2)));
        PG8_LAS f32x2v* P = (PG8_LAS f32x2v*)lds;
        PG8_LAS f32x2v* S = (PG8_LAS f32x2v*)(lds + 8192);
        PG8_LAS unsigned* flag = (PG8_LAS unsigned*)(lds + 8192 + 2048);
#pragma unroll
        for (int ai = 0; ai < 2; ++ai)
#pragma unroll
            for (int m = 0; m < 4; ++m) {
                float s = 0.f;
#pragma unroll
                for (int bj = 0; bj < 2; ++bj)
#pragma unroll
                    for (int n = 0; n < 2; ++n) { const f32x4 x = v[ai][bj][m][n]; s += (x[0] + x[1]) + (x[2] + x[3]); }
                s += __shfl_xor(s, 16); s += __shfl_xor(s, 32);
                const float mw = s * (1.0f / 64.0f); float q = 0.f;
#pragma unroll
                for (int bj = 0; bj < 2; ++bj)
#pragma unroll
                    for (int n = 0; n < 2; ++n) { const f32x4 d = v[ai][bj][m][n] - mw; q += (d[0] * d[0] + d[1] * d[1]) + (d[2] * d[2] + d[3] * d[3]); }
                q += __shfl_xor(q, 16); q += __shfl_xor(q, 32);
                if (fq == 0) P[(ai * HALF + wr * 64 + m * 16 + fr) * 4 + wc] = (f32x2v){mw, q};
            }
        asm volatile("s_waitcnt lgkmcnt(0)" ::: "memory"); __builtin_amdgcn_s_barrier(); asm volatile("" ::: "memory");
#if defined(BROKEN_EXCHANGE_NO_WAIT)
#warning BROKEN CONTROL BUILD: the row-statistics exchange does not wait; results are wrong by design
        if (blockIdx.x >= 64) { const long long t0_ = clock64(); while (clock64() - t0_ < 60000) __builtin_amdgcn_s_sleep(8); }
#endif
        const int row = wid * 32 + (lane & 31);
        if (lane < 32) {
            const f32x2v a = P[row * 4 + 0], b = P[row * 4 + 1], c = P[row * 4 + 2], d = P[row * 4 + 3];
            const float mt = (a.x + b.x + c.x + d.x) * 0.25f;
            const float da = a.x - mt, db = b.x - mt, dc = c.x - mt, dd = d.x - mt;
            const float m2 = (a.y + b.y) + (c.y + d.y) + 64.0f * ((da * da + db * db) + (dc * dc + dd * dd));
            unsigned long long* slot = (unsigned long long*)xbuf + ((size_t)(u.pm * BM + row) * 4 + u.pn);
            __hip_atomic_store(slot, ((unsigned long long)__float_as_uint(m2) << 32) | __float_as_uint(mt), __ATOMIC_RELAXED, __HIP_MEMORY_SCOPE_AGENT);
        }
        asm volatile("s_waitcnt vmcnt(0)" ::: "memory");
        if (lane == 0) __hip_atomic_fetch_add(cnt + 64 * u.pm, 1u, __ATOMIC_RELAXED, __HIP_MEMORY_SCOPE_AGENT);
        if (wid == 0) {
            bool dead = false; const unsigned long long t0 = __builtin_amdgcn_s_memrealtime(); const unsigned want = 8u * (unsigned)ntn;
            for (;;) {
#if defined(BROKEN_EXCHANGE_NO_WAIT)
                break;
#endif
                if ((unsigned)__builtin_amdgcn_readfirstlane(__hip_atomic_load(cnt + 64 * u.pm, __ATOMIC_RELAXED, __HIP_MEMORY_SCOPE_AGENT)) >= want) break;
                if (__builtin_amdgcn_s_memrealtime() - t0 > 2000000ull) {
                    if (lane == 0) { unsigned expect = 0u; __hip_atomic_compare_exchange_strong(tmo + 1, &expect, code | (unsigned)(u.pm & 0xff), __ATOMIC_RELAXED, __ATOMIC_RELAXED, __HIP_MEMORY_SCOPE_AGENT);
                                     __hip_atomic_store(tmo, 1u, __ATOMIC_RELAXED, __HIP_MEMORY_SCOPE_AGENT); }
                    dead = true; break; }
                __builtin_amdgcn_s_sleep(2);
            }
            __builtin_amdgcn_fence(__ATOMIC_ACQUIRE, "agent");
            if (lane == 0) flag[0] = dead ? 1u : 0u;
        }
        asm volatile("s_waitcnt vmcnt(0) lgkmcnt(0)" ::: "memory"); __builtin_amdgcn_s_barrier(); asm volatile("" ::: "memory");
        const bool bad = flag[0] != 0u;
        if (lane < 32) {
            const unsigned long long* slot = (const unsigned long long*)xbuf + (size_t)(u.pm * BM + row) * 4; float mt[4], m2[4]; float ms = 0.f;
#pragma unroll
            for (int t = 0; t < 4; ++t) { if (t < ntn) { const unsigned long long w = __hip_atomic_load(slot + t, __ATOMIC_RELAXED, __HIP_MEMORY_SCOPE_AGENT); mt[t] = __uint_as_float((unsigned)w); m2[t] = __uint_as_float((unsigned)(w >> 32)); } else { mt[t] = 0.f; m2[t] = 0.f; } ms += mt[t]; }
            const float mean = ms / (float)ntn; float q = 0.f;
#pragma unroll
            for (int t = 0; t < 4; ++t) if (t < ntn) { const float dm = mt[t] - mean; q += m2[t] + 256.0f * dm * dm; }
            S[row] = (f32x2v){mean, 1.0f / sqrtf(q / (256.0f * (float)ntn) + eps)};
        }
        asm volatile("s_waitcnt lgkmcnt(0)" ::: "memory"); __builtin_amdgcn_s_barrier(); asm volatile("" ::: "memory");
        return bad;
    }
};
struct EpiLnRes {
    static constexpr bool PERM = false, AFTER_DRAIN = true;
    const float* base; float* out; int ldc; const float* bias; PanelStats st; unsigned poison;
    __device__ __forceinline__ void fused(f32x4 (&acc)[2][2][4][2], const Unit& u, int wr, int wc, int fr, int fq, PG8_LAS unsigned char* lds, int wid, int lane) const {
        typedef float f32x2v __attribute__((ext_vector_type(2)));
        const PG8_LAS f32x2v* S = (const PG8_LAS f32x2v*)(lds + 8192);
        const int col0 = u.pn * BM + wc * 32 + 4 * fq;
#pragma unroll
        for (int bj = 0; bj < 2; ++bj)
#pragma unroll
            for (int n = 0; n < 2; ++n) { const f32x4 bv = bias ? *(const f32x4*)(bias + col0 + bj * HALF + n * 16) : (f32x4){0.f, 0.f, 0.f, 0.f};
#pragma unroll
                for (int ai = 0; ai < 2; ++ai)
#pragma unroll
                    for (int m = 0; m < 4; ++m) acc[ai][bj][m][n] += bv; }
        f32x4 pre[4][2][2];
#pragma unroll
        for (int m = 0; m < 4; ++m) { const size_t off = (size_t)(u.pm * BM + wr * 64 + m * 16 + fr) * ldc + col0;
#pragma unroll
            for (int bj = 0; bj < 2; ++bj)
#pragma unroll
                for (int n = 0; n < 2; ++n) pre[m][bj][n] = *(const f32x4*)(base + off + bj * HALF + n * 16); }
        const bool bad = st.run(acc, u, wr, wc, fr, fq, lds, wid, lane) || poison != 0u;
        const float qnan = __builtin_nanf("");
#pragma unroll
        for (int ai = 0; ai < 2; ++ai)
#pragma unroll
            for (int m = 0; m < 4; ++m) { const int r = ai * HALF + wr * 64 + m * 16 + fr; const f32x2v sr = S[r]; const size_t off = (size_t)(u.pm * BM + r) * ldc + col0;
#pragma unroll
                for (int bj = 0; bj < 2; ++bj)
#pragma unroll
                    for (int n = 0; n < 2; ++n) { const f32x4 bs = ai == 0 ? pre[m][bj][n] : *(const f32x4*)(base + off + bj * HALF + n * 16); f32x4 o = bs + (acc[ai][bj][m][n] - sr.x) * sr.y;
                        if (bad) o = (f32x4){qnan, qnan, qnan, qnan}; *(f32x4*)(out + off + bj * HALF + n * 16) = o; }
                if (m & 1) asm volatile("" ::: "memory"); }
    }
};
struct EpiLnResLn {
    static constexpr bool PERM = false, AFTER_DRAIN = true;
    const float* base; float* out; bf16_t* xn; int ldc; const float* bias; PanelStats st1, st2; unsigned poison;
    __device__ __forceinline__ void fused(f32x4 (&acc)[2][2][4][2], const Unit& u, int wr, int wc, int fr, int fq, PG8_LAS unsigned char* lds, int wid, int lane) const {
        typedef float f32x2v __attribute__((ext_vector_type(2))); typedef unsigned u32x2v __attribute__((ext_vector_type(2)));
        const PG8_LAS f32x2v* S = (const PG8_LAS f32x2v*)(lds + 8192);
        const int col0 = u.pn * BM + wc * 32 + 4 * fq;
#pragma unroll
        for (int bj = 0; bj < 2; ++bj)
#pragma unroll
            for (int n = 0; n < 2; ++n) { const f32x4 bv = bias ? *(const f32x4*)(bias + col0 + bj * HALF + n * 16) : (f32x4){0.f, 0.f, 0.f, 0.f};
#pragma unroll
                for (int ai = 0; ai < 2; ++ai)
#pragma unroll
                    for (int m = 0; m < 4; ++m) acc[ai][bj][m][n] += bv; }
        bool bad = st1.run(acc, u, wr, wc, fr, fq, lds, wid, lane) || poison != 0u;
        const float qnan = __builtin_nanf("");
#pragma unroll
        for (int ai = 0; ai < 2; ++ai)
#pragma unroll
            for (int m = 0; m < 4; ++m) { const int r = ai * HALF + wr * 64 + m * 16 + fr; const f32x2v sr = S[r]; const size_t off = (size_t)(u.pm * BM + r) * ldc + col0;
#pragma unroll
                for (int bj = 0; bj < 2; ++bj)
#pragma unroll
                    for (int n = 0; n < 2; ++n) { const f32x4 bs = *(const f32x4*)(base + off + bj * HALF + n * 16); acc[ai][bj][m][n] = bs + (acc[ai][bj][m][n] - sr.x) * sr.y; }
                asm volatile("" : "+v"(acc[ai][0][m][0]), "+v"(acc[ai][0][m][1]), "+v"(acc[ai][1][m][0]), "+v"(acc[ai][1][m][1]));
                if (m & 1) asm volatile("" ::: "memory"); }
        const bool bad1 = bad;
        bad = st2.run(acc, u, wr, wc, fr, fq, lds, wid, lane) || bad;
#pragma unroll
        for (int ai = 0; ai < 2; ++ai)
#pragma unroll
            for (int m = 0; m < 4; ++m) { const int r = ai * HALF + wr * 64 + m * 16 + fr; const f32x2v sr = S[r]; const size_t off = (size_t)(u.pm * BM + r) * ldc + col0;
#pragma unroll
                for (int bj = 0; bj < 2; ++bj)
#pragma unroll
                    for (int n = 0; n < 2; ++n) { const f32x4 x1 = acc[ai][bj][m][n]; *(f32x4*)(out + off + bj * HALF + n * 16) = bad1 ? (f32x4){qnan, qnan, qnan, qnan} : x1;
                        const f32x4 o = (x1 - sr.x) * sr.y; u32x2v w; w.x = cvt_pk_bf16(o[0], o[1]); w.y = cvt_pk_bf16(o[2], o[3]);
                        if (bad) { w.x = 0x7fc07fc0u; w.y = 0x7fc07fc0u; } *(u32x2v*)(xn + off + bj * HALF + n * 16) = w; }
                asm volatile("" ::: "memory"); }
    }
};

template <class Epi, class Sched, bool ALIGN_EPI = false, bool SP2 = false, int AROW = 0>
__device__ __forceinline__ void gemm_phase(PG8_LAS unsigned char* lds, const Gemm g, const Sched& S, const Epi& E) {
    int tid_ = threadIdx.x; asm volatile("" : "+v"(tid_));
    const int tid = tid_, wid = __builtin_amdgcn_readfirstlane(tid >> 6), lane = tid & 63, wr = wid >> 2, wc = wid & 3, fr = lane & 15, fq = lane >> 4;
    const int K = g.K, nt = K / BK;
    unsigned voffA[2], voffB[2];
#pragma unroll
    for (int i = 0; i < 2; ++i) { int R, C; stage_rc(tid * 16 + i * 8192, R, C); const int Rb = Epi::PERM ? ((R & ~31) + perm32(R & 31)) : R;
        const int Ra = (AROW == 1) ? ((R & ~63) + 4 * (R & 15) + ((R >> 4) & 3)) : R;
        voffA[i] = (unsigned)(Ra * g.lda + C) * 2u; voffB[i] = (unsigned)(Rb * K + C) * 2u;
        if (AROW == 2) { const int tp = 4 * ((lane >> 2) & 3) + (lane >> 4), c = lane & 3;
            voffA[i] = (unsigned)((64 * i + 16 * (wid & 3) + tp) * g.lda + 32 * (wid >> 2) + 8 * c) * 2u; } }
    const size_t kstep = (size_t)(BK * 2);
    const size_t hstep = (size_t)HALF * K * 2;
    const size_t tstep = 2 * hstep;
    const size_t hstepA = (size_t)HALF * g.lda * 2, tstepA = 2 * hstepA;
    const unsigned ldsw = (unsigned)wid * 1024u;
    constexpr int PSTR = 1056, HTBA = (AROW == 2) ? 16 * PSTR : HTB;
    const int aoff = (AROW == 2) ? (wr * 8 + (fr >> 2)) * PSTR + 64 * (fr & 3) + 16 * fq : lds_byte(wr * 64 + fr, fq * 8), boff = lds_byte(wc * 32 + fr, fq * 8);
    constexpr int AM = (AROW == 2) ? 256 : 2048, AK = (AROW == 2) ? 4 * PSTR : 1024;
    const unsigned ldswA = (AROW == 2) ? (unsigned)wid * PSTR : (unsigned)wid * 1024u; constexpr unsigned ISTRA = (AROW == 2) ? 8u * PSTR : 8192u;
#define PG8_SA(b, h) (((b) * 2 + (h)) * HTBA)
#define PG8_SB(b, h) (4 * HTBA + ((b) * 2 + (h)) * HTB)
#define PG8_STAGEA(bufoff, gbase, voff) do { _Pragma("unroll") for (int _i = 0; _i < 2; ++_i) \
        __builtin_amdgcn_global_load_lds((const unsigned*)((const char*)(gbase) + (voff)[_i]), (PG8_LAS unsigned*)(lds + (bufoff) + ldswA + _i * ISTRA), 16, 0, 0); } while (0)
#define PG8_STAGE(bufoff, gbase, voff) do { _Pragma("unroll") for (int _i = 0; _i < 2; ++_i) \
        __builtin_amdgcn_global_load_lds((const unsigned*)((const char*)(gbase) + (voff)[_i]), (PG8_LAS unsigned*)(lds + (bufoff) + ldsw + _i * 8192), 16, 0, 0); } while (0)
#define PG8_LDA(dst, b, h) do { _Pragma("unroll") for (int m = 0; m < 4; ++m) _Pragma("unroll") for (int k = 0; k < 2; ++k) dst[m][k] = *(const PG8_LAS bf16x8*)(lds + PG8_SA(b, h) + aoff + m * AM + k * AK); } while (0)
#define PG8_LDB(dst, b, h) do { _Pragma("unroll") for (int n = 0; n < 2; ++n) _Pragma("unroll") for (int k = 0; k < 2; ++k) dst[n][k] = *(const PG8_LAS bf16x8*)(lds + PG8_SB(b, h) + boff + n * 2048 + k * 1024); } while (0)
#define PG8_MMA(ai, bj, At, Bt) do { __builtin_amdgcn_s_setprio(1); _Pragma("unroll") for (int m = 0; m < 4; ++m) _Pragma("unroll") for (int n = 0; n < 2; ++n) _Pragma("unroll") for (int k = 0; k < 2; ++k) \
        acc[ai][bj][m][n] = __builtin_amdgcn_mfma_f32_16x16x32_bf16(Bt[n][k], At[m][k], acc[ai][bj][m][n], 0, 0, 0); __builtin_amdgcn_s_setprio(0); } while (0)
#define PG8_WAIT_V(n) asm volatile("s_waitcnt vmcnt(" #n ")" ::: "memory")
#define PG8_WAIT_L(n) asm volatile("s_waitcnt lgkmcnt(" #n ")" ::: "memory")
#define PG8_BAR __builtin_amdgcn_s_barrier()
#define PG8_SCHED __builtin_amdgcn_sched_barrier(0)
    Unit cur, nxt; int ui = 0;
    if (!S.next(0, cur)) return;
    f32x4 acc[2][2][4][2];
#pragma unroll
    for (int a = 0; a < 2; ++a)
#pragma unroll
        for (int b = 0; b < 2; ++b)
#pragma unroll
            for (int m = 0; m < 4; ++m)
#pragma unroll
                for (int n = 0; n < 2; ++n) acc[a][b][m][n] = (f32x4){0.f, 0.f, 0.f, 0.f};
    bf16x8 At[4][2], B0[2][2], B1[2][2];
    const char* cA = (const char*)g.A + (size_t)cur.pm * tstepA; const char* cB = (const char*)g.Bt + (size_t)cur.pn * tstep;
    S.a_ready(cur);
    if constexpr (SP2) {
        PG8_STAGE(PG8_SB(0, 0), cB, voffB); PG8_STAGE(PG8_SB(0, 1), cB + hstep, voffB); PG8_STAGEA(PG8_SA(0, 0), cA, voffA); PG8_STAGEA(PG8_SA(0, 1), cA + hstepA, voffA);
        if (wr == 1) PG8_BAR;
        PG8_WAIT_V(2); PG8_BAR;
        PG8_STAGE(PG8_SB(1, 0), cB + kstep, voffB); PG8_STAGEA(PG8_SA(1, 0), cA + kstep, voffA); PG8_STAGE(PG8_SB(1, 1), cB + hstep + kstep, voffB);
        PG8_WAIT_V(6); PG8_BAR;
    } else {
        PG8_STAGE(PG8_SB(0, 0), cB, voffB); PG8_STAGEA(PG8_SA(0, 0), cA, voffA); PG8_STAGE(PG8_SB(0, 1), cB + hstep, voffB); PG8_STAGEA(PG8_SA(0, 1), cA + hstepA, voffA);
        if (wr == 1) PG8_BAR;
        PG8_WAIT_V(4); PG8_BAR;
        PG8_STAGE(PG8_SB(1, 0), cB + kstep, voffB); PG8_STAGEA(PG8_SA(1, 0), cA + kstep, voffA); PG8_STAGE(PG8_SB(1, 1), cB + hstep + kstep, voffB);
        PG8_WAIT_V(6); PG8_BAR;
    }
    for (;;) {
        const bool has_next = S.next(ui + 1, nxt);
        const char* nA = has_next ? (const char*)g.A + (size_t)nxt.pm * tstepA : cA; const char* nB = has_next ? (const char*)g.Bt + (size_t)nxt.pn * tstep : cB;
#pragma unroll 1
        for (int t = 0; t < nt; t += 2) {
            const bool last = (t == nt - 2);
            const char* a1 = cA + (size_t)(t + 1) * kstep;
            const char* a2 = last ? nA : cA + (size_t)(t + 2) * kstep; const char* b2 = last ? nB : cB + (size_t)(t + 2) * kstep;
            const char* a3 = a2 + kstep; const char* b3 = b2 + kstep;
            if (last && has_next) S.a_ready(nxt);
            if constexpr (SP2) {
            PG8_LDB(B0, 0, 0); PG8_LDB(B1, 0, 1); PG8_SCHED; PG8_LDA(At, 0, 0); PG8_STAGEA(PG8_SA(1, 1), a1 + hstepA, voffA);
            PG8_WAIT_V(8); PG8_WAIT_L(0); PG8_BAR; PG8_MMA(0, 0, At, B0); PG8_MMA(0, 1, At, B1); PG8_BAR; PG8_SCHED;
            PG8_LDA(At, 0, 1); PG8_STAGE(PG8_SB(0, 0), b2, voffB); PG8_STAGE(PG8_SB(0, 1), b2 + hstep, voffB); PG8_STAGEA(PG8_SA(0, 0), a2, voffA);
            PG8_WAIT_V(8); PG8_WAIT_L(0); PG8_BAR; PG8_MMA(1, 0, At, B0); PG8_MMA(1, 1, At, B1); PG8_BAR; PG8_SCHED;
            PG8_LDB(B0, 1, 0); PG8_LDB(B1, 1, 1); PG8_SCHED; PG8_LDA(At, 1, 0); PG8_STAGEA(PG8_SA(0, 1), a2 + hstepA, voffA);
            PG8_WAIT_V(8); PG8_WAIT_L(0); PG8_BAR; PG8_MMA(0, 0, At, B0); PG8_MMA(0, 1, At, B1); PG8_BAR; PG8_SCHED;
            PG8_LDA(At, 1, 1); PG8_STAGE(PG8_SB(1, 0), b3, voffB); PG8_STAGE(PG8_SB(1, 1), b3 + hstep, voffB); PG8_STAGEA(PG8_SA(1, 0), a3, voffA);
            PG8_WAIT_V(8); PG8_WAIT_L(0); PG8_BAR; PG8_MMA(1, 0, At, B0); PG8_MMA(1, 1, At, B1); PG8_BAR; PG8_SCHED;
            } else {
            PG8_LDB(B0, 0, 0); PG8_SCHED; PG8_LDA(At, 0, 0); PG8_STAGEA(PG8_SA(1, 1), a1 + hstepA, voffA);
            PG8_WAIT_L(8); PG8_BAR; PG8_WAIT_L(0); PG8_MMA(0, 0, At, B0); PG8_BAR; PG8_SCHED;
            PG8_LDB(B1, 0, 1); PG8_STAGE(PG8_SB(0, 0), b2, voffB);
            PG8_BAR; PG8_WAIT_L(0); PG8_MMA(0, 1, At, B1); PG8_BAR;
            PG8_LDA(At, 0, 1); PG8_STAGEA(PG8_SA(0, 0), a2, voffA);
            PG8_BAR; PG8_WAIT_L(0); PG8_MMA(1, 0, At, B0); PG8_BAR; PG8_SCHED;
            PG8_STAGE(PG8_SB(0, 1), b2 + hstep, voffB);
            PG8_WAIT_V(6); PG8_BAR; PG8_MMA(1, 1, At, B1); PG8_BAR;
            PG8_LDB(B0, 1, 0); PG8_SCHED; PG8_LDA(At, 1, 0); PG8_STAGEA(PG8_SA(0, 1), a2 + hstepA, voffA);
            PG8_WAIT_L(8); PG8_BAR; PG8_WAIT_L(0); PG8_MMA(0, 0, At, B0); PG8_BAR; PG8_SCHED;
            PG8_LDB(B1, 1, 1); PG8_STAGE(PG8_SB(1, 0), b3, voffB);
            PG8_BAR; PG8_WAIT_L(0); PG8_MMA(0, 1, At, B1); PG8_BAR;
            PG8_LDA(At, 1, 1); PG8_STAGEA(PG8_SA(1, 0), a3, voffA);
            PG8_BAR; PG8_WAIT_L(0); PG8_MMA(1, 0, At, B0); PG8_BAR; PG8_SCHED;
            PG8_STAGE(PG8_SB(1, 1), b3 + hstep, voffB);
            PG8_WAIT_V(6); PG8_BAR; PG8_MMA(1, 1, At, B1); PG8_BAR;
            }
        }
        if constexpr (ALIGN_EPI) { if (wr == 0) PG8_BAR; }
        if constexpr (!Epi::AFTER_DRAIN) { E(acc, cur, wr, wc, fr, fq); S.done(cur); }
        if (!has_next) break;
#pragma unroll
        for (int a = 0; a < 2; ++a)
#pragma unroll
            for (int b = 0; b < 2; ++b)
#pragma unroll
                for (int m = 0; m < 4; ++m)
#pragma unroll
                    for (int n = 0; n < 2; ++n) acc[a][b][m][n] = (f32x4){0.f, 0.f, 0.f, 0.f};
        cur = nxt; cA = nA; cB = nB; ++ui;
        if constexpr (ALIGN_EPI) { if (wr == 1) PG8_BAR; }
    }
    PG8_WAIT_V(0);
    if constexpr (!ALIGN_EPI) { if (wr == 0) PG8_BAR; }
    PG8_BAR;
    if constexpr (Epi::AFTER_DRAIN) { E.fused(acc, cur, wr, wc, fr, fq, lds, wid, lane); S.done(cur); }
#undef PG8_SA
#undef PG8_SB
#undef PG8_STAGE
#undef PG8_STAGEA
#undef PG8_LDA
#undef PG8_LDB
#undef PG8_MMA
#undef PG8_WAIT_V
#undef PG8_WAIT_L
#undef PG8_BAR
#undef PG8_SCHED
}
}

#ifndef PG8_SP2
#define PG8_SP2 true
#endif
#ifndef PG8_ALIGN
#define PG8_ALIGN true
#endif
#define GAS __attribute__((address_space(1)))
#define LAS __attribute__((address_space(3)))
typedef unsigned short bf16;
typedef unsigned v4u __attribute__((ext_vector_type(4)));
typedef float f32x4 __attribute__((ext_vector_type(4)));
typedef short bf16x8 __attribute__((ext_vector_type(8)));
typedef GAS unsigned gu32;
typedef GAS unsigned long long gu64;
#define RLX_AGENT __ATOMIC_RELAXED, __HIP_MEMORY_SCOPE_AGENT
#define LDS_WAIT() asm volatile("s_waitcnt lgkmcnt(0)" ::: "memory")
#define VM_WAIT() asm volatile("s_waitcnt vmcnt(0)" ::: "memory")
__device__ __forceinline__ unsigned long long rt() { return __builtin_amdgcn_s_memrealtime(); }
__device__ __forceinline__ unsigned f2bf(float f) { unsigned u = __builtin_bit_cast(unsigned, f); return (u + 0x7fffu + ((u >> 16) & 1u)) >> 16; }
typedef float pk_f32x2_t __attribute__((ext_vector_type(2))); typedef __bf16 pk_bf16x2_t __attribute__((ext_vector_type(2)));
__device__ __forceinline__ unsigned pk2(float lo, float hi) { pk_f32x2_t v = {lo, hi}; pk_bf16x2_t b = __builtin_convertvector(v, pk_bf16x2_t); return __builtin_bit_cast(unsigned, b); }

#define XB_TMO      128
#define XB_XCNT(j)  (256  + 64 * (j))
#define XB_XSUB(j)  (1280 + 64 * (j))
#define XB_XGEN(j)  (2304 + 64 * (j))
#define XB_TOP      3328
#define XB_TOPGEN   3392
#define XCD_BAR_WORDS 3456
#define XB_SPIN_CAP (1u << 18)

__device__ __forceinline__ unsigned xb_ld(unsigned* p)              { return __hip_atomic_load(p, __ATOMIC_RELAXED, __HIP_MEMORY_SCOPE_AGENT); }
__device__ __forceinline__ unsigned xb_add(unsigned* p, unsigned v) { return __hip_atomic_fetch_add(p, v, __ATOMIC_RELAXED, __HIP_MEMORY_SCOPE_AGENT); }
__device__ __forceinline__ unsigned xb_xcc_id() { return (unsigned)__builtin_amdgcn_s_getreg((3 << 11) | 20) & 0xFu; }
#define XB_SPIN(cond, bar) do { unsigned _sp = 0; while (cond) { __builtin_amdgcn_s_sleep(1); \
    if ((++_sp & 255u) == 0u) { if (xb_ld(&(bar)[XB_TMO])) break; if (_sp > XB_SPIN_CAP) { atomicAdd(&(bar)[XB_TMO], 1u); break; } } } } while (0)

struct XcdBarrier {
    unsigned* bar; unsigned x;
    volatile LAS unsigned* st;
};

__device__ __forceinline__ XcdBarrier xcd_barrier_post(unsigned* bar, volatile LAS unsigned* st) {
    XcdBarrier b; b.bar = bar; b.x = xb_xcc_id(); b.st = st;
    if (threadIdx.x == 0) (void)xb_add(&bar[XB_XCNT(b.x)], 1u);
    return b;
}
__device__ __forceinline__ void xcd_barrier_complete(unsigned* bar, unsigned x, unsigned& nloc, unsigned& nx) {
    const unsigned G = gridDim.x * gridDim.y * gridDim.z;
    unsigned sum, cnt, mine, sp = 0u;
    for (;;) {
        sum = 0u; cnt = 0u; mine = 0u;
#pragma unroll
        for (unsigned j = 0; j < 16; ++j) { const unsigned c = xb_ld(&bar[XB_XCNT(j)]); sum += c; cnt += (c > 0u) ? 1u : 0u; mine = (j == x) ? c : mine; }
        if (sum == G) break;
        __builtin_amdgcn_s_sleep(1);
        if ((++sp & 255u) == 0u) { if (xb_ld(&bar[XB_TMO])) break; if (sp > XB_SPIN_CAP) { atomicAdd(&bar[XB_TMO], 1u); break; } }
    }
    nloc = mine > 0u ? mine : 1u; nx = cnt > 0u ? cnt : 1u;
}

__device__ __forceinline__ void xcd_barrier(const XcdBarrier& b) {
    asm volatile("s_waitcnt vmcnt(0)" ::: "memory");
    __syncthreads();
    if (threadIdx.x == 0) {
        unsigned* bar = b.bar;
        __builtin_amdgcn_s_waitcnt(0);
        unsigned nloc = b.st[0], nx = b.st[1];
        if (nloc == 0u) { xcd_barrier_complete(bar, b.x, nloc, nx); b.st[0] = nloc; b.st[1] = nx; }
        const unsigned old = xb_add(&bar[XB_XSUB(b.x)], 1u);
        const unsigned gen = old / nloc;
        if (old + 1u == (gen + 1u) * nloc) {
            __builtin_amdgcn_fence(__ATOMIC_RELEASE, "agent");
            asm volatile("s_waitcnt vmcnt(0)" ::: "memory");
            const unsigned og = xb_add(&bar[XB_TOP], 1u);
            const unsigned tg = og / nx;
            if (og + 1u == (tg + 1u) * nx) xb_add(&bar[XB_TOPGEN], 1u);
            else XB_SPIN(xb_ld(&bar[XB_TOPGEN]) == tg, bar);
            __builtin_amdgcn_fence(__ATOMIC_ACQUIRE, "agent");
            xb_add(&bar[XB_XGEN(b.x)], 1u);
            asm volatile("s_waitcnt vmcnt(0)" ::: "memory");
        } else {
            XB_SPIN(xb_ld(&bar[XB_XGEN(b.x)]) == gen, bar);
            __builtin_amdgcn_fence(__ATOMIC_ACQUIRE, "agent");
            asm volatile("s_waitcnt vmcnt(0)" ::: "memory");
        }
    }
    __syncthreads();
}
__device__ __forceinline__ float bf2f(bf16 v) { return __builtin_bit_cast(float, (unsigned)v << 16); }
__device__ __forceinline__ float bflo(unsigned w) { return __builtin_bit_cast(float, w << 16); }
__device__ __forceinline__ float bfhi(unsigned w) { return __builtin_bit_cast(float, w & 0xffff0000u); }
__device__ __forceinline__ float silu_f(float v) { return v / (1.f + __expf(-v)); }
__device__ __forceinline__ float wave_sum(float v) {
#pragma unroll
    for (int o = 1; o < 64; o <<= 1) v += __shfl_xor(v, o);
    return v;
}


namespace at2 {
typedef short bf16x8 __attribute__((ext_vector_type(8)));
typedef short s16x4 __attribute__((ext_vector_type(4)));
typedef float f32x16 __attribute__((ext_vector_type(16)));
typedef unsigned u32x4 __attribute__((ext_vector_type(4)));
typedef float f32x2_t __attribute__((ext_vector_type(2))); typedef __bf16 bf16x2_t __attribute__((ext_vector_type(2)));
#define AT_LAS __attribute__((address_space(3)))
__device__ __forceinline__ int crow(int r, int hi) { return (r & 3) + 8 * (r >> 2) + 4 * hi; }
__device__ __forceinline__ void glds16(const void* gsrc, unsigned lds_dst) { unsigned keep;
    asm volatile("s_mov_b32 %0, m0\n\ts_mov_b32 m0, %2\n\ts_nop 0\n\tglobal_load_lds_dwordx4 %1, off\n\ts_mov_b32 m0, %0" : "=&s"(keep) : "v"(gsrc), "s"(lds_dst) : "memory"); }
__device__ __forceinline__ unsigned cvtpk(float lo, float hi) { f32x2_t v = {lo, hi}; bf16x2_t b = __builtin_convertvector(v, bf16x2_t); return __builtin_bit_cast(unsigned, b); }
__device__ __forceinline__ float swap_max(float m) { auto rr = __builtin_amdgcn_permlane32_swap(__float_as_uint(m), __float_as_uint(m), false, false); float r; asm("v_max_f32_e32 %0, %1, %2" : "=v"(r) : "v"(__uint_as_float(rr[0])), "v"(__uint_as_float(rr[1]))); return r; }
__device__ __forceinline__ float swap_sum(float m) { auto rr = __builtin_amdgcn_permlane32_swap(__float_as_uint(m), __float_as_uint(m), false, false); return __uint_as_float(rr[0]) + __uint_as_float(rr[1]); }

__device__ __forceinline__ float max3f(float a, float b, float c) { float r; asm("v_max3_f32 %0, %1, %2, %3" : "=v"(r) : "v"(a), "v"(b), "v"(c)); return r; }
__device__ __forceinline__ float max2f(float a, float b) { float r; asm("v_max_f32_e32 %0, %1, %2" : "=v"(r) : "v"(a), "v"(b)); return r; }
constexpr float NEGM = -1e30f;
constexpr float THR = 8.0f;

struct Tensors { const unsigned short* Q; const unsigned short* K; const unsigned short* V; unsigned short* O; int pq, pk, pv, po; };

__device__ __forceinline__ void pv(f32x16* o, int vb, bf16x8 pa0, bf16x8 pa1, bf16x8 pa2, bf16x8 pa3) {
#pragma unroll
    for (int d0 = 0; d0 < 2; ++d0) { s16x4 lo[4], hi[4];
#pragma unroll
        for (int ks = 0; ks < 4; ++ks) {
            asm volatile("ds_read_b64_tr_b16 %0,%1 offset:%c2" : "=&v"(lo[ks]) : "v"(vb), "i"(d0 * 4096 + ks * 1024) : "memory");
            asm volatile("ds_read_b64_tr_b16 %0,%1 offset:%c2" : "=&v"(hi[ks]) : "v"(vb), "i"(d0 * 4096 + ks * 1024 + 512) : "memory"); }
        asm volatile("s_waitcnt lgkmcnt(0)" ::: "memory"); __builtin_amdgcn_sched_barrier(0);
#define AT_PK(k) (bf16x8){lo[k][0], lo[k][1], lo[k][2], lo[k][3], hi[k][0], hi[k][1], hi[k][2], hi[k][3]}
        o[d0] = __builtin_amdgcn_mfma_f32_32x32x16_bf16(pa0, AT_PK(0), o[d0], 0, 0, 0);
        o[d0] = __builtin_amdgcn_mfma_f32_32x32x16_bf16(pa1, AT_PK(1), o[d0], 0, 0, 0);
        o[d0] = __builtin_amdgcn_mfma_f32_32x32x16_bf16(pa2, AT_PK(2), o[d0], 0, 0, 0);
        o[d0] = __builtin_amdgcn_mfma_f32_32x32x16_bf16(pa3, AT_PK(3), o[d0], 0, 0, 0);
#undef AT_PK
    }
}

typedef short v4i16_t __attribute__((ext_vector_type(4)));
__device__ __forceinline__ s16x4 vtr(const AT_LAS unsigned char* p) { return __builtin_bit_cast(s16x4, __builtin_amdgcn_ds_read_tr16_b64_v4i16((AT_LAS v4i16_t*)p)); }
__device__ __forceinline__ void pv2(f32x16* o, const AT_LAS unsigned char* vp, bf16x8 pa0, bf16x8 pa1, bf16x8 pa2, bf16x8 pa3) {
#pragma unroll
    for (int d0 = 0; d0 < 2; ++d0) { s16x4 lo[4], hi[4];
#pragma unroll
        for (int ks = 0; ks < 4; ++ks) { lo[ks] = vtr(vp + d0 * 4096 + ks * 1024); hi[ks] = vtr(vp + d0 * 4096 + ks * 1024 + 512); }
#define AT_PK(k) (bf16x8){lo[k][0], lo[k][1], lo[k][2], lo[k][3], hi[k][0], hi[k][1], hi[k][2], hi[k][3]}
        o[d0] = __builtin_amdgcn_mfma_f32_32x32x16_bf16(pa0, AT_PK(0), o[d0], 0, 0, 0);
        o[d0] = __builtin_amdgcn_mfma_f32_32x32x16_bf16(pa1, AT_PK(1), o[d0], 0, 0, 0);
        o[d0] = __builtin_amdgcn_mfma_f32_32x32x16_bf16(pa2, AT_PK(2), o[d0], 0, 0, 0);
        o[d0] = __builtin_amdgcn_mfma_f32_32x32x16_bf16(pa3, AT_PK(3), o[d0], 0, 0, 0);
#undef AT_PK
    }
}

template <int DQ, bool MOBA, bool QNORM, int G>
__device__ __forceinline__ void attn_unit(AT_LAS unsigned char* lds, const Tensors& T, long rowbase, int qb, const float* km, const float* qg, const float* tab) {
    constexpr int NKP = DQ / 8, NP = NKP + 8, SLOTB = NKP * 1024 + 8192, ND0 = DQ / 16;
    constexpr int NSLOT = 3 * G, LDS_WS = NSLOT * SLOTB, LDS_OST = 0;
    int tid_ = threadIdx.x; asm volatile("" : "+v"(tid_));
    const int tid = tid_, lane = tid & 63, r32 = lane & 31, hi = lane >> 5; const int wid = __builtin_amdgcn_readfirstlane(tid >> 6);
    const int q0 = qb * 256, NT = 4 * (qb + 1);
    const unsigned lds0 = (unsigned)(size_t)lds;
    AT_LAS float* wsf = (AT_LAS float*)(lds + LDS_WS) + wid * 64;
    asm volatile("s_waitcnt vmcnt(0)" ::: "memory");
    const unsigned short* src[3]; unsigned dsto[3];
#pragma unroll
    for (int k = 0; k < 3; ++k) { const int pi = wid + 8 * k;
        if (pi < NKP) { src[k] = (T.pk == 0) ? T.K + pi * 512 + lane * 8 : T.K + (rowbase + lane) * T.pk + 8 * pi; dsto[k] = pi * 1024; }
        else { const int v = pi - NKP; src[k] = (T.pv == 0) ? T.V + v * 512 + lane * 8 : T.V + (rowbase + 16 * (v & 3) + (lane >> 2)) * T.pv + 32 * (v >> 2) + 8 * (lane & 3); dsto[k] = NKP * 1024 + v * 1024; } }
    const long kstep = (T.pk == 0) ? (long)NKP * 512 : (long)64 * T.pk, vstep = (T.pv == 0) ? (long)4096 : (long)64 * T.pv;
#define AT_DMA(t, slot) do { _Pragma("unroll") for (int k_ = 0; k_ < 3; ++k_) { const int pi_ = wid + 8 * k_; if (pi_ < NP) { \
        const unsigned short* s_ = src[k_] + (long)(t) * ((pi_ < NKP) ? kstep : vstep); glds16(s_, (unsigned)__builtin_amdgcn_readfirstlane(lds0 + (slot) * SLOTB + dsto[k_])); } } } while (0)
    _Pragma("unroll") for (int i_ = 0; i_ < G; ++i_) AT_DMA(i_, i_);
    __builtin_amdgcn_sched_barrier(0);
    bf16x8 qr[ND0];
    { const unsigned short* Qw = T.Q + (rowbase + q0 + wid * 32 + r32) * T.pq + hi * 8;
#pragma unroll
      for (int d0 = 0; d0 < ND0; ++d0) qr[d0] = *(const bf16x8*)(Qw + d0 * 16); }
    __builtin_amdgcn_sched_barrier(0);
    if constexpr (QNORM) {
        float s = 0.f;
#pragma unroll
        for (int d0 = 0; d0 < ND0; ++d0)
#pragma unroll
            for (int j = 0; j < 8; ++j) { const float x = bf2f((unsigned short)qr[d0][j]); s += x * x; }
        s = swap_sum(s);
        const float rstd = 0.14724445073472677f / sqrtf(s * (1.f / 96.f) + 1e-6f);
#pragma unroll
        for (int d0 = 0; d0 < 4; ++d0) { const f32x4 g0 = *(const f32x4*)(qg + d0 * 16 + hi * 8), g1 = *(const f32x4*)(qg + d0 * 16 + hi * 8 + 4); u32x4 w;
            w.x = cvtpk(bf2f((unsigned short)qr[d0][0]) * rstd * g0.x, bf2f((unsigned short)qr[d0][1]) * rstd * g0.y); w.y = cvtpk(bf2f((unsigned short)qr[d0][2]) * rstd * g0.z, bf2f((unsigned short)qr[d0][3]) * rstd * g0.w);
            w.z = cvtpk(bf2f((unsigned short)qr[d0][4]) * rstd * g1.x, bf2f((unsigned short)qr[d0][5]) * rstd * g1.y); w.w = cvtpk(bf2f((unsigned short)qr[d0][6]) * rstd * g1.z, bf2f((unsigned short)qr[d0][7]) * rstd * g1.w);
            qr[d0] = __builtin_bit_cast(bf16x8, w); asm volatile("" : "+v"(qr[d0])); }
        { const int pos = q0 + wid * 32 + r32; const float* tb = tab + (pos * 16 + hi * 8) * 2; const float* ga = qg + 64 + hi * 8; const float* gb = qg + 80 + hi * 8; float oa[8], ob[8];
#pragma unroll
          for (int j = 0; j < 8; ++j) { const float x1 = bf2f((unsigned short)qr[4][j]) * rstd * ga[j], x2 = bf2f((unsigned short)qr[5][j]) * rstd * gb[j]; const float c = tb[2 * j], sn = tb[2 * j + 1]; oa[j] = x1 * c - x2 * sn; ob[j] = x1 * sn + x2 * c; }
          u32x4 w; w.x = cvtpk(oa[0], oa[1]); w.y = cvtpk(oa[2], oa[3]); w.z = cvtpk(oa[4], oa[5]); w.w = cvtpk(oa[6], oa[7]); qr[4] = __builtin_bit_cast(bf16x8, w);
          w.x = cvtpk(ob[0], ob[1]); w.y = cvtpk(ob[2], ob[3]); w.z = cvtpk(ob[4], ob[5]); w.w = cvtpk(ob[6], ob[7]); qr[5] = __builtin_bit_cast(bf16x8, w); }
    }
    __builtin_amdgcn_sched_barrier(0);
    unsigned sel = 0xffffffffu;
    if (MOBA) {
        sel = 0u; float gate[8];
#pragma unroll
        for (int j = 0; j < 7; ++j) { float a = 0.f;
            if (j < qb) { const float* kj = km + j * 512 + hi * 8;
#pragma unroll
                for (int d0 = 0; d0 < ND0; ++d0) { const f32x4 k0 = *(const f32x4*)(kj + d0 * 16), k1 = *(const f32x4*)(kj + d0 * 16 + 4);
                    a += bf2f((unsigned short)qr[d0][0]) * k0.x + bf2f((unsigned short)qr[d0][1]) * k0.y + bf2f((unsigned short)qr[d0][2]) * k0.z + bf2f((unsigned short)qr[d0][3]) * k0.w
                       + bf2f((unsigned short)qr[d0][4]) * k1.x + bf2f((unsigned short)qr[d0][5]) * k1.y + bf2f((unsigned short)qr[d0][6]) * k1.z + bf2f((unsigned short)qr[d0][7]) * k1.w; } }
            a = swap_sum(a); gate[j] = (j < qb) ? a : -INFINITY; }
        gate[7] = -INFINITY;
#pragma unroll
        for (int r = 0; r < 3; ++r) { int best = -1; float bv = -INFINITY;
#pragma unroll
            for (int j = 0; j < 8; ++j) if (!((sel >> j) & 1u) && gate[j] > bv) { bv = gate[j]; best = j; }
            if (best >= 0) sel |= 1u << best; }
    }
    __builtin_amdgcn_sched_barrier(0);
    float mhat = 0.f, l = 0.f; f32x16 o[2]; o[0] = f32x16{}; o[1] = f32x16{};
    const int qrel = wid * 32 + r32;
    const int vbl = ((lane >> 4) & 1) * 32 + (lane & 3) * 8 + (4 * hi + ((lane & 15) >> 2)) * 64;
#define AT_GROUP(u) do { asm volatile("s_waitcnt vmcnt(0) lgkmcnt(0)\n\ts_barrier" ::: "memory"); \
        if ((u) + G < NT) { _Pragma("unroll") for (int i_ = 0; i_ < G; ++i_) { const int tt_ = (u) + G + i_; AT_DMA(tt_, tt_ % NSLOT); } } } while (0)
#define AT_KLOAD(sl) do { const AT_LAS unsigned char* kb = lds + (sl) * SLOTB + hi * 1024 + r32 * 16; \
        _Pragma("unroll") for (int d0 = 0; d0 < ND0; ++d0) { kf[2 * d0] = *(const AT_LAS bf16x8*)(kb + d0 * 2048); kf[2 * d0 + 1] = *(const AT_LAS bf16x8*)(kb + d0 * 2048 + 512); } } while (0)
    bf16x8 kf[2 * ND0]; s16x4 vlo[8], vhi[8];
    AT_GROUP(0);
    AT_KLOAD(0);
    int slot = 0;
    for (int t = 0; t < NT; ++t) {
        __builtin_amdgcn_sched_barrier(0);
        { const AT_LAS unsigned char* vp = lds + slot * SLOTB + NKP * 1024 + vbl;
#pragma unroll
          for (int i = 0; i < 8; ++i) { vlo[i] = vtr(vp + (i >> 2) * 4096 + (i & 3) * 1024); vhi[i] = vtr(vp + (i >> 2) * 4096 + (i & 3) * 1024 + 512); } }
        __builtin_amdgcn_sched_barrier(0);
        f32x16 p0, p1;
#pragma unroll
        for (int d0 = 0; d0 < ND0; ++d0) {
            if (d0 == 0) { p0 = __builtin_amdgcn_mfma_f32_32x32x16_bf16(kf[0], qr[0], f32x16{}, 0, 0, 0); p1 = __builtin_amdgcn_mfma_f32_32x32x16_bf16(kf[1], qr[0], f32x16{}, 0, 0, 0); }
            else { p0 = __builtin_amdgcn_mfma_f32_32x32x16_bf16(kf[2 * d0], qr[d0], p0, 0, 0, 0); p1 = __builtin_amdgcn_mfma_f32_32x32x16_bf16(kf[2 * d0 + 1], qr[d0], p1, 0, 0, 0); } }
        __builtin_amdgcn_sched_barrier(0);
        const int nslot = (slot == NSLOT - 1) ? 0 : slot + 1;
        if (t + 1 < NT) { if (((t + 1) % G) == 0) AT_GROUP(t + 1); AT_KLOAD(nslot); }
        __builtin_amdgcn_sched_barrier(0);
        const int jb = t - (NT - 4);
        if (jb >= 0) { const int kb0 = 64 * jb + 4 * hi;
#pragma unroll
            for (int r = 0; r < 16; ++r) { const int kv = kb0 + (r & 3) + 8 * (r >> 2); if (kv > qrel) p0[r] = NEGM; if (kv + 32 > qrel) p1[r] = NEGM; } }
        else if (MOBA) { const bool keep = ((sel >> (t >> 2)) & 1u) != 0u;
            if (!__all(keep)) { if (!keep) {
#pragma unroll
                for (int r = 0; r < 16; ++r) { p0[r] = NEGM; p1[r] = NEGM; } } } }
        float rm;
        { float a_ = fmaxf(fmaxf(p0[0], p0[1]), p1[0]), b_ = fmaxf(fmaxf(p0[2], p0[3]), p1[1]); a_ = fmaxf(fmaxf(a_, p1[2]), p1[3]);
#pragma unroll
          for (int r = 4; r < 16; r += 4) { a_ = fmaxf(fmaxf(a_, p0[r]), p0[r + 1]); b_ = fmaxf(fmaxf(b_, p0[r + 2]), p0[r + 3]); a_ = fmaxf(fmaxf(a_, p1[r]), p1[r + 1]); b_ = fmaxf(fmaxf(b_, p1[r + 2]), p1[r + 3]); }
          rm = swap_max(fmaxf(a_, b_)) - mhat; }
        if (__any(rm > THR)) {
            const float dl = fmaxf(rm, 0.f); mhat += dl;
            const float alpha = __builtin_amdgcn_exp2f(-dl); l *= alpha;
            if (hi == 0) wsf[r32] = alpha;
            asm volatile("s_waitcnt lgkmcnt(0)" ::: "memory");
#pragma unroll
            for (int r = 0; r < 16; ++r) { const float f = wsf[crow(r, hi)]; o[0][r] *= f; o[1][r] *= f; }
        }
        float sacc = 0.f;
#pragma unroll
        for (int r = 0; r < 16; ++r) { p0[r] = __builtin_amdgcn_exp2f(p0[r] - mhat); p1[r] = __builtin_amdgcn_exp2f(p1[r] - mhat); sacc += p0[r] + p1[r]; }
        l += sacc;
        u32x4 pw[4];
        pw[0] = (u32x4){cvtpk(p0[0], p0[1]), cvtpk(p0[2], p0[3]), cvtpk(p0[4], p0[5]), cvtpk(p0[6], p0[7])};
        pw[1] = (u32x4){cvtpk(p0[8], p0[9]), cvtpk(p0[10], p0[11]), cvtpk(p0[12], p0[13]), cvtpk(p0[14], p0[15])};
        pw[2] = (u32x4){cvtpk(p1[0], p1[1]), cvtpk(p1[2], p1[3]), cvtpk(p1[4], p1[5]), cvtpk(p1[6], p1[7])};
        pw[3] = (u32x4){cvtpk(p1[8], p1[9]), cvtpk(p1[10], p1[11]), cvtpk(p1[12], p1[13]), cvtpk(p1[14], p1[15])};
        __builtin_amdgcn_sched_barrier(0);
#pragma unroll
        for (int d0 = 0; d0 < 2; ++d0)
#pragma unroll
            for (int ks = 0; ks < 4; ++ks) { const int i = d0 * 4 + ks;
                o[d0] = __builtin_amdgcn_mfma_f32_32x32x16_bf16(__builtin_bit_cast(bf16x8, pw[ks]), (bf16x8){vlo[i][0], vlo[i][1], vlo[i][2], vlo[i][3], vhi[i][0], vhi[i][1], vhi[i][2], vhi[i][3]}, o[d0], 0, 0, 0); }
        slot = nslot;
    }
#undef AT_GROUP
#undef AT_KLOAD
#undef AT_DMA
    asm volatile("s_waitcnt lgkmcnt(0)\n\ts_barrier" ::: "memory");
    l = swap_sum(l);
    if (hi == 0) wsf[32 + r32] = l;
    asm volatile("s_waitcnt lgkmcnt(0)" ::: "memory");
    float rli[16];
#pragma unroll
    for (int r = 0; r < 16; ++r) rli[r] = __builtin_amdgcn_rcpf(wsf[32 + crow(r, hi)]);
    unsigned short* Ow = T.O + (rowbase + q0 + wid * 32) * T.po;
    { AT_LAS unsigned short* stg = (AT_LAS unsigned short*)(lds + LDS_OST) + wid * 2048;
#pragma unroll
      for (int r = 0; r < 16; ++r) { const int orow = crow(r, hi);
#pragma unroll
          for (int d0 = 0; d0 < 2; ++d0) stg[orow * 64 + d0 * 32 + r32] = (unsigned short)f2bf(o[d0][r] * rli[r]); }
      asm volatile("s_waitcnt lgkmcnt(0)" ::: "memory");
#pragma unroll
      for (int i = 0; i < 4; ++i) { const int row = i * 8 + (lane >> 3), ch = lane & 7; const u32x4 v = *(const AT_LAS u32x4*)(stg + row * 64 + ch * 8); *(u32x4*)(Ow + (long)row * T.po + ch * 8) = v; } }
    asm volatile("s_waitcnt lgkmcnt(0)\n\ts_barrier" ::: "memory");
}
template <int DQ, bool MOBA, bool QNORM, int G>
__device__ __forceinline__ void attn_unit_p(AT_LAS unsigned char* lds, const Tensors& T, long rowbase, int qb, const float* km, const float* qg, const float* tab, float kbound, int tbase, bool prefetched, bool has_next) {
    constexpr int NKP = DQ / 8, NP = NKP + 8, SLOTB = NKP * 1024 + 8192, ND0 = DQ / 16;
    constexpr int NSLOT = 3 * G, LDS_WS = NSLOT * SLOTB, LDS_OST = LDS_WS + 2048;
    int tid_ = threadIdx.x; asm volatile("" : "+v"(tid_));
    const int tid = tid_, lane = tid & 63, r32 = lane & 31, hi = lane >> 5; const int wid = __builtin_amdgcn_readfirstlane(tid >> 6);
    const int q0 = qb * 256, NT = 4 * (qb + 1);
    const unsigned lds0 = (unsigned)(size_t)lds;
    AT_LAS float* wsf = (AT_LAS float*)(lds + LDS_WS) + wid * 64;
    asm volatile("s_waitcnt vmcnt(0)" ::: "memory");
    unsigned soff[3], dsto[3];
#pragma unroll
    for (int k = 0; k < 3; ++k) { const int pi = wid + 8 * k;
        if (pi < NKP) { soff[k] = (T.pk == 0) ? (unsigned)(pi * 512 + lane * 8) : (unsigned)((rowbase + lane) * T.pk + 8 * pi); dsto[k] = pi * 1024; }
        else { const int v = pi - NKP; soff[k] = (T.pv == 0) ? (unsigned)(v * 512 + lane * 8) : (unsigned)((rowbase + 16 * (v & 3) + (lane >> 2)) * T.pv + 32 * (v >> 2) + 8 * (lane & 3)); dsto[k] = NKP * 1024 + v * 1024; } }
    const unsigned kstep = (T.pk == 0) ? (unsigned)NKP * 512u : 64u * (unsigned)T.pk, vstep = (T.pv == 0) ? 4096u : 64u * (unsigned)T.pv;
#define AT_DMA(t, slot) do { _Pragma("unroll") for (int k_ = 0; k_ < 3; ++k_) { const int pi_ = wid + 8 * k_; if (pi_ < NP) { \
        const unsigned short* s_ = ((pi_ < NKP) ? T.K : T.V) + (size_t)(soff[k_] + (unsigned)(t) * ((pi_ < NKP) ? kstep : vstep)); glds16(s_, (unsigned)__builtin_amdgcn_readfirstlane(lds0 + (slot) * SLOTB + dsto[k_])); } } } while (0)
    if (!prefetched) { _Pragma("unroll") for (int i_ = 0; i_ < G; ++i_) AT_DMA(i_, (tbase + i_) % NSLOT); }
    __builtin_amdgcn_sched_barrier(0);
    bf16x8 qr[ND0];
    { const unsigned short* Qw = T.Q + (rowbase + q0 + wid * 32 + r32) * T.pq + hi * 8;
#pragma unroll
      for (int d0 = 0; d0 < ND0; ++d0) qr[d0] = *(const bf16x8*)(Qw + d0 * 16); }
    __builtin_amdgcn_sched_barrier(0);
    if constexpr (QNORM) {
        float s = 0.f;
#pragma unroll
        for (int d0 = 0; d0 < ND0; ++d0)
#pragma unroll
            for (int j = 0; j < 8; ++j) { const float x = bf2f((unsigned short)qr[d0][j]); s += x * x; }
        s = swap_sum(s);
        const float rstd = 0.14724445073472677f / sqrtf(s * (1.f / 96.f) + 1e-6f);
#pragma unroll
        for (int d0 = 0; d0 < 4; ++d0) { const f32x4 g0 = *(const f32x4*)(qg + d0 * 16 + hi * 8), g1 = *(const f32x4*)(qg + d0 * 16 + hi * 8 + 4); u32x4 w;
            w.x = cvtpk(bf2f((unsigned short)qr[d0][0]) * rstd * g0.x, bf2f((unsigned short)qr[d0][1]) * rstd * g0.y); w.y = cvtpk(bf2f((unsigned short)qr[d0][2]) * rstd * g0.z, bf2f((unsigned short)qr[d0][3]) * rstd * g0.w);
            w.z = cvtpk(bf2f((unsigned short)qr[d0][4]) * rstd * g1.x, bf2f((unsigned short)qr[d0][5]) * rstd * g1.y); w.w = cvtpk(bf2f((unsigned short)qr[d0][6]) * rstd * g1.z, bf2f((unsigned short)qr[d0][7]) * rstd * g1.w);
            qr[d0] = __builtin_bit_cast(bf16x8, w); asm volatile("" : "+v"(qr[d0])); }
        { const int pos = q0 + wid * 32 + r32; const float* tb = tab + (pos * 16 + hi * 8) * 2; const float* ga = qg + 64 + hi * 8; const float* gb = qg + 80 + hi * 8; float oa[8], ob[8];
#pragma unroll
          for (int j = 0; j < 8; ++j) { const float x1 = bf2f((unsigned short)qr[4][j]) * rstd * ga[j], x2 = bf2f((unsigned short)qr[5][j]) * rstd * gb[j]; const float c = tb[2 * j], sn = tb[2 * j + 1]; oa[j] = x1 * c - x2 * sn; ob[j] = x1 * sn + x2 * c; }
          u32x4 w; w.x = cvtpk(oa[0], oa[1]); w.y = cvtpk(oa[2], oa[3]); w.z = cvtpk(oa[4], oa[5]); w.w = cvtpk(oa[6], oa[7]); qr[4] = __builtin_bit_cast(bf16x8, w);
          w.x = cvtpk(ob[0], ob[1]); w.y = cvtpk(ob[2], ob[3]); w.z = cvtpk(ob[4], ob[5]); w.w = cvtpk(ob[6], ob[7]); qr[5] = __builtin_bit_cast(bf16x8, w); }
    }
    __builtin_amdgcn_sched_barrier(0);
    unsigned sel = 0xffffffffu;
    if (MOBA) {
        sel = 0u; float gate[8];
#pragma unroll
        for (int j = 0; j < 7; ++j) { float a = 0.f;
            if (j < qb) { const float* kj = km + j * 512 + hi * 8;
#pragma unroll
                for (int d0 = 0; d0 < ND0; ++d0) { const f32x4 k0 = *(const f32x4*)(kj + d0 * 16), k1 = *(const f32x4*)(kj + d0 * 16 + 4);
                    a += bf2f((unsigned short)qr[d0][0]) * k0.x + bf2f((unsigned short)qr[d0][1]) * k0.y + bf2f((unsigned short)qr[d0][2]) * k0.z + bf2f((unsigned short)qr[d0][3]) * k0.w
                       + bf2f((unsigned short)qr[d0][4]) * k1.x + bf2f((unsigned short)qr[d0][5]) * k1.y + bf2f((unsigned short)qr[d0][6]) * k1.z + bf2f((unsigned short)qr[d0][7]) * k1.w; } }
            a = swap_sum(a); gate[j] = (j < qb) ? a : -INFINITY; }
        gate[7] = -INFINITY;
#pragma unroll
        for (int r = 0; r < 3; ++r) { int best = -1; float bv = -INFINITY;
#pragma unroll
            for (int j = 0; j < 8; ++j) if (!((sel >> j) & 1u) && gate[j] > bv) { bv = gate[j]; best = j; }
            if (best >= 0) sel |= 1u << best; }
    }
    __builtin_amdgcn_sched_barrier(0);
    float l = 0.f; f32x16 o[2]; o[0] = f32x16{}; o[1] = f32x16{};
    f32x16 negm;
    { float qss = 0.f;
#pragma unroll
      for (int d0 = 0; d0 < ND0; ++d0)
#pragma unroll
          for (int j = 0; j < 8; ++j) { const float x = bf2f((unsigned short)qr[d0][j]); qss += x * x; }
      qss = swap_sum(qss); const float mrow = sqrtf(qss) * kbound;
#pragma unroll
      for (int r = 0; r < 16; ++r) negm[r] = -mrow;
      asm volatile("" : "+v"(negm)); }

    const int qrel = wid * 32 + r32;
    const int vbl = ((lane >> 4) & 1) * 32 + (lane & 3) * 8 + (4 * hi + ((lane & 15) >> 2)) * 64;
#define AT_GROUP(u) do { asm volatile("s_waitcnt vmcnt(0) lgkmcnt(0)\n\ts_barrier" ::: "memory"); \
        if ((u) + G < NT) { _Pragma("unroll") for (int i_ = 0; i_ < G; ++i_) { const int tt_ = (u) + G + i_; AT_DMA(tt_, (tbase + tt_) % NSLOT); } } \
        else if (has_next) { _Pragma("unroll") for (int i_ = 0; i_ < G; ++i_) AT_DMA(i_, (tbase + NT + i_) % NSLOT); } } while (0)
#define AT_KLOAD(sl) do { const AT_LAS unsigned char* kb = lds + (sl) * SLOTB + hi * 1024 + r32 * 16; \
        _Pragma("unroll") for (int d0 = 0; d0 < ND0; ++d0) { kf[2 * d0] = *(const AT_LAS bf16x8*)(kb + d0 * 2048); kf[2 * d0 + 1] = *(const AT_LAS bf16x8*)(kb + d0 * 2048 + 512); } } while (0)
#define AT_VLOAD(sl) do { const AT_LAS unsigned char* vp = lds + (sl) * SLOTB + NKP * 1024 + vbl; \
        _Pragma("unroll") for (int i = 0; i < 8; ++i) { vlo[i] = vtr(vp + (i >> 2) * 4096 + (i & 3) * 1024); vhi[i] = vtr(vp + (i >> 2) * 4096 + (i & 3) * 1024 + 512); } } while (0)
#define AT_SUMPACK() do { float sacc = 0.f; \
        _Pragma("unroll") for (int r = 0; r < 16; ++r) sacc += c0[r] + c1[r]; \
        l += sacc; \
        pw[0] = (u32x4){cvtpk(c0[0], c0[1]), cvtpk(c0[2], c0[3]), cvtpk(c0[4], c0[5]), cvtpk(c0[6], c0[7])}; \
        pw[1] = (u32x4){cvtpk(c0[8], c0[9]), cvtpk(c0[10], c0[11]), cvtpk(c0[12], c0[13]), cvtpk(c0[14], c0[15])}; \
        pw[2] = (u32x4){cvtpk(c1[0], c1[1]), cvtpk(c1[2], c1[3]), cvtpk(c1[4], c1[5]), cvtpk(c1[6], c1[7])}; \
        pw[3] = (u32x4){cvtpk(c1[8], c1[9]), cvtpk(c1[10], c1[11]), cvtpk(c1[12], c1[13]), cvtpk(c1[14], c1[15])}; } while (0)
#define AT_QKT(N0, N1) do { _Pragma("unroll") for (int d0 = 0; d0 < ND0; ++d0) { \
            if (d0 == 0) { N0 = __builtin_amdgcn_mfma_f32_32x32x16_bf16(kf[0], qr[0], negm, 0, 0, 0); N1 = __builtin_amdgcn_mfma_f32_32x32x16_bf16(kf[1], qr[0], negm, 0, 0, 0); } \
            else { N0 = __builtin_amdgcn_mfma_f32_32x32x16_bf16(kf[2 * d0], qr[d0], N0, 0, 0, 0); N1 = __builtin_amdgcn_mfma_f32_32x32x16_bf16(kf[2 * d0 + 1], qr[d0], N1, 0, 0, 0); } } } while (0)
#define AT_DECIDE(tt) do { \
        { const int jb = (tt) - (NT - 4); \
          if (jb >= 0) { const int kb0 = 64 * jb + 4 * hi; \
              _Pragma("unroll") for (int r = 0; r < 16; ++r) { const int kv = kb0 + (r & 3) + 8 * (r >> 2); if (kv > qrel) c0[r] = NEGM; if (kv + 32 > qrel) c1[r] = NEGM; } } \
          else if (MOBA) { const bool keep = ((sel >> ((tt) >> 2)) & 1u) != 0u; \
              if (!__all(keep)) { if (!keep) { _Pragma("unroll") for (int r = 0; r < 16; ++r) { c0[r] = NEGM; c1[r] = NEGM; } } } } } \
        if ((tt) + 1 < NT && (((tt) + 1) % G) == 0) AT_GROUP((tt) + 1); } while (0)
#define AT_EXPS() do { _Pragma("unroll") for (int r = 0; r < 16; ++r) { c0[r] = __builtin_amdgcn_exp2f(c0[r]); c1[r] = __builtin_amdgcn_exp2f(c1[r]); } } while (0)
#define AT_PV() do { _Pragma("unroll") for (int d0 = 0; d0 < 2; ++d0) _Pragma("unroll") for (int ks = 0; ks < 4; ++ks) { const int i = d0 * 4 + ks; \
            o[d0] = __builtin_amdgcn_mfma_f32_32x32x16_bf16(__builtin_bit_cast(bf16x8, pw[ks]), (bf16x8){vlo[i][0], vlo[i][1], vlo[i][2], vlo[i][3], vhi[i][0], vhi[i][1], vhi[i][2], vhi[i][3]}, o[d0], 0, 0, 0); } } while (0)
#define AT_SGB(mask, n) __builtin_amdgcn_sched_group_barrier(mask, n, 0)
    constexpr int NG = 2 * ND0;
    bf16x8 kf[2 * ND0]; s16x4 vlo[8], vhi[8]; u32x4 pw[4]; f32x16 c0, c1;
    AT_GROUP(0);
    AT_KLOAD(tbase % NSLOT);
    AT_QKT(c0, c1);
    AT_DECIDE(0);
    AT_KLOAD((tbase + 1) % NSLOT);
    AT_EXPS();
    int slot = (tbase + 1) % NSLOT, pslot = tbase % NSLOT;
    for (int t = 1; t < NT; ++t) {
        const int nslot = (t + 1 < NT) ? ((slot == NSLOT - 1) ? 0 : slot + 1) : slot;
        __builtin_amdgcn_sched_barrier(0);
        { f32x16 n0, n1; float sacc = 0.f;
          const AT_LAS unsigned char* vp = lds + pslot * SLOTB + NKP * 1024 + vbl;
#pragma unroll
          for (int i = 0; i < NG; ++i) {
              if (i >= NG - 2) { const int vi = i - (NG - 2); vlo[vi] = vtr(vp + (vi >> 2) * 4096 + (vi & 3) * 1024); vhi[vi] = vtr(vp + (vi >> 2) * 4096 + (vi & 3) * 1024 + 512); }
              const int d0 = i >> 1;
              if (i & 1) n1 = (d0 == 0) ? __builtin_amdgcn_mfma_f32_32x32x16_bf16(kf[i], qr[d0], negm, 0, 0, 0) : __builtin_amdgcn_mfma_f32_32x32x16_bf16(kf[i], qr[d0], n1, 0, 0, 0);
              else n0 = (d0 == 0) ? __builtin_amdgcn_mfma_f32_32x32x16_bf16(kf[i], qr[d0], negm, 0, 0, 0) : __builtin_amdgcn_mfma_f32_32x32x16_bf16(kf[i], qr[d0], n0, 0, 0, 0);
#pragma unroll
              for (int rr = (i * 32) / NG; rr < ((i + 1) * 32) / NG; ++rr) sacc += (rr < 16) ? c0[rr] : c1[rr - 16];
#pragma unroll
              for (int ww = (i * 16) / NG; ww < ((i + 1) * 16) / NG; ++ww) { const int e = 2 * ww; pw[ww >> 2][ww & 3] = (e < 16) ? cvtpk(c0[e], c0[e + 1]) : cvtpk(c1[e - 16], c1[e - 15]); }
              __builtin_amdgcn_sched_barrier(0); }
          l += sacc; c0 = n0; c1 = n1; }
        AT_DECIDE(t);
        __builtin_amdgcn_sched_barrier(0);
        { const AT_LAS unsigned char* kb = lds + nslot * SLOTB + hi * 1024 + r32 * 16; const AT_LAS unsigned char* vpB = lds + pslot * SLOTB + NKP * 1024 + vbl;
#pragma unroll
          for (int i = 0; i < 8; ++i) {
              if (i + 2 < 8) { const int vi = i + 2; vlo[vi] = vtr(vpB + (vi >> 2) * 4096 + (vi & 3) * 1024); vhi[vi] = vtr(vpB + (vi >> 2) * 4096 + (vi & 3) * 1024 + 512); }
              if (i >= 2 && i < 6) {
#pragma unroll
                  for (int q = (i - 2) * NG / 4; q < (i - 1) * NG / 4; ++q) kf[q] = *(const AT_LAS bf16x8*)(kb + (q >> 1) * 2048 + (q & 1) * 512); }
              o[i >> 2] = __builtin_amdgcn_mfma_f32_32x32x16_bf16(__builtin_bit_cast(bf16x8, pw[i & 3]), (bf16x8){vlo[i][0], vlo[i][1], vlo[i][2], vlo[i][3], vhi[i][0], vhi[i][1], vhi[i][2], vhi[i][3]}, o[i >> 2], 0, 0, 0);
#pragma unroll
              for (int rr = 4 * i; rr < 4 * i + 4; ++rr) { if (rr < 16) c0[rr] = __builtin_amdgcn_exp2f(c0[rr]); else c1[rr - 16] = __builtin_amdgcn_exp2f(c1[rr - 16]); }
              __builtin_amdgcn_sched_barrier(0); } }
        pslot = slot; slot = nslot;
    }
    AT_VLOAD(pslot);
    AT_SUMPACK();
    AT_PV();
#undef AT_GROUP
#undef AT_KLOAD
#undef AT_VLOAD
#undef AT_SUMPACK
#undef AT_QKT
#undef AT_DECIDE
#undef AT_EXPS
#undef AT_PV
#undef AT_SGB
#undef AT_DMA
    asm volatile("s_waitcnt lgkmcnt(0)\n\ts_barrier" ::: "memory");
    l = swap_sum(l);
    if (hi == 0) wsf[32 + r32] = l;
    asm volatile("s_waitcnt lgkmcnt(0)" ::: "memory");
    float rli[16];
#pragma unroll
    for (int r = 0; r < 16; ++r) rli[r] = __builtin_amdgcn_rcpf(wsf[32 + crow(r, hi)]);
    unsigned short* Ow = T.O + (rowbase + q0 + wid * 32) * T.po;
    { AT_LAS unsigned short* stg = (AT_LAS unsigned short*)(lds + LDS_OST) + wid * 2048;
#pragma unroll
      for (int r = 0; r < 16; ++r) { const int orow = crow(r, hi);
#pragma unroll
          for (int d0 = 0; d0 < 2; ++d0) stg[orow * 64 + d0 * 32 + r32] = (unsigned short)f2bf(o[d0][r] * rli[r]); }
      asm volatile("s_waitcnt lgkmcnt(0)" ::: "memory");
#pragma unroll
      for (int i = 0; i < 4; ++i) { const int row = i * 8 + (lane >> 3), ch = lane & 7; const u32x4 v = *(const AT_LAS u32x4*)(stg + row * 64 + ch * 8); *(u32x4*)(Ow + (long)row * T.po + ch * 8) = v; } }
    asm volatile("s_waitcnt lgkmcnt(0)\n\ts_barrier" ::: "memory");
}
#undef AT_LAS
}

namespace ssd {
typedef short bf16x8 __attribute__((ext_vector_type(8)));
typedef short v4i16_t __attribute__((ext_vector_type(4)));
typedef float f32x16 __attribute__((ext_vector_type(16)));
typedef unsigned u32x4 __attribute__((ext_vector_type(4)));
#define SS_LAS __attribute__((address_space(3)))
__device__ __forceinline__ int crow(int r, int hi) { return (r & 3) + 8 * (r >> 2) + 4 * hi; }
__device__ __forceinline__ v4i16_t vtr(const SS_LAS unsigned char* p) { return __builtin_amdgcn_ds_read_tr16_b64_v4i16((SS_LAS v4i16_t*)p); }
__device__ __forceinline__ bf16x8 tr_frag(const SS_LAS unsigned char* img, int pitch, int k0, int c0, int lane) {
    const int g4 = lane >> 4, q = (lane & 15) >> 2, p4 = lane & 3;
    const SS_LAS unsigned char* a = img + (k0 + 8 * (g4 >> 1) + q) * pitch + (c0 + 16 * (g4 & 1) + 4 * p4) * 2;
    const v4i16_t lo = vtr(a), hi4 = vtr(a + 4 * pitch);
    return (bf16x8){lo[0], lo[1], lo[2], lo[3], hi4[0], hi4[1], hi4[2], hi4[3]};
}
__device__ __forceinline__ bf16x8 row_frag(const SS_LAS unsigned char* img, int pitch, int r0, int k0, int lane) {
    return *(const SS_LAS bf16x8*)(img + (r0 + (lane & 31)) * pitch + (k0 + 8 * (lane >> 5)) * 2);
}

constexpr int PX4 = 576;
constexpr int PB_T = 320;
constexpr int PR = 272;
constexpr int PX1 = 192;

__device__ __forceinline__ void dt_cs(int t0, int g, const float* DTR, const float* dtb, const float* alog, SS_LAS float* csl, SS_LAS float* dtl, SS_LAS float* wtot, int tid, int lane, int wid) {
    const int l = tid >> 2, hh = tid & 3, h = 4 * g + hh;
    const float r = DTR[(size_t)(t0 + l) * 8 + h] + dtb[h]; const float ex = __expf(fminf(r, 20.f)); const float dt = (r > 20.f) ? r : ((ex < 0.01f) ? ex * (1.f - ex * (0.5f - ex * 0.33333333f)) : __logf(1.f + ex));
    float v = dt * (-expf(alog[h]));
#pragma unroll
    for (int off = 4; off < 64; off <<= 1) { const float t = __shfl_up(v, off); if (lane >= off) v += t; }
    if (lane >= 60) wtot[wid * 4 + hh] = v;
    __syncthreads();
    float base = 0.f;
    for (int w = 0; w < wid; ++w) base += wtot[w * 4 + hh];
    csl[tid] = v + base; dtl[tid] = dt;
    __syncthreads();
}
__device__ __forceinline__ void conv_load(u32x4 (&x)[19], const unsigned short* raw, int t0, int l0, int col) {
    const int pos0 = t0 & 2047;
#pragma unroll
    for (int i = 0; i < 19; ++i) { const int l = l0 - 3 + i; x[i] = (u32x4){0u, 0u, 0u, 0u}; if (pos0 + l >= 0) x[i] = *(const u32x4*)(raw + (size_t)(t0 + l) * 1024 + col); }
}
template <bool SCALED> __device__ __forceinline__ void conv_compute(const u32x4 (&x)[19], int l0, int col, const float* cw, const float* cb, SS_LAS unsigned char* img, int pitch, const SS_LAS float* sc) {
    float w[4][8], b[8];
#pragma unroll
    for (int k = 0; k < 4; ++k) { const f32x4 a = *(const f32x4*)(cw + k * 1024 + col), c = *(const f32x4*)(cw + k * 1024 + col + 4); w[k][0] = a.x; w[k][1] = a.y; w[k][2] = a.z; w[k][3] = a.w; w[k][4] = c.x; w[k][5] = c.y; w[k][6] = c.z; w[k][7] = c.w; }
    { const f32x4 a = *(const f32x4*)(cb + col), c = *(const f32x4*)(cb + col + 4); b[0] = a.x; b[1] = a.y; b[2] = a.z; b[3] = a.w; b[4] = c.x; b[5] = c.y; b[6] = c.z; b[7] = c.w; }
#pragma unroll
    for (int i = 0; i < 16; ++i) { const int l = l0 + i; float o[8]; const float s = SCALED ? sc[l * 4] : 1.f;
#pragma unroll
        for (int j = 0; j < 8; ++j) { float a = b[j];
#pragma unroll
            for (int k = 0; k < 4; ++k) { const unsigned wd = (j < 2) ? x[i + k].x : (j < 4) ? x[i + k].y : (j < 6) ? x[i + k].z : x[i + k].w; a += w[k][j] * ((j & 1) ? bfhi(wd) : bflo(wd)); }
            o[j] = a * __builtin_amdgcn_rcpf(1.f + __expf(-a)) * s; }
        u32x4 p; p.x = pk2(o[0], o[1]); p.y = pk2(o[2], o[3]); p.z = pk2(o[4], o[5]); p.w = pk2(o[6], o[7]);
        *(SS_LAS u32x4*)(img + l * pitch) = p; }
}

__device__ __forceinline__ void states_unit(SS_LAS unsigned char* lds, int bc, int g, const unsigned short* XBC, const float* DTR, const float* cw, const float* cb, const float* dtb, const float* alog, float* ST, float* CEND) {
    int tid_ = threadIdx.x; asm volatile("" : "+v"(tid_));
    const int tid = tid_, lane = tid & 63, r32 = lane & 31, hi = lane >> 5; const int wid = __builtin_amdgcn_readfirstlane(tid >> 6);
    const int t0 = bc * 128;
    SS_LAS unsigned char* XD = lds; SS_LAS unsigned char* BI = lds + 128 * PX4;
    SS_LAS float* csl = (SS_LAS float*)(lds + 128 * PX4 + 128 * PB_T); SS_LAS float* dtl = csl + 512; SS_LAS float* wtot = dtl + 512; SS_LAS float* scl = wtot + 32;
    const int ch = tid % 48, l0 = (tid / 48) * 16; const int col = (ch < 32) ? g * 256 + ch * 8 : 512 + g * 128 + (ch - 32) * 8;
    u32x4 xr[19];
    if (tid < 384) conv_load(xr, XBC, t0, l0, col);
    dt_cs(t0, g, DTR, dtb, alog, csl, dtl, wtot, tid, lane, wid);
    scl[tid] = dtl[tid] * __expf(csl[508 + (tid & 3)] - csl[tid]);
    if (tid < 4) CEND[bc * 8 + g * 4 + tid] = csl[508 + tid];
    __syncthreads();
    if (tid < 384) {
        if (ch < 32) conv_compute<true>(xr, l0, col, cw, cb, XD + ch * 16, PX4, scl + (ch >> 3));
        else conv_compute<false>(xr, l0, col, cw, cb, BI + (ch - 32) * 16, PB_T, nullptr); }
    __syncthreads();
    const int pt = wid >> 2, nt = wid & 3;
#pragma unroll 1
    for (int hh = 0; hh < 4; ++hh) {
        f32x16 acc = f32x16{};
#pragma unroll
        for (int ks = 0; ks < 8; ++ks) {
            const bf16x8 a = tr_frag(XD, PX4, 16 * ks, hh * 64 + 32 * pt, lane);
            const bf16x8 b = tr_frag(BI, PB_T, 16 * ks, 32 * nt, lane);
            acc = __builtin_amdgcn_mfma_f32_32x32x16_bf16(a, b, acc, 0, 0, 0); }
        float* o = ST + (((size_t)(bc * 8 + g * 4 + hh) * 64 + 32 * pt) << 7) + 32 * nt + r32;
#pragma unroll
        for (int r = 0; r < 16; ++r) o[(size_t)crow(r, hi) << 7] = acc[r];
    }
    __syncthreads();
}

__device__ __forceinline__ void out_unit(SS_LAS unsigned char* lds, int bc, int g, const unsigned short* XBC, const unsigned short* VZ, const float* DTR, const float* cw, const float* cb, const float* dtb, const float* alog,
                                         const unsigned short* HIN, const float* Dsk, const float* gn, unsigned short* MIX) {
    int tid_ = threadIdx.x; asm volatile("" : "+v"(tid_));
    const int tid = tid_, lane = tid & 63, r32 = lane & 31, hi = lane >> 5; const int wid = __builtin_amdgcn_readfirstlane(tid >> 6);
    const int t0 = bc * 128;
    SS_LAS unsigned char* CI = lds; SS_LAS unsigned char* BI = lds + 128 * PR; SS_LAS unsigned char* XS = lds + 2 * 128 * PR;
    SS_LAS float* csl = (SS_LAS float*)(lds + 2 * 128 * PR + 128 * PX4); SS_LAS float* dtl = csl + 512; SS_LAS float* wtot = dtl + 512;
    const int ch = tid & 63, l0 = (tid >> 6) * 16; const int col = (ch < 32) ? g * 256 + ch * 8 : (ch < 48) ? 512 + g * 128 + (ch - 32) * 8 : 768 + g * 128 + (ch - 48) * 8;
    u32x4 xr[19];
    conv_load(xr, XBC, t0, l0, col);
    u32x4 zr[8];
    { const unsigned short* zp = VZ + (size_t)(t0 + (tid >> 2)) * 1024 + 512 + g * 256 + (tid & 3) * 64;
#pragma unroll
      for (int c = 0; c < 8; ++c) zr[c] = *(const u32x4*)(zp + c * 8); }
    dt_cs(t0, g, DTR, dtb, alog, csl, dtl, wtot, tid, lane, wid);
    if (ch < 32) conv_compute<false>(xr, l0, col, cw, cb, XS + ch * 16, PX4, nullptr);
    else if (ch < 48) conv_compute<false>(xr, l0, col, cw, cb, BI + (ch - 32) * 16, PR, nullptr);
    else conv_compute<false>(xr, l0, col, cw, cb, CI + (ch - 48) * 16, PR, nullptr);
    __syncthreads();
    const int lt = wid >> 1, st0 = 2 * (wid & 1), pt = wid & 1;
    f32x16 cb2[2]; cb2[0] = f32x16{}; cb2[1] = f32x16{};
#pragma unroll
    for (int ks = 0; ks < 8; ++ks) {
        const bf16x8 a = row_frag(CI, PR, 32 * lt, 16 * ks, lane);
        const bf16x8 b0 = row_frag(BI, PR, 32 * st0, 16 * ks, lane), b1 = row_frag(BI, PR, 32 * st0 + 32, 16 * ks, lane);
        cb2[0] = __builtin_amdgcn_mfma_f32_32x32x16_bf16(a, b0, cb2[0], 0, 0, 0);
        cb2[1] = __builtin_amdgcn_mfma_f32_32x32x16_bf16(a, b1, cb2[1], 0, 0, 0); }
    f32x16 yo[4];
    { bf16x8 hb[2][8];
      const unsigned short* hin0 = HIN + (((size_t)(bc * 8 + g * 4) * 64 + 32 * pt + r32) << 7) + 8 * hi;
#pragma unroll
      for (int ks = 0; ks < 8; ++ks) hb[0][ks] = *(const bf16x8*)(hin0 + 16 * ks);
#pragma unroll
      for (int hh = 0; hh < 4; ++hh) { yo[hh] = f32x16{};
          if (hh < 3) {
#pragma unroll
              for (int ks = 0; ks < 8; ++ks) hb[(hh + 1) & 1][ks] = *(const bf16x8*)(hin0 + ((size_t)(hh + 1) << 13) + 16 * ks); }
          __builtin_amdgcn_sched_barrier(0);
#pragma unroll
          for (int ks = 0; ks < 8; ++ks) yo[hh] = __builtin_amdgcn_mfma_f32_32x32x16_bf16(row_frag(CI, PR, 32 * lt, 16 * ks, lane), hb[hh & 1][ks], yo[hh], 0, 0, 0);
          __builtin_amdgcn_sched_barrier(0); } }
    __syncthreads();
    SS_LAS unsigned char* MI = BI;
#pragma unroll
    for (int hh = 0; hh < 4; ++hh) {
        const int h = g * 4 + hh;
#pragma unroll
        for (int j = 0; j < 2; ++j) { const int s = 32 * (st0 + j) + r32; const float css = csl[s * 4 + hh], dts = dtl[s * 4 + hh];
#pragma unroll
            for (int r = 0; r < 16; ++r) { const int l = 32 * lt + crow(r, hi); const float cl = csl[l * 4 + hh];
                float pr_ = cb2[j][r] * __builtin_amdgcn_exp2f(fminf(cl - css, 0.f) * 1.4426950408889634f) * dts; asm volatile("" : "+v"(pr_)); const float v = (s <= l) ? pr_ : 0.f;
                *(SS_LAS unsigned short*)(MI + l * PR + s * 2) = (unsigned short)f2bf(v); if ((r & 3) == 3) asm volatile("" ::: "memory"); } }
        __syncthreads();
        f32x16 yd = f32x16{};
#pragma unroll
        for (int ks = 0; ks < 8; ++ks) yd = __builtin_amdgcn_mfma_f32_32x32x16_bf16(row_frag(MI, PR, 32 * lt, 16 * ks, lane), tr_frag(XS, PX4, 16 * ks, hh * 64 + 32 * pt, lane), yd, 0, 0, 0);
        __syncthreads();
        const float dsk = Dsk[h]; const int p = 32 * pt + r32;
#pragma unroll
        for (int r = 0; r < 16; ++r) { const int l = 32 * lt + crow(r, hi);
            SS_LAS unsigned short* xp = (SS_LAS unsigned short*)(XS + l * PX4 + (hh * 64 + p) * 2);
            const float y = yd[r] + yo[hh][r] * __expf(csl[l * 4 + hh]) + dsk * bf2f(*xp);
            *xp = (unsigned short)f2bf(y); }
    }
    __syncthreads();
    { const int l = tid >> 2, q = tid & 3; const SS_LAS unsigned char* rowp = XS + l * PX4 + q * 128; float yv[8][8]; float s = 0.f;
#pragma unroll
      for (int c = 0; c < 8; ++c) { const u32x4 v = *(const SS_LAS u32x4*)(rowp + c * 16); const u32x4 z = zr[c];
          yv[c][0] = bflo(v.x) * silu_f(bflo(z.x)); yv[c][1] = bfhi(v.x) * silu_f(bfhi(z.x)); yv[c][2] = bflo(v.y) * silu_f(bflo(z.y)); yv[c][3] = bfhi(v.y) * silu_f(bfhi(z.y));
          yv[c][4] = bflo(v.z) * silu_f(bflo(z.z)); yv[c][5] = bfhi(v.z) * silu_f(bfhi(z.z)); yv[c][6] = bflo(v.w) * silu_f(bflo(z.w)); yv[c][7] = bfhi(v.w) * silu_f(bfhi(z.w));
#pragma unroll
          for (int j = 0; j < 8; ++j) s += yv[c][j] * yv[c][j]; }
      s += __shfl_xor(s, 1); s += __shfl_xor(s, 2);
      const float rstd = 1.f / sqrtf(s * (1.f / 256.f) + 1e-6f); const float* gq = gn + g * 256 + q * 64; unsigned short* op = MIX + (size_t)(t0 + l) * 1024 + 512 + g * 256 + q * 64;
#pragma unroll
      for (int c = 0; c < 8; ++c) { const f32x4 g0 = *(const f32x4*)(gq + c * 8), g1 = *(const f32x4*)(gq + c * 8 + 4); u32x4 o;
          o.x = pk2(yv[c][0] * rstd * g0.x, yv[c][1] * rstd * g0.y); o.y = pk2(yv[c][2] * rstd * g0.z, yv[c][3] * rstd * g0.w);
          o.z = pk2(yv[c][4] * rstd * g1.x, yv[c][5] * rstd * g1.y); o.w = pk2(yv[c][6] * rstd * g1.z, yv[c][7] * rstd * g1.w);
          *(u32x4*)(op + c * 8) = o; } }
    __syncthreads();
}
#undef SS_LAS
}

constexpr int NWAVES = 8, NTHR = 512;
constexpr int T_ = 32768, S_ = 2048, NB_ = 16, D_ = 1024;
constexpr int DFF = 2816, DFF2 = 5632;
constexpr float EPS = 1e-6f;
constexpr size_t MiB = 1u << 20;
constexpr size_t WS_CTL = 0, CTL_ZERO_BYTES = 3 * MiB;
constexpr size_t WS_SSQA = 1 * MiB, WS_SSQB = WS_SSQA + 256 * 1024, WS_SSQC = WS_SSQB + 256 * 1024, WS_SSQQ = WS_SSQC + 256 * 1024, WS_SSQKV = WS_SSQQ + 256 * 1024;
constexpr size_t WS_KMEAN = WS_SSQKV + 256 * 1024;
constexpr size_t WS_DTR = 55 * MiB;
constexpr size_t WS_W_IN0 = 3 * MiB;
constexpr size_t WS_W_OUT0 = WS_W_IN0 + 6656 * 1024;
constexpr size_t WS_W_IN1 = WS_W_OUT0 + 2 * MiB;
constexpr size_t WS_W_UQ = WS_W_IN1 + 2 * MiB;
constexpr size_t WS_W_UKV = WS_W_UQ + 1536 * 1024;
constexpr size_t WS_W_OUT1 = WS_W_UKV + 1 * MiB;
constexpr size_t WS_W_UP = WS_W_OUT1 + 2 * MiB;
constexpr size_t WS_W_DN = WS_W_UP + 22 * MiB;
constexpr size_t WS_TAB64 = 51 * MiB;
constexpr size_t WS_TAB32 = WS_TAB64 + 512 * 1024;
constexpr size_t WS_CWS = 52 * MiB;
constexpr size_t WS_DT = 53 * MiB;
constexpr size_t WS_CS = 54 * MiB;
constexpr size_t WS_XN = 56 * MiB;
constexpr size_t WS_BIG = 120 * MiB;
static_assert(WS_W_DN + 11 * MiB <= WS_TAB64, "weights fit");
constexpr size_t L0_QK = WS_BIG, L0_VZ = WS_BIG + 64 * MiB, L0_XBC = WS_BIG + 128 * MiB, L0_DTR = WS_BIG + 192 * MiB, L0_XBCA = WS_BIG + 256 * MiB, L0_MIX = WS_BIG + 320 * MiB;
constexpr size_t L0_ST = WS_BIG + 192 * MiB;
constexpr size_t L0_KC = WS_BIG + 288 * MiB;
constexpr size_t L0_HIN = WS_BIG + 256 * MiB;
constexpr size_t WS_CEND = 53 * MiB;
constexpr size_t L0_CB = L0_DTR;
constexpr size_t L0_YG = L0_QK;
constexpr size_t FF_ACT = WS_BIG + 64 * MiB, FF_UB = WS_BIG + 240 * MiB;
constexpr size_t L1_C1 = WS_BIG, L1_QR = WS_BIG + 64 * MiB, L1_V2 = WS_BIG + 160 * MiB;
constexpr size_t WS_RG = WS_BIG + 384 * MiB;
constexpr size_t WS_SSQPE = 53 * MiB + 64 * 1024;
constexpr size_t L1_K2 = WS_BIG + 288 * MiB;
constexpr size_t L1_O = WS_BIG + 224 * MiB;
constexpr size_t WS_END = 512 * MiB;
constexpr int CW_BAR = 4096;

constexpr int RING_OFF = 0, RING_BYTES = 162816;
constexpr int LDSCTL_OFF = RING_BYTES, MISC_OFF = LDSCTL_OFF + 320;
constexpr int LDS_BYTES = 163840;

struct Args { const float* in[25]; float* out; unsigned char* ws; int ph_lo, ph_hi; };
typedef const __attribute__((address_space(4))) Args* KArgs;
__device__ __forceinline__ KArgs kargs() { KArgs p = (KArgs)__builtin_amdgcn_kernarg_segment_ptr(); asm volatile("" : "+s"(p)); return p; }
#define PH_VARS KArgs A_ = kargs(); unsigned char* ws = A_->ws; float* out = A_->out; const float* x = A_->in[0]; bf16* XN = (bf16*)(ws + WS_XN); const float* TAB64 = (const float*)(ws + WS_TAB64); const float* TAB32 = (const float*)(ws + WS_TAB32); \
    int tid_ = threadIdx.x; asm volatile("" : "+v"(tid_)); const int tid = tid_, lane = tid & 63, wave = __builtin_amdgcn_readfirstlane(tid >> 6); int G = gridDim.x; asm volatile("" : "+s"(G)); const int gw = blockIdx.x * NWAVES + wave, NGW = G * NWAVES; const int gt = blockIdx.x * NTHR + tid, NGT = G * NTHR; \
    (void)out; (void)x; (void)XN; (void)TAB64; (void)TAB32; (void)lane; (void)gw; (void)NGW; (void)gt; (void)NGT;

template <int MAP> __device__ __forceinline__ int src_col(int n0) {
    if (MAP == 1) { const int pn = n0 >> 8, bj = (n0 >> 7) & 1, wc = (n0 >> 5) & 3; return bj * DFF + pn * 128 + wc * 32; }
    if (MAP == 2) { const int pn = n0 >> 8, bj = (n0 >> 7) & 1, wc = (n0 >> 5) & 3; return (pn < 4) ? pn * 256 + wc * 64 + bj * 32 : n0; }
    if (MAP == 3) { const int pn = n0 >> 8, bj = (n0 >> 7) & 1, wc = (n0 >> 5) & 3; if (pn < 4) return (4 * pn + wc) * 128 + bj * 32; const int col = (pn - 4) * 256 + bj * 128 + wc * 32; return (col >> 6) * 128 + 64 + (col & 63); }
    return n0;
}
template <int MAP> __device__ __forceinline__ void tr_load(f32x4 (&v)[8], const float* W, int Nsrc, int item, int nblk, int lane, const float* gain) {
    const int kb = item / nblk, nb = item % nblk, k0 = 64 * kb, n0 = 32 * nb;
    const int nn = src_col<MAP>(n0) + (lane & 7) * 4; const bool ok = (nn >= 0 && nn < Nsrc);
#pragma unroll
    for (int i = 0; i < 8; ++i) { const int kk = 8 * i + (lane >> 3); v[i] = ok ? *(const f32x4*)(W + (size_t)(k0 + kk) * Nsrc + nn) : (f32x4){0.f, 0.f, 0.f, 0.f}; if (gain) v[i] = v[i] * gain[k0 + kk]; }
}
__device__ __forceinline__ void tr_store(const f32x4 (&v)[8], int K, bf16* WT, LAS float* scr, int item, int nblk, int lane) {
    const int kb = item / nblk, nb = item % nblk, k0 = 64 * kb, n0 = 32 * nb;
#pragma unroll
    for (int i = 0; i < 8; ++i) { const int kk = 8 * i + (lane >> 3); LAS float* d = scr + kk * 33 + (lane & 7) * 4; d[0] = v[i].x; d[1] = v[i].y; d[2] = v[i].z; d[3] = v[i].w; }
    LDS_WAIT(); asm volatile("" ::: "memory");
    const int c = lane & 7;
#pragma unroll
    for (int j = 0; j < 4; ++j) { const int n = (lane >> 3) + 8 * j; const LAS float* s = scr + (8 * c) * 33 + n;
        v4u o; o.x = pk2(s[0 * 33], s[1 * 33]); o.y = pk2(s[2 * 33], s[3 * 33]); o.z = pk2(s[4 * 33], s[5 * 33]); o.w = pk2(s[6 * 33], s[7 * 33]);
        *(GAS v4u*)(WT + (size_t)(n0 + n) * K + k0 + 8 * c) = o; }
    LDS_WAIT(); asm volatile("" ::: "memory");
}
template <int MAP = 0> __device__ __forceinline__ void transpose_mat(const float* W, int K, int Nsrc, int Npad, bf16* WT, LAS float* scr, int gw, int NGW, int lane, const float* gain = nullptr) {
    const int nblk = Npad / 32, nitems = (K / 64) * nblk;
    f32x4 cur[8], nxt[8];
    if (gw < nitems) tr_load<MAP>(cur, W, Nsrc, gw, nblk, lane, gain);
    for (int it = gw; it < nitems; it += NGW) {
        const bool more = it + NGW < nitems;
        if (more) tr_load<MAP>(nxt, W, Nsrc, it + NGW, nblk, lane, gain);
        tr_store(cur, K, WT, scr, it, nblk, lane);
        if (more) {
#pragma unroll
            for (int i = 0; i < 8; ++i) cur[i] = nxt[i]; }
    }
}

struct MatDesc { const float* W; bf16* WT; const float* gain; int K, Nsrc, nblk, map; };
__device__ __forceinline__ int src_col_rt(int map, int n0) { return map == 1 ? src_col<1>(n0) : map == 2 ? src_col<2>(n0) : map == 3 ? src_col<3>(n0) : n0; }
__device__ __forceinline__ void trl_load(f32x4 (&v)[8], const MatDesc& d, int item, int lane) {
    const int kb = item / d.nblk, nb = item % d.nblk, k0 = 64 * kb, n0 = 32 * nb;
    const int nn = src_col_rt(d.map, n0) + (lane & 7) * 4; const bool ok = (nn >= 0 && nn < d.Nsrc);
#pragma unroll
    for (int i = 0; i < 8; ++i) { const int kk = 8 * i + (lane >> 3); v[i] = ok ? __builtin_nontemporal_load((const f32x4*)(d.W + (size_t)(k0 + kk) * d.Nsrc + nn)) : (f32x4){0.f, 0.f, 0.f, 0.f}; if (d.gain) v[i] = v[i] * d.gain[k0 + kk]; }
}
constexpr int NIT_W = 1536 + 512 + 512 + 384 + 256 + 512 + 2 * 2816 + 2 * 1408;
__device__ __forceinline__ MatDesc mat_of(KArgs A_, unsigned char* ws, int item, int& local) {
    MatDesc d; int r = item;
    if (r < 1536) { d = MatDesc{A_->in[3], (bf16*)(ws + WS_W_IN0), nullptr, 1024, 3080, 96, 2}; local = r; return d; } r -= 1536;
    if (r < 512) { d = MatDesc{A_->in[12], (bf16*)(ws + WS_W_OUT0), nullptr, 1024, 1024, 32, 0}; local = r; return d; } r -= 512;
    if (r < 512) { d = MatDesc{A_->in[13], (bf16*)(ws + WS_W_IN1), A_->in[1] + 1024, 1024, 800, 32, 0}; local = r; return d; } r -= 512;
    if (r < 384) { d = MatDesc{A_->in[15], (bf16*)(ws + WS_W_UQ), A_->in[14], 512, 1536, 48, 0}; local = r; return d; } r -= 384;
    if (r < 256) { d = MatDesc{A_->in[17], (bf16*)(ws + WS_W_UKV), A_->in[16], 256, 2048, 64, 3}; local = r; return d; } r -= 256;
    if (r < 512) { d = MatDesc{A_->in[20], (bf16*)(ws + WS_W_OUT1), nullptr, 1024, 1024, 32, 0}; local = r; return d; } r -= 512;
    if (r < 5632) { const int l = r / 2816; d = MatDesc{A_->in[21] + (size_t)l * 1024 * DFF2, (bf16*)(ws + WS_W_UP) + (size_t)l * DFF2 * 1024, A_->in[2] + l * 1024, 1024, DFF2, 176, 1}; local = r - l * 2816; return d; } r -= 5632;
    { const int l = r / 1408; d = MatDesc{A_->in[24] + (size_t)l * DFF * 1024, (bf16*)(ws + WS_W_DN) + (size_t)l * 1024 * DFF, nullptr, DFF, 1024, 32, 0}; local = r - l * 1408; return d; }
}

__device__ __forceinline__ void rms_rows_1024(const float* x, const float* g, bf16* o, int gw, int NGW, int lane) {
    f32x4 v[4], nx[4];
    if (gw < T_) {
#pragma unroll
        for (int j = 0; j < 4; ++j) v[j] = __builtin_nontemporal_load((const f32x4*)(x + (size_t)gw * D_) + lane + 64 * j); }
    for (int m = gw; m < T_; m += NGW) {
        const bool more = m + NGW < T_;
        if (more) {
#pragma unroll
            for (int j = 0; j < 4; ++j) nx[j] = __builtin_nontemporal_load((const f32x4*)(x + (size_t)(m + NGW) * D_) + lane + 64 * j); }
        float s = 0.f;
#pragma unroll
        for (int j = 0; j < 4; ++j) s += (v[j].x * v[j].x + v[j].y * v[j].y) + (v[j].z * v[j].z + v[j].w * v[j].w);
        const float rstd = 1.f / sqrtf(wave_sum(s) * (1.f / D_) + EPS);
        unsigned long long* o8 = (unsigned long long*)(o + (size_t)m * D_) + lane;
#pragma unroll
        for (int j = 0; j < 4; ++j) { const f32x4 gg = ((const f32x4*)g)[lane + 64 * j];
            o8[64 * j] = (unsigned long long)pk2(v[j].x * rstd * gg.x, v[j].y * rstd * gg.y) | ((unsigned long long)pk2(v[j].z * rstd * gg.z, v[j].w * rstd * gg.w) << 32); }
        if (more) {
#pragma unroll
            for (int j = 0; j < 4; ++j) v[j] = nx[j]; }
    }
}

__device__ __forceinline__ void rms_rows_dt(const float* x, const float* g, bf16* o, float* DTR, const LAS f32x4* W2, int gw, int NGW, int lane) {
    f32x4 v[4], nx[4];
    if (gw < T_) {
#pragma unroll
        for (int j = 0; j < 4; ++j) v[j] = __builtin_nontemporal_load((const f32x4*)(x + (size_t)gw * D_) + lane + 64 * j); }
    for (int m = gw; m < T_; m += NGW) {
        const bool more = m + NGW < T_;
        if (more) {
#pragma unroll
            for (int j = 0; j < 4; ++j) nx[j] = __builtin_nontemporal_load((const f32x4*)(x + (size_t)(m + NGW) * D_) + lane + 64 * j); }
        float s = 0.f; f32x4 d0 = {0.f, 0.f, 0.f, 0.f}, d1 = d0;
#pragma unroll
        for (int j = 0; j < 4; ++j) { s += (v[j].x * v[j].x + v[j].y * v[j].y) + (v[j].z * v[j].z + v[j].w * v[j].w);
#pragma unroll
            for (int e = 0; e < 4; ++e) { const int sl = j * 4 + e; const float xk = v[j][e]; d0 += W2[(sl * 2) * 64 + lane] * xk; d1 += W2[(sl * 2 + 1) * 64 + lane] * xk; } }
        const float rstd = 1.f / sqrtf(wave_sum(s) * (1.f / D_) + EPS);
#pragma unroll
        for (int e = 0; e < 4; ++e) { d0[e] = wave_sum(d0[e]); d1[e] = wave_sum(d1[e]); }
        if (lane == 0) { *(f32x4*)(DTR + (size_t)m * 8) = d0 * rstd; *(f32x4*)(DTR + (size_t)m * 8 + 4) = d1 * rstd; }
        unsigned long long* o8 = (unsigned long long*)(o + (size_t)m * D_) + lane;
#pragma unroll
        for (int j = 0; j < 4; ++j) { const f32x4 gg = ((const f32x4*)g)[lane + 64 * j];
            o8[64 * j] = (unsigned long long)pk2(v[j].x * rstd * gg.x, v[j].y * rstd * gg.y) | ((unsigned long long)pk2(v[j].z * rstd * gg.z, v[j].w * rstd * gg.w) << 32); }
        if (more) {
#pragma unroll
            for (int j = 0; j < 4; ++j) v[j] = nx[j]; }
    }
}

struct EpiF32Res {
    static constexpr bool PERM = false, AFTER_DRAIN = false;
    float* C; const float* R; int ldc;
    __device__ __forceinline__ void operator()(const pg8::f32x4 (&acc)[2][2][4][2], const pg8::Unit& u, int wr, int wc, int fr, int fq) const {
        const int row0 = u.pm * pg8::BM + wr * 64 + fr, col0 = u.pn * pg8::BM + wc * 32 + 4 * fq;
#pragma unroll
        for (int ai = 0; ai < 2; ++ai)
#pragma unroll
            for (int m = 0; m < 4; ++m) { const size_t off = (size_t)(row0 + ai * pg8::HALF + m * 16) * ldc + col0;
                f32x4 r[2][2];
#pragma unroll
                for (int bj = 0; bj < 2; ++bj)
#pragma unroll
                    for (int n = 0; n < 2; ++n) r[bj][n] = *(const f32x4*)(R + off + bj * pg8::HALF + n * 16);
#pragma unroll
                for (int bj = 0; bj < 2; ++bj)
#pragma unroll
                    for (int n = 0; n < 2; ++n) *(f32x4*)(C + off + bj * pg8::HALF + n * 16) = acc[ai][bj][m][n] + r[bj][n];
                asm volatile("" ::: "memory"); }
    }
};

template <bool RB16, bool OUTF, bool OUTB> struct EpiRes {
    static constexpr bool PERM = false, AFTER_DRAIN = false;
    float* C; const void* R; bf16* XB; unsigned long long* SSQ;
    __device__ __forceinline__ void operator()(const pg8::f32x4 (&acc)[2][2][4][2], const pg8::Unit& u, int wr, int wc, int fr, int fq) const {
        const int row0 = u.pm * pg8::BM + wr * 64 + fr, col0 = u.pn * pg8::BM + wc * 32 + 4 * fq;
#pragma unroll
        for (int ai = 0; ai < 2; ++ai)
#pragma unroll
            for (int m = 0; m < 4; ++m) { const int row = row0 + ai * pg8::HALF + m * 16; const size_t off = (size_t)row * 1024 + col0;
                f32x4 r[2][2];
#pragma unroll
                for (int bj = 0; bj < 2; ++bj)
#pragma unroll
                    for (int n = 0; n < 2; ++n) {
                        if (RB16) { const unsigned long long w = *(const unsigned long long*)((const bf16*)R + off + bj * pg8::HALF + n * 16); r[bj][n] = (f32x4){bflo((unsigned)w), bfhi((unsigned)w), bflo((unsigned)(w >> 32)), bfhi((unsigned)(w >> 32))}; }
                        else r[bj][n] = *(const f32x4*)((const float*)R + off + bj * pg8::HALF + n * 16); }
                float s = 0.f;
#pragma unroll
                for (int bj = 0; bj < 2; ++bj)
#pragma unroll
                    for (int n = 0; n < 2; ++n) { const f32x4 v = acc[ai][bj][m][n] + r[bj][n];
                        if (OUTF) *(f32x4*)(C + off + bj * pg8::HALF + n * 16) = v;
                        if (OUTB) { s += (v.x * v.x + v.y * v.y) + (v.z * v.z + v.w * v.w);
                            *(unsigned long long*)(XB + off + bj * pg8::HALF + n * 16) = (unsigned long long)pk2(v.x, v.y) | ((unsigned long long)pk2(v.z, v.w) << 32); } }
                if (OUTB) { s += __shfl_xor(s, 16); s += __shfl_xor(s, 32); if (fq == 0) atomicAdd(SSQ + row, (unsigned long long)(s * 1073741824.0f)); }
                asm volatile("" ::: "memory"); }
    }
};
typedef unsigned v2u __attribute__((ext_vector_type(2))); typedef float f32x2 __attribute__((ext_vector_type(2)));
__device__ __forceinline__ float rstd_of(const unsigned long long* SSQ, int row, float inv_n) { const v2u s = ((const v2u*)SSQ)[row]; const float c = inv_n * (1.0f / 1073741824.0f);
    return __builtin_amdgcn_rsqf(__builtin_fmaf((float)s.y, 4294967296.0f * c, __builtin_fmaf((float)s.x, c, EPS))); }
__device__ __forceinline__ f32x2 pk_add_one(f32x2 a) { asm("" : "+v"(a)); return a + 1.0f; }
template <int N> __device__ __forceinline__ float dpp_shr0(float v) { return __builtin_bit_cast(float, __builtin_amdgcn_update_dpp(0, __builtin_bit_cast(int, v), 0x110 + N, 0xf, 0xf, true)); }
template <int N> __device__ __forceinline__ float dpp_shr_old(float old, float v) { return __builtin_bit_cast(float, __builtin_amdgcn_update_dpp(__builtin_bit_cast(int, old), __builtin_bit_cast(int, v), 0x110 + N, 0xf, 0xf, false)); }
template <int N> __device__ __forceinline__ float dpp_ror(float v) { return __builtin_bit_cast(float, __builtin_amdgcn_update_dpp(0, __builtin_bit_cast(int, v), 0x120 + N, 0xf, 0xf, false)); }
struct EpiFfnUp {
    static constexpr bool PERM = true, AFTER_DRAIN = false;
    bf16* ACT; bf16* UB; const unsigned long long* SSQ; const float* cw; const float* cb;
    __device__ __forceinline__ void operator()(const pg8::f32x4 (&acc)[2][2][4][2], const pg8::Unit& u, int wr, int wc, int fr, int fq) const {
        const int ch0 = u.pn * 128 + wc * 32 + 8 * fq;
        float rs[2][4];
#pragma unroll
        for (int ai = 0; ai < 2; ++ai)
#pragma unroll
            for (int m = 0; m < 4; ++m) rs[ai][m] = rstd_of(SSQ, u.pm * pg8::BM + ai * pg8::HALF + wr * 64 + 4 * fr + m, 1.0f / 1024.0f);
        unsigned long long keep[2][4];
#pragma unroll
        for (int n = 0; n < 2; ++n) {
            __builtin_amdgcn_sched_barrier(0);
            const int ch = ch0 + 4 * n;
            const f32x4 wg0 = *(const f32x4*)(cw + ch), wg1 = *(const f32x4*)(cw + DFF2 + ch), wg2 = *(const f32x4*)(cw + 2 * DFF2 + ch), bg = *(const f32x4*)(cw + 3 * DFF2 + ch);
            const f32x4 wu0 = *(const f32x4*)(cw + DFF + ch), wu1 = *(const f32x4*)(cw + DFF2 + DFF + ch), wu2 = *(const f32x4*)(cw + 2 * DFF2 + DFF + ch), bu = *(const f32x4*)(cw + 3 * DFF2 + DFF + ch);
#pragma unroll
            for (int ai = 0; ai < 2; ++ai) {
                const int rowc = u.pm * pg8::BM + ai * pg8::HALF + wr * 64;
                f32x4 g[4], uu[4];
#pragma unroll
                for (int m = 0; m < 4; ++m) { g[m] = acc[ai][0][m][n] * rs[ai][m]; uu[m] = acc[ai][1][m][n] * rs[ai][m]; }
                f32x4 g2p, g3p, u2p, u3p;
#pragma unroll
                for (int j = 0; j < 4; ++j) { g2p[j] = dpp_shr0<1>(g[2][j]); g3p[j] = dpp_shr0<1>(g[3][j]); u2p[j] = dpp_shr0<1>(uu[2][j]); u3p[j] = dpp_shr0<1>(uu[3][j]); }
#pragma unroll
                for (int m = 0; m < 4; ++m) {
                    const f32x4 sg1 = (m == 0) ? g3p : g[m - 1], sg2 = (m == 0) ? g2p : (m == 1) ? g3p : g[m - 2];
                    const f32x4 su1 = (m == 0) ? u3p : uu[m - 1], su2 = (m == 0) ? u2p : (m == 1) ? u3p : uu[m - 2];
                    const f32x4 cg = bg + wg0 * sg2 + wg1 * sg1 + wg2 * g[m], cu = bu + wu0 * su2 + wu1 * su1 + wu2 * uu[m];
                    f32x4 r_;
                    { const f32x2 d0 = pk_add_one((f32x2){__builtin_amdgcn_exp2f(cg[0]), __builtin_amdgcn_exp2f(cg[1])}), d1 = pk_add_one((f32x2){__builtin_amdgcn_exp2f(cg[2]), __builtin_amdgcn_exp2f(cg[3])});
                      r_[0] = __builtin_amdgcn_rcpf(d0.x); r_[1] = __builtin_amdgcn_rcpf(d0.y); r_[2] = __builtin_amdgcn_rcpf(d1.x); r_[3] = __builtin_amdgcn_rcpf(d1.y); }
                    const f32x4 a = cg * r_ * cu;
                    const int row = rowc + 4 * fr + m;
                    const unsigned long long pk_ = (unsigned long long)pk2(a[0], a[1]) | ((unsigned long long)pk2(a[2], a[3]) << 32);
                    if (n == 0) { keep[ai][m] = pk_; asm volatile("" : "+v"(keep[ai][m])); }
                    else if (!(fr == 0 && m < 2)) { v4u w; w.x = (unsigned)keep[ai][m]; w.y = (unsigned)(keep[ai][m] >> 32); w.z = (unsigned)pk_; w.w = (unsigned)(pk_ >> 32); *(v4u*)(ACT + (size_t)row * DFF + ch0) = w; }
                    if ((fr == 0 && m < 2) || (fr == 15 && m >= 2)) { const int slot = m; bf16* ub = UB + ((size_t)(rowc >> 6) * 4 + slot) * DFF2 + ch;
                        *(unsigned long long*)ub = (unsigned long long)pk2(g[m][0], g[m][1]) | ((unsigned long long)pk2(g[m][2], g[m][3]) << 32);
                        *(unsigned long long*)(ub + DFF) = (unsigned long long)pk2(uu[m][0], uu[m][1]) | ((unsigned long long)pk2(uu[m][2], uu[m][3]) << 32); }
                }
            }
        }
    }
};


struct EpiScale {
    static constexpr bool PERM = true, AFTER_DRAIN = false;
    bf16* O; int ldc; const unsigned long long* SSQ; float inv_n;
    __device__ __forceinline__ void operator()(const pg8::f32x4 (&acc)[2][2][4][2], const pg8::Unit& u, int wr, int wc, int fr, int fq) const {
        const int row0 = u.pm * pg8::BM + wr * 64 + fr, col0 = u.pn * pg8::BM + wc * 32 + 8 * fq;
#pragma unroll
        for (int ai = 0; ai < 2; ++ai)
#pragma unroll
            for (int m = 0; m < 4; ++m) { const int row = row0 + ai * pg8::HALF + m * 16; const float rs = rstd_of(SSQ, row, inv_n); bf16* rowp = O + (size_t)row * ldc + col0;
#pragma unroll
                for (int bj = 0; bj < 2; ++bj) { const f32x4 v0 = acc[ai][bj][m][0] * rs, v1 = acc[ai][bj][m][1] * rs;
                    v4u w; w.x = pk2(v0[0], v0[1]); w.y = pk2(v0[2], v0[3]); w.z = pk2(v1[0], v1[1]); w.w = pk2(v1[2], v1[3]); *(v4u*)(rowp + bj * pg8::HALF) = w; } }
    }
};
struct EpiMlaIn {
    static constexpr bool PERM = true, AFTER_DRAIN = false;
    bf16* O; const unsigned long long* SSQ; unsigned long long* SSQ_Q; unsigned long long* SSQ_KV; float* SSQPE; float* RG; const float* kg; const float* TAB;
    __device__ __forceinline__ void operator()(const pg8::f32x4 (&acc)[2][2][4][2], const pg8::Unit& u, int wr, int wc, int fr, int fq) const {
        const int row0 = u.pm * pg8::BM + wr * 64 + fr, col0 = u.pn * pg8::BM + wc * 32 + 8 * fq;
        unsigned long long* tgt = (u.pn < 2) ? SSQ_Q : SSQ_KV;
        float rsv[8];
#pragma unroll
        for (int i = 0; i < 8; ++i) rsv[i] = rstd_of(SSQ, row0 + (i >> 2) * pg8::HALF + (i & 3) * 16, 1.0f / 1024.0f);
        if (u.pn < 3) {
#pragma unroll
        for (int ai = 0; ai < 2; ++ai)
#pragma unroll
            for (int m = 0; m < 4; ++m) { const int row = row0 + ai * pg8::HALF + m * 16; const float rs = rsv[ai * 4 + m]; bf16* rowp = O + (size_t)row * 1024 + col0; float s = 0.f;
#pragma unroll
                for (int bj = 0; bj < 2; ++bj) { const f32x4 v0 = acc[ai][bj][m][0] * rs, v1 = acc[ai][bj][m][1] * rs;
                    s += (v0[0] * v0[0] + v0[1] * v0[1]) + (v0[2] * v0[2] + v0[3] * v0[3]) + (v1[0] * v1[0] + v1[1] * v1[1]) + (v1[2] * v1[2] + v1[3] * v1[3]);
                    v4u w; w.x = pk2(v0[0], v0[1]); w.y = pk2(v0[2], v0[3]); w.z = pk2(v1[0], v1[1]); w.w = pk2(v1[2], v1[3]); *(v4u*)(rowp + bj * pg8::HALF) = w; }
                s += __shfl_xor(s, 16); s += __shfl_xor(s, 32); if (fq == 0) atomicAdd(tgt + row, (unsigned long long)(s * 1073741824.0f)); asm volatile("" ::: "memory"); }
        } else if (wc == 0) {
            const f32x4 g0 = *(const f32x4*)(kg + 64 + 8 * fq), g1 = *(const f32x4*)(kg + 64 + 8 * fq + 4);
            f32x4 tn[4]; { const float* tb = TAB + ((row0 & 2047) * 16 + 8 * (fq & 1)) * 2; tn[0] = *(const f32x4*)tb; tn[1] = *(const f32x4*)(tb + 4); tn[2] = *(const f32x4*)(tb + 8); tn[3] = *(const f32x4*)(tb + 12); }
#pragma unroll
            for (int ai = 0; ai < 2; ++ai)
#pragma unroll
                for (int m = 0; m < 4; ++m) { const int row = row0 + ai * pg8::HALF + m * 16; const float rs = rsv[ai * 4 + m];
                    const f32x4 ta = tn[0], tb4 = tn[1], tc = tn[2], td = tn[3];
                    if (ai * 4 + m < 7) { const int i1 = ai * 4 + m + 1; const float* tb = TAB + (((row0 + (i1 >> 2) * pg8::HALF + (i1 & 3) * 16) & 2047) * 16 + 8 * (fq & 1)) * 2; tn[0] = *(const f32x4*)tb; tn[1] = *(const f32x4*)(tb + 4); tn[2] = *(const f32x4*)(tb + 8); tn[3] = *(const f32x4*)(tb + 12); }
                    const f32x4 v0 = acc[ai][0][m][0] * rs, v1 = acc[ai][0][m][1] * rs;
                    float s = (v0[0] * v0[0] + v0[1] * v0[1]) + (v0[2] * v0[2] + v0[3] * v0[3]) + (v1[0] * v1[0] + v1[1] * v1[1]) + (v1[2] * v1[2] + v1[3] * v1[3]);
                    s += __shfl_xor(s, 16); s += __shfl_xor(s, 32); if (fq == 0) SSQPE[row] = s;
                    const f32x4 y0 = v0 * g0, y1 = v1 * g1;
                    f32x4 p0, p1;
#pragma unroll
                    for (int j = 0; j < 4; ++j) { p0[j] = __shfl_xor(y0[j], 32); p1[j] = __shfl_xor(y1[j], 32); }
                    const f32x4 c0 = {ta[0], ta[2], tb4[0], tb4[2]}, s0 = {ta[1], ta[3], tb4[1], tb4[3]}, c1 = {tc[0], tc[2], td[0], td[2]}, s1 = {tc[1], tc[3], td[1], td[3]};
                    f32x4 o0, o1;
                    if (fq < 2) { o0 = y0 * c0 - p0 * s0; o1 = y1 * c1 - p1 * s1; } else { o0 = p0 * s0 + y0 * c0; o1 = p1 * s1 + y1 * c1; }
                    float* rg = RG + (size_t)row * 32 + 8 * fq; *(f32x4*)rg = o0; *(f32x4*)(rg + 4) = o1; asm volatile("" ::: "memory"); }
        }
    }
};
struct EpiUkv {
    static constexpr bool PERM = true, AFTER_DRAIN = false;
    bf16* K2; bf16* V2; const unsigned long long* SSQ; const float* SSQPE; const float* RG; const float* kg;
    __device__ __forceinline__ void operator()(const pg8::f32x4 (&acc)[2][2][4][2], const pg8::Unit& u, int wr, int wc, int fr, int fq) const {
        const int row0 = u.pm * pg8::BM + wr * 64 + fr;
        if (u.pn < 4) {
            const int head = 4 * u.pn + wc;
            f32x4 g1[2], g2[2];
#pragma unroll
            for (int n = 0; n < 2; ++n) { g1[n] = *(const f32x4*)(kg + 8 * fq + 4 * n); g2[n] = *(const f32x4*)(kg + 32 + 8 * fq + 4 * n); }
            float rsv[8], pev[8];
#pragma unroll
            for (int i = 0; i < 8; ++i) { const int row = row0 + (i >> 2) * pg8::HALF + (i & 3) * 16; rsv[i] = rstd_of(SSQ, row, 1.0f / 256.0f); pev[i] = SSQPE[row]; }
            f32x4 rgn0, rgn1; { const float* rg = RG + (size_t)row0 * 32 + 8 * fq; rgn0 = *(const f32x4*)rg; rgn1 = *(const f32x4*)(rg + 4); }
#pragma unroll
            for (int i = 0; i < 8; ++i) { const int row = row0 + (i >> 2) * pg8::HALF + (i & 3) * 16; const float rs = rsv[i];
                    const f32x4 rgc0 = rgn0, rgc1 = rgn1;
                    if (i < 7) { const float* rg = RG + (size_t)(row0 + ((i + 1) >> 2) * pg8::HALF + ((i + 1) & 3) * 16) * 32 + 8 * fq; rgn0 = *(const f32x4*)rg; rgn1 = *(const f32x4*)(rg + 4); }
                    const int ai = i >> 2, m = i & 3;
                    f32x4 a[2], b[2]; float s = 0.f;
#pragma unroll
                    for (int n = 0; n < 2; ++n) { a[n] = acc[ai][0][m][n] * rs; b[n] = acc[ai][1][m][n] * rs; s += (a[n][0] * a[n][0] + a[n][1] * a[n][1]) + (a[n][2] * a[n][2] + a[n][3] * a[n][3]) + (b[n][0] * b[n][0] + b[n][1] * b[n][1]) + (b[n][2] * b[n][2] + b[n][3] * b[n][3]); }
                    s += __shfl_xor(s, 16); s += __shfl_xor(s, 32);
                    const float rh = __builtin_amdgcn_rsqf((s + pev[i]) * (1.f / 96.f) + EPS);
                    const int pos = row & 2047; bf16* rp = K2 + ((((size_t)(row >> 11) * 16 + head) * 32 + (pos >> 6)) * 12 + fq) * 512 + (pos & 63) * 8;
                    { const f32x4 o0 = a[0] * rh * g1[0], o1 = a[1] * rh * g1[1]; v4u w; w.x = pk2(o0[0], o0[1]); w.y = pk2(o0[2], o0[3]); w.z = pk2(o1[0], o1[1]); w.w = pk2(o1[2], o1[3]); *(v4u*)rp = w; }
                    { const f32x4 o0 = b[0] * rh * g2[0], o1 = b[1] * rh * g2[1]; v4u w; w.x = pk2(o0[0], o0[1]); w.y = pk2(o0[2], o0[3]); w.z = pk2(o1[0], o1[1]); w.w = pk2(o1[2], o1[3]); *(v4u*)(rp + 4 * 512) = w; }
                    { const f32x4 o0 = rgc0 * rh, o1 = rgc1 * rh; v4u w; w.x = pk2(o0[0], o0[1]); w.y = pk2(o0[2], o0[3]); w.z = pk2(o1[0], o1[1]); w.w = pk2(o1[2], o1[3]); *(v4u*)(rp + 8 * 512) = w; }
                    asm volatile("" ::: "memory"); }
        } else {
            bf16* dst = V2 + (u.pn - 4) * 256 + wc * 32 + 8 * fq;
#pragma unroll
            for (int ai = 0; ai < 2; ++ai)
#pragma unroll
                for (int m = 0; m < 4; ++m) { const int row = row0 + ai * pg8::HALF + m * 16; const float rs = rstd_of(SSQ, row, 1.0f / 256.0f); bf16* rp = dst + (size_t)row * 1024;
#pragma unroll
                    for (int bj = 0; bj < 2; ++bj) { const f32x4 v0 = acc[ai][bj][m][0] * rs, v1 = acc[ai][bj][m][1] * rs;
                        v4u w; w.x = pk2(v0[0], v0[1]); w.y = pk2(v0[2], v0[3]); w.z = pk2(v1[0], v1[1]); w.w = pk2(v1[2], v1[3]); *(v4u*)(rp + bj * pg8::HALF) = w; } }
        }
    }
};

struct EpiIn0 {
    static constexpr bool PERM = true, AFTER_DRAIN = false;
    bf16* QK; bf16* KC; const float* TAB; const float* qn; const float* kn; float* KM; float* DTR;
    __device__ __forceinline__ void operator()(const pg8::f32x4 (&acc)[2][2][4][2], const pg8::Unit& u, int wr, int wc, int fr, int fq) const {
        const int row0 = u.pm * pg8::BM + wr * 64 + fr;
        if (u.pn < 4) {
            const bool isq = u.pn < 2; const float* gn = isq ? qn : kn; const int head = 4 * (u.pn & 1) + wc;
            bf16* dst = QK + (isq ? 0 : 512) + head * 64 + 8 * fq;
            f32x4 g1[2], g2[2], ks1[2], ks2[2];
#pragma unroll
            for (int n = 0; n < 2; ++n) { g1[n] = *(const f32x4*)(gn + 8 * fq + 4 * n); g2[n] = *(const f32x4*)(gn + 32 + 8 * fq + 4 * n); ks1[n] = (f32x4){0.f, 0.f, 0.f, 0.f}; ks2[n] = ks1[n]; }
#pragma unroll
            for (int ai = 0; ai < 2; ++ai)
#pragma unroll
                for (int m = 0; m < 4; ++m) { const int row = row0 + ai * pg8::HALF + m * 16, pos = row & 2047;
                    float s = 0.f;
#pragma unroll
                    for (int n = 0; n < 2; ++n) { const f32x4 a = acc[ai][0][m][n], b = acc[ai][1][m][n]; s += (a[0] * a[0] + a[1] * a[1]) + (a[2] * a[2] + a[3] * a[3]) + (b[0] * b[0] + b[1] * b[1]) + (b[2] * b[2] + b[3] * b[3]); }
                    s += __shfl_xor(s, 16); s += __shfl_xor(s, 32);
                    float rstd = 1.f / sqrtf(s * (1.f / 64.f) + EPS); if (isq) rstd *= 0.18033688011112042f;
                    f32x4 o1[2], o2[2];
#pragma unroll
                    for (int n = 0; n < 2; ++n) { const float* tb = TAB + (pos * 32 + 8 * fq + 4 * n) * 2; const f32x4 t0 = *(const f32x4*)tb, t1 = *(const f32x4*)(tb + 4);
                        const f32x4 cs_ = {t0[0], t0[2], t1[0], t1[2]}, sn = {t0[1], t0[3], t1[1], t1[3]};
                        const f32x4 y1 = acc[ai][0][m][n] * rstd * g1[n], y2 = acc[ai][1][m][n] * rstd * g2[n];
                        o1[n] = y1 * cs_ - y2 * sn; o2[n] = y1 * sn + y2 * cs_; ks1[n] += o1[n]; ks2[n] += o2[n]; }
                    bf16* rp = dst + (size_t)row * 1024; int st2 = 32;
                    if (!isq) { rp = KC + ((((size_t)(row >> 11) * 8 + head) * 32 + (pos >> 6)) * 8 + fq) * 512 + (pos & 63) * 8; st2 = 4 * 512; }
                    { v4u w; w.x = pk2(o1[0][0], o1[0][1]); w.y = pk2(o1[0][2], o1[0][3]); w.z = pk2(o1[1][0], o1[1][1]); w.w = pk2(o1[1][2], o1[1][3]); *(v4u*)rp = w; }
                    { v4u w; w.x = pk2(o2[0][0], o2[0][1]); w.y = pk2(o2[0][2], o2[0][3]); w.z = pk2(o2[1][0], o2[1][1]); w.w = pk2(o2[1][2], o2[1][3]); *(v4u*)(rp + st2) = w; }
                    asm volatile("" ::: "memory"); }
            if (!isq) {
                float* km = KM + (((size_t)(u.pm >> 3) * 8 + (u.pm & 7)) * 8 + head) * 64 + 8 * fq;
#pragma unroll
                for (int n = 0; n < 2; ++n)
#pragma unroll
                    for (int j = 0; j < 4; ++j) { float a = ks1[n][j], b = ks2[n][j];
#pragma unroll
                        for (int o = 1; o < 16; o <<= 1) { a += __shfl_xor(a, o); b += __shfl_xor(b, o); }
                        if (fr == 0) { atomicAdd(km + 4 * n + j, a * (1.f / 256.f)); atomicAdd(km + 32 + 4 * n + j, b * (1.f / 256.f)); } } }
        } else if (u.pn < 12) {
            bf16* dst = QK + (size_t)(u.pn >> 2) * ((size_t)T_ * 1024) + (u.pn & 3) * 256 + wc * 32 + 8 * fq;
#pragma unroll
            for (int ai = 0; ai < 2; ++ai)
#pragma unroll
                for (int m = 0; m < 4; ++m) { bf16* rp = dst + (size_t)(row0 + ai * pg8::HALF + m * 16) * 1024;
#pragma unroll
                    for (int bj = 0; bj < 2; ++bj) { const f32x4 v0 = acc[ai][bj][m][0], v1 = acc[ai][bj][m][1];
                        v4u w; w.x = pk2(v0[0], v0[1]); w.y = pk2(v0[2], v0[3]); w.z = pk2(v1[0], v1[1]); w.w = pk2(v1[2], v1[3]); *(v4u*)(rp + bj * pg8::HALF) = w; } }
        } else if (wc == 0 && fq == 0) {
#pragma unroll
            for (int ai = 0; ai < 2; ++ai)
#pragma unroll
                for (int m = 0; m < 4; ++m) { float* rp = DTR + (size_t)(row0 + ai * pg8::HALF + m * 16) * 8; *(f32x4*)rp = acc[ai][0][m][0]; *(f32x4*)(rp + 4) = acc[ai][0][m][1]; }
        }
    }
};

template <class Epi, int AROW = 0> __device__ __forceinline__ void run_gemm(LAS unsigned char* lds, const bf16* A, const bf16* Bt, int M, int N, int K, const Epi& E, int lda = 0) {
    pg8::Gemm g{A, Bt, M, N, K, lda ? lda : K}; pg8::StaticOrder S; S.init(M, N, (int)gridDim.x, (int)blockIdx.x);
    pg8::gemm_phase<Epi, pg8::StaticOrder, PG8_ALIGN, PG8_SP2, AROW>(lds + RING_OFF, g, S, E);
}

#define NPHASES 40
__global__ void __launch_bounds__(NTHR, 2) fwd(Args args) {
    extern __shared__ __attribute__((aligned(16))) unsigned char lds_raw[];
    LAS unsigned char* lds = (LAS unsigned char*)lds_raw;
    volatile LAS unsigned* MISC = (volatile LAS unsigned*)(lds + MISC_OFF);
    {
        const int tid0 = threadIdx.x;
        for (int u = tid0; u < (LDS_BYTES - LDSCTL_OFF) / 4; u += NTHR) ((LAS unsigned*)(lds + LDSCTL_OFF))[u] = 0u;
    }
    __syncthreads();
    int lo, hi; { KArgs A0 = kargs(); lo = A0->ph_lo; hi = A0->ph_hi; }
    const bool multi = (hi - lo) > 1;
    XcdBarrier bar; bar.bar = nullptr; bar.x = 0; bar.st = nullptr;
    if (multi) { KArgs A0 = kargs(); bar = xcd_barrier_post((unsigned*)((gu32*)(A0->ws + WS_CTL) + CW_BAR), MISC + 8); }
#define IN(k) (lo <= (k) && (k) < hi)
#ifndef PROBE_MASK
#define PROBE_MASK 0u
#endif
    unsigned long long pr_acc = 0ull, pr_t = 0ull;
    if (PROBE_MASK) pr_t = __builtin_amdgcn_s_memrealtime();
#define SEAM(k) do { if (IN(k) && IN((k) + 1)) xcd_barrier(bar); \
        if (PROBE_MASK) { const unsigned long long now_ = __builtin_amdgcn_s_memrealtime(); if ((PROBE_MASK >> (k)) & 1u) pr_acc += now_ - pr_t; pr_t = now_; } } while (0)

    if (IN(0)) { PH_VARS
        LAS float* scr = (LAS float*)(lds + RING_OFF + wave * 16384);
        { f32x4 cur[8], nxt[8]; int it = gw, li = 0, ln = 0; MatDesc d{}, dn{};
          if (it < NIT_W) { d = mat_of(A_, ws, it, li); trl_load(cur, d, li, lane); }
          while (it < NIT_W) { const int nit = it + NGW; const bool more = nit < NIT_W;
              if (more) { dn = mat_of(A_, ws, nit, ln); trl_load(nxt, dn, ln, lane); }
              tr_store(cur, d.K, d.WT, scr, li, d.nblk, lane);
              if (more) {
#pragma unroll
                  for (int i = 0; i < 8; ++i) cur[i] = nxt[i];
                  d = dn; li = ln; }
              it = nit; } }
        { float* cws = (float*)(ws + WS_CWS); const float* cw_ = A_->in[22]; const float* cb_ = A_->in[23];
          for (int i = gt; i < 2 * 4 * DFF2; i += NGT) { const int l = i / (4 * DFF2), r = i - l * 4 * DFF2, k = r / DFF2, c = r - k * DFF2;
              const float v = (k < 3) ? cw_[((size_t)l * 3 + k) * DFF2 + c] : cb_[(size_t)l * DFF2 + c]; cws[i] = v * (c < DFF ? -1.44269504088896341f : -0.693147180559945309f); } }
        float* t64 = (float*)(ws + WS_TAB64); float* t32 = (float*)(ws + WS_TAB32);
        for (int i = gt; i < 2048 * 32; i += NGT) { const int pos = i >> 5, f = i & 31; const float inv = 1.0f / powf(10000.0f, (float)(2 * f) / 64.0f); const float ang = (float)pos * inv; t64[2 * i] = cosf(ang); t64[2 * i + 1] = sinf(ang); }
        for (int i = gt; i < 2048 * 16; i += NGT) { const int pos = i >> 4, f = i & 15; const float inv = 1.0f / powf(10000.0f, (float)(2 * f) / 32.0f); const float ang = (float)pos * inv; t32[2 * i] = cosf(ang); t32[2 * i + 1] = sinf(ang); }
        asm volatile("s_waitcnt vmcnt(0) lgkmcnt(0)" ::: "memory"); __syncthreads();
        { LAS f32x4* W2 = (LAS f32x4*)(lds + RING_OFF); const float* Wi = A_->in[3]; const float* gg = A_->in[1];
          for (int i = tid; i < 2048; i += NTHR) { const int ln = i & 63, sh = i >> 6, sl = sh >> 1, half = sh & 1, k = 4 * ln + 256 * (sl >> 2) + (sl & 3);
              W2[i] = *(const f32x4*)(Wi + (size_t)k * 3080 + 3072 + 4 * half) * gg[k]; }
          asm volatile("s_waitcnt vmcnt(0) lgkmcnt(0)" ::: "memory"); __syncthreads();
          rms_rows_dt(x, A_->in[1], XN, (float*)(ws + WS_DTR), W2, gw, NGW, lane); }
    }
    SEAM(0);
    if (IN(1)) { PH_VARS EpiIn0 E{(bf16*)(ws + L0_QK), (bf16*)(ws + L0_KC), TAB64, A_->in[10], A_->in[11], (float*)(ws + WS_KMEAN), (float*)(ws + WS_DTR)}; run_gemm(lds, XN, (const bf16*)(ws + WS_W_IN0), T_, 3072, 1024, E); }
    SEAM(1);
    if (IN(2)) { PH_VARS
        for (int u = blockIdx.x; u < 512; u += G) ssd::states_unit(lds, u >> 1, u & 1, (const bf16*)(ws + L0_XBC), (const float*)(ws + WS_DTR), A_->in[4], A_->in[5], A_->in[6], A_->in[7], (float*)(ws + L0_ST), (float*)(ws + WS_CEND));
    }
    SEAM(2);
    if (IN(3)) { PH_VARS
        const float* ST = (const float*)(ws + L0_ST); const float* CEND = (const float*)(ws + WS_CEND); bf16* HIN = (bf16*)(ws + L0_HIN);
        for (int i = gt; i < 16 * 8 * 64 * 128 / 4; i += NGT) {
            const int pn = (i & 2047) * 4, h = (i >> 11) & 7, b = i >> 14; f32x4 hst = {0.f, 0.f, 0.f, 0.f}; f32x4 tmp[16]; float dec[16];
#pragma unroll
            for (int c = 0; c < 16; ++c) { tmp[c] = *(const f32x4*)(ST + (((size_t)((b * 16 + c) * 8 + h) << 13) + pn)); dec[c] = CEND[(b * 16 + c) * 8 + h]; }
#pragma unroll
            for (int c = 0; c < 16; ++c) { const size_t idx = ((size_t)((b * 16 + c) * 8 + h) << 13) + pn;
                *(unsigned long long*)(HIN + idx) = (unsigned long long)pk2(hst.x, hst.y) | ((unsigned long long)pk2(hst.z, hst.w) << 32);
                hst = hst * __expf(dec[c]) + tmp[c]; }
        }
        const bf16* QK = (const bf16*)(ws + L0_QK); const bf16* VZ = (const bf16*)(ws + L0_VZ); const float* KM = (const float*)(ws + WS_KMEAN); bf16* MIX = (bf16*)(ws + L0_MIX);
        asm volatile("s_waitcnt vmcnt(0) lgkmcnt(0)" ::: "memory"); __syncthreads();
        float kb0; { float gm = fabsf(A_->in[11][lane]);
#pragma unroll
          for (int o_ = 1; o_ < 64; o_ <<= 1) gm = fmaxf(gm, __shfl_xor(gm, o_));
          kb0 = 8.0f * 1.02f * gm; }
        { int tb = 0, pbh = -1;
          for (int i = blockIdx.x; i < 1024; i += G) {
            const int s_ = i >> 8, c = i & 255, bh = c >> 1, half = c & 1, qb = (s_ & 1) ? (s_ - 1 + half) : (7 - half - s_), b = bh >> 3, h = bh & 7;
            const int in_ = i + G; const bool hn = (in_ < 1024) && (((in_ & 255) >> 1) == bh);
            at2::Tensors TT{QK + h * 64, (const bf16*)(ws + L0_KC) + (size_t)(b * 8 + h) * (32 * 8 * 512), VZ + h * 64, MIX + h * 64, 1024, 0, 1024, 1024};
            at2::attn_unit_p<64, true, false, 2>(lds, TT, (long)b * 2048, qb, KM + b * 4096 + h * 64, nullptr, nullptr, kb0, tb, pbh == bh, hn);
            tb = (tb + 4 * (qb + 1)) % 6; pbh = hn ? bh : -1; } }
    }
    SEAM(3);
    if (IN(4)) { PH_VARS
        for (int u = blockIdx.x; u < 512; u += G) ssd::out_unit(lds, u >> 1, u & 1, (const bf16*)(ws + L0_XBC), (const bf16*)(ws + L0_VZ), (const float*)(ws + WS_DTR), A_->in[4], A_->in[5], A_->in[6], A_->in[7],
                                                               (const bf16*)(ws + L0_HIN), A_->in[8], A_->in[9], (bf16*)(ws + L0_MIX));
    }
    SEAM(4);
    if (IN(5)) { PH_VARS EpiRes<false, false, true> E{nullptr, x, XN, (unsigned long long*)(ws + WS_SSQA)}; run_gemm(lds, (const bf16*)(ws + L0_MIX), (const bf16*)(ws + WS_W_OUT0), T_, 1024, 1024, E); }
    SEAM(5);
#define FFN_PHASES(P, L, AIN, SSQ_IN, LASTL, SSQ_OUT) \
    if (IN(P)) { PH_VARS EpiFfnUp E{(bf16*)(ws + FF_ACT), (bf16*)(ws + FF_UB), (const unsigned long long*)(ws + (SSQ_IN)), (const float*)(ws + WS_CWS) + (size_t)(L) * 4 * DFF2, nullptr}; \
        run_gemm<EpiFfnUp, 1>(lds, (const bf16*)(ws + (AIN)), (const bf16*)(ws + WS_W_UP) + (size_t)(L) * DFF2 * 1024, T_, DFF2, 1024, E); } \
    SEAM(P); \
    if (IN((P) + 1)) { PH_VARS \
        const bf16* UB = (const bf16*)(ws + FF_UB); bf16* ACT = (bf16*)(ws + FF_ACT); const float* cw = A_->in[22] + (size_t)(L) * 3 * DFF2; const float* cb = A_->in[23] + (size_t)(L) * DFF2; \
        for (int i = gt; i < 512 * 2 * (DFF / 8); i += NGT) {          \
            const int c0 = (i % (DFF / 8)) * 8, rr = (i / (DFF / 8)) & 1, ck = i / (2 * (DFF / 8)); const bool first = (ck & 31) == 0;     \
            float ag[8], au[8]; \
            _Pragma("unroll") for (int j = 0; j < 8; ++j) { ag[j] = cb[c0 + j]; au[j] = cb[DFF + c0 + j]; } \
            _Pragma("unroll") for (int k = 0; k < 3; ++k) { const int rel = rr - 2 + k;     \
                if (rel >= 0 || !first) { const bf16* src = (rel >= 0) ? UB + ((size_t)ck * 4 + rel) * DFF2 : UB + ((size_t)(ck - 1) * 4 + 4 + rel) * DFF2; \
                    const v4u wg = *(const v4u*)(src + c0); const v4u wu = *(const v4u*)(src + DFF + c0); const float* kg = cw + k * DFF2 + c0; const float* ku = kg + DFF; \
                    ag[0] += kg[0] * bflo(wg.x); ag[1] += kg[1] * bfhi(wg.x); ag[2] += kg[2] * bflo(wg.y); ag[3] += kg[3] * bfhi(wg.y); ag[4] += kg[4] * bflo(wg.z); ag[5] += kg[5] * bfhi(wg.z); ag[6] += kg[6] * bflo(wg.w); ag[7] += kg[7] * bfhi(wg.w); \
                    au[0] += ku[0] * bflo(wu.x); au[1] += ku[1] * bfhi(wu.x); au[2] += ku[2] * bflo(wu.y); au[3] += ku[3] * bfhi(wu.y); au[4] += ku[4] * bflo(wu.z); au[5] += ku[5] * bfhi(wu.z); au[6] += ku[6] * bflo(wu.w); au[7] += ku[7] * bfhi(wu.w); } } \
            v4u o; o.x = pk2(silu_f(ag[0]) * au[0], silu_f(ag[1]) * au[1]); o.y = pk2(silu_f(ag[2]) * au[2], silu_f(ag[3]) * au[3]); o.z = pk2(silu_f(ag[4]) * au[4], silu_f(ag[5]) * au[5]); o.w = pk2(silu_f(ag[6]) * au[6], silu_f(ag[7]) * au[7]); \
            *(v4u*)(ACT + ((size_t)ck * 64 + rr) * DFF + c0) = o; } } \
    SEAM((P) + 1); \
    if (IN((P) + 2)) { PH_VARS EpiRes<true, LASTL, !LASTL> E{out, (const bf16*)(ws + (AIN)), (bf16*)(ws + (AIN)), (unsigned long long*)(ws + (SSQ_OUT))}; run_gemm(lds, (const bf16*)(ws + FF_ACT), (const bf16*)(ws + WS_W_DN) + (size_t)(L) * 1024 * DFF, T_, 1024, DFF, E); } \
    SEAM((P) + 2);
    FFN_PHASES(6, 0, WS_XN, WS_SSQA, false, WS_SSQB)
    if (IN(9)) { PH_VARS EpiMlaIn E{(bf16*)(ws + L1_C1), (const unsigned long long*)(ws + WS_SSQB), (unsigned long long*)(ws + WS_SSQQ), (unsigned long long*)(ws + WS_SSQKV), (float*)(ws + WS_SSQPE), (float*)(ws + WS_RG), A_->in[19], TAB32}; run_gemm(lds, XN, (const bf16*)(ws + WS_W_IN1), T_, 1024, 1024, E); }
    SEAM(9);
    if (IN(10)) { PH_VARS const bf16* C1 = (const bf16*)(ws + L1_C1);
        { EpiScale E{(bf16*)(ws + L1_QR), 1536, (const unsigned long long*)(ws + WS_SSQQ), 1.0f / 512.0f}; run_gemm(lds, C1, (const bf16*)(ws + WS_W_UQ), T_, 1536, 512, E, 1024); }
        { EpiUkv E{(bf16*)(ws + L1_K2), (bf16*)(ws + L1_V2), (const unsigned long long*)(ws + WS_SSQKV), (const float*)(ws + WS_SSQPE), (const float*)(ws + WS_RG), A_->in[19]}; run_gemm(lds, C1 + 512, (const bf16*)(ws + WS_W_UKV), T_, 2048, 256, E, 1024); } }
    SEAM(10);
    if (IN(11)) { PH_VARS
        const bf16* Q2 = (const bf16*)(ws + L1_QR); const bf16* K2 = (const bf16*)(ws + L1_K2); const bf16* V2 = (const bf16*)(ws + L1_V2); bf16* O = (bf16*)(ws + L1_O);
        float kb1; { float gm = fmaxf(fabsf(A_->in[19][lane]), (lane < 32) ? fabsf(A_->in[19][64 + lane]) : 0.f);
#pragma unroll
          for (int o_ = 1; o_ < 64; o_ <<= 1) gm = fmaxf(gm, __shfl_xor(gm, o_));
          kb1 = 9.797958971f * 1.02f * gm; }
        { int tb = 0, pbh = -1;
          for (int i = blockIdx.x; i < 2048; i += G) {
            const int s_ = i >> 8, bh = i & 255, qb = 7 - s_, b = bh >> 4, h = bh & 15;
            const int in_ = i + G; const bool hn = (in_ < 2048) && ((in_ & 255) == bh);
            at2::Tensors TT{Q2 + h * 96, K2 + (size_t)(b * 16 + h) * (32 * 12 * 512), V2 + h * 64, O + h * 64, 1536, 0, 1024, 1024};
            at2::attn_unit_p<96, false, true, 2>(lds, TT, (long)b * 2048, qb, nullptr, A_->in[18], TAB32, kb1, tb, pbh == bh, hn);
            tb = (tb + 4 * (qb + 1)) % 6; pbh = hn ? bh : -1; } }
    }
    SEAM(11);
    if (IN(12)) { PH_VARS EpiRes<true, false, true> E{nullptr, XN, (bf16*)(ws + WS_BIG), (unsigned long long*)(ws + WS_SSQC)}; run_gemm(lds, (const bf16*)(ws + L1_O), (const bf16*)(ws + WS_W_OUT1), T_, 1024, 1024, E); }
    SEAM(12);
    FFN_PHASES(13, 1, WS_BIG, WS_SSQC, true, WS_SSQB)
    if (PROBE_MASK) { if (blockIdx.x == 0 && threadIdx.x == 0) { const unsigned long long t0 = __builtin_amdgcn_s_memrealtime(); while (__builtin_amdgcn_s_memrealtime() - t0 < pr_acc) __builtin_amdgcn_s_sleep(8); } }
#undef IN
#undef SEAM
}
constexpr int LAST_PHASE = 16;

#ifndef MK_ONE_LAUNCH
#define MK_ONE_LAUNCH 1
#endif
extern "C" void kernel_launch(void* const* d_in, const int* in_sizes, int n_in, void* d_out, int out_size, void* d_ws, size_t ws_size, hipStream_t stream) {
    static int grid = 0;
    if (grid == 0) {
        if (n_in != 25 || out_size != T_ * D_ || ws_size < WS_END) { fprintf(stderr, "kernel_launch: unexpected shapes: n_in %d out %d ws %zu\n", n_in, out_size, ws_size); grid = -1; return; }
        if (hipFuncSetAttribute((const void*)fwd, hipFuncAttributeMaxDynamicSharedMemorySize, LDS_BYTES) != hipSuccess) { fprintf(stderr, "kernel_launch: hipFuncSetAttribute failed\n"); grid = -1; return; }
        int dev = 0, cus = 0, per_cu = 0;
        hipGetDevice(&dev); hipDeviceGetAttribute(&cus, hipDeviceAttributeMultiprocessorCount, dev);
        hipOccupancyMaxActiveBlocksPerMultiprocessor(&per_cu, (const void*)fwd, NTHR, LDS_BYTES);
        (void)hipGetLastError();
        grid = (per_cu >= 1) ? cus : -1;
        if (grid < 0) { fprintf(stderr, "kernel_launch: occupancy query says 0 blocks per CU\n"); return; }
    }
    if (grid < 0) return;
    hipMemsetAsync((char*)d_ws + WS_CTL, 0, CTL_ZERO_BYTES, stream);
    Args a{};
    for (int i = 0; i < 25; ++i) a.in[i] = (const float*)d_in[i];
    a.out = (float*)d_out; a.ws = (unsigned char*)d_ws;
#if MK_ONE_LAUNCH
    a.ph_lo = 0; a.ph_hi = LAST_PHASE;
    hipLaunchKernelGGL(fwd, dim3(grid), dim3(NTHR), LDS_BYTES, stream, a);
#else
    for (int p = 0; p < LAST_PHASE; ++p) { a.ph_lo = p; a.ph_hi = p + 1; hipLaunchKernelGGL(fwd, dim3(grid), dim3(NTHR), LDS_BYTES, stream, a); }
#endif
}
```

```cpp
#include <hip/hip_runtime.h>
#include <cstdio>
#include <cstdint>
namespace pg8 {
#define PG8_LAS __attribute__((address_space(3)))
typedef unsigned short bf16_t;
typedef short bf16x8 __attribute__((ext_vector_type(8)));
typedef float f32x4 __attribute__((ext_vector_type(4)));
typedef unsigned u32x4 __attribute__((ext_vector_type(4)));
constexpr int BM = 256, BK = 64, HALF = 128, HTB = HALF * BK * 2  , STAGE_BYTES = 8 * HTB, NXCD = 8, WGM = 8;

__host__ __device__ __forceinline__ int lds_byte(int r, int c) { const int st = (r >> 4) * 2 + (c >> 5), rr = r & 15, cc = c & 31, ob = rr * 64 + cc * 2; return st * 1024 + (ob ^ (((ob >> 9) & 1) << 5)); }
__host__ __device__ __forceinline__ void stage_rc(int b, int& R, int& C) { const int st = b / 1024, sb = b % 1024, swz = sb ^ (((sb >> 9) & 1) << 5); R = (st >> 1) * 16 + swz / 64; C = (st & 1) * 32 + (swz % 64) / 2; }
__host__ __device__ __forceinline__ int perm32(int rho) { const int n = rho >> 4, i = rho & 15; return 8 * (i >> 2) + 4 * n + (i & 3); }

struct Unit { int pm, pn; };
struct Gemm { const bf16_t* A; const bf16_t* Bt; int M, N, K, lda; };

struct StaticOrder {
    int nM, nN, nwg, G, c;
    __host__ __device__ void init(int M, int N, int G_, int c_) { nM = M / BM; nN = N / BM; nwg = nM * nN; G = G_; c = c_; }
    __host__ __device__ bool next(int i, Unit& u) const {
        const long L = (long)i * G + c; if (L >= nwg) return false;
        int wgid = (int)L; { const int q = nwg / NXCD, r = nwg % NXCD, xcd = wgid % NXCD, off = wgid / NXCD; wgid = (xcd < r ? xcd * (q + 1) : r * (q + 1) + (xcd - r) * q) + off; }
        const int nig = WGM * nN, gid = wgid / nig, fm = gid * WGM, gsz = (nM - fm) < WGM ? (nM - fm) : WGM;
        u.pm = fm + ((wgid % nig) % gsz); u.pn = (wgid % nig) / gsz; return true;
    }
    __device__ __forceinline__ void a_ready(const Unit&) const {}
    __device__ __forceinline__ void done(const Unit&) const {}
};

__device__ __forceinline__ unsigned cvt_pk_bf16(float lo, float hi) { unsigned r; asm volatile("v_cvt_pk_bf16_f32 %0, %1, %2" : "=v"(r) : "v"(lo), "v"(hi)); return r; }
typedef float f32x2 __attribute__((ext_vector_type(2)));
__device__ __forceinline__ f32x2 gelu_pk(f32x2 v) {
    const f32x2 av = __builtin_elementwise_abs(v), d = av * 0.2316418882f + 1.0f;
    f32x2 t; t.x = __builtin_amdgcn_rcpf(d.x); t.y = __builtin_amdgcn_rcpf(d.y);
    f32x2 q = t * 0.5307027145f + (-0.7265760135f); q = q * t + 0.7107068705f; q = q * t + (-0.142248368f); q = q * t + 0.127414796f; q = q * t;
    const f32x2 s = (v * v) * (-0.72134752044f);
    f32x2 e; e.x = __builtin_amdgcn_exp2f(s.x); e.y = __builtin_amdgcn_exp2f(s.y);
    const f32x2 m = v * (q * e), r = v - m;
    f32x2 o; o.x = v.x < 0.f ? m.x : r.x; o.y = v.y < 0.f ? m.y : r.y; return o;
}

template <int ACT  > struct EpiBf16 {
    static constexpr bool PERM = true, AFTER_DRAIN = false; static_assert(ACT == 0 || ACT == 1, "EpiBf16: ACT is 0 (none) or 1 (gelu_pk)");
    bf16_t* O; int ldc; const float* bias; int split_cols; size_t split_stride; float scale0;
    __device__ __forceinline__ void operator()(const f32x4 (&acc)[2][2][4][2], const Unit& u, int wr, int wc, int fr, int fq) const {
        const int row0 = u.pm * BM + wr * 64 + fr; int colt = u.pn * BM; bf16_t* base = O;
        float sc = 1.f; if (split_cols) { const int t = colt / split_cols; base += (size_t)t * split_stride; colt -= t * split_cols; if (t == 0) sc = scale0; }
        const int col0 = colt + wc * 32 + 8 * fq, bcol0 = u.pn * BM + wc * 32 + 8 * fq;
        f32x4 bv[2][2];
#pragma unroll
        for (int bj = 0; bj < 2; ++bj)
#pragma unroll
            for (int n = 0; n < 2; ++n) bv[bj][n] = bias ? *(const f32x4*)(bias + bcol0 + bj * HALF + 4 * n) : (f32x4){0.f, 0.f, 0.f, 0.f};
#pragma unroll
        for (int ai = 0; ai < 2; ++ai)
#pragma unroll
            for (int m = 0; m < 4; ++m) { bf16_t* rowp = base + (size_t)(row0 + ai * HALF + m * 16) * ldc + col0;
#pragma unroll
                for (int bj = 0; bj < 2; ++bj) { f32x4 v0 = acc[ai][bj][m][0] + bv[bj][0], v1 = acc[ai][bj][m][1] + bv[bj][1];
                    if (ACT == 1) { f32x2 a = gelu_pk((f32x2){v0[0], v0[1]}), b = gelu_pk((f32x2){v0[2], v0[3]}), c = gelu_pk((f32x2){v1[0], v1[1]}), d = gelu_pk((f32x2){v1[2], v1[3]});
                        v0 = (f32x4){a.x, a.y, b.x, b.y}; v1 = (f32x4){c.x, c.y, d.x, d.y}; }
                    v0 = v0 * sc; v1 = v1 * sc; u32x4 w; w.x = cvt_pk_bf16(v0[0], v0[1]); w.y = cvt_pk_bf16(v0[2], v0[3]); w.z = cvt_pk_bf16(v1[0], v1[1]); w.w = cvt_pk_bf16(v1[2], v1[3]);
                    *(u32x4*)(rowp + bj * HALF) = w; } }
    }
};

struct PanelStats {
    unsigned* xbuf;
    unsigned* cnt;
    unsigned* tmo;
    int ntn; float eps;
    unsigned code;
    __device__ __forceinline__ bool run(const f32x4 (&v)[2][2][4][2], const Unit& u, int wr, int wc, int fr, int fq, PG8_LAS unsigned char* lds, int wid, int lane) const {
        typedef float f32x2v __attribute__((ext_vector_type(2)));
        PG8_LAS f32x2v* P = (PG8_LAS f32x2v*)lds;
        PG8_LAS f32x2v* S = (PG8_LAS f32x2v*)(lds + 8192);
        PG8_LAS unsigned* flag = (PG8_LAS unsigned*)(lds + 8192 + 2048);
#pragma unroll
        for (int ai = 0; ai < 2; ++ai)
#pragma unroll
            for (int m = 0; m < 4; ++m) {
                float s = 0.f;
#pragma unroll
                for (int bj = 0; bj < 2; ++bj)
#pragma unroll
                    for (int n = 0; n < 2; ++n) { const f32x4 x = v[ai][bj][m][n]; s += (x[0] + x[1]) + (x[2] + x[3]); }
                s += __shfl_xor(s, 16); s += __shfl_xor(s, 32);
                const float mw = s * (1.0f / 64.0f); float q = 0.f;
#pragma unroll
                for (int bj = 0; bj < 2; ++bj)
#pragma unroll
                    for (int n = 0; n < 2; ++n) { const f32x4 d = v[ai][bj][m][n] - mw; q += (d[0] * d[0] + d[1] * d[1]) + (d[2] * d[2] + d[3] * d[3]); }
                q += __shfl_xor(q, 16); q += __shfl_xor(q, 32);
                if (fq == 0) P[(ai * HALF + wr * 64 + m * 16 + fr) * 4 + wc] = (f32x2v){mw, q};
            }
        asm volatile("s_waitcnt lgkmcnt(0)" ::: "memory"); __builtin_amdgcn_s_barrier(); asm volatile("" ::: "memory");
#if defined(BROKEN_EXCHANGE_NO_WAIT)
#warning BROKEN CONTROL BUILD: the row-statistics exchange does not wait; results are wrong by design
        if (blockIdx.x >= 64) { const long long t0_ = clock64(); while (clock64() - t0_ < 60000) __builtin_amdgcn_s_sleep(8); }
#endif
        const int row = wid * 32 + (lane & 31);
        if (lane < 32) {
            const f32x2v a = P[row * 4 + 0], b = P[row * 4 + 1], c = P[row * 4 + 2], d = P[row * 4 + 3];
            const float mt = (a.x + b.x + c.x + d.x) * 0.25f;
            const float da = a.x - mt, db = b.x - mt, dc = c.x - mt, dd = d.x - mt;
            const float m2 = (a.y + b.y) + (c.y + d.y) + 64.0f * ((da * da + db * db) + (dc * dc + dd * dd));
            unsigned long long* slot = (unsigned long long*)xbuf + ((size_t)(u.pm * BM + row) * 4 + u.pn);
            __hip_atomic_store(slot, ((unsigned long long)__float_as_uint(m2) << 32) | __float_as_uint(mt), __ATOMIC_RELAXED, __HIP_MEMORY_SCOPE_AGENT);
        }
        asm volatile("s_waitcnt vmcnt(0)" ::: "memory");
        if (lane == 0) __hip_atomic_fetch_add(cnt + 64 * u.pm, 1u, __ATOMIC_RELAXED, __HIP_MEMORY_SCOPE_AGENT);
        if (wid == 0) {
            bool dead = false; const unsigned long long t0 = __builtin_amdgcn_s_memrealtime(); const unsigned want = 8u * (unsigned)ntn;
            for (;;) {
#if defined(BROKEN_EXCHANGE_NO_WAIT)
                break;
#endif
                if ((unsigned)__builtin_amdgcn_readfirstlane(__hip_atomic_load(cnt + 64 * u.pm, __ATOMIC_RELAXED, __HIP_MEMORY_SCOPE_AGENT)) >= want) break;
                if (__builtin_amdgcn_s_memrealtime() - t0 > 2000000ull) {
                    if (lane == 0) { unsigned expect = 0u; __hip_atomic_compare_exchange_strong(tmo + 1, &expect, code | (unsigned)(u.pm & 0xff), __ATOMIC_RELAXED, __ATOMIC_RELAXED, __HIP_MEMORY_SCOPE_AGENT);
                                     __hip_atomic_store(tmo, 1u, __ATOMIC_RELAXED, __HIP_MEMORY_SCOPE_AGENT); }
                    dead = true; break; }
                __builtin_amdgcn_s_sleep(2);
            }
            __builtin_amdgcn_fence(__ATOMIC_ACQUIRE, "agent");
            if (lane == 0) flag[0] = dead ? 1u : 0u;
        }
        asm volatile("s_waitcnt vmcnt(0) lgkmcnt(0)" ::: "memory"); __builtin_amdgcn_s_barrier(); asm volatile("" ::: "memory");
        const bool bad = flag[0] != 0u;
        if (lane < 32) {
            const unsigned long long* slot = (const unsigned long long*)xbuf + (size_t)(u.pm * BM + row) * 4; float mt[4], m2[4]; float ms = 0.f;
#pragma unroll
            for (int t = 0; t < 4; ++t) { if (t < ntn) { const unsigned long long w = __hip_atomic_load(slot + t, __ATOMIC_RELAXED, __HIP_MEMORY_SCOPE_AGENT); mt[t] = __uint_as_float((unsigned)w); m2[t] = __uint_as_float((unsigned)(w >> 32)); } else { mt[t] = 0.f; m2[t] = 0.f; } ms += mt[t]; }
            const float mean = ms / (float)ntn; float q = 0.f;
#pragma unroll
            for (int t = 0; t < 4; ++t) if (t < ntn) { const float dm = mt[t] - mean; q += m2[t] + 256.0f * dm * dm; }
            S[row] = (f32x2v){mean, 1.0f / sqrtf(q / (256.0f * (float)ntn) + eps)};
        }
        asm volatile("s_waitcnt lgkmcnt(0)" ::: "memory"); __builtin_amdgcn_s_barrier(); asm volatile("" ::: "memory");
        return bad;
    }
};
struct EpiLnRes {
    static constexpr bool PERM = false, AFTER_DRAIN = true;
    const float* base; float* out; int ldc; const float* bias; PanelStats st; unsigned poison;
    __device__ __forceinline__ void fused(f32x4 (&acc)[2][2][4][2], const Unit& u, int wr, int wc, int fr, int fq, PG8_LAS unsigned char* lds, int wid, int lane) const {
        typedef float f32x2v __attribute__((ext_vector_type(2)));
        const PG8_LAS f32x2v* S = (const PG8_LAS f32x2v*)(lds + 8192);
        const int col0 = u.pn * BM + wc * 32 + 4 * fq;
#pragma unroll
        for (int bj = 0; bj < 2; ++bj)
#pragma unroll
            for (int n = 0; n < 2; ++n) { const f32x4 bv = bias ? *(const f32x4*)(bias + col0 + bj * HALF + n * 16) : (f32x4){0.f, 0.f, 0.f, 0.f};
#pragma unroll
                for (int ai = 0; ai < 2; ++ai)
#pragma unroll
                    for (int m = 0; m < 4; ++m) acc[ai][bj][m][n] += bv; }
        f32x4 pre[4][2][2];
#pragma unroll
        for (int m = 0; m < 4; ++m) { const size_t off = (size_t)(u.pm * BM + wr * 64 + m * 16 + fr) * ldc + col0;
#pragma unroll
            for (int bj = 0; bj < 2; ++bj)
#pragma unroll
                for (int n = 0; n < 2; ++n) pre[m][bj][n] = *(const f32x4*)(base + off + bj * HALF + n * 16); }
        const bool bad = st.run(acc, u, wr, wc, fr, fq, lds, wid, lane) || poison != 0u;
        const float qnan = __builtin_nanf("");
#pragma unroll
        for (int ai = 0; ai < 2; ++ai)
#pragma unroll
            for (int m = 0; m < 4; ++m) { const int r = ai * HALF + wr * 64 + m * 16 + fr; const f32x2v sr = S[r]; const size_t off = (size_t)(u.pm * BM + r) * ldc + col0;
#pragma unroll
                for (int bj = 0; bj < 2; ++bj)
#pragma unroll
                    for (int n = 0; n < 2; ++n) { const f32x4 bs = ai == 0 ? pre[m][bj][n] : *(const f32x4*)(base + off + bj * HALF + n * 16); f32x4 o = bs + (acc[ai][bj][m][n] - sr.x) * sr.y;
                        if (bad) o = (f32x4){qnan, qnan, qnan, qnan}; *(f32x4*)(out + off + bj * HALF + n * 16) = o; }
                if (m & 1) asm volatile("" ::: "memory"); }
    }
};
struct EpiLnResLn {
    static constexpr bool PERM = false, AFTER_DRAIN = true;
    const float* base; float* out; bf16_t* xn; int ldc; const float* bias; PanelStats st1, st2; unsigned poison;
    __device__ __forceinline__ void fused(f32x4 (&acc)[2][2][4][2], const Unit& u, int wr, int wc, int fr, int fq, PG8_LAS unsigned char* lds, int wid, int lane) const {
        typedef float f32x2v __attribute__((ext_vector_type(2))); typedef unsigned u32x2v __attribute__((ext_vector_type(2)));
        const PG8_LAS f32x2v* S = (const PG8_LAS f32x2v*)(lds + 8192);
        const int col0 = u.pn * BM + wc * 32 + 4 * fq;
#pragma unroll
        for (int bj = 0; bj < 2; ++bj)
#pragma unroll
            for (int n = 0; n < 2; ++n) { const f32x4 bv = bias ? *(const f32x4*)(bias + col0 + bj * HALF + n * 16) : (f32x4){0.f, 0.f, 0.f, 0.f};
#pragma unroll
                for (int ai = 0; ai < 2; ++ai)
#pragma unroll
                    for (int m = 0; m < 4; ++m) acc[ai][bj][m][n] += bv; }
        bool bad = st1.run(acc, u, wr, wc, fr, fq, lds, wid, lane) || poison != 0u;
        const float qnan = __builtin_nanf("");
#pragma unroll
        for (int ai = 0; ai < 2; ++ai)
#pragma unroll
            for (int m = 0; m < 4; ++m) { const int r = ai * HALF + wr * 64 + m * 16 + fr; const f32x2v sr = S[r]; const size_t off = (size_t)(u.pm * BM + r) * ldc + col0;
#pragma unroll
                for (int bj = 0; bj < 2; ++bj)
#pragma unroll
                    for (int n = 0; n < 2; ++n) { const f32x4 bs = *(const f32x4*)(base + off + bj * HALF + n * 16); acc[ai][bj][m][n] = bs + (acc[ai][bj][m][n] - sr.x) * sr.y; }
                asm volatile("" : "+v"(acc[ai][0][m][0]), "+v"(acc[ai][0][m][1]), "+v"(acc[ai][1][m][0]), "+v"(acc[ai][1][m][1]));
                if (m & 1) asm volatile("" ::: "memory"); }
        const bool bad1 = bad;
        bad = st2.run(acc, u, wr, wc, fr, fq, lds, wid, lane) || bad;
#pragma unroll
        for (int ai = 0; ai < 2; ++ai)
#pragma unroll
            for (int m = 0; m < 4; ++m) { const int r = ai * HALF + wr * 64 + m * 16 + fr; const f32x2v sr = S[r]; const size_t off = (size_t)(u.pm * BM + r) * ldc + col0;
#pragma unroll
                for (int bj = 0; bj < 2; ++bj)
#pragma unroll
                    for (int n = 0; n < 2; ++n) { const f32x4 x1 = acc[ai][bj][m][n]; *(f32x4*)(out + off + bj * HALF + n * 16) = bad1 ? (f32x4){qnan, qnan, qnan, qnan} : x1;
                        const f32x4 o = (x1 - sr.x) * sr.y; u32x2v w; w.x = cvt_pk_bf16(o[0], o[1]); w.y = cvt_pk_bf16(o[2], o[3]);
                        if (bad) { w.x = 0x7fc07fc0u; w.y = 0x7fc07fc0u; } *(u32x2v*)(xn + off + bj * HALF + n * 16) = w; }
                asm volatile("" ::: "memory"); }
    }
};

template <class Epi, class Sched, bool ALIGN_EPI = false, bool SP2 = false, int AROW = 0>
__device__ __forceinline__ void gemm_phase(PG8_LAS unsigned char* lds, const Gemm g, const Sched& S, const Epi& E) {
    int tid_ = threadIdx.x; asm volatile("" : "+v"(tid_));
    const int tid = tid_, wid = __builtin_amdgcn_readfirstlane(tid >> 6), lane = tid & 63, wr = wid >> 2, wc = wid & 3, fr = lane & 15, fq = lane >> 4;
    const int K = g.K, nt = K / BK;
    unsigned voffA[2], voffB[2];
#pragma unroll
    for (int i = 0; i < 2; ++i) { int R, C; stage_rc(tid * 16 + i * 8192, R, C); const int Rb = Epi::PERM ? ((R & ~31) + perm32(R & 31)) : R;
        const int Ra = (AROW == 1) ? ((R & ~63) + 4 * (R & 15) + ((R >> 4) & 3)) : R;
        voffA[i] = (unsigned)(Ra * g.lda + C) * 2u; voffB[i] = (unsigned)(Rb * K + C) * 2u;
        if (AROW == 2) { const int tp = 4 * ((lane >> 2) & 3) + (lane >> 4), c = lane & 3;
            voffA[i] = (unsigned)((64 * i + 16 * (wid & 3) + tp) * g.lda + 32 * (wid >> 2) + 8 * c) * 2u; } }
    const size_t kstep = (size_t)(BK * 2);
    const size_t hstep = (size_t)HALF * K * 2;
    const size_t tstep = 2 * hstep;
    const size_t hstepA = (size_t)HALF * g.lda * 2, tstepA = 2 * hstepA;
    const unsigned ldsw = (unsigned)wid * 1024u;
    constexpr int PSTR = 1056, HTBA = (AROW == 2) ? 16 * PSTR : HTB;
    const int aoff = (AROW == 2) ? (wr * 8 + (fr >> 2)) * PSTR + 64 * (fr & 3) + 16 * fq : lds_byte(wr * 64 + fr, fq * 8), boff = lds_byte(wc * 32 + fr, fq * 8);
    constexpr int AM = (AROW == 2) ? 256 : 2048, AK = (AROW == 2) ? 4 * PSTR : 1024;
    const unsigned ldswA = (AROW == 2) ? (unsigned)wid * PSTR : (unsigned)wid * 1024u; constexpr unsigned ISTRA = (AROW == 2) ? 8u * PSTR : 8192u;
#define PG8_SA(b, h) (((b) * 2 + (h)) * HTBA)
#define PG8_SB(b, h) (4 * HTBA + ((b) * 2 + (h)) * HTB)
#define PG8_STAGEA(bufoff, gbase, voff) do { _Pragma("unroll") for (int _i = 0; _i < 2; ++_i) \
        __builtin_amdgcn_global_load_lds((const unsigned*)((const char*)(gbase) + (voff)[_i]), (PG8_LAS unsigned*)(lds + (bufoff) + ldswA + _i * ISTRA), 16, 0, 0); } while (0)
#define PG8_STAGE(bufoff, gbase, voff) do { _Pragma("unroll") for (int _i = 0; _i < 2; ++_i) \
        __builtin_amdgcn_global_load_lds((const unsigned*)((const char*)(gbase) + (voff)[_i]), (PG8_LAS unsigned*)(lds + (bufoff) + ldsw + _i * 8192), 16, 0, 0); } while (0)
#define PG8_LDA(dst, b, h) do { _Pragma("unroll") for (int m = 0; m < 4; ++m) _Pragma("unroll") for (int k = 0; k < 2; ++k) dst[m][k] = *(const PG8_LAS bf16x8*)(lds + PG8_SA(b, h) + aoff + m * AM + k * AK); } while (0)
#define PG8_LDB(dst, b, h) do { _Pragma("unroll") for (int n = 0; n < 2; ++n) _Pragma("unroll") for (int k = 0; k < 2; ++k) dst[n][k] = *(const PG8_LAS bf16x8*)(lds + PG8_SB(b, h) + boff + n * 2048 + k * 1024); } while (0)
#define PG8_MMA(ai, bj, At, Bt) do { __builtin_amdgcn_s_setprio(1); _Pragma("unroll") for (int m = 0; m < 4; ++m) _Pragma("unroll") for (int n = 0; n < 2; ++n) _Pragma("unroll") for (int k = 0; k < 2; ++k) \
        acc[ai][bj][m][n] = __builtin_amdgcn_mfma_f32_16x16x32_bf16(Bt[n][k], At[m][k], acc[ai][bj][m][n], 0, 0, 0); __builtin_amdgcn_s_setprio(0); } while (0)
#define PG8_WAIT_V(n) asm volatile("s_waitcnt vmcnt(" #n ")" ::: "memory")
#define PG8_WAIT_L(n) asm volatile("s_waitcnt lgkmcnt(" #n ")" ::: "memory")
#define PG8_BAR __builtin_amdgcn_s_barrier()
#define PG8_SCHED __builtin_amdgcn_sched_barrier(0)
    Unit cur, nxt; int ui = 0;
    if (!S.next(0, cur)) return;
    f32x4 acc[2][2][4][2];
#pragma unroll
    for (int a = 0; a < 2; ++a)
#pragma unroll
        for (int b = 0; b < 2; ++b)
#pragma unroll
            for (int m = 0; m < 4; ++m)
#pragma unroll
                for (int n = 0; n < 2; ++n) acc[a][b][m][n] = (f32x4){0.f, 0.f, 0.f, 0.f};
    bf16x8 At[4][2], B0[2][2], B1[2][2];
    const char* cA = (const char*)g.A + (size_t)cur.pm * tstepA; const char* cB = (const char*)g.Bt + (size_t)cur.pn * tstep;
    S.a_ready(cur);
    if constexpr (SP2) {
        PG8_STAGE(PG8_SB(0, 0), cB, voffB); PG8_STAGE(PG8_SB(0, 1), cB + hstep, voffB); PG8_STAGEA(PG8_SA(0, 0), cA, voffA); PG8_STAGEA(PG8_SA(0, 1), cA + hstepA, voffA);
        if (wr == 1) PG8_BAR;
        PG8_WAIT_V(2); PG8_BAR;
        PG8_STAGE(PG8_SB(1, 0), cB + kstep, voffB); PG8_STAGEA(PG8_SA(1, 0), cA + kstep, voffA); PG8_STAGE(PG8_SB(1, 1), cB + hstep + kstep, voffB);
        PG8_WAIT_V(6); PG8_BAR;
    } else {
        PG8_STAGE(PG8_SB(0, 0), cB, voffB); PG8_STAGEA(PG8_SA(0, 0), cA, voffA); PG8_STAGE(PG8_SB(0, 1), cB + hstep, voffB); PG8_STAGEA(PG8_SA(0, 1), cA + hstepA, voffA);
        if (wr == 1) PG8_BAR;
        PG8_WAIT_V(4); PG8_BAR;
        PG8_STAGE(PG8_SB(1, 0), cB + kstep, voffB); PG8_STAGEA(PG8_SA(1, 0), cA + kstep, voffA); PG8_STAGE(PG8_SB(1, 1), cB + hstep + kstep, voffB);
        PG8_WAIT_V(6); PG8_BAR;
    }
    for (;;) {
        const bool has_next = S.next(ui + 1, nxt);
        const char* nA = has_next ? (const char*)g.A + (size_t)nxt.pm * tstepA : cA; const char* nB = has_next ? (const char*)g.Bt + (size_t)nxt.pn * tstep : cB;
#pragma unroll 1
        for (int t = 0; t < nt; t += 2) {
            const bool last = (t == nt - 2);
            const char* a1 = cA + (size_t)(t + 1) * kstep;
            const char* a2 = last ? nA : cA + (size_t)(t + 2) * kstep; const char* b2 = last ? nB : cB + (size_t)(t + 2) * kstep;
            const char* a3 = a2 + kstep; const char* b3 = b2 + kstep;
            if (last && has_next) S.a_ready(nxt);
            if constexpr (SP2) {
            PG8_LDB(B0, 0, 0); PG8_LDB(B1, 0, 1); PG8_SCHED; PG8_LDA(At, 0, 0); PG8_STAGEA(PG8_SA(1, 1), a1 + hstepA, voffA);
            PG8_WAIT_V(8); PG8_WAIT_L(0); PG8_BAR; PG8_MMA(0, 0, At, B0); PG8_MMA(0, 1, At, B1); PG8_BAR; PG8_SCHED;
            PG8_LDA(At, 0, 1); PG8_STAGE(PG8_SB(0, 0), b2, voffB); PG8_STAGE(PG8_SB(0, 1), b2 + hstep, voffB); PG8_STAGEA(PG8_SA(0, 0), a2, voffA);
            PG8_WAIT_V(8); PG8_WAIT_L(0); PG8_BAR; PG8_MMA(1, 0, At, B0); PG8_MMA(1, 1, At, B1); PG8_BAR; PG8_SCHED;
            PG8_LDB(B0, 1, 0); PG8_LDB(B1, 1, 1); PG8_SCHED; PG8_LDA(At, 1, 0); PG8_STAGEA(PG8_SA(0, 1), a2 + hstepA, voffA);
            PG8_WAIT_V(8); PG8_WAIT_L(0); PG8_BAR; PG8_MMA(0, 0, At, B0); PG8_MMA(0, 1, At, B1); PG8_BAR; PG8_SCHED;
            PG8_LDA(At, 1, 1); PG8_STAGE(PG8_SB(1, 0), b3, voffB); PG8_STAGE(PG8_SB(1, 1), b3 + hstep, voffB); PG8_STAGEA(PG8_SA(1, 0), a3, voffA);
            PG8_WAIT_V(8); PG8_WAIT_L(0); PG8_BAR; PG8_MMA(1, 0, At, B0); PG8_MMA(1, 1, At, B1); PG8_BAR; PG8_SCHED;
            } else {
            PG8_LDB(B0, 0, 0); PG8_SCHED; PG8_LDA(At, 0, 0); PG8_STAGEA(PG8_SA(1, 1), a1 + hstepA, voffA);
            PG8_WAIT_L(8); PG8_BAR; PG8_WAIT_L(0); PG8_MMA(0, 0, At, B0); PG8_BAR; PG8_SCHED;
            PG8_LDB(B1, 0, 1); PG8_STAGE(PG8_SB(0, 0), b2, voffB);
            PG8_BAR; PG8_WAIT_L(0); PG8_MMA(0, 1, At, B1); PG8_BAR;
            PG8_LDA(At, 0, 1); PG8_STAGEA(PG8_SA(0, 0), a2, voffA);
            PG8_BAR; PG8_WAIT_L(0); PG8_MMA(1, 0, At, B0); PG8_BAR; PG8_SCHED;
            PG8_STAGE(PG8_SB(0, 1), b2 + hstep, voffB);
            PG8_WAIT_V(6); PG8_BAR; PG8_MMA(1, 1, At, B1); PG8_BAR;
            PG8_LDB(B0, 1, 0); PG8_SCHED; PG8_LDA(At, 1, 0); PG8_STAGEA(PG8_SA(0, 1), a2 + hstepA, voffA);
            PG8_WAIT_L(8); PG8_BAR; PG8_WAIT_L(0); PG8_MMA(0, 0, At, B0); PG8_BAR; PG8_SCHED;
            PG8_LDB(B1, 1, 1); PG8_STAGE(PG8_SB(1, 0), b3, voffB);
            PG8_BAR; PG8_WAIT_L(0); PG8_MMA(0, 1, At, B1); PG8_BAR;
            PG8_LDA(At, 1, 1); PG8_STAGEA(PG8_SA(1, 0), a3, voffA);
            PG8_BAR; PG8_WAIT_L(0); PG8_MMA(1, 0, At, B0); PG8_BAR; PG8_SCHED;
            PG8_STAGE(PG8_SB(1, 1), b3 + hstep, voffB);
            PG8_WAIT_V(6); PG8_BAR; PG8_MMA(1, 1, At, B1); PG8_BAR;
            }
        }
        if constexpr (ALIGN_EPI) { if (wr == 0) PG8_BAR; }
        if constexpr (!Epi::AFTER_DRAIN) { E(acc, cur, wr, wc, fr, fq); S.done(cur); }
        if (!has_next) break;
#pragma unroll
        for (int a = 0; a < 2; ++a)
#pragma unroll
            for (int b = 0; b < 2; ++b)
#pragma unroll
                for (int m = 0; m < 4; ++m)
#pragma unroll
                    for (int n = 0; n < 2; ++n) acc[a][b][m][n] = (f32x4){0.f, 0.f, 0.f, 0.f};
        cur = nxt; cA = nA; cB = nB; ++ui;
        if constexpr (ALIGN_EPI) { if (wr == 1) PG8_BAR; }
    }
    PG8_WAIT_V(0);
    if constexpr (!ALIGN_EPI) { if (wr == 0) PG8_BAR; }
    PG8_BAR;
    if constexpr (Epi::AFTER_DRAIN) { E.fused(acc, cur, wr, wc, fr, fq, lds, wid, lane); S.done(cur); }
#undef PG8_SA
#undef PG8_SB
#undef PG8_STAGE
#undef PG8_STAGEA
#undef PG8_LDA
#undef PG8_LDB
#undef PG8_MMA
#undef PG8_WAIT_V
#undef PG8_WAIT_L
#undef PG8_BAR
#undef PG8_SCHED
}
}

#ifndef PG8_SP2
#define PG8_SP2 true
#endif
#ifndef PG8_ALIGN
#define PG8_ALIGN true
#endif
#define GAS __attribute__((address_space(1)))
#define LAS __attribute__((address_space(3)))
typedef unsigned short bf16;
typedef unsigned v4u __attribute__((ext_vector_type(4)));
typedef float f32x4 __attribute__((ext_vector_type(4)));
typedef short bf16x8 __attribute__((ext_vector_type(8)));
typedef GAS unsigned gu32;
typedef GAS unsigned long long gu64;
#define RLX_AGENT __ATOMIC_RELAXED, __HIP_MEMORY_SCOPE_AGENT
#define LDS_WAIT() asm volatile("s_waitcnt lgkmcnt(0)" ::: "memory")
#define VM_WAIT() asm volatile("s_waitcnt vmcnt(0)" ::: "memory")
__device__ __forceinline__ unsigned long long rt() { return __builtin_amdgcn_s_memrealtime(); }
__device__ __forceinline__ unsigned f2bf(float f) { unsigned u = __builtin_bit_cast(unsigned, f); return (u + 0x7fffu + ((u >> 16) & 1u)) >> 16; }
typedef float pk_f32x2_t __attribute__((ext_vector_type(2))); typedef __bf16 pk_bf16x2_t __attribute__((ext_vector_type(2)));
__device__ __forceinline__ unsigned pk2(float lo, float hi) { pk_f32x2_t v = {lo, hi}; pk_bf16x2_t b = __builtin_convertvector(v, pk_bf16x2_t); return __builtin_bit_cast(unsigned, b); }

#define XB_TMO      128
#define XB_XCNT(j)  (256  + 64 * (j))
#define XB_XSUB(j)  (1280 + 64 * (j))
#define XB_XGEN(j)  (2304 + 64 * (j))
#define XB_TOP      3328
#define XB_TOPGEN   3392
#define XCD_BAR_WORDS 3456
#define XB_SPIN_CAP (1u << 18)

__device__ __forceinline__ unsigned xb_ld(unsigned* p)              { return __hip_atomic_load(p, __ATOMIC_RELAXED, __HIP_MEMORY_SCOPE_AGENT); }
__device__ __forceinline__ unsigned xb_add(unsigned* p, unsigned v) { return __hip_atomic_fetch_add(p, v, __ATOMIC_RELAXED, __HIP_MEMORY_SCOPE_AGENT); }
__device__ __forceinline__ unsigned xb_xcc_id() { return (unsigned)__builtin_amdgcn_s_getreg((3 << 11) | 20) & 0xFu; }
#define XB_SPIN(cond, bar) do { unsigned _sp = 0; while (cond) { __builtin_amdgcn_s_sleep(1); \
    if ((++_sp & 255u) == 0u) { if (xb_ld(&(bar)[XB_TMO])) break; if (_sp > XB_SPIN_CAP) { atomicAdd(&(bar)[XB_TMO], 1u); break; } } } } while (0)

struct XcdBarrier {
    unsigned* bar; unsigned x;
    volatile LAS unsigned* st;
};

__device__ __forceinline__ XcdBarrier xcd_barrier_post(unsigned* bar, volatile LAS unsigned* st) {
    XcdBarrier b; b.bar = bar; b.x = xb_xcc_id(); b.st = st;
    if (threadIdx.x == 0) (void)xb_add(&bar[XB_XCNT(b.x)], 1u);
    return b;
}
__device__ __forceinline__ void xcd_barrier_complete(unsigned* bar, unsigned x, unsigned& nloc, unsigned& nx) {
    const unsigned G = gridDim.x * gridDim.y * gridDim.z;
    unsigned sum, cnt, mine, sp = 0u;
    for (;;) {
        sum = 0u; cnt = 0u; mine = 0u;
#pragma unroll
        for (unsigned j = 0; j < 16; ++j) { const unsigned c = xb_ld(&bar[XB_XCNT(j)]); sum += c; cnt += (c > 0u) ? 1u : 0u; mine = (j == x) ? c : mine; }
        if (sum == G) break;
        __builtin_amdgcn_s_sleep(1);
        if ((++sp & 255u) == 0u) { if (xb_ld(&bar[XB_TMO])) break; if (sp > XB_SPIN_CAP) { atomicAdd(&bar[XB_TMO], 1u); break; } }
    }
    nloc = mine > 0u ? mine : 1u; nx = cnt > 0u ? cnt : 1u;
}

__device__ __forceinline__ void xcd_barrier(const XcdBarrier& b) {
    asm volatile("s_waitcnt vmcnt(0)" ::: "memory");
    __syncthreads();
    if (threadIdx.x == 0) {
        unsigned* bar = b.bar;
        __builtin_amdgcn_s_waitcnt(0);
        unsigned nloc = b.st[0], nx = b.st[1];
        if (nloc == 0u) { xcd_barrier_complete(bar, b.x, nloc, nx); b.st[0] = nloc; b.st[1] = nx; }
        const unsigned old = xb_add(&bar[XB_XSUB(b.x)], 1u);
        const unsigned gen = old / nloc;
        if (old + 1u == (gen + 1u) * nloc) {
            __builtin_amdgcn_fence(__ATOMIC_RELEASE, "agent");
            asm volatile("s_waitcnt vmcnt(0)" ::: "memory");
            const unsigned og = xb_add(&bar[XB_TOP], 1u);
            const unsigned tg = og / nx;
            if (og + 1u == (tg + 1u) * nx) xb_add(&bar[XB_TOPGEN], 1u);
            else XB_SPIN(xb_ld(&bar[XB_TOPGEN]) == tg, bar);
            __builtin_amdgcn_fence(__ATOMIC_ACQUIRE, "agent");
            xb_add(&bar[XB_XGEN(b.x)], 1u);
            asm volatile("s_waitcnt vmcnt(0)" ::: "memory");
        } else {
            XB_SPIN(xb_ld(&bar[XB_XGEN(b.x)]) == gen, bar);
            __builtin_amdgcn_fence(__ATOMIC_ACQUIRE, "agent");
            asm volatile("s_waitcnt vmcnt(0)" ::: "memory");
        }
    }
    __syncthreads();
}
__device__ __forceinline__ float bf2f(bf16 v) { return __builtin_bit_cast(float, (unsigned)v << 16); }
__device__ __forceinline__ float bflo(unsigned w) { return __builtin_bit_cast(float, w << 16); }
__device__ __forceinline__ float bfhi(unsigned w) { return __builtin_bit_cast(float, w & 0xffff0000u); }
__device__ __forceinline__ float silu_f(float v) { return v / (1.f + __expf(-v)); }
__device__ __forceinline__ float wave_sum(float v) {
#pragma unroll
    for (int o = 1; o < 64; o <<= 1) v += __shfl_xor(v, o);
    return v;
}


namespace at2 {
typedef short bf16x8 __attribute__((ext_vector_type(8)));
typedef short s16x4 __attribute__((ext_vector_type(4)));
typedef float f32x16 __attribute__((ext_vector_type(16)));
typedef unsigned u32x4 __attribute__((ext_vector_type(4)));
typedef float f32x2_t __attribute__((ext_vector_type(2))); typedef __bf16 bf16x2_t __attribute__((ext_vector_type(2)));
#define AT_LAS __attribute__((address_space(3)))
__device__ __forceinline__ int crow(int r, int hi) { return (r & 3) + 8 * (r >> 2) + 4 * hi; }
__device__ __forceinline__ void glds16(const void* gsrc, unsigned lds_dst) { unsigned keep;
    asm volatile("s_mov_b32 %0, m0\n\ts_mov_b32 m0, %2\n\ts_nop 0\n\tglobal_load_lds_dwordx4 %1, off\n\ts_mov_b32 m0, %0" : "=&s"(keep) : "v"(gsrc), "s"(lds_dst) : "memory"); }
__device__ __forceinline__ unsigned cvtpk(float lo, float hi) { f32x2_t v = {lo, hi}; bf16x2_t b = __builtin_convertvector(v, bf16x2_t); return __builtin_bit_cast(unsigned, b); }
__device__ __forceinline__ float swap_max(float m) { auto rr = __builtin_amdgcn_permlane32_swap(__float_as_uint(m), __float_as_uint(m), false, false); float r; asm("v_max_f32_e32 %0, %1, %2" : "=v"(r) : "v"(__uint_as_float(rr[0])), "v"(__uint_as_float(rr[1]))); return r; }
__device__ __forceinline__ float swap_sum(float m) { auto rr = __builtin_amdgcn_permlane32_swap(__float_as_uint(m), __float_as_uint(m), false, false); return __uint_as_float(rr[0]) + __uint_as_float(rr[1]); }

__device__ __forceinline__ float max3f(float a, float b, float c) { float r; asm("v_max3_f32 %0, %1, %2, %3" : "=v"(r) : "v"(a), "v"(b), "v"(c)); return r; }
__device__ __forceinline__ float max2f(float a, float b) { float r; asm("v_max_f32_e32 %0, %1, %2" : "=v"(r) : "v"(a), "v"(b)); return r; }
constexpr float NEGM = -1e30f;
constexpr float THR = 8.0f;

struct Tensors { const unsigned short* Q; const unsigned short* K; const unsigned short* V; unsigned short* O; int pq, pk, pv, po; };

__device__ __forceinline__ void pv(f32x16* o, int vb, bf16x8 pa0, bf16x8 pa1, bf16x8 pa2, bf16x8 pa3) {
#pragma unroll
    for (int d0 = 0; d0 < 2; ++d0) { s16x4 lo[4], hi[4];
#pragma unroll
        for (int ks = 0; ks < 4; ++ks) {
            asm volatile("ds_read_b64_tr_b16 %0,%1 offset:%c2" : "=&v"(lo[ks]) : "v"(vb), "i"(d0 * 4096 + ks * 1024) : "memory");
            asm volatile("ds_read_b64_tr_b16 %0,%1 offset:%c2" : "=&v"(hi[ks]) : "v"(vb), "i"(d0 * 4096 + ks * 1024 + 512) : "memory"); }
        asm volatile("s_waitcnt lgkmcnt(0)" ::: "memory"); __builtin_amdgcn_sched_barrier(0);
#define AT_PK(k) (bf16x8){lo[k][0], lo[k][1], lo[k][2], lo[k][3], hi[k][0], hi[k][1], hi[k][2], hi[k][3]}
        o[d0] = __builtin_amdgcn_mfma_f32_32x32x16_bf16(pa0, AT_PK(0), o[d0], 0, 0, 0);
        o[d0] = __builtin_amdgcn_mfma_f32_32x32x16_bf16(pa1, AT_PK(1), o[d0], 0, 0, 0);
        o[d0] = __builtin_amdgcn_mfma_f32_32x32x16_bf16(pa2, AT_PK(2), o[d0], 0, 0, 0);
        o[d0] = __builtin_amdgcn_mfma_f32_32x32x16_bf16(pa3, AT_PK(3), o[d0], 0, 0, 0);
#undef AT_PK
    }
}

typedef short v4i16_t __attribute__((ext_vector_type(4)));
__device__ __forceinline__ s16x4 vtr(const AT_LAS unsigned char* p) { return __builtin_bit_cast(s16x4, __builtin_amdgcn_ds_read_tr16_b64_v4i16((AT_LAS v4i16_t*)p)); }
__device__ __forceinline__ void pv2(f32x16* o, const AT_LAS unsigned char* vp, bf16x8 pa0, bf16x8 pa1, bf16x8 pa2, bf16x8 pa3) {
#pragma unroll
    for (int d0 = 0; d0 < 2; ++d0) { s16x4 lo[4], hi[4];
#pragma unroll
        for (int ks = 0; ks < 4; ++ks) { lo[ks] = vtr(vp + d0 * 4096 + ks * 1024); hi[ks] = vtr(vp + d0 * 4096 + ks * 1024 + 512); }
#define AT_PK(k) (bf16x8){lo[k][0], lo[k][1], lo[k][2], lo[k][3], hi[k][0], hi[k][1], hi[k][2], hi[k][3]}
        o[d0] = __builtin_amdgcn_mfma_f32_32x32x16_bf16(pa0, AT_PK(0), o[d0], 0, 0, 0);
        o[d0] = __builtin_amdgcn_mfma_f32_32x32x16_bf16(pa1, AT_PK(1), o[d0], 0, 0, 0);
        o[d0] = __builtin_amdgcn_mfma_f32_32x32x16_bf16(pa2, AT_PK(2), o[d0], 0, 0, 0);
        o[d0] = __builtin_amdgcn_mfma_f32_32x32x16_bf16(pa3, AT_PK(3), o[d0], 0, 0, 0);
#undef AT_PK
    }
}

template <int DQ, bool MOBA, bool QNORM, int G>
__device__ __forceinline__ void attn_unit(AT_LAS unsigned char* lds, const Tensors& T, long rowbase, int qb, const float* km, const float* qg, const float* tab) {
    constexpr int NKP = DQ / 8, NP = NKP + 8, SLOTB = NKP * 1024 + 8192, ND0 = DQ / 16;
    constexpr int NSLOT = 3 * G, LDS_WS = NSLOT * SLOTB, LDS_OST = 0;
    int tid_ = threadIdx.x; asm volatile("" : "+v"(tid_));
    const int tid = tid_, lane = tid & 63, r32 = lane & 31, hi = lane >> 5; const int wid = __builtin_amdgcn_readfirstlane(tid >> 6);
    const int q0 = qb * 256, NT = 4 * (qb + 1);
    const unsigned lds0 = (unsigned)(size_t)lds;
    AT_LAS float* wsf = (AT_LAS float*)(lds + LDS_WS) + wid * 64;
    asm volatile("s_waitcnt vmcnt(0)" ::: "memory");
    const unsigned short* src[3]; unsigned dsto[3];
#pragma unroll
    for (int k = 0; k < 3; ++k) { const int pi = wid + 8 * k;
        if (pi < NKP) { src[k] = (T.pk == 0) ? T.K + pi * 512 + lane * 8 : T.K + (rowbase + lane) * T.pk + 8 * pi; dsto[k] = pi * 1024; }
        else { const int v = pi - NKP; src[k] = (T.pv == 0) ? T.V + v * 512 + lane * 8 : T.V + (rowbase + 16 * (v & 3) + (lane >> 2)) * T.pv + 32 * (v >> 2) + 8 * (lane & 3); dsto[k] = NKP * 1024 + v * 1024; } }
    const long kstep = (T.pk == 0) ? (long)NKP * 512 : (long)64 * T.pk, vstep = (T.pv == 0) ? (long)4096 : (long)64 * T.pv;
#define AT_DMA(t, slot) do { _Pragma("unroll") for (int k_ = 0; k_ < 3; ++k_) { const int pi_ = wid + 8 * k_; if (pi_ < NP) { \
        const unsigned short* s_ = src[k_] + (long)(t) * ((pi_ < NKP) ? kstep : vstep); glds16(s_, (unsigned)__builtin_amdgcn_readfirstlane(lds0 + (slot) * SLOTB + dsto[k_])); } } } while (0)
    _Pragma("unroll") for (int i_ = 0; i_ < G; ++i_) AT_DMA(i_, i_);
    __builtin_amdgcn_sched_barrier(0);
    bf16x8 qr[ND0];
    { const unsigned short* Qw = T.Q + (rowbase + q0 + wid * 32 + r32) * T.pq + hi * 8;
#pragma unroll
      for (int d0 = 0; d0 < ND0; ++d0) qr[d0] = *(const bf16x8*)(Qw + d0 * 16); }
    __builtin_amdgcn_sched_barrier(0);
    if constexpr (QNORM) {
        float s = 0.f;
#pragma unroll
        for (int d0 = 0; d0 < ND0; ++d0)
#pragma unroll
            for (int j = 0; j < 8; ++j) { const float x = bf2f((unsigned short)qr[d0][j]); s += x * x; }
        s = swap_sum(s);
        const float rstd = 0.14724445073472677f / sqrtf(s * (1.f / 96.f) + 1e-6f);
#pragma unroll
        for (int d0 = 0; d0 < 4; ++d0) { const f32x4 g0 = *(const f32x4*)(qg + d0 * 16 + hi * 8), g1 = *(const f32x4*)(qg + d0 * 16 + hi * 8 + 4); u32x4 w;
            w.x = cvtpk(bf2f((unsigned short)qr[d0][0]) * rstd * g0.x, bf2f((unsigned short)qr[d0][1]) * rstd * g0.y); w.y = cvtpk(bf2f((unsigned short)qr[d0][2]) * rstd * g0.z, bf2f((unsigned short)qr[d0][3]) * rstd * g0.w);
            w.z = cvtpk(bf2f((unsigned short)qr[d0][4]) * rstd * g1.x, bf2f((unsigned short)qr[d0][5]) * rstd * g1.y); w.w = cvtpk(bf2f((unsigned short)qr[d0][6]) * rstd * g1.z, bf2f((unsigned short)qr[d0][7]) * rstd * g1.w);
            qr[d0] = __builtin_bit_cast(bf16x8, w); asm volatile("" : "+v"(qr[d0])); }
        { const int pos = q0 + wid * 32 + r32; const float* tb = tab + (pos * 16 + hi * 8) * 2; const float* ga = qg + 64 + hi * 8; const float* gb = qg + 80 + hi * 8; float oa[8], ob[8];
#pragma unroll
          for (int j = 0; j < 8; ++j) { const float x1 = bf2f((unsigned short)qr[4][j]) * rstd * ga[j], x2 = bf2f((unsigned short)qr[5][j]) * rstd * gb[j]; const float c = tb[2 * j], sn = tb[2 * j + 1]; oa[j] = x1 * c - x2 * sn; ob[j] = x1 * sn + x2 * c; }
          u32x4 w; w.x = cvtpk(oa[0], oa[1]); w.y = cvtpk(oa[2], oa[3]); w.z = cvtpk(oa[4], oa[5]); w.w = cvtpk(oa[6], oa[7]); qr[4] = __builtin_bit_cast(bf16x8, w);
          w.x = cvtpk(ob[0], ob[1]); w.y = cvtpk(ob[2], ob[3]); w.z = cvtpk(ob[4], ob[5]); w.w = cvtpk(ob[6], ob[7]); qr[5] = __builtin_bit_cast(bf16x8, w); }
    }
    __builtin_amdgcn_sched_barrier(0);
    unsigned sel = 0xffffffffu;
    if (MOBA) {
        sel = 0u; float gate[8];
#pragma unroll
        for (int j = 0; j < 7; ++j) { float a = 0.f;
            if (j < qb) { const float* kj = km + j * 512 + hi * 8;
#pragma unroll
                for (int d0 = 0; d0 < ND0; ++d0) { const f32x4 k0 = *(const f32x4*)(kj + d0 * 16), k1 = *(const f32x4*)(kj + d0 * 16 + 4);
                    a += bf2f((unsigned short)qr[d0][0]) * k0.x + bf2f((unsigned short)qr[d0][1]) * k0.y + bf2f((unsigned short)qr[d0][2]) * k0.z + bf2f((unsigned short)qr[d0][3]) * k0.w
                       + bf2f((unsigned short)qr[d0][4]) * k1.x + bf2f((unsigned short)qr[d0][5]) * k1.y + bf2f((unsigned short)qr[d0][6]) * k1.z + bf2f((unsigned short)qr[d0][7]) * k1.w; } }
            a = swap_sum(a); gate[j] = (j < qb) ? a : -INFINITY; }
        gate[7] = -INFINITY;
#pragma unroll
        for (int r = 0; r < 3; ++r) { int best = -1; float bv = -INFINITY;
#pragma unroll
            for (int j = 0; j < 8; ++j) if (!((sel >> j) & 1u) && gate[j] > bv) { bv = gate[j]; best = j; }
            if (best >= 0) sel |= 1u << best; }
    }
    __builtin_amdgcn_sched_barrier(0);
    float mhat = 0.f, l = 0.f; f32x16 o[2]; o[0] = f32x16{}; o[1] = f32x16{};
    const int qrel = wid * 32 + r32;
    const int vbl = ((lane >> 4) & 1) * 32 + (lane & 3) * 8 + (4 * hi + ((lane & 15) >> 2)) * 64;
#define AT_GROUP(u) do { asm volatile("s_waitcnt vmcnt(0) lgkmcnt(0)\n\ts_barrier" ::: "memory"); \
        if ((u) + G < NT) { _Pragma("unroll") for (int i_ = 0; i_ < G; ++i_) { const int tt_ = (u) + G + i_; AT_DMA(tt_, tt_ % NSLOT); } } } while (0)
#define AT_KLOAD(sl) do { const AT_LAS unsigned char* kb = lds + (sl) * SLOTB + hi * 1024 + r32 * 16; \
        _Pragma("unroll") for (int d0 = 0; d0 < ND0; ++d0) { kf[2 * d0] = *(const AT_LAS bf16x8*)(kb + d0 * 2048); kf[2 * d0 + 1] = *(const AT_LAS bf16x8*)(kb + d0 * 2048 + 512); } } while (0)
    bf16x8 kf[2 * ND0]; s16x4 vlo[8], vhi[8];
    AT_GROUP(0);
    AT_KLOAD(0);
    int slot = 0;
    for (int t = 0; t < NT; ++t) {
        __builtin_amdgcn_sched_barrier(0);
        { const AT_LAS unsigned char* vp = lds + slot * SLOTB + NKP * 1024 + vbl;
#pragma unroll
          for (int i = 0; i < 8; ++i) { vlo[i] = vtr(vp + (i >> 2) * 4096 + (i & 3) * 1024); vhi[i] = vtr(vp + (i >> 2) * 4096 + (i & 3) * 1024 + 512); } }
        __builtin_amdgcn_sched_barrier(0);
        f32x16 p0, p1;
#pragma unroll
        for (int d0 = 0; d0 < ND0; ++d0) {
            if (d0 == 0) { p0 = __builtin_amdgcn_mfma_f32_32x32x16_bf16(kf[0], qr[0], f32x16{}, 0, 0, 0); p1 = __builtin_amdgcn_mfma_f32_32x32x16_bf16(kf[1], qr[0], f32x16{}, 0, 0, 0); }
            else { p0 = __builtin_amdgcn_mfma_f32_32x32x16_bf16(kf[2 * d0], qr[d0], p0, 0, 0, 0); p1 = __builtin_amdgcn_mfma_f32_32x32x16_bf16(kf[2 * d0 + 1], qr[d0], p1, 0, 0, 0); } }
        __builtin_amdgcn_sched_barrier(0);
        const int nslot = (slot == NSLOT - 1) ? 0 : slot + 1;
        if (t + 1 < NT) { if (((t + 1) % G) == 0) AT_GROUP(t + 1); AT_KLOAD(nslot); }
        __builtin_amdgcn_sched_barrier(0);
        const int jb = t - (NT - 4);
        if (jb >= 0) { const int kb0 = 64 * jb + 4 * hi;
#pragma unroll
            for (int r = 0; r < 16; ++r) { const int kv = kb0 + (r & 3) + 8 * (r >> 2); if (kv > qrel) p0[r] = NEGM; if (kv + 32 > qrel) p1[r] = NEGM; } }
        else if (MOBA) { const bool keep = ((sel >> (t >> 2)) & 1u) != 0u;
            if (!__all(keep)) { if (!keep) {
#pragma unroll
                for (int r = 0; r < 16; ++r) { p0[r] = NEGM; p1[r] = NEGM; } } } }
        float rm;
        { float a_ = fmaxf(fmaxf(p0[0], p0[1]), p1[0]), b_ = fmaxf(fmaxf(p0[2], p0[3]), p1[1]); a_ = fmaxf(fmaxf(a_, p1[2]), p1[3]);
#pragma unroll
          for (int r = 4; r < 16; r += 4) { a_ = fmaxf(fmaxf(a_, p0[r]), p0[r + 1]); b_ = fmaxf(fmaxf(b_, p0[r + 2]), p0[r + 3]); a_ = fmaxf(fmaxf(a_, p1[r]), p1[r + 1]); b_ = fmaxf(fmaxf(b_, p1[r + 2]), p1[r + 3]); }
          rm = swap_max(fmaxf(a_, b_)) - mhat; }
        if (__any(rm > THR)) {
            const float dl = fmaxf(rm, 0.f); mhat += dl;
            const float alpha = __builtin_amdgcn_exp2f(-dl); l *= alpha;
            if (hi == 0) wsf[r32] = alpha;
            asm volatile("s_waitcnt lgkmcnt(0)" ::: "memory");
#pragma unroll
            for (int r = 0; r < 16; ++r) { const float f = wsf[crow(r, hi)]; o[0][r] *= f; o[1][r] *= f; }
        }
        float sacc = 0.f;
#pragma unroll
        for (int r = 0; r < 16; ++r) { p0[r] = __builtin_amdgcn_exp2f(p0[r] - mhat); p1[r] = __builtin_amdgcn_exp2f(p1[r] - mhat); sacc += p0[r] + p1[r]; }
        l += sacc;
        u32x4 pw[4];
        pw[0] = (u32x4){cvtpk(p0[0], p0[1]), cvtpk(p0[2], p0[3]), cvtpk(p0[4], p0[5]), cvtpk(p0[6], p0[7])};
        pw[1] = (u32x4){cvtpk(p0[8], p0[9]), cvtpk(p0[10], p0[11]), cvtpk(p0[12], p0[13]), cvtpk(p0[14], p0[15])};
        pw[2] = (u32x4){cvtpk(p1[0], p1[1]), cvtpk(p1[2], p1[3]), cvtpk(p1[4], p1[5]), cvtpk(p1[6], p1[7])};
        pw[3] = (u32x4){cvtpk(p1[8], p1[9]), cvtpk(p1[10], p1[11]), cvtpk(p1[12], p1[13]), cvtpk(p1[14], p1[15])};
        __builtin_amdgcn_sched_barrier(0);
#pragma unroll
        for (int d0 = 0; d0 < 2; ++d0)
#pragma unroll
            for (int ks = 0; ks < 4; ++ks) { const int i = d0 * 4 + ks;
                o[d0] = __builtin_amdgcn_mfma_f32_32x32x16_bf16(__builtin_bit_cast(bf16x8, pw[ks]), (bf16x8){vlo[i][0], vlo[i][1], vlo[i][2], vlo[i][3], vhi[i][0], vhi[i][1], vhi[i][2], vhi[i][3]}, o[d0], 0, 0, 0); }
        slot = nslot;
    }
#undef AT_GROUP
#undef AT_KLOAD
#undef AT_DMA
    asm volatile("s_waitcnt lgkmcnt(0)\n\ts_barrier" ::: "memory");
    l = swap_sum(l);
    if (hi == 0) wsf[32 + r32] = l;
    asm volatile("s_waitcnt lgkmcnt(0)" ::: "memory");
    float rli[16];
#pragma unroll
    for (int r = 0; r < 16; ++r) rli[r] = __builtin_amdgcn_rcpf(wsf[32 + crow(r, hi)]);
    unsigned short* Ow = T.O + (rowbase + q0 + wid * 32) * T.po;
    { AT_LAS unsigned short* stg = (AT_LAS unsigned short*)(lds + LDS_OST) + wid * 2048;
#pragma unroll
      for (int r = 0; r < 16; ++r) { const int orow = crow(r, hi);
#pragma unroll
          for (int d0 = 0; d0 < 2; ++d0) stg[orow * 64 + d0 * 32 + r32] = (unsigned short)f2bf(o[d0][r] * rli[r]); }
      asm volatile("s_waitcnt lgkmcnt(0)" ::: "memory");
#pragma unroll
      for (int i = 0; i < 4; ++i) { const int row = i * 8 + (lane >> 3), ch = lane & 7; const u32x4 v = *(const AT_LAS u32x4*)(stg + row * 64 + ch * 8); *(u32x4*)(Ow + (long)row * T.po + ch * 8) = v; } }
    asm volatile("s_waitcnt lgkmcnt(0)\n\ts_barrier" ::: "memory");
}
template <int DQ, bool MOBA, bool QNORM, int G>
__device__ __forceinline__ void attn_unit_p(AT_LAS unsigned char* lds, const Tensors& T, long rowbase, int qb, const float* km, const float* qg, const float* tab, float kbound, int tbase, bool prefetched, bool has_next) {
    constexpr int NKP = DQ / 8, NP = NKP + 8, SLOTB = NKP * 1024 + 8192, ND0 = DQ / 16;
    constexpr int NSLOT = 3 * G, LDS_WS = NSLOT * SLOTB, LDS_OST = LDS_WS + 2048;
    int tid_ = threadIdx.x; asm volatile("" : "+v"(tid_));
    const int tid = tid_, lane = tid & 63, r32 = lane & 31, hi = lane >> 5; const int wid = __builtin_amdgcn_readfirstlane(tid >> 6);
    const int q0 = qb * 256, NT = 4 * (qb + 1);
    const unsigned lds0 = (unsigned)(size_t)lds;
    AT_LAS float* wsf = (AT_LAS float*)(lds + LDS_WS) + wid * 64;
    asm volatile("s_waitcnt vmcnt(0)" ::: "memory");
    unsigned soff[3], dsto[3];
#pragma unroll
    for (int k = 0; k < 3; ++k) { const int pi = wid + 8 * k;
        if (pi < NKP) { soff[k] = (T.pk == 0) ? (unsigned)(pi * 512 + lane * 8) : (unsigned)((rowbase + lane) * T.pk + 8 * pi); dsto[k] = pi * 1024; }
        else { const int v = pi - NKP; soff[k] = (T.pv == 0) ? (unsigned)(v * 512 + lane * 8) : (unsigned)((rowbase + 16 * (v & 3) + (lane >> 2)) * T.pv + 32 * (v >> 2) + 8 * (lane & 3)); dsto[k] = NKP * 1024 + v * 1024; } }
    const unsigned kstep = (T.pk == 0) ? (unsigned)NKP * 512u : 64u * (unsigned)T.pk, vstep = (T.pv == 0) ? 4096u : 64u * (unsigned)T.pv;
#define AT_DMA(t, slot) do { _Pragma("unroll") for (int k_ = 0; k_ < 3; ++k_) { const int pi_ = wid + 8 * k_; if (pi_ < NP) { \
        const unsigned short* s_ = ((pi_ < NKP) ? T.K : T.V) + (size_t)(soff[k_] + (unsigned)(t) * ((pi_ < NKP) ? kstep : vstep)); glds16(s_, (unsigned)__builtin_amdgcn_readfirstlane(lds0 + (slot) * SLOTB + dsto[k_])); } } } while (0)
    if (!prefetched) { _Pragma("unroll") for (int i_ = 0; i_ < G; ++i_) AT_DMA(i_, (tbase + i_) % NSLOT); }
    __builtin_amdgcn_sched_barrier(0);
    bf16x8 qr[ND0];
    { const unsigned short* Qw = T.Q + (rowbase + q0 + wid * 32 + r32) * T.pq + hi * 8;
#pragma unroll
      for (int d0 = 0; d0 < ND0; ++d0) qr[d0] = *(const bf16x8*)(Qw + d0 * 16); }
    __builtin_amdgcn_sched_barrier(0);
    if constexpr (QNORM) {
        float s = 0.f;
#pragma unroll
        for (int d0 = 0; d0 < ND0; ++d0)
#pragma unroll
            for (int j = 0; j < 8; ++j) { const float x = bf2f((unsigned short)qr[d0][j]); s += x * x; }
        s = swap_sum(s);
        const float rstd = 0.14724445073472677f / sqrtf(s * (1.f / 96.f) + 1e-6f);
#pragma unroll
        for (int d0 = 0; d0 < 4; ++d0) { const f32x4 g0 = *(const f32x4*)(qg + d0 * 16 + hi * 8), g1 = *(const f32x4*)(qg + d0 * 16 + hi * 8 + 4); u32x4 w;
            w.x = cvtpk(bf2f((unsigned short)qr[d0][0]) * rstd * g0.x, bf2f((unsigned short)qr[d0][1]) * rstd * g0.y); w.y = cvtpk(bf2f((unsigned short)qr[d0][2]) * rstd * g0.z, bf2f((unsigned short)qr[d0][3]) * rstd * g0.w);
            w.z = cvtpk(bf2f((unsigned short)qr[d0][4]) * rstd * g1.x, bf2f((unsigned short)qr[d0][5]) * rstd * g1.y); w.w = cvtpk(bf2f((unsigned short)qr[d0][6]) * rstd * g1.z, bf2f((unsigned short)qr[d0][7]) * rstd * g1.w);
            qr[d0] = __builtin_bit_cast(bf16x8, w); asm volatile("" : "+v"(qr[d0])); }
        { const int pos = q0 + wid * 32 + r32; const float* tb = tab + (pos * 16 + hi * 8) * 2; const float* ga = qg + 64 + hi * 8; const float* gb = qg + 80 + hi * 8; float oa[8], ob[8];
#pragma unroll
          for (int j = 0; j < 8; ++j) { const float x1 = bf2f((unsigned short)qr[4][j]) * rstd * ga[j], x2 = bf2f((unsigned short)qr[5][j]) * rstd * gb[j]; const float c = tb[2 * j], sn = tb[2 * j + 1]; oa[j] = x1 * c - x2 * sn; ob[j] = x1 * sn + x2 * c; }
          u32x4 w; w.x = cvtpk(oa[0], oa[1]); w.y = cvtpk(oa[2], oa[3]); w.z = cvtpk(oa[4], oa[5]); w.w = cvtpk(oa[6], oa[7]); qr[4] = __builtin_bit_cast(bf16x8, w);
          w.x = cvtpk(ob[0], ob[1]); w.y = cvtpk(ob[2], ob[3]); w.z = cvtpk(ob[4], ob[5]); w.w = cvtpk(ob[6], ob[7]); qr[5] = __builtin_bit_cast(bf16x8, w); }
    }
    __builtin_amdgcn_sched_barrier(0);
    unsigned sel = 0xffffffffu;
    if (MOBA) {
        sel = 0u; float gate[8];
#pragma unroll
        for (int j = 0; j < 7; ++j) { float a = 0.f;
            if (j < qb) { const float* kj = km + j * 512 + hi * 8;
#pragma unroll
                for (int d0 = 0; d0 < ND0; ++d0) { const f32x4 k0 = *(const f32x4*)(kj + d0 * 16), k1 = *(const f32x4*)(kj + d0 * 16 + 4);
                    a += bf2f((unsigned short)qr[d0][0]) * k0.x + bf2f((unsigned short)qr[d0][1]) * k0.y + bf2f((unsigned short)qr[d0][2]) * k0.z + bf2f((unsigned short)qr[d0][3]) * k0.w
                       + bf2f((unsigned short)qr[d0][4]) * k1.x + bf2f((unsigned short)qr[d0][5]) * k1.y + bf2f((unsigned short)qr[d0][6]) * k1.z + bf2f((unsigned short)qr[d0][7]) * k1.w; } }
            a = swap_sum(a); gate[j] = (j < qb) ? a : -INFINITY; }
        gate[7] = -INFINITY;
#pragma unroll
        for (int r = 0; r < 3; ++r) { int best = -1; float bv = -INFINITY;
#pragma unroll
            for (int j = 0; j < 8; ++j) if (!((sel >> j) & 1u) && gate[j] > bv) { bv = gate[j]; best = j; }
            if (best >= 0) sel |= 1u << best; }
    }
    __builtin_amdgcn_sched_barrier(0);
    float l = 0.f; f32x16 o[2]; o[0] = f32x16{}; o[1] = f32x16{};
    f32x16 negm;
    { float qss = 0.f;
#pragma unroll
      for (int d0 = 0; d0 < ND0; ++d0)
#pragma unroll
          for (int j = 0; j < 8; ++j) { const float x = bf2f((unsigned short)qr[d0][j]); qss += x * x; }
      qss = swap_sum(qss); const float mrow = sqrtf(qss) * kbound;
#pragma unroll
      for (int r = 0; r < 16; ++r) negm[r] = -mrow;
      asm volatile("" : "+v"(negm)); }

    const int qrel = wid * 32 + r32;
    const int vbl = ((lane >> 4) & 1) * 32 + (lane & 3) * 8 + (4 * hi + ((lane & 15) >> 2)) * 64;
#define AT_GROUP(u) do { asm volatile("s_waitcnt vmcnt(0) lgkmcnt(0)\n\ts_barrier" ::: "memory"); \
        if ((u) + G < NT) { _Pragma("unroll") for (int i_ = 0; i_ < G; ++i_) { const int tt_ = (u) + G + i_; AT_DMA(tt_, (tbase + tt_) % NSLOT); } } \
        else if (has_next) { _Pragma("unroll") for (int i_ = 0; i_ < G; ++i_) AT_DMA(i_, (tbase + NT + i_) % NSLOT); } } while (0)
#define AT_KLOAD(sl) do { const AT_LAS unsigned char* kb = lds + (sl) * SLOTB + hi * 1024 + r32 * 16; \
        _Pragma("unroll") for (int d0 = 0; d0 < ND0; ++d0) { kf[2 * d0] = *(const AT_LAS bf16x8*)(kb + d0 * 2048); kf[2 * d0 + 1] = *(const AT_LAS bf16x8*)(kb + d0 * 2048 + 512); } } while (0)
#define AT_VLOAD(sl) do { const AT_LAS unsigned char* vp = lds + (sl) * SLOTB + NKP * 1024 + vbl; \
        _Pragma("unroll") for (int i = 0; i < 8; ++i) { vlo[i] = vtr(vp + (i >> 2) * 4096 + (i & 3) * 1024); vhi[i] = vtr(vp + (i >> 2) * 4096 + (i & 3) * 1024 + 512); } } while (0)
#define AT_SUMPACK() do { float sacc = 0.f; \
        _Pragma("unroll") for (int r = 0; r < 16; ++r) sacc += c0[r] + c1[r]; \
        l += sacc; \
        pw[0] = (u32x4){cvtpk(c0[0], c0[1]), cvtpk(c0[2], c0[3]), cvtpk(c0[4], c0[5]), cvtpk(c0[6], c0[7])}; \
        pw[1] = (u32x4){cvtpk(c0[8], c0[9]), cvtpk(c0[10], c0[11]), cvtpk(c0[12], c0[13]), cvtpk(c0[14], c0[15])}; \
        pw[2] = (u32x4){cvtpk(c1[0], c1[1]), cvtpk(c1[2], c1[3]), cvtpk(c1[4], c1[5]), cvtpk(c1[6], c1[7])}; \
        pw[3] = (u32x4){cvtpk(c1[8], c1[9]), cvtpk(c1[10], c1[11]), cvtpk(c1[12], c1[13]), cvtpk(c1[14], c1[15])}; } while (0)
#define AT_QKT(N0, N1) do { _Pragma("unroll") for (int d0 = 0; d0 < ND0; ++d0) { \
            if (d0 == 0) { N0 = __builtin_amdgcn_mfma_f32_32x32x16_bf16(kf[0], qr[0], negm, 0, 0, 0); N1 = __builtin_amdgcn_mfma_f32_32x32x16_bf16(kf[1], qr[0], negm, 0, 0, 0); } \
            else { N0 = __builtin_amdgcn_mfma_f32_32x32x16_bf16(kf[2 * d0], qr[d0], N0, 0, 0, 0); N1 = __builtin_amdgcn_mfma_f32_32x32x16_bf16(kf[2 * d0 + 1], qr[d0], N1, 0, 0, 0); } } } while (0)
#define AT_DECIDE(tt) do { \
        { const int jb = (tt) - (NT - 4); \
          if (jb >= 0) { const int kb0 = 64 * jb + 4 * hi; \
              _Pragma("unroll") for (int r = 0; r < 16; ++r) { const int kv = kb0 + (r & 3) + 8 * (r >> 2); if (kv > qrel) c0[r] = NEGM; if (kv + 32 > qrel) c1[r] = NEGM; } } \
          else if (MOBA) { const bool keep = ((sel >> ((tt) >> 2)) & 1u) != 0u; \
              if (!__all(keep)) { if (!keep) { _Pragma("unroll") for (int r = 0; r < 16; ++r) { c0[r] = NEGM; c1[r] = NEGM; } } } } } \
        if ((tt) + 1 < NT && (((tt) + 1) % G) == 0) AT_GROUP((tt) + 1); } while (0)
#define AT_EXPS() do { _Pragma("unroll") for (int r = 0; r < 16; ++r) { c0[r] = __builtin_amdgcn_exp2f(c0[r]); c1[r] = __builtin_amdgcn_exp2f(c1[r]); } } while (0)
#define AT_PV() do { _Pragma("unroll") for (int d0 = 0; d0 < 2; ++d0) _Pragma("unroll") for (int ks = 0; ks < 4; ++ks) { const int i = d0 * 4 + ks; \
            o[d0] = __builtin_amdgcn_mfma_f32_32x32x16_bf16(__builtin_bit_cast(bf16x8, pw[ks]), (bf16x8){vlo[i][0], vlo[i][1], vlo[i][2], vlo[i][3], vhi[i][0], vhi[i][1], vhi[i][2], vhi[i][3]}, o[d0], 0, 0, 0); } } while (0)
#define AT_SGB(mask, n) __builtin_amdgcn_sched_group_barrier(mask, n, 0)
    constexpr int NG = 2 * ND0;
    bf16x8 kf[2 * ND0]; s16x4 vlo[8], vhi[8]; u32x4 pw[4]; f32x16 c0, c1;
    AT_GROUP(0);
    AT_KLOAD(tbase % NSLOT);
    AT_QKT(c0, c1);
    AT_DECIDE(0);
    AT_KLOAD((tbase + 1) % NSLOT);
    AT_EXPS();
    int slot = (tbase + 1) % NSLOT, pslot = tbase % NSLOT;
    for (int t = 1; t < NT; ++t) {
        const int nslot = (t + 1 < NT) ? ((slot == NSLOT - 1) ? 0 : slot + 1) : slot;
        __builtin_amdgcn_sched_barrier(0);
        { f32x16 n0, n1; float sacc = 0.f;
          const AT_LAS unsigned char* vp = lds + pslot * SLOTB + NKP * 1024 + vbl;
#pragma unroll
          for (int i = 0; i < NG; ++i) {
              if (i >= NG - 2) { const int vi = i - (NG - 2); vlo[vi] = vtr(vp + (vi >> 2) * 4096 + (vi & 3) * 1024); vhi[vi] = vtr(vp + (vi >> 2) * 4096 + (vi & 3) * 1024 + 512); }
              const int d0 = i >> 1;
              if (i & 1) n1 = (d0 == 0) ? __builtin_amdgcn_mfma_f32_32x32x16_bf16(kf[i], qr[d0], negm, 0, 0, 0) : __builtin_amdgcn_mfma_f32_32x32x16_bf16(kf[i], qr[d0], n1, 0, 0, 0);
              else n0 = (d0 == 0) ? __builtin_amdgcn_mfma_f32_32x32x16_bf16(kf[i], qr[d0], negm, 0, 0, 0) : __builtin_amdgcn_mfma_f32_32x32x16_bf16(kf[i], qr[d0], n0, 0, 0, 0);
#pragma unroll
              for (int rr = (i * 32) / NG; rr < ((i + 1) * 32) / NG; ++rr) sacc += (rr < 16) ? c0[rr] : c1[rr - 16];
#pragma unroll
              for (int ww = (i * 16) / NG; ww < ((i + 1) * 16) / NG; ++ww) { const int e = 2 * ww; pw[ww >> 2][ww & 3] = (e < 16) ? cvtpk(c0[e], c0[e + 1]) : cvtpk(c1[e - 16], c1[e - 15]); }
              __builtin_amdgcn_sched_barrier(0); }
          l += sacc; c0 = n0; c1 = n1; }
        AT_DECIDE(t);
        __builtin_amdgcn_sched_barrier(0);
        { const AT_LAS unsigned char* kb = lds + nslot * SLOTB + hi * 1024 + r32 * 16; const AT_LAS unsigned char* vpB = lds + pslot * SLOTB + NKP * 1024 + vbl;
#pragma unroll
          for (int i = 0; i < 8; ++i) {
              if (i + 2 < 8) { const int vi = i + 2; vlo[vi] = vtr(vpB + (vi >> 2) * 4096 + (vi & 3) * 1024); vhi[vi] = vtr(vpB + (vi >> 2) * 4096 + (vi & 3) * 1024 + 512); }
              if (i >= 2 && i < 6) {
#pragma unroll
                  for (int q = (i - 2) * NG / 4; q < (i - 1) * NG / 4; ++q) kf[q] = *(const AT_LAS bf16x8*)(kb + (q >> 1) * 2048 + (q & 1) * 512); }
              o[i >> 2] = __builtin_amdgcn_mfma_f32_32x32x16_bf16(__builtin_bit_cast(bf16x8, pw[i & 3]), (bf16x8){vlo[i][0], vlo[i][1], vlo[i][2], vlo[i][3], vhi[i][0], vhi[i][1], vhi[i][2], vhi[i][3]}, o[i >> 2], 0, 0, 0);
#pragma unroll
              for (int rr = 4 * i; rr < 4 * i + 4; ++rr) { if (rr < 16) c0[rr] = __builtin_amdgcn_exp2f(c0[rr]); else c1[rr - 16] = __builtin_amdgcn_exp2f(c1[rr - 16]); }
              __builtin_amdgcn_sched_barrier(0); } }
        pslot = slot; slot = nslot;
    }
    AT_VLOAD(pslot);
    AT_SUMPACK();
    AT_PV();
#undef AT_GROUP
#undef AT_KLOAD
#undef AT_VLOAD
#undef AT_SUMPACK
#undef AT_QKT
#undef AT_DECIDE
#undef AT_EXPS
#undef AT_PV
#undef AT_SGB
#undef AT_DMA
    asm volatile("s_waitcnt lgkmcnt(0)\n\ts_barrier" ::: "memory");
    l = swap_sum(l);
    if (hi == 0) wsf[32 + r32] = l;
    asm volatile("s_waitcnt lgkmcnt(0)" ::: "memory");
    float rli[16];
#pragma unroll
    for (int r = 0; r < 16; ++r) rli[r] = __builtin_amdgcn_rcpf(wsf[32 + crow(r, hi)]);
    unsigned short* Ow = T.O + (rowbase + q0 + wid * 32) * T.po;
    { AT_LAS unsigned short* stg = (AT_LAS unsigned short*)(lds + LDS_OST) + wid * 2048;
#pragma unroll
      for (int r = 0; r < 16; ++r) { const int orow = crow(r, hi);
#pragma unroll
          for (int d0 = 0; d0 < 2; ++d0) stg[orow * 64 + d0 * 32 + r32] = (unsigned short)f2bf(o[d0][r] * rli[r]); }
      asm volatile("s_waitcnt lgkmcnt(0)" ::: "memory");
#pragma unroll
      for (int i = 0; i < 4; ++i) { const int row = i * 8 + (lane >> 3), ch = lane & 7; const u32x4 v = *(const AT_LAS u32x4*)(stg + row * 64 + ch * 8); *(u32x4*)(Ow + (long)row * T.po + ch * 8) = v; } }
    asm volatile("s_waitcnt lgkmcnt(0)\n\ts_barrier" ::: "memory");
}
#undef AT_LAS
}

namespace ssd {
typedef short bf16x8 __attribute__((ext_vector_type(8)));
typedef short v4i16_t __attribute__((ext_vector_type(4)));
typedef float f32x16 __attribute__((ext_vector_type(16)));
typedef unsigned u32x4 __attribute__((ext_vector_type(4)));
#define SS_LAS __attribute__((address_space(3)))
__device__ __forceinline__ int crow(int r, int hi) { return (r & 3) + 8 * (r >> 2) + 4 * hi; }
__device__ __forceinline__ v4i16_t vtr(const SS_LAS unsigned char* p) { return __builtin_amdgcn_ds_read_tr16_b64_v4i16((SS_LAS v4i16_t*)p); }
__device__ __forceinline__ bf16x8 tr_frag(const SS_LAS unsigned char* img, int pitch, int k0, int c0, int lane) {
    const int g4 = lane >> 4, q = (lane & 15) >> 2, p4 = lane & 3;
    const SS_LAS unsigned char* a = img + (k0 + 8 * (g4 >> 1) + q) * pitch + (c0 + 16 * (g4 & 1) + 4 * p4) * 2;
    const v4i16_t lo = vtr(a), hi4 = vtr(a + 4 * pitch);
    return (bf16x8){lo[0], lo[1], lo[2], lo[3], hi4[0], hi4[1], hi4[2], hi4[3]};
}
__device__ __forceinline__ bf16x8 row_frag(const SS_LAS unsigned char* img, int pitch, int r0, int k0, int lane) {
    return *(const SS_LAS bf16x8*)(img + (r0 + (lane & 31)) * pitch + (k0 + 8 * (lane >> 5)) * 2);
}

constexpr int PX4 = 576;
constexpr int PB_T = 320;
constexpr int PR = 272;
constexpr int PX1 = 192;

__device__ __forceinline__ void dt_cs(int t0, int g, const float* DTR, const float* dtb, const float* alog, SS_LAS float* csl, SS_LAS float* dtl, SS_LAS float* wtot, int tid, int lane, int wid) {
    const int l = tid >> 2, hh = tid & 3, h = 4 * g + hh;
    const float r = DTR[(size_t)(t0 + l) * 8 + h] + dtb[h]; const float ex = __expf(fminf(r, 20.f)); const float dt = (r > 20.f) ? r : ((ex < 0.01f) ? ex * (1.f - ex * (0.5f - ex * 0.33333333f)) : __logf(1.f + ex));
    float v = dt * (-expf(alog[h]));
#pragma unroll
    for (int off = 4; off < 64; off <<= 1) { const float t = __shfl_up(v, off); if (lane >= off) v += t; }
    if (lane >= 60) wtot[wid * 4 + hh] = v;
    __syncthreads();
    float base = 0.f;
    for (int w = 0; w < wid; ++w) base += wtot[w * 4 + hh];
    csl[tid] = v + base; dtl[tid] = dt;
    __syncthreads();
}
__device__ __forceinline__ void conv_load(u32x4 (&x)[19], const unsigned short* raw, int t0, int l0, int col) {
    const int pos0 = t0 & 2047;
#pragma unroll
    for (int i = 0; i < 19; ++i) { const int l = l0 - 3 + i; x[i] = (u32x4){0u, 0u, 0u, 0u}; if (pos0 + l >= 0) x[i] = *(const u32x4*)(raw + (size_t)(t0 + l) * 1024 + col); }
}
template <bool SCALED> __device__ __forceinline__ void conv_compute(const u32x4 (&x)[19], int l0, int col, const float* cw, const float* cb, SS_LAS unsigned char* img, int pitch, const SS_LAS float* sc) {
    float w[4][8], b[8];
#pragma unroll
    for (int k = 0; k < 4; ++k) { const f32x4 a = *(const f32x4*)(cw + k * 1024 + col), c = *(const f32x4*)(cw + k * 1024 + col + 4); w[k][0] = a.x; w[k][1] = a.y; w[k][2] = a.z; w[k][3] = a.w; w[k][4] = c.x; w[k][5] = c.y; w[k][6] = c.z; w[k][7] = c.w; }
    { const f32x4 a = *(const f32x4*)(cb + col), c = *(const f32x4*)(cb + col + 4); b[0] = a.x; b[1] = a.y; b[2] = a.z; b[3] = a.w; b[4] = c.x; b[5] = c.y; b[6] = c.z; b[7] = c.w; }
#pragma unroll
    for (int i = 0; i < 16; ++i) { const int l = l0 + i; float o[8]; const float s = SCALED ? sc[l * 4] : 1.f;
#pragma unroll
        for (int j = 0; j < 8; ++j) { float a = b[j];
#pragma unroll
            for (int k = 0; k < 4; ++k) { const unsigned wd = (j < 2) ? x[i + k].x : (j < 4) ? x[i + k].y : (j < 6) ? x[i + k].z : x[i + k].w; a += w[k][j] * ((j & 1) ? bfhi(wd) : bflo(wd)); }
            o[j] = a * __builtin_amdgcn_rcpf(1.f + __expf(-a)) * s; }
        u32x4 p; p.x = pk2(o[0], o[1]); p.y = pk2(o[2], o[3]); p.z = pk2(o[4], o[5]); p.w = pk2(o[6], o[7]);
        *(SS_LAS u32x4*)(img + l * pitch) = p; }
}

__device__ __forceinline__ void states_unit(SS_LAS unsigned char* lds, int bc, int g, const unsigned short* XBC, const float* DTR, const float* cw, const float* cb, const float* dtb, const float* alog, float* ST, float* CEND) {
    int tid_ = threadIdx.x; asm volatile("" : "+v"(tid_));
    const int tid = tid_, lane = tid & 63, r32 = lane & 31, hi = lane >> 5; const int wid = __builtin_amdgcn_readfirstlane(tid >> 6);
    const int t0 = bc * 128;
    SS_LAS unsigned char* XD = lds; SS_LAS unsigned char* BI = lds + 128 * PX4;
    SS_LAS float* csl = (SS_LAS float*)(lds + 128 * PX4 + 128 * PB_T); SS_LAS float* dtl = csl + 512; SS_LAS float* wtot = dtl + 512; SS_LAS float* scl = wtot + 32;
    const int ch = tid % 48, l0 = (tid / 48) * 16; const int col = (ch < 32) ? g * 256 + ch * 8 : 512 + g * 128 + (ch - 32) * 8;
    u32x4 xr[19];
    if (tid < 384) conv_load(xr, XBC, t0, l0, col);
    dt_cs(t0, g, DTR, dtb, alog, csl, dtl, wtot, tid, lane, wid);
    scl[tid] = dtl[tid] * __expf(csl[508 + (tid & 3)] - csl[tid]);
    if (tid < 4) CEND[bc * 8 + g * 4 + tid] = csl[508 + tid];
    __syncthreads();
    if (tid < 384) {
        if (ch < 32) conv_compute<true>(xr, l0, col, cw, cb, XD + ch * 16, PX4, scl + (ch >> 3));
        else conv_compute<false>(xr, l0, col, cw, cb, BI + (ch - 32) * 16, PB_T, nullptr); }
    __syncthreads();
    const int pt = wid >> 2, nt = wid & 3;
#pragma unroll 1
    for (int hh = 0; hh < 4; ++hh) {
        f32x16 acc = f32x16{};
#pragma unroll
        for (int ks = 0; ks < 8; ++ks) {
            const bf16x8 a = tr_frag(XD, PX4, 16 * ks, hh * 64 + 32 * pt, lane);
            const bf16x8 b = tr_frag(BI, PB_T, 16 * ks, 32 * nt, lane);
            acc = __builtin_amdgcn_mfma_f32_32x32x16_bf16(a, b, acc, 0, 0, 0); }
        float* o = ST + (((size_t)(bc * 8 + g * 4 + hh) * 64 + 32 * pt) << 7) + 32 * nt + r32;
#pragma unroll
        for (int r = 0; r < 16; ++r) o[(size_t)crow(r, hi) << 7] = acc[r];
    }
    __syncthreads();
}

__device__ __forceinline__ void out_unit(SS_LAS unsigned char* lds, int bc, int g, const unsigned short* XBC, const unsigned short* VZ, const float* DTR, const float* cw, const float* cb, const float* dtb, const float* alog,
                                         const unsigned short* HIN, const float* Dsk, const float* gn, unsigned short* MIX) {
    int tid_ = threadIdx.x; asm volatile("" : "+v"(tid_));
    const int tid = tid_, lane = tid & 63, r32 = lane & 31, hi = lane >> 5; const int wid = __builtin_amdgcn_readfirstlane(tid >> 6);
    const int t0 = bc * 128;
    SS_LAS unsigned char* CI = lds; SS_LAS unsigned char* BI = lds + 128 * PR; SS_LAS unsigned char* XS = lds + 2 * 128 * PR;
    SS_LAS float* csl = (SS_LAS float*)(lds + 2 * 128 * PR + 128 * PX4); SS_LAS float* dtl = csl + 512; SS_LAS float* wtot = dtl + 512;
    const int ch = tid & 63, l0 = (tid >> 6) * 16; const int col = (ch < 32) ? g * 256 + ch * 8 : (ch < 48) ? 512 + g * 128 + (ch - 32) * 8 : 768 + g * 128 + (ch - 48) * 8;
    u32x4 xr[19];
    conv_load(xr, XBC, t0, l0, col);
    u32x4 zr[8];
    { const unsigned short* zp = VZ + (size_t)(t0 + (tid >> 2)) * 1024 + 512 + g * 256 + (tid & 3) * 64;
#pragma unroll
      for (int c = 0; c < 8; ++c) zr[c] = *(const u32x4*)(zp + c * 8); }
    dt_cs(t0, g, DTR, dtb, alog, csl, dtl, wtot, tid, lane, wid);
    if (ch < 32) conv_compute<false>(xr, l0, col, cw, cb, XS + ch * 16, PX4, nullptr);
    else if (ch < 48) conv_compute<false>(xr, l0, col, cw, cb, BI + (ch - 32) * 16, PR, nullptr);
    else conv_compute<false>(xr, l0, col, cw, cb, CI + (ch - 48) * 16, PR, nullptr);
    __syncthreads();
    const int lt = wid >> 1, st0 = 2 * (wid & 1), pt = wid & 1;
    f32x16 cb2[2]; cb2[0] = f32x16{}; cb2[1] = f32x16{};
#pragma unroll
    for (int ks = 0; ks < 8; ++ks) {
        const bf16x8 a = row_frag(CI, PR, 32 * lt, 16 * ks, lane);
        const bf16x8 b0 = row_frag(BI, PR, 32 * st0, 16 * ks, lane), b1 = row_frag(BI, PR, 32 * st0 + 32, 16 * ks, lane);
        cb2[0] = __builtin_amdgcn_mfma_f32_32x32x16_bf16(a, b0, cb2[0], 0, 0, 0);
        cb2[1] = __builtin_amdgcn_mfma_f32_32x32x16_bf16(a, b1, cb2[1], 0, 0, 0); }
    f32x16 yo[4];
    { bf16x8 hb[2][8];
      const unsigned short* hin0 = HIN + (((size_t)(bc * 8 + g * 4) * 64 + 32 * pt + r32) << 7) + 8 * hi;
#pragma unroll
      for (int ks = 0; ks < 8; ++ks) hb[0][ks] = *(const bf16x8*)(hin0 + 16 * ks);
#pragma unroll
      for (int hh = 0; hh < 4; ++hh) { yo[hh] = f32x16{};
          if (hh < 3) {
#pragma unroll
              for (int ks = 0; ks < 8; ++ks) hb[(hh + 1) & 1][ks] = *(const bf16x8*)(hin0 + ((size_t)(hh + 1) << 13) + 16 * ks); }
          __builtin_amdgcn_sched_barrier(0);
#pragma unroll
          for (int ks = 0; ks < 8; ++ks) yo[hh] = __builtin_amdgcn_mfma_f32_32x32x16_bf16(row_frag(CI, PR, 32 * lt, 16 * ks, lane), hb[hh & 1][ks], yo[hh], 0, 0, 0);
          __builtin_amdgcn_sched_barrier(0); } }
    __syncthreads();
    SS_LAS unsigned char* MI = BI;
#pragma unroll
    for (int hh = 0; hh < 4; ++hh) {
        const int h = g * 4 + hh;
#pragma unroll
        for (int j = 0; j < 2; ++j) { const int s = 32 * (st0 + j) + r32; const float css = csl[s * 4 + hh], dts = dtl[s * 4 + hh];
#pragma unroll
            for (int r = 0; r < 16; ++r) { const int l = 32 * lt + crow(r, hi); const float cl = csl[l * 4 + hh];
                float pr_ = cb2[j][r] * __builtin_amdgcn_exp2f(fminf(cl - css, 0.f) * 1.4426950408889634f) * dts; asm volatile("" : "+v"(pr_)); const float v = (s <= l) ? pr_ : 0.f;
                *(SS_LAS unsigned short*)(MI + l * PR + s * 2) = (unsigned short)f2bf(v); if ((r & 3) == 3) asm volatile("" ::: "memory"); } }
        __syncthreads();
        f32x16 yd = f32x16{};
#pragma unroll
        for (int ks = 0; ks < 8; ++ks) yd = __builtin_amdgcn_mfma_f32_32x32x16_bf16(row_frag(MI, PR, 32 * lt, 16 * ks, lane), tr_frag(XS, PX4, 16 * ks, hh * 64 + 32 * pt, lane), yd, 0, 0, 0);
        __syncthreads();
        const float dsk = Dsk[h]; const int p = 32 * pt + r32;
#pragma unroll
        for (int r = 0; r < 16; ++r) { const int l = 32 * lt + crow(r, hi);
            SS_LAS unsigned short* xp = (SS_LAS unsigned short*)(XS + l * PX4 + (hh * 64 + p) * 2);
            const float y = yd[r] + yo[hh][r] * __expf(csl[l * 4 + hh]) + dsk * bf2f(*xp);
            *xp = (unsigned short)f2bf(y); }
    }
    __syncthreads();
    { const int l = tid >> 2, q = tid & 3; const SS_LAS unsigned char* rowp = XS + l * PX4 + q * 128; float yv[8][8]; float s = 0.f;
#pragma unroll
      for (int c = 0; c < 8; ++c) { const u32x4 v = *(const SS_LAS u32x4*)(rowp + c * 16); const u32x4 z = zr[c];
          yv[c][0] = bflo(v.x) * silu_f(bflo(z.x)); yv[c][1] = bfhi(v.x) * silu_f(bfhi(z.x)); yv[c][2] = bflo(v.y) * silu_f(bflo(z.y)); yv[c][3] = bfhi(v.y) * silu_f(bfhi(z.y));
          yv[c][4] = bflo(v.z) * silu_f(bflo(z.z)); yv[c][5] = bfhi(v.z) * silu_f(bfhi(z.z)); yv[c][6] = bflo(v.w) * silu_f(bflo(z.w)); yv[c][7] = bfhi(v.w) * silu_f(bfhi(z.w));
#pragma unroll
          for (int j = 0; j < 8; ++j) s += yv[c][j] * yv[c][j]; }
      s += __shfl_xor(s, 1); s += __shfl_xor(s, 2);
      const float rstd = 1.f / sqrtf(s * (1.f / 256.f) + 1e-6f); const float* gq = gn + g * 256 + q * 64; unsigned short* op = MIX + (size_t)(t0 + l) * 1024 + 512 + g * 256 + q * 64;
#pragma unroll
      for (int c = 0; c < 8; ++c) { const f32x4 g0 = *(const f32x4*)(gq + c * 8), g1 = *(const f32x4*)(gq + c * 8 + 4); u32x4 o;
          o.x = pk2(yv[c][0] * rstd * g0.x, yv[c][1] * rstd * g0.y); o.y = pk2(yv[c][2] * rstd * g0.z, yv[c][3] * rstd * g0.w);
          o.z = pk2(yv[c][4] * rstd * g1.x, yv[c][5] * rstd * g1.y); o.w = pk2(yv[c][6] * rstd * g1.z, yv[c][7] * rstd * g1.w);
          *(u32x4*)(op + c * 8) = o; } }
    __syncthreads();
}
#undef SS_LAS
}

constexpr int NWAVES = 8, NTHR = 512;
constexpr int T_ = 32768, S_ = 2048, NB_ = 16, D_ = 1024;
constexpr int DFF = 2816, DFF2 = 5632;
constexpr float EPS = 1e-6f;
constexpr size_t MiB = 1u << 20;
constexpr size_t WS_CTL = 0, CTL_ZERO_BYTES = 3 * MiB;
constexpr size_t WS_SSQA = 1 * MiB, WS_SSQB = WS_SSQA + 256 * 1024, WS_SSQC = WS_SSQB + 256 * 1024, WS_SSQQ = WS_SSQC + 256 * 1024, WS_SSQKV = WS_SSQQ + 256 * 1024;
constexpr size_t WS_KMEAN = WS_SSQKV + 256 * 1024;
constexpr size_t WS_DTR = 55 * MiB;
constexpr size_t WS_W_IN0 = 3 * MiB;
constexpr size_t WS_W_OUT0 = WS_W_IN0 + 6656 * 1024;
constexpr size_t WS_W_IN1 = WS_W_OUT0 + 2 * MiB;
constexpr size_t WS_W_UQ = WS_W_IN1 + 2 * MiB;
constexpr size_t WS_W_UKV = WS_W_UQ + 1536 * 1024;
constexpr size_t WS_W_OUT1 = WS_W_UKV + 1 * MiB;
constexpr size_t WS_W_UP = WS_W_OUT1 + 2 * MiB;
constexpr size_t WS_W_DN = WS_W_UP + 22 * MiB;
constexpr size_t WS_TAB64 = 51 * MiB;
constexpr size_t WS_TAB32 = WS_TAB64 + 512 * 1024;
constexpr size_t WS_CWS = 52 * MiB;
constexpr size_t WS_DT = 53 * MiB;
constexpr size_t WS_CS = 54 * MiB;
constexpr size_t WS_XN = 56 * MiB;
constexpr size_t WS_BIG = 120 * MiB;
static_assert(WS_W_DN + 11 * MiB <= WS_TAB64, "weights fit");
constexpr size_t L0_QK = WS_BIG, L0_VZ = WS_BIG + 64 * MiB, L0_XBC = WS_BIG + 128 * MiB, L0_DTR = WS_BIG + 192 * MiB, L0_XBCA = WS_BIG + 256 * MiB, L0_MIX = WS_BIG + 320 * MiB;
constexpr size_t L0_ST = WS_BIG + 192 * MiB;
constexpr size_t L0_KC = WS_BIG + 288 * MiB;
constexpr size_t L0_HIN = WS_BIG + 256 * MiB;
constexpr size_t WS_CEND = 53 * MiB;
constexpr size_t L0_CB = L0_DTR;
constexpr size_t L0_YG = L0_QK;
constexpr size_t FF_ACT = WS_BIG + 64 * MiB, FF_UB = WS_BIG + 240 * MiB;
constexpr size_t L1_C1 = WS_BIG, L1_QR = WS_BIG + 64 * MiB, L1_V2 = WS_BIG + 160 * MiB;
constexpr size_t WS_RG = WS_BIG + 384 * MiB;
constexpr size_t WS_SSQPE = 53 * MiB + 64 * 1024;
constexpr size_t L1_K2 = WS_BIG + 288 * MiB;
constexpr size_t L1_O = WS_BIG + 224 * MiB;
constexpr size_t WS_END = 512 * MiB;
constexpr int CW_BAR = 4096;

constexpr int RING_OFF = 0, RING_BYTES = 162816;
constexpr int LDSCTL_OFF = RING_BYTES, MISC_OFF = LDSCTL_OFF + 320;
constexpr int LDS_BYTES = 163840;

struct Args { const float* in[25]; float* out; unsigned char* ws; int ph_lo, ph_hi; };
typedef const __attribute__((address_space(4))) Args* KArgs;
__device__ __forceinline__ KArgs kargs() { KArgs p = (KArgs)__builtin_amdgcn_kernarg_segment_ptr(); asm volatile("" : "+s"(p)); return p; }
#define PH_VARS KArgs A_ = kargs(); unsigned char* ws = A_->ws; float* out = A_->out; const float* x = A_->in[0]; bf16* XN = (bf16*)(ws + WS_XN); const float* TAB64 = (const float*)(ws + WS_TAB64); const float* TAB32 = (const float*)(ws + WS_TAB32); \
    int tid_ = threadIdx.x; asm volatile("" : "+v"(tid_)); const int tid = tid_, lane = tid & 63, wave = __builtin_amdgcn_readfirstlane(tid >> 6); int G = gridDim.x; asm volatile("" : "+s"(G)); const int gw = blockIdx.x * NWAVES + wave, NGW = G * NWAVES; const int gt = blockIdx.x * NTHR + tid, NGT = G * NTHR; \
    (void)out; (void)x; (void)XN; (void)TAB64; (void)TAB32; (void)lane; (void)gw; (void)NGW; (void)gt; (void)NGT;

template <int MAP> __device__ __forceinline__ int src_col(int n0) {
    if (MAP == 1) { const int pn = n0 >> 8, bj = (n0 >> 7) & 1, wc = (n0 >> 5) & 3; return bj * DFF + pn * 128 + wc * 32; }
    if (MAP == 2) { const int pn = n0 >> 8, bj = (n0 >> 7) & 1, wc = (n0 >> 5) & 3; return (pn < 4) ? pn * 256 + wc * 64 + bj * 32 : n0; }
    if (MAP == 3) { const int pn = n0 >> 8, bj = (n0 >> 7) & 1, wc = (n0 >> 5) & 3; if (pn < 4) return (4 * pn + wc) * 128 + bj * 32; const int col = (pn - 4) * 256 + bj * 128 + wc * 32; return (col >> 6) * 128 + 64 + (col & 63); }
    return n0;
}
template <int MAP> __device__ __forceinline__ void tr_load(f32x4 (&v)[8], const float* W, int Nsrc, int item, int nblk, int lane, const float* gain) {
    const int kb = item / nblk, nb = item % nblk, k0 = 64 * kb, n0 = 32 * nb;
    const int nn = src_col<MAP>(n0) + (lane & 7) * 4; const bool ok = (nn >= 0 && nn < Nsrc);
#pragma unroll
    for (int i = 0; i < 8; ++i) { const int kk = 8 * i + (lane >> 3); v[i] = ok ? *(const f32x4*)(W + (size_t)(k0 + kk) * Nsrc + nn) : (f32x4){0.f, 0.f, 0.f, 0.f}; if (gain) v[i] = v[i] * gain[k0 + kk]; }
}
__device__ __forceinline__ void tr_store(const f32x4 (&v)[8], int K, bf16* WT, LAS float* scr, int item, int nblk, int lane) {
    const int kb = item / nblk, nb = item % nblk, k0 = 64 * kb, n0 = 32 * nb;
#pragma unroll
    for (int i = 0; i < 8; ++i) { const int kk = 8 * i + (lane >> 3); LAS float* d = scr + kk * 33 + (lane & 7) * 4; d[0] = v[i].x; d[1] = v[i].y; d[2] = v[i].z; d[3] = v[i].w; }
    LDS_WAIT(); asm volatile("" ::: "memory");
    const int c = lane & 7;
#pragma unroll
    for (int j = 0; j < 4; ++j) { const int n = (lane >> 3) + 8 * j; const LAS float* s = scr + (8 * c) * 33 + n;
        v4u o; o.x = pk2(s[0 * 33], s[1 * 33]); o.y = pk2(s[2 * 33], s[3 * 33]); o.z = pk2(s[4 * 33], s[5 * 33]); o.w = pk2(s[6 * 33], s[7 * 33]);
        *(GAS v4u*)(WT + (size_t)(n0 + n) * K + k0 + 8 * c) = o; }
    LDS_WAIT(); asm volatile("" ::: "memory");
}
template <int MAP = 0> __device__ __forceinline__ void transpose_mat(const float* W, int K, int Nsrc, int Npad, bf16* WT, LAS float* scr, int gw, int NGW, int lane, const float* gain = nullptr) {
    const int nblk = Npad / 32, nitems = (K / 64) * nblk;
    f32x4 cur[8], nxt[8];
    if (gw < nitems) tr_load<MAP>(cur, W, Nsrc, gw, nblk, lane, gain);
    for (int it = gw; it < nitems; it += NGW) {
        const bool more = it + NGW < nitems;
        if (more) tr_load<MAP>(nxt, W, Nsrc, it + NGW, nblk, lane, gain);
        tr_store(cur, K, WT, scr, it, nblk, lane);
        if (more) {
#pragma unroll
            for (int i = 0; i < 8; ++i) cur[i] = nxt[i]; }
    }
}

struct MatDesc { const float* W; bf16* WT; const float* gain; int K, Nsrc, nblk, map; };
__device__ __forceinline__ int src_col_rt(int map, int n0) { return map == 1 ? src_col<1>(n0) : map == 2 ? src_col<2>(n0) : map == 3 ? src_col<3>(n0) : n0; }
__device__ __forceinline__ void trl_load(f32x4 (&v)[8], const MatDesc& d, int item, int lane) {
    const int kb = item / d.nblk, nb = item % d.nblk, k0 = 64 * kb, n0 = 32 * nb;
    const int nn = src_col_rt(d.map, n0) + (lane & 7) * 4; const bool ok = (nn >= 0 && nn < d.Nsrc);
#pragma unroll
    for (int i = 0; i < 8; ++i) { const int kk = 8 * i + (lane >> 3); v[i] = ok ? __builtin_nontemporal_load((const f32x4*)(d.W + (size_t)(k0 + kk) * d.Nsrc + nn)) : (f32x4){0.f, 0.f, 0.f, 0.f}; if (d.gain) v[i] = v[i] * d.gain[k0 + kk]; }
}
constexpr int NIT_W = 1536 + 512 + 512 + 384 + 256 + 512 + 2 * 2816 + 2 * 1408;
__device__ __forceinline__ MatDesc mat_of(KArgs A_, unsigned char* ws, int item, int& local) {
    MatDesc d; int r = item;
    if (r < 1536) { d = MatDesc{A_->in[3], (bf16*)(ws + WS_W_IN0), nullptr, 1024, 3080, 96, 2}; local = r; return d; } r -= 1536;
    if (r < 512) { d = MatDesc{A_->in[12], (bf16*)(ws + WS_W_OUT0), nullptr, 1024, 1024, 32, 0}; local = r; return d; } r -= 512;
    if (r < 512) { d = MatDesc{A_->in[13], (bf16*)(ws + WS_W_IN1), A_->in[1] + 1024, 1024, 800, 32, 0}; local = r; return d; } r -= 512;
    if (r < 384) { d = MatDesc{A_->in[15], (bf16*)(ws + WS_W_UQ), A_->in[14], 512, 1536, 48, 0}; local = r; return d; } r -= 384;
    if (r < 256) { d = MatDesc{A_->in[17], (bf16*)(ws + WS_W_UKV), A_->in[16], 256, 2048, 64, 3}; local = r; return d; } r -= 256;
    if (r < 512) { d = MatDesc{A_->in[20], (bf16*)(ws + WS_W_OUT1), nullptr, 1024, 1024, 32, 0}; local = r; return d; } r -= 512;
    if (r < 5632) { const int l = r / 2816; d = MatDesc{A_->in[21] + (size_t)l * 1024 * DFF2, (bf16*)(ws + WS_W_UP) + (size_t)l * DFF2 * 1024, A_->in[2] + l * 1024, 1024, DFF2, 176, 1}; local = r - l * 2816; return d; } r -= 5632;
    { const int l = r / 1408; d = MatDesc{A_->in[24] + (size_t)l * DFF * 1024, (bf16*)(ws + WS_W_DN) + (size_t)l * 1024 * DFF, nullptr, DFF, 1024, 32, 0}; local = r - l * 1408; return d; }
}

__device__ __forceinline__ void rms_rows_1024(const float* x, const float* g, bf16* o, int gw, int NGW, int lane) {
    f32x4 v[4], nx[4];
    if (gw < T_) {
#pragma unroll
        for (int j = 0; j < 4; ++j) v[j] = __builtin_nontemporal_load((const f32x4*)(x + (size_t)gw * D_) + lane + 64 * j); }
    for (int m = gw; m < T_; m += NGW) {
        const bool more = m + NGW < T_;
        if (more) {
#pragma unroll
            for (int j = 0; j < 4; ++j) nx[j] = __builtin_nontemporal_load((const f32x4*)(x + (size_t)(m + NGW) * D_) + lane + 64 * j); }
        float s = 0.f;
#pragma unroll
        for (int j = 0; j < 4; ++j) s += (v[j].x * v[j].x + v[j].y * v[j].y) + (v[j].z * v[j].z + v[j].w * v[j].w);
        const float rstd = 1.f / sqrtf(wave_sum(s) * (1.f / D_) + EPS);
        unsigned long long* o8 = (unsigned long long*)(o + (size_t)m * D_) + lane;
#pragma unroll
        for (int j = 0; j < 4; ++j) { const f32x4 gg = ((const f32x4*)g)[lane + 64 * j];
            o8[64 * j] = (unsigned long long)pk2(v[j].x * rstd * gg.x, v[j].y * rstd * gg.y) | ((unsigned long long)pk2(v[j].z * rstd * gg.z, v[j].w * rstd * gg.w) << 32); }
        if (more) {
#pragma unroll
            for (int j = 0; j < 4; ++j) v[j] = nx[j]; }
    }
}

__device__ __forceinline__ void rms_rows_dt(const float* x, const float* g, bf16* o, float* DTR, const LAS f32x4* W2, int gw, int NGW, int lane) {
    f32x4 v[4], nx[4];
    if (gw < T_) {
#pragma unroll
        for (int j = 0; j < 4; ++j) v[j] = __builtin_nontemporal_load((const f32x4*)(x + (size_t)gw * D_) + lane + 64 * j); }
    for (int m = gw; m < T_; m += NGW) {
        const bool more = m + NGW < T_;
        if (more) {
#pragma unroll
            for (int j = 0; j < 4; ++j) nx[j] = __builtin_nontemporal_load((const f32x4*)(x + (size_t)(m + NGW) * D_) + lane + 64 * j); }
        float s = 0.f; f32x4 d0 = {0.f, 0.f, 0.f, 0.f}, d1 = d0;
#pragma unroll
        for (int j = 0; j < 4; ++j) { s += (v[j].x * v[j].x + v[j].y * v[j].y) + (v[j].z * v[j].z + v[j].w * v[j].w);
#pragma unroll
            for (int e = 0; e < 4; ++e) { const int sl = j * 4 + e; const float xk = v[j][e]; d0 += W2[(sl * 2) * 64 + lane] * xk; d1 += W2[(sl * 2 + 1) * 64 + lane] * xk; } }
        const float rstd = 1.f / sqrtf(wave_sum(s) * (1.f / D_) + EPS);
#pragma unroll
        for (int e = 0; e < 4; ++e) { d0[e] = wave_sum(d0[e]); d1[e] = wave_sum(d1[e]); }
        if (lane == 0) { *(f32x4*)(DTR + (size_t)m * 8) = d0 * rstd; *(f32x4*)(DTR + (size_t)m * 8 + 4) = d1 * rstd; }
        unsigned long long* o8 = (unsigned long long*)(o + (size_t)m * D_) + lane;
#pragma unroll
        for (int j = 0; j < 4; ++j) { const f32x4 gg = ((const f32x4*)g)[lane + 64 * j];
            o8[64 * j] = (unsigned long long)pk2(v[j].x * rstd * gg.x, v[j].y * rstd * gg.y) | ((unsigned long long)pk2(v[j].z * rstd * gg.z, v[j].w * rstd * gg.w) << 32); }
        if (more) {
#pragma unroll
            for (int j = 0; j < 4; ++j) v[j] = nx[j]; }
    }
}

struct EpiF32Res {
    static constexpr bool PERM = false, AFTER_DRAIN = false;
    float* C; const float* R; int ldc;
    __device__ __forceinline__ void operator()(const pg8::f32x4 (&acc)[2][2][4][2], const pg8::Unit& u, int wr, int wc, int fr, int fq) const {
        const int row0 = u.pm * pg8::BM + wr * 64 + fr, col0 = u.pn * pg8::BM + wc * 32 + 4 * fq;
#pragma unroll
        for (int ai = 0; ai < 2; ++ai)
#pragma unroll
            for (int m = 0; m < 4; ++m) { const size_t off = (size_t)(row0 + ai * pg8::HALF + m * 16) * ldc + col0;
                f32x4 r[2][2];
#pragma unroll
                for (int bj = 0; bj < 2; ++bj)
#pragma unroll
                    for (int n = 0; n < 2; ++n) r[bj][n] = *(const f32x4*)(R + off + bj * pg8::HALF + n * 16);
#pragma unroll
                for (int bj = 0; bj < 2; ++bj)
#pragma unroll
                    for (int n = 0; n < 2; ++n) *(f32x4*)(C + off + bj * pg8::HALF + n * 16) = acc[ai][bj][m][n] + r[bj][n];
                asm volatile("" ::: "memory"); }
    }
};

template <bool RB16, bool OUTF, bool OUTB> struct EpiRes {
    static constexpr bool PERM = true, AFTER_DRAIN = false;
    float* C; const void* R; bf16* XB; unsigned long long* SSQ;
    struct Raw { f32x4 f[2][2]; v4u h[2]; };
    __device__ __forceinline__ void load_raw(Raw& q, size_t off) const {
#pragma unroll
        for (int bj = 0; bj < 2; ++bj) {
            if (RB16) q.h[bj] = *(const v4u*)((const bf16*)R + off + bj * pg8::HALF);
            else { q.f[bj][0] = *(const f32x4*)((const float*)R + off + bj * pg8::HALF); q.f[bj][1] = *(const f32x4*)((const float*)R + off + bj * pg8::HALF + 4); } }
    }
    __device__ __forceinline__ void operator()(const pg8::f32x4 (&acc)[2][2][4][2], const pg8::Unit& u, int wr, int wc, int fr, int fq) const {
        const int row0 = u.pm * pg8::BM + wr * 64 + fr, col0 = u.pn * pg8::BM + wc * 32 + 8 * fq;
        constexpr int WIN = 4;
        Raw q[8]; float ss[8];
#pragma unroll
        for (int it = 0; it < WIN; ++it) load_raw(q[it], (size_t)(row0 + (it >> 2) * pg8::HALF + (it & 3) * 16) * 1024 + col0);
        __builtin_amdgcn_sched_barrier(0);
#pragma unroll
        for (int it = 0; it < 8; ++it) { const int ai = it >> 2, mm = it & 3; const int row = row0 + ai * pg8::HALF + mm * 16; const size_t off = (size_t)row * 1024 + col0;
            if (it + WIN < 8) { load_raw(q[it + WIN], (size_t)(row0 + ((it + WIN) >> 2) * pg8::HALF + ((it + WIN) & 3) * 16) * 1024 + col0); __builtin_amdgcn_sched_barrier(0); }
            float s = 0.f;
#pragma unroll
            for (int bj = 0; bj < 2; ++bj) {
                f32x4 r0, r1;
                if (RB16) { const v4u w = q[it].h[bj]; r0 = (f32x4){bflo(w.x), bfhi(w.x), bflo(w.y), bfhi(w.y)}; r1 = (f32x4){bflo(w.z), bfhi(w.z), bflo(w.w), bfhi(w.w)}; } else { r0 = q[it].f[bj][0]; r1 = q[it].f[bj][1]; }
                const f32x4 v0 = acc[ai][bj][mm][0] + r0, v1 = acc[ai][bj][mm][1] + r1;
                if (OUTF) { *(f32x4*)(C + off + bj * pg8::HALF) = v0; *(f32x4*)(C + off + bj * pg8::HALF + 4) = v1; }
                if (OUTB) { s += ((v0.x * v0.x + v0.y * v0.y) + (v0.z * v0.z + v0.w * v0.w)) + ((v1.x * v1.x + v1.y * v1.y) + (v1.z * v1.z + v1.w * v1.w));
                    v4u w; w.x = pk2(v0.x, v0.y); w.y = pk2(v0.z, v0.w); w.z = pk2(v1.x, v1.y); w.w = pk2(v1.z, v1.w); *(v4u*)(XB + off + bj * pg8::HALF) = w; } }
            if (OUTB) { s += __shfl_xor(s, 16); s += __shfl_xor(s, 32); ss[it] = s; }
            asm volatile("" ::: "memory"); }
        if (OUTB) { if (fq == 0) {
#pragma unroll
            for (int it = 0; it < 8; ++it) atomicAdd(SSQ + row0 + (it >> 2) * pg8::HALF + (it & 3) * 16, (unsigned long long)(ss[it] * 1073741824.0f)); } }
    }
};
typedef unsigned v2u __attribute__((ext_vector_type(2))); typedef float f32x2 __attribute__((ext_vector_type(2)));
__device__ __forceinline__ float rstd_of(const unsigned long long* SSQ, int row, float inv_n) { const v2u s = ((const v2u*)SSQ)[row]; const float c = inv_n * (1.0f / 1073741824.0f);
    return __builtin_amdgcn_rsqf(__builtin_fmaf((float)s.y, 4294967296.0f * c, __builtin_fmaf((float)s.x, c, EPS))); }
__device__ __forceinline__ f32x2 pk_add_one(f32x2 a) { asm("" : "+v"(a)); return a + 1.0f; }
template <int N> __device__ __forceinline__ float dpp_shr0(float v) { return __builtin_bit_cast(float, __builtin_amdgcn_update_dpp(0, __builtin_bit_cast(int, v), 0x110 + N, 0xf, 0xf, true)); }
template <int N> __device__ __forceinline__ float dpp_shr_old(float old, float v) { return __builtin_bit_cast(float, __builtin_amdgcn_update_dpp(__builtin_bit_cast(int, old), __builtin_bit_cast(int, v), 0x110 + N, 0xf, 0xf, false)); }
template <int N> __device__ __forceinline__ float dpp_ror(float v) { return __builtin_bit_cast(float, __builtin_amdgcn_update_dpp(0, __builtin_bit_cast(int, v), 0x120 + N, 0xf, 0xf, false)); }
struct EpiFfnUp {
    static constexpr bool PERM = true, AFTER_DRAIN = false;
    bf16* ACT; bf16* UB; const unsigned long long* SSQ; const float* cw; const float* cb;
    __device__ __forceinline__ void operator()(const pg8::f32x4 (&acc)[2][2][4][2], const pg8::Unit& u, int wr, int wc, int fr, int fq) const {
        const int ch0 = u.pn * 128 + wc * 32 + 8 * fq;
        float rs[2][4];
#pragma unroll
        for (int ai = 0; ai < 2; ++ai)
#pragma unroll
            for (int m = 0; m < 4; ++m) rs[ai][m] = rstd_of(SSQ, u.pm * pg8::BM + ai * pg8::HALF + wr * 64 + 4 * fr + m, 1.0f / 1024.0f);
        unsigned long long keep[2][4];
#pragma unroll
        for (int n = 0; n < 2; ++n) {
            __builtin_amdgcn_sched_barrier(0);
            const int ch = ch0 + 4 * n;
            const f32x4 wg0 = *(const f32x4*)(cw + ch), wg1 = *(const f32x4*)(cw + DFF2 + ch), wg2 = *(const f32x4*)(cw + 2 * DFF2 + ch), bg = *(const f32x4*)(cw + 3 * DFF2 + ch);
            const f32x4 wu0 = *(const f32x4*)(cw + DFF + ch), wu1 = *(const f32x4*)(cw + DFF2 + DFF + ch), wu2 = *(const f32x4*)(cw + 2 * DFF2 + DFF + ch), bu = *(const f32x4*)(cw + 3 * DFF2 + DFF + ch);
#pragma unroll
            for (int ai = 0; ai < 2; ++ai) {
                const int rowc = u.pm * pg8::BM + ai * pg8::HALF + wr * 64;
                f32x4 g[4], uu[4];
#pragma unroll
                for (int m = 0; m < 4; ++m) { g[m] = acc[ai][0][m][n] * rs[ai][m]; uu[m] = acc[ai][1][m][n] * rs[ai][m]; }
                f32x4 g2p, g3p, u2p, u3p;
#pragma unroll
                for (int j = 0; j < 4; ++j) { g2p[j] = dpp_shr0<1>(g[2][j]); g3p[j] = dpp_shr0<1>(g[3][j]); u2p[j] = dpp_shr0<1>(uu[2][j]); u3p[j] = dpp_shr0<1>(uu[3][j]); }
#pragma unroll
                for (int m = 0; m < 4; ++m) {
                    const f32x4 sg1 = (m == 0) ? g3p : g[m - 1], sg2 = (m == 0) ? g2p : (m == 1) ? g3p : g[m - 2];
                    const f32x4 su1 = (m == 0) ? u3p : uu[m - 1], su2 = (m == 0) ? u2p : (m == 1) ? u3p : uu[m - 2];
                    const f32x4 cg = bg + wg0 * sg2 + wg1 * sg1 + wg2 * g[m], cu = bu + wu0 * su2 + wu1 * su1 + wu2 * uu[m];
                    f32x4 r_;
                    { const f32x2 d0 = pk_add_one((f32x2){__builtin_amdgcn_exp2f(cg[0]), __builtin_amdgcn_exp2f(cg[1])}), d1 = pk_add_one((f32x2){__builtin_amdgcn_exp2f(cg[2]), __builtin_amdgcn_exp2f(cg[3])});
                      r_[0] = __builtin_amdgcn_rcpf(d0.x); r_[1] = __builtin_amdgcn_rcpf(d0.y); r_[2] = __builtin_amdgcn_rcpf(d1.x); r_[3] = __builtin_amdgcn_rcpf(d1.y); }
                    const f32x4 a = cg * r_ * cu;
                    const int row = rowc + 4 * fr + m;
                    const unsigned long long pk_ = (unsigned long long)pk2(a[0], a[1]) | ((unsigned long long)pk2(a[2], a[3]) << 32);
                    if (n == 0) { keep[ai][m] = pk_; asm volatile("" : "+v"(keep[ai][m])); }
                    else if (!(fr == 0 && m < 2)) { v4u w; w.x = (unsigned)keep[ai][m]; w.y = (unsigned)(keep[ai][m] >> 32); w.z = (unsigned)pk_; w.w = (unsigned)(pk_ >> 32); *(v4u*)(ACT + (size_t)row * DFF + ch0) = w; }
                    if ((fr == 0 && m < 2) || (fr == 15 && m >= 2)) { const int slot = m; bf16* ub = UB + ((size_t)(rowc >> 6) * 4 + slot) * DFF2 + ch;
                        *(unsigned long long*)ub = (unsigned long long)pk2(g[m][0], g[m][1]) | ((unsigned long long)pk2(g[m][2], g[m][3]) << 32);
                        *(unsigned long long*)(ub + DFF) = (unsigned long long)pk2(uu[m][0], uu[m][1]) | ((unsigned long long)pk2(uu[m][2], uu[m][3]) << 32); }
                }
            }
        }
    }
};


struct EpiScale {
    static constexpr bool PERM = true, AFTER_DRAIN = false;
    bf16* O; int ldc; const unsigned long long* SSQ; float inv_n;
    __device__ __forceinline__ void operator()(const pg8::f32x4 (&acc)[2][2][4][2], const pg8::Unit& u, int wr, int wc, int fr, int fq) const {
        const int row0 = u.pm * pg8::BM + wr * 64 + fr, col0 = u.pn * pg8::BM + wc * 32 + 8 * fq;
#pragma unroll
        for (int ai = 0; ai < 2; ++ai)
#pragma unroll
            for (int m = 0; m < 4; ++m) { const int row = row0 + ai * pg8::HALF + m * 16; const float rs = rstd_of(SSQ, row, inv_n); bf16* rowp = O + (size_t)row * ldc + col0;
#pragma unroll
                for (int bj = 0; bj < 2; ++bj) { const f32x4 v0 = acc[ai][bj][m][0] * rs, v1 = acc[ai][bj][m][1] * rs;
                    v4u w; w.x = pk2(v0[0], v0[1]); w.y = pk2(v0[2], v0[3]); w.z = pk2(v1[0], v1[1]); w.w = pk2(v1[2], v1[3]); *(v4u*)(rowp + bj * pg8::HALF) = w; } }
    }
};
struct EpiMlaIn {
    static constexpr bool PERM = true, AFTER_DRAIN = false;
    bf16* O; const unsigned long long* SSQ; unsigned long long* SSQ_Q; unsigned long long* SSQ_KV; float* SSQPE; float* RG; const float* kg; const float* TAB;
    __device__ __forceinline__ void operator()(const pg8::f32x4 (&acc)[2][2][4][2], const pg8::Unit& u, int wr, int wc, int fr, int fq) const {
        const int row0 = u.pm * pg8::BM + wr * 64 + fr, col0 = u.pn * pg8::BM + wc * 32 + 8 * fq;
        unsigned long long* tgt = (u.pn < 2) ? SSQ_Q : SSQ_KV;
        float rsv[8];
#pragma unroll
        for (int i = 0; i < 8; ++i) rsv[i] = rstd_of(SSQ, row0 + (i >> 2) * pg8::HALF + (i & 3) * 16, 1.0f / 1024.0f);
        if (u.pn < 3) {
#pragma unroll
        for (int ai = 0; ai < 2; ++ai)
#pragma unroll
            for (int m = 0; m < 4; ++m) { const int row = row0 + ai * pg8::HALF + m * 16; const float rs = rsv[ai * 4 + m]; bf16* rowp = O + (size_t)row * 1024 + col0; float s = 0.f;
#pragma unroll
                for (int bj = 0; bj < 2; ++bj) { const f32x4 v0 = acc[ai][bj][m][0] * rs, v1 = acc[ai][bj][m][1] * rs;
                    s += (v0[0] * v0[0] + v0[1] * v0[1]) + (v0[2] * v0[2] + v0[3] * v0[3]) + (v1[0] * v1[0] + v1[1] * v1[1]) + (v1[2] * v1[2] + v1[3] * v1[3]);
                    v4u w; w.x = pk2(v0[0], v0[1]); w.y = pk2(v0[2], v0[3]); w.z = pk2(v1[0], v1[1]); w.w = pk2(v1[2], v1[3]); *(v4u*)(rowp + bj * pg8::HALF) = w; }
                s += __shfl_xor(s, 16); s += __shfl_xor(s, 32); if (fq == 0) atomicAdd(tgt + row, (unsigned long long)(s * 1073741824.0f)); asm volatile("" ::: "memory"); }
        } else if (wc == 0) {
            const f32x4 g0 = *(const f32x4*)(kg + 64 + 8 * fq), g1 = *(const f32x4*)(kg + 64 + 8 * fq + 4);
            f32x4 tn[4]; { const float* tb = TAB + ((row0 & 2047) * 16 + 8 * (fq & 1)) * 2; tn[0] = *(const f32x4*)tb; tn[1] = *(const f32x4*)(tb + 4); tn[2] = *(const f32x4*)(tb + 8); tn[3] = *(const f32x4*)(tb + 12); }
#pragma unroll
            for (int ai = 0; ai < 2; ++ai)
#pragma unroll
                for (int m = 0; m < 4; ++m) { const int row = row0 + ai * pg8::HALF + m * 16; const float rs = rsv[ai * 4 + m];
                    const f32x4 ta = tn[0], tb4 = tn[1], tc = tn[2], td = tn[3];
                    if (ai * 4 + m < 7) { const int i1 = ai * 4 + m + 1; const float* tb = TAB + (((row0 + (i1 >> 2) * pg8::HALF + (i1 & 3) * 16) & 2047) * 16 + 8 * (fq & 1)) * 2; tn[0] = *(const f32x4*)tb; tn[1] = *(const f32x4*)(tb + 4); tn[2] = *(const f32x4*)(tb + 8); tn[3] = *(const f32x4*)(tb + 12); }
                    const f32x4 v0 = acc[ai][0][m][0] * rs, v1 = acc[ai][0][m][1] * rs;
                    float s = (v0[0] * v0[0] + v0[1] * v0[1]) + (v0[2] * v0[2] + v0[3] * v0[3]) + (v1[0] * v1[0] + v1[1] * v1[1]) + (v1[2] * v1[2] + v1[3] * v1[3]);
                    s += __shfl_xor(s, 16); s += __shfl_xor(s, 32); if (fq == 0) SSQPE[row] = s;
                    const f32x4 y0 = v0 * g0, y1 = v1 * g1;
                    f32x4 p0, p1;
#pragma unroll
                    for (int j = 0; j < 4; ++j) { p0[j] = __shfl_xor(y0[j], 32); p1[j] = __shfl_xor(y1[j], 32); }
                    const f32x4 c0 = {ta[0], ta[2], tb4[0], tb4[2]}, s0 = {ta[1], ta[3], tb4[1], tb4[3]}, c1 = {tc[0], tc[2], td[0], td[2]}, s1 = {tc[1], tc[3], td[1], td[3]};
                    f32x4 o0, o1;
                    if (fq < 2) { o0 = y0 * c0 - p0 * s0; o1 = y1 * c1 - p1 * s1; } else { o0 = p0 * s0 + y0 * c0; o1 = p1 * s1 + y1 * c1; }
                    float* rg = RG + (size_t)row * 32 + 8 * fq; *(f32x4*)rg = o0; *(f32x4*)(rg + 4) = o1; asm volatile("" ::: "memory"); }
        }
    }
};
struct EpiUkv {
    static constexpr bool PERM = true, AFTER_DRAIN = false;
    bf16* K2; bf16* V2; const unsigned long long* SSQ; const float* SSQPE; const float* RG; const float* kg;
    __device__ __forceinline__ void operator()(const pg8::f32x4 (&acc)[2][2][4][2], const pg8::Unit& u, int wr, int wc, int fr, int fq) const {
        const int row0 = u.pm * pg8::BM + wr * 64 + fr;
        if (u.pn < 4) {
            const int head = 4 * u.pn + wc;
            f32x4 g1[2], g2[2];
#pragma unroll
            for (int n = 0; n < 2; ++n) { g1[n] = *(const f32x4*)(kg + 8 * fq + 4 * n); g2[n] = *(const f32x4*)(kg + 32 + 8 * fq + 4 * n); }
            float rsv[8], pev[8];
#pragma unroll
            for (int i = 0; i < 8; ++i) { const int row = row0 + (i >> 2) * pg8::HALF + (i & 3) * 16; rsv[i] = rstd_of(SSQ, row, 1.0f / 256.0f); pev[i] = SSQPE[row]; }
            f32x4 rgn0, rgn1; { const float* rg = RG + (size_t)row0 * 32 + 8 * fq; rgn0 = *(const f32x4*)rg; rgn1 = *(const f32x4*)(rg + 4); }
#pragma unroll
            for (int i = 0; i < 8; ++i) { const int row = row0 + (i >> 2) * pg8::HALF + (i & 3) * 16; const float rs = rsv[i];
                    const f32x4 rgc0 = rgn0, rgc1 = rgn1;
                    if (i < 7) { const float* rg = RG + (size_t)(row0 + ((i + 1) >> 2) * pg8::HALF + ((i + 1) & 3) * 16) * 32 + 8 * fq; rgn0 = *(const f32x4*)rg; rgn1 = *(const f32x4*)(rg + 4); }
                    const int ai = i >> 2, m = i & 3;
                    f32x4 a[2], b[2]; float s = 0.f;
#pragma unroll
                    for (int n = 0; n < 2; ++n) { a[n] = acc[ai][0][m][n] * rs; b[n] = acc[ai][1][m][n] * rs; s += (a[n][0] * a[n][0] + a[n][1] * a[n][1]) + (a[n][2] * a[n][2] + a[n][3] * a[n][3]) + (b[n][0] * b[n][0] + b[n][1] * b[n][1]) + (b[n][2] * b[n][2] + b[n][3] * b[n][3]); }
                    s += __shfl_xor(s, 16); s += __shfl_xor(s, 32);
                    const float rh = __builtin_amdgcn_rsqf((s + pev[i]) * (1.f / 96.f) + EPS);
                    const int pos = row & 2047; bf16* rp = K2 + ((((size_t)(row >> 11) * 16 + head) * 32 + (pos >> 6)) * 12 + fq) * 512 + (pos & 63) * 8;
                    { const f32x4 o0 = a[0] * rh * g1[0], o1 = a[1] * rh * g1[1]; v4u w; w.x = pk2(o0[0], o0[1]); w.y = pk2(o0[2], o0[3]); w.z = pk2(o1[0], o1[1]); w.w = pk2(o1[2], o1[3]); *(v4u*)rp = w; }
                    { const f32x4 o0 = b[0] * rh * g2[0], o1 = b[1] * rh * g2[1]; v4u w; w.x = pk2(o0[0], o0[1]); w.y = pk2(o0[2], o0[3]); w.z = pk2(o1[0], o1[1]); w.w = pk2(o1[2], o1[3]); *(v4u*)(rp + 4 * 512) = w; }
                    { const f32x4 o0 = rgc0 * rh, o1 = rgc1 * rh; v4u w; w.x = pk2(o0[0], o0[1]); w.y = pk2(o0[2], o0[3]); w.z = pk2(o1[0], o1[1]); w.w = pk2(o1[2], o1[3]); *(v4u*)(rp + 8 * 512) = w; }
                    asm volatile("" ::: "memory"); }
        } else {
            bf16* dst = V2 + (u.pn - 4) * 256 + wc * 32 + 8 * fq;
#pragma unroll
            for (int ai = 0; ai < 2; ++ai)
#pragma unroll
                for (int m = 0; m < 4; ++m) { const int row = row0 + ai * pg8::HALF + m * 16; const float rs = rstd_of(SSQ, row, 1.0f / 256.0f); bf16* rp = dst + (size_t)row * 1024;
#pragma unroll
                    for (int bj = 0; bj < 2; ++bj) { const f32x4 v0 = acc[ai][bj][m][0] * rs, v1 = acc[ai][bj][m][1] * rs;
                        v4u w; w.x = pk2(v0[0], v0[1]); w.y = pk2(v0[2], v0[3]); w.z = pk2(v1[0], v1[1]); w.w = pk2(v1[2], v1[3]); *(v4u*)(rp + bj * pg8::HALF) = w; } }
        }
    }
};

struct EpiIn0 {
    static constexpr bool PERM = true, AFTER_DRAIN = false;
    bf16* QK; bf16* KC; const float* TAB; const float* qn; const float* kn; float* KM; float* DTR;
    __device__ __forceinline__ void operator()(const pg8::f32x4 (&acc)[2][2][4][2], const pg8::Unit& u, int wr, int wc, int fr, int fq) const {
        const int row0 = u.pm * pg8::BM + wr * 64 + fr;
        if (u.pn < 4) {
            const bool isq = u.pn < 2; const float* gn = isq ? qn : kn; const int head = 4 * (u.pn & 1) + wc;
            bf16* dst = QK + (isq ? 0 : 512) + head * 64 + 8 * fq;
            f32x4 g1[2], g2[2], ks1[2], ks2[2];
#pragma unroll
            for (int n = 0; n < 2; ++n) { g1[n] = *(const f32x4*)(gn + 8 * fq + 4 * n); g2[n] = *(const f32x4*)(gn + 32 + 8 * fq + 4 * n); ks1[n] = (f32x4){0.f, 0.f, 0.f, 0.f}; ks2[n] = ks1[n]; }
#pragma unroll
            for (int ai = 0; ai < 2; ++ai)
#pragma unroll
                for (int m = 0; m < 4; ++m) { const int row = row0 + ai * pg8::HALF + m * 16, pos = row & 2047;
                    float s = 0.f;
#pragma unroll
                    for (int n = 0; n < 2; ++n) { const f32x4 a = acc[ai][0][m][n], b = acc[ai][1][m][n]; s += (a[0] * a[0] + a[1] * a[1]) + (a[2] * a[2] + a[3] * a[3]) + (b[0] * b[0] + b[1] * b[1]) + (b[2] * b[2] + b[3] * b[3]); }
                    s += __shfl_xor(s, 16); s += __shfl_xor(s, 32);
                    float rstd = 1.f / sqrtf(s * (1.f / 64.f) + EPS); if (isq) rstd *= 0.18033688011112042f;
                    f32x4 o1[2], o2[2];
#pragma unroll
                    for (int n = 0; n < 2; ++n) { const float* tb = TAB + (pos * 32 + 8 * fq + 4 * n) * 2; const f32x4 t0 = *(const f32x4*)tb, t1 = *(const f32x4*)(tb + 4);
                        const f32x4 cs_ = {t0[0], t0[2], t1[0], t1[2]}, sn = {t0[1], t0[3], t1[1], t1[3]};
                        const f32x4 y1 = acc[ai][0][m][n] * rstd * g1[n], y2 = acc[ai][1][m][n] * rstd * g2[n];
                        o1[n] = y1 * cs_ - y2 * sn; o2[n] = y1 * sn + y2 * cs_; ks1[n] += o1[n]; ks2[n] += o2[n]; }
                    bf16* rp = dst + (size_t)row * 1024; int st2 = 32;
                    if (!isq) { rp = KC + ((((size_t)(row >> 11) * 8 + head) * 32 + (pos >> 6)) * 8 + fq) * 512 + (pos & 63) * 8; st2 = 4 * 512; }
                    { v4u w; w.x = pk2(o1[0][0], o1[0][1]); w.y = pk2(o1[0][2], o1[0][3]); w.z = pk2(o1[1][0], o1[1][1]); w.w = pk2(o1[1][2], o1[1][3]); *(v4u*)rp = w; }
                    { v4u w; w.x = pk2(o2[0][0], o2[0][1]); w.y = pk2(o2[0][2], o2[0][3]); w.z = pk2(o2[1][0], o2[1][1]); w.w = pk2(o2[1][2], o2[1][3]); *(v4u*)(rp + st2) = w; }
                    asm volatile("" ::: "memory"); }
            if (!isq) {
                float* km = KM + (((size_t)(u.pm >> 3) * 8 + (u.pm & 7)) * 8 + head) * 64 + 8 * fq;
#pragma unroll
                for (int n = 0; n < 2; ++n)
#pragma unroll
                    for (int j = 0; j < 4; ++j) { float a = ks1[n][j], b = ks2[n][j];
#pragma unroll
                        for (int o = 1; o < 16; o <<= 1) { a += __shfl_xor(a, o); b += __shfl_xor(b, o); }
                        if (fr == 0) { atomicAdd(km + 4 * n + j, a * (1.f / 256.f)); atomicAdd(km + 32 + 4 * n + j, b * (1.f / 256.f)); } } }
        } else if (u.pn < 12) {
            bf16* dst = QK + (size_t)(u.pn >> 2) * ((size_t)T_ * 1024) + (u.pn & 3) * 256 + wc * 32 + 8 * fq;
#pragma unroll
            for (int ai = 0; ai < 2; ++ai)
#pragma unroll
                for (int m = 0; m < 4; ++m) { bf16* rp = dst + (size_t)(row0 + ai * pg8::HALF + m * 16) * 1024;
#pragma unroll
                    for (int bj = 0; bj < 2; ++bj) { const f32x4 v0 = acc[ai][bj][m][0], v1 = acc[ai][bj][m][1];
                        v4u w; w.x = pk2(v0[0], v0[1]); w.y = pk2(v0[2], v0[3]); w.z = pk2(v1[0], v1[1]); w.w = pk2(v1[2], v1[3]); *(v4u*)(rp + bj * pg8::HALF) = w; } }
        } else if (wc == 0 && fq == 0) {
#pragma unroll
            for (int ai = 0; ai < 2; ++ai)
#pragma unroll
                for (int m = 0; m < 4; ++m) { float* rp = DTR + (size_t)(row0 + ai * pg8::HALF + m * 16) * 8; *(f32x4*)rp = acc[ai][0][m][0]; *(f32x4*)(rp + 4) = acc[ai][0][m][1]; }
        }
    }
};

template <class Epi, int AROW = 0> __device__ __forceinline__ void run_gemm(LAS unsigned char* lds, const bf16* A, const bf16* Bt, int M, int N, int K, const Epi& E, int lda = 0) {
    pg8::Gemm g{A, Bt, M, N, K, lda ? lda : K}; pg8::StaticOrder S; S.init(M, N, (int)gridDim.x, (int)blockIdx.x);
    pg8::gemm_phase<Epi, pg8::StaticOrder, PG8_ALIGN, PG8_SP2, AROW>(lds + RING_OFF, g, S, E);
}

#define NPHASES 40
__global__ void __launch_bounds__(NTHR, 2) fwd(Args args) {
    extern __shared__ __attribute__((aligned(16))) unsigned char lds_raw[];
    LAS unsigned char* lds = (LAS unsigned char*)lds_raw;
    volatile LAS unsigned* MISC = (volatile LAS unsigned*)(lds + MISC_OFF);
    {
        const int tid0 = threadIdx.x;
        for (int u = tid0; u < (LDS_BYTES - LDSCTL_OFF) / 4; u += NTHR) ((LAS unsigned*)(lds + LDSCTL_OFF))[u] = 0u;
    }
    __syncthreads();
    int lo, hi; { KArgs A0 = kargs(); lo = A0->ph_lo; hi = A0->ph_hi; }
    const bool multi = (hi - lo) > 1;
    XcdBarrier bar; bar.bar = nullptr; bar.x = 0; bar.st = nullptr;
    if (multi) { KArgs A0 = kargs(); bar = xcd_barrier_post((unsigned*)((gu32*)(A0->ws + WS_CTL) + CW_BAR), MISC + 8); }
#define IN(k) (lo <= (k) && (k) < hi)
#ifndef PROBE_MASK
#define PROBE_MASK 0u
#endif
    unsigned long long pr_acc = 0ull, pr_t = 0ull;
    if (PROBE_MASK) pr_t = __builtin_amdgcn_s_memrealtime();
#define SEAM(k) do { if (IN(k) && IN((k) + 1)) xcd_barrier(bar); \
        if (PROBE_MASK) { const unsigned long long now_ = __builtin_amdgcn_s_memrealtime(); if ((PROBE_MASK >> (k)) & 1u) pr_acc += now_ - pr_t; pr_t = now_; } } while (0)

    if (IN(0)) { PH_VARS
        LAS float* scr = (LAS float*)(lds + RING_OFF + wave * 16384);
        { f32x4 cur[8], nxt[8]; int it = gw, li = 0, ln = 0; MatDesc d{}, dn{};
          if (it < NIT_W) { d = mat_of(A_, ws, it, li); trl_load(cur, d, li, lane); }
          while (it < NIT_W) { const int nit = it + NGW; const bool more = nit < NIT_W;
              if (more) { dn = mat_of(A_, ws, nit, ln); trl_load(nxt, dn, ln, lane); }
              tr_store(cur, d.K, d.WT, scr, li, d.nblk, lane);
              if (more) {
#pragma unroll
                  for (int i = 0; i < 8; ++i) cur[i] = nxt[i];
                  d = dn; li = ln; }
              it = nit; } }
        { float* cws = (float*)(ws + WS_CWS); const float* cw_ = A_->in[22]; const float* cb_ = A_->in[23];
          for (int i = gt; i < 2 * 4 * DFF2; i += NGT) { const int l = i / (4 * DFF2), r = i - l * 4 * DFF2, k = r / DFF2, c = r - k * DFF2;
              const float v = (k < 3) ? cw_[((size_t)l * 3 + k) * DFF2 + c] : cb_[(size_t)l * DFF2 + c]; cws[i] = v * (c < DFF ? -1.44269504088896341f : -0.693147180559945309f); } }
        float* t64 = (float*)(ws + WS_TAB64); float* t32 = (float*)(ws + WS_TAB32);
        for (int i = gt; i < 2048 * 32; i += NGT) { const int pos = i >> 5, f = i & 31; const float inv = 1.0f / powf(10000.0f, (float)(2 * f) / 64.0f); const float ang = (float)pos * inv; t64[2 * i] = cosf(ang); t64[2 * i + 1] = sinf(ang); }
        for (int i = gt; i < 2048 * 16; i += NGT) { const int pos = i >> 4, f = i & 15; const float inv = 1.0f / powf(10000.0f, (float)(2 * f) / 32.0f); const float ang = (float)pos * inv; t32[2 * i] = cosf(ang); t32[2 * i + 1] = sinf(ang); }
        asm volatile("s_waitcnt vmcnt(0) lgkmcnt(0)" ::: "memory"); __syncthreads();
        { LAS f32x4* W2 = (LAS f32x4*)(lds + RING_OFF); const float* Wi = A_->in[3]; const float* gg = A_->in[1];
          for (int i = tid; i < 2048; i += NTHR) { const int ln = i & 63, sh = i >> 6, sl = sh >> 1, half = sh & 1, k = 4 * ln + 256 * (sl >> 2) + (sl & 3);
              W2[i] = *(const f32x4*)(Wi + (size_t)k * 3080 + 3072 + 4 * half) * gg[k]; }
          asm volatile("s_waitcnt vmcnt(0) lgkmcnt(0)" ::: "memory"); __syncthreads();
          rms_rows_dt(x, A_->in[1], XN, (float*)(ws + WS_DTR), W2, gw, NGW, lane); }
    }
    SEAM(0);
    if (IN(1)) { PH_VARS EpiIn0 E{(bf16*)(ws + L0_QK), (bf16*)(ws + L0_KC), TAB64, A_->in[10], A_->in[11], (float*)(ws + WS_KMEAN), (float*)(ws + WS_DTR)}; run_gemm(lds, XN, (const bf16*)(ws + WS_W_IN0), T_, 3072, 1024, E); }
    SEAM(1);
    if (IN(2)) { PH_VARS
        for (int u = blockIdx.x; u < 512; u += G) ssd::states_unit(lds, u >> 1, u & 1, (const bf16*)(ws + L0_XBC), (const float*)(ws + WS_DTR), A_->in[4], A_->in[5], A_->in[6], A_->in[7], (float*)(ws + L0_ST), (float*)(ws + WS_CEND));
    }
    SEAM(2);
    if (IN(3)) { PH_VARS
        const float* ST = (const float*)(ws + L0_ST); const float* CEND = (const float*)(ws + WS_CEND); bf16* HIN = (bf16*)(ws + L0_HIN);
        for (int i = gt; i < 16 * 8 * 64 * 128 / 4; i += NGT) {
            const int pn = (i & 2047) * 4, h = (i >> 11) & 7, b = i >> 14; f32x4 hst = {0.f, 0.f, 0.f, 0.f}; f32x4 tmp[16]; float dec[16];
#pragma unroll
            for (int c = 0; c < 16; ++c) { tmp[c] = *(const f32x4*)(ST + (((size_t)((b * 16 + c) * 8 + h) << 13) + pn)); dec[c] = CEND[(b * 16 + c) * 8 + h]; }
#pragma unroll
            for (int c = 0; c < 16; ++c) { const size_t idx = ((size_t)((b * 16 + c) * 8 + h) << 13) + pn;
                *(unsigned long long*)(HIN + idx) = (unsigned long long)pk2(hst.x, hst.y) | ((unsigned long long)pk2(hst.z, hst.w) << 32);
                hst = hst * __expf(dec[c]) + tmp[c]; }
        }
        const bf16* QK = (const bf16*)(ws + L0_QK); const bf16* VZ = (const bf16*)(ws + L0_VZ); const float* KM = (const float*)(ws + WS_KMEAN); bf16* MIX = (bf16*)(ws + L0_MIX);
        asm volatile("s_waitcnt vmcnt(0) lgkmcnt(0)" ::: "memory"); __syncthreads();
        float kb0; { float gm = fabsf(A_->in[11][lane]);
#pragma unroll
          for (int o_ = 1; o_ < 64; o_ <<= 1) gm = fmaxf(gm, __shfl_xor(gm, o_));
          kb0 = 8.0f * 1.02f * gm; }
        { int tb = 0, pbh = -1;
          for (int i = blockIdx.x; i < 1024; i += G) {
            const int s_ = i >> 8, c = i & 255, bh = c >> 1, half = c & 1, qb = (s_ & 1) ? (s_ - 1 + half) : (7 - half - s_), b = bh >> 3, h = bh & 7;
            const int in_ = i + G; const bool hn = (in_ < 1024) && (((in_ & 255) >> 1) == bh);
            at2::Tensors TT{QK + h * 64, (const bf16*)(ws + L0_KC) + (size_t)(b * 8 + h) * (32 * 8 * 512), VZ + h * 64, MIX + h * 64, 1024, 0, 1024, 1024};
            at2::attn_unit_p<64, true, false, 2>(lds, TT, (long)b * 2048, qb, KM + b * 4096 + h * 64, nullptr, nullptr, kb0, tb, pbh == bh, hn);
            tb = (tb + 4 * (qb + 1)) % 6; pbh = hn ? bh : -1; } }
    }
    SEAM(3);
    if (IN(4)) { PH_VARS
        for (int u = blockIdx.x; u < 512; u += G) ssd::out_unit(lds, u >> 1, u & 1, (const bf16*)(ws + L0_XBC), (const bf16*)(ws + L0_VZ), (const float*)(ws + WS_DTR), A_->in[4], A_->in[5], A_->in[6], A_->in[7],
                                                               (const bf16*)(ws + L0_HIN), A_->in[8], A_->in[9], (bf16*)(ws + L0_MIX));
    }
    SEAM(4);
    if (IN(5)) { PH_VARS EpiRes<false, false, true> E{nullptr, x, XN, (unsigned long long*)(ws + WS_SSQA)}; run_gemm(lds, (const bf16*)(ws + L0_MIX), (const bf16*)(ws + WS_W_OUT0), T_, 1024, 1024, E); }
    SEAM(5);
#define FFN_PHASES(P, L, AIN, SSQ_IN, LASTL, SSQ_OUT) \
    if (IN(P)) { PH_VARS EpiFfnUp E{(bf16*)(ws + FF_ACT), (bf16*)(ws + FF_UB), (const unsigned long long*)(ws + (SSQ_IN)), (const float*)(ws + WS_CWS) + (size_t)(L) * 4 * DFF2, nullptr}; \
        run_gemm<EpiFfnUp, 1>(lds, (const bf16*)(ws + (AIN)), (const bf16*)(ws + WS_W_UP) + (size_t)(L) * DFF2 * 1024, T_, DFF2, 1024, E); } \
    SEAM(P); \
    if (IN((P) + 1)) { PH_VARS \
        const bf16* UB = (const bf16*)(ws + FF_UB); bf16* ACT = (bf16*)(ws + FF_ACT); const float* cw = A_->in[22] + (size_t)(L) * 3 * DFF2; const float* cb = A_->in[23] + (size_t)(L) * DFF2; \
        for (int i = gt; i < 512 * 2 * (DFF / 8); i += NGT) {          \
            const int c0 = (i % (DFF / 8)) * 8, rr = (i / (DFF / 8)) & 1, ck = i / (2 * (DFF / 8)); const bool first = (ck & 31) == 0;     \
            float ag[8], au[8]; \
            _Pragma("unroll") for (int j = 0; j < 8; ++j) { ag[j] = cb[c0 + j]; au[j] = cb[DFF + c0 + j]; } \
            _Pragma("unroll") for (int k = 0; k < 3; ++k) { const int rel = rr - 2 + k;     \
                if (rel >= 0 || !first) { const bf16* src = (rel >= 0) ? UB + ((size_t)ck * 4 + rel) * DFF2 : UB + ((size_t)(ck - 1) * 4 + 4 + rel) * DFF2; \
                    const v4u wg = *(const v4u*)(src + c0); const v4u wu = *(const v4u*)(src + DFF + c0); const float* kg = cw + k * DFF2 + c0; const float* ku = kg + DFF; \
                    ag[0] += kg[0] * bflo(wg.x); ag[1] += kg[1] * bfhi(wg.x); ag[2] += kg[2] * bflo(wg.y); ag[3] += kg[3] * bfhi(wg.y); ag[4] += kg[4] * bflo(wg.z); ag[5] += kg[5] * bfhi(wg.z); ag[6] += kg[6] * bflo(wg.w); ag[7] += kg[7] * bfhi(wg.w); \
                    au[0] += ku[0] * bflo(wu.x); au[1] += ku[1] * bfhi(wu.x); au[2] += ku[2] * bflo(wu.y); au[3] += ku[3] * bfhi(wu.y); au[4] += ku[4] * bflo(wu.z); au[5] += ku[5] * bfhi(wu.z); au[6] += ku[6] * bflo(wu.w); au[7] += ku[7] * bfhi(wu.w); } } \
            v4u o; o.x = pk2(silu_f(ag[0]) * au[0], silu_f(ag[1]) * au[1]); o.y = pk2(silu_f(ag[2]) * au[2], silu_f(ag[3]) * au[3]); o.z = pk2(silu_f(ag[4]) * au[4], silu_f(ag[5]) * au[5]); o.w = pk2(silu_f(ag[6]) * au[6], silu_f(ag[7]) * au[7]); \
            *(v4u*)(ACT + ((size_t)ck * 64 + rr) * DFF + c0) = o; } } \
    SEAM((P) + 1); \
    if (IN((P) + 2)) { PH_VARS EpiRes<true, LASTL, !LASTL> E{out, (const bf16*)(ws + (AIN)), (bf16*)(ws + (AIN)), (unsigned long long*)(ws + (SSQ_OUT))}; run_gemm(lds, (const bf16*)(ws + FF_ACT), (const bf16*)(ws + WS_W_DN) + (size_t)(L) * 1024 * DFF, T_, 1024, DFF, E); } \
    SEAM((P) + 2);
    FFN_PHASES(6, 0, WS_XN, WS_SSQA, false, WS_SSQB)
    if (IN(9)) { PH_VARS EpiMlaIn E{(bf16*)(ws + L1_C1), (const unsigned long long*)(ws + WS_SSQB), (unsigned long long*)(ws + WS_SSQQ), (unsigned long long*)(ws + WS_SSQKV), (float*)(ws + WS_SSQPE), (float*)(ws + WS_RG), A_->in[19], TAB32}; run_gemm(lds, XN, (const bf16*)(ws + WS_W_IN1), T_, 1024, 1024, E); }
    SEAM(9);
    if (IN(10)) { PH_VARS const bf16* C1 = (const bf16*)(ws + L1_C1);
        { EpiScale E{(bf16*)(ws + L1_QR), 1536, (const unsigned long long*)(ws + WS_SSQQ), 1.0f / 512.0f}; run_gemm(lds, C1, (const bf16*)(ws + WS_W_UQ), T_, 1536, 512, E, 1024); }
        { EpiUkv E{(bf16*)(ws + L1_K2), (bf16*)(ws + L1_V2), (const unsigned long long*)(ws + WS_SSQKV), (const float*)(ws + WS_SSQPE), (const float*)(ws + WS_RG), A_->in[19]}; run_gemm(lds, C1 + 512, (const bf16*)(ws + WS_W_UKV), T_, 2048, 256, E, 1024); } }
    SEAM(10);
    if (IN(11)) { PH_VARS
        const bf16* Q2 = (const bf16*)(ws + L1_QR); const bf16* K2 = (const bf16*)(ws + L1_K2); const bf16* V2 = (const bf16*)(ws + L1_V2); bf16* O = (bf16*)(ws + L1_O);
        float kb1; { float gm = fmaxf(fabsf(A_->in[19][lane]), (lane < 32) ? fabsf(A_->in[19][64 + lane]) : 0.f);
#pragma unroll
          for (int o_ = 1; o_ < 64; o_ <<= 1) gm = fmaxf(gm, __shfl_xor(gm, o_));
          kb1 = 9.797958971f * 1.02f * gm; }
        { int tb = 0, pbh = -1;
          for (int i = blockIdx.x; i < 2048; i += G) {
            const int s_ = i >> 8, bh = i & 255, qb = 7 - s_, b = bh >> 4, h = bh & 15;
            const int in_ = i + G; const bool hn = (in_ < 2048) && ((in_ & 255) == bh);
            at2::Tensors TT{Q2 + h * 96, K2 + (size_t)(b * 16 + h) * (32 * 12 * 512), V2 + h * 64, O + h * 64, 1536, 0, 1024, 1024};
            at2::attn_unit_p<96, false, true, 2>(lds, TT, (long)b * 2048, qb, nullptr, A_->in[18], TAB32, kb1, tb, pbh == bh, hn);
            tb = (tb + 4 * (qb + 1)) % 6; pbh = hn ? bh : -1; } }
    }
    SEAM(11);
    if (IN(12)) { PH_VARS EpiRes<true, false, true> E{nullptr, XN, (bf16*)(ws + WS_BIG), (unsigned long long*)(ws + WS_SSQC)}; run_gemm(lds, (const bf16*)(ws + L1_O), (const bf16*)(ws + WS_W_OUT1), T_, 1024, 1024, E); }
    SEAM(12);
    FFN_PHASES(13, 1, WS_BIG, WS_SSQC, true, WS_SSQB)
    if (PROBE_MASK) { if (blockIdx.x == 0 && threadIdx.x == 0) { const unsigned long long t0 = __builtin_amdgcn_s_memrealtime(); while (__builtin_amdgcn_s_memrealtime() - t0 < pr_acc) __builtin_amdgcn_s_sleep(8); } }
#undef IN
#undef SEAM
}
constexpr int LAST_PHASE = 16;

#ifndef MK_ONE_LAUNCH
#define MK_ONE_LAUNCH 1
#endif
extern "C" void kernel_launch(void* const* d_in, const int* in_sizes, int n_in, void* d_out, int out_size, void* d_ws, size_t ws_size, hipStream_t stream) {
    static int grid = 0;
    if (grid == 0) {
        if (n_in != 25 || out_size != T_ * D_ || ws_size < WS_END) { fprintf(stderr, "kernel_launch: unexpected shapes: n_in %d out %d ws %zu\n", n_in, out_size, ws_size); grid = -1; return; }
        if (hipFuncSetAttribute((const void*)fwd, hipFuncAttributeMaxDynamicSharedMemorySize, LDS_BYTES) != hipSuccess) { fprintf(stderr, "kernel_launch: hipFuncSetAttribute failed\n"); grid = -1; return; }
        int dev = 0, cus = 0, per_cu = 0;
        hipGetDevice(&dev); hipDeviceGetAttribute(&cus, hipDeviceAttributeMultiprocessorCount, dev);
        hipOccupancyMaxActiveBlocksPerMultiprocessor(&per_cu, (const void*)fwd, NTHR, LDS_BYTES);
        (void)hipGetLastError();
        grid = (per_cu >= 1) ? cus : -1;
        if (grid < 0) { fprintf(stderr, "kernel_launch: occupancy query says 0 blocks per CU\n"); return; }
    }
    if (grid < 0) return;
    hipMemsetAsync((char*)d_ws + WS_CTL, 0, CTL_ZERO_BYTES, stream);
    Args a{};
    for (int i = 0; i < 25; ++i) a.in[i] = (const float*)d_in[i];
    a.out = (float*)d_out; a.ws = (unsigned char*)d_ws;
#if MK_ONE_LAUNCH
    a.ph_lo = 0; a.ph_hi = LAST_PHASE;
    hipLaunchKernelGGL(fwd, dim3(grid), dim3(NTHR), LDS_BYTES, stream, a);
#else
    for (int p = 0; p < LAST_PHASE; ++p) { a.ph_lo = p; a.ph_hi = p + 1; hipLaunchKernelGGL(fwd, dim3(grid), dim3(NTHR), LDS_BYTES, stream, a); }
#endif
}
```

```cpp
#include <hip/hip_runtime.h>
#include <cstdio>
#include <cstdint>
namespace pg8 {
#define PG8_LAS __attribute__((address_space(3)))
typedef unsigned short bf16_t;
typedef short bf16x8 __attribute__((ext_vector_type(8)));
typedef float f32x4 __attribute__((ext_vector_type(4)));
typedef unsigned u32x4 __attribute__((ext_vector_type(4)));
constexpr int BM = 256, BK = 64, HALF = 128, HTB = HALF * BK * 2  , STAGE_BYTES = 8 * HTB, NXCD = 8, WGM = 8;

__host__ __device__ __forceinline__ int lds_byte(int r, int c) { const int st = (r >> 4) * 2 + (c >> 5), rr = r & 15, cc = c & 31, ob = rr * 64 + cc * 2; return st * 1024 + (ob ^ (((ob >> 9) & 1) << 5)); }
__host__ __device__ __forceinline__ void stage_rc(int b, int& R, int& C) { const int st = b / 1024, sb = b % 1024, swz = sb ^ (((sb >> 9) & 1) << 5); R = (st >> 1) * 16 + swz / 64; C = (st & 1) * 32 + (swz % 64) / 2; }
__host__ __device__ __forceinline__ int perm32(int rho) { const int n = rho >> 4, i = rho & 15; return 8 * (i >> 2) + 4 * n + (i & 3); }

struct Unit { int pm, pn; };
struct Gemm { const bf16_t* A; const bf16_t* Bt; int M, N, K, lda; };

struct StaticOrder {
    int nM, nN, nwg, G, c;
    __host__ __device__ __forceinline__ void init(int M, int N, int G_, int c_) { nM = M / BM; nN = N / BM; nwg = nM * nN; G = G_; c = c_; }
    __host__ __device__ __forceinline__ bool next(int i, Unit& u) const {
        const long L = (long)i * G + c; if (L >= nwg) return false;
        int wgid = (int)L; { const int q = nwg / NXCD, r = nwg % NXCD, xcd = wgid % NXCD, off = wgid / NXCD; wgid = (xcd < r ? xcd * (q + 1) : r * (q + 1) + (xcd - r) * q) + off; }
        const int nig = WGM * nN, gid = wgid / nig, fm = gid * WGM, gsz = (nM - fm) < WGM ? (nM - fm) : WGM;
        u.pm = fm + ((wgid % nig) % gsz); u.pn = (wgid % nig) / gsz; return true;
    }
    __device__ __forceinline__ void a_ready(const Unit&) const {}
    __device__ __forceinline__ void done(const Unit&) const {}
};

__device__ __forceinline__ unsigned cvt_pk_bf16(float lo, float hi) { unsigned r; asm volatile("v_cvt_pk_bf16_f32 %0, %1, %2" : "=v"(r) : "v"(lo), "v"(hi)); return r; }
typedef float f32x2 __attribute__((ext_vector_type(2)));
__device__ __forceinline__ f32x2 gelu_pk(f32x2 v) {
    const f32x2 av = __builtin_elementwise_abs(v), d = av * 0.2316418882f + 1.0f;
    f32x2 t; t.x = __builtin_amdgcn_rcpf(d.x); t.y = __builtin_amdgcn_rcpf(d.y);
    f32x2 q = t * 0.5307027145f + (-0.7265760135f); q = q * t + 0.7107068705f; q = q * t + (-0.142248368f); q = q * t + 0.127414796f; q = q * t;
    const f32x2 s = (v * v) * (-0.72134752044f);
    f32x2 e; e.x = __builtin_amdgcn_exp2f(s.x); e.y = __builtin_amdgcn_exp2f(s.y);
    const f32x2 m = v * (q * e), r = v - m;
    f32x2 o; o.x = v.x < 0.f ? m.x : r.x; o.y = v.y < 0.f ? m.y : r.y; return o;
}

template <int ACT  > struct EpiBf16 {
    static constexpr bool PERM = true, AFTER_DRAIN = false; static_assert(ACT == 0 || ACT == 1, "EpiBf16: ACT is 0 (none) or 1 (gelu_pk)");
    bf16_t* O; int ldc; const float* bias; int split_cols; size_t split_stride; float scale0;
    __device__ __forceinline__ void operator()(const f32x4 (&acc)[2][2][4][2], const Unit& u, int wr, int wc, int fr, int fq) const {
        const int row0 = u.pm * BM + wr * 64 + fr; int colt = u.pn * BM; bf16_t* base = O;
        float sc = 1.f; if (split_cols) { const int t = colt / split_cols; base += (size_t)t * split_stride; colt -= t * split_cols; if (t == 0) sc = scale0; }
        const int col0 = colt + wc * 32 + 8 * fq, bcol0 = u.pn * BM + wc * 32 + 8 * fq;
        f32x4 bv[2][2];
#pragma unroll
        for (int bj = 0; bj < 2; ++bj)
#pragma unroll
            for (int n = 0; n < 2; ++n) bv[bj][n] = bias ? *(const f32x4*)(bias + bcol0 + bj * HALF + 4 * n) : (f32x4){0.f, 0.f, 0.f, 0.f};
#pragma unroll
        for (int ai = 0; ai < 2; ++ai)
#pragma unroll
            for (int m = 0; m < 4; ++m) { bf16_t* rowp = base + (size_t)(row0 + ai * HALF + m * 16) * ldc + col0;
#pragma unroll
                for (int bj = 0; bj < 2; ++bj) { f32x4 v0 = acc[ai][bj][m][0] + bv[bj][0], v1 = acc[ai][bj][m][1] + bv[bj][1];
                    if (ACT == 1) { f32x2 a = gelu_pk((f32x2){v0[0], v0[1]}), b = gelu_pk((f32x2){v0[2], v0[3]}), c = gelu_pk((f32x2){v1[0], v1[1]}), d = gelu_pk((f32x2){v1[2], v1[3]});
                        v0 = (f32x4){a.x, a.y, b.x, b.y}; v1 = (f32x4){c.x, c.y, d.x, d.y}; }
                    v0 = v0 * sc; v1 = v1 * sc; u32x4 w; w.x = cvt_pk_bf16(v0[0], v0[1]); w.y = cvt_pk_bf16(v0[2], v0[3]); w.z = cvt_pk_bf16(v1[0], v1[1]); w.w = cvt_pk_bf16(v1[2], v1[3]);
                    *(u32x4*)(rowp + bj * HALF) = w; } }
    }
};

struct PanelStats {
    unsigned* xbuf;
    unsigned* cnt;
    unsigned* tmo;
    int ntn; float eps;
    unsigned code;
    __device__ __forceinline__ bool run(const f32x4 (&v)[2][2][4][2], const Unit& u, int wr, int wc, int fr, int fq, PG8_LAS unsigned char* lds, int wid, int lane) const {
        typedef float f32x2v __attribute__((ext_vector_type(2)));
        PG8_LAS f32x2v* P = (PG8_LAS f32x2v*)lds;
        PG8_LAS f32x2v* S = (PG8_LAS f32x2v*)(lds + 8192);
        PG8_LAS unsigned* flag = (PG8_LAS unsigned*)(lds + 8192 + 2048);
#pragma unroll
        for (int ai = 0; ai < 2; ++ai)
#pragma unroll
            for (int m = 0; m < 4; ++m) {
                float s = 0.f;
#pragma unroll
                for (int bj = 0; bj < 2; ++bj)
#pragma unroll
                    for (int n = 0; n < 2; ++n) { const f32x4 x = v[ai][bj][m][n]; s += (x[0] + x[1]) + (x[2] + x[3]); }
                s += __shfl_xor(s, 16); s += __shfl_xor(s, 32);
                const float mw = s * (1.0f / 64.0f); float q = 0.f;
#pragma unroll
                for (int bj = 0; bj < 2; ++bj)
#pragma unroll
                    for (int n = 0; n < 2; ++n) { const f32x4 d = v[ai][bj][m][n] - mw; q += (d[0] * d[0] + d[1] * d[1]) + (d[2] * d[2] + d[3] * d[3]); }
                q += __shfl_xor(q, 16); q += __shfl_xor(q, 32);
                if (fq == 0) P[(ai * HALF + wr * 64 + m * 16 + fr) * 4 + wc] = (f32x2v){mw, q};
            }
        asm volatile("s_waitcnt lgkmcnt(0)" ::: "memory"); __builtin_amdgcn_s_barrier(); asm volatile("" ::: "memory");
#if defined(BROKEN_EXCHANGE_NO_WAIT)
#warning BROKEN CONTROL BUILD: the row-statistics exchange does not wait; results are wrong by design
        if (blockIdx.x >= 64) { const long long t0_ = clock64(); while (clock64() - t0_ < 60000) __builtin_amdgcn_s_sleep(8); }
#endif
        const int row = wid * 32 + (lane & 31);
        if (lane < 32) {
            const f32x2v a = P[row * 4 + 0], b = P[row * 4 + 1], c = P[row * 4 + 2], d = P[row * 4 + 3];
            const float mt = (a.x + b.x + c.x + d.x) * 0.25f;
            const float da = a.x - mt, db = b.x - mt, dc = c.x - mt, dd = d.x - mt;
            const float m2 = (a.y + b.y) + (c.y + d.y) + 64.0f * ((da * da + db * db) + (dc * dc + dd * dd));
            unsigned long long* slot = (unsigned long long*)xbuf + ((size_t)(u.pm * BM + row) * 4 + u.pn);
            __hip_atomic_store(slot, ((unsigned long long)__float_as_uint(m2) << 32) | __float_as_uint(mt), __ATOMIC_RELAXED, __HIP_MEMORY_SCOPE_AGENT);
        }
        asm volatile("s_waitcnt vmcnt(0)" ::: "memory");
        if (lane == 0) __hip_atomic_fetch_add(cnt + 64 * u.pm, 1u, __ATOMIC_RELAXED, __HIP_MEMORY_SCOPE_AGENT);
        if (wid == 0) {
            bool dead = false; const unsigned long long t0 = __builtin_amdgcn_s_memrealtime(); const unsigned want = 8u * (unsigned)ntn;
            for (;;) {
#if defined(BROKEN_EXCHANGE_NO_WAIT)
                break;
#endif
                if ((unsigned)__builtin_amdgcn_readfirstlane(__hip_atomic_load(cnt + 64 * u.pm, __ATOMIC_RELAXED, __HIP_MEMORY_SCOPE_AGENT)) >= want) break;
                if (__builtin_amdgcn_s_memrealtime() - t0 > 2000000ull) {
                    if (lane == 0) { unsigned expect = 0u; __hip_atomic_compare_exchange_strong(tmo + 1, &expect, code | (unsigned)(u.pm & 0xff), __ATOMIC_RELAXED, __ATOMIC_RELAXED, __HIP_MEMORY_SCOPE_AGENT);
                                     __hip_atomic_store(tmo, 1u, __ATOMIC_RELAXED, __HIP_MEMORY_SCOPE_AGENT); }
                    dead = true; break; }
                __builtin_amdgcn_s_sleep(2);
            }
            __builtin_amdgcn_fence(__ATOMIC_ACQUIRE, "agent");
            if (lane == 0) flag[0] = dead ? 1u : 0u;
        }
        asm volatile("s_waitcnt vmcnt(0) lgkmcnt(0)" ::: "memory"); __builtin_amdgcn_s_barrier(); asm volatile("" ::: "memory");
        const bool bad = flag[0] != 0u;
        if (lane < 32) {
            const unsigned long long* slot = (const unsigned long long*)xbuf + (size_t)(u.pm * BM + row) * 4; float mt[4], m2[4]; float ms = 0.f;
#pragma unroll
            for (int t = 0; t < 4; ++t) { if (t < ntn) { const unsigned long long w = __hip_atomic_load(slot + t, __ATOMIC_RELAXED, __HIP_MEMORY_SCOPE_AGENT); mt[t] = __uint_as_float((unsigned)w); m2[t] = __uint_as_float((unsigned)(w >> 32)); } else { mt[t] = 0.f; m2[t] = 0.f; } ms += mt[t]; }
            const float mean = ms / (float)ntn; float q = 0.f;
#pragma unroll
            for (int t = 0; t < 4; ++t) if (t < ntn) { const float dm = mt[t] - mean; q += m2[t] + 256.0f * dm * dm; }
            S[row] = (f32x2v){mean, 1.0f / sqrtf(q / (256.0f * (float)ntn) + eps)};
        }
        asm volatile("s_waitcnt lgkmcnt(0)" ::: "memory"); __builtin_amdgcn_s_barrier(); asm volatile("" ::: "memory");
        return bad;
    }
};
struct EpiLnRes {
    static constexpr bool PERM = false, AFTER_DRAIN = true;
    const float* base; float* out; int ldc; const float* bias; PanelStats st; unsigned poison;
    __device__ __forceinline__ void fused(f32x4 (&acc)[2][2][4][2], const Unit& u, int wr, int wc, int fr, int fq, PG8_LAS unsigned char* lds, int wid, int lane) const {
        typedef float f32x2v __attribute__((ext_vector_type(2)));
        const PG8_LAS f32x2v* S = (const PG8_LAS f32x2v*)(lds + 8192);
        const int col0 = u.pn * BM + wc * 32 + 4 * fq;
#pragma unroll
        for (int bj = 0; bj < 2; ++bj)
#pragma unroll
            for (int n = 0; n < 2; ++n) { const f32x4 bv = bias ? *(const f32x4*)(bias + col0 + bj * HALF + n * 16) : (f32x4){0.f, 0.f, 0.f, 0.f};
#pragma unroll
                for (int ai = 0; ai < 2; ++ai)
#pragma unroll
                    for (int m = 0; m < 4; ++m) acc[ai][bj][m][n] += bv; }
        f32x4 pre[4][2][2];
#pragma unroll
        for (int m = 0; m < 4; ++m) { const size_t off = (size_t)(u.pm * BM + wr * 64 + m * 16 + fr) * ldc + col0;
#pragma unroll
            for (int bj = 0; bj < 2; ++bj)
#pragma unroll
                for (int n = 0; n < 2; ++n) pre[m][bj][n] = *(const f32x4*)(base + off + bj * HALF + n * 16); }
        const bool bad = st.run(acc, u, wr, wc, fr, fq, lds, wid, lane) || poison != 0u;
        const float qnan = __builtin_nanf("");
#pragma unroll
        for (int ai = 0; ai < 2; ++ai)
#pragma unroll
            for (int m = 0; m < 4; ++m) { const int r = ai * HALF + wr * 64 + m * 16 + fr; const f32x2v sr = S[r]; const size_t off = (size_t)(u.pm * BM + r) * ldc + col0;
#pragma unroll
                for (int bj = 0; bj < 2; ++bj)
#pragma unroll
                    for (int n = 0; n < 2; ++n) { const f32x4 bs = ai == 0 ? pre[m][bj][n] : *(const f32x4*)(base + off + bj * HALF + n * 16); f32x4 o = bs + (acc[ai][bj][m][n] - sr.x) * sr.y;
                        if (bad) o = (f32x4){qnan, qnan, qnan, qnan}; *(f32x4*)(out + off + bj * HALF + n * 16) = o; }
                if (m & 1) asm volatile("" ::: "memory"); }
    }
};
struct EpiLnResLn {
    static constexpr bool PERM = false, AFTER_DRAIN = true;
    const float* base; float* out; bf16_t* xn; int ldc; const float* bias; PanelStats st1, st2; unsigned poison;
    __device__ __forceinline__ void fused(f32x4 (&acc)[2][2][4][2], const Unit& u, int wr, int wc, int fr, int fq, PG8_LAS unsigned char* lds, int wid, int lane) const {
        typedef float f32x2v __attribute__((ext_vector_type(2))); typedef unsigned u32x2v __attribute__((ext_vector_type(2)));
        const PG8_LAS f32x2v* S = (const PG8_LAS f32x2v*)(lds + 8192);
        const int col0 = u.pn * BM + wc * 32 + 4 * fq;
#pragma unroll
        for (int bj = 0; bj < 2; ++bj)
#pragma unroll
            for (int n = 0; n < 2; ++n) { const f32x4 bv = bias ? *(const f32x4*)(bias + col0 + bj * HALF + n * 16) : (f32x4){0.f, 0.f, 0.f, 0.f};
#pragma unroll
                for (int ai = 0; ai < 2; ++ai)
#pragma unroll
                    for (int m = 0; m < 4; ++m) acc[ai][bj][m][n] += bv; }
        bool bad = st1.run(acc, u, wr, wc, fr, fq, lds, wid, lane) || poison != 0u;
        const float qnan = __builtin_nanf("");
#pragma unroll
        for (int ai = 0; ai < 2; ++ai)
#pragma unroll
            for (int m = 0; m < 4; ++m) { const int r = ai * HALF + wr * 64 + m * 16 + fr; const f32x2v sr = S[r]; const size_t off = (size_t)(u.pm * BM + r) * ldc + col0;
#pragma unroll
                for (int bj = 0; bj < 2; ++bj)
#pragma unroll
                    for (int n = 0; n < 2; ++n) { const f32x4 bs = *(const f32x4*)(base + off + bj * HALF + n * 16); acc[ai][bj][m][n] = bs + (acc[ai][bj][m][n] - sr.x) * sr.y; }
                asm volatile("" : "+v"(acc[ai][0][m][0]), "+v"(acc[ai][0][m][1]), "+v"(acc[ai][1][m][0]), "+v"(acc[ai][1][m][1]));
                if (m & 1) asm volatile("" ::: "memory"); }
        const bool bad1 = bad;
        bad = st2.run(acc, u, wr, wc, fr, fq, lds, wid, lane) || bad;
#pragma unroll
        for (int ai = 0; ai < 2; ++ai)
#pragma unroll
            for (int m = 0; m < 4; ++m) { const int r = ai * HALF + wr * 64 + m * 16 + fr; const f32x2v sr = S[r]; const size_t off = (size_t)(u.pm * BM + r) * ldc + col0;
#pragma unroll
                for (int bj = 0; bj < 2; ++bj)
#pragma unroll
                    for (int n = 0; n < 2; ++n) { const f32x4 x1 = acc[ai][bj][m][n]; *(f32x4*)(out + off + bj * HALF + n * 16) = bad1 ? (f32x4){qnan, qnan, qnan, qnan} : x1;
                        const f32x4 o = (x1 - sr.x) * sr.y; u32x2v w; w.x = cvt_pk_bf16(o[0], o[1]); w.y = cvt_pk_bf16(o[2], o[3]);
                        if (bad) { w.x = 0x7fc07fc0u; w.y = 0x7fc07fc0u; } *(u32x2v*)(xn + off + bj * HALF + n * 16) = w; }
                asm volatile("" ::: "memory"); }
    }
};

template <class Epi, class Sched, bool ALIGN_EPI = false, bool SP2 = false, int AROW = 0>
__device__ __forceinline__ void gemm_phase(PG8_LAS unsigned char* lds, const Gemm g, const Sched& S, const Epi& E) {
    int tid_ = threadIdx.x; asm volatile("" : "+v"(tid_));
    const int tid = tid_, wid = __builtin_amdgcn_readfirstlane(tid >> 6), lane = tid & 63, wr = wid >> 2, wc = wid & 3, fr = lane & 15, fq = lane >> 4;
    const int K = g.K, nt = K / BK;
    unsigned voffA[2], voffB[2];
#pragma unroll
    for (int i = 0; i < 2; ++i) { int R, C; stage_rc(tid * 16 + i * 8192, R, C); const int Rb = Epi::PERM ? ((R & ~31) + perm32(R & 31)) : R;
        const int Ra = (AROW == 1) ? ((R & ~63) + 4 * (R & 15) + ((R >> 4) & 3)) : R;
        voffA[i] = (unsigned)(Ra * g.lda + C) * 2u; voffB[i] = (unsigned)(Rb * K + C) * 2u;
        if (AROW == 2) { const int tp = 4 * ((lane >> 2) & 3) + (lane >> 4), c = lane & 3;
            voffA[i] = (unsigned)((64 * i + 16 * (wid & 3) + tp) * g.lda + 32 * (wid >> 2) + 8 * c) * 2u; } }
    const size_t kstep = (size_t)(BK * 2);
    const size_t hstep = (size_t)HALF * K * 2;
    const size_t tstep = 2 * hstep;
    const size_t hstepA = (size_t)HALF * g.lda * 2, tstepA = 2 * hstepA;
    const unsigned ldsw = (unsigned)wid * 1024u;
    constexpr int PSTR = 1056, HTBA = (AROW == 2) ? 16 * PSTR : HTB;
    const int aoff = (AROW == 2) ? (wr * 8 + (fr >> 2)) * PSTR + 64 * (fr & 3) + 16 * fq : lds_byte(wr * 64 + fr, fq * 8), boff = lds_byte(wc * 32 + fr, fq * 8);
    constexpr int AM = (AROW == 2) ? 256 : 2048, AK = (AROW == 2) ? 4 * PSTR : 1024;
    const unsigned ldswA = (AROW == 2) ? (unsigned)wid * PSTR : (unsigned)wid * 1024u; constexpr unsigned ISTRA = (AROW == 2) ? 8u * PSTR : 8192u;
#define PG8_SA(b, h) (((b) * 2 + (h)) * HTBA)
#define PG8_SB(b, h) (4 * HTBA + ((b) * 2 + (h)) * HTB)
#define PG8_STAGEA(bufoff, gbase, voff) do { _Pragma("unroll") for (int _i = 0; _i < 2; ++_i) \
        __builtin_amdgcn_global_load_lds((const unsigned*)((const char*)(gbase) + (voff)[_i]), (PG8_LAS unsigned*)(lds + (bufoff) + ldswA + _i * ISTRA), 16, 0, 0); } while (0)
#define PG8_STAGE(bufoff, gbase, voff) do { _Pragma("unroll") for (int _i = 0; _i < 2; ++_i) \
        __builtin_amdgcn_global_load_lds((const unsigned*)((const char*)(gbase) + (voff)[_i]), (PG8_LAS unsigned*)(lds + (bufoff) + ldsw + _i * 8192), 16, 0, 0); } while (0)
#define PG8_LDA(dst, b, h) do { _Pragma("unroll") for (int m = 0; m < 4; ++m) _Pragma("unroll") for (int k = 0; k < 2; ++k) dst[m][k] = *(const PG8_LAS bf16x8*)(lds + PG8_SA(b, h) + aoff + m * AM + k * AK); } while (0)
#define PG8_LDB(dst, b, h) do { _Pragma("unroll") for (int n = 0; n < 2; ++n) _Pragma("unroll") for (int k = 0; k < 2; ++k) dst[n][k] = *(const PG8_LAS bf16x8*)(lds + PG8_SB(b, h) + boff + n * 2048 + k * 1024); } while (0)
#define PG8_MMA(ai, bj, At, Bt) do { __builtin_amdgcn_s_setprio(1); _Pragma("unroll") for (int m = 0; m < 4; ++m) _Pragma("unroll") for (int n = 0; n < 2; ++n) _Pragma("unroll") for (int k = 0; k < 2; ++k) \
        acc[ai][bj][m][n] = __builtin_amdgcn_mfma_f32_16x16x32_bf16(Bt[n][k], At[m][k], acc[ai][bj][m][n], 0, 0, 0); __builtin_amdgcn_s_setprio(0); } while (0)
#define PG8_WAIT_V(n) asm volatile("s_waitcnt vmcnt(" #n ")" ::: "memory")
#define PG8_WAIT_L(n) asm volatile("s_waitcnt lgkmcnt(" #n ")" ::: "memory")
#define PG8_BAR __builtin_amdgcn_s_barrier()
#define PG8_SCHED __builtin_amdgcn_sched_barrier(0)
    Unit cur, nxt; int ui = 0;
    if (!S.next(0, cur)) return;
    f32x4 acc[2][2][4][2];
#pragma unroll
    for (int a = 0; a < 2; ++a)
#pragma unroll
        for (int b = 0; b < 2; ++b)
#pragma unroll
            for (int m = 0; m < 4; ++m)
#pragma unroll
                for (int n = 0; n < 2; ++n) acc[a][b][m][n] = (f32x4){0.f, 0.f, 0.f, 0.f};
    bf16x8 At[4][2], B0[2][2], B1[2][2];
    const char* cA = (const char*)g.A + (size_t)cur.pm * tstepA; const char* cB = (const char*)g.Bt + (size_t)cur.pn * tstep;
    S.a_ready(cur);
    if constexpr (SP2) {
        PG8_STAGE(PG8_SB(0, 0), cB, voffB); PG8_STAGE(PG8_SB(0, 1), cB + hstep, voffB); PG8_STAGEA(PG8_SA(0, 0), cA, voffA); PG8_STAGEA(PG8_SA(0, 1), cA + hstepA, voffA);
        if (wr == 1) PG8_BAR;
        PG8_WAIT_V(2); PG8_BAR;
        PG8_STAGE(PG8_SB(1, 0), cB + kstep, voffB); PG8_STAGEA(PG8_SA(1, 0), cA + kstep, voffA); PG8_STAGE(PG8_SB(1, 1), cB + hstep + kstep, voffB);
        PG8_WAIT_V(6); PG8_BAR;
    } else {
        PG8_STAGE(PG8_SB(0, 0), cB, voffB); PG8_STAGEA(PG8_SA(0, 0), cA, voffA); PG8_STAGE(PG8_SB(0, 1), cB + hstep, voffB); PG8_STAGEA(PG8_SA(0, 1), cA + hstepA, voffA);
        if (wr == 1) PG8_BAR;
        PG8_WAIT_V(4); PG8_BAR;
        PG8_STAGE(PG8_SB(1, 0), cB + kstep, voffB); PG8_STAGEA(PG8_SA(1, 0), cA + kstep, voffA); PG8_STAGE(PG8_SB(1, 1), cB + hstep + kstep, voffB);
        PG8_WAIT_V(6); PG8_BAR;
    }
    for (;;) {
        const bool has_next = S.next(ui + 1, nxt);
        const char* nA = has_next ? (const char*)g.A + (size_t)nxt.pm * tstepA : cA; const char* nB = has_next ? (const char*)g.Bt + (size_t)nxt.pn * tstep : cB;
#pragma unroll 1
        for (int t = 0; t < nt; t += 2) {
            const bool last = (t == nt - 2);
            const char* a1 = cA + (size_t)(t + 1) * kstep;
            const char* a2 = last ? nA : cA + (size_t)(t + 2) * kstep; const char* b2 = last ? nB : cB + (size_t)(t + 2) * kstep;
            const char* a3 = a2 + kstep; const char* b3 = b2 + kstep;
            if (last && has_next) S.a_ready(nxt);
            if constexpr (SP2) {
            PG8_LDB(B0, 0, 0); PG8_LDB(B1, 0, 1); PG8_SCHED; PG8_LDA(At, 0, 0); PG8_STAGEA(PG8_SA(1, 1), a1 + hstepA, voffA);
            PG8_WAIT_V(8); PG8_WAIT_L(0); PG8_BAR; PG8_MMA(0, 0, At, B0); PG8_MMA(0, 1, At, B1); PG8_BAR; PG8_SCHED;
            PG8_LDA(At, 0, 1); PG8_STAGE(PG8_SB(0, 0), b2, voffB); PG8_STAGE(PG8_SB(0, 1), b2 + hstep, voffB); PG8_STAGEA(PG8_SA(0, 0), a2, voffA);
            PG8_WAIT_V(8); PG8_WAIT_L(0); PG8_BAR; PG8_MMA(1, 0, At, B0); PG8_MMA(1, 1, At, B1); PG8_BAR; PG8_SCHED;
            PG8_LDB(B0, 1, 0); PG8_LDB(B1, 1, 1); PG8_SCHED; PG8_LDA(At, 1, 0); PG8_STAGEA(PG8_SA(0, 1), a2 + hstepA, voffA);
            PG8_WAIT_V(8); PG8_WAIT_L(0); PG8_BAR; PG8_MMA(0, 0, At, B0); PG8_MMA(0, 1, At, B1); PG8_BAR; PG8_SCHED;
            PG8_LDA(At, 1, 1); PG8_STAGE(PG8_SB(1, 0), b3, voffB); PG8_STAGE(PG8_SB(1, 1), b3 + hstep, voffB); PG8_STAGEA(PG8_SA(1, 0), a3, voffA);
            PG8_WAIT_V(8); PG8_WAIT_L(0); PG8_BAR; PG8_MMA(1, 0, At, B0); PG8_MMA(1, 1, At, B1); PG8_BAR; PG8_SCHED;
            } else {
            PG8_LDB(B0, 0, 0); PG8_SCHED; PG8_LDA(At, 0, 0); PG8_STAGEA(PG8_SA(1, 1), a1 + hstepA, voffA);
            PG8_WAIT_L(8); PG8_BAR; PG8_WAIT_L(0); PG8_MMA(0, 0, At, B0); PG8_BAR; PG8_SCHED;
            PG8_LDB(B1, 0, 1); PG8_STAGE(PG8_SB(0, 0), b2, voffB);
            PG8_BAR; PG8_WAIT_L(0); PG8_MMA(0, 1, At, B1); PG8_BAR;
            PG8_LDA(At, 0, 1); PG8_STAGEA(PG8_SA(0, 0), a2, voffA);
            PG8_BAR; PG8_WAIT_L(0); PG8_MMA(1, 0, At, B0); PG8_BAR; PG8_SCHED;
            PG8_STAGE(PG8_SB(0, 1), b2 + hstep, voffB);
            PG8_WAIT_V(6); PG8_BAR; PG8_MMA(1, 1, At, B1); PG8_BAR;
            PG8_LDB(B0, 1, 0); PG8_SCHED; PG8_LDA(At, 1, 0); PG8_STAGEA(PG8_SA(0, 1), a2 + hstepA, voffA);
            PG8_WAIT_L(8); PG8_BAR; PG8_WAIT_L(0); PG8_MMA(0, 0, At, B0); PG8_BAR; PG8_SCHED;
            PG8_LDB(B1, 1, 1); PG8_STAGE(PG8_SB(1, 0), b3, voffB);
            PG8_BAR; PG8_WAIT_L(0); PG8_MMA(0, 1, At, B1); PG8_BAR;
            PG8_LDA(At, 1, 1); PG8_STAGEA(PG8_SA(1, 0), a3, voffA);
            PG8_BAR; PG8_WAIT_L(0); PG8_MMA(1, 0, At, B0); PG8_BAR; PG8_SCHED;
            PG8_STAGE(PG8_SB(1, 1), b3 + hstep, voffB);
            PG8_WAIT_V(6); PG8_BAR; PG8_MMA(1, 1, At, B1); PG8_BAR;
            }
        }
        if constexpr (ALIGN_EPI) { if (wr == 0) PG8_BAR; }
        if constexpr (!Epi::AFTER_DRAIN) { E(acc, cur, wr, wc, fr, fq); S.done(cur); }
        if (!has_next) break;
#pragma unroll
        for (int a = 0; a < 2; ++a)
#pragma unroll
            for (int b = 0; b < 2; ++b)
#pragma unroll
                for (int m = 0; m < 4; ++m)
#pragma unroll
                    for (int n = 0; n < 2; ++n) acc[a][b][m][n] = (f32x4){0.f, 0.f, 0.f, 0.f};
        cur = nxt; cA = nA; cB = nB; ++ui;
        if constexpr (ALIGN_EPI) { if (wr == 1) PG8_BAR; }
    }
    PG8_WAIT_V(0);
    if constexpr (!ALIGN_EPI) { if (wr == 0) PG8_BAR; }
    PG8_BAR;
    if constexpr (Epi::AFTER_DRAIN) { E.fused(acc, cur, wr, wc, fr, fq, lds, wid, lane); S.done(cur); }
#undef PG8_SA
#undef PG8_SB
#undef PG8_STAGE
#undef PG8_STAGEA
#undef PG8_LDA
#undef PG8_LDB
#undef PG8_MMA
#undef PG8_WAIT_V
#undef PG8_WAIT_L
#undef PG8_BAR
#undef PG8_SCHED
}
}

#ifndef PG8_SP2
#define PG8_SP2 true
#endif
#ifndef PG8_ALIGN
#define PG8_ALIGN true
#endif
#define GAS __attribute__((address_space(1)))
#define LAS __attribute__((address_space(3)))
typedef unsigned short bf16;
typedef unsigned v4u __attribute__((ext_vector_type(4)));
typedef float f32x4 __attribute__((ext_vector_type(4)));
typedef short bf16x8 __attribute__((ext_vector_type(8)));
typedef GAS unsigned gu32;
typedef GAS unsigned long long gu64;
#define RLX_AGENT __ATOMIC_RELAXED, __HIP_MEMORY_SCOPE_AGENT
#define LDS_WAIT() asm volatile("s_waitcnt lgkmcnt(0)" ::: "memory")
#define VM_WAIT() asm volatile("s_waitcnt vmcnt(0)" ::: "memory")
__device__ __forceinline__ unsigned long long rt() { return __builtin_amdgcn_s_memrealtime(); }
__device__ __forceinline__ unsigned f2bf(float f) { unsigned u = __builtin_bit_cast(unsigned, f); return (u + 0x7fffu + ((u >> 16) & 1u)) >> 16; }
typedef float pk_f32x2_t __attribute__((ext_vector_type(2))); typedef __bf16 pk_bf16x2_t __attribute__((ext_vector_type(2)));
__device__ __forceinline__ unsigned pk2(float lo, float hi) { pk_f32x2_t v = {lo, hi}; pk_bf16x2_t b = __builtin_convertvector(v, pk_bf16x2_t); return __builtin_bit_cast(unsigned, b); }

#define XB_TMO      128
#define XB_XCNT(j)  (256  + 64 * (j))
#define XB_XSUB(j)  (1280 + 64 * (j))
#define XB_XGEN(j)  (2304 + 64 * (j))
#define XB_TOP      3328
#define XB_TOPGEN   3392
#define XCD_BAR_WORDS 3456
#define XB_SPIN_CAP (1u << 18)

__device__ __forceinline__ unsigned xb_ld(unsigned* p)              { return __hip_atomic_load(p, __ATOMIC_RELAXED, __HIP_MEMORY_SCOPE_AGENT); }
__device__ __forceinline__ unsigned xb_add(unsigned* p, unsigned v) { return __hip_atomic_fetch_add(p, v, __ATOMIC_RELAXED, __HIP_MEMORY_SCOPE_AGENT); }
__device__ __forceinline__ unsigned xb_xcc_id() { return (unsigned)__builtin_amdgcn_s_getreg((3 << 11) | 20) & 0xFu; }
#define XB_SPIN(cond, bar) do { unsigned _sp = 0; while (cond) { __builtin_amdgcn_s_sleep(1); \
    if ((++_sp & 255u) == 0u) { if (xb_ld(&(bar)[XB_TMO])) break; if (_sp > XB_SPIN_CAP) { atomicAdd(&(bar)[XB_TMO], 1u); break; } } } } while (0)

struct XcdBarrier {
    unsigned* bar; unsigned x;
    volatile LAS unsigned* st;
};

__device__ __forceinline__ XcdBarrier xcd_barrier_post(unsigned* bar, volatile LAS unsigned* st) {
    XcdBarrier b; b.bar = bar; b.x = xb_xcc_id(); b.st = st;
    if (threadIdx.x == 0) (void)xb_add(&bar[XB_XCNT(b.x)], 1u);
    return b;
}
__device__ __forceinline__ void xcd_barrier_complete(unsigned* bar, unsigned x, unsigned& nloc, unsigned& nx) {
    const unsigned G = gridDim.x * gridDim.y * gridDim.z;
    unsigned sum, cnt, mine, sp = 0u;
    for (;;) {
        sum = 0u; cnt = 0u; mine = 0u;
#pragma unroll
        for (unsigned j = 0; j < 16; ++j) { const unsigned c = xb_ld(&bar[XB_XCNT(j)]); sum += c; cnt += (c > 0u) ? 1u : 0u; mine = (j == x) ? c : mine; }
        if (sum == G) break;
        __builtin_amdgcn_s_sleep(1);
        if ((++sp & 255u) == 0u) { if (xb_ld(&bar[XB_TMO])) break; if (sp > XB_SPIN_CAP) { atomicAdd(&bar[XB_TMO], 1u); break; } }
    }
    nloc = mine > 0u ? mine : 1u; nx = cnt > 0u ? cnt : 1u;
}

__device__ __forceinline__ void xcd_barrier(const XcdBarrier& b) {
    asm volatile("s_waitcnt vmcnt(0)" ::: "memory");
    __syncthreads();
    if (threadIdx.x == 0) {
        unsigned* bar = b.bar;
        __builtin_amdgcn_s_waitcnt(0);
        unsigned nloc = b.st[0], nx = b.st[1];
        if (nloc == 0u) { xcd_barrier_complete(bar, b.x, nloc, nx); b.st[0] = nloc; b.st[1] = nx; }
        const unsigned old = xb_add(&bar[XB_XSUB(b.x)], 1u);
        const unsigned gen = old / nloc;
        if (old + 1u == (gen + 1u) * nloc) {
            __builtin_amdgcn_fence(__ATOMIC_RELEASE, "agent");
            asm volatile("s_waitcnt vmcnt(0)" ::: "memory");
            const unsigned og = xb_add(&bar[XB_TOP], 1u);
            const unsigned tg = og / nx;
            if (og + 1u == (tg + 1u) * nx) xb_add(&bar[XB_TOPGEN], 1u);
            else XB_SPIN(xb_ld(&bar[XB_TOPGEN]) == tg, bar);
            __builtin_amdgcn_fence(__ATOMIC_ACQUIRE, "agent");
            xb_add(&bar[XB_XGEN(b.x)], 1u);
            asm volatile("s_waitcnt vmcnt(0)" ::: "memory");
        } else {
            XB_SPIN(xb_ld(&bar[XB_XGEN(b.x)]) == gen, bar);
            __builtin_amdgcn_fence(__ATOMIC_ACQUIRE, "agent");
            asm volatile("s_waitcnt vmcnt(0)" ::: "memory");
        }
    }
    __syncthreads();
}
__device__ __forceinline__ float bf2f(bf16 v) { return __builtin_bit_cast(float, (unsigned)v << 16); }
__device__ __forceinline__ float bflo(unsigned w) { return __builtin_bit_cast(float, w << 16); }
__device__ __forceinline__ float bfhi(unsigned w) { return __builtin_bit_cast(float, w & 0xffff0000u); }
__device__ __forceinline__ float silu_f(float v) { return v / (1.f + __expf(-v)); }
__device__ __forceinline__ float wave_sum(float v) {
#pragma unroll
    for (int o = 1; o < 64; o <<= 1) v += __shfl_xor(v, o);
    return v;
}


namespace at2 {
typedef short bf16x8 __attribute__((ext_vector_type(8)));
typedef short s16x4 __attribute__((ext_vector_type(4)));
typedef float f32x16 __attribute__((ext_vector_type(16)));
typedef unsigned u32x4 __attribute__((ext_vector_type(4)));
typedef float f32x2_t __attribute__((ext_vector_type(2))); typedef __bf16 bf16x2_t __attribute__((ext_vector_type(2)));
#define AT_LAS __attribute__((address_space(3)))
__device__ __forceinline__ int crow(int r, int hi) { return (r & 3) + 8 * (r >> 2) + 4 * hi; }
__device__ __forceinline__ void glds16(const void* gsrc, unsigned lds_dst) { unsigned keep;
    asm volatile("s_mov_b32 %0, m0\n\ts_mov_b32 m0, %2\n\ts_nop 0\n\tglobal_load_lds_dwordx4 %1, off\n\ts_mov_b32 m0, %0" : "=&s"(keep) : "v"(gsrc), "s"(lds_dst) : "memory"); }
__device__ __forceinline__ unsigned cvtpk(float lo, float hi) { f32x2_t v = {lo, hi}; bf16x2_t b = __builtin_convertvector(v, bf16x2_t); return __builtin_bit_cast(unsigned, b); }
__device__ __forceinline__ float swap_max(float m) { auto rr = __builtin_amdgcn_permlane32_swap(__float_as_uint(m), __float_as_uint(m), false, false); float r; asm("v_max_f32_e32 %0, %1, %2" : "=v"(r) : "v"(__uint_as_float(rr[0])), "v"(__uint_as_float(rr[1]))); return r; }
__device__ __forceinline__ float swap_sum(float m) { auto rr = __builtin_amdgcn_permlane32_swap(__float_as_uint(m), __float_as_uint(m), false, false); return __uint_as_float(rr[0]) + __uint_as_float(rr[1]); }

__device__ __forceinline__ float max3f(float a, float b, float c) { float r; asm("v_max3_f32 %0, %1, %2, %3" : "=v"(r) : "v"(a), "v"(b), "v"(c)); return r; }
__device__ __forceinline__ float max2f(float a, float b) { float r; asm("v_max_f32_e32 %0, %1, %2" : "=v"(r) : "v"(a), "v"(b)); return r; }
constexpr float NEGM = -1e30f;
constexpr float THR = 8.0f;

struct Tensors { const unsigned short* Q; const unsigned short* K; const unsigned short* V; unsigned short* O; int pq, pk, pv, po; };

__device__ __forceinline__ void pv(f32x16* o, int vb, bf16x8 pa0, bf16x8 pa1, bf16x8 pa2, bf16x8 pa3) {
#pragma unroll
    for (int d0 = 0; d0 < 2; ++d0) { s16x4 lo[4], hi[4];
#pragma unroll
        for (int ks = 0; ks < 4; ++ks) {
            asm volatile("ds_read_b64_tr_b16 %0,%1 offset:%c2" : "=&v"(lo[ks]) : "v"(vb), "i"(d0 * 4096 + ks * 1024) : "memory");
            asm volatile("ds_read_b64_tr_b16 %0,%1 offset:%c2" : "=&v"(hi[ks]) : "v"(vb), "i"(d0 * 4096 + ks * 1024 + 512) : "memory"); }
        asm volatile("s_waitcnt lgkmcnt(0)" ::: "memory"); __builtin_amdgcn_sched_barrier(0);
#define AT_PK(k) (bf16x8){lo[k][0], lo[k][1], lo[k][2], lo[k][3], hi[k][0], hi[k][1], hi[k][2], hi[k][3]}
        o[d0] = __builtin_amdgcn_mfma_f32_32x32x16_bf16(pa0, AT_PK(0), o[d0], 0, 0, 0);
        o[d0] = __builtin_amdgcn_mfma_f32_32x32x16_bf16(pa1, AT_PK(1), o[d0], 0, 0, 0);
        o[d0] = __builtin_amdgcn_mfma_f32_32x32x16_bf16(pa2, AT_PK(2), o[d0], 0, 0, 0);
        o[d0] = __builtin_amdgcn_mfma_f32_32x32x16_bf16(pa3, AT_PK(3), o[d0], 0, 0, 0);
#undef AT_PK
    }
}

typedef short v4i16_t __attribute__((ext_vector_type(4)));
__device__ __forceinline__ s16x4 vtr(const AT_LAS unsigned char* p) { return __builtin_bit_cast(s16x4, __builtin_amdgcn_ds_read_tr16_b64_v4i16((AT_LAS v4i16_t*)p)); }
__device__ __forceinline__ void pv2(f32x16* o, const AT_LAS unsigned char* vp, bf16x8 pa0, bf16x8 pa1, bf16x8 pa2, bf16x8 pa3) {
#pragma unroll
    for (int d0 = 0; d0 < 2; ++d0) { s16x4 lo[4], hi[4];
#pragma unroll
        for (int ks = 0; ks < 4; ++ks) { lo[ks] = vtr(vp + d0 * 4096 + ks * 1024); hi[ks] = vtr(vp + d0 * 4096 + ks * 1024 + 512); }
#define AT_PK(k) (bf16x8){lo[k][0], lo[k][1], lo[k][2], lo[k][3], hi[k][0], hi[k][1], hi[k][2], hi[k][3]}
        o[d0] = __builtin_amdgcn_mfma_f32_32x32x16_bf16(pa0, AT_PK(0), o[d0], 0, 0, 0);
        o[d0] = __builtin_amdgcn_mfma_f32_32x32x16_bf16(pa1, AT_PK(1), o[d0], 0, 0, 0);
        o[d0] = __builtin_amdgcn_mfma_f32_32x32x16_bf16(pa2, AT_PK(2), o[d0], 0, 0, 0);
        o[d0] = __builtin_amdgcn_mfma_f32_32x32x16_bf16(pa3, AT_PK(3), o[d0], 0, 0, 0);
#undef AT_PK
    }
}

template <int DQ, bool MOBA, bool QNORM, int G>
__device__ __forceinline__ void attn_unit(AT_LAS unsigned char* lds, const Tensors& T, long rowbase, int qb, const float* km, const float* qg, const float* tab) {
    constexpr int NKP = DQ / 8, NP = NKP + 8, SLOTB = NKP * 1024 + 8192, ND0 = DQ / 16;
    constexpr int NSLOT = 3 * G, LDS_WS = NSLOT * SLOTB, LDS_OST = 0;
    int tid_ = threadIdx.x; asm volatile("" : "+v"(tid_));
    const int tid = tid_, lane = tid & 63, r32 = lane & 31, hi = lane >> 5; const int wid = __builtin_amdgcn_readfirstlane(tid >> 6);
    const int q0 = qb * 256, NT = 4 * (qb + 1);
    const unsigned lds0 = (unsigned)(size_t)lds;
    AT_LAS float* wsf = (AT_LAS float*)(lds + LDS_WS) + wid * 64;
    asm volatile("s_waitcnt vmcnt(0)" ::: "memory");
    const unsigned short* src[3]; unsigned dsto[3];
#pragma unroll
    for (int k = 0; k < 3; ++k) { const int pi = wid + 8 * k;
        if (pi < NKP) { src[k] = (T.pk == 0) ? T.K + pi * 512 + lane * 8 : T.K + (rowbase + lane) * T.pk + 8 * pi; dsto[k] = pi * 1024; }
        else { const int v = pi - NKP; src[k] = (T.pv == 0) ? T.V + v * 512 + lane * 8 : T.V + (rowbase + 16 * (v & 3) + (lane >> 2)) * T.pv + 32 * (v >> 2) + 8 * (lane & 3); dsto[k] = NKP * 1024 + v * 1024; } }
    const long kstep = (T.pk == 0) ? (long)NKP * 512 : (long)64 * T.pk, vstep = (T.pv == 0) ? (long)4096 : (long)64 * T.pv;
#define AT_DMA(t, slot) do { _Pragma("unroll") for (int k_ = 0; k_ < 3; ++k_) { const int pi_ = wid + 8 * k_; if (pi_ < NP) { \
        const unsigned short* s_ = src[k_] + (long)(t) * ((pi_ < NKP) ? kstep : vstep); glds16(s_, (unsigned)__builtin_amdgcn_readfirstlane(lds0 + (slot) * SLOTB + dsto[k_])); } } } while (0)
    _Pragma("unroll") for (int i_ = 0; i_ < G; ++i_) AT_DMA(i_, i_);
    __builtin_amdgcn_sched_barrier(0);
    bf16x8 qr[ND0];
    { const unsigned short* Qw = T.Q + (rowbase + q0 + wid * 32 + r32) * T.pq + hi * 8;
#pragma unroll
      for (int d0 = 0; d0 < ND0; ++d0) qr[d0] = *(const bf16x8*)(Qw + d0 * 16); }
    __builtin_amdgcn_sched_barrier(0);
    if constexpr (QNORM) {
        float s = 0.f;
#pragma unroll
        for (int d0 = 0; d0 < ND0; ++d0)
#pragma unroll
            for (int j = 0; j < 8; ++j) { const float x = bf2f((unsigned short)qr[d0][j]); s += x * x; }
        s = swap_sum(s);
        const float rstd = 0.14724445073472677f / sqrtf(s * (1.f / 96.f) + 1e-6f);
#pragma unroll
        for (int d0 = 0; d0 < 4; ++d0) { const f32x4 g0 = *(const f32x4*)(qg + d0 * 16 + hi * 8), g1 = *(const f32x4*)(qg + d0 * 16 + hi * 8 + 4); u32x4 w;
            w.x = cvtpk(bf2f((unsigned short)qr[d0][0]) * rstd * g0.x, bf2f((unsigned short)qr[d0][1]) * rstd * g0.y); w.y = cvtpk(bf2f((unsigned short)qr[d0][2]) * rstd * g0.z, bf2f((unsigned short)qr[d0][3]) * rstd * g0.w);
            w.z = cvtpk(bf2f((unsigned short)qr[d0][4]) * rstd * g1.x, bf2f((unsigned short)qr[d0][5]) * rstd * g1.y); w.w = cvtpk(bf2f((unsigned short)qr[d0][6]) * rstd * g1.z, bf2f((unsigned short)qr[d0][7]) * rstd * g1.w);
            qr[d0] = __builtin_bit_cast(bf16x8, w); asm volatile("" : "+v"(qr[d0])); }
        { const int pos = q0 + wid * 32 + r32; const float* tb = tab + (pos * 16 + hi * 8) * 2; const float* ga = qg + 64 + hi * 8; const float* gb = qg + 80 + hi * 8; float oa[8], ob[8];
#pragma unroll
          for (int j = 0; j < 8; ++j) { const float x1 = bf2f((unsigned short)qr[4][j]) * rstd * ga[j], x2 = bf2f((unsigned short)qr[5][j]) * rstd * gb[j]; const float c = tb[2 * j], sn = tb[2 * j + 1]; oa[j] = x1 * c - x2 * sn; ob[j] = x1 * sn + x2 * c; }
          u32x4 w; w.x = cvtpk(oa[0], oa[1]); w.y = cvtpk(oa[2], oa[3]); w.z = cvtpk(oa[4], oa[5]); w.w = cvtpk(oa[6], oa[7]); qr[4] = __builtin_bit_cast(bf16x8, w);
          w.x = cvtpk(ob[0], ob[1]); w.y = cvtpk(ob[2], ob[3]); w.z = cvtpk(ob[4], ob[5]); w.w = cvtpk(ob[6], ob[7]); qr[5] = __builtin_bit_cast(bf16x8, w); }
    }
    __builtin_amdgcn_sched_barrier(0);
    unsigned sel = 0xffffffffu;
    if (MOBA) {
        sel = 0u; float gate[8];
#pragma unroll
        for (int j = 0; j < 7; ++j) { float a = 0.f;
            if (j < qb) { const float* kj = km + j * 512 + hi * 8;
#pragma unroll
                for (int d0 = 0; d0 < ND0; ++d0) { const f32x4 k0 = *(const f32x4*)(kj + d0 * 16), k1 = *(const f32x4*)(kj + d0 * 16 + 4);
                    a += bf2f((unsigned short)qr[d0][0]) * k0.x + bf2f((unsigned short)qr[d0][1]) * k0.y + bf2f((unsigned short)qr[d0][2]) * k0.z + bf2f((unsigned short)qr[d0][3]) * k0.w
                       + bf2f((unsigned short)qr[d0][4]) * k1.x + bf2f((unsigned short)qr[d0][5]) * k1.y + bf2f((unsigned short)qr[d0][6]) * k1.z + bf2f((unsigned short)qr[d0][7]) * k1.w; } }
            a = swap_sum(a); gate[j] = (j < qb) ? a : -INFINITY; }
        gate[7] = -INFINITY;
#pragma unroll
        for (int r = 0; r < 3; ++r) { int best = -1; float bv = -INFINITY;
#pragma unroll
            for (int j = 0; j < 8; ++j) if (!((sel >> j) & 1u) && gate[j] > bv) { bv = gate[j]; best = j; }
            if (best >= 0) sel |= 1u << best; }
    }
    __builtin_amdgcn_sched_barrier(0);
    float mhat = 0.f, l = 0.f; f32x16 o[2]; o[0] = f32x16{}; o[1] = f32x16{};
    const int qrel = wid * 32 + r32;
    const int vbl = ((lane >> 4) & 1) * 32 + (lane & 3) * 8 + (4 * hi + ((lane & 15) >> 2)) * 64;
#define AT_GROUP(u) do { asm volatile("s_waitcnt vmcnt(0) lgkmcnt(0)\n\ts_barrier" ::: "memory"); \
        if ((u) + G < NT) { _Pragma("unroll") for (int i_ = 0; i_ < G; ++i_) { const int tt_ = (u) + G + i_; AT_DMA(tt_, tt_ % NSLOT); } } } while (0)
#define AT_KLOAD(sl) do { const AT_LAS unsigned char* kb = lds + (sl) * SLOTB + hi * 1024 + r32 * 16; \
        _Pragma("unroll") for (int d0 = 0; d0 < ND0; ++d0) { kf[2 * d0] = *(const AT_LAS bf16x8*)(kb + d0 * 2048); kf[2 * d0 + 1] = *(const AT_LAS bf16x8*)(kb + d0 * 2048 + 512); } } while (0)
    bf16x8 kf[2 * ND0]; s16x4 vlo[8], vhi[8];
    AT_GROUP(0);
    AT_KLOAD(0);
    int slot = 0;
    for (int t = 0; t < NT; ++t) {
        __builtin_amdgcn_sched_barrier(0);
        { const AT_LAS unsigned char* vp = lds + slot * SLOTB + NKP * 1024 + vbl;
#pragma unroll
          for (int i = 0; i < 8; ++i) { vlo[i] = vtr(vp + (i >> 2) * 4096 + (i & 3) * 1024); vhi[i] = vtr(vp + (i >> 2) * 4096 + (i & 3) * 1024 + 512); } }
        __builtin_amdgcn_sched_barrier(0);
        f32x16 p0, p1;
#pragma unroll
        for (int d0 = 0; d0 < ND0; ++d0) {
            if (d0 == 0) { p0 = __builtin_amdgcn_mfma_f32_32x32x16_bf16(kf[0], qr[0], f32x16{}, 0, 0, 0); p1 = __builtin_amdgcn_mfma_f32_32x32x16_bf16(kf[1], qr[0], f32x16{}, 0, 0, 0); }
            else { p0 = __builtin_amdgcn_mfma_f32_32x32x16_bf16(kf[2 * d0], qr[d0], p0, 0, 0, 0); p1 = __builtin_amdgcn_mfma_f32_32x32x16_bf16(kf[2 * d0 + 1], qr[d0], p1, 0, 0, 0); } }
        __builtin_amdgcn_sched_barrier(0);
        const int nslot = (slot == NSLOT - 1) ? 0 : slot + 1;
        if (t + 1 < NT) { if (((t + 1) % G) == 0) AT_GROUP(t + 1); AT_KLOAD(nslot); }
        __builtin_amdgcn_sched_barrier(0);
        const int jb = t - (NT - 4);
        if (jb >= 0) { const int kb0 = 64 * jb + 4 * hi;
#pragma unroll
            for (int r = 0; r < 16; ++r) { const int kv = kb0 + (r & 3) + 8 * (r >> 2); if (kv > qrel) p0[r] = NEGM; if (kv + 32 > qrel) p1[r] = NEGM; } }
        else if (MOBA) { const bool keep = ((sel >> (t >> 2)) & 1u) != 0u;
            if (!__all(keep)) { if (!keep) {
#pragma unroll
                for (int r = 0; r < 16; ++r) { p0[r] = NEGM; p1[r] = NEGM; } } } }
        float rm;
        { float a_ = fmaxf(fmaxf(p0[0], p0[1]), p1[0]), b_ = fmaxf(fmaxf(p0[2], p0[3]), p1[1]); a_ = fmaxf(fmaxf(a_, p1[2]), p1[3]);
#pragma unroll
          for (int r = 4; r < 16; r += 4) { a_ = fmaxf(fmaxf(a_, p0[r]), p0[r + 1]); b_ = fmaxf(fmaxf(b_, p0[r + 2]), p0[r + 3]); a_ = fmaxf(fmaxf(a_, p1[r]), p1[r + 1]); b_ = fmaxf(fmaxf(b_, p1[r + 2]), p1[r + 3]); }
          rm = swap_max(fmaxf(a_, b_)) - mhat; }
        if (__any(rm > THR)) {
            const float dl = fmaxf(rm, 0.f); mhat += dl;
            const float alpha = __builtin_amdgcn_exp2f(-dl); l *= alpha;
            if (hi == 0) wsf[r32] = alpha;
            asm volatile("s_waitcnt lgkmcnt(0)" ::: "memory");
#pragma unroll
            for (int r = 0; r < 16; ++r) { const float f = wsf[crow(r, hi)]; o[0][r] *= f; o[1][r] *= f; }
        }
        float sacc = 0.f;
#pragma unroll
        for (int r = 0; r < 16; ++r) { p0[r] = __builtin_amdgcn_exp2f(p0[r] - mhat); p1[r] = __builtin_amdgcn_exp2f(p1[r] - mhat); sacc += p0[r] + p1[r]; }
        l += sacc;
        u32x4 pw[4];
        pw[0] = (u32x4){cvtpk(p0[0], p0[1]), cvtpk(p0[2], p0[3]), cvtpk(p0[4], p0[5]), cvtpk(p0[6], p0[7])};
        pw[1] = (u32x4){cvtpk(p0[8], p0[9]), cvtpk(p0[10], p0[11]), cvtpk(p0[12], p0[13]), cvtpk(p0[14], p0[15])};
        pw[2] = (u32x4){cvtpk(p1[0], p1[1]), cvtpk(p1[2], p1[3]), cvtpk(p1[4], p1[5]), cvtpk(p1[6], p1[7])};
        pw[3] = (u32x4){cvtpk(p1[8], p1[9]), cvtpk(p1[10], p1[11]), cvtpk(p1[12], p1[13]), cvtpk(p1[14], p1[15])};
        __builtin_amdgcn_sched_barrier(0);
#pragma unroll
        for (int d0 = 0; d0 < 2; ++d0)
#pragma unroll
            for (int ks = 0; ks < 4; ++ks) { const int i = d0 * 4 + ks;
                o[d0] = __builtin_amdgcn_mfma_f32_32x32x16_bf16(__builtin_bit_cast(bf16x8, pw[ks]), (bf16x8){vlo[i][0], vlo[i][1], vlo[i][2], vlo[i][3], vhi[i][0], vhi[i][1], vhi[i][2], vhi[i][3]}, o[d0], 0, 0, 0); }
        slot = nslot;
    }
#undef AT_GROUP
#undef AT_KLOAD
#undef AT_DMA
    asm volatile("s_waitcnt lgkmcnt(0)\n\ts_barrier" ::: "memory");
    l = swap_sum(l);
    if (hi == 0) wsf[32 + r32] = l;
    asm volatile("s_waitcnt lgkmcnt(0)" ::: "memory");
    float rli[16];
#pragma unroll
    for (int r = 0; r < 16; ++r) rli[r] = __builtin_amdgcn_rcpf(wsf[32 + crow(r, hi)]);
    unsigned short* Ow = T.O + (rowbase + q0 + wid * 32) * T.po;
    { AT_LAS unsigned short* stg = (AT_LAS unsigned short*)(lds + LDS_OST) + wid * 2048;
#pragma unroll
      for (int r = 0; r < 16; ++r) { const int orow = crow(r, hi);
#pragma unroll
          for (int d0 = 0; d0 < 2; ++d0) stg[orow * 64 + d0 * 32 + r32] = (unsigned short)f2bf(o[d0][r] * rli[r]); }
      asm volatile("s_waitcnt lgkmcnt(0)" ::: "memory");
#pragma unroll
      for (int i = 0; i < 4; ++i) { const int row = i * 8 + (lane >> 3), ch = lane & 7; const u32x4 v = *(const AT_LAS u32x4*)(stg + row * 64 + ch * 8); *(u32x4*)(Ow + (long)row * T.po + ch * 8) = v; } }
    asm volatile("s_waitcnt lgkmcnt(0)\n\ts_barrier" ::: "memory");
}
template <int DQ, bool MOBA, bool QNORM, int G>
__device__ __forceinline__ void attn_unit_p(AT_LAS unsigned char* lds, const Tensors& T, long rowbase, int qb, const float* km, const float* qg, const float* tab, float kbound, int tbase, bool prefetched, bool has_next) {
    constexpr int NKP = DQ / 8, NP = NKP + 8, SLOTB = NKP * 1024 + 8192, ND0 = DQ / 16;
    constexpr int NSLOT = 3 * G, LDS_WS = NSLOT * SLOTB, LDS_OST = LDS_WS + 2048;
    int tid_ = threadIdx.x; asm volatile("" : "+v"(tid_));
    const int tid = tid_, lane = tid & 63, r32 = lane & 31, hi = lane >> 5; const int wid = __builtin_amdgcn_readfirstlane(tid >> 6);
    const int q0 = qb * 256, NT = 4 * (qb + 1);
    const unsigned lds0 = (unsigned)(size_t)lds;
    AT_LAS float* wsf = (AT_LAS float*)(lds + LDS_WS) + wid * 64;
    asm volatile("s_waitcnt vmcnt(0)" ::: "memory");
    unsigned soff[3], dsto[3];
#pragma unroll
    for (int k = 0; k < 3; ++k) { const int pi = wid + 8 * k;
        if (pi < NKP) { soff[k] = (T.pk == 0) ? (unsigned)(pi * 512 + lane * 8) : (unsigned)((rowbase + lane) * T.pk + 8 * pi); dsto[k] = pi * 1024; }
        else { const int v = pi - NKP; soff[k] = (T.pv == 0) ? (unsigned)(v * 512 + lane * 8) : (unsigned)((rowbase + 16 * (v & 3) + (lane >> 2)) * T.pv + 32 * (v >> 2) + 8 * (lane & 3)); dsto[k] = NKP * 1024 + v * 1024; } }
    const unsigned kstep = (T.pk == 0) ? (unsigned)NKP * 512u : 64u * (unsigned)T.pk, vstep = (T.pv == 0) ? 4096u : 64u * (unsigned)T.pv;
#define AT_DMA(t, slot) do { _Pragma("unroll") for (int k_ = 0; k_ < 3; ++k_) { const int pi_ = wid + 8 * k_; if (pi_ < NP) { \
        const unsigned short* s_ = ((pi_ < NKP) ? T.K : T.V) + (size_t)(soff[k_] + (unsigned)(t) * ((pi_ < NKP) ? kstep : vstep)); glds16(s_, (unsigned)__builtin_amdgcn_readfirstlane(lds0 + (slot) * SLOTB + dsto[k_])); } } } while (0)
    if (!prefetched) { _Pragma("unroll") for (int i_ = 0; i_ < G; ++i_) AT_DMA(i_, (tbase + i_) % NSLOT); }
    __builtin_amdgcn_sched_barrier(0);
    bf16x8 qr[ND0];
    { const unsigned short* Qw = T.Q + (rowbase + q0 + wid * 32 + r32) * T.pq + hi * 8;
#pragma unroll
      for (int d0 = 0; d0 < ND0; ++d0) qr[d0] = *(const bf16x8*)(Qw + d0 * 16); }
    __builtin_amdgcn_sched_barrier(0);
    if constexpr (QNORM) {
        float s = 0.f;
#pragma unroll
        for (int d0 = 0; d0 < ND0; ++d0)
#pragma unroll
            for (int j = 0; j < 8; ++j) { const float x = bf2f((unsigned short)qr[d0][j]); s += x * x; }
        s = swap_sum(s);
        const float rstd = 0.14724445073472677f / sqrtf(s * (1.f / 96.f) + 1e-6f);
#pragma unroll
        for (int d0 = 0; d0 < 4; ++d0) { const f32x4 g0 = *(const f32x4*)(qg + d0 * 16 + hi * 8), g1 = *(const f32x4*)(qg + d0 * 16 + hi * 8 + 4); u32x4 w;
            w.x = cvtpk(bf2f((unsigned short)qr[d0][0]) * rstd * g0.x, bf2f((unsigned short)qr[d0][1]) * rstd * g0.y); w.y = cvtpk(bf2f((unsigned short)qr[d0][2]) * rstd * g0.z, bf2f((unsigned short)qr[d0][3]) * rstd * g0.w);
            w.z = cvtpk(bf2f((unsigned short)qr[d0][4]) * rstd * g1.x, bf2f((unsigned short)qr[d0][5]) * rstd * g1.y); w.w = cvtpk(bf2f((unsigned short)qr[d0][6]) * rstd * g1.z, bf2f((unsigned short)qr[d0][7]) * rstd * g1.w);
            qr[d0] = __builtin_bit_cast(bf16x8, w); asm volatile("" : "+v"(qr[d0])); }
        { const int pos = q0 + wid * 32 + r32; const float* tb = tab + (pos * 16 + hi * 8) * 2; const float* ga = qg + 64 + hi * 8; const float* gb = qg + 80 + hi * 8; float oa[8], ob[8];
#pragma unroll
          for (int j = 0; j < 8; ++j) { const float x1 = bf2f((unsigned short)qr[4][j]) * rstd * ga[j], x2 = bf2f((unsigned short)qr[5][j]) * rstd * gb[j]; const float c = tb[2 * j], sn = tb[2 * j + 1]; oa[j] = x1 * c - x2 * sn; ob[j] = x1 * sn + x2 * c; }
          u32x4 w; w.x = cvtpk(oa[0], oa[1]); w.y = cvtpk(oa[2], oa[3]); w.z = cvtpk(oa[4], oa[5]); w.w = cvtpk(oa[6], oa[7]); qr[4] = __builtin_bit_cast(bf16x8, w);
          w.x = cvtpk(ob[0], ob[1]); w.y = cvtpk(ob[2], ob[3]); w.z = cvtpk(ob[4], ob[5]); w.w = cvtpk(ob[6], ob[7]); qr[5] = __builtin_bit_cast(bf16x8, w); }
    }
    __builtin_amdgcn_sched_barrier(0);
    unsigned sel = 0xffffffffu;
    if (MOBA) {
        sel = 0u; float gate[8];
#pragma unroll
        for (int j = 0; j < 7; ++j) { float a = 0.f;
            if (j < qb) { const float* kj = km + j * 512 + hi * 8;
#pragma unroll
                for (int d0 = 0; d0 < ND0; ++d0) { const f32x4 k0 = *(const f32x4*)(kj + d0 * 16), k1 = *(const f32x4*)(kj + d0 * 16 + 4);
                    a += bf2f((unsigned short)qr[d0][0]) * k0.x + bf2f((unsigned short)qr[d0][1]) * k0.y + bf2f((unsigned short)qr[d0][2]) * k0.z + bf2f((unsigned short)qr[d0][3]) * k0.w
                       + bf2f((unsigned short)qr[d0][4]) * k1.x + bf2f((unsigned short)qr[d0][5]) * k1.y + bf2f((unsigned short)qr[d0][6]) * k1.z + bf2f((unsigned short)qr[d0][7]) * k1.w; } }
            a = swap_sum(a); gate[j] = (j < qb) ? a : -INFINITY; }
        gate[7] = -INFINITY;
#pragma unroll
        for (int r = 0; r < 3; ++r) { int best = -1; float bv = -INFINITY;
#pragma unroll
            for (int j = 0; j < 8; ++j) if (!((sel >> j) & 1u) && gate[j] > bv) { bv = gate[j]; best = j; }
            if (best >= 0) sel |= 1u << best; }
    }
    __builtin_amdgcn_sched_barrier(0);
    float l = 0.f; f32x16 o[2]; o[0] = f32x16{}; o[1] = f32x16{};
    f32x16 negm;
    { float qss = 0.f;
#pragma unroll
      for (int d0 = 0; d0 < ND0; ++d0)
#pragma unroll
          for (int j = 0; j < 8; ++j) { const float x = bf2f((unsigned short)qr[d0][j]); qss += x * x; }
      qss = swap_sum(qss); const float mrow = sqrtf(qss) * kbound;
#pragma unroll
      for (int r = 0; r < 16; ++r) negm[r] = -mrow;
      asm volatile("" : "+v"(negm)); }

    const int qrel = wid * 32 + r32;
    const int vbl = ((lane >> 4) & 1) * 32 + (lane & 3) * 8 + (4 * hi + ((lane & 15) >> 2)) * 64;
#define AT_GROUP(u) do { asm volatile("s_waitcnt vmcnt(0) lgkmcnt(0)\n\ts_barrier" ::: "memory"); \
        if ((u) + G < NT) { _Pragma("unroll") for (int i_ = 0; i_ < G; ++i_) { const int tt_ = (u) + G + i_; AT_DMA(tt_, (tbase + tt_) % NSLOT); } } \
        else if (has_next) { _Pragma("unroll") for (int i_ = 0; i_ < G; ++i_) AT_DMA(i_, (tbase + NT + i_) % NSLOT); } } while (0)
#define AT_KLOAD(sl) do { const AT_LAS unsigned char* kb = lds + (sl) * SLOTB + hi * 1024 + r32 * 16; \
        _Pragma("unroll") for (int d0 = 0; d0 < ND0; ++d0) { kf[2 * d0] = *(const AT_LAS bf16x8*)(kb + d0 * 2048); kf[2 * d0 + 1] = *(const AT_LAS bf16x8*)(kb + d0 * 2048 + 512); } } while (0)
#define AT_VLOAD(sl) do { const AT_LAS unsigned char* vp = lds + (sl) * SLOTB + NKP * 1024 + vbl; \
        _Pragma("unroll") for (int i = 0; i < 8; ++i) { vlo[i] = vtr(vp + (i >> 2) * 4096 + (i & 3) * 1024); vhi[i] = vtr(vp + (i >> 2) * 4096 + (i & 3) * 1024 + 512); } } while (0)
#define AT_SUMPACK() do { float sacc = 0.f; \
        _Pragma("unroll") for (int r = 0; r < 16; ++r) sacc += c0[r] + c1[r]; \
        l += sacc; \
        pw[0] = (u32x4){cvtpk(c0[0], c0[1]), cvtpk(c0[2], c0[3]), cvtpk(c0[4], c0[5]), cvtpk(c0[6], c0[7])}; \
        pw[1] = (u32x4){cvtpk(c0[8], c0[9]), cvtpk(c0[10], c0[11]), cvtpk(c0[12], c0[13]), cvtpk(c0[14], c0[15])}; \
        pw[2] = (u32x4){cvtpk(c1[0], c1[1]), cvtpk(c1[2], c1[3]), cvtpk(c1[4], c1[5]), cvtpk(c1[6], c1[7])}; \
        pw[3] = (u32x4){cvtpk(c1[8], c1[9]), cvtpk(c1[10], c1[11]), cvtpk(c1[12], c1[13]), cvtpk(c1[14], c1[15])}; } while (0)
#define AT_QKT(N0, N1) do { _Pragma("unroll") for (int d0 = 0; d0 < ND0; ++d0) { \
            if (d0 == 0) { N0 = __builtin_amdgcn_mfma_f32_32x32x16_bf16(kf[0], qr[0], negm, 0, 0, 0); N1 = __builtin_amdgcn_mfma_f32_32x32x16_bf16(kf[1], qr[0], negm, 0, 0, 0); } \
            else { N0 = __builtin_amdgcn_mfma_f32_32x32x16_bf16(kf[2 * d0], qr[d0], N0, 0, 0, 0); N1 = __builtin_amdgcn_mfma_f32_32x32x16_bf16(kf[2 * d0 + 1], qr[d0], N1, 0, 0, 0); } } } while (0)
#define AT_DECIDE(tt) do { \
        { const int jb = (tt) - (NT - 4); \
          if (jb >= 0) { const int kb0 = 64 * jb + 4 * hi; \
              _Pragma("unroll") for (int r = 0; r < 16; ++r) { const int kv = kb0 + (r & 3) + 8 * (r >> 2); if (kv > qrel) c0[r] = NEGM; if (kv + 32 > qrel) c1[r] = NEGM; } } \
          else if (MOBA) { const bool keep = ((sel >> ((tt) >> 2)) & 1u) != 0u; \
              if (!__all(keep)) { if (!keep) { _Pragma("unroll") for (int r = 0; r < 16; ++r) { c0[r] = NEGM; c1[r] = NEGM; } } } } } \
        if ((tt) + 1 < NT && (((tt) + 1) % G) == 0) AT_GROUP((tt) + 1); } while (0)
#define AT_EXPS() do { _Pragma("unroll") for (int r = 0; r < 16; ++r) { c0[r] = __builtin_amdgcn_exp2f(c0[r]); c1[r] = __builtin_amdgcn_exp2f(c1[r]); } } while (0)
#define AT_PV() do { _Pragma("unroll") for (int d0 = 0; d0 < 2; ++d0) _Pragma("unroll") for (int ks = 0; ks < 4; ++ks) { const int i = d0 * 4 + ks; \
            o[d0] = __builtin_amdgcn_mfma_f32_32x32x16_bf16(__builtin_bit_cast(bf16x8, pw[ks]), (bf16x8){vlo[i][0], vlo[i][1], vlo[i][2], vlo[i][3], vhi[i][0], vhi[i][1], vhi[i][2], vhi[i][3]}, o[d0], 0, 0, 0); } } while (0)
#define AT_SGB(mask, n) __builtin_amdgcn_sched_group_barrier(mask, n, 0)
    constexpr int NG = 2 * ND0;
    bf16x8 kf[2 * ND0]; s16x4 vlo[8], vhi[8]; u32x4 pw[4]; f32x16 c0, c1;
    AT_GROUP(0);
    AT_KLOAD(tbase % NSLOT);
    AT_QKT(c0, c1);
    AT_DECIDE(0);
    AT_KLOAD((tbase + 1) % NSLOT);
    AT_EXPS();
    int slot = (tbase + 1) % NSLOT, pslot = tbase % NSLOT;
    for (int t = 1; t < NT; ++t) {
        const int nslot = (t + 1 < NT) ? ((slot == NSLOT - 1) ? 0 : slot + 1) : slot;
        __builtin_amdgcn_sched_barrier(0);
        { f32x16 n0, n1; float sacc = 0.f;
          const AT_LAS unsigned char* vp = lds + pslot * SLOTB + NKP * 1024 + vbl;
#pragma unroll
          for (int i = 0; i < NG; ++i) {
              if (i >= NG - 2) { const int vi = i - (NG - 2); vlo[vi] = vtr(vp + (vi >> 2) * 4096 + (vi & 3) * 1024); vhi[vi] = vtr(vp + (vi >> 2) * 4096 + (vi & 3) * 1024 + 512); }
              const int d0 = i >> 1;
              if (i & 1) n1 = (d0 == 0) ? __builtin_amdgcn_mfma_f32_32x32x16_bf16(kf[i], qr[d0], negm, 0, 0, 0) : __builtin_amdgcn_mfma_f32_32x32x16_bf16(kf[i], qr[d0], n1, 0, 0, 0);
              else n0 = (d0 == 0) ? __builtin_amdgcn_mfma_f32_32x32x16_bf16(kf[i], qr[d0], negm, 0, 0, 0) : __builtin_amdgcn_mfma_f32_32x32x16_bf16(kf[i], qr[d0], n0, 0, 0, 0);
#pragma unroll
              for (int rr = (i * 32) / NG; rr < ((i + 1) * 32) / NG; ++rr) sacc += (rr < 16) ? c0[rr] : c1[rr - 16];
#pragma unroll
              for (int ww = (i * 16) / NG; ww < ((i + 1) * 16) / NG; ++ww) { const int e = 2 * ww; pw[ww >> 2][ww & 3] = (e < 16) ? cvtpk(c0[e], c0[e + 1]) : cvtpk(c1[e - 16], c1[e - 15]); }
              __builtin_amdgcn_sched_barrier(0); }
          l += sacc; c0 = n0; c1 = n1; }
        AT_DECIDE(t);
        __builtin_amdgcn_sched_barrier(0);
        { const AT_LAS unsigned char* kb = lds + nslot * SLOTB + hi * 1024 + r32 * 16; const AT_LAS unsigned char* vpB = lds + pslot * SLOTB + NKP * 1024 + vbl;
#pragma unroll
          for (int i = 0; i < 8; ++i) {
              if (i + 2 < 8) { const int vi = i + 2; vlo[vi] = vtr(vpB + (vi >> 2) * 4096 + (vi & 3) * 1024); vhi[vi] = vtr(vpB + (vi >> 2) * 4096 + (vi & 3) * 1024 + 512); }
              if (i >= 2 && i < 6) {
#pragma unroll
                  for (int q = (i - 2) * NG / 4; q < (i - 1) * NG / 4; ++q) kf[q] = *(const AT_LAS bf16x8*)(kb + (q >> 1) * 2048 + (q & 1) * 512); }
              o[i >> 2] = __builtin_amdgcn_mfma_f32_32x32x16_bf16(__builtin_bit_cast(bf16x8, pw[i & 3]), (bf16x8){vlo[i][0], vlo[i][1], vlo[i][2], vlo[i][3], vhi[i][0], vhi[i][1], vhi[i][2], vhi[i][3]}, o[i >> 2], 0, 0, 0);
#pragma unroll
              for (int rr = 4 * i; rr < 4 * i + 4; ++rr) { if (rr < 16) c0[rr] = __builtin_amdgcn_exp2f(c0[rr]); else c1[rr - 16] = __builtin_amdgcn_exp2f(c1[rr - 16]); }
              __builtin_amdgcn_sched_barrier(0); } }
        pslot = slot; slot = nslot;
    }
    AT_VLOAD(pslot);
    AT_SUMPACK();
    AT_PV();
#undef AT_GROUP
#undef AT_KLOAD
#undef AT_VLOAD
#undef AT_SUMPACK
#undef AT_QKT
#undef AT_DECIDE
#undef AT_EXPS
#undef AT_PV
#undef AT_SGB
#undef AT_DMA
    asm volatile("s_waitcnt lgkmcnt(0)\n\ts_barrier" ::: "memory");
    l = swap_sum(l);
    if (hi == 0) wsf[32 + r32] = l;
    asm volatile("s_waitcnt lgkmcnt(0)" ::: "memory");
    float rli[16];
#pragma unroll
    for (int r = 0; r < 16; ++r) rli[r] = __builtin_amdgcn_rcpf(wsf[32 + crow(r, hi)]);
    unsigned short* Ow = T.O + (rowbase + q0 + wid * 32) * T.po;
    { AT_LAS unsigned short* stg = (AT_LAS unsigned short*)(lds + LDS_OST) + wid * 2048;
#pragma unroll
      for (int r = 0; r < 16; ++r) { const int orow = crow(r, hi);
#pragma unroll
          for (int d0 = 0; d0 < 2; ++d0) stg[orow * 64 + d0 * 32 + r32] = (unsigned short)f2bf(o[d0][r] * rli[r]); }
      asm volatile("s_waitcnt lgkmcnt(0)" ::: "memory");
#pragma unroll
      for (int i = 0; i < 4; ++i) { const int row = i * 8 + (lane >> 3), ch = lane & 7; const u32x4 v = *(const AT_LAS u32x4*)(stg + row * 64 + ch * 8); *(u32x4*)(Ow + (long)row * T.po + ch * 8) = v; } }
    asm volatile("s_waitcnt lgkmcnt(0)\n\ts_barrier" ::: "memory");
}
#undef AT_LAS
}

namespace ssd {
typedef short bf16x8 __attribute__((ext_vector_type(8)));
typedef short v4i16_t __attribute__((ext_vector_type(4)));
typedef float f32x16 __attribute__((ext_vector_type(16)));
typedef unsigned u32x4 __attribute__((ext_vector_type(4)));
#define SS_LAS __attribute__((address_space(3)))
__device__ __forceinline__ int crow(int r, int hi) { return (r & 3) + 8 * (r >> 2) + 4 * hi; }
__device__ __forceinline__ v4i16_t vtr(const SS_LAS unsigned char* p) { return __builtin_amdgcn_ds_read_tr16_b64_v4i16((SS_LAS v4i16_t*)p); }
__device__ __forceinline__ bf16x8 tr_frag(const SS_LAS unsigned char* img, int pitch, int k0, int c0, int lane) {
    const int g4 = lane >> 4, q = (lane & 15) >> 2, p4 = lane & 3;
    const SS_LAS unsigned char* a = img + (k0 + 8 * (g4 >> 1) + q) * pitch + (c0 + 16 * (g4 & 1) + 4 * p4) * 2;
    const v4i16_t lo = vtr(a), hi4 = vtr(a + 4 * pitch);
    return (bf16x8){lo[0], lo[1], lo[2], lo[3], hi4[0], hi4[1], hi4[2], hi4[3]};
}
__device__ __forceinline__ bf16x8 row_frag(const SS_LAS unsigned char* img, int pitch, int r0, int k0, int lane) {
    return *(const SS_LAS bf16x8*)(img + (r0 + (lane & 31)) * pitch + (k0 + 8 * (lane >> 5)) * 2);
}

constexpr int PX4 = 576;
constexpr int PB_T = 320;
constexpr int PR = 272;
constexpr int PX1 = 192;

__device__ __forceinline__ void dt_cs(int t0, int g, const float* DTR, const float* dtb, const float* alog, SS_LAS float* csl, SS_LAS float* dtl, SS_LAS float* wtot, int tid, int lane, int wid) {
    const int l = tid >> 2, hh = tid & 3, h = 4 * g + hh;
    const float r = DTR[(size_t)(t0 + l) * 8 + h] + dtb[h]; const float ex = __expf(fminf(r, 20.f)); const float dt = (r > 20.f) ? r : ((ex < 0.01f) ? ex * (1.f - ex * (0.5f - ex * 0.33333333f)) : __logf(1.f + ex));
    float v = dt * (-expf(alog[h]));
#pragma unroll
    for (int off = 4; off < 64; off <<= 1) { const float t = __shfl_up(v, off); if (lane >= off) v += t; }
    if (lane >= 60) wtot[wid * 4 + hh] = v;
    __syncthreads();
    float base = 0.f;
    for (int w = 0; w < wid; ++w) base += wtot[w * 4 + hh];
    csl[tid] = v + base; dtl[tid] = dt;
    __syncthreads();
}
__device__ __forceinline__ void conv_load(u32x4 (&x)[19], const unsigned short* raw, int t0, int l0, int col) {
    const int pos0 = t0 & 2047;
#pragma unroll
    for (int i = 0; i < 19; ++i) { const int l = l0 - 3 + i; x[i] = (u32x4){0u, 0u, 0u, 0u}; if (pos0 + l >= 0) x[i] = *(const u32x4*)(raw + (size_t)(t0 + l) * 1024 + col); }
}
template <bool SCALED> __device__ __forceinline__ void conv_compute(const u32x4 (&x)[19], int l0, int col, const float* cw, const float* cb, SS_LAS unsigned char* img, int pitch, const SS_LAS float* sc) {
    float w[4][8], b[8];
#pragma unroll
    for (int k = 0; k < 4; ++k) { const f32x4 a = *(const f32x4*)(cw + k * 1024 + col), c = *(const f32x4*)(cw + k * 1024 + col + 4); w[k][0] = a.x; w[k][1] = a.y; w[k][2] = a.z; w[k][3] = a.w; w[k][4] = c.x; w[k][5] = c.y; w[k][6] = c.z; w[k][7] = c.w; }
    { const f32x4 a = *(const f32x4*)(cb + col), c = *(const f32x4*)(cb + col + 4); b[0] = a.x; b[1] = a.y; b[2] = a.z; b[3] = a.w; b[4] = c.x; b[5] = c.y; b[6] = c.z; b[7] = c.w; }
#pragma unroll
    for (int i = 0; i < 16; ++i) { const int l = l0 + i; float o[8]; const float s = SCALED ? sc[l * 4] : 1.f;
#pragma unroll
        for (int j = 0; j < 8; ++j) { float a = b[j];
#pragma unroll
            for (int k = 0; k < 4; ++k) { const unsigned wd = (j < 2) ? x[i + k].x : (j < 4) ? x[i + k].y : (j < 6) ? x[i + k].z : x[i + k].w; a += w[k][j] * ((j & 1) ? bfhi(wd) : bflo(wd)); }
            o[j] = a * __builtin_amdgcn_rcpf(1.f + __expf(-a)) * s; }
        u32x4 p; p.x = pk2(o[0], o[1]); p.y = pk2(o[2], o[3]); p.z = pk2(o[4], o[5]); p.w = pk2(o[6], o[7]);
        *(SS_LAS u32x4*)(img + l * pitch) = p; }
}

__device__ __forceinline__ void states_unit(SS_LAS unsigned char* lds, int bc, int g, const unsigned short* XBC, const float* DTR, const float* cw, const float* cb, const float* dtb, const float* alog, float* ST, float* CEND) {
    int tid_ = threadIdx.x; asm volatile("" : "+v"(tid_));
    const int tid = tid_, lane = tid & 63, r32 = lane & 31, hi = lane >> 5; const int wid = __builtin_amdgcn_readfirstlane(tid >> 6);
    const int t0 = bc * 128;
    SS_LAS unsigned char* XD = lds; SS_LAS unsigned char* BI = lds + 128 * PX4;
    SS_LAS float* csl = (SS_LAS float*)(lds + 128 * PX4 + 128 * PB_T); SS_LAS float* dtl = csl + 512; SS_LAS float* wtot = dtl + 512; SS_LAS float* scl = wtot + 32;
    const int ch = tid % 48, l0 = (tid / 48) * 16; const int col = (ch < 32) ? g * 256 + ch * 8 : 512 + g * 128 + (ch - 32) * 8;
    u32x4 xr[19];
    if (tid < 384) conv_load(xr, XBC, t0, l0, col);
    dt_cs(t0, g, DTR, dtb, alog, csl, dtl, wtot, tid, lane, wid);
    scl[tid] = dtl[tid] * __expf(csl[508 + (tid & 3)] - csl[tid]);
    if (tid < 4) CEND[bc * 8 + g * 4 + tid] = csl[508 + tid];
    __syncthreads();
    if (tid < 384) {
        if (ch < 32) conv_compute<true>(xr, l0, col, cw, cb, XD + ch * 16, PX4, scl + (ch >> 3));
        else conv_compute<false>(xr, l0, col, cw, cb, BI + (ch - 32) * 16, PB_T, nullptr); }
    __syncthreads();
    const int pt = wid >> 2, nt = wid & 3;
#pragma unroll 1
    for (int hh = 0; hh < 4; ++hh) {
        f32x16 acc = f32x16{};
#pragma unroll
        for (int ks = 0; ks < 8; ++ks) {
            const bf16x8 a = tr_frag(XD, PX4, 16 * ks, hh * 64 + 32 * pt, lane);
            const bf16x8 b = tr_frag(BI, PB_T, 16 * ks, 32 * nt, lane);
            acc = __builtin_amdgcn_mfma_f32_32x32x16_bf16(a, b, acc, 0, 0, 0); }
        float* o = ST + (((size_t)(bc * 8 + g * 4 + hh) * 64 + 32 * pt) << 7) + 32 * nt + r32;
#pragma unroll
        for (int r = 0; r < 16; ++r) o[(size_t)crow(r, hi) << 7] = acc[r];
    }
    __syncthreads();
}

__device__ __forceinline__ void out_unit(SS_LAS unsigned char* lds, int bc, int g, const unsigned short* XBC, const unsigned short* VZ, const float* DTR, const float* cw, const float* cb, const float* dtb, const float* alog,
                                         const unsigned short* HIN, const float* Dsk, const float* gn, unsigned short* MIX) {
    int tid_ = threadIdx.x; asm volatile("" : "+v"(tid_));
    const int tid = tid_, lane = tid & 63, r32 = lane & 31, hi = lane >> 5; const int wid = __builtin_amdgcn_readfirstlane(tid >> 6);
    const int t0 = bc * 128;
    SS_LAS unsigned char* CI = lds; SS_LAS unsigned char* BI = lds + 128 * PR; SS_LAS unsigned char* XS = lds + 2 * 128 * PR;
    SS_LAS float* csl = (SS_LAS float*)(lds + 2 * 128 * PR + 128 * PX4); SS_LAS float* dtl = csl + 512; SS_LAS float* wtot = dtl + 512;
    const int ch = tid & 63, l0 = (tid >> 6) * 16; const int col = (ch < 32) ? g * 256 + ch * 8 : (ch < 48) ? 512 + g * 128 + (ch - 32) * 8 : 768 + g * 128 + (ch - 48) * 8;
    u32x4 xr[19];
    conv_load(xr, XBC, t0, l0, col);
    u32x4 zr[8];
    { const unsigned short* zp = VZ + (size_t)(t0 + (tid >> 2)) * 1024 + 512 + g * 256 + (tid & 3) * 64;
#pragma unroll
      for (int c = 0; c < 8; ++c) zr[c] = *(const u32x4*)(zp + c * 8); }
    dt_cs(t0, g, DTR, dtb, alog, csl, dtl, wtot, tid, lane, wid);
    if (ch < 32) conv_compute<false>(xr, l0, col, cw, cb, XS + ch * 16, PX4, nullptr);
    else if (ch < 48) conv_compute<false>(xr, l0, col, cw, cb, BI + (ch - 32) * 16, PR, nullptr);
    else conv_compute<false>(xr, l0, col, cw, cb, CI + (ch - 48) * 16, PR, nullptr);
    __syncthreads();
    const int lt = wid >> 1, st0 = 2 * (wid & 1), pt = wid & 1;
    f32x16 cb2[2]; cb2[0] = f32x16{}; cb2[1] = f32x16{};
#pragma unroll
    for (int ks = 0; ks < 8; ++ks) {
        const bf16x8 a = row_frag(CI, PR, 32 * lt, 16 * ks, lane);
        const bf16x8 b0 = row_frag(BI, PR, 32 * st0, 16 * ks, lane), b1 = row_frag(BI, PR, 32 * st0 + 32, 16 * ks, lane);
        cb2[0] = __builtin_amdgcn_mfma_f32_32x32x16_bf16(a, b0, cb2[0], 0, 0, 0);
        cb2[1] = __builtin_amdgcn_mfma_f32_32x32x16_bf16(a, b1, cb2[1], 0, 0, 0); }
    f32x16 yo[4];
    { bf16x8 hb[2][8];
      const unsigned short* hin0 = HIN + (((size_t)(bc * 8 + g * 4) * 64 + 32 * pt + r32) << 7) + 8 * hi;
#pragma unroll
      for (int ks = 0; ks < 8; ++ks) hb[0][ks] = *(const bf16x8*)(hin0 + 16 * ks);
#pragma unroll
      for (int hh = 0; hh < 4; ++hh) { yo[hh] = f32x16{};
          if (hh < 3) {
#pragma unroll
              for (int ks = 0; ks < 8; ++ks) hb[(hh + 1) & 1][ks] = *(const bf16x8*)(hin0 + ((size_t)(hh + 1) << 13) + 16 * ks); }
          __builtin_amdgcn_sched_barrier(0);
#pragma unroll
          for (int ks = 0; ks < 8; ++ks) yo[hh] = __builtin_amdgcn_mfma_f32_32x32x16_bf16(row_frag(CI, PR, 32 * lt, 16 * ks, lane), hb[hh & 1][ks], yo[hh], 0, 0, 0);
          __builtin_amdgcn_sched_barrier(0); } }
    __syncthreads();
    SS_LAS unsigned char* MI = BI;
#pragma unroll
    for (int hh = 0; hh < 4; ++hh) {
        const int h = g * 4 + hh;
#pragma unroll
        for (int j = 0; j < 2; ++j) { const int s = 32 * (st0 + j) + r32; const float css = csl[s * 4 + hh], dts = dtl[s * 4 + hh];
#pragma unroll
            for (int r = 0; r < 16; ++r) { const int l = 32 * lt + crow(r, hi); const float cl = csl[l * 4 + hh];
                float pr_ = cb2[j][r] * __builtin_amdgcn_exp2f(fminf(cl - css, 0.f) * 1.4426950408889634f) * dts; asm volatile("" : "+v"(pr_)); const float v = (s <= l) ? pr_ : 0.f;
                *(SS_LAS unsigned short*)(MI + l * PR + s * 2) = (unsigned short)f2bf(v); if ((r & 3) == 3) asm volatile("" ::: "memory"); } }
        __syncthreads();
        f32x16 yd = f32x16{};
#pragma unroll
        for (int ks = 0; ks < 8; ++ks) yd = __builtin_amdgcn_mfma_f32_32x32x16_bf16(row_frag(MI, PR, 32 * lt, 16 * ks, lane), tr_frag(XS, PX4, 16 * ks, hh * 64 + 32 * pt, lane), yd, 0, 0, 0);
        __syncthreads();
        const float dsk = Dsk[h]; const int p = 32 * pt + r32;
#pragma unroll
        for (int r = 0; r < 16; ++r) { const int l = 32 * lt + crow(r, hi);
            SS_LAS unsigned short* xp = (SS_LAS unsigned short*)(XS + l * PX4 + (hh * 64 + p) * 2);
            const float y = yd[r] + yo[hh][r] * __expf(csl[l * 4 + hh]) + dsk * bf2f(*xp);
            *xp = (unsigned short)f2bf(y); }
    }
    __syncthreads();
    { const int l = tid >> 2, q = tid & 3; const SS_LAS unsigned char* rowp = XS + l * PX4 + q * 128; float yv[8][8]; float s = 0.f;
#pragma unroll
      for (int c = 0; c < 8; ++c) { const u32x4 v = *(const SS_LAS u32x4*)(rowp + c * 16); const u32x4 z = zr[c];
          yv[c][0] = bflo(v.x) * silu_f(bflo(z.x)); yv[c][1] = bfhi(v.x) * silu_f(bfhi(z.x)); yv[c][2] = bflo(v.y) * silu_f(bflo(z.y)); yv[c][3] = bfhi(v.y) * silu_f(bfhi(z.y));
          yv[c][4] = bflo(v.z) * silu_f(bflo(z.z)); yv[c][5] = bfhi(v.z) * silu_f(bfhi(z.z)); yv[c][6] = bflo(v.w) * silu_f(bflo(z.w)); yv[c][7] = bfhi(v.w) * silu_f(bfhi(z.w));
#pragma unroll
          for (int j = 0; j < 8; ++j) s += yv[c][j] * yv[c][j]; }
      s += __shfl_xor(s, 1); s += __shfl_xor(s, 2);
      const float rstd = 1.f / sqrtf(s * (1.f / 256.f) + 1e-6f); const float* gq = gn + g * 256 + q * 64; unsigned short* op = MIX + (size_t)(t0 + l) * 1024 + 512 + g * 256 + q * 64;
#pragma unroll
      for (int c = 0; c < 8; ++c) { const f32x4 g0 = *(const f32x4*)(gq + c * 8), g1 = *(const f32x4*)(gq + c * 8 + 4); u32x4 o;
          o.x = pk2(yv[c][0] * rstd * g0.x, yv[c][1] * rstd * g0.y); o.y = pk2(yv[c][2] * rstd * g0.z, yv[c][3] * rstd * g0.w);
          o.z = pk2(yv[c][4] * rstd * g1.x, yv[c][5] * rstd * g1.y); o.w = pk2(yv[c][6] * rstd * g1.z, yv[c][7] * rstd * g1.w);
          *(u32x4*)(op + c * 8) = o; } }
    __syncthreads();
}
#undef SS_LAS
}

constexpr int NWAVES = 8, NTHR = 512;
constexpr int T_ = 32768, S_ = 2048, NB_ = 16, D_ = 1024;
constexpr int DFF = 2816, DFF2 = 5632;
constexpr float EPS = 1e-6f;
constexpr size_t MiB = 1u << 20;
constexpr size_t WS_CTL = 0, CTL_ZERO_BYTES = 3 * MiB;
constexpr size_t WS_SSQA = 1 * MiB, WS_SSQB = WS_SSQA + 256 * 1024, WS_SSQC = WS_SSQB + 256 * 1024, WS_SSQQ = WS_SSQC + 256 * 1024, WS_SSQKV = WS_SSQQ + 256 * 1024;
constexpr size_t WS_KMEAN = WS_SSQKV + 256 * 1024;
constexpr size_t WS_DTR = 55 * MiB;
constexpr size_t WS_W_IN0 = 3 * MiB;
constexpr size_t WS_W_OUT0 = WS_W_IN0 + 6656 * 1024;
constexpr size_t WS_W_IN1 = WS_W_OUT0 + 2 * MiB;
constexpr size_t WS_W_UQ = WS_W_IN1 + 2 * MiB;
constexpr size_t WS_W_UKV = WS_W_UQ + 1536 * 1024;
constexpr size_t WS_W_OUT1 = WS_W_UKV + 1 * MiB;
constexpr size_t WS_W_UP = WS_W_OUT1 + 2 * MiB;
constexpr size_t WS_W_DN = WS_W_UP + 22 * MiB;
constexpr size_t WS_TAB64 = 51 * MiB;
constexpr size_t WS_TAB32 = WS_TAB64 + 512 * 1024;
constexpr size_t WS_CWS = 52 * MiB;
constexpr size_t WS_DT = 53 * MiB;
constexpr size_t WS_CS = 54 * MiB;
constexpr size_t WS_XN = 56 * MiB;
constexpr size_t WS_BIG = 120 * MiB;
static_assert(WS_W_DN + 11 * MiB <= WS_TAB64, "weights fit");
constexpr size_t L0_QK = WS_BIG, L0_VZ = WS_BIG + 64 * MiB, L0_XBC = WS_BIG + 128 * MiB, L0_DTR = WS_BIG + 192 * MiB, L0_XBCA = WS_BIG + 256 * MiB, L0_MIX = WS_BIG + 320 * MiB;
constexpr size_t L0_ST = WS_BIG + 192 * MiB;
constexpr size_t L0_KC = WS_BIG + 288 * MiB;
constexpr size_t L0_HIN = WS_BIG + 256 * MiB;
constexpr size_t WS_CEND = 53 * MiB;
constexpr size_t L0_CB = L0_DTR;
constexpr size_t L0_YG = L0_QK;
constexpr size_t FF_ACT = WS_BIG + 64 * MiB, FF_UB = WS_BIG + 240 * MiB;
constexpr size_t L1_C1 = WS_BIG, L1_QR = WS_BIG + 64 * MiB, L1_V2 = WS_BIG + 160 * MiB;
constexpr size_t WS_RG = WS_BIG + 384 * MiB;
constexpr size_t WS_SSQPE = 53 * MiB + 64 * 1024;
constexpr size_t L1_K2 = WS_BIG + 288 * MiB;
constexpr size_t L1_O = WS_BIG + 224 * MiB;
constexpr size_t WS_END = 512 * MiB;
constexpr int CW_BAR = 4096;

constexpr int RING_OFF = 0, RING_BYTES = 162816;
constexpr int LDSCTL_OFF = RING_BYTES, MISC_OFF = LDSCTL_OFF + 320;
constexpr int LDS_BYTES = 163840;

struct Args { const float* in[25]; float* out; unsigned char* ws; int ph_lo, ph_hi; };
typedef const __attribute__((address_space(4))) Args* KArgs;
__device__ __forceinline__ KArgs kargs() { KArgs p = (KArgs)__builtin_amdgcn_kernarg_segment_ptr(); asm volatile("" : "+s"(p)); return p; }
#define PH_VARS KArgs A_ = kargs(); unsigned char* ws = A_->ws; float* out = A_->out; const float* x = A_->in[0]; bf16* XN = (bf16*)(ws + WS_XN); const float* TAB64 = (const float*)(ws + WS_TAB64); const float* TAB32 = (const float*)(ws + WS_TAB32); \
    int tid_ = threadIdx.x; asm volatile("" : "+v"(tid_)); const int tid = tid_, lane = tid & 63, wave = __builtin_amdgcn_readfirstlane(tid >> 6); int G = gridDim.x; asm volatile("" : "+s"(G)); const int gw = blockIdx.x * NWAVES + wave, NGW = G * NWAVES; const int gt = blockIdx.x * NTHR + tid, NGT = G * NTHR; \
    (void)out; (void)x; (void)XN; (void)TAB64; (void)TAB32; (void)lane; (void)gw; (void)NGW; (void)gt; (void)NGT;

template <int MAP> __device__ __forceinline__ int src_col(int n0) {
    if (MAP == 1) { const int pn = n0 >> 8, bj = (n0 >> 7) & 1, wc = (n0 >> 5) & 3; return bj * DFF + pn * 128 + wc * 32; }
    if (MAP == 2) { const int pn = n0 >> 8, bj = (n0 >> 7) & 1, wc = (n0 >> 5) & 3; return (pn < 4) ? pn * 256 + wc * 64 + bj * 32 : n0; }
    if (MAP == 3) { const int pn = n0 >> 8, bj = (n0 >> 7) & 1, wc = (n0 >> 5) & 3; if (pn < 4) return (4 * pn + wc) * 128 + bj * 32; const int col = (pn - 4) * 256 + bj * 128 + wc * 32; return (col >> 6) * 128 + 64 + (col & 63); }
    return n0;
}
template <int MAP> __device__ __forceinline__ void tr_load(f32x4 (&v)[8], const float* W, int Nsrc, int item, int nblk, int lane, const float* gain) {
    const int kb = item / nblk, nb = item % nblk, k0 = 64 * kb, n0 = 32 * nb;
    const int nn = src_col<MAP>(n0) + (lane & 7) * 4; const bool ok = (nn >= 0 && nn < Nsrc);
#pragma unroll
    for (int i = 0; i < 8; ++i) { const int kk = 8 * i + (lane >> 3); v[i] = ok ? *(const f32x4*)(W + (size_t)(k0 + kk) * Nsrc + nn) : (f32x4){0.f, 0.f, 0.f, 0.f}; if (gain) v[i] = v[i] * gain[k0 + kk]; }
}
__device__ __forceinline__ void tr_store(const f32x4 (&v)[8], int K, bf16* WT, LAS float* scr, int item, int nblk, int lane) {
    const int kb = item / nblk, nb = item % nblk, k0 = 64 * kb, n0 = 32 * nb;
#pragma unroll
    for (int i = 0; i < 8; ++i) { const int kk = 8 * i + (lane >> 3); LAS float* d = scr + kk * 33 + (lane & 7) * 4; d[0] = v[i].x; d[1] = v[i].y; d[2] = v[i].z; d[3] = v[i].w; }
    LDS_WAIT(); asm volatile("" ::: "memory");
    const int c = lane & 7;
#pragma unroll
    for (int j = 0; j < 4; ++j) { const int n = (lane >> 3) + 8 * j; const LAS float* s = scr + (8 * c) * 33 + n;
        v4u o; o.x = pk2(s[0 * 33], s[1 * 33]); o.y = pk2(s[2 * 33], s[3 * 33]); o.z = pk2(s[4 * 33], s[5 * 33]); o.w = pk2(s[6 * 33], s[7 * 33]);
        *(GAS v4u*)(WT + (size_t)(n0 + n) * K + k0 + 8 * c) = o; }
    LDS_WAIT(); asm volatile("" ::: "memory");
}
template <int MAP = 0> __device__ __forceinline__ void transpose_mat(const float* W, int K, int Nsrc, int Npad, bf16* WT, LAS float* scr, int gw, int NGW, int lane, const float* gain = nullptr) {
    const int nblk = Npad / 32, nitems = (K / 64) * nblk;
    f32x4 cur[8], nxt[8];
    if (gw < nitems) tr_load<MAP>(cur, W, Nsrc, gw, nblk, lane, gain);
    for (int it = gw; it < nitems; it += NGW) {
        const bool more = it + NGW < nitems;
        if (more) tr_load<MAP>(nxt, W, Nsrc, it + NGW, nblk, lane, gain);
        tr_store(cur, K, WT, scr, it, nblk, lane);
        if (more) {
#pragma unroll
            for (int i = 0; i < 8; ++i) cur[i] = nxt[i]; }
    }
}

struct MatDesc { const float* W; bf16* WT; const float* gain; int K, Nsrc, nblk, map; };
__device__ __forceinline__ int src_col_rt(int map, int n0) { return map == 1 ? src_col<1>(n0) : map == 2 ? src_col<2>(n0) : map == 3 ? src_col<3>(n0) : n0; }
__device__ __forceinline__ void trl_load(f32x4 (&v)[8], const MatDesc& d, int item, int lane) {
    const int kb = item / d.nblk, nb = item % d.nblk, k0 = 64 * kb, n0 = 32 * nb;
    const int nn = src_col_rt(d.map, n0) + (lane & 7) * 4; const bool ok = (nn >= 0 && nn < d.Nsrc);
#pragma unroll
    for (int i = 0; i < 8; ++i) { const int kk = 8 * i + (lane >> 3); v[i] = ok ? __builtin_nontemporal_load((const f32x4*)(d.W + (size_t)(k0 + kk) * d.Nsrc + nn)) : (f32x4){0.f, 0.f, 0.f, 0.f}; if (d.gain) v[i] = v[i] * d.gain[k0 + kk]; }
}
constexpr int NIT_W = 1536 + 512 + 512 + 384 + 256 + 512 + 2 * 2816 + 2 * 1408;
__device__ __forceinline__ MatDesc mat_of(KArgs A_, unsigned char* ws, int item, int& local) {
    MatDesc d; int r = item;
    if (r < 1536) { d = MatDesc{A_->in[3], (bf16*)(ws + WS_W_IN0), nullptr, 1024, 3080, 96, 2}; local = r; return d; } r -= 1536;
    if (r < 512) { d = MatDesc{A_->in[12], (bf16*)(ws + WS_W_OUT0), nullptr, 1024, 1024, 32, 0}; local = r; return d; } r -= 512;
    if (r < 512) { d = MatDesc{A_->in[13], (bf16*)(ws + WS_W_IN1), A_->in[1] + 1024, 1024, 800, 32, 0}; local = r; return d; } r -= 512;
    if (r < 384) { d = MatDesc{A_->in[15], (bf16*)(ws + WS_W_UQ), A_->in[14], 512, 1536, 48, 0}; local = r; return d; } r -= 384;
    if (r < 256) { d = MatDesc{A_->in[17], (bf16*)(ws + WS_W_UKV), A_->in[16], 256, 2048, 64, 3}; local = r; return d; } r -= 256;
    if (r < 512) { d = MatDesc{A_->in[20], (bf16*)(ws + WS_W_OUT1), nullptr, 1024, 1024, 32, 0}; local = r; return d; } r -= 512;
    if (r < 5632) { const int l = r / 2816; d = MatDesc{A_->in[21] + (size_t)l * 1024 * DFF2, (bf16*)(ws + WS_W_UP) + (size_t)l * DFF2 * 1024, A_->in[2] + l * 1024, 1024, DFF2, 176, 1}; local = r - l * 2816; return d; } r -= 5632;
    { const int l = r / 1408; d = MatDesc{A_->in[24] + (size_t)l * DFF * 1024, (bf16*)(ws + WS_W_DN) + (size_t)l * 1024 * DFF, nullptr, DFF, 1024, 32, 0}; local = r - l * 1408; return d; }
}

__device__ __forceinline__ void rms_rows_1024(const float* x, const float* g, bf16* o, int gw, int NGW, int lane) {
    f32x4 v[4], nx[4];
    if (gw < T_) {
#pragma unroll
        for (int j = 0; j < 4; ++j) v[j] = __builtin_nontemporal_load((const f32x4*)(x + (size_t)gw * D_) + lane + 64 * j); }
    for (int m = gw; m < T_; m += NGW) {
        const bool more = m + NGW < T_;
        if (more) {
#pragma unroll
            for (int j = 0; j < 4; ++j) nx[j] = __builtin_nontemporal_load((const f32x4*)(x + (size_t)(m + NGW) * D_) + lane + 64 * j); }
        float s = 0.f;
#pragma unroll
        for (int j = 0; j < 4; ++j) s += (v[j].x * v[j].x + v[j].y * v[j].y) + (v[j].z * v[j].z + v[j].w * v[j].w);
        const float rstd = 1.f / sqrtf(wave_sum(s) * (1.f / D_) + EPS);
        unsigned long long* o8 = (unsigned long long*)(o + (size_t)m * D_) + lane;
#pragma unroll
        for (int j = 0; j < 4; ++j) { const f32x4 gg = ((const f32x4*)g)[lane + 64 * j];
            o8[64 * j] = (unsigned long long)pk2(v[j].x * rstd * gg.x, v[j].y * rstd * gg.y) | ((unsigned long long)pk2(v[j].z * rstd * gg.z, v[j].w * rstd * gg.w) << 32); }
        if (more) {
#pragma unroll
            for (int j = 0; j < 4; ++j) v[j] = nx[j]; }
    }
}

__device__ __forceinline__ void rms_rows_dt(const float* x, const float* g, bf16* o, float* DTR, const LAS f32x4* W2, int gw, int NGW, int lane) {
    f32x4 v[4], nx[4];
    if (gw < T_) {
#pragma unroll
        for (int j = 0; j < 4; ++j) v[j] = __builtin_nontemporal_load((const f32x4*)(x + (size_t)gw * D_) + lane + 64 * j); }
    for (int m = gw; m < T_; m += NGW) {
        const bool more = m + NGW < T_;
        if (more) {
#pragma unroll
            for (int j = 0; j < 4; ++j) nx[j] = __builtin_nontemporal_load((const f32x4*)(x + (size_t)(m + NGW) * D_) + lane + 64 * j); }
        float s = 0.f; f32x4 d0 = {0.f, 0.f, 0.f, 0.f}, d1 = d0;
#pragma unroll
        for (int j = 0; j < 4; ++j) { s += (v[j].x * v[j].x + v[j].y * v[j].y) + (v[j].z * v[j].z + v[j].w * v[j].w);
#pragma unroll
            for (int e = 0; e < 4; ++e) { const int sl = j * 4 + e; const float xk = v[j][e]; d0 += W2[(sl * 2) * 64 + lane] * xk; d1 += W2[(sl * 2 + 1) * 64 + lane] * xk; } }
        const float rstd = 1.f / sqrtf(wave_sum(s) * (1.f / D_) + EPS);
#pragma unroll
        for (int e = 0; e < 4; ++e) { d0[e] = wave_sum(d0[e]); d1[e] = wave_sum(d1[e]); }
        if (lane == 0) { *(f32x4*)(DTR + (size_t)m * 8) = d0 * rstd; *(f32x4*)(DTR + (size_t)m * 8 + 4) = d1 * rstd; }
        unsigned long long* o8 = (unsigned long long*)(o + (size_t)m * D_) + lane;
#pragma unroll
        for (int j = 0; j < 4; ++j) { const f32x4 gg = ((const f32x4*)g)[lane + 64 * j];
            o8[64 * j] = (unsigned long long)pk2(v[j].x * rstd * gg.x, v[j].y * rstd * gg.y) | ((unsigned long long)pk2(v[j].z * rstd * gg.z, v[j].w * rstd * gg.w) << 32); }
        if (more) {
#pragma unroll
            for (int j = 0; j < 4; ++j) v[j] = nx[j]; }
    }
}

struct EpiF32Res {
    static constexpr bool PERM = false, AFTER_DRAIN = false;
    float* C; const float* R; int ldc;
    __device__ __forceinline__ void operator()(const pg8::f32x4 (&acc)[2][2][4][2], const pg8::Unit& u, int wr, int wc, int fr, int fq) const {
        const int row0 = u.pm * pg8::BM + wr * 64 + fr, col0 = u.pn * pg8::BM + wc * 32 + 4 * fq;
#pragma unroll
        for (int ai = 0; ai < 2; ++ai)
#pragma unroll
            for (int m = 0; m < 4; ++m) { const size_t off = (size_t)(row0 + ai * pg8::HALF + m * 16) * ldc + col0;
                f32x4 r[2][2];
#pragma unroll
                for (int bj = 0; bj < 2; ++bj)
#pragma unroll
                    for (int n = 0; n < 2; ++n) r[bj][n] = *(const f32x4*)(R + off + bj * pg8::HALF + n * 16);
#pragma unroll
                for (int bj = 0; bj < 2; ++bj)
#pragma unroll
                    for (int n = 0; n < 2; ++n) *(f32x4*)(C + off + bj * pg8::HALF + n * 16) = acc[ai][bj][m][n] + r[bj][n];
                asm volatile("" ::: "memory"); }
    }
};

template <bool RB16, bool OUTF, bool OUTB> struct EpiRes {
    static constexpr bool PERM = true, AFTER_DRAIN = false;
    float* C; const void* R; bf16* XB; unsigned long long* SSQ;
    struct Raw { f32x4 f[2][2]; v4u h[2]; };
    __device__ __forceinline__ void load_raw(Raw& q, size_t off) const {
#pragma unroll
        for (int bj = 0; bj < 2; ++bj) {
            if (RB16) q.h[bj] = *(const v4u*)((const bf16*)R + off + bj * pg8::HALF);
            else { q.f[bj][0] = *(const f32x4*)((const float*)R + off + bj * pg8::HALF); q.f[bj][1] = *(const f32x4*)((const float*)R + off + bj * pg8::HALF + 4); } }
    }
    __device__ __forceinline__ void operator()(const pg8::f32x4 (&acc)[2][2][4][2], const pg8::Unit& u, int wr, int wc, int fr, int fq) const {
        const int row0 = u.pm * pg8::BM + wr * 64 + fr, col0 = u.pn * pg8::BM + wc * 32 + 8 * fq;
        constexpr int WIN = 4;
        Raw q[8]; float ss[8];
#pragma unroll
        for (int it = 0; it < WIN; ++it) load_raw(q[it], (size_t)(row0 + (it >> 2) * pg8::HALF + (it & 3) * 16) * 1024 + col0);
        __builtin_amdgcn_sched_barrier(0);
#pragma unroll
        for (int it = 0; it < 8; ++it) { const int ai = it >> 2, mm = it & 3; const int row = row0 + ai * pg8::HALF + mm * 16; const size_t off = (size_t)row * 1024 + col0;
            if (it + WIN < 8) { load_raw(q[it + WIN], (size_t)(row0 + ((it + WIN) >> 2) * pg8::HALF + ((it + WIN) & 3) * 16) * 1024 + col0); __builtin_amdgcn_sched_barrier(0); }
            float s = 0.f;
#pragma unroll
            for (int bj = 0; bj < 2; ++bj) {
                f32x4 r0, r1;
                if (RB16) { const v4u w = q[it].h[bj]; r0 = (f32x4){bflo(w.x), bfhi(w.x), bflo(w.y), bfhi(w.y)}; r1 = (f32x4){bflo(w.z), bfhi(w.z), bflo(w.w), bfhi(w.w)}; } else { r0 = q[it].f[bj][0]; r1 = q[it].f[bj][1]; }
                const f32x4 v0 = acc[ai][bj][mm][0] + r0, v1 = acc[ai][bj][mm][1] + r1;
                if (OUTF) { *(f32x4*)(C + off + bj * pg8::HALF) = v0; *(f32x4*)(C + off + bj * pg8::HALF + 4) = v1; }
                if (OUTB) { s += ((v0.x * v0.x + v0.y * v0.y) + (v0.z * v0.z + v0.w * v0.w)) + ((v1.x * v1.x + v1.y * v1.y) + (v1.z * v1.z + v1.w * v1.w));
                    v4u w; w.x = pk2(v0.x, v0.y); w.y = pk2(v0.z, v0.w); w.z = pk2(v1.x, v1.y); w.w = pk2(v1.z, v1.w); *(v4u*)(XB + off + bj * pg8::HALF) = w; } }
            if (OUTB) { s += __shfl_xor(s, 16); s += __shfl_xor(s, 32); ss[it] = s; }
            asm volatile("" ::: "memory"); }
        if (OUTB) { if (fq == 0) {
#pragma unroll
            for (int it = 0; it < 8; ++it) atomicAdd(SSQ + row0 + (it >> 2) * pg8::HALF + (it & 3) * 16, (unsigned long long)(ss[it] * 1073741824.0f)); } }
    }
};
typedef unsigned v2u __attribute__((ext_vector_type(2))); typedef float f32x2 __attribute__((ext_vector_type(2)));
__device__ __forceinline__ float rstd_of(const unsigned long long* SSQ, int row, float inv_n) { const v2u s = ((const v2u*)SSQ)[row]; const float c = inv_n * (1.0f / 1073741824.0f);
    return __builtin_amdgcn_rsqf(__builtin_fmaf((float)s.y, 4294967296.0f * c, __builtin_fmaf((float)s.x, c, EPS))); }
__device__ __forceinline__ f32x2 pk_add_one(f32x2 a) { asm("" : "+v"(a)); return a + 1.0f; }
template <int N> __device__ __forceinline__ float dpp_shr0(float v) { return __builtin_bit_cast(float, __builtin_amdgcn_update_dpp(0, __builtin_bit_cast(int, v), 0x110 + N, 0xf, 0xf, true)); }
template <int N> __device__ __forceinline__ float dpp_shr_old(float old, float v) { return __builtin_bit_cast(float, __builtin_amdgcn_update_dpp(__builtin_bit_cast(int, old), __builtin_bit_cast(int, v), 0x110 + N, 0xf, 0xf, false)); }
template <int N> __device__ __forceinline__ float dpp_ror(float v) { return __builtin_bit_cast(float, __builtin_amdgcn_update_dpp(0, __builtin_bit_cast(int, v), 0x120 + N, 0xf, 0xf, false)); }
struct EpiFfnUp {
    static constexpr bool PERM = true, AFTER_DRAIN = false;
    bf16* ACT; bf16* UB; const unsigned long long* SSQ; const float* cw; const float* cb;
    __device__ __forceinline__ void operator()(const pg8::f32x4 (&acc)[2][2][4][2], const pg8::Unit& u, int wr, int wc, int fr, int fq) const {
        const int ch0 = u.pn * 128 + wc * 32 + 8 * fq;
        float rs[2][4];
#pragma unroll
        for (int ai = 0; ai < 2; ++ai)
#pragma unroll
            for (int m = 0; m < 4; ++m) rs[ai][m] = rstd_of(SSQ, u.pm * pg8::BM + ai * pg8::HALF + wr * 64 + 4 * fr + m, 1.0f / 1024.0f);
        unsigned long long keep[2][4];
#pragma unroll
        for (int n = 0; n < 2; ++n) {
            __builtin_amdgcn_sched_barrier(0);
            const int ch = ch0 + 4 * n;
            const f32x4 wg0 = *(const f32x4*)(cw + ch), wg1 = *(const f32x4*)(cw + DFF2 + ch), wg2 = *(const f32x4*)(cw + 2 * DFF2 + ch), bg = *(const f32x4*)(cw + 3 * DFF2 + ch);
            const f32x4 wu0 = *(const f32x4*)(cw + DFF + ch), wu1 = *(const f32x4*)(cw + DFF2 + DFF + ch), wu2 = *(const f32x4*)(cw + 2 * DFF2 + DFF + ch), bu = *(const f32x4*)(cw + 3 * DFF2 + DFF + ch);
#pragma unroll
            for (int ai = 0; ai < 2; ++ai) {
                const int rowc = u.pm * pg8::BM + ai * pg8::HALF + wr * 64;
                f32x4 g[4], uu[4];
#pragma unroll
                for (int m = 0; m < 4; ++m) { g[m] = acc[ai][0][m][n] * rs[ai][m]; uu[m] = acc[ai][1][m][n] * rs[ai][m]; }
                f32x4 g2p, g3p, u2p, u3p;
#pragma unroll
                for (int j = 0; j < 4; ++j) { g2p[j] = dpp_shr0<1>(g[2][j]); g3p[j] = dpp_shr0<1>(g[3][j]); u2p[j] = dpp_shr0<1>(uu[2][j]); u3p[j] = dpp_shr0<1>(uu[3][j]); }
#pragma unroll
                for (int m = 0; m < 4; ++m) {
                    const f32x4 sg1 = (m == 0) ? g3p : g[m - 1], sg2 = (m == 0) ? g2p : (m == 1) ? g3p : g[m - 2];
                    const f32x4 su1 = (m == 0) ? u3p : uu[m - 1], su2 = (m == 0) ? u2p : (m == 1) ? u3p : uu[m - 2];
                    const f32x4 cg = bg + wg0 * sg2 + wg1 * sg1 + wg2 * g[m], cu = bu + wu0 * su2 + wu1 * su1 + wu2 * uu[m];
                    f32x4 r_;
                    { const f32x2 d0 = pk_add_one((f32x2){__builtin_amdgcn_exp2f(cg[0]), __builtin_amdgcn_exp2f(cg[1])}), d1 = pk_add_one((f32x2){__builtin_amdgcn_exp2f(cg[2]), __builtin_amdgcn_exp2f(cg[3])});
                      r_[0] = __builtin_amdgcn_rcpf(d0.x); r_[1] = __builtin_amdgcn_rcpf(d0.y); r_[2] = __builtin_amdgcn_rcpf(d1.x); r_[3] = __builtin_amdgcn_rcpf(d1.y); }
                    const f32x4 a = cg * r_ * cu;
                    const int row = rowc + 4 * fr + m;
                    const unsigned long long pk_ = (unsigned long long)pk2(a[0], a[1]) | ((unsigned long long)pk2(a[2], a[3]) << 32);
                    if (n == 0) { keep[ai][m] = pk_; asm volatile("" : "+v"(keep[ai][m])); }
                    else if (!(fr == 0 && m < 2)) { v4u w; w.x = (unsigned)keep[ai][m]; w.y = (unsigned)(keep[ai][m] >> 32); w.z = (unsigned)pk_; w.w = (unsigned)(pk_ >> 32); *(v4u*)(ACT + (size_t)row * DFF + ch0) = w; }
                    if ((fr == 0 && m < 2) || (fr == 15 && m >= 2)) { const int slot = m; bf16* ub = UB + ((size_t)(rowc >> 6) * 4 + slot) * DFF2 + ch;
                        *(unsigned long long*)ub = (unsigned long long)pk2(g[m][0], g[m][1]) | ((unsigned long long)pk2(g[m][2], g[m][3]) << 32);
                        *(unsigned long long*)(ub + DFF) = (unsigned long long)pk2(uu[m][0], uu[m][1]) | ((unsigned long long)pk2(uu[m][2], uu[m][3]) << 32); }
                }
            }
        }
    }
};


struct EpiScale {
    static constexpr bool PERM = true, AFTER_DRAIN = false;
    bf16* O; int ldc; const unsigned long long* SSQ; float inv_n;
    __device__ __forceinline__ void operator()(const pg8::f32x4 (&acc)[2][2][4][2], const pg8::Unit& u, int wr, int wc, int fr, int fq) const {
        const int row0 = u.pm * pg8::BM + wr * 64 + fr, col0 = u.pn * pg8::BM + wc * 32 + 8 * fq;
#pragma unroll
        for (int ai = 0; ai < 2; ++ai)
#pragma unroll
            for (int m = 0; m < 4; ++m) { const int row = row0 + ai * pg8::HALF + m * 16; const float rs = rstd_of(SSQ, row, inv_n); bf16* rowp = O + (size_t)row * ldc + col0;
#pragma unroll
                for (int bj = 0; bj < 2; ++bj) { const f32x4 v0 = acc[ai][bj][m][0] * rs, v1 = acc[ai][bj][m][1] * rs;
                    v4u w; w.x = pk2(v0[0], v0[1]); w.y = pk2(v0[2], v0[3]); w.z = pk2(v1[0], v1[1]); w.w = pk2(v1[2], v1[3]); *(v4u*)(rowp + bj * pg8::HALF) = w; } }
    }
};
struct EpiMlaIn {
    static constexpr bool PERM = true, AFTER_DRAIN = false;
    bf16* O; const unsigned long long* SSQ; unsigned long long* SSQ_Q; unsigned long long* SSQ_KV; float* SSQPE; float* RG; const float* kg; const float* TAB;
    __device__ __forceinline__ void operator()(const pg8::f32x4 (&acc)[2][2][4][2], const pg8::Unit& u, int wr, int wc, int fr, int fq) const {
        const int row0 = u.pm * pg8::BM + wr * 64 + fr, col0 = u.pn * pg8::BM + wc * 32 + 8 * fq;
        unsigned long long* tgt = (u.pn < 2) ? SSQ_Q : SSQ_KV;
        float rsv[8];
#pragma unroll
        for (int i = 0; i < 8; ++i) rsv[i] = rstd_of(SSQ, row0 + (i >> 2) * pg8::HALF + (i & 3) * 16, 1.0f / 1024.0f);
        if (u.pn < 3) {
#pragma unroll
        for (int ai = 0; ai < 2; ++ai)
#pragma unroll
            for (int m = 0; m < 4; ++m) { const int row = row0 + ai * pg8::HALF + m * 16; const float rs = rsv[ai * 4 + m]; bf16* rowp = O + (size_t)row * 1024 + col0; float s = 0.f;
#pragma unroll
                for (int bj = 0; bj < 2; ++bj) { const f32x4 v0 = acc[ai][bj][m][0] * rs, v1 = acc[ai][bj][m][1] * rs;
                    s += (v0[0] * v0[0] + v0[1] * v0[1]) + (v0[2] * v0[2] + v0[3] * v0[3]) + (v1[0] * v1[0] + v1[1] * v1[1]) + (v1[2] * v1[2] + v1[3] * v1[3]);
                    v4u w; w.x = pk2(v0[0], v0[1]); w.y = pk2(v0[2], v0[3]); w.z = pk2(v1[0], v1[1]); w.w = pk2(v1[2], v1[3]); *(v4u*)(rowp + bj * pg8::HALF) = w; }
                s += __shfl_xor(s, 16); s += __shfl_xor(s, 32); if (fq == 0) atomicAdd(tgt + row, (unsigned long long)(s * 1073741824.0f)); asm volatile("" ::: "memory"); }
        } else if (wc == 0) {
            const f32x4 g0 = *(const f32x4*)(kg + 64 + 8 * fq), g1 = *(const f32x4*)(kg + 64 + 8 * fq + 4);
            f32x4 tn[4]; { const float* tb = TAB + ((row0 & 2047) * 16 + 8 * (fq & 1)) * 2; tn[0] = *(const f32x4*)tb; tn[1] = *(const f32x4*)(tb + 4); tn[2] = *(const f32x4*)(tb + 8); tn[3] = *(const f32x4*)(tb + 12); }
#pragma unroll
            for (int ai = 0; ai < 2; ++ai)
#pragma unroll
                for (int m = 0; m < 4; ++m) { const int row = row0 + ai * pg8::HALF + m * 16; const float rs = rsv[ai * 4 + m];
                    const f32x4 ta = tn[0], tb4 = tn[1], tc = tn[2], td = tn[3];
                    if (ai * 4 + m < 7) { const int i1 = ai * 4 + m + 1; const float* tb = TAB + (((row0 + (i1 >> 2) * pg8::HALF + (i1 & 3) * 16) & 2047) * 16 + 8 * (fq & 1)) * 2; tn[0] = *(const f32x4*)tb; tn[1] = *(const f32x4*)(tb + 4); tn[2] = *(const f32x4*)(tb + 8); tn[3] = *(const f32x4*)(tb + 12); }
                    const f32x4 v0 = acc[ai][0][m][0] * rs, v1 = acc[ai][0][m][1] * rs;
                    float s = (v0[0] * v0[0] + v0[1] * v0[1]) + (v0[2] * v0[2] + v0[3] * v0[3]) + (v1[0] * v1[0] + v1[1] * v1[1]) + (v1[2] * v1[2] + v1[3] * v1[3]);
                    s += __shfl_xor(s, 16); s += __shfl_xor(s, 32); if (fq == 0) SSQPE[row] = s;
                    const f32x4 y0 = v0 * g0, y1 = v1 * g1;
                    f32x4 p0, p1;
#pragma unroll
                    for (int j = 0; j < 4; ++j) { p0[j] = __shfl_xor(y0[j], 32); p1[j] = __shfl_xor(y1[j], 32); }
                    const f32x4 c0 = {ta[0], ta[2], tb4[0], tb4[2]}, s0 = {ta[1], ta[3], tb4[1], tb4[3]}, c1 = {tc[0], tc[2], td[0], td[2]}, s1 = {tc[1], tc[3], td[1], td[3]};
                    f32x4 o0, o1;
                    if (fq < 2) { o0 = y0 * c0 - p0 * s0; o1 = y1 * c1 - p1 * s1; } else { o0 = p0 * s0 + y0 * c0; o1 = p1 * s1 + y1 * c1; }
                    float* rg = RG + (size_t)row * 32 + 8 * fq; *(f32x4*)rg = o0; *(f32x4*)(rg + 4) = o1; asm volatile("" ::: "memory"); }
        }
    }
};
struct EpiUkv {
    static constexpr bool PERM = true, AFTER_DRAIN = false;
    bf16* K2; bf16* V2; const unsigned long long* SSQ; const float* SSQPE; const float* RG; const float* kg;
    __device__ __forceinline__ void operator()(const pg8::f32x4 (&acc)[2][2][4][2], const pg8::Unit& u, int wr, int wc, int fr, int fq) const {
        const int row0 = u.pm * pg8::BM + wr * 64 + fr;
        if (u.pn < 4) {
            const int head = 4 * u.pn + wc;
            f32x4 g1[2], g2[2];
#pragma unroll
            for (int n = 0; n < 2; ++n) { g1[n] = *(const f32x4*)(kg + 8 * fq + 4 * n); g2[n] = *(const f32x4*)(kg + 32 + 8 * fq + 4 * n); }
            float rsv[8], pev[8];
#pragma unroll
            for (int i = 0; i < 8; ++i) { const int row = row0 + (i >> 2) * pg8::HALF + (i & 3) * 16; rsv[i] = rstd_of(SSQ, row, 1.0f / 256.0f); pev[i] = SSQPE[row]; }
            f32x4 rgn0, rgn1; { const float* rg = RG + (size_t)row0 * 32 + 8 * fq; rgn0 = *(const f32x4*)rg; rgn1 = *(const f32x4*)(rg + 4); }
#pragma unroll
            for (int i = 0; i < 8; ++i) { const int row = row0 + (i >> 2) * pg8::HALF + (i & 3) * 16; const float rs = rsv[i];
                    const f32x4 rgc0 = rgn0, rgc1 = rgn1;
                    if (i < 7) { const float* rg = RG + (size_t)(row0 + ((i + 1) >> 2) * pg8::HALF + ((i + 1) & 3) * 16) * 32 + 8 * fq; rgn0 = *(const f32x4*)rg; rgn1 = *(const f32x4*)(rg + 4); }
                    const int ai = i >> 2, m = i & 3;
                    f32x4 a[2], b[2]; float s = 0.f;
#pragma unroll
                    for (int n = 0; n < 2; ++n) { a[n] = acc[ai][0][m][n] * rs; b[n] = acc[ai][1][m][n] * rs; s += (a[n][0] * a[n][0] + a[n][1] * a[n][1]) + (a[n][2] * a[n][2] + a[n][3] * a[n][3]) + (b[n][0] * b[n][0] + b[n][1] * b[n][1]) + (b[n][2] * b[n][2] + b[n][3] * b[n][3]); }
                    s += __shfl_xor(s, 16); s += __shfl_xor(s, 32);
                    const float rh = __builtin_amdgcn_rsqf((s + pev[i]) * (1.f / 96.f) + EPS);
                    const int pos = row & 2047; bf16* rp = K2 + ((((size_t)(row >> 11) * 16 + head) * 32 + (pos >> 6)) * 12 + fq) * 512 + (pos & 63) * 8;
                    { const f32x4 o0 = a[0] * rh * g1[0], o1 = a[1] * rh * g1[1]; v4u w; w.x = pk2(o0[0], o0[1]); w.y = pk2(o0[2], o0[3]); w.z = pk2(o1[0], o1[1]); w.w = pk2(o1[2], o1[3]); *(v4u*)rp = w; }
                    { const f32x4 o0 = b[0] * rh * g2[0], o1 = b[1] * rh * g2[1]; v4u w; w.x = pk2(o0[0], o0[1]); w.y = pk2(o0[2], o0[3]); w.z = pk2(o1[0], o1[1]); w.w = pk2(o1[2], o1[3]); *(v4u*)(rp + 4 * 512) = w; }
                    { const f32x4 o0 = rgc0 * rh, o1 = rgc1 * rh; v4u w; w.x = pk2(o0[0], o0[1]); w.y = pk2(o0[2], o0[3]); w.z = pk2(o1[0], o1[1]); w.w = pk2(o1[2], o1[3]); *(v4u*)(rp + 8 * 512) = w; }
                    asm volatile("" ::: "memory"); }
        } else {
            bf16* dst = V2 + (u.pn - 4) * 256 + wc * 32 + 8 * fq;
#pragma unroll
            for (int ai = 0; ai < 2; ++ai)
#pragma unroll
                for (int m = 0; m < 4; ++m) { const int row = row0 + ai * pg8::HALF + m * 16; const float rs = rstd_of(SSQ, row, 1.0f / 256.0f); bf16* rp = dst + (size_t)row * 1024;
#pragma unroll
                    for (int bj = 0; bj < 2; ++bj) { const f32x4 v0 = acc[ai][bj][m][0] * rs, v1 = acc[ai][bj][m][1] * rs;
                        v4u w; w.x = pk2(v0[0], v0[1]); w.y = pk2(v0[2], v0[3]); w.z = pk2(v1[0], v1[1]); w.w = pk2(v1[2], v1[3]); *(v4u*)(rp + bj * pg8::HALF) = w; } }
        }
    }
};

struct EpiIn0 {
    static constexpr bool PERM = true, AFTER_DRAIN = false;
    bf16* QK; bf16* KC; const float* TAB; const float* qn; const float* kn; float* KM; float* DTR;
    __device__ __forceinline__ void operator()(const pg8::f32x4 (&acc)[2][2][4][2], const pg8::Unit& u, int wr, int wc, int fr, int fq) const {
        const int row0 = u.pm * pg8::BM + wr * 64 + fr;
        if (u.pn < 4) {
            const bool isq = u.pn < 2; const float* gn = isq ? qn : kn; const int head = 4 * (u.pn & 1) + wc;
            bf16* dst = QK + (isq ? 0 : 512) + head * 64 + 8 * fq;
            f32x4 g1[2], g2[2], ks1[2], ks2[2];
#pragma unroll
            for (int n = 0; n < 2; ++n) { g1[n] = *(const f32x4*)(gn + 8 * fq + 4 * n); g2[n] = *(const f32x4*)(gn + 32 + 8 * fq + 4 * n); ks1[n] = (f32x4){0.f, 0.f, 0.f, 0.f}; ks2[n] = ks1[n]; }
#pragma unroll
            for (int ai = 0; ai < 2; ++ai)
#pragma unroll
                for (int m = 0; m < 4; ++m) { const int row = row0 + ai * pg8::HALF + m * 16, pos = row & 2047;
                    float s = 0.f;
#pragma unroll
                    for (int n = 0; n < 2; ++n) { const f32x4 a = acc[ai][0][m][n], b = acc[ai][1][m][n]; s += (a[0] * a[0] + a[1] * a[1]) + (a[2] * a[2] + a[3] * a[3]) + (b[0] * b[0] + b[1] * b[1]) + (b[2] * b[2] + b[3] * b[3]); }
                    s += __shfl_xor(s, 16); s += __shfl_xor(s, 32);
                    float rstd = 1.f / sqrtf(s * (1.f / 64.f) + EPS); if (isq) rstd *= 0.18033688011112042f;
                    f32x4 o1[2], o2[2];
#pragma unroll
                    for (int n = 0; n < 2; ++n) { const float* tb = TAB + (pos * 32 + 8 * fq + 4 * n) * 2; const f32x4 t0 = *(const f32x4*)tb, t1 = *(const f32x4*)(tb + 4);
                        const f32x4 cs_ = {t0[0], t0[2], t1[0], t1[2]}, sn = {t0[1], t0[3], t1[1], t1[3]};
                        const f32x4 y1 = acc[ai][0][m][n] * rstd * g1[n], y2 = acc[ai][1][m][n] * rstd * g2[n];
                        o1[n] = y1 * cs_ - y2 * sn; o2[n] = y1 * sn + y2 * cs_; ks1[n] += o1[n]; ks2[n] += o2[n]; }
                    bf16* rp = dst + (size_t)row * 1024; int st2 = 32;
                    if (!isq) { rp = KC + ((((size_t)(row >> 11) * 8 + head) * 32 + (pos >> 6)) * 8 + fq) * 512 + (pos & 63) * 8; st2 = 4 * 512; }
                    { v4u w; w.x = pk2(o1[0][0], o1[0][1]); w.y = pk2(o1[0][2], o1[0][3]); w.z = pk2(o1[1][0], o1[1][1]); w.w = pk2(o1[1][2], o1[1][3]); *(v4u*)rp = w; }
                    { v4u w; w.x = pk2(o2[0][0], o2[0][1]); w.y = pk2(o2[0][2], o2[0][3]); w.z = pk2(o2[1][0], o2[1][1]); w.w = pk2(o2[1][2], o2[1][3]); *(v4u*)(rp + st2) = w; }
                    asm volatile("" ::: "memory"); }
            if (!isq) {
                float* km = KM + (((size_t)(u.pm >> 3) * 8 + (u.pm & 7)) * 8 + head) * 64 + 8 * fq;
#pragma unroll
                for (int n = 0; n < 2; ++n)
#pragma unroll
                    for (int j = 0; j < 4; ++j) { float a = ks1[n][j], b = ks2[n][j];
#pragma unroll
                        for (int o = 1; o < 16; o <<= 1) { a += __shfl_xor(a, o); b += __shfl_xor(b, o); }
                        if (fr == 0) { atomicAdd(km + 4 * n + j, a * (1.f / 256.f)); atomicAdd(km + 32 + 4 * n + j, b * (1.f / 256.f)); } } }
        } else if (u.pn < 12) {
            bf16* dst = QK + (size_t)(u.pn >> 2) * ((size_t)T_ * 1024) + (u.pn & 3) * 256 + wc * 32 + 8 * fq;
#pragma unroll
            for (int ai = 0; ai < 2; ++ai)
#pragma unroll
                for (int m = 0; m < 4; ++m) { bf16* rp = dst + (size_t)(row0 + ai * pg8::HALF + m * 16) * 1024;
#pragma unroll
                    for (int bj = 0; bj < 2; ++bj) { const f32x4 v0 = acc[ai][bj][m][0], v1 = acc[ai][bj][m][1];
                        v4u w; w.x = pk2(v0[0], v0[1]); w.y = pk2(v0[2], v0[3]); w.z = pk2(v1[0], v1[1]); w.w = pk2(v1[2], v1[3]); *(v4u*)(rp + bj * pg8::HALF) = w; } }
        } else if (wc == 0 && fq == 0) {
#pragma unroll
            for (int ai = 0; ai < 2; ++ai)
#pragma unroll
                for (int m = 0; m < 4; ++m) { float* rp = DTR + (size_t)(row0 + ai * pg8::HALF + m * 16) * 8; *(f32x4*)rp = acc[ai][0][m][0]; *(f32x4*)(rp + 4) = acc[ai][0][m][1]; }
        }
    }
};

__device__ __forceinline__ void ffn_fix_rows(int i0, int i1, int step, const bf16* UB, bf16* ACT, const float* cw, const float* cb) {
#pragma unroll 1
    for (int il = i0; il < i1; il += step) {
        const int c0 = (il % (DFF / 8)) * 8, rr = (il / (DFF / 8)) & 1, ck = il / (2 * (DFF / 8)); const bool first = (ck & 31) == 0;
        v4u wg[3], wu[3]; f32x4 kg[3][2], ku[3][2]; float vm[3];
#pragma unroll
        for (int k = 0; k < 3; ++k) { const int rel = rr - 2 + k; const bool ok = (rel >= 0) || !first;
            const size_t srow = (rel >= 0) ? (size_t)ck * 4 + rel : (ok ? (size_t)(ck - 1) * 4 + 4 + rel : (size_t)ck * 4);
            const bf16* src = UB + srow * DFF2; wg[k] = *(const v4u*)(src + c0); wu[k] = *(const v4u*)(src + DFF + c0); vm[k] = ok ? 1.f : 0.f;
            const float* kp = cw + k * DFF2 + c0; kg[k][0] = *(const f32x4*)kp; kg[k][1] = *(const f32x4*)(kp + 4); ku[k][0] = *(const f32x4*)(kp + DFF); ku[k][1] = *(const f32x4*)(kp + DFF + 4); }
        f32x4 ag0 = *(const f32x4*)(cb + c0), ag1 = *(const f32x4*)(cb + c0 + 4), au0 = *(const f32x4*)(cb + DFF + c0), au1 = *(const f32x4*)(cb + DFF + c0 + 4);
#pragma unroll
        for (int k = 0; k < 3; ++k) {
            const f32x4 g0 = (f32x4){bflo(wg[k].x), bfhi(wg[k].x), bflo(wg[k].y), bfhi(wg[k].y)} * vm[k], g1 = (f32x4){bflo(wg[k].z), bfhi(wg[k].z), bflo(wg[k].w), bfhi(wg[k].w)} * vm[k];
            const f32x4 u0 = (f32x4){bflo(wu[k].x), bfhi(wu[k].x), bflo(wu[k].y), bfhi(wu[k].y)} * vm[k], u1 = (f32x4){bflo(wu[k].z), bfhi(wu[k].z), bflo(wu[k].w), bfhi(wu[k].w)} * vm[k];
            ag0 += kg[k][0] * g0; ag1 += kg[k][1] * g1; au0 += ku[k][0] * u0; au1 += ku[k][1] * u1; }
        f32x4 o0, o1;
#pragma unroll
        for (int j = 0; j < 4; ++j) { o0[j] = ag0[j] * __builtin_amdgcn_rcpf(1.f + __expf(-ag0[j])) * au0[j]; o1[j] = ag1[j] * __builtin_amdgcn_rcpf(1.f + __expf(-ag1[j])) * au1[j]; }
        v4u o; o.x = pk2(o0[0], o0[1]); o.y = pk2(o0[2], o0[3]); o.z = pk2(o1[0], o1[1]); o.w = pk2(o1[2], o1[3]);
        *(v4u*)(ACT + ((size_t)ck * 64 + rr) * DFF + c0) = o; }
}

template <class Epi, int AROW = 0> __device__ __forceinline__ void run_gemm(LAS unsigned char* lds, const bf16* A, const bf16* Bt, int M, int N, int K, const Epi& E, int lda = 0) {
    pg8::Gemm g{A, Bt, M, N, K, lda ? lda : K}; pg8::StaticOrder S; S.init(M, N, (int)gridDim.x, (int)blockIdx.x);
    pg8::gemm_phase<Epi, pg8::StaticOrder, PG8_ALIGN, PG8_SP2, AROW>(lds + RING_OFF, g, S, E);
}

#define NPHASES 40
__global__ void __launch_bounds__(NTHR, 2) fwd(Args args) {
    extern __shared__ __attribute__((aligned(16))) unsigned char lds_raw[];
    LAS unsigned char* lds = (LAS unsigned char*)lds_raw;
    volatile LAS unsigned* MISC = (volatile LAS unsigned*)(lds + MISC_OFF);
    {
        const int tid0 = threadIdx.x;
        for (int u = tid0; u < (LDS_BYTES - LDSCTL_OFF) / 4; u += NTHR) ((LAS unsigned*)(lds + LDSCTL_OFF))[u] = 0u;
    }
    __syncthreads();
    int lo, hi; { KArgs A0 = kargs(); lo = A0->ph_lo; hi = A0->ph_hi; }
    const bool multi = (hi - lo) > 1;
    XcdBarrier bar; bar.bar = nullptr; bar.x = 0; bar.st = nullptr;
    if (multi) { KArgs A0 = kargs(); bar = xcd_barrier_post((unsigned*)((gu32*)(A0->ws + WS_CTL) + CW_BAR), MISC + 8); }
#define IN(k) (lo <= (k) && (k) < hi)
#ifndef PROBE_MASK
#define PROBE_MASK 0u
#endif
    unsigned long long pr_acc = 0ull, pr_t = 0ull;
    if (PROBE_MASK) pr_t = __builtin_amdgcn_s_memrealtime();
#define SEAM(k) do { if (IN(k) && IN((k) + 1)) xcd_barrier(bar); \
        if (PROBE_MASK) { const unsigned long long now_ = __builtin_amdgcn_s_memrealtime(); if ((PROBE_MASK >> (k)) & 1u) pr_acc += now_ - pr_t; pr_t = now_; } } while (0)

    if (IN(0)) { PH_VARS
        LAS float* scr = (LAS float*)(lds + RING_OFF + wave * 16384);
        { f32x4 cur[8], nxt[8]; int it = gw, li = 0, ln = 0; MatDesc d{}, dn{};
          if (it < NIT_W) { d = mat_of(A_, ws, it, li); trl_load(cur, d, li, lane); }
          while (it < NIT_W) { const int nit = it + NGW; const bool more = nit < NIT_W;
              if (more) { dn = mat_of(A_, ws, nit, ln); trl_load(nxt, dn, ln, lane); }
              tr_store(cur, d.K, d.WT, scr, li, d.nblk, lane);
              if (more) {
#pragma unroll
                  for (int i = 0; i < 8; ++i) cur[i] = nxt[i];
                  d = dn; li = ln; }
              it = nit; } }
        { float* cws = (float*)(ws + WS_CWS); const float* cw_ = A_->in[22]; const float* cb_ = A_->in[23];
          for (int i = gt; i < 2 * 4 * DFF2; i += NGT) { const int l = i / (4 * DFF2), r = i - l * 4 * DFF2, k = r / DFF2, c = r - k * DFF2;
              const float v = (k < 3) ? cw_[((size_t)l * 3 + k) * DFF2 + c] : cb_[(size_t)l * DFF2 + c]; cws[i] = v * (c < DFF ? -1.44269504088896341f : -0.693147180559945309f); } }
        float* t64 = (float*)(ws + WS_TAB64); float* t32 = (float*)(ws + WS_TAB32);
        for (int i = gt; i < 2048 * 32; i += NGT) { const int pos = i >> 5, f = i & 31; const float inv = 1.0f / powf(10000.0f, (float)(2 * f) / 64.0f); const float ang = (float)pos * inv; t64[2 * i] = cosf(ang); t64[2 * i + 1] = sinf(ang); }
        for (int i = gt; i < 2048 * 16; i += NGT) { const int pos = i >> 4, f = i & 15; const float inv = 1.0f / powf(10000.0f, (float)(2 * f) / 32.0f); const float ang = (float)pos * inv; t32[2 * i] = cosf(ang); t32[2 * i + 1] = sinf(ang); }
        asm volatile("s_waitcnt vmcnt(0) lgkmcnt(0)" ::: "memory"); __syncthreads();
        { LAS f32x4* W2 = (LAS f32x4*)(lds + RING_OFF); const float* Wi = A_->in[3]; const float* gg = A_->in[1];
          for (int i = tid; i < 2048; i += NTHR) { const int ln = i & 63, sh = i >> 6, sl = sh >> 1, half = sh & 1, k = 4 * ln + 256 * (sl >> 2) + (sl & 3);
              W2[i] = *(const f32x4*)(Wi + (size_t)k * 3080 + 3072 + 4 * half) * gg[k]; }
          asm volatile("s_waitcnt vmcnt(0) lgkmcnt(0)" ::: "memory"); __syncthreads();
          rms_rows_dt(x, A_->in[1], XN, (float*)(ws + WS_DTR), W2, gw, NGW, lane); }
    }
    SEAM(0);
    if (IN(1)) { PH_VARS EpiIn0 E{(bf16*)(ws + L0_QK), (bf16*)(ws + L0_KC), TAB64, A_->in[10], A_->in[11], (float*)(ws + WS_KMEAN), (float*)(ws + WS_DTR)}; run_gemm(lds, XN, (const bf16*)(ws + WS_W_IN0), T_, 3072, 1024, E); }
    SEAM(1);
    if (IN(2)) { PH_VARS
        for (int u = blockIdx.x; u < 512; u += G) ssd::states_unit(lds, u >> 1, u & 1, (const bf16*)(ws + L0_XBC), (const float*)(ws + WS_DTR), A_->in[4], A_->in[5], A_->in[6], A_->in[7], (float*)(ws + L0_ST), (float*)(ws + WS_CEND));
    }
    SEAM(2);
    if (IN(3)) { PH_VARS
        const float* ST = (const float*)(ws + L0_ST); const float* CEND = (const float*)(ws + WS_CEND); bf16* HIN = (bf16*)(ws + L0_HIN);
        for (int i = gt; i < 16 * 8 * 64 * 128 / 4; i += NGT) {
            const int pn = (i & 2047) * 4, h = (i >> 11) & 7, b = i >> 14; f32x4 hst = {0.f, 0.f, 0.f, 0.f}; f32x4 tmp[16]; float dec[16];
#pragma unroll
            for (int c = 0; c < 16; ++c) { tmp[c] = *(const f32x4*)(ST + (((size_t)((b * 16 + c) * 8 + h) << 13) + pn)); dec[c] = CEND[(b * 16 + c) * 8 + h]; }
#pragma unroll
            for (int c = 0; c < 16; ++c) { const size_t idx = ((size_t)((b * 16 + c) * 8 + h) << 13) + pn;
                *(unsigned long long*)(HIN + idx) = (unsigned long long)pk2(hst.x, hst.y) | ((unsigned long long)pk2(hst.z, hst.w) << 32);
                hst = hst * __expf(dec[c]) + tmp[c]; }
        }
        const bf16* QK = (const bf16*)(ws + L0_QK); const bf16* VZ = (const bf16*)(ws + L0_VZ); const float* KM = (const float*)(ws + WS_KMEAN); bf16* MIX = (bf16*)(ws + L0_MIX);
        asm volatile("s_waitcnt vmcnt(0) lgkmcnt(0)" ::: "memory"); __syncthreads();
        float kb0; { float gm = fabsf(A_->in[11][lane]);
#pragma unroll
          for (int o_ = 1; o_ < 64; o_ <<= 1) gm = fmaxf(gm, __shfl_xor(gm, o_));
          kb0 = 8.0f * 1.02f * gm; }
        { int tb = 0, pbh = -1;
          for (int i = blockIdx.x; i < 1024; i += G) {
            const int s_ = i >> 8, c = i & 255, bh = c >> 1, half = c & 1, qb = (s_ & 1) ? (s_ - 1 + half) : (7 - half - s_), b = bh >> 3, h = bh & 7;
            const int in_ = i + G; const bool hn = (in_ < 1024) && (((in_ & 255) >> 1) == bh);
            at2::Tensors TT{QK + h * 64, (const bf16*)(ws + L0_KC) + (size_t)(b * 8 + h) * (32 * 8 * 512), VZ + h * 64, MIX + h * 64, 1024, 0, 1024, 1024};
            at2::attn_unit_p<64, true, false, 2>(lds, TT, (long)b * 2048, qb, KM + b * 4096 + h * 64, nullptr, nullptr, kb0, tb, pbh == bh, hn);
            tb = (tb + 4 * (qb + 1)) % 6; pbh = hn ? bh : -1; } }
    }
    SEAM(3);
    if (IN(4)) { PH_VARS
        for (int u = blockIdx.x; u < 512; u += G) ssd::out_unit(lds, u >> 1, u & 1, (const bf16*)(ws + L0_XBC), (const bf16*)(ws + L0_VZ), (const float*)(ws + WS_DTR), A_->in[4], A_->in[5], A_->in[6], A_->in[7],
                                                               (const bf16*)(ws + L0_HIN), A_->in[8], A_->in[9], (bf16*)(ws + L0_MIX));
    }
    SEAM(4);
    if (IN(5)) { PH_VARS EpiRes<false, false, true> E{nullptr, x, XN, (unsigned long long*)(ws + WS_SSQA)}; run_gemm(lds, (const bf16*)(ws + L0_MIX), (const bf16*)(ws + WS_W_OUT0), T_, 1024, 1024, E); }
    SEAM(5);
#define FFN_PHASES(P, L, AIN, SSQ_IN, LASTL, SSQ_OUT) \
    if (IN(P)) { PH_VARS EpiFfnUp E{(bf16*)(ws + FF_ACT), (bf16*)(ws + FF_UB), (const unsigned long long*)(ws + (SSQ_IN)), (const float*)(ws + WS_CWS) + (size_t)(L) * 4 * DFF2, nullptr}; \
        run_gemm<EpiFfnUp, 1>(lds, (const bf16*)(ws + (AIN)), (const bf16*)(ws + WS_W_UP) + (size_t)(L) * DFF2 * 1024, T_, DFF2, 1024, E); } \
    SEAM(P); \
    if (IN((P) + 1)) { PH_VARS ffn_fix_rows(gt, 512 * 2 * (DFF / 8), NGT, (const bf16*)(ws + FF_UB), (bf16*)(ws + FF_ACT), A_->in[22] + (size_t)(L) * 3 * DFF2, A_->in[23] + (size_t)(L) * DFF2); } \
    SEAM((P) + 1); \
    if (IN((P) + 2)) { PH_VARS EpiRes<true, LASTL, !LASTL> E{out, (const bf16*)(ws + (AIN)), (bf16*)(ws + (AIN)), (unsigned long long*)(ws + (SSQ_OUT))}; run_gemm(lds, (const bf16*)(ws + FF_ACT), (const bf16*)(ws + WS_W_DN) + (size_t)(L) * 1024 * DFF, T_, 1024, DFF, E); } \
    SEAM((P) + 2);
    FFN_PHASES(6, 0, WS_XN, WS_SSQA, false, WS_SSQB)
    if (IN(9)) { PH_VARS EpiMlaIn E{(bf16*)(ws + L1_C1), (const unsigned long long*)(ws + WS_SSQB), (unsigned long long*)(ws + WS_SSQQ), (unsigned long long*)(ws + WS_SSQKV), (float*)(ws + WS_SSQPE), (float*)(ws + WS_RG), A_->in[19], TAB32}; run_gemm(lds, XN, (const bf16*)(ws + WS_W_IN1), T_, 1024, 1024, E); }
    SEAM(9);
    if (IN(10)) { PH_VARS const bf16* C1 = (const bf16*)(ws + L1_C1);
        { EpiScale E{(bf16*)(ws + L1_QR), 1536, (const unsigned long long*)(ws + WS_SSQQ), 1.0f / 512.0f}; run_gemm(lds, C1, (const bf16*)(ws + WS_W_UQ), T_, 1536, 512, E, 1024); }
        { EpiUkv E{(bf16*)(ws + L1_K2), (bf16*)(ws + L1_V2), (const unsigned long long*)(ws + WS_SSQKV), (const float*)(ws + WS_SSQPE), (const float*)(ws + WS_RG), A_->in[19]}; run_gemm(lds, C1 + 512, (const bf16*)(ws + WS_W_UKV), T_, 2048, 256, E, 1024); } }
    SEAM(10);
    if (IN(11)) { PH_VARS
        const bf16* Q2 = (const bf16*)(ws + L1_QR); const bf16* K2 = (const bf16*)(ws + L1_K2); const bf16* V2 = (const bf16*)(ws + L1_V2); bf16* O = (bf16*)(ws + L1_O);
        float kb1; { float gm = fmaxf(fabsf(A_->in[19][lane]), (lane < 32) ? fabsf(A_->in[19][64 + lane]) : 0.f);
#pragma unroll
          for (int o_ = 1; o_ < 64; o_ <<= 1) gm = fmaxf(gm, __shfl_xor(gm, o_));
          kb1 = 9.797958971f * 1.02f * gm; }
        { int tb = 0, pbh = -1;
          for (int i = blockIdx.x; i < 2048; i += G) {
            const int s_ = i >> 8, bh = i & 255, qb = 7 - s_, b = bh >> 4, h = bh & 15;
            const int in_ = i + G; const bool hn = (in_ < 2048) && ((in_ & 255) == bh);
            at2::Tensors TT{Q2 + h * 96, K2 + (size_t)(b * 16 + h) * (32 * 12 * 512), V2 + h * 64, O + h * 64, 1536, 0, 1024, 1024};
            at2::attn_unit_p<96, false, true, 2>(lds, TT, (long)b * 2048, qb, nullptr, A_->in[18], TAB32, kb1, tb, pbh == bh, hn);
            tb = (tb + 4 * (qb + 1)) % 6; pbh = hn ? bh : -1; } }
    }
    SEAM(11);
    if (IN(12)) { PH_VARS EpiRes<true, false, true> E{nullptr, XN, (bf16*)(ws + WS_BIG), (unsigned long long*)(ws + WS_SSQC)}; run_gemm(lds, (const bf16*)(ws + L1_O), (const bf16*)(ws + WS_W_OUT1), T_, 1024, 1024, E); }
    SEAM(12);
    FFN_PHASES(13, 1, WS_BIG, WS_SSQC, true, WS_SSQB)
    if (PROBE_MASK) { if (blockIdx.x == 0 && threadIdx.x == 0) { const unsigned long long t0 = __builtin_amdgcn_s_memrealtime(); while (__builtin_amdgcn_s_memrealtime() - t0 < pr_acc) __builtin_amdgcn_s_sleep(8); } }
#undef IN
#undef SEAM
}
constexpr int LAST_PHASE = 16;

#ifndef MK_ONE_LAUNCH
#define MK_ONE_LAUNCH 1
#endif
extern "C" void kernel_launch(void* const* d_in, const int* in_sizes, int n_in, void* d_out, int out_size, void* d_ws, size_t ws_size, hipStream_t stream) {
    static int grid = 0;
    if (grid == 0) {
        if (n_in != 25 || out_size != T_ * D_ || ws_size < WS_END) { fprintf(stderr, "kernel_launch: unexpected shapes: n_in %d out %d ws %zu\n", n_in, out_size, ws_size); grid = -1; return; }
        if (hipFuncSetAttribute((const void*)fwd, hipFuncAttributeMaxDynamicSharedMemorySize, LDS_BYTES) != hipSuccess) { fprintf(stderr, "kernel_launch: hipFuncSetAttribute failed\n"); grid = -1; return; }
        int dev = 0, cus = 0, per_cu = 0;
        hipGetDevice(&dev); hipDeviceGetAttribute(&cus, hipDeviceAttributeMultiprocessorCount, dev);
        hipOccupancyMaxActiveBlocksPerMultiprocessor(&per_cu, (const void*)fwd, NTHR, LDS_BYTES);
        (void)hipGetLastError();
        grid = (per_cu >= 1) ? cus : -1;
        if (grid < 0) { fprintf(stderr, "kernel_launch: occupancy query says 0 blocks per CU\n"); return; }
    }
    if (grid < 0) return;
    hipMemsetAsync((char*)d_ws + WS_CTL, 0, CTL_ZERO_BYTES, stream);
    Args a{};
    for (int i = 0; i < 25; ++i) a.in[i] = (const float*)d_in[i];
    a.out = (float*)d_out; a.ws = (unsigned char*)d_ws;
#if MK_ONE_LAUNCH
    a.ph_lo = 0; a.ph_hi = LAST_PHASE;
    hipLaunchKernelGGL(fwd, dim3(grid), dim3(NTHR), LDS_BYTES, stream, a);
#else
    for (int p = 0; p < LAST_PHASE; ++p) { a.ph_lo = p; a.ph_hi = p + 1; hipLaunchKernelGGL(fwd, dim3(grid), dim3(NTHR), LDS_BYTES, stream, a); }
#endif
}
```

```cpp
#include <hip/hip_runtime.h>
#include <cstdio>
#include <cstdint>
namespace pg8 {
#define PG8_LAS __attribute__((address_space(3)))
typedef unsigned short bf16_t;
typedef short bf16x8 __attribute__((ext_vector_type(8)));
typedef float f32x4 __attribute__((ext_vector_type(4)));
typedef unsigned u32x4 __attribute__((ext_vector_type(4)));
constexpr int BM = 256, BK = 64, HALF = 128, HTB = HALF * BK * 2  , STAGE_BYTES = 8 * HTB, NXCD = 8, WGM = 8;

__host__ __device__ __forceinline__ int lds_byte(int r, int c) { const int st = (r >> 4) * 2 + (c >> 5), rr = r & 15, cc = c & 31, ob = rr * 64 + cc * 2; return st * 1024 + (ob ^ (((ob >> 9) & 1) << 5)); }
__host__ __device__ __forceinline__ void stage_rc(int b, int& R, int& C) { const int st = b / 1024, sb = b % 1024, swz = sb ^ (((sb >> 9) & 1) << 5); R = (st >> 1) * 16 + swz / 64; C = (st & 1) * 32 + (swz % 64) / 2; }
__host__ __device__ __forceinline__ int perm32(int rho) { const int n = rho >> 4, i = rho & 15; return 8 * (i >> 2) + 4 * n + (i & 3); }

struct Unit { int pm, pn; };
struct Gemm { const bf16_t* A; const bf16_t* Bt; int M, N, K, lda; };

struct StaticOrder {
    int nM, nN, nwg, G, c;
    __host__ __device__ __forceinline__ void init(int M, int N, int G_, int c_) { nM = M / BM; nN = N / BM; nwg = nM * nN; G = G_; c = c_; }
    __host__ __device__ __forceinline__ bool next(int i, Unit& u) const {
        const long L = (long)i * G + c; if (L >= nwg) return false;
        int wgid = (int)L; { const int q = nwg / NXCD, r = nwg % NXCD, xcd = wgid % NXCD, off = wgid / NXCD; wgid = (xcd < r ? xcd * (q + 1) : r * (q + 1) + (xcd - r) * q) + off; }
        const int nig = WGM * nN, gid = wgid / nig, fm = gid * WGM, gsz = (nM - fm) < WGM ? (nM - fm) : WGM;
        u.pm = fm + ((wgid % nig) % gsz); u.pn = (wgid % nig) / gsz; return true;
    }
    __device__ __forceinline__ void a_ready(const Unit&) const {}
    __device__ __forceinline__ void done(const Unit&) const {}
};

__device__ __forceinline__ unsigned cvt_pk_bf16(float lo, float hi) { unsigned r; asm volatile("v_cvt_pk_bf16_f32 %0, %1, %2" : "=v"(r) : "v"(lo), "v"(hi)); return r; }
typedef float f32x2 __attribute__((ext_vector_type(2)));
__device__ __forceinline__ f32x2 gelu_pk(f32x2 v) {
    const f32x2 av = __builtin_elementwise_abs(v), d = av * 0.2316418882f + 1.0f;
    f32x2 t; t.x = __builtin_amdgcn_rcpf(d.x); t.y = __builtin_amdgcn_rcpf(d.y);
    f32x2 q = t * 0.5307027145f + (-0.7265760135f); q = q * t + 0.7107068705f; q = q * t + (-0.142248368f); q = q * t + 0.127414796f; q = q * t;
    const f32x2 s = (v * v) * (-0.72134752044f);
    f32x2 e; e.x = __builtin_amdgcn_exp2f(s.x); e.y = __builtin_amdgcn_exp2f(s.y);
    const f32x2 m = v * (q * e), r = v - m;
    f32x2 o; o.x = v.x < 0.f ? m.x : r.x; o.y = v.y < 0.f ? m.y : r.y; return o;
}

template <int ACT  > struct EpiBf16 {
    static constexpr bool PERM = true, AFTER_DRAIN = false; static_assert(ACT == 0 || ACT == 1, "EpiBf16: ACT is 0 (none) or 1 (gelu_pk)");
    bf16_t* O; int ldc; const float* bias; int split_cols; size_t split_stride; float scale0;
    __device__ __forceinline__ void operator()(const f32x4 (&acc)[2][2][4][2], const Unit& u, int wr, int wc, int fr, int fq) const {
        const int row0 = u.pm * BM + wr * 64 + fr; int colt = u.pn * BM; bf16_t* base = O;
        float sc = 1.f; if (split_cols) { const int t = colt / split_cols; base += (size_t)t * split_stride; colt -= t * split_cols; if (t == 0) sc = scale0; }
        const int col0 = colt + wc * 32 + 8 * fq, bcol0 = u.pn * BM + wc * 32 + 8 * fq;
        f32x4 bv[2][2];
#pragma unroll
        for (int bj = 0; bj < 2; ++bj)
#pragma unroll
            for (int n = 0; n < 2; ++n) bv[bj][n] = bias ? *(const f32x4*)(bias + bcol0 + bj * HALF + 4 * n) : (f32x4){0.f, 0.f, 0.f, 0.f};
#pragma unroll
        for (int ai = 0; ai < 2; ++ai)
#pragma unroll
            for (int m = 0; m < 4; ++m) { bf16_t* rowp = base + (size_t)(row0 + ai * HALF + m * 16) * ldc + col0;
#pragma unroll
                for (int bj = 0; bj < 2; ++bj) { f32x4 v0 = acc[ai][bj][m][0] + bv[bj][0], v1 = acc[ai][bj][m][1] + bv[bj][1];
                    if (ACT == 1) { f32x2 a = gelu_pk((f32x2){v0[0], v0[1]}), b = gelu_pk((f32x2){v0[2], v0[3]}), c = gelu_pk((f32x2){v1[0], v1[1]}), d = gelu_pk((f32x2){v1[2], v1[3]});
                        v0 = (f32x4){a.x, a.y, b.x, b.y}; v1 = (f32x4){c.x, c.y, d.x, d.y}; }
                    v0 = v0 * sc; v1 = v1 * sc; u32x4 w; w.x = cvt_pk_bf16(v0[0], v0[1]); w.y = cvt_pk_bf16(v0[2], v0[3]); w.z = cvt_pk_bf16(v1[0], v1[1]); w.w = cvt_pk_bf16(v1[2], v1[3]);
                    *(u32x4*)(rowp + bj * HALF) = w; } }
    }
};

struct PanelStats {
    unsigned* xbuf;
    unsigned* cnt;
    unsigned* tmo;
    int ntn; float eps;
    unsigned code;
    __device__ __forceinline__ bool run(const f32x4 (&v)[2][2][4][2], const Unit& u, int wr, int wc, int fr, int fq, PG8_LAS unsigned char* lds, int wid, int lane) const {
        typedef float f32x2v __attribute__((ext_vector_type(2)));
        PG8_LAS f32x2v* P = (PG8_LAS f32x2v*)lds;
        PG8_LAS f32x2v* S = (PG8_LAS f32x2v*)(lds + 8192);
        PG8_LAS unsigned* flag = (PG8_LAS unsigned*)(lds + 8192 + 2048);
#pragma unroll
        for (int ai = 0; ai < 2; ++ai)
#pragma unroll
            for (int m = 0; m < 4; ++m) {
                float s = 0.f;
#pragma unroll
                for (int bj = 0; bj < 2; ++bj)
#pragma unroll
                    for (int n = 0; n < 2; ++n) { const f32x4 x = v[ai][bj][m][n]; s += (x[0] + x[1]) + (x[2] + x[3]); }
                s += __shfl_xor(s, 16); s += __shfl_xor(s, 32);
                const float mw = s * (1.0f / 64.0f); float q = 0.f;
#pragma unroll
                for (int bj = 0; bj < 2; ++bj)
#pragma unroll
                    for (int n = 0; n < 2; ++n) { const f32x4 d = v[ai][bj][m][n] - mw; q += (d[0] * d[0] + d[1] * d[1]) + (d[2] * d[2] + d[3] * d[3]); }
                q += __shfl_xor(q, 16); q += __shfl_xor(q, 32);
                if (fq == 0) P[(ai * HALF + wr * 64 + m * 16 + fr) * 4 + wc] = (f32x2v){mw, q};
            }
        asm volatile("s_waitcnt lgkmcnt(0)" ::: "memory"); __builtin_amdgcn_s_barrier(); asm volatile("" ::: "memory");
#if defined(BROKEN_EXCHANGE_NO_WAIT)
#warning BROKEN CONTROL BUILD: the row-statistics exchange does not wait; results are wrong by design
        if (blockIdx.x >= 64) { const long long t0_ = clock64(); while (clock64() - t0_ < 60000) __builtin_amdgcn_s_sleep(8); }
#endif
        const int row = wid * 32 + (lane & 31);
        if (lane < 32) {
            const f32x2v a = P[row * 4 + 0], b = P[row * 4 + 1], c = P[row * 4 + 2], d = P[row * 4 + 3];
            const float mt = (a.x + b.x + c.x + d.x) * 0.25f;
            const float da = a.x - mt, db = b.x - mt, dc = c.x - mt, dd = d.x - mt;
            const float m2 = (a.y + b.y) + (c.y + d.y) + 64.0f * ((da * da + db * db) + (dc * dc + dd * dd));
            unsigned long long* slot = (unsigned long long*)xbuf + ((size_t)(u.pm * BM + row) * 4 + u.pn);
            __hip_atomic_store(slot, ((unsigned long long)__float_as_uint(m2) << 32) | __float_as_uint(mt), __ATOMIC_RELAXED, __HIP_MEMORY_SCOPE_AGENT);
        }
        asm volatile("s_waitcnt vmcnt(0)" ::: "memory");
        if (lane == 0) __hip_atomic_fetch_add(cnt + 64 * u.pm, 1u, __ATOMIC_RELAXED, __HIP_MEMORY_SCOPE_AGENT);
        if (wid == 0) {
            bool dead = false; const unsigned long long t0 = __builtin_amdgcn_s_memrealtime(); const unsigned want = 8u * (unsigned)ntn;
            for (;;) {
#if defined(BROKEN_EXCHANGE_NO_WAIT)
                break;
#endif
                if ((unsigned)__builtin_amdgcn_readfirstlane(__hip_atomic_load(cnt + 64 * u.pm, __ATOMIC_RELAXED, __HIP_MEMORY_SCOPE_AGENT)) >= want) break;
                if (__builtin_amdgcn_s_memrealtime() - t0 > 2000000ull) {
                    if (lane == 0) { unsigned expect = 0u; __hip_atomic_compare_exchange_strong(tmo + 1, &expect, code | (unsigned)(u.pm & 0xff), __ATOMIC_RELAXED, __ATOMIC_RELAXED, __HIP_MEMORY_SCOPE_AGENT);
                                     __hip_atomic_store(tmo, 1u, __ATOMIC_RELAXED, __HIP_MEMORY_SCOPE_AGENT); }
                    dead = true; break; }
                __builtin_amdgcn_s_sleep(2);
            }
            __builtin_amdgcn_fence(__ATOMIC_ACQUIRE, "agent");
            if (lane == 0) flag[0] = dead ? 1u : 0u;
        }
        asm volatile("s_waitcnt vmcnt(0) lgkmcnt(0)" ::: "memory"); __builtin_amdgcn_s_barrier(); asm volatile("" ::: "memory");
        const bool bad = flag[0] != 0u;
        if (lane < 32) {
            const unsigned long long* slot = (const unsigned long long*)xbuf + (size_t)(u.pm * BM + row) * 4; float mt[4], m2[4]; float ms = 0.f;
#pragma unroll
            for (int t = 0; t < 4; ++t) { if (t < ntn) { const unsigned long long w = __hip_atomic_load(slot + t, __ATOMIC_RELAXED, __HIP_MEMORY_SCOPE_AGENT); mt[t] = __uint_as_float((unsigned)w); m2[t] = __uint_as_float((unsigned)(w >> 32)); } else { mt[t] = 0.f; m2[t] = 0.f; } ms += mt[t]; }
            const float mean = ms / (float)ntn; float q = 0.f;
#pragma unroll
            for (int t = 0; t < 4; ++t) if (t < ntn) { const float dm = mt[t] - mean; q += m2[t] + 256.0f * dm * dm; }
            S[row] = (f32x2v){mean, 1.0f / sqrtf(q / (256.0f * (float)ntn) + eps)};
        }
        asm volatile("s_waitcnt lgkmcnt(0)" ::: "memory"); __builtin_amdgcn_s_barrier(); asm volatile("" ::: "memory");
        return bad;
    }
};
struct EpiLnRes {
    static constexpr bool PERM = false, AFTER_DRAIN = true;
    const float* base; float* out; int ldc; const float* bias; PanelStats st; unsigned poison;
    __device__ __forceinline__ void fused(f32x4 (&acc)[2][2][4][2], const Unit& u, int wr, int wc, int fr, int fq, PG8_LAS unsigned char* lds, int wid, int lane) const {
        typedef float f32x2v __attribute__((ext_vector_type(2)));
        const PG8_LAS f32x2v* S = (const PG8_LAS f32x2v*)(lds + 8192);
        const int col0 = u.pn * BM + wc * 32 + 4 * fq;
#pragma unroll
        for (int bj = 0; bj < 2; ++bj)
#pragma unroll
            for (int n = 0; n < 2; ++n) { const f32x4 bv = bias ? *(const f32x4*)(bias + col0 + bj * HALF + n * 16) : (f32x4){0.f, 0.f, 0.f, 0.f};
#pragma unroll
                for (int ai = 0; ai < 2; ++ai)
#pragma unroll
                    for (int m = 0; m < 4; ++m) acc[ai][bj][m][n] += bv; }
        f32x4 pre[4][2][2];
#pragma unroll
        for (int m = 0; m < 4; ++m) { const size_t off = (size_t)(u.pm * BM + wr * 64 + m * 16 + fr) * ldc + col0;
#pragma unroll
            for (int bj = 0; bj < 2; ++bj)
#pragma unroll
                for (int n = 0; n < 2; ++n) pre[m][bj][n] = *(const f32x4*)(base + off + bj * HALF + n * 16); }
        const bool bad = st.run(acc, u, wr, wc, fr, fq, lds, wid, lane) || poison != 0u;
        const float qnan = __builtin_nanf("");
#pragma unroll
        for (int ai = 0; ai < 2; ++ai)
#pragma unroll
            for (int m = 0; m < 4; ++m) { const int r = ai * HALF + wr * 64 + m * 16 + fr; const f32x2v sr = S[r]; const size_t off = (size_t)(u.pm * BM + r) * ldc + col0;
#pragma unroll
                for (int bj = 0; bj < 2; ++bj)
#pragma unroll
                    for (int n = 0; n < 2; ++n) { const f32x4 bs = ai == 0 ? pre[m][bj][n] : *(const f32x4*)(base + off + bj * HALF + n * 16); f32x4 o = bs + (acc[ai][bj][m][n] - sr.x) * sr.y;
                        if (bad) o = (f32x4){qnan, qnan, qnan, qnan}; *(f32x4*)(out + off + bj * HALF + n * 16) = o; }
                if (m & 1) asm volatile("" ::: "memory"); }
    }
};
struct EpiLnResLn {
    static constexpr bool PERM = false, AFTER_DRAIN = true;
    const float* base; float* out; bf16_t* xn; int ldc; const float* bias; PanelStats st1, st2; unsigned poison;
    __device__ __forceinline__ void fused(f32x4 (&acc)[2][2][4][2], const Unit& u, int wr, int wc, int fr, int fq, PG8_LAS unsigned char* lds, int wid, int lane) const {
        typedef float f32x2v __attribute__((ext_vector_type(2))); typedef unsigned u32x2v __attribute__((ext_vector_type(2)));
        const PG8_LAS f32x2v* S = (const PG8_LAS f32x2v*)(lds + 8192);
        const int col0 = u.pn * BM + wc * 32 + 4 * fq;
#pragma unroll
        for (int bj = 0; bj < 2; ++bj)
#pragma unroll
            for (int n = 0; n < 2; ++n) { const f32x4 bv = bias ? *(const f32x4*)(bias + col0 + bj * HALF + n * 16) : (f32x4){0.f, 0.f, 0.f, 0.f};
#pragma unroll
                for (int ai = 0; ai < 2; ++ai)
#pragma unroll
                    for (int m = 0; m < 4; ++m) acc[ai][bj][m][n] += bv; }
        bool bad = st1.run(acc, u, wr, wc, fr, fq, lds, wid, lane) || poison != 0u;
        const float qnan = __builtin_nanf("");
#pragma unroll
        for (int ai = 0; ai < 2; ++ai)
#pragma unroll
            for (int m = 0; m < 4; ++m) { const int r = ai * HALF + wr * 64 + m * 16 + fr; const f32x2v sr = S[r]; const size_t off = (size_t)(u.pm * BM + r) * ldc + col0;
#pragma unroll
                for (int bj = 0; bj < 2; ++bj)
#pragma unroll
                    for (int n = 0; n < 2; ++n) { const f32x4 bs = *(const f32x4*)(base + off + bj * HALF + n * 16); acc[ai][bj][m][n] = bs + (acc[ai][bj][m][n] - sr.x) * sr.y; }
                asm volatile("" : "+v"(acc[ai][0][m][0]), "+v"(acc[ai][0][m][1]), "+v"(acc[ai][1][m][0]), "+v"(acc[ai][1][m][1]));
                if (m & 1) asm volatile("" ::: "memory"); }
        const bool bad1 = bad;
        bad = st2.run(acc, u, wr, wc, fr, fq, lds, wid, lane) || bad;
#pragma unroll
        for (int ai = 0; ai < 2; ++ai)
#pragma unroll
            for (int m = 0; m < 4; ++m) { const int r = ai * HALF + wr * 64 + m * 16 + fr; const f32x2v sr = S[r]; const size_t off = (size_t)(u.pm * BM + r) * ldc + col0;
#pragma unroll
                for (int bj = 0; bj < 2; ++bj)
#pragma unroll
                    for (int n = 0; n < 2; ++n) { const f32x4 x1 = acc[ai][bj][m][n]; *(f32x4*)(out + off + bj * HALF + n * 16) = bad1 ? (f32x4){qnan, qnan, qnan, qnan} : x1;
                        const f32x4 o = (x1 - sr.x) * sr.y; u32x2v w; w.x = cvt_pk_bf16(o[0], o[1]); w.y = cvt_pk_bf16(o[2], o[3]);
                        if (bad) { w.x = 0x7fc07fc0u; w.y = 0x7fc07fc0u; } *(u32x2v*)(xn + off + bj * HALF + n * 16) = w; }
                asm volatile("" ::: "memory"); }
    }
};

template <class Epi, class Sched, bool ALIGN_EPI = false, bool SP2 = false, int AROW = 0>
__device__ __forceinline__ void gemm_phase(PG8_LAS unsigned char* lds, const Gemm g, const Sched& S, const Epi& E) {
    int tid_ = threadIdx.x; asm volatile("" : "+v"(tid_));
    const int tid = tid_, wid = __builtin_amdgcn_readfirstlane(tid >> 6), lane = tid & 63, wr = wid >> 2, wc = wid & 3, fr = lane & 15, fq = lane >> 4;
    const int K = g.K, nt = K / BK;
    unsigned voffA[2], voffB[2];
#pragma unroll
    for (int i = 0; i < 2; ++i) { int R, C; stage_rc(tid * 16 + i * 8192, R, C); const int Rb = Epi::PERM ? ((R & ~31) + perm32(R & 31)) : R;
        const int Ra = (AROW == 1) ? ((R & ~63) + 4 * (R & 15) + ((R >> 4) & 3)) : R;
        voffA[i] = (unsigned)(Ra * g.lda + C) * 2u; voffB[i] = (unsigned)(Rb * K + C) * 2u;
        if (AROW == 2) { const int tp = 4 * ((lane >> 2) & 3) + (lane >> 4), c = lane & 3;
            voffA[i] = (unsigned)((64 * i + 16 * (wid & 3) + tp) * g.lda + 32 * (wid >> 2) + 8 * c) * 2u; } }
    const size_t kstep = (size_t)(BK * 2);
    const size_t hstep = (size_t)HALF * K * 2;
    const size_t tstep = 2 * hstep;
    const size_t hstepA = (size_t)HALF * g.lda * 2, tstepA = 2 * hstepA;
    const unsigned ldsw = (unsigned)wid * 1024u;
    constexpr int PSTR = 1056, HTBA = (AROW == 2) ? 16 * PSTR : HTB;
    const int aoff = (AROW == 2) ? (wr * 8 + (fr >> 2)) * PSTR + 64 * (fr & 3) + 16 * fq : lds_byte(wr * 64 + fr, fq * 8), boff = lds_byte(wc * 32 + fr, fq * 8);
    constexpr int AM = (AROW == 2) ? 256 : 2048, AK = (AROW == 2) ? 4 * PSTR : 1024;
    const unsigned ldswA = (AROW == 2) ? (unsigned)wid * PSTR : (unsigned)wid * 1024u; constexpr unsigned ISTRA = (AROW == 2) ? 8u * PSTR : 8192u;
#define PG8_SA(b, h) (((b) * 2 + (h)) * HTBA)
#define PG8_SB(b, h) (4 * HTBA + ((b) * 2 + (h)) * HTB)
#define PG8_STAGEA(bufoff, gbase, voff) do { _Pragma("unroll") for (int _i = 0; _i < 2; ++_i) \
        __builtin_amdgcn_global_load_lds((const unsigned*)((const char*)(gbase) + (voff)[_i]), (PG8_LAS unsigned*)(lds + (bufoff) + ldswA + _i * ISTRA), 16, 0, 0); } while (0)
#define PG8_STAGE(bufoff, gbase, voff) do { _Pragma("unroll") for (int _i = 0; _i < 2; ++_i) \
        __builtin_amdgcn_global_load_lds((const unsigned*)((const char*)(gbase) + (voff)[_i]), (PG8_LAS unsigned*)(lds + (bufoff) + ldsw + _i * 8192), 16, 0, 0); } while (0)
#define PG8_LDA(dst, b, h) do { _Pragma("unroll") for (int m = 0; m < 4; ++m) _Pragma("unroll") for (int k = 0; k < 2; ++k) dst[m][k] = *(const PG8_LAS bf16x8*)(lds + PG8_SA(b, h) + aoff + m * AM + k * AK); } while (0)
#define PG8_LDB(dst, b, h) do { _Pragma("unroll") for (int n = 0; n < 2; ++n) _Pragma("unroll") for (int k = 0; k < 2; ++k) dst[n][k] = *(const PG8_LAS bf16x8*)(lds + PG8_SB(b, h) + boff + n * 2048 + k * 1024); } while (0)
#define PG8_MMA(ai, bj, At, Bt) do { __builtin_amdgcn_s_setprio(1); _Pragma("unroll") for (int m = 0; m < 4; ++m) _Pragma("unroll") for (int n = 0; n < 2; ++n) _Pragma("unroll") for (int k = 0; k < 2; ++k) \
        acc[ai][bj][m][n] = __builtin_amdgcn_mfma_f32_16x16x32_bf16(Bt[n][k], At[m][k], acc[ai][bj][m][n], 0, 0, 0); __builtin_amdgcn_s_setprio(0); } while (0)
#define PG8_WAIT_V(n) asm volatile("s_waitcnt vmcnt(" #n ")" ::: "memory")
#define PG8_WAIT_L(n) asm volatile("s_waitcnt lgkmcnt(" #n ")" ::: "memory")
#define PG8_BAR __builtin_amdgcn_s_barrier()
#define PG8_SCHED __builtin_amdgcn_sched_barrier(0)
    Unit cur, nxt; int ui = 0;
    if (!S.next(0, cur)) return;
    f32x4 acc[2][2][4][2];
#pragma unroll
    for (int a = 0; a < 2; ++a)
#pragma unroll
        for (int b = 0; b < 2; ++b)
#pragma unroll
            for (int m = 0; m < 4; ++m)
#pragma unroll
                for (int n = 0; n < 2; ++n) acc[a][b][m][n] = (f32x4){0.f, 0.f, 0.f, 0.f};
    bf16x8 At[4][2], B0[2][2], B1[2][2];
    const char* cA = (const char*)g.A + (size_t)cur.pm * tstepA; const char* cB = (const char*)g.Bt + (size_t)cur.pn * tstep;
    S.a_ready(cur);
    if constexpr (SP2) {
        PG8_STAGE(PG8_SB(0, 0), cB, voffB); PG8_STAGE(PG8_SB(0, 1), cB + hstep, voffB); PG8_STAGEA(PG8_SA(0, 0), cA, voffA); PG8_STAGEA(PG8_SA(0, 1), cA + hstepA, voffA);
        if (wr == 1) PG8_BAR;
        PG8_WAIT_V(2); PG8_BAR;
        PG8_STAGE(PG8_SB(1, 0), cB + kstep, voffB); PG8_STAGEA(PG8_SA(1, 0), cA + kstep, voffA); PG8_STAGE(PG8_SB(1, 1), cB + hstep + kstep, voffB);
        PG8_WAIT_V(6); PG8_BAR;
    } else {
        PG8_STAGE(PG8_SB(0, 0), cB, voffB); PG8_STAGEA(PG8_SA(0, 0), cA, voffA); PG8_STAGE(PG8_SB(0, 1), cB + hstep, voffB); PG8_STAGEA(PG8_SA(0, 1), cA + hstepA, voffA);
        if (wr == 1) PG8_BAR;
        PG8_WAIT_V(4); PG8_BAR;
        PG8_STAGE(PG8_SB(1, 0), cB + kstep, voffB); PG8_STAGEA(PG8_SA(1, 0), cA + kstep, voffA); PG8_STAGE(PG8_SB(1, 1), cB + hstep + kstep, voffB);
        PG8_WAIT_V(6); PG8_BAR;
    }
    for (;;) {
        const bool has_next = S.next(ui + 1, nxt);
        const char* nA = has_next ? (const char*)g.A + (size_t)nxt.pm * tstepA : cA; const char* nB = has_next ? (const char*)g.Bt + (size_t)nxt.pn * tstep : cB;
#pragma unroll 1
        for (int t = 0; t < nt; t += 2) {
            const bool last = (t == nt - 2);
            const char* a1 = cA + (size_t)(t + 1) * kstep;
            const char* a2 = last ? nA : cA + (size_t)(t + 2) * kstep; const char* b2 = last ? nB : cB + (size_t)(t + 2) * kstep;
            const char* a3 = a2 + kstep; const char* b3 = b2 + kstep;
            if (last && has_next) S.a_ready(nxt);
            if constexpr (SP2) {
            PG8_LDB(B0, 0, 0); PG8_LDB(B1, 0, 1); PG8_SCHED; PG8_LDA(At, 0, 0); PG8_STAGEA(PG8_SA(1, 1), a1 + hstepA, voffA);
            PG8_WAIT_V(8); PG8_WAIT_L(0); PG8_BAR; PG8_MMA(0, 0, At, B0); PG8_MMA(0, 1, At, B1); PG8_BAR; PG8_SCHED;
            PG8_LDA(At, 0, 1); PG8_STAGE(PG8_SB(0, 0), b2, voffB); PG8_STAGE(PG8_SB(0, 1), b2 + hstep, voffB); PG8_STAGEA(PG8_SA(0, 0), a2, voffA);
            PG8_WAIT_V(8); PG8_WAIT_L(0); PG8_BAR; PG8_MMA(1, 0, At, B0); PG8_MMA(1, 1, At, B1); PG8_BAR; PG8_SCHED;
            PG8_LDB(B0, 1, 0); PG8_LDB(B1, 1, 1); PG8_SCHED; PG8_LDA(At, 1, 0); PG8_STAGEA(PG8_SA(0, 1), a2 + hstepA, voffA);
            PG8_WAIT_V(8); PG8_WAIT_L(0); PG8_BAR; PG8_MMA(0, 0, At, B0); PG8_MMA(0, 1, At, B1); PG8_BAR; PG8_SCHED;
            PG8_LDA(At, 1, 1); PG8_STAGE(PG8_SB(1, 0), b3, voffB); PG8_STAGE(PG8_SB(1, 1), b3 + hstep, voffB); PG8_STAGEA(PG8_SA(1, 0), a3, voffA);
            PG8_WAIT_V(8); PG8_WAIT_L(0); PG8_BAR; PG8_MMA(1, 0, At, B0); PG8_MMA(1, 1, At, B1); PG8_BAR; PG8_SCHED;
            } else {
            PG8_LDB(B0, 0, 0); PG8_SCHED; PG8_LDA(At, 0, 0); PG8_STAGEA(PG8_SA(1, 1), a1 + hstepA, voffA);
            PG8_WAIT_L(8); PG8_BAR; PG8_WAIT_L(0); PG8_MMA(0, 0, At, B0); PG8_BAR; PG8_SCHED;
            PG8_LDB(B1, 0, 1); PG8_STAGE(PG8_SB(0, 0), b2, voffB);
            PG8_BAR; PG8_WAIT_L(0); PG8_MMA(0, 1, At, B1); PG8_BAR;
            PG8_LDA(At, 0, 1); PG8_STAGEA(PG8_SA(0, 0), a2, voffA);
            PG8_BAR; PG8_WAIT_L(0); PG8_MMA(1, 0, At, B0); PG8_BAR; PG8_SCHED;
            PG8_STAGE(PG8_SB(0, 1), b2 + hstep, voffB);
            PG8_WAIT_V(6); PG8_BAR; PG8_MMA(1, 1, At, B1); PG8_BAR;
            PG8_LDB(B0, 1, 0); PG8_SCHED; PG8_LDA(At, 1, 0); PG8_STAGEA(PG8_SA(0, 1), a2 + hstepA, voffA);
            PG8_WAIT_L(8); PG8_BAR; PG8_WAIT_L(0); PG8_MMA(0, 0, At, B0); PG8_BAR; PG8_SCHED;
            PG8_LDB(B1, 1, 1); PG8_STAGE(PG8_SB(1, 0), b3, voffB);
            PG8_BAR; PG8_WAIT_L(0); PG8_MMA(0, 1, At, B1); PG8_BAR;
            PG8_LDA(At, 1, 1); PG8_STAGEA(PG8_SA(1, 0), a3, voffA);
            PG8_BAR; PG8_WAIT_L(0); PG8_MMA(1, 0, At, B0); PG8_BAR; PG8_SCHED;
            PG8_STAGE(PG8_SB(1, 1), b3 + hstep, voffB);
            PG8_WAIT_V(6); PG8_BAR; PG8_MMA(1, 1, At, B1); PG8_BAR;
            }
        }
        if constexpr (ALIGN_EPI) { if (wr == 0) PG8_BAR; }
        if constexpr (!Epi::AFTER_DRAIN) { E(acc, cur, wr, wc, fr, fq); S.done(cur); }
        if (!has_next) break;
#pragma unroll
        for (int a = 0; a < 2; ++a)
#pragma unroll
            for (int b = 0; b < 2; ++b)
#pragma unroll
                for (int m = 0; m < 4; ++m)
#pragma unroll
                    for (int n = 0; n < 2; ++n) acc[a][b][m][n] = (f32x4){0.f, 0.f, 0.f, 0.f};
        cur = nxt; cA = nA; cB = nB; ++ui;
        if constexpr (ALIGN_EPI) { if (wr == 1) PG8_BAR; }
    }
    PG8_WAIT_V(0);
    if constexpr (!ALIGN_EPI) { if (wr == 0) PG8_BAR; }
    PG8_BAR;
    if constexpr (Epi::AFTER_DRAIN) { E.fused(acc, cur, wr, wc, fr, fq, lds, wid, lane); S.done(cur); }
#undef PG8_SA
#undef PG8_SB
#undef PG8_STAGE
#undef PG8_STAGEA
#undef PG8_LDA
#undef PG8_LDB
#undef PG8_MMA
#undef PG8_WAIT_V
#undef PG8_WAIT_L
#undef PG8_BAR
#undef PG8_SCHED
}
}

#ifndef PG8_SP2
#define PG8_SP2 true
#endif
#ifndef PG8_ALIGN
#define PG8_ALIGN true
#endif
#define GAS __attribute__((address_space(1)))
#define LAS __attribute__((address_space(3)))
typedef unsigned short bf16;
typedef unsigned v4u __attribute__((ext_vector_type(4)));
typedef float f32x4 __attribute__((ext_vector_type(4)));
typedef short bf16x8 __attribute__((ext_vector_type(8)));
typedef GAS unsigned gu32;
typedef GAS unsigned long long gu64;
#define RLX_AGENT __ATOMIC_RELAXED, __HIP_MEMORY_SCOPE_AGENT
#define LDS_WAIT() asm volatile("s_waitcnt lgkmcnt(0)" ::: "memory")
#define VM_WAIT() asm volatile("s_waitcnt vmcnt(0)" ::: "memory")
__device__ __forceinline__ unsigned long long rt() { return __builtin_amdgcn_s_memrealtime(); }
__device__ __forceinline__ unsigned f2bf(float f) { unsigned u = __builtin_bit_cast(unsigned, f); return (u + 0x7fffu + ((u >> 16) & 1u)) >> 16; }
typedef float pk_f32x2_t __attribute__((ext_vector_type(2))); typedef __bf16 pk_bf16x2_t __attribute__((ext_vector_type(2)));
__device__ __forceinline__ unsigned pk2(float lo, float hi) { pk_f32x2_t v = {lo, hi}; pk_bf16x2_t b = __builtin_convertvector(v, pk_bf16x2_t); return __builtin_bit_cast(unsigned, b); }

#define XB_TMO      128
#define XB_XCNT(j)  (256  + 64 * (j))
#define XB_XSUB(j)  (1280 + 64 * (j))
#define XB_XGEN(j)  (2304 + 64 * (j))
#define XB_TOP      3328
#define XB_TOPGEN   3392
#define XCD_BAR_WORDS 3456
#define XB_SPIN_CAP (1u << 18)

__device__ __forceinline__ unsigned xb_ld(unsigned* p)              { return __hip_atomic_load(p, __ATOMIC_RELAXED, __HIP_MEMORY_SCOPE_AGENT); }
__device__ __forceinline__ unsigned xb_add(unsigned* p, unsigned v) { return __hip_atomic_fetch_add(p, v, __ATOMIC_RELAXED, __HIP_MEMORY_SCOPE_AGENT); }
__device__ __forceinline__ unsigned xb_xcc_id() { return (unsigned)__builtin_amdgcn_s_getreg((3 << 11) | 20) & 0xFu; }
#define XB_SPIN(cond, bar) do { unsigned _sp = 0; while (cond) { __builtin_amdgcn_s_sleep(1); \
    if ((++_sp & 255u) == 0u) { if (xb_ld(&(bar)[XB_TMO])) break; if (_sp > XB_SPIN_CAP) { atomicAdd(&(bar)[XB_TMO], 1u); break; } } } } while (0)

struct XcdBarrier {
    unsigned* bar; unsigned x;
    volatile LAS unsigned* st;
};

__device__ __forceinline__ XcdBarrier xcd_barrier_post(unsigned* bar, volatile LAS unsigned* st) {
    XcdBarrier b; b.bar = bar; b.x = xb_xcc_id(); b.st = st;
    if (threadIdx.x == 0) (void)xb_add(&bar[XB_XCNT(b.x)], 1u);
    return b;
}
__device__ __forceinline__ void xcd_barrier_complete(unsigned* bar, unsigned x, unsigned& nloc, unsigned& nx) {
    const unsigned G = gridDim.x * gridDim.y * gridDim.z;
    unsigned sum, cnt, mine, sp = 0u;
    for (;;) {
        sum = 0u; cnt = 0u; mine = 0u;
#pragma unroll
        for (unsigned j = 0; j < 16; ++j) { const unsigned c = xb_ld(&bar[XB_XCNT(j)]); sum += c; cnt += (c > 0u) ? 1u : 0u; mine = (j == x) ? c : mine; }
        if (sum == G) break;
        __builtin_amdgcn_s_sleep(1);
        if ((++sp & 255u) == 0u) { if (xb_ld(&bar[XB_TMO])) break; if (sp > XB_SPIN_CAP) { atomicAdd(&bar[XB_TMO], 1u); break; } }
    }
    nloc = mine > 0u ? mine : 1u; nx = cnt > 0u ? cnt : 1u;
}

__device__ __forceinline__ void xcd_barrier(const XcdBarrier& b) {
    asm volatile("s_waitcnt vmcnt(0)" ::: "memory");
    __syncthreads();
    if (threadIdx.x == 0) {
        unsigned* bar = b.bar;
        __builtin_amdgcn_s_waitcnt(0);
        unsigned nloc = b.st[0], nx = b.st[1];
        if (nloc == 0u) { xcd_barrier_complete(bar, b.x, nloc, nx); b.st[0] = nloc; b.st[1] = nx; }
        const unsigned old = xb_add(&bar[XB_XSUB(b.x)], 1u);
        const unsigned gen = old / nloc;
        if (old + 1u == (gen + 1u) * nloc) {
            __builtin_amdgcn_fence(__ATOMIC_RELEASE, "agent");
            asm volatile("s_waitcnt vmcnt(0)" ::: "memory");
            const unsigned og = xb_add(&bar[XB_TOP], 1u);
            const unsigned tg = og / nx;
            if (og + 1u == (tg + 1u) * nx) xb_add(&bar[XB_TOPGEN], 1u);
            else XB_SPIN(xb_ld(&bar[XB_TOPGEN]) == tg, bar);
            __builtin_amdgcn_fence(__ATOMIC_ACQUIRE, "agent");
            xb_add(&bar[XB_XGEN(b.x)], 1u);
            asm volatile("s_waitcnt vmcnt(0)" ::: "memory");
        } else {
            XB_SPIN(xb_ld(&bar[XB_XGEN(b.x)]) == gen, bar);
            __builtin_amdgcn_fence(__ATOMIC_ACQUIRE, "agent");
            asm volatile("s_waitcnt vmcnt(0)" ::: "memory");
        }
    }
    __syncthreads();
}
__device__ __forceinline__ float bf2f(bf16 v) { return __builtin_bit_cast(float, (unsigned)v << 16); }
__device__ __forceinline__ float bflo(unsigned w) { return __builtin_bit_cast(float, w << 16); }
__device__ __forceinline__ float bfhi(unsigned w) { return __builtin_bit_cast(float, w & 0xffff0000u); }
__device__ __forceinline__ float silu_f(float v) { return v / (1.f + __expf(-v)); }
__device__ __forceinline__ float wave_sum(float v) {
#pragma unroll
    for (int o = 1; o < 64; o <<= 1) v += __shfl_xor(v, o);
    return v;
}


namespace at2 {
typedef short bf16x8 __attribute__((ext_vector_type(8)));
typedef short s16x4 __attribute__((ext_vector_type(4)));
typedef float f32x16 __attribute__((ext_vector_type(16)));
typedef unsigned u32x4 __attribute__((ext_vector_type(4)));
typedef float f32x2_t __attribute__((ext_vector_type(2))); typedef __bf16 bf16x2_t __attribute__((ext_vector_type(2)));
#define AT_LAS __attribute__((address_space(3)))
__device__ __forceinline__ int crow(int r, int hi) { return (r & 3) + 8 * (r >> 2) + 4 * hi; }
__device__ __forceinline__ void glds16(const void* gsrc, unsigned lds_dst) { unsigned keep;
    asm volatile("s_mov_b32 %0, m0\n\ts_mov_b32 m0, %2\n\ts_nop 0\n\tglobal_load_lds_dwordx4 %1, off\n\ts_mov_b32 m0, %0" : "=&s"(keep) : "v"(gsrc), "s"(lds_dst) : "memory"); }
__device__ __forceinline__ unsigned cvtpk(float lo, float hi) { f32x2_t v = {lo, hi}; bf16x2_t b = __builtin_convertvector(v, bf16x2_t); return __builtin_bit_cast(unsigned, b); }
__device__ __forceinline__ float swap_max(float m) { auto rr = __builtin_amdgcn_permlane32_swap(__float_as_uint(m), __float_as_uint(m), false, false); float r; asm("v_max_f32_e32 %0, %1, %2" : "=v"(r) : "v"(__uint_as_float(rr[0])), "v"(__uint_as_float(rr[1]))); return r; }
__device__ __forceinline__ float swap_sum(float m) { auto rr = __builtin_amdgcn_permlane32_swap(__float_as_uint(m), __float_as_uint(m), false, false); return __uint_as_float(rr[0]) + __uint_as_float(rr[1]); }

__device__ __forceinline__ float max3f(float a, float b, float c) { float r; asm("v_max3_f32 %0, %1, %2, %3" : "=v"(r) : "v"(a), "v"(b), "v"(c)); return r; }
__device__ __forceinline__ float max2f(float a, float b) { float r; asm("v_max_f32_e32 %0, %1, %2" : "=v"(r) : "v"(a), "v"(b)); return r; }
constexpr float NEGM = -1e30f;
constexpr float THR = 8.0f;

struct Tensors { const unsigned short* Q; const unsigned short* K; const unsigned short* V; unsigned short* O; int pq, pk, pv, po; };

__device__ __forceinline__ void pv(f32x16* o, int vb, bf16x8 pa0, bf16x8 pa1, bf16x8 pa2, bf16x8 pa3) {
#pragma unroll
    for (int d0 = 0; d0 < 2; ++d0) { s16x4 lo[4], hi[4];
#pragma unroll
        for (int ks = 0; ks < 4; ++ks) {
            asm volatile("ds_read_b64_tr_b16 %0,%1 offset:%c2" : "=&v"(lo[ks]) : "v"(vb), "i"(d0 * 4096 + ks * 1024) : "memory");
            asm volatile("ds_read_b64_tr_b16 %0,%1 offset:%c2" : "=&v"(hi[ks]) : "v"(vb), "i"(d0 * 4096 + ks * 1024 + 512) : "memory"); }
        asm volatile("s_waitcnt lgkmcnt(0)" ::: "memory"); __builtin_amdgcn_sched_barrier(0);
#define AT_PK(k) (bf16x8){lo[k][0], lo[k][1], lo[k][2], lo[k][3], hi[k][0], hi[k][1], hi[k][2], hi[k][3]}
        o[d0] = __builtin_amdgcn_mfma_f32_32x32x16_bf16(pa0, AT_PK(0), o[d0], 0, 0, 0);
        o[d0] = __builtin_amdgcn_mfma_f32_32x32x16_bf16(pa1, AT_PK(1), o[d0], 0, 0, 0);
        o[d0] = __builtin_amdgcn_mfma_f32_32x32x16_bf16(pa2, AT_PK(2), o[d0], 0, 0, 0);
        o[d0] = __builtin_amdgcn_mfma_f32_32x32x16_bf16(pa3, AT_PK(3), o[d0], 0, 0, 0);
#undef AT_PK
    }
}

typedef short v4i16_t __attribute__((ext_vector_type(4)));
__device__ __forceinline__ s16x4 vtr(const AT_LAS unsigned char* p) { return __builtin_bit_cast(s16x4, __builtin_amdgcn_ds_read_tr16_b64_v4i16((AT_LAS v4i16_t*)p)); }
__device__ __forceinline__ void pv2(f32x16* o, const AT_LAS unsigned char* vp, bf16x8 pa0, bf16x8 pa1, bf16x8 pa2, bf16x8 pa3) {
#pragma unroll
    for (int d0 = 0; d0 < 2; ++d0) { s16x4 lo[4], hi[4];
#pragma unroll
        for (int ks = 0; ks < 4; ++ks) { lo[ks] = vtr(vp + d0 * 4096 + ks * 1024); hi[ks] = vtr(vp + d0 * 4096 + ks * 1024 + 512); }
#define AT_PK(k) (bf16x8){lo[k][0], lo[k][1], lo[k][2], lo[k][3], hi[k][0], hi[k][1], hi[k][2], hi[k][3]}
        o[d0] = __builtin_amdgcn_mfma_f32_32x32x16_bf16(pa0, AT_PK(0), o[d0], 0, 0, 0);
        o[d0] = __builtin_amdgcn_mfma_f32_32x32x16_bf16(pa1, AT_PK(1), o[d0], 0, 0, 0);
        o[d0] = __builtin_amdgcn_mfma_f32_32x32x16_bf16(pa2, AT_PK(2), o[d0], 0, 0, 0);
        o[d0] = __builtin_amdgcn_mfma_f32_32x32x16_bf16(pa3, AT_PK(3), o[d0], 0, 0, 0);
#undef AT_PK
    }
}

template <int DQ, bool MOBA, bool QNORM, int G>
__device__ __forceinline__ void attn_unit(AT_LAS unsigned char* lds, const Tensors& T, long rowbase, int qb, const float* km, const float* qg, const float* tab) {
    constexpr int NKP = DQ / 8, NP = NKP + 8, SLOTB = NKP * 1024 + 8192, ND0 = DQ / 16;
    constexpr int NSLOT = 3 * G, LDS_WS = NSLOT * SLOTB, LDS_OST = 0;
    int tid_ = threadIdx.x; asm volatile("" : "+v"(tid_));
    const int tid = tid_, lane = tid & 63, r32 = lane & 31, hi = lane >> 5; const int wid = __builtin_amdgcn_readfirstlane(tid >> 6);
    const int q0 = qb * 256, NT = 4 * (qb + 1);
    const unsigned lds0 = (unsigned)(size_t)lds;
    AT_LAS float* wsf = (AT_LAS float*)(lds + LDS_WS) + wid * 64;
    asm volatile("s_waitcnt vmcnt(0)" ::: "memory");
    const unsigned short* src[3]; unsigned dsto[3];
#pragma unroll
    for (int k = 0; k < 3; ++k) { const int pi = wid + 8 * k;
        if (pi < NKP) { src[k] = (T.pk == 0) ? T.K + pi * 512 + lane * 8 : T.K + (rowbase + lane) * T.pk + 8 * pi; dsto[k] = pi * 1024; }
        else { const int v = pi - NKP; src[k] = (T.pv == 0) ? T.V + v * 512 + lane * 8 : T.V + (rowbase + 16 * (v & 3) + (lane >> 2)) * T.pv + 32 * (v >> 2) + 8 * (lane & 3); dsto[k] = NKP * 1024 + v * 1024; } }
    const long kstep = (T.pk == 0) ? (long)NKP * 512 : (long)64 * T.pk, vstep = (T.pv == 0) ? (long)4096 : (long)64 * T.pv;
#define AT_DMA(t, slot) do { _Pragma("unroll") for (int k_ = 0; k_ < 3; ++k_) { const int pi_ = wid + 8 * k_; if (pi_ < NP) { \
        const unsigned short* s_ = src[k_] + (long)(t) * ((pi_ < NKP) ? kstep : vstep); glds16(s_, (unsigned)__builtin_amdgcn_readfirstlane(lds0 + (slot) * SLOTB + dsto[k_])); } } } while (0)
    _Pragma("unroll") for (int i_ = 0; i_ < G; ++i_) AT_DMA(i_, i_);
    __builtin_amdgcn_sched_barrier(0);
    bf16x8 qr[ND0];
    { const unsigned short* Qw = T.Q + (rowbase + q0 + wid * 32 + r32) * T.pq + hi * 8;
#pragma unroll
      for (int d0 = 0; d0 < ND0; ++d0) qr[d0] = *(const bf16x8*)(Qw + d0 * 16); }
    __builtin_amdgcn_sched_barrier(0);
    if constexpr (QNORM) {
        float s = 0.f;
#pragma unroll
        for (int d0 = 0; d0 < ND0; ++d0)
#pragma unroll
            for (int j = 0; j < 8; ++j) { const float x = bf2f((unsigned short)qr[d0][j]); s += x * x; }
        s = swap_sum(s);
        const float rstd = 0.14724445073472677f / sqrtf(s * (1.f / 96.f) + 1e-6f);
#pragma unroll
        for (int d0 = 0; d0 < 4; ++d0) { const f32x4 g0 = *(const f32x4*)(qg + d0 * 16 + hi * 8), g1 = *(const f32x4*)(qg + d0 * 16 + hi * 8 + 4); u32x4 w;
            w.x = cvtpk(bf2f((unsigned short)qr[d0][0]) * rstd * g0.x, bf2f((unsigned short)qr[d0][1]) * rstd * g0.y); w.y = cvtpk(bf2f((unsigned short)qr[d0][2]) * rstd * g0.z, bf2f((unsigned short)qr[d0][3]) * rstd * g0.w);
            w.z = cvtpk(bf2f((unsigned short)qr[d0][4]) * rstd * g1.x, bf2f((unsigned short)qr[d0][5]) * rstd * g1.y); w.w = cvtpk(bf2f((unsigned short)qr[d0][6]) * rstd * g1.z, bf2f((unsigned short)qr[d0][7]) * rstd * g1.w);
            qr[d0] = __builtin_bit_cast(bf16x8, w); asm volatile("" : "+v"(qr[d0])); }
        { const int pos = q0 + wid * 32 + r32; const float* tb = tab + (pos * 16 + hi * 8) * 2; const float* ga = qg + 64 + hi * 8; const float* gb = qg + 80 + hi * 8; float oa[8], ob[8];
#pragma unroll
          for (int j = 0; j < 8; ++j) { const float x1 = bf2f((unsigned short)qr[4][j]) * rstd * ga[j], x2 = bf2f((unsigned short)qr[5][j]) * rstd * gb[j]; const float c = tb[2 * j], sn = tb[2 * j + 1]; oa[j] = x1 * c - x2 * sn; ob[j] = x1 * sn + x2 * c; }
          u32x4 w; w.x = cvtpk(oa[0], oa[1]); w.y = cvtpk(oa[2], oa[3]); w.z = cvtpk(oa[4], oa[5]); w.w = cvtpk(oa[6], oa[7]); qr[4] = __builtin_bit_cast(bf16x8, w);
          w.x = cvtpk(ob[0], ob[1]); w.y = cvtpk(ob[2], ob[3]); w.z = cvtpk(ob[4], ob[5]); w.w = cvtpk(ob[6], ob[7]); qr[5] = __builtin_bit_cast(bf16x8, w); }
    }
    __builtin_amdgcn_sched_barrier(0);
    unsigned sel = 0xffffffffu;
    if (MOBA) {
        sel = 0u; float gate[8];
#pragma unroll
        for (int j = 0; j < 7; ++j) { float a = 0.f;
            if (j < qb) { const float* kj = km + j * 512 + hi * 8;
#pragma unroll
                for (int d0 = 0; d0 < ND0; ++d0) { const f32x4 k0 = *(const f32x4*)(kj + d0 * 16), k1 = *(const f32x4*)(kj + d0 * 16 + 4);
                    a += bf2f((unsigned short)qr[d0][0]) * k0.x + bf2f((unsigned short)qr[d0][1]) * k0.y + bf2f((unsigned short)qr[d0][2]) * k0.z + bf2f((unsigned short)qr[d0][3]) * k0.w
                       + bf2f((unsigned short)qr[d0][4]) * k1.x + bf2f((unsigned short)qr[d0][5]) * k1.y + bf2f((unsigned short)qr[d0][6]) * k1.z + bf2f((unsigned short)qr[d0][7]) * k1.w; } }
            a = swap_sum(a); gate[j] = (j < qb) ? a : -INFINITY; }
        gate[7] = -INFINITY;
#pragma unroll
        for (int r = 0; r < 3; ++r) { int best = -1; float bv = -INFINITY;
#pragma unroll
            for (int j = 0; j < 8; ++j) if (!((sel >> j) & 1u) && gate[j] > bv) { bv = gate[j]; best = j; }
            if (best >= 0) sel |= 1u << best; }
    }
    __builtin_amdgcn_sched_barrier(0);
    float mhat = 0.f, l = 0.f; f32x16 o[2]; o[0] = f32x16{}; o[1] = f32x16{};
    const int qrel = wid * 32 + r32;
    const int vbl = ((lane >> 4) & 1) * 32 + (lane & 3) * 8 + (4 * hi + ((lane & 15) >> 2)) * 64;
#define AT_GROUP(u) do { asm volatile("s_waitcnt vmcnt(0) lgkmcnt(0)\n\ts_barrier" ::: "memory"); \
        if ((u) + G < NT) { _Pragma("unroll") for (int i_ = 0; i_ < G; ++i_) { const int tt_ = (u) + G + i_; AT_DMA(tt_, tt_ % NSLOT); } } } while (0)
#define AT_KLOAD(sl) do { const AT_LAS unsigned char* kb = lds + (sl) * SLOTB + hi * 1024 + r32 * 16; \
        _Pragma("unroll") for (int d0 = 0; d0 < ND0; ++d0) { kf[2 * d0] = *(const AT_LAS bf16x8*)(kb + d0 * 2048); kf[2 * d0 + 1] = *(const AT_LAS bf16x8*)(kb + d0 * 2048 + 512); } } while (0)
    bf16x8 kf[2 * ND0]; s16x4 vlo[8], vhi[8];
    AT_GROUP(0);
    AT_KLOAD(0);
    int slot = 0;
    for (int t = 0; t < NT; ++t) {
        __builtin_amdgcn_sched_barrier(0);
        { const AT_LAS unsigned char* vp = lds + slot * SLOTB + NKP * 1024 + vbl;
#pragma unroll
          for (int i = 0; i < 8; ++i) { vlo[i] = vtr(vp + (i >> 2) * 4096 + (i & 3) * 1024); vhi[i] = vtr(vp + (i >> 2) * 4096 + (i & 3) * 1024 + 512); } }
        __builtin_amdgcn_sched_barrier(0);
        f32x16 p0, p1;
#pragma unroll
        for (int d0 = 0; d0 < ND0; ++d0) {
            if (d0 == 0) { p0 = __builtin_amdgcn_mfma_f32_32x32x16_bf16(kf[0], qr[0], f32x16{}, 0, 0, 0); p1 = __builtin_amdgcn_mfma_f32_32x32x16_bf16(kf[1], qr[0], f32x16{}, 0, 0, 0); }
            else { p0 = __builtin_amdgcn_mfma_f32_32x32x16_bf16(kf[2 * d0], qr[d0], p0, 0, 0, 0); p1 = __builtin_amdgcn_mfma_f32_32x32x16_bf16(kf[2 * d0 + 1], qr[d0], p1, 0, 0, 0); } }
        __builtin_amdgcn_sched_barrier(0);
        const int nslot = (slot == NSLOT - 1) ? 0 : slot + 1;
        if (t + 1 < NT) { if (((t + 1) % G) == 0) AT_GROUP(t + 1); AT_KLOAD(nslot); }
        __builtin_amdgcn_sched_barrier(0);
        const int jb = t - (NT - 4);
        if (jb >= 0) { const int kb0 = 64 * jb + 4 * hi;
#pragma unroll
            for (int r = 0; r < 16; ++r) { const int kv = kb0 + (r & 3) + 8 * (r >> 2); if (kv > qrel) p0[r] = NEGM; if (kv + 32 > qrel) p1[r] = NEGM; } }
        else if (MOBA) { const bool keep = ((sel >> (t >> 2)) & 1u) != 0u;
            if (!__all(keep)) { if (!keep) {
#pragma unroll
                for (int r = 0; r < 16; ++r) { p0[r] = NEGM; p1[r] = NEGM; } } } }
        float rm;
        { float a_ = fmaxf(fmaxf(p0[0], p0[1]), p1[0]), b_ = fmaxf(fmaxf(p0[2], p0[3]), p1[1]); a_ = fmaxf(fmaxf(a_, p1[2]), p1[3]);
#pragma unroll
          for (int r = 4; r < 16; r += 4) { a_ = fmaxf(fmaxf(a_, p0[r]), p0[r + 1]); b_ = fmaxf(fmaxf(b_, p0[r + 2]), p0[r + 3]); a_ = fmaxf(fmaxf(a_, p1[r]), p1[r + 1]); b_ = fmaxf(fmaxf(b_, p1[r + 2]), p1[r + 3]); }
          rm = swap_max(fmaxf(a_, b_)) - mhat; }
        if (__any(rm > THR)) {
            const float dl = fmaxf(rm, 0.f); mhat += dl;
            const float alpha = __builtin_amdgcn_exp2f(-dl); l *= alpha;
            if (hi == 0) wsf[r32] = alpha;
            asm volatile("s_waitcnt lgkmcnt(0)" ::: "memory");
#pragma unroll
            for (int r = 0; r < 16; ++r) { const float f = wsf[crow(r, hi)]; o[0][r] *= f; o[1][r] *= f; }
        }
        float sacc = 0.f;
#pragma unroll
        for (int r = 0; r < 16; ++r) { p0[r] = __builtin_amdgcn_exp2f(p0[r] - mhat); p1[r] = __builtin_amdgcn_exp2f(p1[r] - mhat); sacc += p0[r] + p1[r]; }
        l += sacc;
        u32x4 pw[4];
        pw[0] = (u32x4){cvtpk(p0[0], p0[1]), cvtpk(p0[2], p0[3]), cvtpk(p0[4], p0[5]), cvtpk(p0[6], p0[7])};
        pw[1] = (u32x4){cvtpk(p0[8], p0[9]), cvtpk(p0[10], p0[11]), cvtpk(p0[12], p0[13]), cvtpk(p0[14], p0[15])};
        pw[2] = (u32x4){cvtpk(p1[0], p1[1]), cvtpk(p1[2], p1[3]), cvtpk(p1[4], p1[5]), cvtpk(p1[6], p1[7])};
        pw[3] = (u32x4){cvtpk(p1[8], p1[9]), cvtpk(p1[10], p1[11]), cvtpk(p1[12], p1[13]), cvtpk(p1[14], p1[15])};
        __builtin_amdgcn_sched_barrier(0);
#pragma unroll
        for (int d0 = 0; d0 < 2; ++d0)
#pragma unroll
            for (int ks = 0; ks < 4; ++ks) { const int i = d0 * 4 + ks;
                o[d0] = __builtin_amdgcn_mfma_f32_32x32x16_bf16(__builtin_bit_cast(bf16x8, pw[ks]), (bf16x8){vlo[i][0], vlo[i][1], vlo[i][2], vlo[i][3], vhi[i][0], vhi[i][1], vhi[i][2], vhi[i][3]}, o[d0], 0, 0, 0); }
        slot = nslot;
    }
#undef AT_GROUP
#undef AT_KLOAD
#undef AT_DMA
    asm volatile("s_waitcnt lgkmcnt(0)\n\ts_barrier" ::: "memory");
    l = swap_sum(l);
    if (hi == 0) wsf[32 + r32] = l;
    asm volatile("s_waitcnt lgkmcnt(0)" ::: "memory");
    float rli[16];
#pragma unroll
    for (int r = 0; r < 16; ++r) rli[r] = __builtin_amdgcn_rcpf(wsf[32 + crow(r, hi)]);
    unsigned short* Ow = T.O + (rowbase + q0 + wid * 32) * T.po;
    { AT_LAS unsigned short* stg = (AT_LAS unsigned short*)(lds + LDS_OST) + wid * 2048;
#pragma unroll
      for (int r = 0; r < 16; ++r) { const int orow = crow(r, hi);
#pragma unroll
          for (int d0 = 0; d0 < 2; ++d0) stg[orow * 64 + d0 * 32 + r32] = (unsigned short)f2bf(o[d0][r] * rli[r]); }
      asm volatile("s_waitcnt lgkmcnt(0)" ::: "memory");
#pragma unroll
      for (int i = 0; i < 4; ++i) { const int row = i * 8 + (lane >> 3), ch = lane & 7; const u32x4 v = *(const AT_LAS u32x4*)(stg + row * 64 + ch * 8); *(u32x4*)(Ow + (long)row * T.po + ch * 8) = v; } }
    asm volatile("s_waitcnt lgkmcnt(0)\n\ts_barrier" ::: "memory");
}
template <int DQ, bool MOBA, bool QNORM, int G>
__device__ __forceinline__ void attn_unit_p(AT_LAS unsigned char* lds, const Tensors& T, long rowbase, int qb, const float* km, const float* qg, const float* tab, float kbound, int tbase, bool prefetched, bool has_next) {
    constexpr int NKP = DQ / 8, NP = NKP + 8, SLOTB = NKP * 1024 + 8192, ND0 = DQ / 16;
    constexpr int NSLOT = 3 * G, LDS_WS = NSLOT * SLOTB, LDS_OST = LDS_WS + 2048;
    int tid_ = threadIdx.x; asm volatile("" : "+v"(tid_));
    const int tid = tid_, lane = tid & 63, r32 = lane & 31, hi = lane >> 5; const int wid = __builtin_amdgcn_readfirstlane(tid >> 6);
    const int q0 = qb * 256, NT = 4 * (qb + 1);
    const unsigned lds0 = (unsigned)(size_t)lds;
    AT_LAS float* wsf = (AT_LAS float*)(lds + LDS_WS) + wid * 64;
    asm volatile("s_waitcnt vmcnt(0)" ::: "memory");
    unsigned soff[3], dsto[3];
#pragma unroll
    for (int k = 0; k < 3; ++k) { const int pi = wid + 8 * k;
        if (pi < NKP) { soff[k] = (T.pk == 0) ? (unsigned)(pi * 512 + lane * 8) : (unsigned)((rowbase + lane) * T.pk + 8 * pi); dsto[k] = pi * 1024; }
        else { const int v = pi - NKP; soff[k] = (T.pv == 0) ? (unsigned)(v * 512 + lane * 8) : (unsigned)((rowbase + 16 * (v & 3) + (lane >> 2)) * T.pv + 32 * (v >> 2) + 8 * (lane & 3)); dsto[k] = NKP * 1024 + v * 1024; } }
    const unsigned kstep = (T.pk == 0) ? (unsigned)NKP * 512u : 64u * (unsigned)T.pk, vstep = (T.pv == 0) ? 4096u : 64u * (unsigned)T.pv;
#define AT_DMA(t, slot) do { _Pragma("unroll") for (int k_ = 0; k_ < 3; ++k_) { const int pi_ = wid + 8 * k_; if (pi_ < NP) { \
        const unsigned short* s_ = ((pi_ < NKP) ? T.K : T.V) + (size_t)(soff[k_] + (unsigned)(t) * ((pi_ < NKP) ? kstep : vstep)); glds16(s_, (unsigned)__builtin_amdgcn_readfirstlane(lds0 + (slot) * SLOTB + dsto[k_])); } } } while (0)
    if (!prefetched) { _Pragma("unroll") for (int i_ = 0; i_ < G; ++i_) AT_DMA(i_, (tbase + i_) % NSLOT); }
    __builtin_amdgcn_sched_barrier(0);
    bf16x8 qr[ND0];
    { const unsigned short* Qw = T.Q + (rowbase + q0 + wid * 32 + r32) * T.pq + hi * 8;
#pragma unroll
      for (int d0 = 0; d0 < ND0; ++d0) qr[d0] = *(const bf16x8*)(Qw + d0 * 16); }
    __builtin_amdgcn_sched_barrier(0);
    if constexpr (QNORM) {
        float s = 0.f;
#pragma unroll
        for (int d0 = 0; d0 < ND0; ++d0)
#pragma unroll
            for (int j = 0; j < 8; ++j) { const float x = bf2f((unsigned short)qr[d0][j]); s += x * x; }
        s = swap_sum(s);
        const float rstd = 0.14724445073472677f / sqrtf(s * (1.f / 96.f) + 1e-6f);
#pragma unroll
        for (int d0 = 0; d0 < 4; ++d0) { const f32x4 g0 = *(const f32x4*)(qg + d0 * 16 + hi * 8), g1 = *(const f32x4*)(qg + d0 * 16 + hi * 8 + 4); u32x4 w;
            w.x = cvtpk(bf2f((unsigned short)qr[d0][0]) * rstd * g0.x, bf2f((unsigned short)qr[d0][1]) * rstd * g0.y); w.y = cvtpk(bf2f((unsigned short)qr[d0][2]) * rstd * g0.z, bf2f((unsigned short)qr[d0][3]) * rstd * g0.w);
            w.z = cvtpk(bf2f((unsigned short)qr[d0][4]) * rstd * g1.x, bf2f((unsigned short)qr[d0][5]) * rstd * g1.y); w.w = cvtpk(bf2f((unsigned short)qr[d0][6]) * rstd * g1.z, bf2f((unsigned short)qr[d0][7]) * rstd * g1.w);
            qr[d0] = __builtin_bit_cast(bf16x8, w); asm volatile("" : "+v"(qr[d0])); }
        { const int pos = q0 + wid * 32 + r32; const float* tb = tab + (pos * 16 + hi * 8) * 2; const float* ga = qg + 64 + hi * 8; const float* gb = qg + 80 + hi * 8; float oa[8], ob[8];
#pragma unroll
          for (int j = 0; j < 8; ++j) { const float x1 = bf2f((unsigned short)qr[4][j]) * rstd * ga[j], x2 = bf2f((unsigned short)qr[5][j]) * rstd * gb[j]; const float c = tb[2 * j], sn = tb[2 * j + 1]; oa[j] = x1 * c - x2 * sn; ob[j] = x1 * sn + x2 * c; }
          u32x4 w; w.x = cvtpk(oa[0], oa[1]); w.y = cvtpk(oa[2], oa[3]); w.z = cvtpk(oa[4], oa[5]); w.w = cvtpk(oa[6], oa[7]); qr[4] = __builtin_bit_cast(bf16x8, w);
          w.x = cvtpk(ob[0], ob[1]); w.y = cvtpk(ob[2], ob[3]); w.z = cvtpk(ob[4], ob[5]); w.w = cvtpk(ob[6], ob[7]); qr[5] = __builtin_bit_cast(bf16x8, w); }
    }
    __builtin_amdgcn_sched_barrier(0);
    unsigned sel = 0xffffffffu;
    if (MOBA) {
        sel = 0u; float gate[8];
#pragma unroll
        for (int j = 0; j < 7; ++j) { float a = 0.f;
            if (j < qb) { const float* kj = km + j * 512 + hi * 8;
#pragma unroll
                for (int d0 = 0; d0 < ND0; ++d0) { const f32x4 k0 = *(const f32x4*)(kj + d0 * 16), k1 = *(const f32x4*)(kj + d0 * 16 + 4);
                    a += bf2f((unsigned short)qr[d0][0]) * k0.x + bf2f((unsigned short)qr[d0][1]) * k0.y + bf2f((unsigned short)qr[d0][2]) * k0.z + bf2f((unsigned short)qr[d0][3]) * k0.w
                       + bf2f((unsigned short)qr[d0][4]) * k1.x + bf2f((unsigned short)qr[d0][5]) * k1.y + bf2f((unsigned short)qr[d0][6]) * k1.z + bf2f((unsigned short)qr[d0][7]) * k1.w; } }
            a = swap_sum(a); gate[j] = (j < qb) ? a : -INFINITY; }
        gate[7] = -INFINITY;
#pragma unroll
        for (int r = 0; r < 3; ++r) { int best = -1; float bv = -INFINITY;
#pragma unroll
            for (int j = 0; j < 8; ++j) if (!((sel >> j) & 1u) && gate[j] > bv) { bv = gate[j]; best = j; }
            if (best >= 0) sel |= 1u << best; }
    }
    __builtin_amdgcn_sched_barrier(0);
    float l = 0.f; f32x16 o[2]; o[0] = f32x16{}; o[1] = f32x16{};
    f32x16 negm;
    { float qss = 0.f;
#pragma unroll
      for (int d0 = 0; d0 < ND0; ++d0)
#pragma unroll
          for (int j = 0; j < 8; ++j) { const float x = bf2f((unsigned short)qr[d0][j]); qss += x * x; }
      qss = swap_sum(qss); const float mrow = sqrtf(qss) * kbound;
#pragma unroll
      for (int r = 0; r < 16; ++r) negm[r] = -mrow;
      asm volatile("" : "+v"(negm)); }

    const int qrel = wid * 32 + r32;
    const int vbl = ((lane >> 4) & 1) * 32 + (lane & 3) * 8 + (4 * hi + ((lane & 15) >> 2)) * 64;
#define AT_GROUP(u) do { asm volatile("s_waitcnt vmcnt(0) lgkmcnt(0)\n\ts_barrier" ::: "memory"); \
        if ((u) + G < NT) { _Pragma("unroll") for (int i_ = 0; i_ < G; ++i_) { const int tt_ = (u) + G + i_; AT_DMA(tt_, (tbase + tt_) % NSLOT); } } \
        else if (has_next) { _Pragma("unroll") for (int i_ = 0; i_ < G; ++i_) AT_DMA(i_, (tbase + NT + i_) % NSLOT); } } while (0)
#define AT_KLOAD(sl) do { const AT_LAS unsigned char* kb = lds + (sl) * SLOTB + hi * 1024 + r32 * 16; \
        _Pragma("unroll") for (int d0 = 0; d0 < ND0; ++d0) { kf[2 * d0] = *(const AT_LAS bf16x8*)(kb + d0 * 2048); kf[2 * d0 + 1] = *(const AT_LAS bf16x8*)(kb + d0 * 2048 + 512); } } while (0)
#define AT_VLOAD(sl) do { const AT_LAS unsigned char* vp = lds + (sl) * SLOTB + NKP * 1024 + vbl; \
        _Pragma("unroll") for (int i = 0; i < 8; ++i) { vlo[i] = vtr(vp + (i >> 2) * 4096 + (i & 3) * 1024); vhi[i] = vtr(vp + (i >> 2) * 4096 + (i & 3) * 1024 + 512); } } while (0)
#define AT_SUMPACK() do { float sacc = 0.f; \
        _Pragma("unroll") for (int r = 0; r < 16; ++r) sacc += c0[r] + c1[r]; \
        l += sacc; \
        pw[0] = (u32x4){cvtpk(c0[0], c0[1]), cvtpk(c0[2], c0[3]), cvtpk(c0[4], c0[5]), cvtpk(c0[6], c0[7])}; \
        pw[1] = (u32x4){cvtpk(c0[8], c0[9]), cvtpk(c0[10], c0[11]), cvtpk(c0[12], c0[13]), cvtpk(c0[14], c0[15])}; \
        pw[2] = (u32x4){cvtpk(c1[0], c1[1]), cvtpk(c1[2], c1[3]), cvtpk(c1[4], c1[5]), cvtpk(c1[6], c1[7])}; \
        pw[3] = (u32x4){cvtpk(c1[8], c1[9]), cvtpk(c1[10], c1[11]), cvtpk(c1[12], c1[13]), cvtpk(c1[14], c1[15])}; } while (0)
#define AT_QKT(N0, N1) do { _Pragma("unroll") for (int d0 = 0; d0 < ND0; ++d0) { \
            if (d0 == 0) { N0 = __builtin_amdgcn_mfma_f32_32x32x16_bf16(kf[0], qr[0], negm, 0, 0, 0); N1 = __builtin_amdgcn_mfma_f32_32x32x16_bf16(kf[1], qr[0], negm, 0, 0, 0); } \
            else { N0 = __builtin_amdgcn_mfma_f32_32x32x16_bf16(kf[2 * d0], qr[d0], N0, 0, 0, 0); N1 = __builtin_amdgcn_mfma_f32_32x32x16_bf16(kf[2 * d0 + 1], qr[d0], N1, 0, 0, 0); } } } while (0)
#define AT_DECIDE(tt) do { \
        { const int jb = (tt) - (NT - 4); \
          if (jb >= 0) { const int kb0 = 64 * jb + 4 * hi; \
              _Pragma("unroll") for (int r = 0; r < 16; ++r) { const int kv = kb0 + (r & 3) + 8 * (r >> 2); if (kv > qrel) c0[r] = NEGM; if (kv + 32 > qrel) c1[r] = NEGM; } } \
          else if (MOBA) { const bool keep = ((sel >> ((tt) >> 2)) & 1u) != 0u; \
              if (!__all(keep)) { if (!keep) { _Pragma("unroll") for (int r = 0; r < 16; ++r) { c0[r] = NEGM; c1[r] = NEGM; } } } } } \
        if ((tt) + 1 < NT && (((tt) + 1) % G) == 0) AT_GROUP((tt) + 1); } while (0)
#define AT_EXPS() do { _Pragma("unroll") for (int r = 0; r < 16; ++r) { c0[r] = __builtin_amdgcn_exp2f(c0[r]); c1[r] = __builtin_amdgcn_exp2f(c1[r]); } } while (0)
#define AT_PV() do { _Pragma("unroll") for (int d0 = 0; d0 < 2; ++d0) _Pragma("unroll") for (int ks = 0; ks < 4; ++ks) { const int i = d0 * 4 + ks; \
            o[d0] = __builtin_amdgcn_mfma_f32_32x32x16_bf16(__builtin_bit_cast(bf16x8, pw[ks]), (bf16x8){vlo[i][0], vlo[i][1], vlo[i][2], vlo[i][3], vhi[i][0], vhi[i][1], vhi[i][2], vhi[i][3]}, o[d0], 0, 0, 0); } } while (0)
#define AT_SGB(mask, n) __builtin_amdgcn_sched_group_barrier(mask, n, 0)
    constexpr int NG = 2 * ND0;
    bf16x8 kf[2 * ND0]; s16x4 vlo[8], vhi[8]; u32x4 pw[4]; f32x16 c0, c1;
    AT_GROUP(0);
    AT_KLOAD(tbase % NSLOT);
    AT_QKT(c0, c1);
    AT_DECIDE(0);
    AT_KLOAD((tbase + 1) % NSLOT);
    AT_EXPS();
    int slot = (tbase + 1) % NSLOT, pslot = tbase % NSLOT;
    for (int t = 1; t < NT; ++t) {
        const int nslot = (t + 1 < NT) ? ((slot == NSLOT - 1) ? 0 : slot + 1) : slot;
        __builtin_amdgcn_sched_barrier(0);
        { f32x16 n0, n1; float sacc = 0.f;
          const AT_LAS unsigned char* vp = lds + pslot * SLOTB + NKP * 1024 + vbl;
#pragma unroll
          for (int i = 0; i < NG; ++i) {
              if (i >= NG - 2) { const int vi = i - (NG - 2); vlo[vi] = vtr(vp + (vi >> 2) * 4096 + (vi & 3) * 1024); vhi[vi] = vtr(vp + (vi >> 2) * 4096 + (vi & 3) * 1024 + 512); }
              const int d0 = i >> 1;
              if (i & 1) n1 = (d0 == 0) ? __builtin_amdgcn_mfma_f32_32x32x16_bf16(kf[i], qr[d0], negm, 0, 0, 0) : __builtin_amdgcn_mfma_f32_32x32x16_bf16(kf[i], qr[d0], n1, 0, 0, 0);
              else n0 = (d0 == 0) ? __builtin_amdgcn_mfma_f32_32x32x16_bf16(kf[i], qr[d0], negm, 0, 0, 0) : __builtin_amdgcn_mfma_f32_32x32x16_bf16(kf[i], qr[d0], n0, 0, 0, 0);
#pragma unroll
              for (int rr = (i * 32) / NG; rr < ((i + 1) * 32) / NG; ++rr) sacc += (rr < 16) ? c0[rr] : c1[rr - 16];
#pragma unroll
              for (int ww = (i * 16) / NG; ww < ((i + 1) * 16) / NG; ++ww) { const int e = 2 * ww; pw[ww >> 2][ww & 3] = (e < 16) ? cvtpk(c0[e], c0[e + 1]) : cvtpk(c1[e - 16], c1[e - 15]); }
              __builtin_amdgcn_sched_barrier(0); }
          l += sacc; c0 = n0; c1 = n1; }
        AT_DECIDE(t);
        __builtin_amdgcn_sched_barrier(0);
        { const AT_LAS unsigned char* kb = lds + nslot * SLOTB + hi * 1024 + r32 * 16; const AT_LAS unsigned char* vpB = lds + pslot * SLOTB + NKP * 1024 + vbl;
#pragma unroll
          for (int i = 0; i < 8; ++i) {
              if (i + 2 < 8) { const int vi = i + 2; vlo[vi] = vtr(vpB + (vi >> 2) * 4096 + (vi & 3) * 1024); vhi[vi] = vtr(vpB + (vi >> 2) * 4096 + (vi & 3) * 1024 + 512); }
              if (i >= 2 && i < 6) {
#pragma unroll
                  for (int q = (i - 2) * NG / 4; q < (i - 1) * NG / 4; ++q) kf[q] = *(const AT_LAS bf16x8*)(kb + (q >> 1) * 2048 + (q & 1) * 512); }
              o[i >> 2] = __builtin_amdgcn_mfma_f32_32x32x16_bf16(__builtin_bit_cast(bf16x8, pw[i & 3]), (bf16x8){vlo[i][0], vlo[i][1], vlo[i][2], vlo[i][3], vhi[i][0], vhi[i][1], vhi[i][2], vhi[i][3]}, o[i >> 2], 0, 0, 0);
#pragma unroll
              for (int rr = 4 * i; rr < 4 * i + 4; ++rr) { if (rr < 16) c0[rr] = __builtin_amdgcn_exp2f(c0[rr]); else c1[rr - 16] = __builtin_amdgcn_exp2f(c1[rr - 16]); }
              __builtin_amdgcn_sched_barrier(0); } }
        pslot = slot; slot = nslot;
    }
    AT_VLOAD(pslot);
    AT_SUMPACK();
    AT_PV();
#undef AT_GROUP
#undef AT_KLOAD
#undef AT_VLOAD
#undef AT_SUMPACK
#undef AT_QKT
#undef AT_DECIDE
#undef AT_EXPS
#undef AT_PV
#undef AT_SGB
#undef AT_DMA
    asm volatile("s_waitcnt lgkmcnt(0)\n\ts_barrier" ::: "memory");
    l = swap_sum(l);
    if (hi == 0) wsf[32 + r32] = l;
    asm volatile("s_waitcnt lgkmcnt(0)" ::: "memory");
    float rli[16];
#pragma unroll
    for (int r = 0; r < 16; ++r) rli[r] = __builtin_amdgcn_rcpf(wsf[32 + crow(r, hi)]);
    unsigned short* Ow = T.O + (rowbase + q0 + wid * 32) * T.po;
    { AT_LAS unsigned short* stg = (AT_LAS unsigned short*)(lds + LDS_OST) + wid * 2048;
#pragma unroll
      for (int r = 0; r < 16; ++r) { const int orow = crow(r, hi);
#pragma unroll
          for (int d0 = 0; d0 < 2; ++d0) stg[orow * 64 + d0 * 32 + r32] = (unsigned short)f2bf(o[d0][r] * rli[r]); }
      asm volatile("s_waitcnt lgkmcnt(0)" ::: "memory");
#pragma unroll
      for (int i = 0; i < 4; ++i) { const int row = i * 8 + (lane >> 3), ch = lane & 7; const u32x4 v = *(const AT_LAS u32x4*)(stg + row * 64 + ch * 8); *(u32x4*)(Ow + (long)row * T.po + ch * 8) = v; } }
    asm volatile("s_waitcnt lgkmcnt(0)\n\ts_barrier" ::: "memory");
}
#undef AT_LAS
}

namespace ssd {
typedef short bf16x8 __attribute__((ext_vector_type(8)));
typedef short v4i16_t __attribute__((ext_vector_type(4)));
typedef float f32x16 __attribute__((ext_vector_type(16)));
typedef unsigned u32x4 __attribute__((ext_vector_type(4)));
#define SS_LAS __attribute__((address_space(3)))
__device__ __forceinline__ int crow(int r, int hi) { return (r & 3) + 8 * (r >> 2) + 4 * hi; }
__device__ __forceinline__ v4i16_t vtr(const SS_LAS unsigned char* p) { return __builtin_amdgcn_ds_read_tr16_b64_v4i16((SS_LAS v4i16_t*)p); }
__device__ __forceinline__ bf16x8 tr_frag(const SS_LAS unsigned char* img, int pitch, int k0, int c0, int lane) {
    const int g4 = lane >> 4, q = (lane & 15) >> 2, p4 = lane & 3;
    const SS_LAS unsigned char* a = img + (k0 + 8 * (g4 >> 1) + q) * pitch + (c0 + 16 * (g4 & 1) + 4 * p4) * 2;
    const v4i16_t lo = vtr(a), hi4 = vtr(a + 4 * pitch);
    return (bf16x8){lo[0], lo[1], lo[2], lo[3], hi4[0], hi4[1], hi4[2], hi4[3]};
}
__device__ __forceinline__ bf16x8 row_frag(const SS_LAS unsigned char* img, int pitch, int r0, int k0, int lane) {
    return *(const SS_LAS bf16x8*)(img + (r0 + (lane & 31)) * pitch + (k0 + 8 * (lane >> 5)) * 2);
}

constexpr int PX4 = 576;
constexpr int PB_T = 320;
constexpr int PR = 272;
constexpr int PX1 = 192;

__device__ __forceinline__ void dt_cs(int t0, int g, const float* DTR, const float* dtb, const float* alog, SS_LAS float* csl, SS_LAS float* dtl, SS_LAS float* wtot, int tid, int lane, int wid) {
    const int l = tid >> 2, hh = tid & 3, h = 4 * g + hh;
    const float r = DTR[(size_t)(t0 + l) * 8 + h] + dtb[h]; const float ex = __expf(fminf(r, 20.f)); const float dt = (r > 20.f) ? r : ((ex < 0.01f) ? ex * (1.f - ex * (0.5f - ex * 0.33333333f)) : __logf(1.f + ex));
    float v = dt * (-expf(alog[h]));
#pragma unroll
    for (int off = 4; off < 64; off <<= 1) { const float t = __shfl_up(v, off); if (lane >= off) v += t; }
    if (lane >= 60) wtot[wid * 4 + hh] = v;
    __syncthreads();
    float base = 0.f;
    for (int w = 0; w < wid; ++w) base += wtot[w * 4 + hh];
    csl[tid] = v + base; dtl[tid] = dt;
    __syncthreads();
}
__device__ __forceinline__ void conv_load(u32x4 (&x)[19], const unsigned short* raw, int t0, int l0, int col) {
    const int pos0 = t0 & 2047;
#pragma unroll
    for (int i = 0; i < 19; ++i) { const int l = l0 - 3 + i; x[i] = (u32x4){0u, 0u, 0u, 0u}; if (pos0 + l >= 0) x[i] = *(const u32x4*)(raw + (size_t)(t0 + l) * 1024 + col); }
}
template <bool SCALED> __device__ __forceinline__ void conv_compute(const u32x4 (&x)[19], int l0, int col, const float* cw, const float* cb, SS_LAS unsigned char* img, int pitch, const SS_LAS float* sc) {
    float w[4][8], b[8];
#pragma unroll
    for (int k = 0; k < 4; ++k) { const f32x4 a = *(const f32x4*)(cw + k * 1024 + col), c = *(const f32x4*)(cw + k * 1024 + col + 4); w[k][0] = a.x; w[k][1] = a.y; w[k][2] = a.z; w[k][3] = a.w; w[k][4] = c.x; w[k][5] = c.y; w[k][6] = c.z; w[k][7] = c.w; }
    { const f32x4 a = *(const f32x4*)(cb + col), c = *(const f32x4*)(cb + col + 4); b[0] = a.x; b[1] = a.y; b[2] = a.z; b[3] = a.w; b[4] = c.x; b[5] = c.y; b[6] = c.z; b[7] = c.w; }
#pragma unroll
    for (int i = 0; i < 16; ++i) { const int l = l0 + i; float o[8]; const float s = SCALED ? sc[l * 4] : 1.f;
#pragma unroll
        for (int j = 0; j < 8; ++j) { float a = b[j];
#pragma unroll
            for (int k = 0; k < 4; ++k) { const unsigned wd = (j < 2) ? x[i + k].x : (j < 4) ? x[i + k].y : (j < 6) ? x[i + k].z : x[i + k].w; a += w[k][j] * ((j & 1) ? bfhi(wd) : bflo(wd)); }
            o[j] = a * __builtin_amdgcn_rcpf(1.f + __expf(-a)) * s; }
        u32x4 p; p.x = pk2(o[0], o[1]); p.y = pk2(o[2], o[3]); p.z = pk2(o[4], o[5]); p.w = pk2(o[6], o[7]);
        *(SS_LAS u32x4*)(img + l * pitch) = p; }
}

__device__ __forceinline__ void states_unit(SS_LAS unsigned char* lds, int bc, int g, const unsigned short* XBC, const float* DTR, const float* cw, const float* cb, const float* dtb, const float* alog, float* ST, float* CEND) {
    int tid_ = threadIdx.x; asm volatile("" : "+v"(tid_));
    const int tid = tid_, lane = tid & 63, r32 = lane & 31, hi = lane >> 5; const int wid = __builtin_amdgcn_readfirstlane(tid >> 6);
    const int t0 = bc * 128;
    SS_LAS unsigned char* XD = lds; SS_LAS unsigned char* BI = lds + 128 * PX4;
    SS_LAS float* csl = (SS_LAS float*)(lds + 128 * PX4 + 128 * PB_T); SS_LAS float* dtl = csl + 512; SS_LAS float* wtot = dtl + 512; SS_LAS float* scl = wtot + 32;
    const int ch = tid % 48, l0 = (tid / 48) * 16; const int col = (ch < 32) ? g * 256 + ch * 8 : 512 + g * 128 + (ch - 32) * 8;
    u32x4 xr[19];
    if (tid < 384) conv_load(xr, XBC, t0, l0, col);
    dt_cs(t0, g, DTR, dtb, alog, csl, dtl, wtot, tid, lane, wid);
    scl[tid] = dtl[tid] * __expf(csl[508 + (tid & 3)] - csl[tid]);
    if (tid < 4) CEND[bc * 8 + g * 4 + tid] = csl[508 + tid];
    __syncthreads();
    if (tid < 384) {
        if (ch < 32) conv_compute<true>(xr, l0, col, cw, cb, XD + ch * 16, PX4, scl + (ch >> 3));
        else conv_compute<false>(xr, l0, col, cw, cb, BI + (ch - 32) * 16, PB_T, nullptr); }
    __syncthreads();
    const int pt = wid >> 2, nt = wid & 3;
#pragma unroll 1
    for (int hh = 0; hh < 4; ++hh) {
        f32x16 acc = f32x16{};
#pragma unroll
        for (int ks = 0; ks < 8; ++ks) {
            const bf16x8 a = tr_frag(XD, PX4, 16 * ks, hh * 64 + 32 * pt, lane);
            const bf16x8 b = tr_frag(BI, PB_T, 16 * ks, 32 * nt, lane);
            acc = __builtin_amdgcn_mfma_f32_32x32x16_bf16(a, b, acc, 0, 0, 0); }
        float* o = ST + (((size_t)(bc * 8 + g * 4 + hh) * 64 + 32 * pt) << 7) + 32 * nt + r32;
#pragma unroll
        for (int r = 0; r < 16; ++r) o[(size_t)crow(r, hi) << 7] = acc[r];
    }
    __syncthreads();
}

__device__ __forceinline__ void out_unit(SS_LAS unsigned char* lds, int bc, int g, const unsigned short* XBC, const unsigned short* VZ, const float* DTR, const float* cw, const float* cb, const float* dtb, const float* alog,
                                         const unsigned short* HIN, const float* Dsk, const float* gn, unsigned short* MIX) {
    int tid_ = threadIdx.x; asm volatile("" : "+v"(tid_));
    const int tid = tid_, lane = tid & 63, r32 = lane & 31, hi = lane >> 5; const int wid = __builtin_amdgcn_readfirstlane(tid >> 6);
    const int t0 = bc * 128;
    SS_LAS unsigned char* CI = lds; SS_LAS unsigned char* BI = lds + 128 * PR; SS_LAS unsigned char* XS = lds + 2 * 128 * PR;
    SS_LAS float* csl = (SS_LAS float*)(lds + 2 * 128 * PR + 128 * PX4); SS_LAS float* dtl = csl + 512; SS_LAS float* wtot = dtl + 512;
    const int ch = tid & 63, l0 = (tid >> 6) * 16; const int col = (ch < 32) ? g * 256 + ch * 8 : (ch < 48) ? 512 + g * 128 + (ch - 32) * 8 : 768 + g * 128 + (ch - 48) * 8;
    u32x4 xr[19];
    conv_load(xr, XBC, t0, l0, col);
    u32x4 zr[8];
    { const unsigned short* zp = VZ + (size_t)(t0 + (tid >> 2)) * 1024 + 512 + g * 256 + (tid & 3) * 64;
#pragma unroll
      for (int c = 0; c < 8; ++c) zr[c] = *(const u32x4*)(zp + c * 8); }
    dt_cs(t0, g, DTR, dtb, alog, csl, dtl, wtot, tid, lane, wid);
    if (ch < 32) conv_compute<false>(xr, l0, col, cw, cb, XS + ch * 16, PX4, nullptr);
    else if (ch < 48) conv_compute<false>(xr, l0, col, cw, cb, BI + (ch - 32) * 16, PR, nullptr);
    else conv_compute<false>(xr, l0, col, cw, cb, CI + (ch - 48) * 16, PR, nullptr);
    __syncthreads();
    const int lt = wid >> 1, st0 = 2 * (wid & 1), pt = wid & 1;
    f32x16 cb2[2]; cb2[0] = f32x16{}; cb2[1] = f32x16{};
#pragma unroll
    for (int ks = 0; ks < 8; ++ks) {
        const bf16x8 a = row_frag(CI, PR, 32 * lt, 16 * ks, lane);
        const bf16x8 b0 = row_frag(BI, PR, 32 * st0, 16 * ks, lane), b1 = row_frag(BI, PR, 32 * st0 + 32, 16 * ks, lane);
        cb2[0] = __builtin_amdgcn_mfma_f32_32x32x16_bf16(a, b0, cb2[0], 0, 0, 0);
        cb2[1] = __builtin_amdgcn_mfma_f32_32x32x16_bf16(a, b1, cb2[1], 0, 0, 0); }
    f32x16 yo[4];
    { bf16x8 hb[2][8];
      const unsigned short* hin0 = HIN + (((size_t)(bc * 8 + g * 4) * 64 + 32 * pt + r32) << 7) + 8 * hi;
#pragma unroll
      for (int ks = 0; ks < 8; ++ks) hb[0][ks] = *(const bf16x8*)(hin0 + 16 * ks);
#pragma unroll
      for (int hh = 0; hh < 4; ++hh) { yo[hh] = f32x16{};
          if (hh < 3) {
#pragma unroll
              for (int ks = 0; ks < 8; ++ks) hb[(hh + 1) & 1][ks] = *(const bf16x8*)(hin0 + ((size_t)(hh + 1) << 13) + 16 * ks); }
          __builtin_amdgcn_sched_barrier(0);
#pragma unroll
          for (int ks = 0; ks < 8; ++ks) yo[hh] = __builtin_amdgcn_mfma_f32_32x32x16_bf16(row_frag(CI, PR, 32 * lt, 16 * ks, lane), hb[hh & 1][ks], yo[hh], 0, 0, 0);
          __builtin_amdgcn_sched_barrier(0); } }
    __syncthreads();
    SS_LAS unsigned char* MI = BI;
#pragma unroll
    for (int hh = 0; hh < 4; ++hh) {
        const int h = g * 4 + hh;
#pragma unroll
        for (int j = 0; j < 2; ++j) { const int s = 32 * (st0 + j) + r32; const float css = csl[s * 4 + hh], dts = dtl[s * 4 + hh];
#pragma unroll
            for (int r = 0; r < 16; ++r) { const int l = 32 * lt + crow(r, hi); const float cl = csl[l * 4 + hh];
                float pr_ = cb2[j][r] * __builtin_amdgcn_exp2f(fminf(cl - css, 0.f) * 1.4426950408889634f) * dts; asm volatile("" : "+v"(pr_)); const float v = (s <= l) ? pr_ : 0.f;
                *(SS_LAS unsigned short*)(MI + l * PR + s * 2) = (unsigned short)f2bf(v); if ((r & 3) == 3) asm volatile("" ::: "memory"); } }
        __syncthreads();
        f32x16 yd = f32x16{};
#pragma unroll
        for (int ks = 0; ks < 8; ++ks) yd = __builtin_amdgcn_mfma_f32_32x32x16_bf16(row_frag(MI, PR, 32 * lt, 16 * ks, lane), tr_frag(XS, PX4, 16 * ks, hh * 64 + 32 * pt, lane), yd, 0, 0, 0);
        __syncthreads();
        const float dsk = Dsk[h]; const int p = 32 * pt + r32;
#pragma unroll
        for (int r = 0; r < 16; ++r) { const int l = 32 * lt + crow(r, hi);
            SS_LAS unsigned short* xp = (SS_LAS unsigned short*)(XS + l * PX4 + (hh * 64 + p) * 2);
            const float y = yd[r] + yo[hh][r] * __expf(csl[l * 4 + hh]) + dsk * bf2f(*xp);
            *xp = (unsigned short)f2bf(y); }
    }
    __syncthreads();
    { const int l = tid >> 2, q = tid & 3; const SS_LAS unsigned char* rowp = XS + l * PX4 + q * 128; float yv[8][8]; float s = 0.f;
#pragma unroll
      for (int c = 0; c < 8; ++c) { const u32x4 v = *(const SS_LAS u32x4*)(rowp + c * 16); const u32x4 z = zr[c];
          yv[c][0] = bflo(v.x) * silu_f(bflo(z.x)); yv[c][1] = bfhi(v.x) * silu_f(bfhi(z.x)); yv[c][2] = bflo(v.y) * silu_f(bflo(z.y)); yv[c][3] = bfhi(v.y) * silu_f(bfhi(z.y));
          yv[c][4] = bflo(v.z) * silu_f(bflo(z.z)); yv[c][5] = bfhi(v.z) * silu_f(bfhi(z.z)); yv[c][6] = bflo(v.w) * silu_f(bflo(z.w)); yv[c][7] = bfhi(v.w) * silu_f(bfhi(z.w));
#pragma unroll
          for (int j = 0; j < 8; ++j) s += yv[c][j] * yv[c][j]; }
      s += __shfl_xor(s, 1); s += __shfl_xor(s, 2);
      const float rstd = 1.f / sqrtf(s * (1.f / 256.f) + 1e-6f); const float* gq = gn + g * 256 + q * 64; unsigned short* op = MIX + (size_t)(t0 + l) * 1024 + 512 + g * 256 + q * 64;
#pragma unroll
      for (int c = 0; c < 8; ++c) { const f32x4 g0 = *(const f32x4*)(gq + c * 8), g1 = *(const f32x4*)(gq + c * 8 + 4); u32x4 o;
          o.x = pk2(yv[c][0] * rstd * g0.x, yv[c][1] * rstd * g0.y); o.y = pk2(yv[c][2] * rstd * g0.z, yv[c][3] * rstd * g0.w);
          o.z = pk2(yv[c][4] * rstd * g1.x, yv[c][5] * rstd * g1.y); o.w = pk2(yv[c][6] * rstd * g1.z, yv[c][7] * rstd * g1.w);
          *(u32x4*)(op + c * 8) = o; } }
    __syncthreads();
}
#undef SS_LAS
}

constexpr int NWAVES = 8, NTHR = 512;
constexpr int T_ = 32768, S_ = 2048, NB_ = 16, D_ = 1024;
constexpr int DFF = 2816, DFF2 = 5632;
constexpr float EPS = 1e-6f;
constexpr size_t MiB = 1u << 20;
constexpr size_t WS_CTL = 0, CTL_ZERO_BYTES = 3 * MiB;
constexpr size_t WS_SSQA = 1 * MiB, WS_SSQB = WS_SSQA + 256 * 1024, WS_SSQC = WS_SSQB + 256 * 1024, WS_SSQQ = WS_SSQC + 256 * 1024, WS_SSQKV = WS_SSQQ + 256 * 1024;
constexpr size_t WS_KMEAN = WS_SSQKV + 256 * 1024;
constexpr size_t WS_DTR = 55 * MiB;
constexpr size_t WS_W_IN0 = 3 * MiB;
constexpr size_t WS_W_OUT0 = WS_W_IN0 + 6656 * 1024;
constexpr size_t WS_W_IN1 = WS_W_OUT0 + 2 * MiB;
constexpr size_t WS_W_UQ = WS_W_IN1 + 2 * MiB;
constexpr size_t WS_W_UKV = WS_W_UQ + 1536 * 1024;
constexpr size_t WS_W_OUT1 = WS_W_UKV + 1 * MiB;
constexpr size_t WS_W_UP = WS_W_OUT1 + 2 * MiB;
constexpr size_t WS_W_DN = WS_W_UP + 22 * MiB;
constexpr size_t WS_TAB64 = 51 * MiB;
constexpr size_t WS_TAB32 = WS_TAB64 + 512 * 1024;
constexpr size_t WS_CWS = 52 * MiB;
constexpr size_t WS_DT = 53 * MiB;
constexpr size_t WS_CS = 54 * MiB;
constexpr size_t WS_XN = 56 * MiB;
constexpr size_t WS_BIG = 120 * MiB;
static_assert(WS_W_DN + 11 * MiB <= WS_TAB64, "weights fit");
constexpr size_t L0_QK = WS_BIG, L0_VZ = WS_BIG + 64 * MiB, L0_XBC = WS_BIG + 128 * MiB, L0_DTR = WS_BIG + 192 * MiB, L0_XBCA = WS_BIG + 256 * MiB, L0_MIX = WS_BIG + 320 * MiB;
constexpr size_t L0_ST = WS_BIG + 192 * MiB;
constexpr size_t L0_KC = WS_BIG + 288 * MiB;
constexpr size_t L0_HIN = WS_BIG + 256 * MiB;
constexpr size_t WS_CEND = 53 * MiB;
constexpr size_t L0_CB = L0_DTR;
constexpr size_t L0_YG = L0_QK;
constexpr size_t FF_ACT = WS_BIG + 64 * MiB, FF_UB = WS_BIG + 240 * MiB;
constexpr size_t L1_C1 = WS_BIG, L1_QR = WS_BIG + 64 * MiB, L1_V2 = WS_BIG + 160 * MiB;
constexpr size_t WS_RG = WS_BIG + 384 * MiB;
constexpr size_t WS_SSQPE = 53 * MiB + 64 * 1024;
constexpr size_t L1_K2 = WS_BIG + 288 * MiB;
constexpr size_t L1_O = WS_BIG + 224 * MiB;
constexpr size_t WS_END = 512 * MiB;
constexpr int CW_BAR = 4096;

constexpr int RING_OFF = 0, RING_BYTES = 162816;
constexpr int LDSCTL_OFF = RING_BYTES, MISC_OFF = LDSCTL_OFF + 320;
constexpr int LDS_BYTES = 163840;

struct Args { const float* in[25]; float* out; unsigned char* ws; int ph_lo, ph_hi; };
typedef const __attribute__((address_space(4))) Args* KArgs;
__device__ __forceinline__ KArgs kargs() { KArgs p = (KArgs)__builtin_amdgcn_kernarg_segment_ptr(); asm volatile("" : "+s"(p)); return p; }
#define PH_VARS KArgs A_ = kargs(); unsigned char* ws = A_->ws; float* out = A_->out; const float* x = A_->in[0]; bf16* XN = (bf16*)(ws + WS_XN); const float* TAB64 = (const float*)(ws + WS_TAB64); const float* TAB32 = (const float*)(ws + WS_TAB32); \
    int tid_ = threadIdx.x; asm volatile("" : "+v"(tid_)); const int tid = tid_, lane = tid & 63, wave = __builtin_amdgcn_readfirstlane(tid >> 6); int G = gridDim.x; asm volatile("" : "+s"(G)); const int gw = blockIdx.x * NWAVES + wave, NGW = G * NWAVES; const int gt = blockIdx.x * NTHR + tid, NGT = G * NTHR; \
    (void)out; (void)x; (void)XN; (void)TAB64; (void)TAB32; (void)lane; (void)gw; (void)NGW; (void)gt; (void)NGT;

template <int MAP> __device__ __forceinline__ int src_col(int n0) {
    if (MAP == 1) { const int pn = n0 >> 8, bj = (n0 >> 7) & 1, wc = (n0 >> 5) & 3; return bj * DFF + pn * 128 + wc * 32; }
    if (MAP == 2) { const int pn = n0 >> 8, bj = (n0 >> 7) & 1, wc = (n0 >> 5) & 3; return (pn < 4) ? pn * 256 + wc * 64 + bj * 32 : n0; }
    if (MAP == 3) { const int pn = n0 >> 8, bj = (n0 >> 7) & 1, wc = (n0 >> 5) & 3; if (pn < 4) return (4 * pn + wc) * 128 + bj * 32; const int col = (pn - 4) * 256 + bj * 128 + wc * 32; return (col >> 6) * 128 + 64 + (col & 63); }
    return n0;
}
template <int MAP> __device__ __forceinline__ void tr_load(f32x4 (&v)[8], const float* W, int Nsrc, int item, int nblk, int lane, const float* gain) {
    const int kb = item / nblk, nb = item % nblk, k0 = 64 * kb, n0 = 32 * nb;
    const int nn = src_col<MAP>(n0) + (lane & 7) * 4; const bool ok = (nn >= 0 && nn < Nsrc);
#pragma unroll
    for (int i = 0; i < 8; ++i) { const int kk = 8 * i + (lane >> 3); v[i] = ok ? *(const f32x4*)(W + (size_t)(k0 + kk) * Nsrc + nn) : (f32x4){0.f, 0.f, 0.f, 0.f}; if (gain) v[i] = v[i] * gain[k0 + kk]; }
}
__device__ __forceinline__ void tr_store(const f32x4 (&v)[8], int K, bf16* WT, LAS float* scr, int item, int nblk, int lane) {
    const int kb = item / nblk, nb = item % nblk, k0 = 64 * kb, n0 = 32 * nb;
#pragma unroll
    for (int i = 0; i < 8; ++i) { const int kk = 8 * i + (lane >> 3); LAS float* d = scr + kk * 33 + (lane & 7) * 4; d[0] = v[i].x; d[1] = v[i].y; d[2] = v[i].z; d[3] = v[i].w; }
    LDS_WAIT(); asm volatile("" ::: "memory");
    const int c = lane & 7;
#pragma unroll
    for (int j = 0; j < 4; ++j) { const int n = (lane >> 3) + 8 * j; const LAS float* s = scr + (8 * c) * 33 + n;
        v4u o; o.x = pk2(s[0 * 33], s[1 * 33]); o.y = pk2(s[2 * 33], s[3 * 33]); o.z = pk2(s[4 * 33], s[5 * 33]); o.w = pk2(s[6 * 33], s[7 * 33]);
        *(GAS v4u*)(WT + (size_t)(n0 + n) * K + k0 + 8 * c) = o; }
    LDS_WAIT(); asm volatile("" ::: "memory");
}
template <int MAP = 0> __device__ __forceinline__ void transpose_mat(const float* W, int K, int Nsrc, int Npad, bf16* WT, LAS float* scr, int gw, int NGW, int lane, const float* gain = nullptr) {
    const int nblk = Npad / 32, nitems = (K / 64) * nblk;
    f32x4 cur[8], nxt[8];
    if (gw < nitems) tr_load<MAP>(cur, W, Nsrc, gw, nblk, lane, gain);
    for (int it = gw; it < nitems; it += NGW) {
        const bool more = it + NGW < nitems;
        if (more) tr_load<MAP>(nxt, W, Nsrc, it + NGW, nblk, lane, gain);
        tr_store(cur, K, WT, scr, it, nblk, lane);
        if (more) {
#pragma unroll
            for (int i = 0; i < 8; ++i) cur[i] = nxt[i]; }
    }
}

struct MatDesc { const float* W; bf16* WT; const float* gain; int K, Nsrc, nblk, map; };
__device__ __forceinline__ int src_col_rt(int map, int n0) { return map == 1 ? src_col<1>(n0) : map == 2 ? src_col<2>(n0) : map == 3 ? src_col<3>(n0) : n0; }
__device__ __forceinline__ void trl_load(f32x4 (&v)[8], const MatDesc& d, int item, int lane) {
    const int kb = item / d.nblk, nb = item % d.nblk, k0 = 64 * kb, n0 = 32 * nb;
    const int nn = src_col_rt(d.map, n0) + (lane & 7) * 4; const bool ok = (nn >= 0 && nn < d.Nsrc);
#pragma unroll
    for (int i = 0; i < 8; ++i) { const int kk = 8 * i + (lane >> 3); v[i] = ok ? __builtin_nontemporal_load((const f32x4*)(d.W + (size_t)(k0 + kk) * d.Nsrc + nn)) : (f32x4){0.f, 0.f, 0.f, 0.f}; if (d.gain) v[i] = v[i] * d.gain[k0 + kk]; }
}
constexpr int NIT_W = 1536 + 512 + 512 + 384 + 256 + 512 + 2 * 2816 + 2 * 1408;
__device__ __forceinline__ MatDesc mat_of(KArgs A_, unsigned char* ws, int item, int& local) {
    MatDesc d; int r = item;
    if (r < 1536) { d = MatDesc{A_->in[3], (bf16*)(ws + WS_W_IN0), nullptr, 1024, 3080, 96, 2}; local = r; return d; } r -= 1536;
    if (r < 512) { d = MatDesc{A_->in[12], (bf16*)(ws + WS_W_OUT0), nullptr, 1024, 1024, 32, 0}; local = r; return d; } r -= 512;
    if (r < 512) { d = MatDesc{A_->in[13], (bf16*)(ws + WS_W_IN1), A_->in[1] + 1024, 1024, 800, 32, 0}; local = r; return d; } r -= 512;
    if (r < 384) { d = MatDesc{A_->in[15], (bf16*)(ws + WS_W_UQ), A_->in[14], 512, 1536, 48, 0}; local = r; return d; } r -= 384;
    if (r < 256) { d = MatDesc{A_->in[17], (bf16*)(ws + WS_W_UKV), A_->in[16], 256, 2048, 64, 3}; local = r; return d; } r -= 256;
    if (r < 512) { d = MatDesc{A_->in[20], (bf16*)(ws + WS_W_OUT1), nullptr, 1024, 1024, 32, 0}; local = r; return d; } r -= 512;
    if (r < 5632) { const int l = r / 2816; d = MatDesc{A_->in[21] + (size_t)l * 1024 * DFF2, (bf16*)(ws + WS_W_UP) + (size_t)l * DFF2 * 1024, A_->in[2] + l * 1024, 1024, DFF2, 176, 1}; local = r - l * 2816; return d; } r -= 5632;
    { const int l = r / 1408; d = MatDesc{A_->in[24] + (size_t)l * DFF * 1024, (bf16*)(ws + WS_W_DN) + (size_t)l * 1024 * DFF, nullptr, DFF, 1024, 32, 0}; local = r - l * 1408; return d; }
}

__device__ __forceinline__ void rms_rows_1024(const float* x, const float* g, bf16* o, int gw, int NGW, int lane) {
    f32x4 v[4], nx[4];
    if (gw < T_) {
#pragma unroll
        for (int j = 0; j < 4; ++j) v[j] = __builtin_nontemporal_load((const f32x4*)(x + (size_t)gw * D_) + lane + 64 * j); }
    for (int m = gw; m < T_; m += NGW) {
        const bool more = m + NGW < T_;
        if (more) {
#pragma unroll
            for (int j = 0; j < 4; ++j) nx[j] = __builtin_nontemporal_load((const f32x4*)(x + (size_t)(m + NGW) * D_) + lane + 64 * j); }
        float s = 0.f;
#pragma unroll
        for (int j = 0; j < 4; ++j) s += (v[j].x * v[j].x + v[j].y * v[j].y) + (v[j].z * v[j].z + v[j].w * v[j].w);
        const float rstd = 1.f / sqrtf(wave_sum(s) * (1.f / D_) + EPS);
        unsigned long long* o8 = (unsigned long long*)(o + (size_t)m * D_) + lane;
#pragma unroll
        for (int j = 0; j < 4; ++j) { const f32x4 gg = ((const f32x4*)g)[lane + 64 * j];
            o8[64 * j] = (unsigned long long)pk2(v[j].x * rstd * gg.x, v[j].y * rstd * gg.y) | ((unsigned long long)pk2(v[j].z * rstd * gg.z, v[j].w * rstd * gg.w) << 32); }
        if (more) {
#pragma unroll
            for (int j = 0; j < 4; ++j) v[j] = nx[j]; }
    }
}

__device__ __forceinline__ void rms_rows_dt(const float* x, const float* g, bf16* o, float* DTR, const LAS f32x4* W2, int gw, int NGW, int lane) {
    f32x4 v[4], nx[4];
    if (gw < T_) {
#pragma unroll
        for (int j = 0; j < 4; ++j) v[j] = __builtin_nontemporal_load((const f32x4*)(x + (size_t)gw * D_) + lane + 64 * j); }
    for (int m = gw; m < T_; m += NGW) {
        const bool more = m + NGW < T_;
        if (more) {
#pragma unroll
            for (int j = 0; j < 4; ++j) nx[j] = __builtin_nontemporal_load((const f32x4*)(x + (size_t)(m + NGW) * D_) + lane + 64 * j); }
        float s = 0.f; f32x4 d0 = {0.f, 0.f, 0.f, 0.f}, d1 = d0;
#pragma unroll
        for (int j = 0; j < 4; ++j) { s += (v[j].x * v[j].x + v[j].y * v[j].y) + (v[j].z * v[j].z + v[j].w * v[j].w);
#pragma unroll
            for (int e = 0; e < 4; ++e) { const int sl = j * 4 + e; const float xk = v[j][e]; d0 += W2[(sl * 2) * 64 + lane] * xk; d1 += W2[(sl * 2 + 1) * 64 + lane] * xk; } }
        const float rstd = 1.f / sqrtf(wave_sum(s) * (1.f / D_) + EPS);
#pragma unroll
        for (int e = 0; e < 4; ++e) { d0[e] = wave_sum(d0[e]); d1[e] = wave_sum(d1[e]); }
        if (lane == 0) { *(f32x4*)(DTR + (size_t)m * 8) = d0 * rstd; *(f32x4*)(DTR + (size_t)m * 8 + 4) = d1 * rstd; }
        unsigned long long* o8 = (unsigned long long*)(o + (size_t)m * D_) + lane;
#pragma unroll
        for (int j = 0; j < 4; ++j) { const f32x4 gg = ((const f32x4*)g)[lane + 64 * j];
            o8[64 * j] = (unsigned long long)pk2(v[j].x * rstd * gg.x, v[j].y * rstd * gg.y) | ((unsigned long long)pk2(v[j].z * rstd * gg.z, v[j].w * rstd * gg.w) << 32); }
        if (more) {
#pragma unroll
            for (int j = 0; j < 4; ++j) v[j] = nx[j]; }
    }
}

struct EpiF32Res {
    static constexpr bool PERM = false, AFTER_DRAIN = false;
    float* C; const float* R; int ldc;
    __device__ __forceinline__ void operator()(const pg8::f32x4 (&acc)[2][2][4][2], const pg8::Unit& u, int wr, int wc, int fr, int fq) const {
        const int row0 = u.pm * pg8::BM + wr * 64 + fr, col0 = u.pn * pg8::BM + wc * 32 + 4 * fq;
#pragma unroll
        for (int ai = 0; ai < 2; ++ai)
#pragma unroll
            for (int m = 0; m < 4; ++m) { const size_t off = (size_t)(row0 + ai * pg8::HALF + m * 16) * ldc + col0;
                f32x4 r[2][2];
#pragma unroll
                for (int bj = 0; bj < 2; ++bj)
#pragma unroll
                    for (int n = 0; n < 2; ++n) r[bj][n] = *(const f32x4*)(R + off + bj * pg8::HALF + n * 16);
#pragma unroll
                for (int bj = 0; bj < 2; ++bj)
#pragma unroll
                    for (int n = 0; n < 2; ++n) *(f32x4*)(C + off + bj * pg8::HALF + n * 16) = acc[ai][bj][m][n] + r[bj][n];
                asm volatile("" ::: "memory"); }
    }
};

template <bool RB16, bool OUTF, bool OUTB> struct EpiRes {
    static constexpr bool PERM = true, AFTER_DRAIN = false;
    float* C; const void* R; bf16* XB; unsigned long long* SSQ;
    struct Raw { f32x4 f[2][2]; v4u h[2]; };
    __device__ __forceinline__ void load_raw(Raw& q, size_t off) const {
#pragma unroll
        for (int bj = 0; bj < 2; ++bj) {
            if (RB16) q.h[bj] = *(const v4u*)((const bf16*)R + off + bj * pg8::HALF);
            else { q.f[bj][0] = *(const f32x4*)((const float*)R + off + bj * pg8::HALF); q.f[bj][1] = *(const f32x4*)((const float*)R + off + bj * pg8::HALF + 4); } }
    }
    __device__ __forceinline__ void operator()(const pg8::f32x4 (&acc)[2][2][4][2], const pg8::Unit& u, int wr, int wc, int fr, int fq) const {
        const int row0 = u.pm * pg8::BM + wr * 64 + fr, col0 = u.pn * pg8::BM + wc * 32 + 8 * fq;
        constexpr int WIN = 4;
        Raw q[8]; float ss[8];
#pragma unroll
        for (int it = 0; it < WIN; ++it) load_raw(q[it], (size_t)(row0 + (it >> 2) * pg8::HALF + (it & 3) * 16) * 1024 + col0);
        __builtin_amdgcn_sched_barrier(0);
#pragma unroll
        for (int it = 0; it < 8; ++it) { const int ai = it >> 2, mm = it & 3; const int row = row0 + ai * pg8::HALF + mm * 16; const size_t off = (size_t)row * 1024 + col0;
            if (it + WIN < 8) { load_raw(q[it + WIN], (size_t)(row0 + ((it + WIN) >> 2) * pg8::HALF + ((it + WIN) & 3) * 16) * 1024 + col0); __builtin_amdgcn_sched_barrier(0); }
            float s = 0.f;
#pragma unroll
            for (int bj = 0; bj < 2; ++bj) {
                f32x4 r0, r1;
                if (RB16) { const v4u w = q[it].h[bj]; r0 = (f32x4){bflo(w.x), bfhi(w.x), bflo(w.y), bfhi(w.y)}; r1 = (f32x4){bflo(w.z), bfhi(w.z), bflo(w.w), bfhi(w.w)}; } else { r0 = q[it].f[bj][0]; r1 = q[it].f[bj][1]; }
                const f32x4 v0 = acc[ai][bj][mm][0] + r0, v1 = acc[ai][bj][mm][1] + r1;
                if (OUTF) { *(f32x4*)(C + off + bj * pg8::HALF) = v0; *(f32x4*)(C + off + bj * pg8::HALF + 4) = v1; }
                if (OUTB) { s += ((v0.x * v0.x + v0.y * v0.y) + (v0.z * v0.z + v0.w * v0.w)) + ((v1.x * v1.x + v1.y * v1.y) + (v1.z * v1.z + v1.w * v1.w));
                    v4u w; w.x = pk2(v0.x, v0.y); w.y = pk2(v0.z, v0.w); w.z = pk2(v1.x, v1.y); w.w = pk2(v1.z, v1.w); *(v4u*)(XB + off + bj * pg8::HALF) = w; } }
            if (OUTB) { s += __shfl_xor(s, 16); s += __shfl_xor(s, 32); ss[it] = s; }
            asm volatile("" ::: "memory"); }
        if (OUTB) { if (fq == 0) {
#pragma unroll
            for (int it = 0; it < 8; ++it) atomicAdd(SSQ + row0 + (it >> 2) * pg8::HALF + (it & 3) * 16, (unsigned long long)(ss[it] * 1073741824.0f)); } }
    }
};
typedef unsigned v2u __attribute__((ext_vector_type(2))); typedef float f32x2 __attribute__((ext_vector_type(2)));
__device__ __forceinline__ float rstd_of(const unsigned long long* SSQ, int row, float inv_n) { const v2u s = ((const v2u*)SSQ)[row]; const float c = inv_n * (1.0f / 1073741824.0f);
    return __builtin_amdgcn_rsqf(__builtin_fmaf((float)s.y, 4294967296.0f * c, __builtin_fmaf((float)s.x, c, EPS))); }
__device__ __forceinline__ f32x2 pk_add_one(f32x2 a) { asm("" : "+v"(a)); return a + 1.0f; }
template <int N> __device__ __forceinline__ float dpp_shr0(float v) { return __builtin_bit_cast(float, __builtin_amdgcn_update_dpp(0, __builtin_bit_cast(int, v), 0x110 + N, 0xf, 0xf, true)); }
template <int N> __device__ __forceinline__ float dpp_shr_old(float old, float v) { return __builtin_bit_cast(float, __builtin_amdgcn_update_dpp(__builtin_bit_cast(int, old), __builtin_bit_cast(int, v), 0x110 + N, 0xf, 0xf, false)); }
template <int N> __device__ __forceinline__ float dpp_ror(float v) { return __builtin_bit_cast(float, __builtin_amdgcn_update_dpp(0, __builtin_bit_cast(int, v), 0x120 + N, 0xf, 0xf, false)); }
struct EpiFfnUp {
    static constexpr bool PERM = true, AFTER_DRAIN = false;
    bf16* ACT; bf16* UB; const unsigned long long* SSQ; const float* cw; const float* cb;
    __device__ __forceinline__ void operator()(const pg8::f32x4 (&acc)[2][2][4][2], const pg8::Unit& u, int wr, int wc, int fr, int fq) const {
        const int ch0 = u.pn * 128 + wc * 32 + 8 * fq;
        float rs[2][4];
#pragma unroll
        for (int ai = 0; ai < 2; ++ai)
#pragma unroll
            for (int m = 0; m < 4; ++m) rs[ai][m] = rstd_of(SSQ, u.pm * pg8::BM + ai * pg8::HALF + wr * 64 + 4 * fr + m, 1.0f / 1024.0f);
        unsigned long long keep[2][4];
#pragma unroll
        for (int n = 0; n < 2; ++n) {
            __builtin_amdgcn_sched_barrier(0);
            const int ch = ch0 + 4 * n;
            const f32x4 wg0 = *(const f32x4*)(cw + ch), wg1 = *(const f32x4*)(cw + DFF2 + ch), wg2 = *(const f32x4*)(cw + 2 * DFF2 + ch), bg = *(const f32x4*)(cw + 3 * DFF2 + ch);
            const f32x4 wu0 = *(const f32x4*)(cw + DFF + ch), wu1 = *(const f32x4*)(cw + DFF2 + DFF + ch), wu2 = *(const f32x4*)(cw + 2 * DFF2 + DFF + ch), bu = *(const f32x4*)(cw + 3 * DFF2 + DFF + ch);
#pragma unroll
            for (int ai = 0; ai < 2; ++ai) {
                const int rowc = u.pm * pg8::BM + ai * pg8::HALF + wr * 64;
                f32x4 g[4], uu[4];
#pragma unroll
                for (int m = 0; m < 4; ++m) { g[m] = acc[ai][0][m][n] * rs[ai][m]; uu[m] = acc[ai][1][m][n] * rs[ai][m]; }
                f32x4 g2p, g3p, u2p, u3p;
#pragma unroll
                for (int j = 0; j < 4; ++j) { g2p[j] = dpp_shr0<1>(g[2][j]); g3p[j] = dpp_shr0<1>(g[3][j]); u2p[j] = dpp_shr0<1>(uu[2][j]); u3p[j] = dpp_shr0<1>(uu[3][j]); }
#pragma unroll
                for (int m = 0; m < 4; ++m) {
                    const f32x4 sg1 = (m == 0) ? g3p : g[m - 1], sg2 = (m == 0) ? g2p : (m == 1) ? g3p : g[m - 2];
                    const f32x4 su1 = (m == 0) ? u3p : uu[m - 1], su2 = (m == 0) ? u2p : (m == 1) ? u3p : uu[m - 2];
                    const f32x4 cg = bg + wg0 * sg2 + wg1 * sg1 + wg2 * g[m], cu = bu + wu0 * su2 + wu1 * su1 + wu2 * uu[m];
                    f32x4 r_;
                    { const f32x2 d0 = pk_add_one((f32x2){__builtin_amdgcn_exp2f(cg[0]), __builtin_amdgcn_exp2f(cg[1])}), d1 = pk_add_one((f32x2){__builtin_amdgcn_exp2f(cg[2]), __builtin_amdgcn_exp2f(cg[3])});
                      r_[0] = __builtin_amdgcn_rcpf(d0.x); r_[1] = __builtin_amdgcn_rcpf(d0.y); r_[2] = __builtin_amdgcn_rcpf(d1.x); r_[3] = __builtin_amdgcn_rcpf(d1.y); }
                    const f32x4 a = cg * r_ * cu;
                    const int row = rowc + 4 * fr + m;
                    const unsigned long long pk_ = (unsigned long long)pk2(a[0], a[1]) | ((unsigned long long)pk2(a[2], a[3]) << 32);
                    if (n == 0) { keep[ai][m] = pk_; asm volatile("" : "+v"(keep[ai][m])); }
                    else if (!(fr == 0 && m < 2)) { v4u w; w.x = (unsigned)keep[ai][m]; w.y = (unsigned)(keep[ai][m] >> 32); w.z = (unsigned)pk_; w.w = (unsigned)(pk_ >> 32); *(v4u*)(ACT + (size_t)row * DFF + ch0) = w; }
                    if ((fr == 0 && m < 2) || (fr == 15 && m >= 2)) { const int slot = m; bf16* ub = UB + ((size_t)(rowc >> 6) * 4 + slot) * DFF2 + ch;
                        *(unsigned long long*)ub = (unsigned long long)pk2(g[m][0], g[m][1]) | ((unsigned long long)pk2(g[m][2], g[m][3]) << 32);
                        *(unsigned long long*)(ub + DFF) = (unsigned long long)pk2(uu[m][0], uu[m][1]) | ((unsigned long long)pk2(uu[m][2], uu[m][3]) << 32); }
                }
            }
        }
    }
};


struct EpiScale {
    static constexpr bool PERM = true, AFTER_DRAIN = false;
    bf16* O; int ldc; const unsigned long long* SSQ; float inv_n;
    __device__ __forceinline__ void operator()(const pg8::f32x4 (&acc)[2][2][4][2], const pg8::Unit& u, int wr, int wc, int fr, int fq) const {
        const int row0 = u.pm * pg8::BM + wr * 64 + fr, col0 = u.pn * pg8::BM + wc * 32 + 8 * fq;
#pragma unroll
        for (int ai = 0; ai < 2; ++ai)
#pragma unroll
            for (int m = 0; m < 4; ++m) { const int row = row0 + ai * pg8::HALF + m * 16; const float rs = rstd_of(SSQ, row, inv_n); bf16* rowp = O + (size_t)row * ldc + col0;
#pragma unroll
                for (int bj = 0; bj < 2; ++bj) { const f32x4 v0 = acc[ai][bj][m][0] * rs, v1 = acc[ai][bj][m][1] * rs;
                    v4u w; w.x = pk2(v0[0], v0[1]); w.y = pk2(v0[2], v0[3]); w.z = pk2(v1[0], v1[1]); w.w = pk2(v1[2], v1[3]); *(v4u*)(rowp + bj * pg8::HALF) = w; } }
    }
};
struct EpiMlaIn {
    static constexpr bool PERM = true, AFTER_DRAIN = false;
    bf16* O; const unsigned long long* SSQ; unsigned long long* SSQ_Q; unsigned long long* SSQ_KV; float* SSQPE; float* RG; const float* kg; const float* TAB;
    __device__ __forceinline__ void operator()(const pg8::f32x4 (&acc)[2][2][4][2], const pg8::Unit& u, int wr, int wc, int fr, int fq) const {
        const int row0 = u.pm * pg8::BM + wr * 64 + fr, col0 = u.pn * pg8::BM + wc * 32 + 8 * fq;
        unsigned long long* tgt = (u.pn < 2) ? SSQ_Q : SSQ_KV;
        float rsv[8];
#pragma unroll
        for (int i = 0; i < 8; ++i) rsv[i] = rstd_of(SSQ, row0 + (i >> 2) * pg8::HALF + (i & 3) * 16, 1.0f / 1024.0f);
        if (u.pn < 3) {
#pragma unroll
        for (int ai = 0; ai < 2; ++ai)
#pragma unroll
            for (int m = 0; m < 4; ++m) { const int row = row0 + ai * pg8::HALF + m * 16; const float rs = rsv[ai * 4 + m]; bf16* rowp = O + (size_t)row * 1024 + col0; float s = 0.f;
#pragma unroll
                for (int bj = 0; bj < 2; ++bj) { const f32x4 v0 = acc[ai][bj][m][0] * rs, v1 = acc[ai][bj][m][1] * rs;
                    s += (v0[0] * v0[0] + v0[1] * v0[1]) + (v0[2] * v0[2] + v0[3] * v0[3]) + (v1[0] * v1[0] + v1[1] * v1[1]) + (v1[2] * v1[2] + v1[3] * v1[3]);
                    v4u w; w.x = pk2(v0[0], v0[1]); w.y = pk2(v0[2], v0[3]); w.z = pk2(v1[0], v1[1]); w.w = pk2(v1[2], v1[3]); *(v4u*)(rowp + bj * pg8::HALF) = w; }
                s += __shfl_xor(s, 16); s += __shfl_xor(s, 32); if (fq == 0) atomicAdd(tgt + row, (unsigned long long)(s * 1073741824.0f)); asm volatile("" ::: "memory"); }
        } else if (wc == 0) {
            const f32x4 g0 = *(const f32x4*)(kg + 64 + 8 * fq), g1 = *(const f32x4*)(kg + 64 + 8 * fq + 4);
            f32x4 tn[4]; { const float* tb = TAB + ((row0 & 2047) * 16 + 8 * (fq & 1)) * 2; tn[0] = *(const f32x4*)tb; tn[1] = *(const f32x4*)(tb + 4); tn[2] = *(const f32x4*)(tb + 8); tn[3] = *(const f32x4*)(tb + 12); }
#pragma unroll
            for (int ai = 0; ai < 2; ++ai)
#pragma unroll
                for (int m = 0; m < 4; ++m) { const int row = row0 + ai * pg8::HALF + m * 16; const float rs = rsv[ai * 4 + m];
                    const f32x4 ta = tn[0], tb4 = tn[1], tc = tn[2], td = tn[3];
                    if (ai * 4 + m < 7) { const int i1 = ai * 4 + m + 1; const float* tb = TAB + (((row0 + (i1 >> 2) * pg8::HALF + (i1 & 3) * 16) & 2047) * 16 + 8 * (fq & 1)) * 2; tn[0] = *(const f32x4*)tb; tn[1] = *(const f32x4*)(tb + 4); tn[2] = *(const f32x4*)(tb + 8); tn[3] = *(const f32x4*)(tb + 12); }
                    const f32x4 v0 = acc[ai][0][m][0] * rs, v1 = acc[ai][0][m][1] * rs;
                    float s = (v0[0] * v0[0] + v0[1] * v0[1]) + (v0[2] * v0[2] + v0[3] * v0[3]) + (v1[0] * v1[0] + v1[1] * v1[1]) + (v1[2] * v1[2] + v1[3] * v1[3]);
                    s += __shfl_xor(s, 16); s += __shfl_xor(s, 32); if (fq == 0) SSQPE[row] = s;
                    const f32x4 y0 = v0 * g0, y1 = v1 * g1;
                    f32x4 p0, p1;
#pragma unroll
                    for (int j = 0; j < 4; ++j) { p0[j] = __shfl_xor(y0[j], 32); p1[j] = __shfl_xor(y1[j], 32); }
                    const f32x4 c0 = {ta[0], ta[2], tb4[0], tb4[2]}, s0 = {ta[1], ta[3], tb4[1], tb4[3]}, c1 = {tc[0], tc[2], td[0], td[2]}, s1 = {tc[1], tc[3], td[1], td[3]};
                    f32x4 o0, o1;
                    if (fq < 2) { o0 = y0 * c0 - p0 * s0; o1 = y1 * c1 - p1 * s1; } else { o0 = p0 * s0 + y0 * c0; o1 = p1 * s1 + y1 * c1; }
                    float* rg = RG + (size_t)row * 32 + 8 * fq; *(f32x4*)rg = o0; *(f32x4*)(rg + 4) = o1; asm volatile("" ::: "memory"); }
        }
    }
};
struct EpiUkv {
    static constexpr bool PERM = true, AFTER_DRAIN = false;
    bf16* K2; bf16* V2; const unsigned long long* SSQ; const float* SSQPE; const float* RG; const float* kg;
    __device__ __forceinline__ void operator()(const pg8::f32x4 (&acc)[2][2][4][2], const pg8::Unit& u, int wr, int wc, int fr, int fq) const {
        const int row0 = u.pm * pg8::BM + wr * 64 + fr;
        if (u.pn < 4) {
            const int head = 4 * u.pn + wc;
            f32x4 g1[2], g2[2];
#pragma unroll
            for (int n = 0; n < 2; ++n) { g1[n] = *(const f32x4*)(kg + 8 * fq + 4 * n); g2[n] = *(const f32x4*)(kg + 32 + 8 * fq + 4 * n); }
            float rsv[8], pev[8];
#pragma unroll
            for (int i = 0; i < 8; ++i) { const int row = row0 + (i >> 2) * pg8::HALF + (i & 3) * 16; rsv[i] = rstd_of(SSQ, row, 1.0f / 256.0f); pev[i] = SSQPE[row]; }
            f32x4 rgn0, rgn1; { const float* rg = RG + (size_t)row0 * 32 + 8 * fq; rgn0 = *(const f32x4*)rg; rgn1 = *(const f32x4*)(rg + 4); }
#pragma unroll
            for (int i = 0; i < 8; ++i) { const int row = row0 + (i >> 2) * pg8::HALF + (i & 3) * 16; const float rs = rsv[i];
                    const f32x4 rgc0 = rgn0, rgc1 = rgn1;
                    if (i < 7) { const float* rg = RG + (size_t)(row0 + ((i + 1) >> 2) * pg8::HALF + ((i + 1) & 3) * 16) * 32 + 8 * fq; rgn0 = *(const f32x4*)rg; rgn1 = *(const f32x4*)(rg + 4); }
                    const int ai = i >> 2, m = i & 3;
                    f32x4 a[2], b[2]; float s = 0.f;
#pragma unroll
                    for (int n = 0; n < 2; ++n) { a[n] = acc[ai][0][m][n] * rs; b[n] = acc[ai][1][m][n] * rs; s += (a[n][0] * a[n][0] + a[n][1] * a[n][1]) + (a[n][2] * a[n][2] + a[n][3] * a[n][3]) + (b[n][0] * b[n][0] + b[n][1] * b[n][1]) + (b[n][2] * b[n][2] + b[n][3] * b[n][3]); }
                    s += __shfl_xor(s, 16); s += __shfl_xor(s, 32);
                    const float rh = __builtin_amdgcn_rsqf((s + pev[i]) * (1.f / 96.f) + EPS);
                    const int pos = row & 2047; bf16* rp = K2 + ((((size_t)(row >> 11) * 16 + head) * 32 + (pos >> 6)) * 12 + fq) * 512 + (pos & 63) * 8;
                    { const f32x4 o0 = a[0] * rh * g1[0], o1 = a[1] * rh * g1[1]; v4u w; w.x = pk2(o0[0], o0[1]); w.y = pk2(o0[2], o0[3]); w.z = pk2(o1[0], o1[1]); w.w = pk2(o1[2], o1[3]); *(v4u*)rp = w; }
                    { const f32x4 o0 = b[0] * rh * g2[0], o1 = b[1] * rh * g2[1]; v4u w; w.x = pk2(o0[0], o0[1]); w.y = pk2(o0[2], o0[3]); w.z = pk2(o1[0], o1[1]); w.w = pk2(o1[2], o1[3]); *(v4u*)(rp + 4 * 512) = w; }
                    { const f32x4 o0 = rgc0 * rh, o1 = rgc1 * rh; v4u w; w.x = pk2(o0[0], o0[1]); w.y = pk2(o0[2], o0[3]); w.z = pk2(o1[0], o1[1]); w.w = pk2(o1[2], o1[3]); *(v4u*)(rp + 8 * 512) = w; }
                    asm volatile("" ::: "memory"); }
        } else {
            bf16* dst = V2 + (u.pn - 4) * 256 + wc * 32 + 8 * fq;
#pragma unroll
            for (int ai = 0; ai < 2; ++ai)
#pragma unroll
                for (int m = 0; m < 4; ++m) { const int row = row0 + ai * pg8::HALF + m * 16; const float rs = rstd_of(SSQ, row, 1.0f / 256.0f); bf16* rp = dst + (size_t)row * 1024;
#pragma unroll
                    for (int bj = 0; bj < 2; ++bj) { const f32x4 v0 = acc[ai][bj][m][0] * rs, v1 = acc[ai][bj][m][1] * rs;
                        v4u w; w.x = pk2(v0[0], v0[1]); w.y = pk2(v0[2], v0[3]); w.z = pk2(v1[0], v1[1]); w.w = pk2(v1[2], v1[3]); *(v4u*)(rp + bj * pg8::HALF) = w; } }
        }
    }
};

struct EpiIn0 {
    static constexpr bool PERM = true, AFTER_DRAIN = false;
    bf16* QK; bf16* KC; const float* TAB; const float* qn; const float* kn; float* KM; float* DTR;
    __device__ __forceinline__ void operator()(const pg8::f32x4 (&acc)[2][2][4][2], const pg8::Unit& u, int wr, int wc, int fr, int fq) const {
        const int row0 = u.pm * pg8::BM + wr * 64 + fr;
        if (u.pn < 4) {
            const bool isq = u.pn < 2; const float* gn = isq ? qn : kn; const int head = 4 * (u.pn & 1) + wc;
            bf16* dst = QK + (isq ? 0 : 512) + head * 64 + 8 * fq;
            f32x4 g1[2], g2[2], ks1[2], ks2[2];
#pragma unroll
            for (int n = 0; n < 2; ++n) { g1[n] = *(const f32x4*)(gn + 8 * fq + 4 * n); g2[n] = *(const f32x4*)(gn + 32 + 8 * fq + 4 * n); ks1[n] = (f32x4){0.f, 0.f, 0.f, 0.f}; ks2[n] = ks1[n]; }
#pragma unroll
            for (int ai = 0; ai < 2; ++ai)
#pragma unroll
                for (int m = 0; m < 4; ++m) { const int row = row0 + ai * pg8::HALF + m * 16, pos = row & 2047;
                    float s = 0.f;
#pragma unroll
                    for (int n = 0; n < 2; ++n) { const f32x4 a = acc[ai][0][m][n], b = acc[ai][1][m][n]; s += (a[0] * a[0] + a[1] * a[1]) + (a[2] * a[2] + a[3] * a[3]) + (b[0] * b[0] + b[1] * b[1]) + (b[2] * b[2] + b[3] * b[3]); }
                    s += __shfl_xor(s, 16); s += __shfl_xor(s, 32);
                    float rstd = 1.f / sqrtf(s * (1.f / 64.f) + EPS); if (isq) rstd *= 0.18033688011112042f;
                    f32x4 o1[2], o2[2];
#pragma unroll
                    for (int n = 0; n < 2; ++n) { const float* tb = TAB + (pos * 32 + 8 * fq + 4 * n) * 2; const f32x4 t0 = *(const f32x4*)tb, t1 = *(const f32x4*)(tb + 4);
                        const f32x4 cs_ = {t0[0], t0[2], t1[0], t1[2]}, sn = {t0[1], t0[3], t1[1], t1[3]};
                        const f32x4 y1 = acc[ai][0][m][n] * rstd * g1[n], y2 = acc[ai][1][m][n] * rstd * g2[n];
                        o1[n] = y1 * cs_ - y2 * sn; o2[n] = y1 * sn + y2 * cs_; ks1[n] += o1[n]; ks2[n] += o2[n]; }
                    bf16* rp = dst + (size_t)row * 1024; int st2 = 32;
                    if (!isq) { rp = KC + ((((size_t)(row >> 11) * 8 + head) * 32 + (pos >> 6)) * 8 + fq) * 512 + (pos & 63) * 8; st2 = 4 * 512; }
                    { v4u w; w.x = pk2(o1[0][0], o1[0][1]); w.y = pk2(o1[0][2], o1[0][3]); w.z = pk2(o1[1][0], o1[1][1]); w.w = pk2(o1[1][2], o1[1][3]); *(v4u*)rp = w; }
                    { v4u w; w.x = pk2(o2[0][0], o2[0][1]); w.y = pk2(o2[0][2], o2[0][3]); w.z = pk2(o2[1][0], o2[1][1]); w.w = pk2(o2[1][2], o2[1][3]); *(v4u*)(rp + st2) = w; }
                    asm volatile("" ::: "memory"); }
            if (!isq) {
                float* km = KM + (((size_t)(u.pm >> 3) * 8 + (u.pm & 7)) * 8 + head) * 64 + 8 * fq;
#pragma unroll
                for (int n = 0; n < 2; ++n)
#pragma unroll
                    for (int j = 0; j < 4; ++j) { float a = ks1[n][j], b = ks2[n][j];
#pragma unroll
                        for (int o = 1; o < 16; o <<= 1) { a += __shfl_xor(a, o); b += __shfl_xor(b, o); }
                        if (fr == 0) { atomicAdd(km + 4 * n + j, a * (1.f / 256.f)); atomicAdd(km + 32 + 4 * n + j, b * (1.f / 256.f)); } } }
        } else if (u.pn < 12) {
            bf16* dst = QK + (size_t)(u.pn >> 2) * ((size_t)T_ * 1024) + (u.pn & 3) * 256 + wc * 32 + 8 * fq;
#pragma unroll
            for (int ai = 0; ai < 2; ++ai)
#pragma unroll
                for (int m = 0; m < 4; ++m) { bf16* rp = dst + (size_t)(row0 + ai * pg8::HALF + m * 16) * 1024;
#pragma unroll
                    for (int bj = 0; bj < 2; ++bj) { const f32x4 v0 = acc[ai][bj][m][0], v1 = acc[ai][bj][m][1];
                        v4u w; w.x = pk2(v0[0], v0[1]); w.y = pk2(v0[2], v0[3]); w.z = pk2(v1[0], v1[1]); w.w = pk2(v1[2], v1[3]); *(v4u*)(rp + bj * pg8::HALF) = w; } }
        } else if (wc == 0 && fq == 0) {
#pragma unroll
            for (int ai = 0; ai < 2; ++ai)
#pragma unroll
                for (int m = 0; m < 4; ++m) { float* rp = DTR + (size_t)(row0 + ai * pg8::HALF + m * 16) * 8; *(f32x4*)rp = acc[ai][0][m][0]; *(f32x4*)(rp + 4) = acc[ai][0][m][1]; }
        }
    }
};

__device__ __forceinline__ void ffn_fix_rows(int i0, int i1, int step, const bf16* UB, bf16* ACT, const float* cw, const float* cb) {
#pragma unroll 1
    for (int il = i0; il < i1; il += step) {
        const int c0 = (il % (DFF / 8)) * 8, rr = (il / (DFF / 8)) & 1, ck = il / (2 * (DFF / 8)); const bool first = (ck & 31) == 0;
        v4u wg[3], wu[3]; f32x4 kg[3][2], ku[3][2]; float vm[3];
#pragma unroll
        for (int k = 0; k < 3; ++k) { const int rel = rr - 2 + k; const bool ok = (rel >= 0) || !first;
            const size_t srow = (rel >= 0) ? (size_t)ck * 4 + rel : (ok ? (size_t)(ck - 1) * 4 + 4 + rel : (size_t)ck * 4);
            const bf16* src = UB + srow * DFF2; wg[k] = *(const v4u*)(src + c0); wu[k] = *(const v4u*)(src + DFF + c0); vm[k] = ok ? 1.f : 0.f;
            const float* kp = cw + k * DFF2 + c0; kg[k][0] = *(const f32x4*)kp; kg[k][1] = *(const f32x4*)(kp + 4); ku[k][0] = *(const f32x4*)(kp + DFF); ku[k][1] = *(const f32x4*)(kp + DFF + 4); }
        f32x4 ag0 = *(const f32x4*)(cb + c0), ag1 = *(const f32x4*)(cb + c0 + 4), au0 = *(const f32x4*)(cb + DFF + c0), au1 = *(const f32x4*)(cb + DFF + c0 + 4);
#pragma unroll
        for (int k = 0; k < 3; ++k) {
            const f32x4 g0 = (f32x4){bflo(wg[k].x), bfhi(wg[k].x), bflo(wg[k].y), bfhi(wg[k].y)} * vm[k], g1 = (f32x4){bflo(wg[k].z), bfhi(wg[k].z), bflo(wg[k].w), bfhi(wg[k].w)} * vm[k];
            const f32x4 u0 = (f32x4){bflo(wu[k].x), bfhi(wu[k].x), bflo(wu[k].y), bfhi(wu[k].y)} * vm[k], u1 = (f32x4){bflo(wu[k].z), bfhi(wu[k].z), bflo(wu[k].w), bfhi(wu[k].w)} * vm[k];
            ag0 += kg[k][0] * g0; ag1 += kg[k][1] * g1; au0 += ku[k][0] * u0; au1 += ku[k][1] * u1; }
        f32x4 o0, o1;
#pragma unroll
        for (int j = 0; j < 4; ++j) { o0[j] = ag0[j] * __builtin_amdgcn_rcpf(1.f + __expf(-ag0[j])) * au0[j]; o1[j] = ag1[j] * __builtin_amdgcn_rcpf(1.f + __expf(-ag1[j])) * au1[j]; }
        v4u o; o.x = pk2(o0[0], o0[1]); o.y = pk2(o0[2], o0[3]); o.z = pk2(o1[0], o1[1]); o.w = pk2(o1[2], o1[3]);
        *(v4u*)(ACT + ((size_t)ck * 64 + rr) * DFF + c0) = o; }
}

template <class Epi, int AROW = 0> __device__ __forceinline__ void run_gemm(LAS unsigned char* lds, const bf16* A, const bf16* Bt, int M, int N, int K, const Epi& E, int lda = 0) {
    pg8::Gemm g{A, Bt, M, N, K, lda ? lda : K}; pg8::StaticOrder S; S.init(M, N, (int)gridDim.x, (int)blockIdx.x);
    pg8::gemm_phase<Epi, pg8::StaticOrder, PG8_ALIGN, PG8_SP2, AROW>(lds + RING_OFF, g, S, E);
}

#define NPHASES 40
__global__ void __launch_bounds__(NTHR, 2) fwd(Args args) {
    extern __shared__ __attribute__((aligned(16))) unsigned char lds_raw[];
    LAS unsigned char* lds = (LAS unsigned char*)lds_raw;
    volatile LAS unsigned* MISC = (volatile LAS unsigned*)(lds + MISC_OFF);
    {
        const int tid0 = threadIdx.x;
        for (int u = tid0; u < (LDS_BYTES - LDSCTL_OFF) / 4; u += NTHR) ((LAS unsigned*)(lds + LDSCTL_OFF))[u] = 0u;
    }
    __syncthreads();
    int lo, hi; { KArgs A0 = kargs(); lo = A0->ph_lo; hi = A0->ph_hi; }
    const bool multi = (hi - lo) > 1;
    XcdBarrier bar; bar.bar = nullptr; bar.x = 0; bar.st = nullptr;
    if (multi) { KArgs A0 = kargs(); bar = xcd_barrier_post((unsigned*)((gu32*)(A0->ws + WS_CTL) + CW_BAR), MISC + 8); }
#define IN(k) (lo <= (k) && (k) < hi)
#ifndef PROBE_MASK
#define PROBE_MASK 0u
#endif
    unsigned long long pr_acc = 0ull, pr_t = 0ull;
    if (PROBE_MASK) pr_t = __builtin_amdgcn_s_memrealtime();
#define SEAM(k) do { if (IN(k) && IN((k) + 1)) xcd_barrier(bar); \
        if (PROBE_MASK) { const unsigned long long now_ = __builtin_amdgcn_s_memrealtime(); if ((PROBE_MASK >> (k)) & 1u) pr_acc += now_ - pr_t; pr_t = now_; } } while (0)

    if (IN(0)) { PH_VARS
        LAS float* scr = (LAS float*)(lds + RING_OFF + wave * 16384);
        { f32x4 cur[8], nxt[8]; int it = gw, li = 0, ln = 0; MatDesc d{}, dn{};
          if (it < NIT_W) { d = mat_of(A_, ws, it, li); trl_load(cur, d, li, lane); }
          while (it < NIT_W) { const int nit = it + NGW; const bool more = nit < NIT_W;
              if (more) { dn = mat_of(A_, ws, nit, ln); trl_load(nxt, dn, ln, lane); }
              tr_store(cur, d.K, d.WT, scr, li, d.nblk, lane);
              if (more) {
#pragma unroll
                  for (int i = 0; i < 8; ++i) cur[i] = nxt[i];
                  d = dn; li = ln; }
              it = nit; } }
        { float* cws = (float*)(ws + WS_CWS); const float* cw_ = A_->in[22]; const float* cb_ = A_->in[23];
          for (int i = gt; i < 2 * 4 * DFF2; i += NGT) { const int l = i / (4 * DFF2), r = i - l * 4 * DFF2, k = r / DFF2, c = r - k * DFF2;
              const float v = (k < 3) ? cw_[((size_t)l * 3 + k) * DFF2 + c] : cb_[(size_t)l * DFF2 + c]; cws[i] = v * (c < DFF ? -1.44269504088896341f : -0.693147180559945309f); } }
        float* t64 = (float*)(ws + WS_TAB64); float* t32 = (float*)(ws + WS_TAB32);
        for (int i = gt; i < 2048 * 32; i += NGT) { const int pos = i >> 5, f = i & 31; const float inv = 1.0f / powf(10000.0f, (float)(2 * f) / 64.0f); const float ang = (float)pos * inv; t64[2 * i] = cosf(ang); t64[2 * i + 1] = sinf(ang); }
        for (int i = gt; i < 2048 * 16; i += NGT) { const int pos = i >> 4, f = i & 15; const float inv = 1.0f / powf(10000.0f, (float)(2 * f) / 32.0f); const float ang = (float)pos * inv; t32[2 * i] = cosf(ang); t32[2 * i + 1] = sinf(ang); }
        asm volatile("s_waitcnt vmcnt(0) lgkmcnt(0)" ::: "memory"); __syncthreads();
        { LAS f32x4* W2 = (LAS f32x4*)(lds + RING_OFF); const float* Wi = A_->in[3]; const float* gg = A_->in[1];
          for (int i = tid; i < 2048; i += NTHR) { const int ln = i & 63, sh = i >> 6, sl = sh >> 1, half = sh & 1, k = 4 * ln + 256 * (sl >> 2) + (sl & 3);
              W2[i] = *(const f32x4*)(Wi + (size_t)k * 3080 + 3072 + 4 * half) * gg[k]; }
          asm volatile("s_waitcnt vmcnt(0) lgkmcnt(0)" ::: "memory"); __syncthreads();
          rms_rows_dt(x, A_->in[1], XN, (float*)(ws + WS_DTR), W2, gw, NGW, lane); }
    }
    SEAM(0);
    if (IN(1)) { PH_VARS EpiIn0 E{(bf16*)(ws + L0_QK), (bf16*)(ws + L0_KC), TAB64, A_->in[10], A_->in[11], (float*)(ws + WS_KMEAN), (float*)(ws + WS_DTR)}; run_gemm(lds, XN, (const bf16*)(ws + WS_W_IN0), T_, 3072, 1024, E); }
    SEAM(1);
    if (IN(2)) { PH_VARS
        for (int u = blockIdx.x; u < 512; u += G) ssd::states_unit(lds, u >> 1, u & 1, (const bf16*)(ws + L0_XBC), (const float*)(ws + WS_DTR), A_->in[4], A_->in[5], A_->in[6], A_->in[7], (float*)(ws + L0_ST), (float*)(ws + WS_CEND));
    }
    SEAM(2);
    if (IN(3)) { PH_VARS
        const float* ST = (const float*)(ws + L0_ST); const float* CEND = (const float*)(ws + WS_CEND); bf16* HIN = (bf16*)(ws + L0_HIN);
        auto do_scan = [&]() {
        for (int i = gt; i < 16 * 8 * 64 * 128 / 4; i += NGT) {
            const int pn = (i & 2047) * 4, h = (i >> 11) & 7, b = i >> 14; f32x4 hst = {0.f, 0.f, 0.f, 0.f}; f32x4 tmp[16]; float dec[16];
#pragma unroll
            for (int c = 0; c < 16; ++c) { tmp[c] = *(const f32x4*)(ST + (((size_t)((b * 16 + c) * 8 + h) << 13) + pn)); dec[c] = CEND[(b * 16 + c) * 8 + h]; }
#pragma unroll
            for (int c = 0; c < 16; ++c) { const size_t idx = ((size_t)((b * 16 + c) * 8 + h) << 13) + pn;
                *(unsigned long long*)(HIN + idx) = (unsigned long long)pk2(hst.x, hst.y) | ((unsigned long long)pk2(hst.z, hst.w) << 32);
                hst = hst * __expf(dec[c]) + tmp[c]; }
        }
            asm volatile("s_waitcnt vmcnt(0) lgkmcnt(0)" ::: "memory"); };
        const bf16* QK = (const bf16*)(ws + L0_QK); const bf16* VZ = (const bf16*)(ws + L0_VZ); const float* KM = (const float*)(ws + WS_KMEAN); bf16* MIX = (bf16*)(ws + L0_MIX);
        float kb0; { float gm = fabsf(A_->in[11][lane]);
#pragma unroll
          for (int o_ = 1; o_ < 64; o_ <<= 1) gm = fmaxf(gm, __shfl_xor(gm, o_));
          kb0 = 8.0f * 1.02f * gm; }
        { int tb = 0, pbh = -1;
          int un_ = 0; const int scan_at = (int)(blockIdx.x & 3);
          for (int i = blockIdx.x; i < 1024; i += G) {
            if (un_ == scan_at) do_scan(); ++un_;
            const int s_ = i >> 8, c = i & 255, bh = c >> 1, half = c & 1, qb = (s_ & 1) ? (s_ - 1 + half) : (7 - half - s_), b = bh >> 3, h = bh & 7;
            const int in_ = i + G; const bool hn = (in_ < 1024) && (((in_ & 255) >> 1) == bh);
            at2::Tensors TT{QK + h * 64, (const bf16*)(ws + L0_KC) + (size_t)(b * 8 + h) * (32 * 8 * 512), VZ + h * 64, MIX + h * 64, 1024, 0, 1024, 1024};
            at2::attn_unit_p<64, true, false, 2>(lds, TT, (long)b * 2048, qb, KM + b * 4096 + h * 64, nullptr, nullptr, kb0, tb, pbh == bh, hn);
            tb = (tb + 4 * (qb + 1)) % 6; pbh = hn ? bh : -1; } }
    }
    SEAM(3);
    if (IN(4)) { PH_VARS
        for (int u = blockIdx.x; u < 512; u += G) ssd::out_unit(lds, u >> 1, u & 1, (const bf16*)(ws + L0_XBC), (const bf16*)(ws + L0_VZ), (const float*)(ws + WS_DTR), A_->in[4], A_->in[5], A_->in[6], A_->in[7],
                                                               (const bf16*)(ws + L0_HIN), A_->in[8], A_->in[9], (bf16*)(ws + L0_MIX));
    }
    SEAM(4);
    if (IN(5)) { PH_VARS EpiRes<false, false, true> E{nullptr, x, XN, (unsigned long long*)(ws + WS_SSQA)}; run_gemm(lds, (const bf16*)(ws + L0_MIX), (const bf16*)(ws + WS_W_OUT0), T_, 1024, 1024, E); }
    SEAM(5);
#define FFN_PHASES(P, L, AIN, SSQ_IN, LASTL, SSQ_OUT) \
    if (IN(P)) { PH_VARS EpiFfnUp E{(bf16*)(ws + FF_ACT), (bf16*)(ws + FF_UB), (const unsigned long long*)(ws + (SSQ_IN)), (const float*)(ws + WS_CWS) + (size_t)(L) * 4 * DFF2, nullptr}; \
        run_gemm<EpiFfnUp, 1>(lds, (const bf16*)(ws + (AIN)), (const bf16*)(ws + WS_W_UP) + (size_t)(L) * DFF2 * 1024, T_, DFF2, 1024, E); } \
    SEAM(P); \
    if (IN((P) + 1)) { PH_VARS ffn_fix_rows(gt, 512 * 2 * (DFF / 8), NGT, (const bf16*)(ws + FF_UB), (bf16*)(ws + FF_ACT), A_->in[22] + (size_t)(L) * 3 * DFF2, A_->in[23] + (size_t)(L) * DFF2); } \
    SEAM((P) + 1); \
    if (IN((P) + 2)) { PH_VARS EpiRes<true, LASTL, !LASTL> E{out, (const bf16*)(ws + (AIN)), (bf16*)(ws + (AIN)), (unsigned long long*)(ws + (SSQ_OUT))}; run_gemm(lds, (const bf16*)(ws + FF_ACT), (const bf16*)(ws + WS_W_DN) + (size_t)(L) * 1024 * DFF, T_, 1024, DFF, E); } \
    SEAM((P) + 2);
    FFN_PHASES(6, 0, WS_XN, WS_SSQA, false, WS_SSQB)
    if (IN(9)) { PH_VARS EpiMlaIn E{(bf16*)(ws + L1_C1), (const unsigned long long*)(ws + WS_SSQB), (unsigned long long*)(ws + WS_SSQQ), (unsigned long long*)(ws + WS_SSQKV), (float*)(ws + WS_SSQPE), (float*)(ws + WS_RG), A_->in[19], TAB32}; run_gemm(lds, XN, (const bf16*)(ws + WS_W_IN1), T_, 1024, 1024, E); }
    SEAM(9);
    if (IN(10)) { PH_VARS const bf16* C1 = (const bf16*)(ws + L1_C1);
        { EpiScale E{(bf16*)(ws + L1_QR), 1536, (const unsigned long long*)(ws + WS_SSQQ), 1.0f / 512.0f}; run_gemm(lds, C1, (const bf16*)(ws + WS_W_UQ), T_, 1536, 512, E, 1024); }
        { EpiUkv E{(bf16*)(ws + L1_K2), (bf16*)(ws + L1_V2), (const unsigned long long*)(ws + WS_SSQKV), (const float*)(ws + WS_SSQPE), (const float*)(ws + WS_RG), A_->in[19]}; run_gemm(lds, C1 + 512, (const bf16*)(ws + WS_W_UKV), T_, 2048, 256, E, 1024); } }
    SEAM(10);
    if (IN(11)) { PH_VARS
        const bf16* Q2 = (const bf16*)(ws + L1_QR); const bf16* K2 = (const bf16*)(ws + L1_K2); const bf16* V2 = (const bf16*)(ws + L1_V2); bf16* O = (bf16*)(ws + L1_O);
        float kb1; { float gm = fmaxf(fabsf(A_->in[19][lane]), (lane < 32) ? fabsf(A_->in[19][64 + lane]) : 0.f);
#pragma unroll
          for (int o_ = 1; o_ < 64; o_ <<= 1) gm = fmaxf(gm, __shfl_xor(gm, o_));
          kb1 = 9.797958971f * 1.02f * gm; }
        { int tb = 0, pbh = -1;
          for (int i = blockIdx.x; i < 2048; i += G) {
            const int s_ = i >> 8, bh = i & 255, qb = 7 - s_, b = bh >> 4, h = bh & 15;
            const int in_ = i + G; const bool hn = (in_ < 2048) && ((in_ & 255) == bh);
            at2::Tensors TT{Q2 + h * 96, K2 + (size_t)(b * 16 + h) * (32 * 12 * 512), V2 + h * 64, O + h * 64, 1536, 0, 1024, 1024};
            at2::attn_unit_p<96, false, true, 2>(lds, TT, (long)b * 2048, qb, nullptr, A_->in[18], TAB32, kb1, tb, pbh == bh, hn);
            tb = (tb + 4 * (qb + 1)) % 6; pbh = hn ? bh : -1; } }
    }
    SEAM(11);
    if (IN(12)) { PH_VARS EpiRes<true, false, true> E{nullptr, XN, (bf16*)(ws + WS_BIG), (unsigned long long*)(ws + WS_SSQC)}; run_gemm(lds, (const bf16*)(ws + L1_O), (const bf16*)(ws + WS_W_OUT1), T_, 1024, 1024, E); }
    SEAM(12);
    FFN_PHASES(13, 1, WS_BIG, WS_SSQC, true, WS_SSQB)
    if (PROBE_MASK) { if (blockIdx.x == 0 && threadIdx.x == 0) { const unsigned long long t0 = __builtin_amdgcn_s_memrealtime(); while (__builtin_amdgcn_s_memrealtime() - t0 < pr_acc) __builtin_amdgcn_s_sleep(8); } }
#undef IN
#undef SEAM
}
constexpr int LAST_PHASE = 16;

#ifndef MK_ONE_LAUNCH
#define MK_ONE_LAUNCH 1
#endif
extern "C" void kernel_launch(void* const* d_in, const int* in_sizes, int n_in, void* d_out, int out_size, void* d_ws, size_t ws_size, hipStream_t stream) {
    static int grid = 0;
    if (grid == 0) {
        if (n_in != 25 || out_size != T_ * D_ || ws_size < WS_END) { fprintf(stderr, "kernel_launch: unexpected shapes: n_in %d out %d ws %zu\n", n_in, out_size, ws_size); grid = -1; return; }
        if (hipFuncSetAttribute((const void*)fwd, hipFuncAttributeMaxDynamicSharedMemorySize, LDS_BYTES) != hipSuccess) { fprintf(stderr, "kernel_launch: hipFuncSetAttribute failed\n"); grid = -1; return; }
        int dev = 0, cus = 0, per_cu = 0;
        hipGetDevice(&dev); hipDeviceGetAttribute(&cus, hipDeviceAttributeMultiprocessorCount, dev);
        hipOccupancyMaxActiveBlocksPerMultiprocessor(&per_cu, (const void*)fwd, NTHR, LDS_BYTES);
        (void)hipGetLastError();
        grid = (per_cu >= 1) ? cus : -1;
        if (grid < 0) { fprintf(stderr, "kernel_launch: occupancy query says 0 blocks per CU\n"); return; }
    }
    if (grid < 0) return;
    hipMemsetAsync((char*)d_ws + WS_CTL, 0, CTL_ZERO_BYTES, stream);
    Args a{};
    for (int i = 0; i < 25; ++i) a.in[i] = (const float*)d_in[i];
    a.out = (float*)d_out; a.ws = (unsigned char*)d_ws;
#if MK_ONE_LAUNCH
    a.ph_lo = 0; a.ph_hi = LAST_PHASE;
    hipLaunchKernelGGL(fwd, dim3(grid), dim3(NTHR), LDS_BYTES, stream, a);
#else
    for (int p = 0; p < LAST_PHASE; ++p) { a.ph_lo = p; a.ph_hi = p + 1; hipLaunchKernelGGL(fwd, dim3(grid), dim3(NTHR), LDS_BYTES, stream, a); }
#endif
}
```

```cpp
#include <hip/hip_runtime.h>
#include <cstdio>
#include <cstdint>
namespace pg8 {
#define PG8_LAS __attribute__((address_space(3)))
typedef unsigned short bf16_t;
typedef short bf16x8 __attribute__((ext_vector_type(8)));
typedef float f32x4 __attribute__((ext_vector_type(4)));
typedef unsigned u32x4 __attribute__((ext_vector_type(4)));
constexpr int BM = 256, BK = 64, HALF = 128, HTB = HALF * BK * 2  , STAGE_BYTES = 8 * HTB, NXCD = 8, WGM = 8;

__host__ __device__ __forceinline__ int lds_byte(int r, int c) { const int st = (r >> 4) * 2 + (c >> 5), rr = r & 15, cc = c & 31, ob = rr * 64 + cc * 2; return st * 1024 + (ob ^ (((ob >> 9) & 1) << 5)); }
__host__ __device__ __forceinline__ void stage_rc(int b, int& R, int& C) { const int st = b / 1024, sb = b % 1024, swz = sb ^ (((sb >> 9) & 1) << 5); R = (st >> 1) * 16 + swz / 64; C = (st & 1) * 32 + (swz % 64) / 2; }
__host__ __device__ __forceinline__ int perm32(int rho) { const int n = rho >> 4, i = rho & 15; return 8 * (i >> 2) + 4 * n + (i & 3); }

struct Unit { int pm, pn; };
struct Gemm { const bf16_t* A; const bf16_t* Bt; int M, N, K, lda; };

struct StaticOrder {
    int nM, nN, nwg, G, c;
    __host__ __device__ __forceinline__ void init(int M, int N, int G_, int c_) { nM = M / BM; nN = N / BM; nwg = nM * nN; G = G_; c = c_; }
    __host__ __device__ __forceinline__ bool next(int i, Unit& u) const {
        const long L = (long)i * G + c; if (L >= nwg) return false;
        int wgid = (int)L; { const int q = nwg / NXCD, r = nwg % NXCD, xcd = wgid % NXCD, off = wgid / NXCD; wgid = (xcd < r ? xcd * (q + 1) : r * (q + 1) + (xcd - r) * q) + off; }
        const int nig = WGM * nN, gid = wgid / nig, fm = gid * WGM, gsz = (nM - fm) < WGM ? (nM - fm) : WGM;
        u.pm = fm + ((wgid % nig) % gsz); u.pn = (wgid % nig) / gsz; return true;
    }
    __device__ __forceinline__ void a_ready(const Unit&) const {}
    __device__ __forceinline__ void done(const Unit&) const {}
};

__device__ __forceinline__ unsigned cvt_pk_bf16(float lo, float hi) { unsigned r; asm volatile("v_cvt_pk_bf16_f32 %0, %1, %2" : "=v"(r) : "v"(lo), "v"(hi)); return r; }
typedef float f32x2 __attribute__((ext_vector_type(2)));
__device__ __forceinline__ f32x2 gelu_pk(f32x2 v) {
    const f32x2 av = __builtin_elementwise_abs(v), d = av * 0.2316418882f + 1.0f;
    f32x2 t; t.x = __builtin_amdgcn_rcpf(d.x); t.y = __builtin_amdgcn_rcpf(d.y);
    f32x2 q = t * 0.5307027145f + (-0.7265760135f); q = q * t + 0.7107068705f; q = q * t + (-0.142248368f); q = q * t + 0.127414796f; q = q * t;
    const f32x2 s = (v * v) * (-0.72134752044f);
    f32x2 e; e.x = __builtin_amdgcn_exp2f(s.x); e.y = __builtin_amdgcn_exp2f(s.y);
    const f32x2 m = v * (q * e), r = v - m;
    f32x2 o; o.x = v.x < 0.f ? m.x : r.x; o.y = v.y < 0.f ? m.y : r.y; return o;
}

template <int ACT  > struct EpiBf16 {
    static constexpr bool PERM = true, AFTER_DRAIN = false; static_assert(ACT == 0 || ACT == 1, "EpiBf16: ACT is 0 (none) or 1 (gelu_pk)");
    bf16_t* O; int ldc; const float* bias; int split_cols; size_t split_stride; float scale0;
    __device__ __forceinline__ void operator()(const f32x4 (&acc)[2][2][4][2], const Unit& u, int wr, int wc, int fr, int fq) const {
        const int row0 = u.pm * BM + wr * 64 + fr; int colt = u.pn * BM; bf16_t* base = O;
        float sc = 1.f; if (split_cols) { const int t = colt / split_cols; base += (size_t)t * split_stride; colt -= t * split_cols; if (t == 0) sc = scale0; }
        const int col0 = colt + wc * 32 + 8 * fq, bcol0 = u.pn * BM + wc * 32 + 8 * fq;
        f32x4 bv[2][2];
#pragma unroll
        for (int bj = 0; bj < 2; ++bj)
#pragma unroll
            for (int n = 0; n < 2; ++n) bv[bj][n] = bias ? *(const f32x4*)(bias + bcol0 + bj * HALF + 4 * n) : (f32x4){0.f, 0.f, 0.f, 0.f};
#pragma unroll
        for (int ai = 0; ai < 2; ++ai)
#pragma unroll
            for (int m = 0; m < 4; ++m) { bf16_t* rowp = base + (size_t)(row0 + ai * HALF + m * 16) * ldc + col0;
#pragma unroll
                for (int bj = 0; bj < 2; ++bj) { f32x4 v0 = acc[ai][bj][m][0] + bv[bj][0], v1 = acc[ai][bj][m][1] + bv[bj][1];
                    if (ACT == 1) { f32x2 a = gelu_pk((f32x2){v0[0], v0[1]}), b = gelu_pk((f32x2){v0[2], v0[3]}), c = gelu_pk((f32x2){v1[0], v1[1]}), d = gelu_pk((f32x2){v1[2], v1[3]});
                        v0 = (f32x4){a.x, a.y, b.x, b.y}; v1 = (f32x4){c.x, c.y, d.x, d.y}; }
                    v0 = v0 * sc; v1 = v1 * sc; u32x4 w; w.x = cvt_pk_bf16(v0[0], v0[1]); w.y = cvt_pk_bf16(v0[2], v0[3]); w.z = cvt_pk_bf16(v1[0], v1[1]); w.w = cvt_pk_bf16(v1[2], v1[3]);
                    *(u32x4*)(rowp + bj * HALF) = w; } }
    }
};

struct PanelStats {
    unsigned* xbuf;
    unsigned* cnt;
    unsigned* tmo;
    int ntn; float eps;
    unsigned code;
    __device__ __forceinline__ bool run(const f32x4 (&v)[2][2][4][2], const Unit& u, int wr, int wc, int fr, int fq, PG8_LAS unsigned char* lds, int wid, int lane) const {
        typedef float f32x2v __attribute__((ext_vector_type(2)));
        PG8_LAS f32x2v* P = (PG8_LAS f32x2v*)lds;
        PG8_LAS f32x2v* S = (PG8_LAS f32x2v*)(lds + 8192);
        PG8_LAS unsigned* flag = (PG8_LAS unsigned*)(lds + 8192 + 2048);
#pragma unroll
        for (int ai = 0; ai < 2; ++ai)
#pragma unroll
            for (int m = 0; m < 4; ++m) {
                float s = 0.f;
#pragma unroll
                for (int bj = 0; bj < 2; ++bj)
#pragma unroll
                    for (int n = 0; n < 2; ++n) { const f32x4 x = v[ai][bj][m][n]; s += (x[0] + x[1]) + (x[2] + x[3]); }
                s += __shfl_xor(s, 16); s += __shfl_xor(s, 32);
                const float mw = s * (1.0f / 64.0f); float q = 0.f;
#pragma unroll
                for (int bj = 0; bj < 2; ++bj)
#pragma unroll
                    for (int n = 0; n < 2; ++n) { const f32x4 d = v[ai][bj][m][n] - mw; q += (d[0] * d[0] + d[1] * d[1]) + (d[2] * d[2] + d[3] * d[3]); }
                q += __shfl_xor(q, 16); q += __shfl_xor(q, 32);
                if (fq == 0) P[(ai * HALF + wr * 64 + m * 16 + fr) * 4 + wc] = (f32x2v){mw, q};
            }
        asm volatile("s_waitcnt lgkmcnt(0)" ::: "memory"); __builtin_amdgcn_s_barrier(); asm volatile("" ::: "memory");
#if defined(BROKEN_EXCHANGE_NO_WAIT)
#warning BROKEN CONTROL BUILD: the row-statistics exchange does not wait; results are wrong by design
        if (blockIdx.x >= 64) { const long long t0_ = clock64(); while (clock64() - t0_ < 60000) __builtin_amdgcn_s_sleep(8); }
#endif
        const int row = wid * 32 + (lane & 31);
        if (lane < 32) {
            const f32x2v a = P[row * 4 + 0], b = P[row * 4 + 1], c = P[row * 4 + 2], d = P[row * 4 + 3];
            const float mt = (a.x + b.x + c.x + d.x) * 0.25f;
            const float da = a.x - mt, db = b.x - mt, dc = c.x - mt, dd = d.x - mt;
            const float m2 = (a.y + b.y) + (c.y + d.y) + 64.0f * ((da * da + db * db) + (dc * dc + dd * dd));
            unsigned long long* slot = (unsigned long long*)xbuf + ((size_t)(u.pm * BM + row) * 4 + u.pn);
            __hip_atomic_store(slot, ((unsigned long long)__float_as_uint(m2) << 32) | __float_as_uint(mt), __ATOMIC_RELAXED, __HIP_MEMORY_SCOPE_AGENT);
        }
        asm volatile("s_waitcnt vmcnt(0)" ::: "memory");
        if (lane == 0) __hip_atomic_fetch_add(cnt + 64 * u.pm, 1u, __ATOMIC_RELAXED, __HIP_MEMORY_SCOPE_AGENT);
        if (wid == 0) {
            bool dead = false; const unsigned long long t0 = __builtin_amdgcn_s_memrealtime(); const unsigned want = 8u * (unsigned)ntn;
            for (;;) {
#if defined(BROKEN_EXCHANGE_NO_WAIT)
                break;
#endif
                if ((unsigned)__builtin_amdgcn_readfirstlane(__hip_atomic_load(cnt + 64 * u.pm, __ATOMIC_RELAXED, __HIP_MEMORY_SCOPE_AGENT)) >= want) break;
                if (__builtin_amdgcn_s_memrealtime() - t0 > 2000000ull) {
                    if (lane == 0) { unsigned expect = 0u; __hip_atomic_compare_exchange_strong(tmo + 1, &expect, code | (unsigned)(u.pm & 0xff), __ATOMIC_RELAXED, __ATOMIC_RELAXED, __HIP_MEMORY_SCOPE_AGENT);
                                     __hip_atomic_store(tmo, 1u, __ATOMIC_RELAXED, __HIP_MEMORY_SCOPE_AGENT); }
                    dead = true; break; }
                __builtin_amdgcn_s_sleep(2);
            }
            __builtin_amdgcn_fence(__ATOMIC_ACQUIRE, "agent");
            if (lane == 0) flag[0] = dead ? 1u : 0u;
        }
        asm volatile("s_waitcnt vmcnt(0) lgkmcnt(0)" ::: "memory"); __builtin_amdgcn_s_barrier(); asm volatile("" ::: "memory");
        const bool bad = flag[0] != 0u;
        if (lane < 32) {
            const unsigned long long* slot = (const unsigned long long*)xbuf + (size_t)(u.pm * BM + row) * 4; float mt[4], m2[4]; float ms = 0.f;
#pragma unroll
            for (int t = 0; t < 4; ++t) { if (t < ntn) { const unsigned long long w = __hip_atomic_load(slot + t, __ATOMIC_RELAXED, __HIP_MEMORY_SCOPE_AGENT); mt[t] = __uint_as_float((unsigned)w); m2[t] = __uint_as_float((unsigned)(w >> 32)); } else { mt[t] = 0.f; m2[t] = 0.f; } ms += mt[t]; }
            const float mean = ms / (float)ntn; float q = 0.f;
#pragma unroll
            for (int t = 0; t < 4; ++t) if (t < ntn) { const float dm = mt[t] - mean; q += m2[t] + 256.0f * dm * dm; }
            S[row] = (f32x2v){mean, 1.0f / sqrtf(q / (256.0f * (float)ntn) + eps)};
        }
        asm volatile("s_waitcnt lgkmcnt(0)" ::: "memory"); __builtin_amdgcn_s_barrier(); asm volatile("" ::: "memory");
        return bad;
    }
};
struct EpiLnRes {
    static constexpr bool PERM = false, AFTER_DRAIN = true;
    const float* base; float* out; int ldc; const float* bias; PanelStats st; unsigned poison;
    __device__ __forceinline__ void fused(f32x4 (&acc)[2][2][4][2], const Unit& u, int wr, int wc, int fr, int fq, PG8_LAS unsigned char* lds, int wid, int lane) const {
        typedef float f32x2v __attribute__((ext_vector_type(2)));
        const PG8_LAS f32x2v* S = (const PG8_LAS f32x2v*)(lds + 8192);
        const int col0 = u.pn * BM + wc * 32 + 4 * fq;
#pragma unroll
        for (int bj = 0; bj < 2; ++bj)
#pragma unroll
            for (int n = 0; n < 2; ++n) { const f32x4 bv = bias ? *(const f32x4*)(bias + col0 + bj * HALF + n * 16) : (f32x4){0.f, 0.f, 0.f, 0.f};
#pragma unroll
                for (int ai = 0; ai < 2; ++ai)
#pragma unroll
                    for (int m = 0; m < 4; ++m) acc[ai][bj][m][n] += bv; }
        f32x4 pre[4][2][2];
#pragma unroll
        for (int m = 0; m < 4; ++m) { const size_t off = (size_t)(u.pm * BM + wr * 64 + m * 16 + fr) * ldc + col0;
#pragma unroll
            for (int bj = 0; bj < 2; ++bj)
#pragma unroll
                for (int n = 0; n < 2; ++n) pre[m][bj][n] = *(const f32x4*)(base + off + bj * HALF + n * 16); }
        const bool bad = st.run(acc, u, wr, wc, fr, fq, lds, wid, lane) || poison != 0u;
        const float qnan = __builtin_nanf("");
#pragma unroll
        for (int ai = 0; ai < 2; ++ai)
#pragma unroll
            for (int m = 0; m < 4; ++m) { const int r = ai * HALF + wr * 64 + m * 16 + fr; const f32x2v sr = S[r]; const size_t off = (size_t)(u.pm * BM + r) * ldc + col0;
#pragma unroll
                for (int bj = 0; bj < 2; ++bj)
#pragma unroll
                    for (int n = 0; n < 2; ++n) { const f32x4 bs = ai == 0 ? pre[m][bj][n] : *(const f32x4*)(base + off + bj * HALF + n * 16); f32x4 o = bs + (acc[ai][bj][m][n] - sr.x) * sr.y;
                        if (bad) o = (f32x4){qnan, qnan, qnan, qnan}; *(f32x4*)(out + off + bj * HALF + n * 16) = o; }
                if (m & 1) asm volatile("" ::: "memory"); }
    }
};
struct EpiLnResLn {
    static constexpr bool PERM = false, AFTER_DRAIN = true;
    const float* base; float* out; bf16_t* xn; int ldc; const float* bias; PanelStats st1, st2; unsigned poison;
    __device__ __forceinline__ void fused(f32x4 (&acc)[2][2][4][2], const Unit& u, int wr, int wc, int fr, int fq, PG8_LAS unsigned char* lds, int wid, int lane) const {
        typedef float f32x2v __attribute__((ext_vector_type(2))); typedef unsigned u32x2v __attribute__((ext_vector_type(2)));
        const PG8_LAS f32x2v* S = (const PG8_LAS f32x2v*)(lds + 8192);
        const int col0 = u.pn * BM + wc * 32 + 4 * fq;
#pragma unroll
        for (int bj = 0; bj < 2; ++bj)
#pragma unroll
            for (int n = 0; n < 2; ++n) { const f32x4 bv = bias ? *(const f32x4*)(bias + col0 + bj * HALF + n * 16) : (f32x4){0.f, 0.f, 0.f, 0.f};
#pragma unroll
                for (int ai = 0; ai < 2; ++ai)
#pragma unroll
                    for (int m = 0; m < 4; ++m) acc[ai][bj][m][n] += bv; }
        bool bad = st1.run(acc, u, wr, wc, fr, fq, lds, wid, lane) || poison != 0u;
        const float qnan = __builtin_nanf("");
#pragma unroll
        for (int ai = 0; ai < 2; ++ai)
#pragma unroll
            for (int m = 0; m < 4; ++m) { const int r = ai * HALF + wr * 64 + m * 16 + fr; const f32x2v sr = S[r]; const size_t off = (size_t)(u.pm * BM + r) * ldc + col0;
#pragma unroll
                for (int bj = 0; bj < 2; ++bj)
#pragma unroll
                    for (int n = 0; n < 2; ++n) { const f32x4 bs = *(const f32x4*)(base + off + bj * HALF + n * 16); acc[ai][bj][m][n] = bs + (acc[ai][bj][m][n] - sr.x) * sr.y; }
                asm volatile("" : "+v"(acc[ai][0][m][0]), "+v"(acc[ai][0][m][1]), "+v"(acc[ai][1][m][0]), "+v"(acc[ai][1][m][1]));
                if (m & 1) asm volatile("" ::: "memory"); }
        const bool bad1 = bad;
        bad = st2.run(acc, u, wr, wc, fr, fq, lds, wid, lane) || bad;
#pragma unroll
        for (int ai = 0; ai < 2; ++ai)
#pragma unroll
            for (int m = 0; m < 4; ++m) { const int r = ai * HALF + wr * 64 + m * 16 + fr; const f32x2v sr = S[r]; const size_t off = (size_t)(u.pm * BM + r) * ldc + col0;
#pragma unroll
                for (int bj = 0; bj < 2; ++bj)
#pragma unroll
                    for (int n = 0; n < 2; ++n) { const f32x4 x1 = acc[ai][bj][m][n]; *(f32x4*)(out + off + bj * HALF + n * 16) = bad1 ? (f32x4){qnan, qnan, qnan, qnan} : x1;
                        const f32x4 o = (x1 - sr.x) * sr.y; u32x2v w; w.x = cvt_pk_bf16(o[0], o[1]); w.y = cvt_pk_bf16(o[2], o[3]);
                        if (bad) { w.x = 0x7fc07fc0u; w.y = 0x7fc07fc0u; } *(u32x2v*)(xn + off + bj * HALF + n * 16) = w; }
                asm volatile("" ::: "memory"); }
    }
};

template <class T, class = void> struct epi_touch_t { static constexpr bool value = false; };
template <class T> struct epi_touch_t<T, decltype((void)T::TOUCH)> { static constexpr bool value = T::TOUCH; };
template <class Epi, class Sched, bool ALIGN_EPI = false, bool SP2 = false, int AROW = 0>
__device__ __forceinline__ void gemm_phase(PG8_LAS unsigned char* lds, const Gemm g, const Sched& S, const Epi& E) {
    int tid_ = threadIdx.x; asm volatile("" : "+v"(tid_));
    const int tid = tid_, wid = __builtin_amdgcn_readfirstlane(tid >> 6), lane = tid & 63, wr = wid >> 2, wc = wid & 3, fr = lane & 15, fq = lane >> 4;
    const int K = g.K, nt = K / BK;
    unsigned voffA[2], voffB[2];
#pragma unroll
    for (int i = 0; i < 2; ++i) { int R, C; stage_rc(tid * 16 + i * 8192, R, C); const int Rb = Epi::PERM ? ((R & ~31) + perm32(R & 31)) : R;
        const int Ra = (AROW == 1) ? ((R & ~63) + 4 * (R & 15) + ((R >> 4) & 3)) : (AROW == 3) ? (128 * (R >> 6) + 8 * (R & 15) + ((R >> 4) & 3)) : R;
        voffA[i] = (unsigned)(Ra * g.lda + C) * 2u; voffB[i] = (unsigned)(Rb * K + C) * 2u;
        if (AROW == 2) { const int tp = 4 * ((lane >> 2) & 3) + (lane >> 4), c = lane & 3;
            voffA[i] = (unsigned)((64 * i + 16 * (wid & 3) + tp) * g.lda + 32 * (wid >> 2) + 8 * c) * 2u; } }
    const size_t kstep = (size_t)(BK * 2);
    const size_t hstep = (size_t)HALF * K * 2;
    const size_t tstep = 2 * hstep;
    const size_t tstepA = (size_t)2 * HALF * g.lda * 2, hstepA = (AROW == 3) ? (size_t)4 * g.lda * 2 : tstepA / 2;
    const unsigned ldsw = (unsigned)wid * 1024u;
    constexpr int PSTR = 1056, HTBA = (AROW == 2) ? 16 * PSTR : HTB;
    const int aoff = (AROW == 2) ? (wr * 8 + (fr >> 2)) * PSTR + 64 * (fr & 3) + 16 * fq : lds_byte(wr * 64 + fr, fq * 8), boff = lds_byte(wc * 32 + fr, fq * 8);
    constexpr int AM = (AROW == 2) ? 256 : 2048, AK = (AROW == 2) ? 4 * PSTR : 1024;
    const unsigned ldswA = (AROW == 2) ? (unsigned)wid * PSTR : (unsigned)wid * 1024u; constexpr unsigned ISTRA = (AROW == 2) ? 8u * PSTR : 8192u;
#define PG8_SA(b, h) (((b) * 2 + (h)) * HTBA)
#define PG8_SB(b, h) (4 * HTBA + ((b) * 2 + (h)) * HTB)
#define PG8_STAGEA(bufoff, gbase, voff) do { _Pragma("unroll") for (int _i = 0; _i < 2; ++_i) \
        __builtin_amdgcn_global_load_lds((const unsigned*)((const char*)(gbase) + (voff)[_i]), (PG8_LAS unsigned*)(lds + (bufoff) + ldswA + _i * ISTRA), 16, 0, 0); } while (0)
#define PG8_STAGE(bufoff, gbase, voff) do { _Pragma("unroll") for (int _i = 0; _i < 2; ++_i) \
        __builtin_amdgcn_global_load_lds((const unsigned*)((const char*)(gbase) + (voff)[_i]), (PG8_LAS unsigned*)(lds + (bufoff) + ldsw + _i * 8192), 16, 0, 0); } while (0)
#define PG8_LDA(dst, b, h) do { _Pragma("unroll") for (int m = 0; m < 4; ++m) _Pragma("unroll") for (int k = 0; k < 2; ++k) dst[m][k] = *(const PG8_LAS bf16x8*)(lds + PG8_SA(b, h) + aoff + m * AM + k * AK); } while (0)
#define PG8_LDB(dst, b, h) do { _Pragma("unroll") for (int n = 0; n < 2; ++n) _Pragma("unroll") for (int k = 0; k < 2; ++k) dst[n][k] = *(const PG8_LAS bf16x8*)(lds + PG8_SB(b, h) + boff + n * 2048 + k * 1024); } while (0)
#define PG8_MMA(ai, bj, At, Bt) do { __builtin_amdgcn_s_setprio(1); _Pragma("unroll") for (int m = 0; m < 4; ++m) _Pragma("unroll") for (int n = 0; n < 2; ++n) _Pragma("unroll") for (int k = 0; k < 2; ++k) \
        acc[ai][bj][m][n] = __builtin_amdgcn_mfma_f32_16x16x32_bf16(Bt[n][k], At[m][k], acc[ai][bj][m][n], 0, 0, 0); __builtin_amdgcn_s_setprio(0); } while (0)
#define PG8_WAIT_V(n) asm volatile("s_waitcnt vmcnt(" #n ")" ::: "memory")
#define PG8_WAIT_L(n) asm volatile("s_waitcnt lgkmcnt(" #n ")" ::: "memory")
#define PG8_BAR __builtin_amdgcn_s_barrier()
#define PG8_SCHED __builtin_amdgcn_sched_barrier(0)
    Unit cur, nxt; int ui = 0;
    if (!S.next(0, cur)) return;
    f32x4 acc[2][2][4][2];
#pragma unroll
    for (int a = 0; a < 2; ++a)
#pragma unroll
        for (int b = 0; b < 2; ++b)
#pragma unroll
            for (int m = 0; m < 4; ++m)
#pragma unroll
                for (int n = 0; n < 2; ++n) acc[a][b][m][n] = (f32x4){0.f, 0.f, 0.f, 0.f};
    bf16x8 At[4][2], B0[2][2], B1[2][2];
    const char* cA = (const char*)g.A + (size_t)cur.pm * tstepA; const char* cB = (const char*)g.Bt + (size_t)cur.pn * tstep;
    S.a_ready(cur);
    if constexpr (epi_touch_t<Epi>::value) E.touch(cur, lds + STAGE_BYTES, wid, lane);
    if constexpr (SP2) {
        PG8_STAGE(PG8_SB(0, 0), cB, voffB); PG8_STAGE(PG8_SB(0, 1), cB + hstep, voffB); PG8_STAGEA(PG8_SA(0, 0), cA, voffA); PG8_STAGEA(PG8_SA(0, 1), cA + hstepA, voffA);
        if (wr == 1) PG8_BAR;
        PG8_WAIT_V(2); PG8_BAR;
        PG8_STAGE(PG8_SB(1, 0), cB + kstep, voffB); PG8_STAGEA(PG8_SA(1, 0), cA + kstep, voffA); PG8_STAGE(PG8_SB(1, 1), cB + hstep + kstep, voffB);
        PG8_WAIT_V(6); PG8_BAR;
    } else {
        PG8_STAGE(PG8_SB(0, 0), cB, voffB); PG8_STAGEA(PG8_SA(0, 0), cA, voffA); PG8_STAGE(PG8_SB(0, 1), cB + hstep, voffB); PG8_STAGEA(PG8_SA(0, 1), cA + hstepA, voffA);
        if (wr == 1) PG8_BAR;
        PG8_WAIT_V(4); PG8_BAR;
        PG8_STAGE(PG8_SB(1, 0), cB + kstep, voffB); PG8_STAGEA(PG8_SA(1, 0), cA + kstep, voffA); PG8_STAGE(PG8_SB(1, 1), cB + hstep + kstep, voffB);
        PG8_WAIT_V(6); PG8_BAR;
    }
    for (;;) {
        const bool has_next = S.next(ui + 1, nxt);
        const char* nA = has_next ? (const char*)g.A + (size_t)nxt.pm * tstepA : cA; const char* nB = has_next ? (const char*)g.Bt + (size_t)nxt.pn * tstep : cB;
#pragma unroll 1
        for (int t = 0; t < nt; t += 2) {
            const bool last = (t == nt - 2);
            const char* a1 = cA + (size_t)(t + 1) * kstep;
            const char* a2 = last ? nA : cA + (size_t)(t + 2) * kstep; const char* b2 = last ? nB : cB + (size_t)(t + 2) * kstep;
            const char* a3 = a2 + kstep; const char* b3 = b2 + kstep;
            if (last && has_next) S.a_ready(nxt);
            if constexpr (SP2) {
            PG8_LDB(B0, 0, 0); PG8_LDB(B1, 0, 1); PG8_SCHED; PG8_LDA(At, 0, 0); PG8_STAGEA(PG8_SA(1, 1), a1 + hstepA, voffA);
            PG8_WAIT_V(8); PG8_WAIT_L(0); PG8_BAR; PG8_MMA(0, 0, At, B0); PG8_MMA(0, 1, At, B1); PG8_BAR; PG8_SCHED;
            PG8_LDA(At, 0, 1); PG8_STAGE(PG8_SB(0, 0), b2, voffB); PG8_STAGE(PG8_SB(0, 1), b2 + hstep, voffB); PG8_STAGEA(PG8_SA(0, 0), a2, voffA);
            PG8_WAIT_V(8); PG8_WAIT_L(0); PG8_BAR; PG8_MMA(1, 0, At, B0); PG8_MMA(1, 1, At, B1); PG8_BAR; PG8_SCHED;
            PG8_LDB(B0, 1, 0); PG8_LDB(B1, 1, 1); PG8_SCHED; PG8_LDA(At, 1, 0); PG8_STAGEA(PG8_SA(0, 1), a2 + hstepA, voffA);
            PG8_WAIT_V(8); PG8_WAIT_L(0); PG8_BAR; PG8_MMA(0, 0, At, B0); PG8_MMA(0, 1, At, B1); PG8_BAR; PG8_SCHED;
            PG8_LDA(At, 1, 1); PG8_STAGE(PG8_SB(1, 0), b3, voffB); PG8_STAGE(PG8_SB(1, 1), b3 + hstep, voffB); PG8_STAGEA(PG8_SA(1, 0), a3, voffA);
            PG8_WAIT_V(8); PG8_WAIT_L(0); PG8_BAR; PG8_MMA(1, 0, At, B0); PG8_MMA(1, 1, At, B1); PG8_BAR; PG8_SCHED;
            } else {
            PG8_LDB(B0, 0, 0); PG8_SCHED; PG8_LDA(At, 0, 0); PG8_STAGEA(PG8_SA(1, 1), a1 + hstepA, voffA);
            PG8_WAIT_L(8); PG8_BAR; PG8_WAIT_L(0); PG8_MMA(0, 0, At, B0); PG8_BAR; PG8_SCHED;
            PG8_LDB(B1, 0, 1); PG8_STAGE(PG8_SB(0, 0), b2, voffB);
            PG8_BAR; PG8_WAIT_L(0); PG8_MMA(0, 1, At, B1); PG8_BAR;
            PG8_LDA(At, 0, 1); PG8_STAGEA(PG8_SA(0, 0), a2, voffA);
            PG8_BAR; PG8_WAIT_L(0); PG8_MMA(1, 0, At, B0); PG8_BAR; PG8_SCHED;
            PG8_STAGE(PG8_SB(0, 1), b2 + hstep, voffB);
            PG8_WAIT_V(6); PG8_BAR; PG8_MMA(1, 1, At, B1); PG8_BAR;
            PG8_LDB(B0, 1, 0); PG8_SCHED; PG8_LDA(At, 1, 0); PG8_STAGEA(PG8_SA(0, 1), a2 + hstepA, voffA);
            PG8_WAIT_L(8); PG8_BAR; PG8_WAIT_L(0); PG8_MMA(0, 0, At, B0); PG8_BAR; PG8_SCHED;
            PG8_LDB(B1, 1, 1); PG8_STAGE(PG8_SB(1, 0), b3, voffB);
            PG8_BAR; PG8_WAIT_L(0); PG8_MMA(0, 1, At, B1); PG8_BAR;
            PG8_LDA(At, 1, 1); PG8_STAGEA(PG8_SA(1, 0), a3, voffA);
            PG8_BAR; PG8_WAIT_L(0); PG8_MMA(1, 0, At, B0); PG8_BAR; PG8_SCHED;
            PG8_STAGE(PG8_SB(1, 1), b3 + hstep, voffB);
            PG8_WAIT_V(6); PG8_BAR; PG8_MMA(1, 1, At, B1); PG8_BAR;
            }
        }
        if constexpr (ALIGN_EPI) { if (wr == 0) PG8_BAR; }
        if constexpr (epi_touch_t<Epi>::value) { if (has_next) E.touch(nxt, lds + STAGE_BYTES, wid, lane); }
        if constexpr (!Epi::AFTER_DRAIN) { E(acc, cur, wr, wc, fr, fq); S.done(cur); }
        if (!has_next) break;
#pragma unroll
        for (int a = 0; a < 2; ++a)
#pragma unroll
            for (int b = 0; b < 2; ++b)
#pragma unroll
                for (int m = 0; m < 4; ++m)
#pragma unroll
                    for (int n = 0; n < 2; ++n) acc[a][b][m][n] = (f32x4){0.f, 0.f, 0.f, 0.f};
        cur = nxt; cA = nA; cB = nB; ++ui;
        if constexpr (ALIGN_EPI) { if (wr == 1) PG8_BAR; }
    }
    PG8_WAIT_V(0);
    if constexpr (!ALIGN_EPI) { if (wr == 0) PG8_BAR; }
    PG8_BAR;
    if constexpr (Epi::AFTER_DRAIN) { E.fused(acc, cur, wr, wc, fr, fq, lds, wid, lane); S.done(cur); }
#undef PG8_SA
#undef PG8_SB
#undef PG8_STAGE
#undef PG8_STAGEA
#undef PG8_LDA
#undef PG8_LDB
#undef PG8_MMA
#undef PG8_WAIT_V
#undef PG8_WAIT_L
#undef PG8_BAR
#undef PG8_SCHED
}
}

#ifndef PG8_SP2
#define PG8_SP2 true
#endif
#ifndef PG8_ALIGN
#define PG8_ALIGN true
#endif
#define GAS __attribute__((address_space(1)))
#define LAS __attribute__((address_space(3)))
typedef unsigned short bf16;
typedef unsigned v4u __attribute__((ext_vector_type(4)));
typedef float f32x4 __attribute__((ext_vector_type(4)));
typedef short bf16x8 __attribute__((ext_vector_type(8)));
typedef GAS unsigned gu32;
typedef GAS unsigned long long gu64;
#define RLX_AGENT __ATOMIC_RELAXED, __HIP_MEMORY_SCOPE_AGENT
#define LDS_WAIT() asm volatile("s_waitcnt lgkmcnt(0)" ::: "memory")
#define VM_WAIT() asm volatile("s_waitcnt vmcnt(0)" ::: "memory")
__device__ __forceinline__ unsigned long long rt() { return __builtin_amdgcn_s_memrealtime(); }
__device__ __forceinline__ unsigned f2bf(float f) { unsigned u = __builtin_bit_cast(unsigned, f); return (u + 0x7fffu + ((u >> 16) & 1u)) >> 16; }
typedef float pk_f32x2_t __attribute__((ext_vector_type(2))); typedef __bf16 pk_bf16x2_t __attribute__((ext_vector_type(2)));
__device__ __forceinline__ unsigned pk2(float lo, float hi) { pk_f32x2_t v = {lo, hi}; pk_bf16x2_t b = __builtin_convertvector(v, pk_bf16x2_t); return __builtin_bit_cast(unsigned, b); }

#define XB_TMO      128
#define XB_XCNT(j)  (256  + 64 * (j))
#define XB_XSUB(j)  (1280 + 64 * (j))
#define XB_XGEN(j)  (2304 + 64 * (j))
#define XB_TOP      3328
#define XB_TOPGEN   3392
#define XCD_BAR_WORDS 3456
#define XB_SPIN_CAP (1u << 18)

__device__ __forceinline__ unsigned xb_ld(unsigned* p)              { return __hip_atomic_load(p, __ATOMIC_RELAXED, __HIP_MEMORY_SCOPE_AGENT); }
__device__ __forceinline__ unsigned xb_add(unsigned* p, unsigned v) { return __hip_atomic_fetch_add(p, v, __ATOMIC_RELAXED, __HIP_MEMORY_SCOPE_AGENT); }
__device__ __forceinline__ unsigned xb_xcc_id() { return (unsigned)__builtin_amdgcn_s_getreg((3 << 11) | 20) & 0xFu; }
#define XB_SPIN(cond, bar) do { unsigned _sp = 0; while (cond) { __builtin_amdgcn_s_sleep(1); \
    if ((++_sp & 255u) == 0u) { if (xb_ld(&(bar)[XB_TMO])) break; if (_sp > XB_SPIN_CAP) { atomicAdd(&(bar)[XB_TMO], 1u); break; } } } } while (0)

struct XcdBarrier {
    unsigned* bar; unsigned x;
    volatile LAS unsigned* st;
};

__device__ __forceinline__ XcdBarrier xcd_barrier_post(unsigned* bar, volatile LAS unsigned* st) {
    XcdBarrier b; b.bar = bar; b.x = xb_xcc_id(); b.st = st;
    if (threadIdx.x == 0) (void)xb_add(&bar[XB_XCNT(b.x)], 1u);
    return b;
}
__device__ __forceinline__ void xcd_barrier_complete(unsigned* bar, unsigned x, unsigned& nloc, unsigned& nx) {
    const unsigned G = gridDim.x * gridDim.y * gridDim.z;
    unsigned sum, cnt, mine, sp = 0u;
    for (;;) {
        sum = 0u; cnt = 0u; mine = 0u;
#pragma unroll
        for (unsigned j = 0; j < 16; ++j) { const unsigned c = xb_ld(&bar[XB_XCNT(j)]); sum += c; cnt += (c > 0u) ? 1u : 0u; mine = (j == x) ? c : mine; }
        if (sum == G) break;
        __builtin_amdgcn_s_sleep(1);
        if ((++sp & 255u) == 0u) { if (xb_ld(&bar[XB_TMO])) break; if (sp > XB_SPIN_CAP) { atomicAdd(&bar[XB_TMO], 1u); break; } }
    }
    nloc = mine > 0u ? mine : 1u; nx = cnt > 0u ? cnt : 1u;
}

__device__ __forceinline__ void xcd_barrier(const XcdBarrier& b) {
    asm volatile("s_waitcnt vmcnt(0)" ::: "memory");
    __syncthreads();
    if (threadIdx.x == 0) {
        unsigned* bar = b.bar;
        __builtin_amdgcn_s_waitcnt(0);
        unsigned nloc = b.st[0], nx = b.st[1];
        if (nloc == 0u) { xcd_barrier_complete(bar, b.x, nloc, nx); b.st[0] = nloc; b.st[1] = nx; }
        const unsigned old = xb_add(&bar[XB_XSUB(b.x)], 1u);
        const unsigned gen = old / nloc;
        if (old + 1u == (gen + 1u) * nloc) {
            __builtin_amdgcn_fence(__ATOMIC_RELEASE, "agent");
            asm volatile("s_waitcnt vmcnt(0)" ::: "memory");
            const unsigned og = xb_add(&bar[XB_TOP], 1u);
            const unsigned tg = og / nx;
            if (og + 1u == (tg + 1u) * nx) xb_add(&bar[XB_TOPGEN], 1u);
            else XB_SPIN(xb_ld(&bar[XB_TOPGEN]) == tg, bar);
            __builtin_amdgcn_fence(__ATOMIC_ACQUIRE, "agent");
            xb_add(&bar[XB_XGEN(b.x)], 1u);
            asm volatile("s_waitcnt vmcnt(0)" ::: "memory");
        } else {
            XB_SPIN(xb_ld(&bar[XB_XGEN(b.x)]) == gen, bar);
            __builtin_amdgcn_fence(__ATOMIC_ACQUIRE, "agent");
            asm volatile("s_waitcnt vmcnt(0)" ::: "memory");
        }
    }
    __syncthreads();
}
__device__ __forceinline__ float bf2f(bf16 v) { return __builtin_bit_cast(float, (unsigned)v << 16); }
__device__ __forceinline__ float bflo(unsigned w) { return __builtin_bit_cast(float, w << 16); }
__device__ __forceinline__ float bfhi(unsigned w) { return __builtin_bit_cast(float, w & 0xffff0000u); }
__device__ __forceinline__ float silu_f(float v) { return v / (1.f + __expf(-v)); }
__device__ __forceinline__ float wave_sum(float v) {
#pragma unroll
    for (int o = 1; o < 64; o <<= 1) v += __shfl_xor(v, o);
    return v;
}


namespace at2 {
typedef short bf16x8 __attribute__((ext_vector_type(8)));
typedef short s16x4 __attribute__((ext_vector_type(4)));
typedef float f32x16 __attribute__((ext_vector_type(16)));
typedef unsigned u32x4 __attribute__((ext_vector_type(4)));
typedef float f32x2_t __attribute__((ext_vector_type(2))); typedef __bf16 bf16x2_t __attribute__((ext_vector_type(2)));
#define AT_LAS __attribute__((address_space(3)))
__device__ __forceinline__ int crow(int r, int hi) { return (r & 3) + 8 * (r >> 2) + 4 * hi; }
__device__ __forceinline__ void glds16(const void* gsrc, unsigned lds_dst) { unsigned keep;
    asm volatile("s_mov_b32 %0, m0\n\ts_mov_b32 m0, %2\n\ts_nop 0\n\tglobal_load_lds_dwordx4 %1, off\n\ts_mov_b32 m0, %0" : "=&s"(keep) : "v"(gsrc), "s"(lds_dst) : "memory"); }
__device__ __forceinline__ unsigned cvtpk(float lo, float hi) { f32x2_t v = {lo, hi}; bf16x2_t b = __builtin_convertvector(v, bf16x2_t); return __builtin_bit_cast(unsigned, b); }
__device__ __forceinline__ float swap_max(float m) { auto rr = __builtin_amdgcn_permlane32_swap(__float_as_uint(m), __float_as_uint(m), false, false); float r; asm("v_max_f32_e32 %0, %1, %2" : "=v"(r) : "v"(__uint_as_float(rr[0])), "v"(__uint_as_float(rr[1]))); return r; }
__device__ __forceinline__ float swap_sum(float m) { auto rr = __builtin_amdgcn_permlane32_swap(__float_as_uint(m), __float_as_uint(m), false, false); return __uint_as_float(rr[0]) + __uint_as_float(rr[1]); }

__device__ __forceinline__ float max3f(float a, float b, float c) { float r; asm("v_max3_f32 %0, %1, %2, %3" : "=v"(r) : "v"(a), "v"(b), "v"(c)); return r; }
__device__ __forceinline__ float max2f(float a, float b) { float r; asm("v_max_f32_e32 %0, %1, %2" : "=v"(r) : "v"(a), "v"(b)); return r; }
constexpr float NEGM = -1e30f;
constexpr float THR = 8.0f;

struct Tensors { const unsigned short* Q; const unsigned short* K; const unsigned short* V; unsigned short* O; int pq, pk, pv, po; };

__device__ __forceinline__ void pv(f32x16* o, int vb, bf16x8 pa0, bf16x8 pa1, bf16x8 pa2, bf16x8 pa3) {
#pragma unroll
    for (int d0 = 0; d0 < 2; ++d0) { s16x4 lo[4], hi[4];
#pragma unroll
        for (int ks = 0; ks < 4; ++ks) {
            asm volatile("ds_read_b64_tr_b16 %0,%1 offset:%c2" : "=&v"(lo[ks]) : "v"(vb), "i"(d0 * 4096 + ks * 1024) : "memory");
            asm volatile("ds_read_b64_tr_b16 %0,%1 offset:%c2" : "=&v"(hi[ks]) : "v"(vb), "i"(d0 * 4096 + ks * 1024 + 512) : "memory"); }
        asm volatile("s_waitcnt lgkmcnt(0)" ::: "memory"); __builtin_amdgcn_sched_barrier(0);
#define AT_PK(k) (bf16x8){lo[k][0], lo[k][1], lo[k][2], lo[k][3], hi[k][0], hi[k][1], hi[k][2], hi[k][3]}
        o[d0] = __builtin_amdgcn_mfma_f32_32x32x16_bf16(pa0, AT_PK(0), o[d0], 0, 0, 0);
        o[d0] = __builtin_amdgcn_mfma_f32_32x32x16_bf16(pa1, AT_PK(1), o[d0], 0, 0, 0);
        o[d0] = __builtin_amdgcn_mfma_f32_32x32x16_bf16(pa2, AT_PK(2), o[d0], 0, 0, 0);
        o[d0] = __builtin_amdgcn_mfma_f32_32x32x16_bf16(pa3, AT_PK(3), o[d0], 0, 0, 0);
#undef AT_PK
    }
}

typedef short v4i16_t __attribute__((ext_vector_type(4)));
__device__ __forceinline__ s16x4 vtr(const AT_LAS unsigned char* p) { return __builtin_bit_cast(s16x4, __builtin_amdgcn_ds_read_tr16_b64_v4i16((AT_LAS v4i16_t*)p)); }
__device__ __forceinline__ void pv2(f32x16* o, const AT_LAS unsigned char* vp, bf16x8 pa0, bf16x8 pa1, bf16x8 pa2, bf16x8 pa3) {
#pragma unroll
    for (int d0 = 0; d0 < 2; ++d0) { s16x4 lo[4], hi[4];
#pragma unroll
        for (int ks = 0; ks < 4; ++ks) { lo[ks] = vtr(vp + d0 * 4096 + ks * 1024); hi[ks] = vtr(vp + d0 * 4096 + ks * 1024 + 512); }
#define AT_PK(k) (bf16x8){lo[k][0], lo[k][1], lo[k][2], lo[k][3], hi[k][0], hi[k][1], hi[k][2], hi[k][3]}
        o[d0] = __builtin_amdgcn_mfma_f32_32x32x16_bf16(pa0, AT_PK(0), o[d0], 0, 0, 0);
        o[d0] = __builtin_amdgcn_mfma_f32_32x32x16_bf16(pa1, AT_PK(1), o[d0], 0, 0, 0);
        o[d0] = __builtin_amdgcn_mfma_f32_32x32x16_bf16(pa2, AT_PK(2), o[d0], 0, 0, 0);
        o[d0] = __builtin_amdgcn_mfma_f32_32x32x16_bf16(pa3, AT_PK(3), o[d0], 0, 0, 0);
#undef AT_PK
    }
}

template <int DQ, bool MOBA, bool QNORM, int G>
__device__ __forceinline__ void attn_unit(AT_LAS unsigned char* lds, const Tensors& T, long rowbase, int qb, const float* km, const float* qg, const float* tab) {
    constexpr int NKP = DQ / 8, NP = NKP + 8, SLOTB = NKP * 1024 + 8192, ND0 = DQ / 16;
    constexpr int NSLOT = 3 * G, LDS_WS = NSLOT * SLOTB, LDS_OST = 0;
    int tid_ = threadIdx.x; asm volatile("" : "+v"(tid_));
    const int tid = tid_, lane = tid & 63, r32 = lane & 31, hi = lane >> 5; const int wid = __builtin_amdgcn_readfirstlane(tid >> 6);
    const int q0 = qb * 256, NT = 4 * (qb + 1);
    const unsigned lds0 = (unsigned)(size_t)lds;
    AT_LAS float* wsf = (AT_LAS float*)(lds + LDS_WS) + wid * 64;
    asm volatile("s_waitcnt vmcnt(0)" ::: "memory");
    const unsigned short* src[3]; unsigned dsto[3];
#pragma unroll
    for (int k = 0; k < 3; ++k) { const int pi = wid + 8 * k;
        if (pi < NKP) { src[k] = (T.pk == 0) ? T.K + pi * 512 + lane * 8 : T.K + (rowbase + lane) * T.pk + 8 * pi; dsto[k] = pi * 1024; }
        else { const int v = pi - NKP; src[k] = (T.pv == 0) ? T.V + v * 512 + lane * 8 : T.V + (rowbase + 16 * (v & 3) + (lane >> 2)) * T.pv + 32 * (v >> 2) + 8 * (lane & 3); dsto[k] = NKP * 1024 + v * 1024; } }
    const long kstep = (T.pk == 0) ? (long)NKP * 512 : (long)64 * T.pk, vstep = (T.pv == 0) ? (long)4096 : (long)64 * T.pv;
#define AT_DMA(t, slot) do { _Pragma("unroll") for (int k_ = 0; k_ < 3; ++k_) { const int pi_ = wid + 8 * k_; if (pi_ < NP) { \
        const unsigned short* s_ = src[k_] + (long)(t) * ((pi_ < NKP) ? kstep : vstep); glds16(s_, (unsigned)__builtin_amdgcn_readfirstlane(lds0 + (slot) * SLOTB + dsto[k_])); } } } while (0)
    _Pragma("unroll") for (int i_ = 0; i_ < G; ++i_) AT_DMA(i_, i_);
    __builtin_amdgcn_sched_barrier(0);
    bf16x8 qr[ND0];
    { const unsigned short* Qw = T.Q + (rowbase + q0 + wid * 32 + r32) * T.pq + hi * 8;
#pragma unroll
      for (int d0 = 0; d0 < ND0; ++d0) qr[d0] = *(const bf16x8*)(Qw + d0 * 16); }
    __builtin_amdgcn_sched_barrier(0);
    if constexpr (QNORM) {
        float s = 0.f;
#pragma unroll
        for (int d0 = 0; d0 < ND0; ++d0)
#pragma unroll
            for (int j = 0; j < 8; ++j) { const float x = bf2f((unsigned short)qr[d0][j]); s += x * x; }
        s = swap_sum(s);
        const float rstd = 0.14724445073472677f / sqrtf(s * (1.f / 96.f) + 1e-6f);
#pragma unroll
        for (int d0 = 0; d0 < 4; ++d0) { const f32x4 g0 = *(const f32x4*)(qg + d0 * 16 + hi * 8), g1 = *(const f32x4*)(qg + d0 * 16 + hi * 8 + 4); u32x4 w;
            w.x = cvtpk(bf2f((unsigned short)qr[d0][0]) * rstd * g0.x, bf2f((unsigned short)qr[d0][1]) * rstd * g0.y); w.y = cvtpk(bf2f((unsigned short)qr[d0][2]) * rstd * g0.z, bf2f((unsigned short)qr[d0][3]) * rstd * g0.w);
            w.z = cvtpk(bf2f((unsigned short)qr[d0][4]) * rstd * g1.x, bf2f((unsigned short)qr[d0][5]) * rstd * g1.y); w.w = cvtpk(bf2f((unsigned short)qr[d0][6]) * rstd * g1.z, bf2f((unsigned short)qr[d0][7]) * rstd * g1.w);
            qr[d0] = __builtin_bit_cast(bf16x8, w); asm volatile("" : "+v"(qr[d0])); }
        { const int pos = q0 + wid * 32 + r32; const float* tb = tab + (pos * 16 + hi * 8) * 2; const float* ga = qg + 64 + hi * 8; const float* gb = qg + 80 + hi * 8; float oa[8], ob[8];
#pragma unroll
          for (int j = 0; j < 8; ++j) { const float x1 = bf2f((unsigned short)qr[4][j]) * rstd * ga[j], x2 = bf2f((unsigned short)qr[5][j]) * rstd * gb[j]; const float c = tb[2 * j], sn = tb[2 * j + 1]; oa[j] = x1 * c - x2 * sn; ob[j] = x1 * sn + x2 * c; }
          u32x4 w; w.x = cvtpk(oa[0], oa[1]); w.y = cvtpk(oa[2], oa[3]); w.z = cvtpk(oa[4], oa[5]); w.w = cvtpk(oa[6], oa[7]); qr[4] = __builtin_bit_cast(bf16x8, w);
          w.x = cvtpk(ob[0], ob[1]); w.y = cvtpk(ob[2], ob[3]); w.z = cvtpk(ob[4], ob[5]); w.w = cvtpk(ob[6], ob[7]); qr[5] = __builtin_bit_cast(bf16x8, w); }
    }
    __builtin_amdgcn_sched_barrier(0);
    unsigned sel = 0xffffffffu;
    if (MOBA) {
        sel = 0u; float gate[8];
#pragma unroll
        for (int j = 0; j < 7; ++j) { float a = 0.f;
            if (j < qb) { const float* kj = km + j * 512 + hi * 8;
#pragma unroll
                for (int d0 = 0; d0 < ND0; ++d0) { const f32x4 k0 = *(const f32x4*)(kj + d0 * 16), k1 = *(const f32x4*)(kj + d0 * 16 + 4);
                    a += bf2f((unsigned short)qr[d0][0]) * k0.x + bf2f((unsigned short)qr[d0][1]) * k0.y + bf2f((unsigned short)qr[d0][2]) * k0.z + bf2f((unsigned short)qr[d0][3]) * k0.w
                       + bf2f((unsigned short)qr[d0][4]) * k1.x + bf2f((unsigned short)qr[d0][5]) * k1.y + bf2f((unsigned short)qr[d0][6]) * k1.z + bf2f((unsigned short)qr[d0][7]) * k1.w; } }
            a = swap_sum(a); gate[j] = (j < qb) ? a : -INFINITY; }
        gate[7] = -INFINITY;
#pragma unroll
        for (int r = 0; r < 3; ++r) { int best = -1; float bv = -INFINITY;
#pragma unroll
            for (int j = 0; j < 8; ++j) if (!((sel >> j) & 1u) && gate[j] > bv) { bv = gate[j]; best = j; }
            if (best >= 0) sel |= 1u << best; }
    }
    __builtin_amdgcn_sched_barrier(0);
    float mhat = 0.f, l = 0.f; f32x16 o[2]; o[0] = f32x16{}; o[1] = f32x16{};
    const int qrel = wid * 32 + r32;
    const int vbl = ((lane >> 4) & 1) * 32 + (lane & 3) * 8 + (4 * hi + ((lane & 15) >> 2)) * 64;
#define AT_GROUP(u) do { asm volatile("s_waitcnt vmcnt(0) lgkmcnt(0)\n\ts_barrier" ::: "memory"); \
        if ((u) + G < NT) { _Pragma("unroll") for (int i_ = 0; i_ < G; ++i_) { const int tt_ = (u) + G + i_; AT_DMA(tt_, tt_ % NSLOT); } } } while (0)
#define AT_KLOAD(sl) do { const AT_LAS unsigned char* kb = lds + (sl) * SLOTB + hi * 1024 + r32 * 16; \
        _Pragma("unroll") for (int d0 = 0; d0 < ND0; ++d0) { kf[2 * d0] = *(const AT_LAS bf16x8*)(kb + d0 * 2048); kf[2 * d0 + 1] = *(const AT_LAS bf16x8*)(kb + d0 * 2048 + 512); } } while (0)
    bf16x8 kf[2 * ND0]; s16x4 vlo[8], vhi[8];
    AT_GROUP(0);
    AT_KLOAD(0);
    int slot = 0;
    for (int t = 0; t < NT; ++t) {
        __builtin_amdgcn_sched_barrier(0);
        { const AT_LAS unsigned char* vp = lds + slot * SLOTB + NKP * 1024 + vbl;
#pragma unroll
          for (int i = 0; i < 8; ++i) { vlo[i] = vtr(vp + (i >> 2) * 4096 + (i & 3) * 1024); vhi[i] = vtr(vp + (i >> 2) * 4096 + (i & 3) * 1024 + 512); } }
        __builtin_amdgcn_sched_barrier(0);
        f32x16 p0, p1;
#pragma unroll
        for (int d0 = 0; d0 < ND0; ++d0) {
            if (d0 == 0) { p0 = __builtin_amdgcn_mfma_f32_32x32x16_bf16(kf[0], qr[0], f32x16{}, 0, 0, 0); p1 = __builtin_amdgcn_mfma_f32_32x32x16_bf16(kf[1], qr[0], f32x16{}, 0, 0, 0); }
            else { p0 = __builtin_amdgcn_mfma_f32_32x32x16_bf16(kf[2 * d0], qr[d0], p0, 0, 0, 0); p1 = __builtin_amdgcn_mfma_f32_32x32x16_bf16(kf[2 * d0 + 1], qr[d0], p1, 0, 0, 0); } }
        __builtin_amdgcn_sched_barrier(0);
        const int nslot = (slot == NSLOT - 1) ? 0 : slot + 1;
        if (t + 1 < NT) { if (((t + 1) % G) == 0) AT_GROUP(t + 1); AT_KLOAD(nslot); }
        __builtin_amdgcn_sched_barrier(0);
        const int jb = t - (NT - 4);
        if (jb >= 0) { const int kb0 = 64 * jb + 4 * hi;
#pragma unroll
            for (int r = 0; r < 16; ++r) { const int kv = kb0 + (r & 3) + 8 * (r >> 2); if (kv > qrel) p0[r] = NEGM; if (kv + 32 > qrel) p1[r] = NEGM; } }
        else if (MOBA) { const bool keep = ((sel >> (t >> 2)) & 1u) != 0u;
            if (!__all(keep)) { if (!keep) {
#pragma unroll
                for (int r = 0; r < 16; ++r) { p0[r] = NEGM; p1[r] = NEGM; } } } }
        float rm;
        { float a_ = fmaxf(fmaxf(p0[0], p0[1]), p1[0]), b_ = fmaxf(fmaxf(p0[2], p0[3]), p1[1]); a_ = fmaxf(fmaxf(a_, p1[2]), p1[3]);
#pragma unroll
          for (int r = 4; r < 16; r += 4) { a_ = fmaxf(fmaxf(a_, p0[r]), p0[r + 1]); b_ = fmaxf(fmaxf(b_, p0[r + 2]), p0[r + 3]); a_ = fmaxf(fmaxf(a_, p1[r]), p1[r + 1]); b_ = fmaxf(fmaxf(b_, p1[r + 2]), p1[r + 3]); }
          rm = swap_max(fmaxf(a_, b_)) - mhat; }
        if (__any(rm > THR)) {
            const float dl = fmaxf(rm, 0.f); mhat += dl;
            const float alpha = __builtin_amdgcn_exp2f(-dl); l *= alpha;
            if (hi == 0) wsf[r32] = alpha;
            asm volatile("s_waitcnt lgkmcnt(0)" ::: "memory");
#pragma unroll
            for (int r = 0; r < 16; ++r) { const float f = wsf[crow(r, hi)]; o[0][r] *= f; o[1][r] *= f; }
        }
        float sacc = 0.f;
#pragma unroll
        for (int r = 0; r < 16; ++r) { p0[r] = __builtin_amdgcn_exp2f(p0[r] - mhat); p1[r] = __builtin_amdgcn_exp2f(p1[r] - mhat); sacc += p0[r] + p1[r]; }
        l += sacc;
        u32x4 pw[4];
        pw[0] = (u32x4){cvtpk(p0[0], p0[1]), cvtpk(p0[2], p0[3]), cvtpk(p0[4], p0[5]), cvtpk(p0[6], p0[7])};
        pw[1] = (u32x4){cvtpk(p0[8], p0[9]), cvtpk(p0[10], p0[11]), cvtpk(p0[12], p0[13]), cvtpk(p0[14], p0[15])};
        pw[2] = (u32x4){cvtpk(p1[0], p1[1]), cvtpk(p1[2], p1[3]), cvtpk(p1[4], p1[5]), cvtpk(p1[6], p1[7])};
        pw[3] = (u32x4){cvtpk(p1[8], p1[9]), cvtpk(p1[10], p1[11]), cvtpk(p1[12], p1[13]), cvtpk(p1[14], p1[15])};
        __builtin_amdgcn_sched_barrier(0);
#pragma unroll
        for (int d0 = 0; d0 < 2; ++d0)
#pragma unroll
            for (int ks = 0; ks < 4; ++ks) { const int i = d0 * 4 + ks;
                o[d0] = __builtin_amdgcn_mfma_f32_32x32x16_bf16(__builtin_bit_cast(bf16x8, pw[ks]), (bf16x8){vlo[i][0], vlo[i][1], vlo[i][2], vlo[i][3], vhi[i][0], vhi[i][1], vhi[i][2], vhi[i][3]}, o[d0], 0, 0, 0); }
        slot = nslot;
    }
#undef AT_GROUP
#undef AT_KLOAD
#undef AT_DMA
    asm volatile("s_waitcnt lgkmcnt(0)\n\ts_barrier" ::: "memory");
    l = swap_sum(l);
    if (hi == 0) wsf[32 + r32] = l;
    asm volatile("s_waitcnt lgkmcnt(0)" ::: "memory");
    float rli[16];
#pragma unroll
    for (int r = 0; r < 16; ++r) rli[r] = __builtin_amdgcn_rcpf(wsf[32 + crow(r, hi)]);
    unsigned short* Ow = T.O + (rowbase + q0 + wid * 32) * T.po;
    { AT_LAS unsigned short* stg = (AT_LAS unsigned short*)(lds + LDS_OST) + wid * 2048;
#pragma unroll
      for (int r = 0; r < 16; ++r) { const int orow = crow(r, hi);
#pragma unroll
          for (int d0 = 0; d0 < 2; ++d0) stg[orow * 64 + d0 * 32 + r32] = (unsigned short)f2bf(o[d0][r] * rli[r]); }
      asm volatile("s_waitcnt lgkmcnt(0)" ::: "memory");
#pragma unroll
      for (int i = 0; i < 4; ++i) { const int row = i * 8 + (lane >> 3), ch = lane & 7; const u32x4 v = *(const AT_LAS u32x4*)(stg + row * 64 + ch * 8); *(u32x4*)(Ow + (long)row * T.po + ch * 8) = v; } }
    asm volatile("s_waitcnt lgkmcnt(0)\n\ts_barrier" ::: "memory");
}
template <int DQ, bool MOBA, bool QNORM, int G>
__device__ __forceinline__ void attn_unit_p(AT_LAS unsigned char* lds, const Tensors& T, long rowbase, int qb, const float* km, const float* qg, const float* tab, float kbound, int tbase, bool prefetched, bool has_next) {
    constexpr int NKP = DQ / 8, NP = NKP + 8, SLOTB = NKP * 1024 + 8192, ND0 = DQ / 16;
    constexpr int NSLOT = 3 * G, LDS_WS = NSLOT * SLOTB, LDS_OST = LDS_WS + 2048;
    int tid_ = threadIdx.x; asm volatile("" : "+v"(tid_));
    const int tid = tid_, lane = tid & 63, r32 = lane & 31, hi = lane >> 5; const int wid = __builtin_amdgcn_readfirstlane(tid >> 6);
    const int q0 = qb * 256, NT = 4 * (qb + 1);
    const unsigned lds0 = (unsigned)(size_t)lds;
    AT_LAS float* wsf = (AT_LAS float*)(lds + LDS_WS) + wid * 64;
    asm volatile("s_waitcnt vmcnt(0)" ::: "memory");
    unsigned soff[3], dsto[3];
#pragma unroll
    for (int k = 0; k < 3; ++k) { const int pi = wid + 8 * k;
        if (pi < NKP) { soff[k] = (T.pk == 0) ? (unsigned)(pi * 512 + lane * 8) : (unsigned)((rowbase + lane) * T.pk + 8 * pi); dsto[k] = pi * 1024; }
        else { const int v = pi - NKP; soff[k] = (T.pv == 0) ? (unsigned)(v * 512 + lane * 8) : (unsigned)((rowbase + 16 * (v & 3) + (lane >> 2)) * T.pv + 32 * (v >> 2) + 8 * (lane & 3)); dsto[k] = NKP * 1024 + v * 1024; } }
    const unsigned kstep = (T.pk == 0) ? (unsigned)NKP * 512u : 64u * (unsigned)T.pk, vstep = (T.pv == 0) ? 4096u : 64u * (unsigned)T.pv;
#define AT_DMA(t, slot) do { _Pragma("unroll") for (int k_ = 0; k_ < 3; ++k_) { const int pi_ = wid + 8 * k_; if (pi_ < NP) { \
        const unsigned short* s_ = ((pi_ < NKP) ? T.K : T.V) + (size_t)(soff[k_] + (unsigned)(t) * ((pi_ < NKP) ? kstep : vstep)); glds16(s_, (unsigned)__builtin_amdgcn_readfirstlane(lds0 + (slot) * SLOTB + dsto[k_])); } } } while (0)
    if (!prefetched) { _Pragma("unroll") for (int i_ = 0; i_ < G; ++i_) AT_DMA(i_, (tbase + i_) % NSLOT); }
    __builtin_amdgcn_sched_barrier(0);
    bf16x8 qr[ND0];
    { const unsigned short* Qw = T.Q + (rowbase + q0 + wid * 32 + r32) * T.pq + hi * 8;
#pragma unroll
      for (int d0 = 0; d0 < ND0; ++d0) qr[d0] = *(const bf16x8*)(Qw + d0 * 16); }
    __builtin_amdgcn_sched_barrier(0);
    if constexpr (QNORM) {
        float s = 0.f;
#pragma unroll
        for (int d0 = 0; d0 < ND0; ++d0)
#pragma unroll
            for (int j = 0; j < 8; ++j) { const float x = bf2f((unsigned short)qr[d0][j]); s += x * x; }
        s = swap_sum(s);
        const float rstd = 0.14724445073472677f / sqrtf(s * (1.f / 96.f) + 1e-6f);
#pragma unroll
        for (int d0 = 0; d0 < 4; ++d0) { const f32x4 g0 = *(const f32x4*)(qg + d0 * 16 + hi * 8), g1 = *(const f32x4*)(qg + d0 * 16 + hi * 8 + 4); u32x4 w;
            w.x = cvtpk(bf2f((unsigned short)qr[d0][0]) * rstd * g0.x, bf2f((unsigned short)qr[d0][1]) * rstd * g0.y); w.y = cvtpk(bf2f((unsigned short)qr[d0][2]) * rstd * g0.z, bf2f((unsigned short)qr[d0][3]) * rstd * g0.w);
            w.z = cvtpk(bf2f((unsigned short)qr[d0][4]) * rstd * g1.x, bf2f((unsigned short)qr[d0][5]) * rstd * g1.y); w.w = cvtpk(bf2f((unsigned short)qr[d0][6]) * rstd * g1.z, bf2f((unsigned short)qr[d0][7]) * rstd * g1.w);
            qr[d0] = __builtin_bit_cast(bf16x8, w); asm volatile("" : "+v"(qr[d0])); }
        { const int pos = q0 + wid * 32 + r32; const float* tb = tab + (pos * 16 + hi * 8) * 2; const float* ga = qg + 64 + hi * 8; const float* gb = qg + 80 + hi * 8; float oa[8], ob[8];
#pragma unroll
          for (int j = 0; j < 8; ++j) { const float x1 = bf2f((unsigned short)qr[4][j]) * rstd * ga[j], x2 = bf2f((unsigned short)qr[5][j]) * rstd * gb[j]; const float c = tb[2 * j], sn = tb[2 * j + 1]; oa[j] = x1 * c - x2 * sn; ob[j] = x1 * sn + x2 * c; }
          u32x4 w; w.x = cvtpk(oa[0], oa[1]); w.y = cvtpk(oa[2], oa[3]); w.z = cvtpk(oa[4], oa[5]); w.w = cvtpk(oa[6], oa[7]); qr[4] = __builtin_bit_cast(bf16x8, w);
          w.x = cvtpk(ob[0], ob[1]); w.y = cvtpk(ob[2], ob[3]); w.z = cvtpk(ob[4], ob[5]); w.w = cvtpk(ob[6], ob[7]); qr[5] = __builtin_bit_cast(bf16x8, w); }
    }
    __builtin_amdgcn_sched_barrier(0);
    unsigned sel = 0xffffffffu;
    if (MOBA) {
        sel = 0u; float gate[8];
#pragma unroll
        for (int j = 0; j < 7; ++j) { float a = 0.f;
            if (j < qb) { const float* kj = km + j * 512 + hi * 8;
#pragma unroll
                for (int d0 = 0; d0 < ND0; ++d0) { const f32x4 k0 = *(const f32x4*)(kj + d0 * 16), k1 = *(const f32x4*)(kj + d0 * 16 + 4);
                    a += bf2f((unsigned short)qr[d0][0]) * k0.x + bf2f((unsigned short)qr[d0][1]) * k0.y + bf2f((unsigned short)qr[d0][2]) * k0.z + bf2f((unsigned short)qr[d0][3]) * k0.w
                       + bf2f((unsigned short)qr[d0][4]) * k1.x + bf2f((unsigned short)qr[d0][5]) * k1.y + bf2f((unsigned short)qr[d0][6]) * k1.z + bf2f((unsigned short)qr[d0][7]) * k1.w; } }
            a = swap_sum(a); gate[j] = (j < qb) ? a : -INFINITY; }
        gate[7] = -INFINITY;
#pragma unroll
        for (int r = 0; r < 3; ++r) { int best = -1; float bv = -INFINITY;
#pragma unroll
            for (int j = 0; j < 8; ++j) if (!((sel >> j) & 1u) && gate[j] > bv) { bv = gate[j]; best = j; }
            if (best >= 0) sel |= 1u << best; }
    }
    __builtin_amdgcn_sched_barrier(0);
    float l = 0.f; f32x16 o[2]; o[0] = f32x16{}; o[1] = f32x16{};
    f32x16 negm;
    { float qss = 0.f;
#pragma unroll
      for (int d0 = 0; d0 < ND0; ++d0)
#pragma unroll
          for (int j = 0; j < 8; ++j) { const float x = bf2f((unsigned short)qr[d0][j]); qss += x * x; }
      qss = swap_sum(qss); const float mrow = sqrtf(qss) * kbound;
#pragma unroll
      for (int r = 0; r < 16; ++r) negm[r] = -mrow;
      asm volatile("" : "+v"(negm)); }

    const int qrel = wid * 32 + r32;
    const int vbl = ((lane >> 4) & 1) * 32 + (lane & 3) * 8 + (4 * hi + ((lane & 15) >> 2)) * 64;
#define AT_GROUP(u) do { asm volatile("s_waitcnt vmcnt(0) lgkmcnt(0)\n\ts_barrier" ::: "memory"); \
        if ((u) + G < NT) { _Pragma("unroll") for (int i_ = 0; i_ < G; ++i_) { const int tt_ = (u) + G + i_; AT_DMA(tt_, (tbase + tt_) % NSLOT); } } \
        else if (has_next) { _Pragma("unroll") for (int i_ = 0; i_ < G; ++i_) AT_DMA(i_, (tbase + NT + i_) % NSLOT); } } while (0)
#define AT_KLOAD(sl) do { const AT_LAS unsigned char* kb = lds + (sl) * SLOTB + hi * 1024 + r32 * 16; \
        _Pragma("unroll") for (int d0 = 0; d0 < ND0; ++d0) { kf[2 * d0] = *(const AT_LAS bf16x8*)(kb + d0 * 2048); kf[2 * d0 + 1] = *(const AT_LAS bf16x8*)(kb + d0 * 2048 + 512); } } while (0)
#define AT_VLOAD(sl) do { const AT_LAS unsigned char* vp = lds + (sl) * SLOTB + NKP * 1024 + vbl; \
        _Pragma("unroll") for (int i = 0; i < 8; ++i) { vlo[i] = vtr(vp + (i >> 2) * 4096 + (i & 3) * 1024); vhi[i] = vtr(vp + (i >> 2) * 4096 + (i & 3) * 1024 + 512); } } while (0)
#define AT_SUMPACK() do { float sacc = 0.f; \
        _Pragma("unroll") for (int r = 0; r < 16; ++r) sacc += c0[r] + c1[r]; \
        l += sacc; \
        pw[0] = (u32x4){cvtpk(c0[0], c0[1]), cvtpk(c0[2], c0[3]), cvtpk(c0[4], c0[5]), cvtpk(c0[6], c0[7])}; \
        pw[1] = (u32x4){cvtpk(c0[8], c0[9]), cvtpk(c0[10], c0[11]), cvtpk(c0[12], c0[13]), cvtpk(c0[14], c0[15])}; \
        pw[2] = (u32x4){cvtpk(c1[0], c1[1]), cvtpk(c1[2], c1[3]), cvtpk(c1[4], c1[5]), cvtpk(c1[6], c1[7])}; \
        pw[3] = (u32x4){cvtpk(c1[8], c1[9]), cvtpk(c1[10], c1[11]), cvtpk(c1[12], c1[13]), cvtpk(c1[14], c1[15])}; } while (0)
#define AT_QKT(N0, N1) do { _Pragma("unroll") for (int d0 = 0; d0 < ND0; ++d0) { \
            if (d0 == 0) { N0 = __builtin_amdgcn_mfma_f32_32x32x16_bf16(kf[0], qr[0], negm, 0, 0, 0); N1 = __builtin_amdgcn_mfma_f32_32x32x16_bf16(kf[1], qr[0], negm, 0, 0, 0); } \
            else { N0 = __builtin_amdgcn_mfma_f32_32x32x16_bf16(kf[2 * d0], qr[d0], N0, 0, 0, 0); N1 = __builtin_amdgcn_mfma_f32_32x32x16_bf16(kf[2 * d0 + 1], qr[d0], N1, 0, 0, 0); } } } while (0)
#define AT_DECIDE(tt) do { \
        { const int jb = (tt) - (NT - 4); \
          if (jb >= 0) { const int kb0 = 64 * jb + 4 * hi; \
              _Pragma("unroll") for (int r = 0; r < 16; ++r) { const int kv = kb0 + (r & 3) + 8 * (r >> 2); if (kv > qrel) c0[r] = NEGM; if (kv + 32 > qrel) c1[r] = NEGM; } } \
          else if (MOBA) { const bool keep = ((sel >> ((tt) >> 2)) & 1u) != 0u; \
              if (!__all(keep)) { if (!keep) { _Pragma("unroll") for (int r = 0; r < 16; ++r) { c0[r] = NEGM; c1[r] = NEGM; } } } } } \
        if ((tt) + 1 < NT && (((tt) + 1) % G) == 0) AT_GROUP((tt) + 1); } while (0)
#define AT_EXPS() do { _Pragma("unroll") for (int r = 0; r < 16; ++r) { c0[r] = __builtin_amdgcn_exp2f(c0[r]); c1[r] = __builtin_amdgcn_exp2f(c1[r]); } } while (0)
#define AT_PV() do { _Pragma("unroll") for (int d0 = 0; d0 < 2; ++d0) _Pragma("unroll") for (int ks = 0; ks < 4; ++ks) { const int i = d0 * 4 + ks; \
            o[d0] = __builtin_amdgcn_mfma_f32_32x32x16_bf16(__builtin_bit_cast(bf16x8, pw[ks]), (bf16x8){vlo[i][0], vlo[i][1], vlo[i][2], vlo[i][3], vhi[i][0], vhi[i][1], vhi[i][2], vhi[i][3]}, o[d0], 0, 0, 0); } } while (0)
#define AT_SGB(mask, n) __builtin_amdgcn_sched_group_barrier(mask, n, 0)
    constexpr int NG = 2 * ND0;
    bf16x8 kf[2 * ND0]; s16x4 vlo[8], vhi[8]; u32x4 pw[4]; f32x16 c0, c1;
    AT_GROUP(0);
    AT_KLOAD(tbase % NSLOT);
    AT_QKT(c0, c1);
    AT_DECIDE(0);
    AT_KLOAD((tbase + 1) % NSLOT);
    AT_EXPS();
    int slot = (tbase + 1) % NSLOT, pslot = tbase % NSLOT;
    for (int t = 1; t < NT; ++t) {
        const int nslot = (t + 1 < NT) ? ((slot == NSLOT - 1) ? 0 : slot + 1) : slot;
        __builtin_amdgcn_sched_barrier(0);
        { f32x16 n0, n1; float sacc = 0.f;
          const AT_LAS unsigned char* vp = lds + pslot * SLOTB + NKP * 1024 + vbl;
#pragma unroll
          for (int i = 0; i < NG; ++i) {
              if (i >= NG - 2) { const int vi = i - (NG - 2); vlo[vi] = vtr(vp + (vi >> 2) * 4096 + (vi & 3) * 1024); vhi[vi] = vtr(vp + (vi >> 2) * 4096 + (vi & 3) * 1024 + 512); }
              const int d0 = i >> 1;
              if (i & 1) n1 = (d0 == 0) ? __builtin_amdgcn_mfma_f32_32x32x16_bf16(kf[i], qr[d0], negm, 0, 0, 0) : __builtin_amdgcn_mfma_f32_32x32x16_bf16(kf[i], qr[d0], n1, 0, 0, 0);
              else n0 = (d0 == 0) ? __builtin_amdgcn_mfma_f32_32x32x16_bf16(kf[i], qr[d0], negm, 0, 0, 0) : __builtin_amdgcn_mfma_f32_32x32x16_bf16(kf[i], qr[d0], n0, 0, 0, 0);
#pragma unroll
              for (int rr = (i * 32) / NG; rr < ((i + 1) * 32) / NG; ++rr) sacc += (rr < 16) ? c0[rr] : c1[rr - 16];
#pragma unroll
              for (int ww = (i * 16) / NG; ww < ((i + 1) * 16) / NG; ++ww) { const int e = 2 * ww; pw[ww >> 2][ww & 3] = (e < 16) ? cvtpk(c0[e], c0[e + 1]) : cvtpk(c1[e - 16], c1[e - 15]); }
              __builtin_amdgcn_sched_barrier(0); }
          l += sacc; c0 = n0; c1 = n1; }
        AT_DECIDE(t);
        __builtin_amdgcn_sched_barrier(0);
        { const AT_LAS unsigned char* kb = lds + nslot * SLOTB + hi * 1024 + r32 * 16; const AT_LAS unsigned char* vpB = lds + pslot * SLOTB + NKP * 1024 + vbl;
#pragma unroll
          for (int i = 0; i < 8; ++i) {
              if (i + 2 < 8) { const int vi = i + 2; vlo[vi] = vtr(vpB + (vi >> 2) * 4096 + (vi & 3) * 1024); vhi[vi] = vtr(vpB + (vi >> 2) * 4096 + (vi & 3) * 1024 + 512); }
              if (i >= 2 && i < 6) {
#pragma unroll
                  for (int q = (i - 2) * NG / 4; q < (i - 1) * NG / 4; ++q) kf[q] = *(const AT_LAS bf16x8*)(kb + (q >> 1) * 2048 + (q & 1) * 512); }
              o[i >> 2] = __builtin_amdgcn_mfma_f32_32x32x16_bf16(__builtin_bit_cast(bf16x8, pw[i & 3]), (bf16x8){vlo[i][0], vlo[i][1], vlo[i][2], vlo[i][3], vhi[i][0], vhi[i][1], vhi[i][2], vhi[i][3]}, o[i >> 2], 0, 0, 0);
#pragma unroll
              for (int rr = 4 * i; rr < 4 * i + 4; ++rr) { if (rr < 16) c0[rr] = __builtin_amdgcn_exp2f(c0[rr]); else c1[rr - 16] = __builtin_amdgcn_exp2f(c1[rr - 16]); }
              __builtin_amdgcn_sched_barrier(0); } }
        pslot = slot; slot = nslot;
    }
    AT_VLOAD(pslot);
    AT_SUMPACK();
    AT_PV();
#undef AT_GROUP
#undef AT_KLOAD
#undef AT_VLOAD
#undef AT_SUMPACK
#undef AT_QKT
#undef AT_DECIDE
#undef AT_EXPS
#undef AT_PV
#undef AT_SGB
#undef AT_DMA
    asm volatile("s_waitcnt lgkmcnt(0)\n\ts_barrier" ::: "memory");
    l = swap_sum(l);
    if (hi == 0) wsf[32 + r32] = l;
    asm volatile("s_waitcnt lgkmcnt(0)" ::: "memory");
    float rli[16];
#pragma unroll
    for (int r = 0; r < 16; ++r) rli[r] = __builtin_amdgcn_rcpf(wsf[32 + crow(r, hi)]);
    unsigned short* Ow = T.O + (rowbase + q0 + wid * 32) * T.po;
    { AT_LAS unsigned short* stg = (AT_LAS unsigned short*)(lds + LDS_OST) + wid * 2048;
#pragma unroll
      for (int r = 0; r < 16; ++r) { const int orow = crow(r, hi);
#pragma unroll
          for (int d0 = 0; d0 < 2; ++d0) stg[orow * 64 + d0 * 32 + r32] = (unsigned short)f2bf(o[d0][r] * rli[r]); }
      asm volatile("s_waitcnt lgkmcnt(0)" ::: "memory");
#pragma unroll
      for (int i = 0; i < 4; ++i) { const int row = i * 8 + (lane >> 3), ch = lane & 7; const u32x4 v = *(const AT_LAS u32x4*)(stg + row * 64 + ch * 8); *(u32x4*)(Ow + (long)row * T.po + ch * 8) = v; } }
    asm volatile("s_waitcnt lgkmcnt(0)\n\ts_barrier" ::: "memory");
}
#undef AT_LAS
}

namespace ssd {
typedef short bf16x8 __attribute__((ext_vector_type(8)));
typedef short v4i16_t __attribute__((ext_vector_type(4)));
typedef float f32x16 __attribute__((ext_vector_type(16)));
typedef unsigned u32x4 __attribute__((ext_vector_type(4)));
#define SS_LAS __attribute__((address_space(3)))
__device__ __forceinline__ int crow(int r, int hi) { return (r & 3) + 8 * (r >> 2) + 4 * hi; }
__device__ __forceinline__ v4i16_t vtr(const SS_LAS unsigned char* p) { return __builtin_amdgcn_ds_read_tr16_b64_v4i16((SS_LAS v4i16_t*)p); }
__device__ __forceinline__ bf16x8 tr_frag(const SS_LAS unsigned char* img, int pitch, int k0, int c0, int lane) {
    const int g4 = lane >> 4, q = (lane & 15) >> 2, p4 = lane & 3;
    const SS_LAS unsigned char* a = img + (k0 + 8 * (g4 >> 1) + q) * pitch + (c0 + 16 * (g4 & 1) + 4 * p4) * 2;
    const v4i16_t lo = vtr(a), hi4 = vtr(a + 4 * pitch);
    return (bf16x8){lo[0], lo[1], lo[2], lo[3], hi4[0], hi4[1], hi4[2], hi4[3]};
}
__device__ __forceinline__ bf16x8 row_frag(const SS_LAS unsigned char* img, int pitch, int r0, int k0, int lane) {
    return *(const SS_LAS bf16x8*)(img + (r0 + (lane & 31)) * pitch + (k0 + 8 * (lane >> 5)) * 2);
}

constexpr int PX4 = 576;
constexpr int PB_T = 320;
constexpr int PR = 272;
constexpr int PX1 = 192;

__device__ __forceinline__ void dt_cs(int t0, int g, const float* DTR, const float* dtb, const float* alog, SS_LAS float* csl, SS_LAS float* dtl, SS_LAS float* wtot, int tid, int lane, int wid) {
    const int l = tid >> 2, hh = tid & 3, h = 4 * g + hh;
    const float r = DTR[(size_t)(t0 + l) * 8 + h] + dtb[h]; const float ex = __expf(fminf(r, 20.f)); const float dt = (r > 20.f) ? r : ((ex < 0.01f) ? ex * (1.f - ex * (0.5f - ex * 0.33333333f)) : __logf(1.f + ex));
    float v = dt * (-expf(alog[h]));
#pragma unroll
    for (int off = 4; off < 64; off <<= 1) { const float t = __shfl_up(v, off); if (lane >= off) v += t; }
    if (lane >= 60) wtot[wid * 4 + hh] = v;
    __syncthreads();
    float base = 0.f;
    for (int w = 0; w < wid; ++w) base += wtot[w * 4 + hh];
    csl[tid] = v + base; dtl[tid] = dt;
    __syncthreads();
}
__device__ __forceinline__ void conv_load(u32x4 (&x)[19], const unsigned short* raw, int t0, int l0, int col) {
    const int pos0 = t0 & 2047;
#pragma unroll
    for (int i = 0; i < 19; ++i) { const int l = l0 - 3 + i; x[i] = (u32x4){0u, 0u, 0u, 0u}; if (pos0 + l >= 0) x[i] = *(const u32x4*)(raw + (size_t)(t0 + l) * 1024 + col); }
}
template <bool SCALED> __device__ __forceinline__ void conv_compute(const u32x4 (&x)[19], int l0, int col, const float* cw, const float* cb, SS_LAS unsigned char* img, int pitch, const SS_LAS float* sc) {
    float w[4][8], b[8];
#pragma unroll
    for (int k = 0; k < 4; ++k) { const f32x4 a = *(const f32x4*)(cw + k * 1024 + col), c = *(const f32x4*)(cw + k * 1024 + col + 4); w[k][0] = a.x; w[k][1] = a.y; w[k][2] = a.z; w[k][3] = a.w; w[k][4] = c.x; w[k][5] = c.y; w[k][6] = c.z; w[k][7] = c.w; }
    { const f32x4 a = *(const f32x4*)(cb + col), c = *(const f32x4*)(cb + col + 4); b[0] = a.x; b[1] = a.y; b[2] = a.z; b[3] = a.w; b[4] = c.x; b[5] = c.y; b[6] = c.z; b[7] = c.w; }
#pragma unroll
    for (int i = 0; i < 16; ++i) { const int l = l0 + i; float o[8]; const float s = SCALED ? sc[l * 4] : 1.f;
#pragma unroll
        for (int j = 0; j < 8; ++j) { float a = b[j];
#pragma unroll
            for (int k = 0; k < 4; ++k) { const unsigned wd = (j < 2) ? x[i + k].x : (j < 4) ? x[i + k].y : (j < 6) ? x[i + k].z : x[i + k].w; a += w[k][j] * ((j & 1) ? bfhi(wd) : bflo(wd)); }
            o[j] = a * __builtin_amdgcn_rcpf(1.f + __expf(-a)) * s; }
        u32x4 p; p.x = pk2(o[0], o[1]); p.y = pk2(o[2], o[3]); p.z = pk2(o[4], o[5]); p.w = pk2(o[6], o[7]);
        *(SS_LAS u32x4*)(img + l * pitch) = p; }
}

__device__ __forceinline__ void states_unit(SS_LAS unsigned char* lds, int bc, int g, const unsigned short* XBC, const float* DTR, const float* cw, const float* cb, const float* dtb, const float* alog, float* ST, float* CEND) {
    int tid_ = threadIdx.x; asm volatile("" : "+v"(tid_));
    const int tid = tid_, lane = tid & 63, r32 = lane & 31, hi = lane >> 5; const int wid = __builtin_amdgcn_readfirstlane(tid >> 6);
    const int t0 = bc * 128;
    SS_LAS unsigned char* XD = lds; SS_LAS unsigned char* BI = lds + 128 * PX4;
    SS_LAS float* csl = (SS_LAS float*)(lds + 128 * PX4 + 128 * PB_T); SS_LAS float* dtl = csl + 512; SS_LAS float* wtot = dtl + 512; SS_LAS float* scl = wtot + 32;
    const int ch = tid % 48, l0 = (tid / 48) * 16; const int col = (ch < 32) ? g * 256 + ch * 8 : 512 + g * 128 + (ch - 32) * 8;
    u32x4 xr[19];
    if (tid < 384) conv_load(xr, XBC, t0, l0, col);
    dt_cs(t0, g, DTR, dtb, alog, csl, dtl, wtot, tid, lane, wid);
    scl[tid] = dtl[tid] * __expf(csl[508 + (tid & 3)] - csl[tid]);
    if (tid < 4) CEND[bc * 8 + g * 4 + tid] = csl[508 + tid];
    __syncthreads();
    if (tid < 384) {
        if (ch < 32) conv_compute<true>(xr, l0, col, cw, cb, XD + ch * 16, PX4, scl + (ch >> 3));
        else conv_compute<false>(xr, l0, col, cw, cb, BI + (ch - 32) * 16, PB_T, nullptr); }
    __syncthreads();
    const int pt = wid >> 2, nt = wid & 3;
#pragma unroll 1
    for (int hh = 0; hh < 4; ++hh) {
        f32x16 acc = f32x16{};
#pragma unroll
        for (int ks = 0; ks < 8; ++ks) {
            const bf16x8 a = tr_frag(XD, PX4, 16 * ks, hh * 64 + 32 * pt, lane);
            const bf16x8 b = tr_frag(BI, PB_T, 16 * ks, 32 * nt, lane);
            acc = __builtin_amdgcn_mfma_f32_32x32x16_bf16(a, b, acc, 0, 0, 0); }
        float* o = ST + (((size_t)(bc * 8 + g * 4 + hh) * 64 + 32 * pt) << 7) + 32 * nt + r32;
#pragma unroll
        for (int r = 0; r < 16; ++r) o[(size_t)crow(r, hi) << 7] = acc[r];
    }
    __syncthreads();
}

__device__ __forceinline__ void out_unit(SS_LAS unsigned char* lds, int bc, int g, const unsigned short* XBC, const unsigned short* VZ, const float* DTR, const float* cw, const float* cb, const float* dtb, const float* alog,
                                         const unsigned short* HIN, const float* Dsk, const float* gn, unsigned short* MIX) {
    int tid_ = threadIdx.x; asm volatile("" : "+v"(tid_));
    const int tid = tid_, lane = tid & 63, r32 = lane & 31, hi = lane >> 5; const int wid = __builtin_amdgcn_readfirstlane(tid >> 6);
    const int t0 = bc * 128;
    SS_LAS unsigned char* CI = lds; SS_LAS unsigned char* BI = lds + 128 * PR; SS_LAS unsigned char* XS = lds + 2 * 128 * PR;
    SS_LAS float* csl = (SS_LAS float*)(lds + 2 * 128 * PR + 128 * PX4); SS_LAS float* dtl = csl + 512; SS_LAS float* wtot = dtl + 512;
    const int ch = tid & 63, l0 = (tid >> 6) * 16; const int col = (ch < 32) ? g * 256 + ch * 8 : (ch < 48) ? 512 + g * 128 + (ch - 32) * 8 : 768 + g * 128 + (ch - 48) * 8;
    u32x4 xr[19];
    conv_load(xr, XBC, t0, l0, col);
    u32x4 zr[8];
    { const unsigned short* zp = VZ + (size_t)(t0 + (tid >> 2)) * 1024 + 512 + g * 256 + (tid & 3) * 64;
#pragma unroll
      for (int c = 0; c < 8; ++c) zr[c] = *(const u32x4*)(zp + c * 8); }
    dt_cs(t0, g, DTR, dtb, alog, csl, dtl, wtot, tid, lane, wid);
    if (ch < 32) conv_compute<false>(xr, l0, col, cw, cb, XS + ch * 16, PX4, nullptr);
    else if (ch < 48) conv_compute<false>(xr, l0, col, cw, cb, BI + (ch - 32) * 16, PR, nullptr);
    else conv_compute<false>(xr, l0, col, cw, cb, CI + (ch - 48) * 16, PR, nullptr);
    __syncthreads();
    const int lt = wid >> 1, st0 = 2 * (wid & 1), pt = wid & 1;
    f32x16 cb2[2]; cb2[0] = f32x16{}; cb2[1] = f32x16{};
#pragma unroll
    for (int ks = 0; ks < 8; ++ks) {
        const bf16x8 a = row_frag(CI, PR, 32 * lt, 16 * ks, lane);
        const bf16x8 b0 = row_frag(BI, PR, 32 * st0, 16 * ks, lane), b1 = row_frag(BI, PR, 32 * st0 + 32, 16 * ks, lane);
        cb2[0] = __builtin_amdgcn_mfma_f32_32x32x16_bf16(a, b0, cb2[0], 0, 0, 0);
        cb2[1] = __builtin_amdgcn_mfma_f32_32x32x16_bf16(a, b1, cb2[1], 0, 0, 0); }
    f32x16 yo[4];
    { bf16x8 hb[2][8];
      const unsigned short* hin0 = HIN + (((size_t)(bc * 8 + g * 4) * 64 + 32 * pt + r32) << 7) + 8 * hi;
#pragma unroll
      for (int ks = 0; ks < 8; ++ks) hb[0][ks] = *(const bf16x8*)(hin0 + 16 * ks);
#pragma unroll
      for (int hh = 0; hh < 4; ++hh) { yo[hh] = f32x16{};
          if (hh < 3) {
#pragma unroll
              for (int ks = 0; ks < 8; ++ks) hb[(hh + 1) & 1][ks] = *(const bf16x8*)(hin0 + ((size_t)(hh + 1) << 13) + 16 * ks); }
          __builtin_amdgcn_sched_barrier(0);
#pragma unroll
          for (int ks = 0; ks < 8; ++ks) yo[hh] = __builtin_amdgcn_mfma_f32_32x32x16_bf16(row_frag(CI, PR, 32 * lt, 16 * ks, lane), hb[hh & 1][ks], yo[hh], 0, 0, 0);
          __builtin_amdgcn_sched_barrier(0); } }
    __syncthreads();
    SS_LAS unsigned char* MI = BI;
#pragma unroll
    for (int hh = 0; hh < 4; ++hh) {
        const int h = g * 4 + hh;
#pragma unroll
        for (int j = 0; j < 2; ++j) { const int s = 32 * (st0 + j) + r32; const float css = csl[s * 4 + hh], dts = dtl[s * 4 + hh];
#pragma unroll
            for (int r = 0; r < 16; ++r) { const int l = 32 * lt + crow(r, hi); const float cl = csl[l * 4 + hh];
                float pr_ = cb2[j][r] * __builtin_amdgcn_exp2f(fminf(cl - css, 0.f) * 1.4426950408889634f) * dts; asm volatile("" : "+v"(pr_)); const float v = (s <= l) ? pr_ : 0.f;
                *(SS_LAS unsigned short*)(MI + l * PR + s * 2) = (unsigned short)f2bf(v); if ((r & 3) == 3) asm volatile("" ::: "memory"); } }
        __syncthreads();
        f32x16 yd = f32x16{};
#pragma unroll
        for (int ks = 0; ks < 8; ++ks) yd = __builtin_amdgcn_mfma_f32_32x32x16_bf16(row_frag(MI, PR, 32 * lt, 16 * ks, lane), tr_frag(XS, PX4, 16 * ks, hh * 64 + 32 * pt, lane), yd, 0, 0, 0);
        __syncthreads();
        const float dsk = Dsk[h]; const int p = 32 * pt + r32;
#pragma unroll
        for (int r = 0; r < 16; ++r) { const int l = 32 * lt + crow(r, hi);
            SS_LAS unsigned short* xp = (SS_LAS unsigned short*)(XS + l * PX4 + (hh * 64 + p) * 2);
            const float y = yd[r] + yo[hh][r] * __expf(csl[l * 4 + hh]) + dsk * bf2f(*xp);
            *xp = (unsigned short)f2bf(y); }
    }
    __syncthreads();
    { const int l = tid >> 2, q = tid & 3; const SS_LAS unsigned char* rowp = XS + l * PX4 + q * 128; float yv[8][8]; float s = 0.f;
#pragma unroll
      for (int c = 0; c < 8; ++c) { const u32x4 v = *(const SS_LAS u32x4*)(rowp + c * 16); const u32x4 z = zr[c];
          yv[c][0] = bflo(v.x) * silu_f(bflo(z.x)); yv[c][1] = bfhi(v.x) * silu_f(bfhi(z.x)); yv[c][2] = bflo(v.y) * silu_f(bflo(z.y)); yv[c][3] = bfhi(v.y) * silu_f(bfhi(z.y));
          yv[c][4] = bflo(v.z) * silu_f(bflo(z.z)); yv[c][5] = bfhi(v.z) * silu_f(bfhi(z.z)); yv[c][6] = bflo(v.w) * silu_f(bflo(z.w)); yv[c][7] = bfhi(v.w) * silu_f(bfhi(z.w));
#pragma unroll
          for (int j = 0; j < 8; ++j) s += yv[c][j] * yv[c][j]; }
      s += __shfl_xor(s, 1); s += __shfl_xor(s, 2);
      const float rstd = 1.f / sqrtf(s * (1.f / 256.f) + 1e-6f); const float* gq = gn + g * 256 + q * 64; unsigned short* op = MIX + (size_t)(t0 + l) * 1024 + 512 + g * 256 + q * 64;
#pragma unroll
      for (int c = 0; c < 8; ++c) { const f32x4 g0 = *(const f32x4*)(gq + c * 8), g1 = *(const f32x4*)(gq + c * 8 + 4); u32x4 o;
          o.x = pk2(yv[c][0] * rstd * g0.x, yv[c][1] * rstd * g0.y); o.y = pk2(yv[c][2] * rstd * g0.z, yv[c][3] * rstd * g0.w);
          o.z = pk2(yv[c][4] * rstd * g1.x, yv[c][5] * rstd * g1.y); o.w = pk2(yv[c][6] * rstd * g1.z, yv[c][7] * rstd * g1.w);
          *(u32x4*)(op + c * 8) = o; } }
    __syncthreads();
}
#undef SS_LAS
}

constexpr int NWAVES = 8, NTHR = 512;
constexpr int T_ = 32768, S_ = 2048, NB_ = 16, D_ = 1024;
constexpr int DFF = 2816, DFF2 = 5632;
constexpr float EPS = 1e-6f;
constexpr size_t MiB = 1u << 20;
constexpr size_t WS_CTL = 0, CTL_ZERO_BYTES = 3 * MiB;
constexpr size_t WS_SSQA = 1 * MiB, WS_SSQB = WS_SSQA + 256 * 1024, WS_SSQC = WS_SSQB + 256 * 1024, WS_SSQQ = WS_SSQC + 256 * 1024, WS_SSQKV = WS_SSQQ + 256 * 1024;
constexpr size_t WS_KMEAN = WS_SSQKV + 256 * 1024;
constexpr size_t WS_DTR = 55 * MiB;
constexpr size_t WS_W_IN0 = 3 * MiB;
constexpr size_t WS_W_OUT0 = WS_W_IN0 + 6656 * 1024;
constexpr size_t WS_W_IN1 = WS_W_OUT0 + 2 * MiB;
constexpr size_t WS_W_UQ = WS_W_IN1 + 2 * MiB;
constexpr size_t WS_W_UKV = WS_W_UQ + 1536 * 1024;
constexpr size_t WS_W_OUT1 = WS_W_UKV + 1 * MiB;
constexpr size_t WS_W_UP = WS_W_OUT1 + 2 * MiB;
constexpr size_t WS_W_DN = WS_W_UP + 22 * MiB;
constexpr size_t WS_TAB64 = 51 * MiB;
constexpr size_t WS_TAB32 = WS_TAB64 + 512 * 1024;
constexpr size_t WS_CWS = 52 * MiB;
constexpr size_t WS_DT = 53 * MiB;
constexpr size_t WS_CS = 54 * MiB;
constexpr size_t WS_XN = 56 * MiB;
constexpr size_t WS_BIG = 120 * MiB;
static_assert(WS_W_DN + 11 * MiB <= WS_TAB64, "weights fit");
constexpr size_t L0_QK = WS_BIG, L0_VZ = WS_BIG + 64 * MiB, L0_XBC = WS_BIG + 128 * MiB, L0_DTR = WS_BIG + 192 * MiB, L0_XBCA = WS_BIG + 256 * MiB, L0_MIX = WS_BIG + 320 * MiB;
constexpr size_t L0_ST = WS_BIG + 192 * MiB;
constexpr size_t L0_KC = WS_BIG + 288 * MiB;
constexpr size_t L0_HIN = WS_BIG + 256 * MiB;
constexpr size_t WS_CEND = 53 * MiB;
constexpr size_t L0_CB = L0_DTR;
constexpr size_t L0_YG = L0_QK;
constexpr size_t FF_ACT = WS_BIG + 64 * MiB, FF_UB = WS_BIG + 240 * MiB;
constexpr size_t L1_C1 = WS_BIG, L1_QR = WS_BIG + 64 * MiB, L1_V2 = WS_BIG + 160 * MiB;
constexpr size_t WS_RG = WS_BIG + 384 * MiB;
constexpr size_t WS_SSQPE = 53 * MiB + 64 * 1024;
constexpr size_t L1_K2 = WS_BIG + 288 * MiB;
constexpr size_t L1_O = WS_BIG + 224 * MiB;
constexpr size_t WS_END = 512 * MiB;
constexpr int CW_BAR = 4096;

constexpr int RING_OFF = 0, RING_BYTES = 162816;
constexpr int LDSCTL_OFF = RING_BYTES, MISC_OFF = LDSCTL_OFF + 320;
constexpr int LDS_BYTES = 163840;

struct Args { const float* in[25]; float* out; unsigned char* ws; int ph_lo, ph_hi; };
typedef const __attribute__((address_space(4))) Args* KArgs;
__device__ __forceinline__ KArgs kargs() { KArgs p = (KArgs)__builtin_amdgcn_kernarg_segment_ptr(); asm volatile("" : "+s"(p)); return p; }
#define PH_VARS KArgs A_ = kargs(); unsigned char* ws = A_->ws; float* out = A_->out; const float* x = A_->in[0]; bf16* XN = (bf16*)(ws + WS_XN); const float* TAB64 = (const float*)(ws + WS_TAB64); const float* TAB32 = (const float*)(ws + WS_TAB32); \
    int tid_ = threadIdx.x; asm volatile("" : "+v"(tid_)); const int tid = tid_, lane = tid & 63, wave = __builtin_amdgcn_readfirstlane(tid >> 6); int G = gridDim.x; asm volatile("" : "+s"(G)); const int gw = blockIdx.x * NWAVES + wave, NGW = G * NWAVES; const int gt = blockIdx.x * NTHR + tid, NGT = G * NTHR; \
    (void)out; (void)x; (void)XN; (void)TAB64; (void)TAB32; (void)lane; (void)gw; (void)NGW; (void)gt; (void)NGT;

template <int MAP> __device__ __forceinline__ int src_col(int n0) {
    if (MAP == 1) { const int pn = n0 >> 8, bj = (n0 >> 7) & 1, wc = (n0 >> 5) & 3; return bj * DFF + pn * 128 + wc * 32; }
    if (MAP == 2) { const int pn = n0 >> 8, bj = (n0 >> 7) & 1, wc = (n0 >> 5) & 3; return (pn < 4) ? pn * 256 + wc * 64 + bj * 32 : n0; }
    if (MAP == 3) { const int pn = n0 >> 8, bj = (n0 >> 7) & 1, wc = (n0 >> 5) & 3; if (pn < 4) return (4 * pn + wc) * 128 + bj * 32; const int col = (pn - 4) * 256 + bj * 128 + wc * 32; return (col >> 6) * 128 + 64 + (col & 63); }
    return n0;
}
template <int MAP> __device__ __forceinline__ void tr_load(f32x4 (&v)[8], const float* W, int Nsrc, int item, int nblk, int lane, const float* gain) {
    const int kb = item / nblk, nb = item % nblk, k0 = 64 * kb, n0 = 32 * nb;
    const int nn = src_col<MAP>(n0) + (lane & 7) * 4; const bool ok = (nn >= 0 && nn < Nsrc);
#pragma unroll
    for (int i = 0; i < 8; ++i) { const int kk = 8 * i + (lane >> 3); v[i] = ok ? *(const f32x4*)(W + (size_t)(k0 + kk) * Nsrc + nn) : (f32x4){0.f, 0.f, 0.f, 0.f}; if (gain) v[i] = v[i] * gain[k0 + kk]; }
}
__device__ __forceinline__ void tr_store(const f32x4 (&v)[8], int K, bf16* WT, LAS float* scr, int item, int nblk, int lane) {
    const int kb = item / nblk, nb = item % nblk, k0 = 64 * kb, n0 = 32 * nb;
#pragma unroll
    for (int i = 0; i < 8; ++i) { const int kk = 8 * i + (lane >> 3); LAS float* d = scr + kk * 33 + (lane & 7) * 4; d[0] = v[i].x; d[1] = v[i].y; d[2] = v[i].z; d[3] = v[i].w; }
    LDS_WAIT(); asm volatile("" ::: "memory");
    const int c = lane & 7;
#pragma unroll
    for (int j = 0; j < 4; ++j) { const int n = (lane >> 3) + 8 * j; const LAS float* s = scr + (8 * c) * 33 + n;
        v4u o; o.x = pk2(s[0 * 33], s[1 * 33]); o.y = pk2(s[2 * 33], s[3 * 33]); o.z = pk2(s[4 * 33], s[5 * 33]); o.w = pk2(s[6 * 33], s[7 * 33]);
        *(GAS v4u*)(WT + (size_t)(n0 + n) * K + k0 + 8 * c) = o; }
    LDS_WAIT(); asm volatile("" ::: "memory");
}
template <int MAP = 0> __device__ __forceinline__ void transpose_mat(const float* W, int K, int Nsrc, int Npad, bf16* WT, LAS float* scr, int gw, int NGW, int lane, const float* gain = nullptr) {
    const int nblk = Npad / 32, nitems = (K / 64) * nblk;
    f32x4 cur[8], nxt[8];
    if (gw < nitems) tr_load<MAP>(cur, W, Nsrc, gw, nblk, lane, gain);
    for (int it = gw; it < nitems; it += NGW) {
        const bool more = it + NGW < nitems;
        if (more) tr_load<MAP>(nxt, W, Nsrc, it + NGW, nblk, lane, gain);
        tr_store(cur, K, WT, scr, it, nblk, lane);
        if (more) {
#pragma unroll
            for (int i = 0; i < 8; ++i) cur[i] = nxt[i]; }
    }
}

struct MatDesc { const float* W; bf16* WT; const float* gain; int K, Nsrc, nblk, map; };
__device__ __forceinline__ int src_col_rt(int map, int n0) { return map == 1 ? src_col<1>(n0) : map == 2 ? src_col<2>(n0) : map == 3 ? src_col<3>(n0) : n0; }
__device__ __forceinline__ void trl_load(f32x4 (&v)[8], const MatDesc& d, int item, int lane) {
    const int kb = item / d.nblk, nb = item % d.nblk, k0 = 64 * kb, n0 = 32 * nb;
    const int nn = src_col_rt(d.map, n0) + (lane & 7) * 4; const bool ok = (nn >= 0 && nn < d.Nsrc);
#pragma unroll
    for (int i = 0; i < 8; ++i) { const int kk = 8 * i + (lane >> 3); v[i] = ok ? __builtin_nontemporal_load((const f32x4*)(d.W + (size_t)(k0 + kk) * d.Nsrc + nn)) : (f32x4){0.f, 0.f, 0.f, 0.f}; if (d.gain) v[i] = v[i] * d.gain[k0 + kk]; }
}
constexpr int NIT_W = 1536 + 512 + 512 + 384 + 256 + 512 + 2 * 2816 + 2 * 1408;
__device__ __forceinline__ MatDesc mat_of(KArgs A_, unsigned char* ws, int item, int& local) {
    MatDesc d; int r = item;
    if (r < 1536) { d = MatDesc{A_->in[3], (bf16*)(ws + WS_W_IN0), nullptr, 1024, 3080, 96, 2}; local = r; return d; } r -= 1536;
    if (r < 512) { d = MatDesc{A_->in[12], (bf16*)(ws + WS_W_OUT0), nullptr, 1024, 1024, 32, 0}; local = r; return d; } r -= 512;
    if (r < 512) { d = MatDesc{A_->in[13], (bf16*)(ws + WS_W_IN1), A_->in[1] + 1024, 1024, 800, 32, 0}; local = r; return d; } r -= 512;
    if (r < 384) { d = MatDesc{A_->in[15], (bf16*)(ws + WS_W_UQ), A_->in[14], 512, 1536, 48, 0}; local = r; return d; } r -= 384;
    if (r < 256) { d = MatDesc{A_->in[17], (bf16*)(ws + WS_W_UKV), A_->in[16], 256, 2048, 64, 3}; local = r; return d; } r -= 256;
    if (r < 512) { d = MatDesc{A_->in[20], (bf16*)(ws + WS_W_OUT1), nullptr, 1024, 1024, 32, 0}; local = r; return d; } r -= 512;
    if (r < 5632) { const int l = r / 2816; d = MatDesc{A_->in[21] + (size_t)l * 1024 * DFF2, (bf16*)(ws + WS_W_UP) + (size_t)l * DFF2 * 1024, A_->in[2] + l * 1024, 1024, DFF2, 176, 1}; local = r - l * 2816; return d; } r -= 5632;
    { const int l = r / 1408; d = MatDesc{A_->in[24] + (size_t)l * DFF * 1024, (bf16*)(ws + WS_W_DN) + (size_t)l * 1024 * DFF, nullptr, DFF, 1024, 32, 0}; local = r - l * 1408; return d; }
}

__device__ __forceinline__ void rms_rows_1024(const float* x, const float* g, bf16* o, int gw, int NGW, int lane) {
    f32x4 v[4], nx[4];
    if (gw < T_) {
#pragma unroll
        for (int j = 0; j < 4; ++j) v[j] = __builtin_nontemporal_load((const f32x4*)(x + (size_t)gw * D_) + lane + 64 * j); }
    for (int m = gw; m < T_; m += NGW) {
        const bool more = m + NGW < T_;
        if (more) {
#pragma unroll
            for (int j = 0; j < 4; ++j) nx[j] = __builtin_nontemporal_load((const f32x4*)(x + (size_t)(m + NGW) * D_) + lane + 64 * j); }
        float s = 0.f;
#pragma unroll
        for (int j = 0; j < 4; ++j) s += (v[j].x * v[j].x + v[j].y * v[j].y) + (v[j].z * v[j].z + v[j].w * v[j].w);
        const float rstd = 1.f / sqrtf(wave_sum(s) * (1.f / D_) + EPS);
        unsigned long long* o8 = (unsigned long long*)(o + (size_t)m * D_) + lane;
#pragma unroll
        for (int j = 0; j < 4; ++j) { const f32x4 gg = ((const f32x4*)g)[lane + 64 * j];
            o8[64 * j] = (unsigned long long)pk2(v[j].x * rstd * gg.x, v[j].y * rstd * gg.y) | ((unsigned long long)pk2(v[j].z * rstd * gg.z, v[j].w * rstd * gg.w) << 32); }
        if (more) {
#pragma unroll
            for (int j = 0; j < 4; ++j) v[j] = nx[j]; }
    }
}

__device__ __forceinline__ void rms_rows_dt(const float* x, const float* g, bf16* o, float* DTR, const LAS f32x4* W2, int gw, int NGW, int lane) {
    f32x4 v[4], nx[4];
    if (gw < T_) {
#pragma unroll
        for (int j = 0; j < 4; ++j) v[j] = __builtin_nontemporal_load((const f32x4*)(x + (size_t)gw * D_) + lane + 64 * j); }
    for (int m = gw; m < T_; m += NGW) {
        const bool more = m + NGW < T_;
        if (more) {
#pragma unroll
            for (int j = 0; j < 4; ++j) nx[j] = __builtin_nontemporal_load((const f32x4*)(x + (size_t)(m + NGW) * D_) + lane + 64 * j); }
        float s = 0.f; f32x4 d0 = {0.f, 0.f, 0.f, 0.f}, d1 = d0;
#pragma unroll
        for (int j = 0; j < 4; ++j) { s += (v[j].x * v[j].x + v[j].y * v[j].y) + (v[j].z * v[j].z + v[j].w * v[j].w);
#pragma unroll
            for (int e = 0; e < 4; ++e) { const int sl = j * 4 + e; const float xk = v[j][e]; d0 += W2[(sl * 2) * 64 + lane] * xk; d1 += W2[(sl * 2 + 1) * 64 + lane] * xk; } }
        const float rstd = 1.f / sqrtf(wave_sum(s) * (1.f / D_) + EPS);
#pragma unroll
        for (int e = 0; e < 4; ++e) { d0[e] = wave_sum(d0[e]); d1[e] = wave_sum(d1[e]); }
        if (lane == 0) { *(f32x4*)(DTR + (size_t)m * 8) = d0 * rstd; *(f32x4*)(DTR + (size_t)m * 8 + 4) = d1 * rstd; }
        unsigned long long* o8 = (unsigned long long*)(o + (size_t)m * D_) + lane;
#pragma unroll
        for (int j = 0; j < 4; ++j) { const f32x4 gg = ((const f32x4*)g)[lane + 64 * j];
            o8[64 * j] = (unsigned long long)pk2(v[j].x * rstd * gg.x, v[j].y * rstd * gg.y) | ((unsigned long long)pk2(v[j].z * rstd * gg.z, v[j].w * rstd * gg.w) << 32); }
        if (more) {
#pragma unroll
            for (int j = 0; j < 4; ++j) v[j] = nx[j]; }
    }
}

struct EpiF32Res {
    static constexpr bool PERM = false, AFTER_DRAIN = false;
    float* C; const float* R; int ldc;
    __device__ __forceinline__ void operator()(const pg8::f32x4 (&acc)[2][2][4][2], const pg8::Unit& u, int wr, int wc, int fr, int fq) const {
        const int row0 = u.pm * pg8::BM + wr * 64 + fr, col0 = u.pn * pg8::BM + wc * 32 + 4 * fq;
#pragma unroll
        for (int ai = 0; ai < 2; ++ai)
#pragma unroll
            for (int m = 0; m < 4; ++m) { const size_t off = (size_t)(row0 + ai * pg8::HALF + m * 16) * ldc + col0;
                f32x4 r[2][2];
#pragma unroll
                for (int bj = 0; bj < 2; ++bj)
#pragma unroll
                    for (int n = 0; n < 2; ++n) r[bj][n] = *(const f32x4*)(R + off + bj * pg8::HALF + n * 16);
#pragma unroll
                for (int bj = 0; bj < 2; ++bj)
#pragma unroll
                    for (int n = 0; n < 2; ++n) *(f32x4*)(C + off + bj * pg8::HALF + n * 16) = acc[ai][bj][m][n] + r[bj][n];
                asm volatile("" ::: "memory"); }
    }
};

template <bool RB16, bool OUTF, bool OUTB> struct EpiRes {
    static constexpr bool PERM = true, AFTER_DRAIN = false, TOUCH = false;
    float* C; const void* R; bf16* XB; unsigned long long* SSQ;
    __device__ __forceinline__ void touch(const pg8::Unit& u, LAS unsigned char* junk, int wid, int lane) const {
        constexpr int ESZ = RB16 ? 2 : 4, LPR = 256 * ESZ / 128;
#pragma unroll
        for (int k = 0; k < LPR / 2; ++k) { const int idx = (k * 8 + wid) * 64 + lane, row = idx / LPR, seg = idx % LPR;
            const char* p_ = (const char*)R + ((size_t)(u.pm * pg8::BM + row) * 1024 + u.pn * pg8::BM) * ESZ + seg * 128;
            __builtin_amdgcn_global_load_lds((const unsigned*)p_, (LAS unsigned*)(junk + wid * 256), 4, 0, 2); }
    }
    struct Raw { f32x4 f[2][2]; v4u h[2]; };
    __device__ __forceinline__ void load_raw(Raw& q, size_t off) const {
#pragma unroll
        for (int bj = 0; bj < 2; ++bj) {
            if (RB16) q.h[bj] = *(const v4u*)((const bf16*)R + off + bj * pg8::HALF);
            else { q.f[bj][0] = *(const f32x4*)((const float*)R + off + bj * pg8::HALF); q.f[bj][1] = *(const f32x4*)((const float*)R + off + bj * pg8::HALF + 4); } }
    }
    __device__ __forceinline__ void operator()(const pg8::f32x4 (&acc)[2][2][4][2], const pg8::Unit& u, int wr, int wc, int fr, int fq) const {
        const int row0 = u.pm * pg8::BM + wr * 64 + fr, col0 = u.pn * pg8::BM + wc * 32 + 8 * fq;
        constexpr int WIN = 4;
        Raw q[8]; float ss[8];
#pragma unroll
        for (int it = 0; it < WIN; ++it) load_raw(q[it], (size_t)(row0 + (it >> 2) * pg8::HALF + (it & 3) * 16) * 1024 + col0);
        __builtin_amdgcn_sched_barrier(0);
#pragma unroll
        for (int it = 0; it < 8; ++it) { const int ai = it >> 2, mm = it & 3; const int row = row0 + ai * pg8::HALF + mm * 16; const size_t off = (size_t)row * 1024 + col0;
            if (it + WIN < 8) { load_raw(q[it + WIN], (size_t)(row0 + ((it + WIN) >> 2) * pg8::HALF + ((it + WIN) & 3) * 16) * 1024 + col0); __builtin_amdgcn_sched_barrier(0); }
            float s = 0.f;
#pragma unroll
            for (int bj = 0; bj < 2; ++bj) {
                f32x4 r0, r1;
                if (RB16) { const v4u w = q[it].h[bj]; r0 = (f32x4){bflo(w.x), bfhi(w.x), bflo(w.y), bfhi(w.y)}; r1 = (f32x4){bflo(w.z), bfhi(w.z), bflo(w.w), bfhi(w.w)}; } else { r0 = q[it].f[bj][0]; r1 = q[it].f[bj][1]; }
                const f32x4 v0 = acc[ai][bj][mm][0] + r0, v1 = acc[ai][bj][mm][1] + r1;
                if (OUTF) { *(f32x4*)(C + off + bj * pg8::HALF) = v0; *(f32x4*)(C + off + bj * pg8::HALF + 4) = v1; }
                if (OUTB) { s += ((v0.x * v0.x + v0.y * v0.y) + (v0.z * v0.z + v0.w * v0.w)) + ((v1.x * v1.x + v1.y * v1.y) + (v1.z * v1.z + v1.w * v1.w));
                    v4u w; w.x = pk2(v0.x, v0.y); w.y = pk2(v0.z, v0.w); w.z = pk2(v1.x, v1.y); w.w = pk2(v1.z, v1.w); *(v4u*)(XB + off + bj * pg8::HALF) = w; } }
            if (OUTB) { s += __shfl_xor(s, 16); s += __shfl_xor(s, 32); ss[it] = s; }
            asm volatile("" ::: "memory"); }
        if (OUTB) { if (fq == 0) {
#pragma unroll
            for (int it = 0; it < 8; ++it) atomicAdd(SSQ + row0 + (it >> 2) * pg8::HALF + (it & 3) * 16, (unsigned long long)(ss[it] * 1073741824.0f)); } }
    }
};
typedef unsigned v2u __attribute__((ext_vector_type(2))); typedef float f32x2 __attribute__((ext_vector_type(2)));
__device__ __forceinline__ float rstd_of(const unsigned long long* SSQ, int row, float inv_n) { const v2u s = ((const v2u*)SSQ)[row]; const float c = inv_n * (1.0f / 1073741824.0f);
    return __builtin_amdgcn_rsqf(__builtin_fmaf((float)s.y, 4294967296.0f * c, __builtin_fmaf((float)s.x, c, EPS))); }
__device__ __forceinline__ f32x2 pk_add_one(f32x2 a) { asm("" : "+v"(a)); return a + 1.0f; }
template <int N> __device__ __forceinline__ float dpp_shr0(float v) { return __builtin_bit_cast(float, __builtin_amdgcn_update_dpp(0, __builtin_bit_cast(int, v), 0x110 + N, 0xf, 0xf, true)); }
template <int N> __device__ __forceinline__ float dpp_shr_old(float old, float v) { return __builtin_bit_cast(float, __builtin_amdgcn_update_dpp(__builtin_bit_cast(int, old), __builtin_bit_cast(int, v), 0x110 + N, 0xf, 0xf, false)); }
template <int N> __device__ __forceinline__ float dpp_ror(float v) { return __builtin_bit_cast(float, __builtin_amdgcn_update_dpp(0, __builtin_bit_cast(int, v), 0x120 + N, 0xf, 0xf, false)); }
struct EpiFfnUp {
    static constexpr bool PERM = true, AFTER_DRAIN = false;
    bf16* ACT; bf16* UB; const unsigned long long* SSQ; const float* cw; const float* cb;
    __device__ __forceinline__ void operator()(const pg8::f32x4 (&acc)[2][2][4][2], const pg8::Unit& u, int wr, int wc, int fr, int fq) const {
        const int ch0 = u.pn * 128 + wc * 32 + 8 * fq;
        const int rowc = u.pm * pg8::BM + wr * 128;
        float rs[2][4];
#pragma unroll
        for (int ai = 0; ai < 2; ++ai)
#pragma unroll
            for (int m = 0; m < 4; ++m) rs[ai][m] = rstd_of(SSQ, rowc + 8 * fr + 4 * ai + m, 1.0f / 1024.0f);
        unsigned long long keep[2][4];
#pragma unroll
        for (int n = 0; n < 2; ++n) {
            __builtin_amdgcn_sched_barrier(0);
            const int ch = ch0 + 4 * n;
            const f32x4 wg0 = *(const f32x4*)(cw + ch), wg1 = *(const f32x4*)(cw + DFF2 + ch), wg2 = *(const f32x4*)(cw + 2 * DFF2 + ch), bg = *(const f32x4*)(cw + 3 * DFF2 + ch);
            const f32x4 wu0 = *(const f32x4*)(cw + DFF + ch), wu1 = *(const f32x4*)(cw + DFF2 + DFF + ch), wu2 = *(const f32x4*)(cw + 2 * DFF2 + DFF + ch), bu = *(const f32x4*)(cw + 3 * DFF2 + DFF + ch);
            const f32x4 g6 = acc[1][0][2][n] * rs[1][2], g7 = acc[1][0][3][n] * rs[1][3], u6 = acc[1][1][2][n] * rs[1][2], u7 = acc[1][1][3][n] * rs[1][3];
            f32x4 gp2, gp1, up2, up1;
#pragma unroll
            for (int j = 0; j < 4; ++j) { gp2[j] = dpp_shr0<1>(g6[j]); gp1[j] = dpp_shr0<1>(g7[j]); up2[j] = dpp_shr0<1>(u6[j]); up1[j] = dpp_shr0<1>(u7[j]); }
#pragma unroll
            for (int ai = 0; ai < 2; ++ai) {
                f32x4 g[4], uu[4];
#pragma unroll
                for (int m = 0; m < 4; ++m) { if (ai == 1 && m >= 2) { g[m] = (m == 2) ? g6 : g7; uu[m] = (m == 2) ? u6 : u7; } else { g[m] = acc[ai][0][m][n] * rs[ai][m]; uu[m] = acc[ai][1][m][n] * rs[ai][m]; } }
#pragma unroll
                for (int m = 0; m < 4; ++m) {
                    const f32x4 sg1 = (m == 0) ? gp1 : g[m - 1], sg2 = (m == 0) ? gp2 : (m == 1) ? gp1 : g[m - 2];
                    const f32x4 su1 = (m == 0) ? up1 : uu[m - 1], su2 = (m == 0) ? up2 : (m == 1) ? up1 : uu[m - 2];
                    const f32x4 cg = bg + wg0 * sg2 + wg1 * sg1 + wg2 * g[m], cu = bu + wu0 * su2 + wu1 * su1 + wu2 * uu[m];
                    f32x4 r_;
                    { const f32x2 d0 = pk_add_one((f32x2){__builtin_amdgcn_exp2f(cg[0]), __builtin_amdgcn_exp2f(cg[1])}), d1 = pk_add_one((f32x2){__builtin_amdgcn_exp2f(cg[2]), __builtin_amdgcn_exp2f(cg[3])});
                      r_[0] = __builtin_amdgcn_rcpf(d0.x); r_[1] = __builtin_amdgcn_rcpf(d0.y); r_[2] = __builtin_amdgcn_rcpf(d1.x); r_[3] = __builtin_amdgcn_rcpf(d1.y); }
                    const f32x4 a = cg * r_ * cu;
                    const int row = rowc + 8 * fr + 4 * ai + m;
                    const unsigned long long pk_ = (unsigned long long)pk2(a[0], a[1]) | ((unsigned long long)pk2(a[2], a[3]) << 32);
                    if (n == 0) { keep[ai][m] = pk_; asm volatile("" : "+v"(keep[ai][m])); }
                    else if (!(ai == 0 && fr == 0 && m < 2)) { v4u w; w.x = (unsigned)keep[ai][m]; w.y = (unsigned)(keep[ai][m] >> 32); w.z = (unsigned)pk_; w.w = (unsigned)(pk_ >> 32); *(v4u*)(ACT + (size_t)row * DFF + ch0) = w; }
                    if ((ai == 0 && m < 2) || (ai == 1 && m >= 2)) {
                        if ((ai == 0) ? (fr == 0) : (fr == 15)) { bf16* ub = UB + ((size_t)(rowc >> 7) * 4 + m) * DFF2 + ch;
                            *(unsigned long long*)ub = (unsigned long long)pk2(g[m][0], g[m][1]) | ((unsigned long long)pk2(g[m][2], g[m][3]) << 32);
                            *(unsigned long long*)(ub + DFF) = (unsigned long long)pk2(uu[m][0], uu[m][1]) | ((unsigned long long)pk2(uu[m][2], uu[m][3]) << 32); } }
                    if (m == 1) { gp2 = g[2]; gp1 = g[3]; up2 = uu[2]; up1 = uu[3]; }
                }
            }
        }
    }
};


struct EpiScale {
    static constexpr bool PERM = true, AFTER_DRAIN = false;
    bf16* O; int ldc; const unsigned long long* SSQ; float inv_n;
    __device__ __forceinline__ void operator()(const pg8::f32x4 (&acc)[2][2][4][2], const pg8::Unit& u, int wr, int wc, int fr, int fq) const {
        const int row0 = u.pm * pg8::BM + wr * 64 + fr, col0 = u.pn * pg8::BM + wc * 32 + 8 * fq;
#pragma unroll
        for (int ai = 0; ai < 2; ++ai)
#pragma unroll
            for (int m = 0; m < 4; ++m) { const int row = row0 + ai * pg8::HALF + m * 16; const float rs = rstd_of(SSQ, row, inv_n); bf16* rowp = O + (size_t)row * ldc + col0;
#pragma unroll
                for (int bj = 0; bj < 2; ++bj) { const f32x4 v0 = acc[ai][bj][m][0] * rs, v1 = acc[ai][bj][m][1] * rs;
                    v4u w; w.x = pk2(v0[0], v0[1]); w.y = pk2(v0[2], v0[3]); w.z = pk2(v1[0], v1[1]); w.w = pk2(v1[2], v1[3]); *(v4u*)(rowp + bj * pg8::HALF) = w; } }
    }
};
struct EpiMlaIn {
    static constexpr bool PERM = true, AFTER_DRAIN = false;
    bf16* O; const unsigned long long* SSQ; unsigned long long* SSQ_Q; unsigned long long* SSQ_KV; float* SSQPE; float* RG; const float* kg; const float* TAB;
    __device__ __forceinline__ void operator()(const pg8::f32x4 (&acc)[2][2][4][2], const pg8::Unit& u, int wr, int wc, int fr, int fq) const {
        const int row0 = u.pm * pg8::BM + wr * 64 + fr, col0 = u.pn * pg8::BM + wc * 32 + 8 * fq;
        unsigned long long* tgt = (u.pn < 2) ? SSQ_Q : SSQ_KV;
        float rsv[8];
#pragma unroll
        for (int i = 0; i < 8; ++i) rsv[i] = rstd_of(SSQ, row0 + (i >> 2) * pg8::HALF + (i & 3) * 16, 1.0f / 1024.0f);
        if (u.pn < 3) {
#pragma unroll
        for (int ai = 0; ai < 2; ++ai)
#pragma unroll
            for (int m = 0; m < 4; ++m) { const int row = row0 + ai * pg8::HALF + m * 16; const float rs = rsv[ai * 4 + m]; bf16* rowp = O + (size_t)row * 1024 + col0; float s = 0.f;
#pragma unroll
                for (int bj = 0; bj < 2; ++bj) { const f32x4 v0 = acc[ai][bj][m][0] * rs, v1 = acc[ai][bj][m][1] * rs;
                    s += (v0[0] * v0[0] + v0[1] * v0[1]) + (v0[2] * v0[2] + v0[3] * v0[3]) + (v1[0] * v1[0] + v1[1] * v1[1]) + (v1[2] * v1[2] + v1[3] * v1[3]);
                    v4u w; w.x = pk2(v0[0], v0[1]); w.y = pk2(v0[2], v0[3]); w.z = pk2(v1[0], v1[1]); w.w = pk2(v1[2], v1[3]); *(v4u*)(rowp + bj * pg8::HALF) = w; }
                s += __shfl_xor(s, 16); s += __shfl_xor(s, 32); if (fq == 0) atomicAdd(tgt + row, (unsigned long long)(s * 1073741824.0f)); asm volatile("" ::: "memory"); }
        } else if (wc == 0) {
            const f32x4 g0 = *(const f32x4*)(kg + 64 + 8 * fq), g1 = *(const f32x4*)(kg + 64 + 8 * fq + 4);
            f32x4 tn[4]; { const float* tb = TAB + ((row0 & 2047) * 16 + 8 * (fq & 1)) * 2; tn[0] = *(const f32x4*)tb; tn[1] = *(const f32x4*)(tb + 4); tn[2] = *(const f32x4*)(tb + 8); tn[3] = *(const f32x4*)(tb + 12); }
#pragma unroll
            for (int ai = 0; ai < 2; ++ai)
#pragma unroll
                for (int m = 0; m < 4; ++m) { const int row = row0 + ai * pg8::HALF + m * 16; const float rs = rsv[ai * 4 + m];
                    const f32x4 ta = tn[0], tb4 = tn[1], tc = tn[2], td = tn[3];
                    if (ai * 4 + m < 7) { const int i1 = ai * 4 + m + 1; const float* tb = TAB + (((row0 + (i1 >> 2) * pg8::HALF + (i1 & 3) * 16) & 2047) * 16 + 8 * (fq & 1)) * 2; tn[0] = *(const f32x4*)tb; tn[1] = *(const f32x4*)(tb + 4); tn[2] = *(const f32x4*)(tb + 8); tn[3] = *(const f32x4*)(tb + 12); }
                    const f32x4 v0 = acc[ai][0][m][0] * rs, v1 = acc[ai][0][m][1] * rs;
                    float s = (v0[0] * v0[0] + v0[1] * v0[1]) + (v0[2] * v0[2] + v0[3] * v0[3]) + (v1[0] * v1[0] + v1[1] * v1[1]) + (v1[2] * v1[2] + v1[3] * v1[3]);
                    s += __shfl_xor(s, 16); s += __shfl_xor(s, 32); if (fq == 0) SSQPE[row] = s;
                    const f32x4 y0 = v0 * g0, y1 = v1 * g1;
                    f32x4 p0, p1;
#pragma unroll
                    for (int j = 0; j < 4; ++j) { p0[j] = __shfl_xor(y0[j], 32); p1[j] = __shfl_xor(y1[j], 32); }
                    const f32x4 c0 = {ta[0], ta[2], tb4[0], tb4[2]}, s0 = {ta[1], ta[3], tb4[1], tb4[3]}, c1 = {tc[0], tc[2], td[0], td[2]}, s1 = {tc[1], tc[3], td[1], td[3]};
                    f32x4 o0, o1;
                    if (fq < 2) { o0 = y0 * c0 - p0 * s0; o1 = y1 * c1 - p1 * s1; } else { o0 = p0 * s0 + y0 * c0; o1 = p1 * s1 + y1 * c1; }
                    float* rg = RG + (size_t)row * 32 + 8 * fq; *(f32x4*)rg = o0; *(f32x4*)(rg + 4) = o1; asm volatile("" ::: "memory"); }
        }
    }
};
struct EpiUkv {
    static constexpr bool PERM = true, AFTER_DRAIN = false;
    bf16* K2; bf16* V2; const unsigned long long* SSQ; const float* SSQPE; const float* RG; const float* kg;
    __device__ __forceinline__ void operator()(const pg8::f32x4 (&acc)[2][2][4][2], const pg8::Unit& u, int wr, int wc, int fr, int fq) const {
        const int row0 = u.pm * pg8::BM + wr * 64 + fr;
        if (u.pn < 4) {
            const int head = 4 * u.pn + wc;
            f32x4 g1[2], g2[2];
#pragma unroll
            for (int n = 0; n < 2; ++n) { g1[n] = *(const f32x4*)(kg + 8 * fq + 4 * n); g2[n] = *(const f32x4*)(kg + 32 + 8 * fq + 4 * n); }
            float rsv[8], pev[8];
#pragma unroll
            for (int i = 0; i < 8; ++i) { const int row = row0 + (i >> 2) * pg8::HALF + (i & 3) * 16; rsv[i] = rstd_of(SSQ, row, 1.0f / 256.0f); pev[i] = SSQPE[row]; }
            f32x4 rgn0, rgn1; { const float* rg = RG + (size_t)row0 * 32 + 8 * fq; rgn0 = *(const f32x4*)rg; rgn1 = *(const f32x4*)(rg + 4); }
#pragma unroll
            for (int i = 0; i < 8; ++i) { const int row = row0 + (i >> 2) * pg8::HALF + (i & 3) * 16; const float rs = rsv[i];
                    const f32x4 rgc0 = rgn0, rgc1 = rgn1;
                    if (i < 7) { const float* rg = RG + (size_t)(row0 + ((i + 1) >> 2) * pg8::HALF + ((i + 1) & 3) * 16) * 32 + 8 * fq; rgn0 = *(const f32x4*)rg; rgn1 = *(const f32x4*)(rg + 4); }
                    const int ai = i >> 2, m = i & 3;
                    f32x4 a[2], b[2]; float s = 0.f;
#pragma unroll
                    for (int n = 0; n < 2; ++n) { a[n] = acc[ai][0][m][n] * rs; b[n] = acc[ai][1][m][n] * rs; s += (a[n][0] * a[n][0] + a[n][1] * a[n][1]) + (a[n][2] * a[n][2] + a[n][3] * a[n][3]) + (b[n][0] * b[n][0] + b[n][1] * b[n][1]) + (b[n][2] * b[n][2] + b[n][3] * b[n][3]); }
                    s += __shfl_xor(s, 16); s += __shfl_xor(s, 32);
                    const float rh = __builtin_amdgcn_rsqf((s + pev[i]) * (1.f / 96.f) + EPS);
                    const int pos = row & 2047; bf16* rp = K2 + ((((size_t)(row >> 11) * 16 + head) * 32 + (pos >> 6)) * 12 + fq) * 512 + (pos & 63) * 8;
                    { const f32x4 o0 = a[0] * rh * g1[0], o1 = a[1] * rh * g1[1]; v4u w; w.x = pk2(o0[0], o0[1]); w.y = pk2(o0[2], o0[3]); w.z = pk2(o1[0], o1[1]); w.w = pk2(o1[2], o1[3]); *(v4u*)rp = w; }
                    { const f32x4 o0 = b[0] * rh * g2[0], o1 = b[1] * rh * g2[1]; v4u w; w.x = pk2(o0[0], o0[1]); w.y = pk2(o0[2], o0[3]); w.z = pk2(o1[0], o1[1]); w.w = pk2(o1[2], o1[3]); *(v4u*)(rp + 4 * 512) = w; }
                    { const f32x4 o0 = rgc0 * rh, o1 = rgc1 * rh; v4u w; w.x = pk2(o0[0], o0[1]); w.y = pk2(o0[2], o0[3]); w.z = pk2(o1[0], o1[1]); w.w = pk2(o1[2], o1[3]); *(v4u*)(rp + 8 * 512) = w; }
                    asm volatile("" ::: "memory"); }
        } else {
            bf16* dst = V2 + (u.pn - 4) * 256 + wc * 32 + 8 * fq;
#pragma unroll
            for (int ai = 0; ai < 2; ++ai)
#pragma unroll
                for (int m = 0; m < 4; ++m) { const int row = row0 + ai * pg8::HALF + m * 16; const float rs = rstd_of(SSQ, row, 1.0f / 256.0f); bf16* rp = dst + (size_t)row * 1024;
#pragma unroll
                    for (int bj = 0; bj < 2; ++bj) { const f32x4 v0 = acc[ai][bj][m][0] * rs, v1 = acc[ai][bj][m][1] * rs;
                        v4u w; w.x = pk2(v0[0], v0[1]); w.y = pk2(v0[2], v0[3]); w.z = pk2(v1[0], v1[1]); w.w = pk2(v1[2], v1[3]); *(v4u*)(rp + bj * pg8::HALF) = w; } }
        }
    }
};

struct EpiIn0 {
    static constexpr bool PERM = true, AFTER_DRAIN = false;
    bf16* QK; bf16* KC; const float* TAB; const float* qn; const float* kn; float* KM; float* DTR;
    __device__ __forceinline__ void operator()(const pg8::f32x4 (&acc)[2][2][4][2], const pg8::Unit& u, int wr, int wc, int fr, int fq) const {
        const int row0 = u.pm * pg8::BM + wr * 64 + fr;
        if (u.pn < 4) {
            const bool isq = u.pn < 2; const float* gn = isq ? qn : kn; const int head = 4 * (u.pn & 1) + wc;
            bf16* dst = QK + (isq ? 0 : 512) + head * 64 + 8 * fq;
            f32x4 g1[2], g2[2], ks1[2], ks2[2];
#pragma unroll
            for (int n = 0; n < 2; ++n) { g1[n] = *(const f32x4*)(gn + 8 * fq + 4 * n); g2[n] = *(const f32x4*)(gn + 32 + 8 * fq + 4 * n); ks1[n] = (f32x4){0.f, 0.f, 0.f, 0.f}; ks2[n] = ks1[n]; }
#pragma unroll
            for (int ai = 0; ai < 2; ++ai)
#pragma unroll
                for (int m = 0; m < 4; ++m) { const int row = row0 + ai * pg8::HALF + m * 16, pos = row & 2047;
                    float s = 0.f;
#pragma unroll
                    for (int n = 0; n < 2; ++n) { const f32x4 a = acc[ai][0][m][n], b = acc[ai][1][m][n]; s += (a[0] * a[0] + a[1] * a[1]) + (a[2] * a[2] + a[3] * a[3]) + (b[0] * b[0] + b[1] * b[1]) + (b[2] * b[2] + b[3] * b[3]); }
                    s += __shfl_xor(s, 16); s += __shfl_xor(s, 32);
                    float rstd = 1.f / sqrtf(s * (1.f / 64.f) + EPS); if (isq) rstd *= 0.18033688011112042f;
                    f32x4 o1[2], o2[2];
#pragma unroll
                    for (int n = 0; n < 2; ++n) { const float* tb = TAB + (pos * 32 + 8 * fq + 4 * n) * 2; const f32x4 t0 = *(const f32x4*)tb, t1 = *(const f32x4*)(tb + 4);
                        const f32x4 cs_ = {t0[0], t0[2], t1[0], t1[2]}, sn = {t0[1], t0[3], t1[1], t1[3]};
                        const f32x4 y1 = acc[ai][0][m][n] * rstd * g1[n], y2 = acc[ai][1][m][n] * rstd * g2[n];
                        o1[n] = y1 * cs_ - y2 * sn; o2[n] = y1 * sn + y2 * cs_; ks1[n] += o1[n]; ks2[n] += o2[n]; }
                    bf16* rp = dst + (size_t)row * 1024; int st2 = 32;
                    if (!isq) { rp = KC + ((((size_t)(row >> 11) * 8 + head) * 32 + (pos >> 6)) * 8 + fq) * 512 + (pos & 63) * 8; st2 = 4 * 512; }
                    { v4u w; w.x = pk2(o1[0][0], o1[0][1]); w.y = pk2(o1[0][2], o1[0][3]); w.z = pk2(o1[1][0], o1[1][1]); w.w = pk2(o1[1][2], o1[1][3]); *(v4u*)rp = w; }
                    { v4u w; w.x = pk2(o2[0][0], o2[0][1]); w.y = pk2(o2[0][2], o2[0][3]); w.z = pk2(o2[1][0], o2[1][1]); w.w = pk2(o2[1][2], o2[1][3]); *(v4u*)(rp + st2) = w; }
                    asm volatile("" ::: "memory"); }
            if (!isq) {
                float* km = KM + (((size_t)(u.pm >> 3) * 8 + (u.pm & 7)) * 8 + head) * 64 + 8 * fq;
#pragma unroll
                for (int n = 0; n < 2; ++n)
#pragma unroll
                    for (int j = 0; j < 4; ++j) { float a = ks1[n][j], b = ks2[n][j];
#pragma unroll
                        for (int o = 1; o < 16; o <<= 1) { a += __shfl_xor(a, o); b += __shfl_xor(b, o); }
                        if (fr == 0) { atomicAdd(km + 4 * n + j, a * (1.f / 256.f)); atomicAdd(km + 32 + 4 * n + j, b * (1.f / 256.f)); } } }
        } else if (u.pn < 12) {
            bf16* dst = QK + (size_t)(u.pn >> 2) * ((size_t)T_ * 1024) + (u.pn & 3) * 256 + wc * 32 + 8 * fq;
#pragma unroll
            for (int ai = 0; ai < 2; ++ai)
#pragma unroll
                for (int m = 0; m < 4; ++m) { bf16* rp = dst + (size_t)(row0 + ai * pg8::HALF + m * 16) * 1024;
#pragma unroll
                    for (int bj = 0; bj < 2; ++bj) { const f32x4 v0 = acc[ai][bj][m][0], v1 = acc[ai][bj][m][1];
                        v4u w; w.x = pk2(v0[0], v0[1]); w.y = pk2(v0[2], v0[3]); w.z = pk2(v1[0], v1[1]); w.w = pk2(v1[2], v1[3]); *(v4u*)(rp + bj * pg8::HALF) = w; } }
        } else if (wc == 0 && fq == 0) {
#pragma unroll
            for (int ai = 0; ai < 2; ++ai)
#pragma unroll
                for (int m = 0; m < 4; ++m) { float* rp = DTR + (size_t)(row0 + ai * pg8::HALF + m * 16) * 8; *(f32x4*)rp = acc[ai][0][m][0]; *(f32x4*)(rp + 4) = acc[ai][0][m][1]; }
        }
    }
};

__device__ __forceinline__ void ffn_fix_rows(int i0, int i1, int step, const bf16* UB, bf16* ACT, const float* cw, const float* cb) {
#pragma unroll 1
    for (int il = i0; il < i1; il += step) {
        const int c0 = (il % (DFF / 8)) * 8, rr = (il / (DFF / 8)) & 1, ck = il / (2 * (DFF / 8)); const bool first = (ck & 15) == 0;
        v4u wg[3], wu[3]; f32x4 kg[3][2], ku[3][2]; float vm[3];
#pragma unroll
        for (int k = 0; k < 3; ++k) { const int rel = rr - 2 + k; const bool ok = (rel >= 0) || !first;
            const size_t srow = (rel >= 0) ? (size_t)ck * 4 + rel : (ok ? (size_t)(ck - 1) * 4 + 4 + rel : (size_t)ck * 4);
            const bf16* src = UB + srow * DFF2; wg[k] = *(const v4u*)(src + c0); wu[k] = *(const v4u*)(src + DFF + c0); vm[k] = ok ? 1.f : 0.f;
            const float* kp = cw + k * DFF2 + c0; kg[k][0] = *(const f32x4*)kp; kg[k][1] = *(const f32x4*)(kp + 4); ku[k][0] = *(const f32x4*)(kp + DFF); ku[k][1] = *(const f32x4*)(kp + DFF + 4); }
        f32x4 ag0 = *(const f32x4*)(cb + c0), ag1 = *(const f32x4*)(cb + c0 + 4), au0 = *(const f32x4*)(cb + DFF + c0), au1 = *(const f32x4*)(cb + DFF + c0 + 4);
#pragma unroll
        for (int k = 0; k < 3; ++k) {
            const f32x4 g0 = (f32x4){bflo(wg[k].x), bfhi(wg[k].x), bflo(wg[k].y), bfhi(wg[k].y)} * vm[k], g1 = (f32x4){bflo(wg[k].z), bfhi(wg[k].z), bflo(wg[k].w), bfhi(wg[k].w)} * vm[k];
            const f32x4 u0 = (f32x4){bflo(wu[k].x), bfhi(wu[k].x), bflo(wu[k].y), bfhi(wu[k].y)} * vm[k], u1 = (f32x4){bflo(wu[k].z), bfhi(wu[k].z), bflo(wu[k].w), bfhi(wu[k].w)} * vm[k];
            ag0 += kg[k][0] * g0; ag1 += kg[k][1] * g1; au0 += ku[k][0] * u0; au1 += ku[k][1] * u1; }
        f32x4 o0, o1;
#pragma unroll
        for (int j = 0; j < 4; ++j) { o0[j] = ag0[j] * __builtin_amdgcn_rcpf(1.f + __expf(-ag0[j])) * au0[j]; o1[j] = ag1[j] * __builtin_amdgcn_rcpf(1.f + __expf(-ag1[j])) * au1[j]; }
        v4u o; o.x = pk2(o0[0], o0[1]); o.y = pk2(o0[2], o0[3]); o.z = pk2(o1[0], o1[1]); o.w = pk2(o1[2], o1[3]);
        *(v4u*)(ACT + ((size_t)ck * 128 + rr) * DFF + c0) = o; }
}

template <class Epi, int AROW = 0> __device__ __forceinline__ void run_gemm(LAS unsigned char* lds, const bf16* A, const bf16* Bt, int M, int N, int K, const Epi& E, int lda = 0) {
    pg8::Gemm g{A, Bt, M, N, K, lda ? lda : K}; pg8::StaticOrder S; S.init(M, N, (int)gridDim.x, (int)blockIdx.x);
    pg8::gemm_phase<Epi, pg8::StaticOrder, PG8_ALIGN, PG8_SP2, AROW>(lds + RING_OFF, g, S, E);
}

#define NPHASES 40
__global__ void __launch_bounds__(NTHR, 2) fwd(Args args) {
    extern __shared__ __attribute__((aligned(16))) unsigned char lds_raw[];
    LAS unsigned char* lds = (LAS unsigned char*)lds_raw;
    volatile LAS unsigned* MISC = (volatile LAS unsigned*)(lds + MISC_OFF);
    {
        const int tid0 = threadIdx.x;
        for (int u = tid0; u < (LDS_BYTES - LDSCTL_OFF) / 4; u += NTHR) ((LAS unsigned*)(lds + LDSCTL_OFF))[u] = 0u;
    }
    __syncthreads();
    int lo, hi; { KArgs A0 = kargs(); lo = A0->ph_lo; hi = A0->ph_hi; }
    const bool multi = (hi - lo) > 1;
    XcdBarrier bar; bar.bar = nullptr; bar.x = 0; bar.st = nullptr;
    if (multi) { KArgs A0 = kargs(); bar = xcd_barrier_post((unsigned*)((gu32*)(A0->ws + WS_CTL) + CW_BAR), MISC + 8); }
#define IN(k) (lo <= (k) && (k) < hi)
#ifndef PROBE_MASK
#define PROBE_MASK 0u
#endif
    unsigned long long pr_acc = 0ull, pr_t = 0ull;
    if (PROBE_MASK) pr_t = __builtin_amdgcn_s_memrealtime();
#define SEAM(k) do { if (IN(k) && IN((k) + 1)) xcd_barrier(bar); \
        if (PROBE_MASK) { const unsigned long long now_ = __builtin_amdgcn_s_memrealtime(); if ((PROBE_MASK >> (k)) & 1u) pr_acc += now_ - pr_t; pr_t = now_; } } while (0)

    if (IN(0)) { PH_VARS
        LAS float* scr = (LAS float*)(lds + RING_OFF + wave * 16384);
        { f32x4 cur[8], nxt[8]; int it = gw, li = 0, ln = 0; MatDesc d{}, dn{};
          if (it < NIT_W) { d = mat_of(A_, ws, it, li); trl_load(cur, d, li, lane); }
          while (it < NIT_W) { const int nit = it + NGW; const bool more = nit < NIT_W;
              if (more) { dn = mat_of(A_, ws, nit, ln); trl_load(nxt, dn, ln, lane); }
              tr_store(cur, d.K, d.WT, scr, li, d.nblk, lane);
              if (more) {
#pragma unroll
                  for (int i = 0; i < 8; ++i) cur[i] = nxt[i];
                  d = dn; li = ln; }
              it = nit; } }
        { float* cws = (float*)(ws + WS_CWS); const float* cw_ = A_->in[22]; const float* cb_ = A_->in[23];
          for (int i = gt; i < 2 * 4 * DFF2; i += NGT) { const int l = i / (4 * DFF2), r = i - l * 4 * DFF2, k = r / DFF2, c = r - k * DFF2;
              const float v = (k < 3) ? cw_[((size_t)l * 3 + k) * DFF2 + c] : cb_[(size_t)l * DFF2 + c]; cws[i] = v * (c < DFF ? -1.44269504088896341f : -0.693147180559945309f); } }
        float* t64 = (float*)(ws + WS_TAB64); float* t32 = (float*)(ws + WS_TAB32);
        for (int i = gt; i < 2048 * 32; i += NGT) { const int pos = i >> 5, f = i & 31; const float inv = 1.0f / powf(10000.0f, (float)(2 * f) / 64.0f); const float ang = (float)pos * inv; t64[2 * i] = cosf(ang); t64[2 * i + 1] = sinf(ang); }
        for (int i = gt; i < 2048 * 16; i += NGT) { const int pos = i >> 4, f = i & 15; const float inv = 1.0f / powf(10000.0f, (float)(2 * f) / 32.0f); const float ang = (float)pos * inv; t32[2 * i] = cosf(ang); t32[2 * i + 1] = sinf(ang); }
        asm volatile("s_waitcnt vmcnt(0) lgkmcnt(0)" ::: "memory"); __syncthreads();
        { LAS f32x4* W2 = (LAS f32x4*)(lds + RING_OFF); const float* Wi = A_->in[3]; const float* gg = A_->in[1];
          for (int i = tid; i < 2048; i += NTHR) { const int ln = i & 63, sh = i >> 6, sl = sh >> 1, half = sh & 1, k = 4 * ln + 256 * (sl >> 2) + (sl & 3);
              W2[i] = *(const f32x4*)(Wi + (size_t)k * 3080 + 3072 + 4 * half) * gg[k]; }
          asm volatile("s_waitcnt vmcnt(0) lgkmcnt(0)" ::: "memory"); __syncthreads();
          rms_rows_dt(x, A_->in[1], XN, (float*)(ws + WS_DTR), W2, gw, NGW, lane); }
    }
    SEAM(0);
    if (IN(1)) { PH_VARS EpiIn0 E{(bf16*)(ws + L0_QK), (bf16*)(ws + L0_KC), TAB64, A_->in[10], A_->in[11], (float*)(ws + WS_KMEAN), (float*)(ws + WS_DTR)}; run_gemm(lds, XN, (const bf16*)(ws + WS_W_IN0), T_, 3072, 1024, E); }
    SEAM(1);
    if (IN(2)) { PH_VARS
        for (int u = blockIdx.x; u < 512; u += G) ssd::states_unit(lds, u >> 1, u & 1, (const bf16*)(ws + L0_XBC), (const float*)(ws + WS_DTR), A_->in[4], A_->in[5], A_->in[6], A_->in[7], (float*)(ws + L0_ST), (float*)(ws + WS_CEND));
    }
    SEAM(2);
    if (IN(3)) { PH_VARS
        const float* ST = (const float*)(ws + L0_ST); const float* CEND = (const float*)(ws + WS_CEND); bf16* HIN = (bf16*)(ws + L0_HIN);
        auto do_scan = [&]() {
        for (int i = gt; i < 16 * 8 * 64 * 128 / 4; i += NGT) {
            const int pn = (i & 2047) * 4, h = (i >> 11) & 7, b = i >> 14; f32x4 hst = {0.f, 0.f, 0.f, 0.f}; f32x4 tmp[16]; float dec[16];
#pragma unroll
            for (int c = 0; c < 16; ++c) { tmp[c] = *(const f32x4*)(ST + (((size_t)((b * 16 + c) * 8 + h) << 13) + pn)); dec[c] = CEND[(b * 16 + c) * 8 + h]; }
#pragma unroll
            for (int c = 0; c < 16; ++c) { const size_t idx = ((size_t)((b * 16 + c) * 8 + h) << 13) + pn;
                *(unsigned long long*)(HIN + idx) = (unsigned long long)pk2(hst.x, hst.y) | ((unsigned long long)pk2(hst.z, hst.w) << 32);
                hst = hst * __expf(dec[c]) + tmp[c]; }
        }
            asm volatile("s_waitcnt vmcnt(0) lgkmcnt(0)" ::: "memory"); };
        const bf16* QK = (const bf16*)(ws + L0_QK); const bf16* VZ = (const bf16*)(ws + L0_VZ); const float* KM = (const float*)(ws + WS_KMEAN); bf16* MIX = (bf16*)(ws + L0_MIX);
        float kb0; { float gm = fabsf(A_->in[11][lane]);
#pragma unroll
          for (int o_ = 1; o_ < 64; o_ <<= 1) gm = fmaxf(gm, __shfl_xor(gm, o_));
          kb0 = 8.0f * 1.02f * gm; }
        { int tb = 0, pbh = -1;
          int un_ = 0; const int scan_at = (int)(blockIdx.x & 3);
          for (int i = blockIdx.x; i < 1024; i += G) {
            if (un_ == scan_at) do_scan(); ++un_;
            const int s_ = i >> 8, c = i & 255, bh = c >> 1, half = c & 1, qb = (s_ & 1) ? (s_ - 1 + half) : (7 - half - s_), b = bh >> 3, h = bh & 7;
            const int in_ = i + G; const bool hn = (in_ < 1024) && (((in_ & 255) >> 1) == bh);
            at2::Tensors TT{QK + h * 64, (const bf16*)(ws + L0_KC) + (size_t)(b * 8 + h) * (32 * 8 * 512), VZ + h * 64, MIX + h * 64, 1024, 0, 1024, 1024};
            at2::attn_unit_p<64, true, false, 2>(lds, TT, (long)b * 2048, qb, KM + b * 4096 + h * 64, nullptr, nullptr, kb0, tb, pbh == bh, hn);
            tb = (tb + 4 * (qb + 1)) % 6; pbh = hn ? bh : -1; } }
    }
    SEAM(3);
    if (IN(4)) { PH_VARS
        for (int u = blockIdx.x; u < 512; u += G) ssd::out_unit(lds, u >> 1, u & 1, (const bf16*)(ws + L0_XBC), (const bf16*)(ws + L0_VZ), (const float*)(ws + WS_DTR), A_->in[4], A_->in[5], A_->in[6], A_->in[7],
                                                               (const bf16*)(ws + L0_HIN), A_->in[8], A_->in[9], (bf16*)(ws + L0_MIX));
    }
    SEAM(4);
    if (IN(5)) { PH_VARS EpiRes<false, false, true> E{nullptr, x, XN, (unsigned long long*)(ws + WS_SSQA)}; run_gemm(lds, (const bf16*)(ws + L0_MIX), (const bf16*)(ws + WS_W_OUT0), T_, 1024, 1024, E); }
    SEAM(5);
#define FFN_PHASES(P, L, AIN, SSQ_IN, LASTL, SSQ_OUT) \
    if (IN(P)) { PH_VARS EpiFfnUp E{(bf16*)(ws + FF_ACT), (bf16*)(ws + FF_UB), (const unsigned long long*)(ws + (SSQ_IN)), (const float*)(ws + WS_CWS) + (size_t)(L) * 4 * DFF2, nullptr}; \
        run_gemm<EpiFfnUp, 3>(lds, (const bf16*)(ws + (AIN)), (const bf16*)(ws + WS_W_UP) + (size_t)(L) * DFF2 * 1024, T_, DFF2, 1024, E); } \
    SEAM(P); \
    if (IN((P) + 1)) { PH_VARS ffn_fix_rows(gt, 256 * 2 * (DFF / 8), NGT, (const bf16*)(ws + FF_UB), (bf16*)(ws + FF_ACT), A_->in[22] + (size_t)(L) * 3 * DFF2, A_->in[23] + (size_t)(L) * DFF2); } \
    SEAM((P) + 1); \
    if (IN((P) + 2)) { PH_VARS EpiRes<true, LASTL, !LASTL> E{out, (const bf16*)(ws + (AIN)), (bf16*)(ws + (AIN)), (unsigned long long*)(ws + (SSQ_OUT))}; run_gemm(lds, (const bf16*)(ws + FF_ACT), (const bf16*)(ws + WS_W_DN) + (size_t)(L) * 1024 * DFF, T_, 1024, DFF, E); } \
    SEAM((P) + 2);
    FFN_PHASES(6, 0, WS_XN, WS_SSQA, false, WS_SSQB)
    if (IN(9)) { PH_VARS EpiMlaIn E{(bf16*)(ws + L1_C1), (const unsigned long long*)(ws + WS_SSQB), (unsigned long long*)(ws + WS_SSQQ), (unsigned long long*)(ws + WS_SSQKV), (float*)(ws + WS_SSQPE), (float*)(ws + WS_RG), A_->in[19], TAB32}; run_gemm(lds, XN, (const bf16*)(ws + WS_W_IN1), T_, 1024, 1024, E); }
    SEAM(9);
    if (IN(10)) { PH_VARS const bf16* C1 = (const bf16*)(ws + L1_C1);
        { EpiScale E{(bf16*)(ws + L1_QR), 1536, (const unsigned long long*)(ws + WS_SSQQ), 1.0f / 512.0f}; run_gemm(lds, C1, (const bf16*)(ws + WS_W_UQ), T_, 1536, 512, E, 1024); }
        { EpiUkv E{(bf16*)(ws + L1_K2), (bf16*)(ws + L1_V2), (const unsigned long long*)(ws + WS_SSQKV), (const float*)(ws + WS_SSQPE), (const float*)(ws + WS_RG), A_->in[19]}; run_gemm(lds, C1 + 512, (const bf16*)(ws + WS_W_UKV), T_, 2048, 256, E, 1024); } }
    SEAM(10);
    if (IN(11)) { PH_VARS
        const bf16* Q2 = (const bf16*)(ws + L1_QR); const bf16* K2 = (const bf16*)(ws + L1_K2); const bf16* V2 = (const bf16*)(ws + L1_V2); bf16* O = (bf16*)(ws + L1_O);
        float kb1; { float gm = fmaxf(fabsf(A_->in[19][lane]), (lane < 32) ? fabsf(A_->in[19][64 + lane]) : 0.f);
#pragma unroll
          for (int o_ = 1; o_ < 64; o_ <<= 1) gm = fmaxf(gm, __shfl_xor(gm, o_));
          kb1 = 9.797958971f * 1.02f * gm; }
        { int tb = 0, pbh = -1;
          for (int i = blockIdx.x; i < 2048; i += G) {
            const int s_ = i >> 8, bh = i & 255, qb = 7 - s_, b = bh >> 4, h = bh & 15;
            const int in_ = i + G; const bool hn = (in_ < 2048) && ((in_ & 255) == bh);
            at2::Tensors TT{Q2 + h * 96, K2 + (size_t)(b * 16 + h) * (32 * 12 * 512), V2 + h * 64, O + h * 64, 1536, 0, 1024, 1024};
            at2::attn_unit_p<96, false, true, 2>(lds, TT, (long)b * 2048, qb, nullptr, A_->in[18], TAB32, kb1, tb, pbh == bh, hn);
            tb = (tb + 4 * (qb + 1)) % 6; pbh = hn ? bh : -1; } }
    }
    SEAM(11);
    if (IN(12)) { PH_VARS EpiRes<true, false, true> E{nullptr, XN, (bf16*)(ws + WS_BIG), (unsigned long long*)(ws + WS_SSQC)}; run_gemm(lds, (const bf16*)(ws + L1_O), (const bf16*)(ws + WS_W_OUT1), T_, 1024, 1024, E); }
    SEAM(12);
    FFN_PHASES(13, 1, WS_BIG, WS_SSQC, true, WS_SSQB)
    if (PROBE_MASK) { if (blockIdx.x == 0 && threadIdx.x == 0) { const unsigned long long t0 = __builtin_amdgcn_s_memrealtime(); while (__builtin_amdgcn_s_memrealtime() - t0 < pr_acc) __builtin_amdgcn_s_sleep(8); } }
#undef IN
#undef SEAM
}
constexpr int LAST_PHASE = 16;

#ifndef MK_ONE_LAUNCH
#define MK_ONE_LAUNCH 1
#endif
extern "C" void kernel_launch(void* const* d_in, const int* in_sizes, int n_in, void* d_out, int out_size, void* d_ws, size_t ws_size, hipStream_t stream) {
    static int grid = 0;
    if (grid == 0) {
        if (n_in != 25 || out_size != T_ * D_ || ws_size < WS_END) { fprintf(stderr, "kernel_launch: unexpected shapes: n_in %d out %d ws %zu\n", n_in, out_size, ws_size); grid = -1; return; }
        if (hipFuncSetAttribute((const void*)fwd, hipFuncAttributeMaxDynamicSharedMemorySize, LDS_BYTES) != hipSuccess) { fprintf(stderr, "kernel_launch: hipFuncSetAttribute failed\n"); grid = -1; return; }
        int dev = 0, cus = 0, per_cu = 0;
        hipGetDevice(&dev); hipDeviceGetAttribute(&cus, hipDeviceAttributeMultiprocessorCount, dev);
        hipOccupancyMaxActiveBlocksPerMultiprocessor(&per_cu, (const void*)fwd, NTHR, LDS_BYTES);
        (void)hipGetLastError();
        grid = (per_cu >= 1) ? cus : -1;
        if (grid < 0) { fprintf(stderr, "kernel_launch: occupancy query says 0 blocks per CU\n"); return; }
    }
    if (grid < 0) return;
    hipMemsetAsync((char*)d_ws + WS_CTL, 0, CTL_ZERO_BYTES, stream);
    Args a{};
    for (int i = 0; i < 25; ++i) a.in[i] = (const float*)d_in[i];
    a.out = (float*)d_out; a.ws = (unsigned char*)d_ws;
#if MK_ONE_LAUNCH
    a.ph_lo = 0; a.ph_hi = LAST_PHASE;
    hipLaunchKernelGGL(fwd, dim3(grid), dim3(NTHR), LDS_BYTES, stream, a);
#else
    for (int p = 0; p < LAST_PHASE; ++p) { a.ph_lo = p; a.ph_hi = p + 1; hipLaunchKernelGGL(fwd, dim3(grid), dim3(NTHR), LDS_BYTES, stream, a); }
#endif
}
```

```cpp
#include <hip/hip_runtime.h>
#include <cstdio>
#include <cstdint>
namespace pg8 {
#define PG8_LAS __attribute__((address_space(3)))
typedef unsigned short bf16_t;
typedef short bf16x8 __attribute__((ext_vector_type(8)));
typedef float f32x4 __attribute__((ext_vector_type(4)));
typedef unsigned u32x4 __attribute__((ext_vector_type(4)));
constexpr int BM = 256, BK = 64, HALF = 128, HTB = HALF * BK * 2  , STAGE_BYTES = 8 * HTB, NXCD = 8, WGM = 8;

__host__ __device__ __forceinline__ int lds_byte(int r, int c) { const int st = (r >> 4) * 2 + (c >> 5), rr = r & 15, cc = c & 31, ob = rr * 64 + cc * 2; return st * 1024 + (ob ^ (((ob >> 9) & 1) << 5)); }
__host__ __device__ __forceinline__ void stage_rc(int b, int& R, int& C) { const int st = b / 1024, sb = b % 1024, swz = sb ^ (((sb >> 9) & 1) << 5); R = (st >> 1) * 16 + swz / 64; C = (st & 1) * 32 + (swz % 64) / 2; }
__host__ __device__ __forceinline__ int perm32(int rho) { const int n = rho >> 4, i = rho & 15; return 8 * (i >> 2) + 4 * n + (i & 3); }

struct Unit { int pm, pn; };
struct Gemm { const bf16_t* A; const bf16_t* Bt; int M, N, K, lda; };

struct StaticOrder {
    int nM, nN, nwg, G, c;
    __host__ __device__ __forceinline__ void init(int M, int N, int G_, int c_) { nM = M / BM; nN = N / BM; nwg = nM * nN; G = G_; c = c_; }
    __host__ __device__ __forceinline__ bool next(int i, Unit& u) const {
        const long L = (long)i * G + c; if (L >= nwg) return false;
        int wgid = (int)L; { const int q = nwg / NXCD, r = nwg % NXCD, xcd = wgid % NXCD, off = wgid / NXCD; wgid = (xcd < r ? xcd * (q + 1) : r * (q + 1) + (xcd - r) * q) + off; }
        const int nig = WGM * nN, gid = wgid / nig, fm = gid * WGM, gsz = (nM - fm) < WGM ? (nM - fm) : WGM;
        u.pm = fm + ((wgid % nig) % gsz); u.pn = (wgid % nig) / gsz; return true;
    }
    __device__ __forceinline__ void a_ready(const Unit&) const {}
    __device__ __forceinline__ void done(const Unit&) const {}
};

__device__ __forceinline__ unsigned cvt_pk_bf16(float lo, float hi) { unsigned r; asm volatile("v_cvt_pk_bf16_f32 %0, %1, %2" : "=v"(r) : "v"(lo), "v"(hi)); return r; }
typedef float f32x2 __attribute__((ext_vector_type(2)));
__device__ __forceinline__ f32x2 gelu_pk(f32x2 v) {
    const f32x2 av = __builtin_elementwise_abs(v), d = av * 0.2316418882f + 1.0f;
    f32x2 t; t.x = __builtin_amdgcn_rcpf(d.x); t.y = __builtin_amdgcn_rcpf(d.y);
    f32x2 q = t * 0.5307027145f + (-0.7265760135f); q = q * t + 0.7107068705f; q = q * t + (-0.142248368f); q = q * t + 0.127414796f; q = q * t;
    const f32x2 s = (v * v) * (-0.72134752044f);
    f32x2 e; e.x = __builtin_amdgcn_exp2f(s.x); e.y = __builtin_amdgcn_exp2f(s.y);
    const f32x2 m = v * (q * e), r = v - m;
    f32x2 o; o.x = v.x < 0.f ? m.x : r.x; o.y = v.y < 0.f ? m.y : r.y; return o;
}

template <int ACT  > struct EpiBf16 {
    static constexpr bool PERM = true, AFTER_DRAIN = false; static_assert(ACT == 0 || ACT == 1, "EpiBf16: ACT is 0 (none) or 1 (gelu_pk)");
    bf16_t* O; int ldc; const float* bias; int split_cols; size_t split_stride; float scale0;
    __device__ __forceinline__ void operator()(const f32x4 (&acc)[2][2][4][2], const Unit& u, int wr, int wc, int fr, int fq) const {
        const int row0 = u.pm * BM + wr * 64 + fr; int colt = u.pn * BM; bf16_t* base = O;
        float sc = 1.f; if (split_cols) { const int t = colt / split_cols; base += (size_t)t * split_stride; colt -= t * split_cols; if (t == 0) sc = scale0; }
        const int col0 = colt + wc * 32 + 8 * fq, bcol0 = u.pn * BM + wc * 32 + 8 * fq;
        f32x4 bv[2][2];
#pragma unroll
        for (int bj = 0; bj < 2; ++bj)
#pragma unroll
            for (int n = 0; n < 2; ++n) bv[bj][n] = bias ? *(const f32x4*)(bias + bcol0 + bj * HALF + 4 * n) : (f32x4){0.f, 0.f, 0.f, 0.f};
#pragma unroll
        for (int ai = 0; ai < 2; ++ai)
#pragma unroll
            for (int m = 0; m < 4; ++m) { bf16_t* rowp = base + (size_t)(row0 + ai * HALF + m * 16) * ldc + col0;
#pragma unroll
                for (int bj = 0; bj < 2; ++bj) { f32x4 v0 = acc[ai][bj][m][0] + bv[bj][0], v1 = acc[ai][bj][m][1] + bv[bj][1];
                    if (ACT == 1) { f32x2 a = gelu_pk((f32x2){v0[0], v0[1]}), b = gelu_pk((f32x2){v0[2], v0[3]}), c = gelu_pk((f32x2){v1[0], v1[1]}), d = gelu_pk((f32x2){v1[2], v1[3]});
                        v0 = (f32x4){a.x, a.y, b.x, b.y}; v1 = (f32x4){c.x, c.y, d.x, d.y}; }
                    v0 = v0 * sc; v1 = v1 * sc; u32x4 w; w.x = cvt_pk_bf16(v0[0], v0[1]); w.y = cvt_pk_bf16(v0[2], v0[3]); w.z = cvt_pk_bf16(v1[0], v1[1]); w.w = cvt_pk_bf16(v1[2], v1[3]);
                    *(u32x4*)(rowp + bj * HALF) = w; } }
    }
};

struct PanelStats {
    unsigned* xbuf;
    unsigned* cnt;
    unsigned* tmo;
    int ntn; float eps;
    unsigned code;
    __device__ __forceinline__ bool run(const f32x4 (&v)[2][2][4][2], const Unit& u, int wr, int wc, int fr, int fq, PG8_LAS unsigned char* lds, int wid, int lane) const {
        typedef float f32x2v __attribute__((ext_vector_type(2)));
        PG8_LAS f32x2v* P = (PG8_LAS f32x2v*)lds;
        PG8_LAS f32x2v* S = (PG8_LAS f32x2v*)(lds + 8192);
        PG8_LAS unsigned* flag = (PG8_LAS unsigned*)(lds + 8192 + 2048);
#pragma unroll
        for (int ai = 0; ai < 2; ++ai)
#pragma unroll
            for (int m = 0; m < 4; ++m) {
                float s = 0.f;
#pragma unroll
                for (int bj = 0; bj < 2; ++bj)
#pragma unroll
                    for (int n = 0; n < 2; ++n) { const f32x4 x = v[ai][bj][m][n]; s += (x[0] + x[1]) + (x[2] + x[3]); }
                s += __shfl_xor(s, 16); s += __shfl_xor(s, 32);
                const float mw = s * (1.0f / 64.0f); float q = 0.f;
#pragma unroll
                for (int bj = 0; bj < 2; ++bj)
#pragma unroll
                    for (int n = 0; n < 2; ++n) { const f32x4 d = v[ai][bj][m][n] - mw; q += (d[0] * d[0] + d[1] * d[1]) + (d[2] * d[2] + d[3] * d[3]); }
                q += __shfl_xor(q, 16); q += __shfl_xor(q, 32);
                if (fq == 0) P[(ai * HALF + wr * 64 + m * 16 + fr) * 4 + wc] = (f32x2v){mw, q};
            }
        asm volatile("s_waitcnt lgkmcnt(0)" ::: "memory"); __builtin_amdgcn_s_barrier(); asm volatile("" ::: "memory");
#if defined(BROKEN_EXCHANGE_NO_WAIT)
#warning BROKEN CONTROL BUILD: the row-statistics exchange does not wait; results are wrong by design
        if (blockIdx.x >= 64) { const long long t0_ = clock64(); while (clock64() - t0_ < 60000) __builtin_amdgcn_s_sleep(8); }
#endif
        const int row = wid * 32 + (lane & 31);
        if (lane < 32) {
            const f32x2v a = P[row * 4 + 0], b = P[row * 4 + 1], c = P[row * 4 + 2], d = P[row * 4 + 3];
            const float mt = (a.x + b.x + c.x + d.x) * 0.25f;
            const float da = a.x - mt, db = b.x - mt, dc = c.x - mt, dd = d.x - mt;
            const float m2 = (a.y + b.y) + (c.y + d.y) + 64.0f * ((da * da + db * db) + (dc * dc + dd * dd));
            unsigned long long* slot = (unsigned long long*)xbuf + ((size_t)(u.pm * BM + row) * 4 + u.pn);
            __hip_atomic_store(slot, ((unsigned long long)__float_as_uint(m2) << 32) | __float_as_uint(mt), __ATOMIC_RELAXED, __HIP_MEMORY_SCOPE_AGENT);
        }
        asm volatile("s_waitcnt vmcnt(0)" ::: "memory");
        if (lane == 0) __hip_atomic_fetch_add(cnt + 64 * u.pm, 1u, __ATOMIC_RELAXED, __HIP_MEMORY_SCOPE_AGENT);
        if (wid == 0) {
            bool dead = false; const unsigned long long t0 = __builtin_amdgcn_s_memrealtime(); const unsigned want = 8u * (unsigned)ntn;
            for (;;) {
#if defined(BROKEN_EXCHANGE_NO_WAIT)
                break;
#endif
                if ((unsigned)__builtin_amdgcn_readfirstlane(__hip_atomic_load(cnt + 64 * u.pm, __ATOMIC_RELAXED, __HIP_MEMORY_SCOPE_AGENT)) >= want) break;
                if (__builtin_amdgcn_s_memrealtime() - t0 > 2000000ull) {
                    if (lane == 0) { unsigned expect = 0u; __hip_atomic_compare_exchange_strong(tmo + 1, &expect, code | (unsigned)(u.pm & 0xff), __ATOMIC_RELAXED, __ATOMIC_RELAXED, __HIP_MEMORY_SCOPE_AGENT);
                                     __hip_atomic_store(tmo, 1u, __ATOMIC_RELAXED, __HIP_MEMORY_SCOPE_AGENT); }
                    dead = true; break; }
                __builtin_amdgcn_s_sleep(2);
            }
            __builtin_amdgcn_fence(__ATOMIC_ACQUIRE, "agent");
            if (lane == 0) flag[0] = dead ? 1u : 0u;
        }
        asm volatile("s_waitcnt vmcnt(0) lgkmcnt(0)" ::: "memory"); __builtin_amdgcn_s_barrier(); asm volatile("" ::: "memory");
        const bool bad = flag[0] != 0u;
        if (lane < 32) {
            const unsigned long long* slot = (const unsigned long long*)xbuf + (size_t)(u.pm * BM + row) * 4; float mt[4], m2[4]; float ms = 0.f;
#pragma unroll
            for (int t = 0; t < 4; ++t) { if (t < ntn) { const unsigned long long w = __hip_atomic_load(slot + t, __ATOMIC_RELAXED, __HIP_MEMORY_SCOPE_AGENT); mt[t] = __uint_as_float((unsigned)w); m2[t] = __uint_as_float((unsigned)(w >> 32)); } else { mt[t] = 0.f; m2[t] = 0.f; } ms += mt[t]; }
            const float mean = ms / (float)ntn; float q = 0.f;
#pragma unroll
            for (int t = 0; t < 4; ++t) if (t < ntn) { const float dm = mt[t] - mean; q += m2[t] + 256.0f * dm * dm; }
            S[row] = (f32x2v){mean, 1.0f / sqrtf(q / (256.0f * (float)ntn) + eps)};
        }
        asm volatile("s_waitcnt lgkmcnt(0)" ::: "memory"); __builtin_amdgcn_s_barrier(); asm volatile("" ::: "memory");
        return bad;
    }
};
struct EpiLnRes {
    static constexpr bool PERM = false, AFTER_DRAIN = true;
    const float* base; float* out; int ldc; const float* bias; PanelStats st; unsigned poison;
    __device__ __forceinline__ void fused(f32x4 (&acc)[2][2][4][2], const Unit& u, int wr, int wc, int fr, int fq, PG8_LAS unsigned char* lds, int wid, int lane) const {
        typedef float f32x2v __attribute__((ext_vector_type(2)));
        const PG8_LAS f32x2v* S = (const PG8_LAS f32x2v*)(lds + 8192);
        const int col0 = u.pn * BM + wc * 32 + 4 * fq;
#pragma unroll
        for (int bj = 0; bj < 2; ++bj)
#pragma unroll
            for (int n = 0; n < 2; ++n) { const f32x4 bv = bias ? *(const f32x4*)(bias + col0 + bj * HALF + n * 16) : (f32x4){0.f, 0.f, 0.f, 0.f};
#pragma unroll
                for (int ai = 0; ai < 2; ++ai)
#pragma unroll
                    for (int m = 0; m < 4; ++m) acc[ai][bj][m][n] += bv; }
        f32x4 pre[4][2][2];
#pragma unroll
        for (int m = 0; m < 4; ++m) { const size_t off = (size_t)(u.pm * BM + wr * 64 + m * 16 + fr) * ldc + col0;
#pragma unroll
            for (int bj = 0; bj < 2; ++bj)
#pragma unroll
                for (int n = 0; n < 2; ++n) pre[m][bj][n] = *(const f32x4*)(base + off + bj * HALF + n * 16); }
        const bool bad = st.run(acc, u, wr, wc, fr, fq, lds, wid, lane) || poison != 0u;
        const float qnan = __builtin_nanf("");
#pragma unroll
        for (int ai = 0; ai < 2; ++ai)
#pragma unroll
            for (int m = 0; m < 4; ++m) { const int r = ai * HALF + wr * 64 + m * 16 + fr; const f32x2v sr = S[r]; const size_t off = (size_t)(u.pm * BM + r) * ldc + col0;
#pragma unroll
                for (int bj = 0; bj < 2; ++bj)
#pragma unroll
                    for (int n = 0; n < 2; ++n) { const f32x4 bs = ai == 0 ? pre[m][bj][n] : *(const f32x4*)(base + off + bj * HALF + n * 16); f32x4 o = bs + (acc[ai][bj][m][n] - sr.x) * sr.y;
                        if (bad) o = (f32x4){qnan, qnan, qnan, qnan}; *(f32x4*)(out + off + bj * HALF + n * 16) = o; }
                if (m & 1) asm volatile("" ::: "memory"); }
    }
};
struct EpiLnResLn {
    static constexpr bool PERM = false, AFTER_DRAIN = true;
    const float* base; float* out; bf16_t* xn; int ldc; const float* bias; PanelStats st1, st2; unsigned poison;
    __device__ __forceinline__ void fused(f32x4 (&acc)[2][2][4][2], const Unit& u, int wr, int wc, int fr, int fq, PG8_LAS unsigned char* lds, int wid, int lane) const {
        typedef float f32x2v __attribute__((ext_vector_type(2))); typedef unsigned u32x2v __attribute__((ext_vector_type(2)));
        const PG8_LAS f32x2v* S = (const PG8_LAS f32x2v*)(lds + 8192);
        const int col0 = u.pn * BM + wc * 32 + 4 * fq;
#pragma unroll
        for (int bj = 0; bj < 2; ++bj)
#pragma unroll
            for (int n = 0; n < 2; ++n) { const f32x4 bv = bias ? *(const f32x4*)(bias + col0 + bj * HALF + n * 16) : (f32x4){0.f, 0.f, 0.f, 0.f};
#pragma unroll
                for (int ai = 0; ai < 2; ++ai)
#pragma unroll
                    for (int m = 0; m < 4; ++m) acc[ai][bj][m][n] += bv; }
        bool bad = st1.run(acc, u, wr, wc, fr, fq, lds, wid, lane) || poison != 0u;
        const float qnan = __builtin_nanf("");
#pragma unroll
        for (int ai = 0; ai < 2; ++ai)
#pragma unroll
            for (int m = 0; m < 4; ++m) { const int r = ai * HALF + wr * 64 + m * 16 + fr; const f32x2v sr = S[r]; const size_t off = (size_t)(u.pm * BM + r) * ldc + col0;
#pragma unroll
                for (int bj = 0; bj < 2; ++bj)
#pragma unroll
                    for (int n = 0; n < 2; ++n) { const f32x4 bs = *(const f32x4*)(base + off + bj * HALF + n * 16); acc[ai][bj][m][n] = bs + (acc[ai][bj][m][n] - sr.x) * sr.y; }
                asm volatile("" : "+v"(acc[ai][0][m][0]), "+v"(acc[ai][0][m][1]), "+v"(acc[ai][1][m][0]), "+v"(acc[ai][1][m][1]));
                if (m & 1) asm volatile("" ::: "memory"); }
        const bool bad1 = bad;
        bad = st2.run(acc, u, wr, wc, fr, fq, lds, wid, lane) || bad;
#pragma unroll
        for (int ai = 0; ai < 2; ++ai)
#pragma unroll
            for (int m = 0; m < 4; ++m) { const int r = ai * HALF + wr * 64 + m * 16 + fr; const f32x2v sr = S[r]; const size_t off = (size_t)(u.pm * BM + r) * ldc + col0;
#pragma unroll
                for (int bj = 0; bj < 2; ++bj)
#pragma unroll
                    for (int n = 0; n < 2; ++n) { const f32x4 x1 = acc[ai][bj][m][n]; *(f32x4*)(out + off + bj * HALF + n * 16) = bad1 ? (f32x4){qnan, qnan, qnan, qnan} : x1;
                        const f32x4 o = (x1 - sr.x) * sr.y; u32x2v w; w.x = cvt_pk_bf16(o[0], o[1]); w.y = cvt_pk_bf16(o[2], o[3]);
                        if (bad) { w.x = 0x7fc07fc0u; w.y = 0x7fc07fc0u; } *(u32x2v*)(xn + off + bj * HALF + n * 16) = w; }
                asm volatile("" ::: "memory"); }
    }
};

template <class T, class = void> struct epi_touch_t { static constexpr bool value = false; };
template <class T> struct epi_touch_t<T, decltype((void)T::TOUCH)> { static constexpr bool value = T::TOUCH; };
template <class Epi, class Sched, bool ALIGN_EPI = false, bool SP2 = false, int AROW = 0>
__device__ __forceinline__ void gemm_phase(PG8_LAS unsigned char* lds, const Gemm g, const Sched& S, const Epi& E) {
    int tid_ = threadIdx.x; asm volatile("" : "+v"(tid_));
    const int tid = tid_, wid = __builtin_amdgcn_readfirstlane(tid >> 6), lane = tid & 63, wr = wid >> 2, wc = wid & 3, fr = lane & 15, fq = lane >> 4;
    const int K = g.K, nt = K / BK;
    unsigned voffA[2], voffB[2];
#pragma unroll
    for (int i = 0; i < 2; ++i) { int R, C; stage_rc(tid * 16 + i * 8192, R, C); const int Rb = Epi::PERM ? ((R & ~31) + perm32(R & 31)) : R;
        const int Ra = (AROW == 1) ? ((R & ~63) + 4 * (R & 15) + ((R >> 4) & 3)) : (AROW == 3) ? (128 * (R >> 6) + 8 * (R & 15) + ((R >> 4) & 3)) : R;
        voffA[i] = (unsigned)(Ra * g.lda + C) * 2u; voffB[i] = (unsigned)(Rb * K + C) * 2u;
        if (AROW == 2) { const int tp = 4 * ((lane >> 2) & 3) + (lane >> 4), c = lane & 3;
            voffA[i] = (unsigned)((64 * i + 16 * (wid & 3) + tp) * g.lda + 32 * (wid >> 2) + 8 * c) * 2u; } }
    const size_t kstep = (size_t)(BK * 2);
    const size_t hstep = (size_t)HALF * K * 2;
    const size_t tstep = 2 * hstep;
    const size_t tstepA = (size_t)2 * HALF * g.lda * 2, hstepA = (AROW == 3) ? (size_t)4 * g.lda * 2 : tstepA / 2;
    const unsigned ldsw = (unsigned)wid * 1024u;
    constexpr int PSTR = 1056, HTBA = (AROW == 2) ? 16 * PSTR : HTB;
    const int aoff = (AROW == 2) ? (wr * 8 + (fr >> 2)) * PSTR + 64 * (fr & 3) + 16 * fq : lds_byte(wr * 64 + fr, fq * 8), boff = lds_byte(wc * 32 + fr, fq * 8);
    constexpr int AM = (AROW == 2) ? 256 : 2048, AK = (AROW == 2) ? 4 * PSTR : 1024;
    const unsigned ldswA = (AROW == 2) ? (unsigned)wid * PSTR : (unsigned)wid * 1024u; constexpr unsigned ISTRA = (AROW == 2) ? 8u * PSTR : 8192u;
#define PG8_SA(b, h) (((b) * 2 + (h)) * HTBA)
#define PG8_SB(b, h) (4 * HTBA + ((b) * 2 + (h)) * HTB)
#define PG8_STAGEA(bufoff, gbase, voff) do { _Pragma("unroll") for (int _i = 0; _i < 2; ++_i) \
        __builtin_amdgcn_global_load_lds((const unsigned*)((const char*)(gbase) + (voff)[_i]), (PG8_LAS unsigned*)(lds + (bufoff) + ldswA + _i * ISTRA), 16, 0, 0); } while (0)
#define PG8_STAGE(bufoff, gbase, voff) do { _Pragma("unroll") for (int _i = 0; _i < 2; ++_i) \
        __builtin_amdgcn_global_load_lds((const unsigned*)((const char*)(gbase) + (voff)[_i]), (PG8_LAS unsigned*)(lds + (bufoff) + ldsw + _i * 8192), 16, 0, 0); } while (0)
#define PG8_LDA(dst, b, h) do { _Pragma("unroll") for (int m = 0; m < 4; ++m) _Pragma("unroll") for (int k = 0; k < 2; ++k) dst[m][k] = *(const PG8_LAS bf16x8*)(lds + PG8_SA(b, h) + aoff + m * AM + k * AK); } while (0)
#define PG8_LDB(dst, b, h) do { _Pragma("unroll") for (int n = 0; n < 2; ++n) _Pragma("unroll") for (int k = 0; k < 2; ++k) dst[n][k] = *(const PG8_LAS bf16x8*)(lds + PG8_SB(b, h) + boff + n * 2048 + k * 1024); } while (0)
#define PG8_MMA(ai, bj, At, Bt) do { __builtin_amdgcn_s_setprio(1); _Pragma("unroll") for (int m = 0; m < 4; ++m) _Pragma("unroll") for (int n = 0; n < 2; ++n) _Pragma("unroll") for (int k = 0; k < 2; ++k) \
        acc[ai][bj][m][n] = __builtin_amdgcn_mfma_f32_16x16x32_bf16(Bt[n][k], At[m][k], acc[ai][bj][m][n], 0, 0, 0); __builtin_amdgcn_s_setprio(0); } while (0)
#define PG8_WAIT_V(n) asm volatile("s_waitcnt vmcnt(" #n ")" ::: "memory")
#define PG8_WAIT_L(n) asm volatile("s_waitcnt lgkmcnt(" #n ")" ::: "memory")
#define PG8_BAR __builtin_amdgcn_s_barrier()
#define PG8_SCHED __builtin_amdgcn_sched_barrier(0)
    Unit cur, nxt; int ui = 0;
    if (!S.next(0, cur)) return;
    f32x4 acc[2][2][4][2];
#pragma unroll
    for (int a = 0; a < 2; ++a)
#pragma unroll
        for (int b = 0; b < 2; ++b)
#pragma unroll
            for (int m = 0; m < 4; ++m)
#pragma unroll
                for (int n = 0; n < 2; ++n) acc[a][b][m][n] = (f32x4){0.f, 0.f, 0.f, 0.f};
    bf16x8 At[4][2], B0[2][2], B1[2][2];
    const char* cA = (const char*)g.A + (size_t)cur.pm * tstepA; const char* cB = (const char*)g.Bt + (size_t)cur.pn * tstep;
    S.a_ready(cur);
    if constexpr (epi_touch_t<Epi>::value) E.touch(cur, lds + STAGE_BYTES, wid, lane);
    if constexpr (SP2) {
        PG8_STAGE(PG8_SB(0, 0), cB, voffB); PG8_STAGE(PG8_SB(0, 1), cB + hstep, voffB); PG8_STAGEA(PG8_SA(0, 0), cA, voffA); PG8_STAGEA(PG8_SA(0, 1), cA + hstepA, voffA);
        if (wr == 1) PG8_BAR;
        PG8_WAIT_V(2); PG8_BAR;
        PG8_STAGE(PG8_SB(1, 0), cB + kstep, voffB); PG8_STAGEA(PG8_SA(1, 0), cA + kstep, voffA); PG8_STAGE(PG8_SB(1, 1), cB + hstep + kstep, voffB);
        PG8_WAIT_V(6); PG8_BAR;
    } else {
        PG8_STAGE(PG8_SB(0, 0), cB, voffB); PG8_STAGEA(PG8_SA(0, 0), cA, voffA); PG8_STAGE(PG8_SB(0, 1), cB + hstep, voffB); PG8_STAGEA(PG8_SA(0, 1), cA + hstepA, voffA);
        if (wr == 1) PG8_BAR;
        PG8_WAIT_V(4); PG8_BAR;
        PG8_STAGE(PG8_SB(1, 0), cB + kstep, voffB); PG8_STAGEA(PG8_SA(1, 0), cA + kstep, voffA); PG8_STAGE(PG8_SB(1, 1), cB + hstep + kstep, voffB);
        PG8_WAIT_V(6); PG8_BAR;
    }
    for (;;) {
        const bool has_next = S.next(ui + 1, nxt);
        const char* nA = has_next ? (const char*)g.A + (size_t)nxt.pm * tstepA : cA; const char* nB = has_next ? (const char*)g.Bt + (size_t)nxt.pn * tstep : cB;
#pragma unroll 1
        for (int t = 0; t < nt; t += 2) {
            const bool last = (t == nt - 2);
            const char* a1 = cA + (size_t)(t + 1) * kstep;
            const char* a2 = last ? nA : cA + (size_t)(t + 2) * kstep; const char* b2 = last ? nB : cB + (size_t)(t + 2) * kstep;
            const char* a3 = a2 + kstep; const char* b3 = b2 + kstep;
            if (last && has_next) S.a_ready(nxt);
            if constexpr (SP2) {
            PG8_LDB(B0, 0, 0); PG8_LDB(B1, 0, 1); PG8_SCHED; PG8_LDA(At, 0, 0); PG8_STAGEA(PG8_SA(1, 1), a1 + hstepA, voffA);
            PG8_WAIT_V(8); PG8_WAIT_L(0); PG8_BAR; PG8_MMA(0, 0, At, B0); PG8_MMA(0, 1, At, B1); PG8_BAR; PG8_SCHED;
            PG8_LDA(At, 0, 1); PG8_STAGE(PG8_SB(0, 0), b2, voffB); PG8_STAGE(PG8_SB(0, 1), b2 + hstep, voffB); PG8_STAGEA(PG8_SA(0, 0), a2, voffA);
            PG8_WAIT_V(8); PG8_WAIT_L(0); PG8_BAR; PG8_MMA(1, 0, At, B0); PG8_MMA(1, 1, At, B1); PG8_BAR; PG8_SCHED;
            PG8_LDB(B0, 1, 0); PG8_LDB(B1, 1, 1); PG8_SCHED; PG8_LDA(At, 1, 0); PG8_STAGEA(PG8_SA(0, 1), a2 + hstepA, voffA);
            PG8_WAIT_V(8); PG8_WAIT_L(0); PG8_BAR; PG8_MMA(0, 0, At, B0); PG8_MMA(0, 1, At, B1); PG8_BAR; PG8_SCHED;
            PG8_LDA(At, 1, 1); PG8_STAGE(PG8_SB(1, 0), b3, voffB); PG8_STAGE(PG8_SB(1, 1), b3 + hstep, voffB); PG8_STAGEA(PG8_SA(1, 0), a3, voffA);
            PG8_WAIT_V(8); PG8_WAIT_L(0); PG8_BAR; PG8_MMA(1, 0, At, B0); PG8_MMA(1, 1, At, B1); PG8_BAR; PG8_SCHED;
            } else {
            PG8_LDB(B0, 0, 0); PG8_SCHED; PG8_LDA(At, 0, 0); PG8_STAGEA(PG8_SA(1, 1), a1 + hstepA, voffA);
            PG8_WAIT_L(8); PG8_BAR; PG8_WAIT_L(0); PG8_MMA(0, 0, At, B0); PG8_BAR; PG8_SCHED;
            PG8_LDB(B1, 0, 1); PG8_STAGE(PG8_SB(0, 0), b2, voffB);
            PG8_BAR; PG8_WAIT_L(0); PG8_MMA(0, 1, At, B1); PG8_BAR;
            PG8_LDA(At, 0, 1); PG8_STAGEA(PG8_SA(0, 0), a2, voffA);
            PG8_BAR; PG8_WAIT_L(0); PG8_MMA(1, 0, At, B0); PG8_BAR; PG8_SCHED;
            PG8_STAGE(PG8_SB(0, 1), b2 + hstep, voffB);
            PG8_WAIT_V(6); PG8_BAR; PG8_MMA(1, 1, At, B1); PG8_BAR;
            PG8_LDB(B0, 1, 0); PG8_SCHED; PG8_LDA(At, 1, 0); PG8_STAGEA(PG8_SA(0, 1), a2 + hstepA, voffA);
            PG8_WAIT_L(8); PG8_BAR; PG8_WAIT_L(0); PG8_MMA(0, 0, At, B0); PG8_BAR; PG8_SCHED;
            PG8_LDB(B1, 1, 1); PG8_STAGE(PG8_SB(1, 0), b3, voffB);
            PG8_BAR; PG8_WAIT_L(0); PG8_MMA(0, 1, At, B1); PG8_BAR;
            PG8_LDA(At, 1, 1); PG8_STAGEA(PG8_SA(1, 0), a3, voffA);
            PG8_BAR; PG8_WAIT_L(0); PG8_MMA(1, 0, At, B0); PG8_BAR; PG8_SCHED;
            PG8_STAGE(PG8_SB(1, 1), b3 + hstep, voffB);
            PG8_WAIT_V(6); PG8_BAR; PG8_MMA(1, 1, At, B1); PG8_BAR;
            }
        }
        if constexpr (ALIGN_EPI) { if (wr == 0) PG8_BAR; }
        if constexpr (epi_touch_t<Epi>::value) { if (has_next) E.touch(nxt, lds + STAGE_BYTES, wid, lane); }
        if constexpr (!Epi::AFTER_DRAIN) { E(acc, cur, wr, wc, fr, fq); S.done(cur); }
        if (!has_next) break;
#pragma unroll
        for (int a = 0; a < 2; ++a)
#pragma unroll
            for (int b = 0; b < 2; ++b)
#pragma unroll
                for (int m = 0; m < 4; ++m)
#pragma unroll
                    for (int n = 0; n < 2; ++n) acc[a][b][m][n] = (f32x4){0.f, 0.f, 0.f, 0.f};
        cur = nxt; cA = nA; cB = nB; ++ui;
        if constexpr (ALIGN_EPI) { if (wr == 1) PG8_BAR; }
    }
    PG8_WAIT_V(0);
    if constexpr (!ALIGN_EPI) { if (wr == 0) PG8_BAR; }
    PG8_BAR;
    if constexpr (Epi::AFTER_DRAIN) { E.fused(acc, cur, wr, wc, fr, fq, lds, wid, lane); S.done(cur); }
#undef PG8_SA
#undef PG8_SB
#undef PG8_STAGE
#undef PG8_STAGEA
#undef PG8_LDA
#undef PG8_LDB
#undef PG8_MMA
#undef PG8_WAIT_V
#undef PG8_WAIT_L
#undef PG8_BAR
#undef PG8_SCHED
}
}

#ifndef PG8_SP2
#define PG8_SP2 true
#endif
#ifndef PG8_ALIGN
#define PG8_ALIGN true
#endif
#define GAS __attribute__((address_space(1)))
#define LAS __attribute__((address_space(3)))
typedef unsigned short bf16;
typedef unsigned v4u __attribute__((ext_vector_type(4)));
typedef float f32x4 __attribute__((ext_vector_type(4)));
typedef short bf16x8 __attribute__((ext_vector_type(8)));
typedef GAS unsigned gu32;
typedef GAS unsigned long long gu64;
#define RLX_AGENT __ATOMIC_RELAXED, __HIP_MEMORY_SCOPE_AGENT
#define LDS_WAIT() asm volatile("s_waitcnt lgkmcnt(0)" ::: "memory")
#define VM_WAIT() asm volatile("s_waitcnt vmcnt(0)" ::: "memory")
__device__ __forceinline__ unsigned long long rt() { return __builtin_amdgcn_s_memrealtime(); }
__device__ __forceinline__ unsigned f2bf(float f) { unsigned u = __builtin_bit_cast(unsigned, f); return (u + 0x7fffu + ((u >> 16) & 1u)) >> 16; }
typedef float pk_f32x2_t __attribute__((ext_vector_type(2))); typedef __bf16 pk_bf16x2_t __attribute__((ext_vector_type(2)));
__device__ __forceinline__ unsigned pk2(float lo, float hi) { pk_f32x2_t v = {lo, hi}; pk_bf16x2_t b = __builtin_convertvector(v, pk_bf16x2_t); return __builtin_bit_cast(unsigned, b); }

#define XB_TMO      128
#define XB_XCNT(j)  (256  + 64 * (j))
#define XB_XSUB(j)  (1280 + 64 * (j))
#define XB_XGEN(j)  (2304 + 64 * (j))
#define XB_TOP      3328
#define XB_TOPGEN   3392
#define XCD_BAR_WORDS 3456
#define XB_SPIN_CAP (1u << 18)

__device__ __forceinline__ unsigned xb_ld(unsigned* p)              { return __hip_atomic_load(p, __ATOMIC_RELAXED, __HIP_MEMORY_SCOPE_AGENT); }
__device__ __forceinline__ unsigned xb_add(unsigned* p, unsigned v) { return __hip_atomic_fetch_add(p, v, __ATOMIC_RELAXED, __HIP_MEMORY_SCOPE_AGENT); }
__device__ __forceinline__ unsigned xb_xcc_id() { return (unsigned)__builtin_amdgcn_s_getreg((3 << 11) | 20) & 0xFu; }
#define XB_SPIN(cond, bar) do { unsigned _sp = 0; while (cond) { __builtin_amdgcn_s_sleep(1); \
    if ((++_sp & 255u) == 0u) { if (xb_ld(&(bar)[XB_TMO])) break; if (_sp > XB_SPIN_CAP) { atomicAdd(&(bar)[XB_TMO], 1u); break; } } } } while (0)

struct XcdBarrier {
    unsigned* bar; unsigned x;
    volatile LAS unsigned* st;
};

__device__ __forceinline__ XcdBarrier xcd_barrier_post(unsigned* bar, volatile LAS unsigned* st) {
    XcdBarrier b; b.bar = bar; b.x = xb_xcc_id(); b.st = st;
    if (threadIdx.x == 0) (void)xb_add(&bar[XB_XCNT(b.x)], 1u);
    return b;
}
__device__ __forceinline__ void xcd_barrier_complete(unsigned* bar, unsigned x, unsigned& nloc, unsigned& nx) {
    const unsigned G = gridDim.x * gridDim.y * gridDim.z;
    unsigned sum, cnt, mine, sp = 0u;
    for (;;) {
        sum = 0u; cnt = 0u; mine = 0u;
#pragma unroll
        for (unsigned j = 0; j < 16; ++j) { const unsigned c = xb_ld(&bar[XB_XCNT(j)]); sum += c; cnt += (c > 0u) ? 1u : 0u; mine = (j == x) ? c : mine; }
        if (sum == G) break;
        __builtin_amdgcn_s_sleep(1);
        if ((++sp & 255u) == 0u) { if (xb_ld(&bar[XB_TMO])) break; if (sp > XB_SPIN_CAP) { atomicAdd(&bar[XB_TMO], 1u); break; } }
    }
    nloc = mine > 0u ? mine : 1u; nx = cnt > 0u ? cnt : 1u;
}

__device__ __forceinline__ void xcd_barrier(const XcdBarrier& b) {
    asm volatile("s_waitcnt vmcnt(0)" ::: "memory");
    __syncthreads();
    if (threadIdx.x == 0) {
        unsigned* bar = b.bar;
        __builtin_amdgcn_s_waitcnt(0);
        unsigned nloc = b.st[0], nx = b.st[1];
        if (nloc == 0u) { xcd_barrier_complete(bar, b.x, nloc, nx); b.st[0] = nloc; b.st[1] = nx; }
        const unsigned old = xb_add(&bar[XB_XSUB(b.x)], 1u);
        const unsigned gen = old / nloc;
        if (old + 1u == (gen + 1u) * nloc) {
            __builtin_amdgcn_fence(__ATOMIC_RELEASE, "agent");
            asm volatile("s_waitcnt vmcnt(0)" ::: "memory");
            const unsigned og = xb_add(&bar[XB_TOP], 1u);
            const unsigned tg = og / nx;
            if (og + 1u == (tg + 1u) * nx) xb_add(&bar[XB_TOPGEN], 1u);
            else XB_SPIN(xb_ld(&bar[XB_TOPGEN]) == tg, bar);
            __builtin_amdgcn_fence(__ATOMIC_ACQUIRE, "agent");
            xb_add(&bar[XB_XGEN(b.x)], 1u);
            asm volatile("s_waitcnt vmcnt(0)" ::: "memory");
        } else {
            XB_SPIN(xb_ld(&bar[XB_XGEN(b.x)]) == gen, bar);
            __builtin_amdgcn_fence(__ATOMIC_ACQUIRE, "agent");
            asm volatile("s_waitcnt vmcnt(0)" ::: "memory");
        }
    }
    __syncthreads();
}
__device__ __forceinline__ float bf2f(bf16 v) { return __builtin_bit_cast(float, (unsigned)v << 16); }
__device__ __forceinline__ float bflo(unsigned w) { return __builtin_bit_cast(float, w << 16); }
__device__ __forceinline__ float bfhi(unsigned w) { return __builtin_bit_cast(float, w & 0xffff0000u); }
__device__ __forceinline__ float silu_f(float v) { return v * __builtin_amdgcn_rcpf(1.f + __expf(-v)); }
__device__ __forceinline__ float wave_sum(float v) {
#pragma unroll
    for (int o = 1; o < 64; o <<= 1) v += __shfl_xor(v, o);
    return v;
}


namespace at2 {
typedef short bf16x8 __attribute__((ext_vector_type(8)));
typedef short s16x4 __attribute__((ext_vector_type(4)));
typedef float f32x16 __attribute__((ext_vector_type(16)));
typedef unsigned u32x4 __attribute__((ext_vector_type(4)));
typedef float f32x2_t __attribute__((ext_vector_type(2))); typedef __bf16 bf16x2_t __attribute__((ext_vector_type(2)));
#define AT_LAS __attribute__((address_space(3)))
__device__ __forceinline__ int crow(int r, int hi) { return (r & 3) + 8 * (r >> 2) + 4 * hi; }
__device__ __forceinline__ void glds16(const void* gsrc, unsigned lds_dst) { unsigned keep;
    asm volatile("s_mov_b32 %0, m0\n\ts_mov_b32 m0, %2\n\ts_nop 0\n\tglobal_load_lds_dwordx4 %1, off\n\ts_mov_b32 m0, %0" : "=&s"(keep) : "v"(gsrc), "s"(lds_dst) : "memory"); }
__device__ __forceinline__ unsigned cvtpk(float lo, float hi) { f32x2_t v = {lo, hi}; bf16x2_t b = __builtin_convertvector(v, bf16x2_t); return __builtin_bit_cast(unsigned, b); }
__device__ __forceinline__ float swap_max(float m) { auto rr = __builtin_amdgcn_permlane32_swap(__float_as_uint(m), __float_as_uint(m), false, false); float r; asm("v_max_f32_e32 %0, %1, %2" : "=v"(r) : "v"(__uint_as_float(rr[0])), "v"(__uint_as_float(rr[1]))); return r; }
__device__ __forceinline__ float swap_sum(float m) { auto rr = __builtin_amdgcn_permlane32_swap(__float_as_uint(m), __float_as_uint(m), false, false); return __uint_as_float(rr[0]) + __uint_as_float(rr[1]); }

__device__ __forceinline__ float max3f(float a, float b, float c) { float r; asm("v_max3_f32 %0, %1, %2, %3" : "=v"(r) : "v"(a), "v"(b), "v"(c)); return r; }
__device__ __forceinline__ float max2f(float a, float b) { float r; asm("v_max_f32_e32 %0, %1, %2" : "=v"(r) : "v"(a), "v"(b)); return r; }
constexpr float NEGM = -1e30f;
constexpr float THR = 8.0f;

struct Tensors { const unsigned short* Q; const unsigned short* K; const unsigned short* V; unsigned short* O; int pq, pk, pv, po; };

__device__ __forceinline__ void pv(f32x16* o, int vb, bf16x8 pa0, bf16x8 pa1, bf16x8 pa2, bf16x8 pa3) {
#pragma unroll
    for (int d0 = 0; d0 < 2; ++d0) { s16x4 lo[4], hi[4];
#pragma unroll
        for (int ks = 0; ks < 4; ++ks) {
            asm volatile("ds_read_b64_tr_b16 %0,%1 offset:%c2" : "=&v"(lo[ks]) : "v"(vb), "i"(d0 * 4096 + ks * 1024) : "memory");
            asm volatile("ds_read_b64_tr_b16 %0,%1 offset:%c2" : "=&v"(hi[ks]) : "v"(vb), "i"(d0 * 4096 + ks * 1024 + 512) : "memory"); }
        asm volatile("s_waitcnt lgkmcnt(0)" ::: "memory"); __builtin_amdgcn_sched_barrier(0);
#define AT_PK(k) (bf16x8){lo[k][0], lo[k][1], lo[k][2], lo[k][3], hi[k][0], hi[k][1], hi[k][2], hi[k][3]}
        o[d0] = __builtin_amdgcn_mfma_f32_32x32x16_bf16(pa0, AT_PK(0), o[d0], 0, 0, 0);
        o[d0] = __builtin_amdgcn_mfma_f32_32x32x16_bf16(pa1, AT_PK(1), o[d0], 0, 0, 0);
        o[d0] = __builtin_amdgcn_mfma_f32_32x32x16_bf16(pa2, AT_PK(2), o[d0], 0, 0, 0);
        o[d0] = __builtin_amdgcn_mfma_f32_32x32x16_bf16(pa3, AT_PK(3), o[d0], 0, 0, 0);
#undef AT_PK
    }
}

typedef short v4i16_t __attribute__((ext_vector_type(4)));
__device__ __forceinline__ s16x4 vtr(const AT_LAS unsigned char* p) { return __builtin_bit_cast(s16x4, __builtin_amdgcn_ds_read_tr16_b64_v4i16((AT_LAS v4i16_t*)p)); }
__device__ __forceinline__ void pv2(f32x16* o, const AT_LAS unsigned char* vp, bf16x8 pa0, bf16x8 pa1, bf16x8 pa2, bf16x8 pa3) {
#pragma unroll
    for (int d0 = 0; d0 < 2; ++d0) { s16x4 lo[4], hi[4];
#pragma unroll
        for (int ks = 0; ks < 4; ++ks) { lo[ks] = vtr(vp + d0 * 4096 + ks * 1024); hi[ks] = vtr(vp + d0 * 4096 + ks * 1024 + 512); }
#define AT_PK(k) (bf16x8){lo[k][0], lo[k][1], lo[k][2], lo[k][3], hi[k][0], hi[k][1], hi[k][2], hi[k][3]}
        o[d0] = __builtin_amdgcn_mfma_f32_32x32x16_bf16(pa0, AT_PK(0), o[d0], 0, 0, 0);
        o[d0] = __builtin_amdgcn_mfma_f32_32x32x16_bf16(pa1, AT_PK(1), o[d0], 0, 0, 0);
        o[d0] = __builtin_amdgcn_mfma_f32_32x32x16_bf16(pa2, AT_PK(2), o[d0], 0, 0, 0);
        o[d0] = __builtin_amdgcn_mfma_f32_32x32x16_bf16(pa3, AT_PK(3), o[d0], 0, 0, 0);
#undef AT_PK
    }
}

template <int DQ, bool MOBA, bool QNORM, int G>
__device__ __forceinline__ void attn_unit(AT_LAS unsigned char* lds, const Tensors& T, long rowbase, int qb, const float* km, const float* qg, const float* tab) {
    constexpr int NKP = DQ / 8, NP = NKP + 8, SLOTB = NKP * 1024 + 8192, ND0 = DQ / 16;
    constexpr int NSLOT = 3 * G, LDS_WS = NSLOT * SLOTB, LDS_OST = 0;
    int tid_ = threadIdx.x; asm volatile("" : "+v"(tid_));
    const int tid = tid_, lane = tid & 63, r32 = lane & 31, hi = lane >> 5; const int wid = __builtin_amdgcn_readfirstlane(tid >> 6);
    const int q0 = qb * 256, NT = 4 * (qb + 1);
    const unsigned lds0 = (unsigned)(size_t)lds;
    AT_LAS float* wsf = (AT_LAS float*)(lds + LDS_WS) + wid * 64;
    asm volatile("s_waitcnt vmcnt(0)" ::: "memory");
    const unsigned short* src[3]; unsigned dsto[3];
#pragma unroll
    for (int k = 0; k < 3; ++k) { const int pi = wid + 8 * k;
        if (pi < NKP) { src[k] = (T.pk == 0) ? T.K + pi * 512 + lane * 8 : T.K + (rowbase + lane) * T.pk + 8 * pi; dsto[k] = pi * 1024; }
        else { const int v = pi - NKP; src[k] = (T.pv == 0) ? T.V + v * 512 + lane * 8 : T.V + (rowbase + 16 * (v & 3) + (lane >> 2)) * T.pv + 32 * (v >> 2) + 8 * (lane & 3); dsto[k] = NKP * 1024 + v * 1024; } }
    const long kstep = (T.pk == 0) ? (long)NKP * 512 : (long)64 * T.pk, vstep = (T.pv == 0) ? (long)4096 : (long)64 * T.pv;
#define AT_DMA(t, slot) do { _Pragma("unroll") for (int k_ = 0; k_ < 3; ++k_) { const int pi_ = wid + 8 * k_; if (pi_ < NP) { \
        const unsigned short* s_ = src[k_] + (long)(t) * ((pi_ < NKP) ? kstep : vstep); glds16(s_, (unsigned)__builtin_amdgcn_readfirstlane(lds0 + (slot) * SLOTB + dsto[k_])); } } } while (0)
    _Pragma("unroll") for (int i_ = 0; i_ < G; ++i_) AT_DMA(i_, i_);
    __builtin_amdgcn_sched_barrier(0);
    bf16x8 qr[ND0];
    { const unsigned short* Qw = T.Q + (rowbase + q0 + wid * 32 + r32) * T.pq + hi * 8;
#pragma unroll
      for (int d0 = 0; d0 < ND0; ++d0) qr[d0] = *(const bf16x8*)(Qw + d0 * 16); }
    __builtin_amdgcn_sched_barrier(0);
    if constexpr (QNORM) {
        float s = 0.f;
#pragma unroll
        for (int d0 = 0; d0 < ND0; ++d0)
#pragma unroll
            for (int j = 0; j < 8; ++j) { const float x = bf2f((unsigned short)qr[d0][j]); s += x * x; }
        s = swap_sum(s);
        const float rstd = 0.14724445073472677f / sqrtf(s * (1.f / 96.f) + 1e-6f);
#pragma unroll
        for (int d0 = 0; d0 < 4; ++d0) { const f32x4 g0 = *(const f32x4*)(qg + d0 * 16 + hi * 8), g1 = *(const f32x4*)(qg + d0 * 16 + hi * 8 + 4); u32x4 w;
            w.x = cvtpk(bf2f((unsigned short)qr[d0][0]) * rstd * g0.x, bf2f((unsigned short)qr[d0][1]) * rstd * g0.y); w.y = cvtpk(bf2f((unsigned short)qr[d0][2]) * rstd * g0.z, bf2f((unsigned short)qr[d0][3]) * rstd * g0.w);
            w.z = cvtpk(bf2f((unsigned short)qr[d0][4]) * rstd * g1.x, bf2f((unsigned short)qr[d0][5]) * rstd * g1.y); w.w = cvtpk(bf2f((unsigned short)qr[d0][6]) * rstd * g1.z, bf2f((unsigned short)qr[d0][7]) * rstd * g1.w);
            qr[d0] = __builtin_bit_cast(bf16x8, w); asm volatile("" : "+v"(qr[d0])); }
        { const int pos = q0 + wid * 32 + r32; const float* tb = tab + (pos * 16 + hi * 8) * 2; const float* ga = qg + 64 + hi * 8; const float* gb = qg + 80 + hi * 8; float oa[8], ob[8];
#pragma unroll
          for (int j = 0; j < 8; ++j) { const float x1 = bf2f((unsigned short)qr[4][j]) * rstd * ga[j], x2 = bf2f((unsigned short)qr[5][j]) * rstd * gb[j]; const float c = tb[2 * j], sn = tb[2 * j + 1]; oa[j] = x1 * c - x2 * sn; ob[j] = x1 * sn + x2 * c; }
          u32x4 w; w.x = cvtpk(oa[0], oa[1]); w.y = cvtpk(oa[2], oa[3]); w.z = cvtpk(oa[4], oa[5]); w.w = cvtpk(oa[6], oa[7]); qr[4] = __builtin_bit_cast(bf16x8, w);
          w.x = cvtpk(ob[0], ob[1]); w.y = cvtpk(ob[2], ob[3]); w.z = cvtpk(ob[4], ob[5]); w.w = cvtpk(ob[6], ob[7]); qr[5] = __builtin_bit_cast(bf16x8, w); }
    }
    __builtin_amdgcn_sched_barrier(0);
    unsigned sel = 0xffffffffu;
    if (MOBA) {
        sel = 0u; float gate[8];
#pragma unroll
        for (int j = 0; j < 7; ++j) { float a = 0.f;
            if (j < qb) { const float* kj = km + j * 512 + hi * 8;
#pragma unroll
                for (int d0 = 0; d0 < ND0; ++d0) { const f32x4 k0 = *(const f32x4*)(kj + d0 * 16), k1 = *(const f32x4*)(kj + d0 * 16 + 4);
                    a += bf2f((unsigned short)qr[d0][0]) * k0.x + bf2f((unsigned short)qr[d0][1]) * k0.y + bf2f((unsigned short)qr[d0][2]) * k0.z + bf2f((unsigned short)qr[d0][3]) * k0.w
                       + bf2f((unsigned short)qr[d0][4]) * k1.x + bf2f((unsigned short)qr[d0][5]) * k1.y + bf2f((unsigned short)qr[d0][6]) * k1.z + bf2f((unsigned short)qr[d0][7]) * k1.w; } }
            a = swap_sum(a); gate[j] = (j < qb) ? a : -INFINITY; }
        gate[7] = -INFINITY;
#pragma unroll
        for (int r = 0; r < 3; ++r) { int best = -1; float bv = -INFINITY;
#pragma unroll
            for (int j = 0; j < 8; ++j) if (!((sel >> j) & 1u) && gate[j] > bv) { bv = gate[j]; best = j; }
            if (best >= 0) sel |= 1u << best; }
    }
    __builtin_amdgcn_sched_barrier(0);
    float mhat = 0.f, l = 0.f; f32x16 o[2]; o[0] = f32x16{}; o[1] = f32x16{};
    const int qrel = wid * 32 + r32;
    const int vbl = ((lane >> 4) & 1) * 32 + (lane & 3) * 8 + (4 * hi + ((lane & 15) >> 2)) * 64;
#define AT_GROUP(u) do { asm volatile("s_waitcnt vmcnt(0) lgkmcnt(0)\n\ts_barrier" ::: "memory"); \
        if ((u) + G < NT) { _Pragma("unroll") for (int i_ = 0; i_ < G; ++i_) { const int tt_ = (u) + G + i_; AT_DMA(tt_, tt_ % NSLOT); } } } while (0)
#define AT_KLOAD(sl) do { const AT_LAS unsigned char* kb = lds + (sl) * SLOTB + hi * 1024 + r32 * 16; \
        _Pragma("unroll") for (int d0 = 0; d0 < ND0; ++d0) { kf[2 * d0] = *(const AT_LAS bf16x8*)(kb + d0 * 2048); kf[2 * d0 + 1] = *(const AT_LAS bf16x8*)(kb + d0 * 2048 + 512); } } while (0)
    bf16x8 kf[2 * ND0]; s16x4 vlo[8], vhi[8];
    AT_GROUP(0);
    AT_KLOAD(0);
    int slot = 0;
    for (int t = 0; t < NT; ++t) {
        __builtin_amdgcn_sched_barrier(0);
        { const AT_LAS unsigned char* vp = lds + slot * SLOTB + NKP * 1024 + vbl;
#pragma unroll
          for (int i = 0; i < 8; ++i) { vlo[i] = vtr(vp + (i >> 2) * 4096 + (i & 3) * 1024); vhi[i] = vtr(vp + (i >> 2) * 4096 + (i & 3) * 1024 + 512); } }
        __builtin_amdgcn_sched_barrier(0);
        f32x16 p0, p1;
#pragma unroll
        for (int d0 = 0; d0 < ND0; ++d0) {
            if (d0 == 0) { p0 = __builtin_amdgcn_mfma_f32_32x32x16_bf16(kf[0], qr[0], f32x16{}, 0, 0, 0); p1 = __builtin_amdgcn_mfma_f32_32x32x16_bf16(kf[1], qr[0], f32x16{}, 0, 0, 0); }
            else { p0 = __builtin_amdgcn_mfma_f32_32x32x16_bf16(kf[2 * d0], qr[d0], p0, 0, 0, 0); p1 = __builtin_amdgcn_mfma_f32_32x32x16_bf16(kf[2 * d0 + 1], qr[d0], p1, 0, 0, 0); } }
        __builtin_amdgcn_sched_barrier(0);
        const int nslot = (slot == NSLOT - 1) ? 0 : slot + 1;
        if (t + 1 < NT) { if (((t + 1) % G) == 0) AT_GROUP(t + 1); AT_KLOAD(nslot); }
        __builtin_amdgcn_sched_barrier(0);
        const int jb = t - (NT - 4);
        if (jb >= 0) { const int kb0 = 64 * jb + 4 * hi;
#pragma unroll
            for (int r = 0; r < 16; ++r) { const int kv = kb0 + (r & 3) + 8 * (r >> 2); if (kv > qrel) p0[r] = NEGM; if (kv + 32 > qrel) p1[r] = NEGM; } }
        else if (MOBA) { const bool keep = ((sel >> (t >> 2)) & 1u) != 0u;
            if (!__all(keep)) { if (!keep) {
#pragma unroll
                for (int r = 0; r < 16; ++r) { p0[r] = NEGM; p1[r] = NEGM; } } } }
        float rm;
        { float a_ = fmaxf(fmaxf(p0[0], p0[1]), p1[0]), b_ = fmaxf(fmaxf(p0[2], p0[3]), p1[1]); a_ = fmaxf(fmaxf(a_, p1[2]), p1[3]);
#pragma unroll
          for (int r = 4; r < 16; r += 4) { a_ = fmaxf(fmaxf(a_, p0[r]), p0[r + 1]); b_ = fmaxf(fmaxf(b_, p0[r + 2]), p0[r + 3]); a_ = fmaxf(fmaxf(a_, p1[r]), p1[r + 1]); b_ = fmaxf(fmaxf(b_, p1[r + 2]), p1[r + 3]); }
          rm = swap_max(fmaxf(a_, b_)) - mhat; }
        if (__any(rm > THR)) {
            const float dl = fmaxf(rm, 0.f); mhat += dl;
            const float alpha = __builtin_amdgcn_exp2f(-dl); l *= alpha;
            if (hi == 0) wsf[r32] = alpha;
            asm volatile("s_waitcnt lgkmcnt(0)" ::: "memory");
#pragma unroll
            for (int r = 0; r < 16; ++r) { const float f = wsf[crow(r, hi)]; o[0][r] *= f; o[1][r] *= f; }
        }
        float sacc = 0.f;
#pragma unroll
        for (int r = 0; r < 16; ++r) { p0[r] = __builtin_amdgcn_exp2f(p0[r] - mhat); p1[r] = __builtin_amdgcn_exp2f(p1[r] - mhat); sacc += p0[r] + p1[r]; }
        l += sacc;
        u32x4 pw[4];
        pw[0] = (u32x4){cvtpk(p0[0], p0[1]), cvtpk(p0[2], p0[3]), cvtpk(p0[4], p0[5]), cvtpk(p0[6], p0[7])};
        pw[1] = (u32x4){cvtpk(p0[8], p0[9]), cvtpk(p0[10], p0[11]), cvtpk(p0[12], p0[13]), cvtpk(p0[14], p0[15])};
        pw[2] = (u32x4){cvtpk(p1[0], p1[1]), cvtpk(p1[2], p1[3]), cvtpk(p1[4], p1[5]), cvtpk(p1[6], p1[7])};
        pw[3] = (u32x4){cvtpk(p1[8], p1[9]), cvtpk(p1[10], p1[11]), cvtpk(p1[12], p1[13]), cvtpk(p1[14], p1[15])};
        __builtin_amdgcn_sched_barrier(0);
#pragma unroll
        for (int d0 = 0; d0 < 2; ++d0)
#pragma unroll
            for (int ks = 0; ks < 4; ++ks) { const int i = d0 * 4 + ks;
                o[d0] = __builtin_amdgcn_mfma_f32_32x32x16_bf16(__builtin_bit_cast(bf16x8, pw[ks]), (bf16x8){vlo[i][0], vlo[i][1], vlo[i][2], vlo[i][3], vhi[i][0], vhi[i][1], vhi[i][2], vhi[i][3]}, o[d0], 0, 0, 0); }
        slot = nslot;
    }
#undef AT_GROUP
#undef AT_KLOAD
#undef AT_DMA
    asm volatile("s_waitcnt lgkmcnt(0)\n\ts_barrier" ::: "memory");
    l = swap_sum(l);
    if (hi == 0) wsf[32 + r32] = l;
    asm volatile("s_waitcnt lgkmcnt(0)" ::: "memory");
    float rli[16];
#pragma unroll
    for (int r = 0; r < 16; ++r) rli[r] = __builtin_amdgcn_rcpf(wsf[32 + crow(r, hi)]);
    unsigned short* Ow = T.O + (rowbase + q0 + wid * 32) * T.po;
    { AT_LAS unsigned short* stg = (AT_LAS unsigned short*)(lds + LDS_OST) + wid * 2048;
#pragma unroll
      for (int r = 0; r < 16; ++r) { const int orow = crow(r, hi);
#pragma unroll
          for (int d0 = 0; d0 < 2; ++d0) stg[orow * 64 + d0 * 32 + r32] = (unsigned short)f2bf(o[d0][r] * rli[r]); }
      asm volatile("s_waitcnt lgkmcnt(0)" ::: "memory");
#pragma unroll
      for (int i = 0; i < 4; ++i) { const int row = i * 8 + (lane >> 3), ch = lane & 7; const u32x4 v = *(const AT_LAS u32x4*)(stg + row * 64 + ch * 8); *(u32x4*)(Ow + (long)row * T.po + ch * 8) = v; } }
    asm volatile("s_waitcnt lgkmcnt(0)\n\ts_barrier" ::: "memory");
}
template <int DQ, bool MOBA, bool QNORM, int G>
__device__ __forceinline__ void attn_unit_p(AT_LAS unsigned char* lds, const Tensors& T, long rowbase, int qb, const float* km, const float* qg, const float* tab, float kbound, int tbase, bool prefetched, bool has_next, int qb_next, bf16x8 (&qpre)[DQ / 16], f32x4 (&gpre)[12], f32x4 (&tpre)[4]) {
    constexpr int NKP = DQ / 8, NP = NKP + 8, SLOTB = NKP * 1024 + 8192, ND0 = DQ / 16;
    constexpr int NSLOT = 3 * G, LDS_WS = NSLOT * SLOTB, LDS_OST = LDS_WS + 2048;
    int tid_ = threadIdx.x; asm volatile("" : "+v"(tid_));
    const int tid = tid_, lane = tid & 63, r32 = lane & 31, hi = lane >> 5; const int wid = __builtin_amdgcn_readfirstlane(tid >> 6);
    const int rb = (wid < 4) ? wid : (wid ^ 2);
    const int q0 = qb * 256, NT = 4 * (qb + 1);
    const unsigned lds0 = (unsigned)(size_t)lds;
    AT_LAS float* wsf = (AT_LAS float*)(lds + LDS_WS) + wid * 64;
    asm volatile("s_waitcnt vmcnt(0)" ::: "memory");
    AT_LAS float* kml = (AT_LAS float*)(lds + 150016);
    float kmv = 0.f; if (MOBA && !prefetched) kmv = km[(tid >> 6) * 512 + (tid & 63)];
    unsigned soff[3], dsto[3];
#pragma unroll
    for (int k = 0; k < 3; ++k) { const int pi = wid + 8 * k;
        if (pi < NKP) { soff[k] = (T.pk == 0) ? (unsigned)(pi * 512 + lane * 8) : (unsigned)((rowbase + lane) * T.pk + 8 * pi); dsto[k] = pi * 1024; }
        else { const int v = pi - NKP; soff[k] = (T.pv == 0) ? (unsigned)(v * 512 + lane * 8) : (unsigned)((rowbase + 16 * (v & 3) + (lane >> 2)) * T.pv + 32 * (v >> 2) + 8 * (lane & 3)); dsto[k] = NKP * 1024 + v * 1024; } }
    const unsigned kstep = (T.pk == 0) ? (unsigned)NKP * 512u : 64u * (unsigned)T.pk, vstep = (T.pv == 0) ? 4096u : 64u * (unsigned)T.pv;
#define AT_DMA(t, slot) do { _Pragma("unroll") for (int k_ = 0; k_ < 3; ++k_) { const int pi_ = wid + 8 * k_; if (pi_ < NP) { \
        const unsigned short* s_ = ((pi_ < NKP) ? T.K : T.V) + (size_t)(soff[k_] + (unsigned)(t) * ((pi_ < NKP) ? kstep : vstep)); glds16(s_, (unsigned)__builtin_amdgcn_readfirstlane(lds0 + (slot) * SLOTB + dsto[k_])); } } } while (0)
    if (!prefetched) { _Pragma("unroll") for (int i_ = 0; i_ < G; ++i_) AT_DMA(i_, (tbase + i_) % NSLOT); }
    __builtin_amdgcn_sched_barrier(0);
#define AT_QLOAD(q0_) do { const unsigned short* Qw_ = T.Q + (rowbase + (q0_) + rb * 32 + r32) * T.pq + hi * 8; \
        _Pragma("unroll") for (int d0 = 0; d0 < ND0; ++d0) qpre[d0] = *(const bf16x8*)(Qw_ + d0 * 16); \
        if constexpr (QNORM) {     \
            _Pragma("unroll") for (int d0 = 0; d0 < 6; ++d0) { gpre[2 * d0] = *(const f32x4*)(qg + d0 * 16 + hi * 8); gpre[2 * d0 + 1] = *(const f32x4*)(qg + d0 * 16 + hi * 8 + 4); } \
            const float* tb_ = tab + (((q0_) + rb * 32 + r32) * 16 + hi * 8) * 2; \
            _Pragma("unroll") for (int j = 0; j < 4; ++j) tpre[j] = *(const f32x4*)(tb_ + 4 * j); } } while (0)
    if (!prefetched) AT_QLOAD(q0);
    __builtin_amdgcn_sched_barrier(0);
    bf16x8 qr[ND0];
#pragma unroll
    for (int d0 = 0; d0 < ND0; ++d0) qr[d0] = qpre[d0];
    f32x4 qg4[QNORM ? 12 : 1], tb4[QNORM ? 4 : 1];
    if constexpr (QNORM) {
#pragma unroll
        for (int j = 0; j < 12; ++j) qg4[j] = gpre[j];
#pragma unroll
        for (int j = 0; j < 4; ++j) tb4[j] = tpre[j]; }
    if constexpr (QNORM) {
        float s = 0.f;
#pragma unroll
        for (int d0 = 0; d0 < ND0; ++d0)
#pragma unroll
            for (int j = 0; j < 8; ++j) { const float x = bf2f((unsigned short)qr[d0][j]); s += x * x; }
        s = swap_sum(s);
        const float rstd = 0.14724445073472677f / sqrtf(s * (1.f / 96.f) + 1e-6f);
#pragma unroll
        for (int d0 = 0; d0 < 4; ++d0) { const f32x4 g0 = qg4[2 * d0], g1 = qg4[2 * d0 + 1]; u32x4 w;
            w.x = cvtpk(bf2f((unsigned short)qr[d0][0]) * rstd * g0.x, bf2f((unsigned short)qr[d0][1]) * rstd * g0.y); w.y = cvtpk(bf2f((unsigned short)qr[d0][2]) * rstd * g0.z, bf2f((unsigned short)qr[d0][3]) * rstd * g0.w);
            w.z = cvtpk(bf2f((unsigned short)qr[d0][4]) * rstd * g1.x, bf2f((unsigned short)qr[d0][5]) * rstd * g1.y); w.w = cvtpk(bf2f((unsigned short)qr[d0][6]) * rstd * g1.z, bf2f((unsigned short)qr[d0][7]) * rstd * g1.w);
            qr[d0] = __builtin_bit_cast(bf16x8, w); asm volatile("" : "+v"(qr[d0])); }
        { float oa[8], ob[8];
#pragma unroll
          for (int j = 0; j < 8; ++j) { const float x1 = bf2f((unsigned short)qr[4][j]) * rstd * qg4[8 + (j >> 2)][j & 3], x2 = bf2f((unsigned short)qr[5][j]) * rstd * qg4[10 + (j >> 2)][j & 3]; const float c = tb4[j >> 1][2 * (j & 1)], sn = tb4[j >> 1][2 * (j & 1) + 1]; oa[j] = x1 * c - x2 * sn; ob[j] = x1 * sn + x2 * c; }
          u32x4 w; w.x = cvtpk(oa[0], oa[1]); w.y = cvtpk(oa[2], oa[3]); w.z = cvtpk(oa[4], oa[5]); w.w = cvtpk(oa[6], oa[7]); qr[4] = __builtin_bit_cast(bf16x8, w);
          w.x = cvtpk(ob[0], ob[1]); w.y = cvtpk(ob[2], ob[3]); w.z = cvtpk(ob[4], ob[5]); w.w = cvtpk(ob[6], ob[7]); qr[5] = __builtin_bit_cast(bf16x8, w); }
    }
    __builtin_amdgcn_sched_barrier(0);
    unsigned sel = 0xffffffffu;
    if (MOBA) {
        if (!prefetched) { kml[tid] = kmv; asm volatile("s_waitcnt lgkmcnt(0)\n\ts_barrier" ::: "memory"); }
        sel = 0u; float gate[8];
#pragma unroll
        for (int j = 0; j < 7; ++j) { float a = 0.f;
            if (j < qb) { const AT_LAS float* kj = kml + j * 64 + hi * 8;
#pragma unroll
                for (int d0 = 0; d0 < ND0; ++d0) { const f32x4 k0 = *(const AT_LAS f32x4*)(kj + d0 * 16), k1 = *(const AT_LAS f32x4*)(kj + d0 * 16 + 4);
                    a += bf2f((unsigned short)qr[d0][0]) * k0.x + bf2f((unsigned short)qr[d0][1]) * k0.y + bf2f((unsigned short)qr[d0][2]) * k0.z + bf2f((unsigned short)qr[d0][3]) * k0.w
                       + bf2f((unsigned short)qr[d0][4]) * k1.x + bf2f((unsigned short)qr[d0][5]) * k1.y + bf2f((unsigned short)qr[d0][6]) * k1.z + bf2f((unsigned short)qr[d0][7]) * k1.w; } }
            a = swap_sum(a); gate[j] = (j < qb) ? a : -INFINITY; }
        gate[7] = -INFINITY;
#pragma unroll
        for (int r = 0; r < 3; ++r) { int best = -1; float bv = -INFINITY;
#pragma unroll
            for (int j = 0; j < 8; ++j) if (!((sel >> j) & 1u) && gate[j] > bv) { bv = gate[j]; best = j; }
            if (best >= 0) sel |= 1u << best; }
    }
    __builtin_amdgcn_sched_barrier(0);
    float l = 0.f; f32x16 o[2]; o[0] = f32x16{}; o[1] = f32x16{};
    f32x16 negm;
    { float qss = 0.f;
#pragma unroll
      for (int d0 = 0; d0 < ND0; ++d0)
#pragma unroll
          for (int j = 0; j < 8; ++j) { const float x = bf2f((unsigned short)qr[d0][j]); qss += x * x; }
      qss = swap_sum(qss); const float mrow = sqrtf(qss) * kbound;
#pragma unroll
      for (int r = 0; r < 16; ++r) negm[r] = -mrow;
      asm volatile("" : "+v"(negm)); }

    const int qrel = rb * 32 + r32;
    const int vbl = ((lane >> 4) & 1) * 32 + (lane & 3) * 8 + (4 * hi + ((lane & 15) >> 2)) * 64;
#define AT_GROUP(u) do { asm volatile("s_waitcnt vmcnt(0) lgkmcnt(0)\n\ts_barrier" ::: "memory"); \
        if ((u) + G < NT) { _Pragma("unroll") for (int i_ = 0; i_ < G; ++i_) { const int tt_ = (u) + G + i_; AT_DMA(tt_, (tbase + tt_) % NSLOT); } } \
        else if (has_next) { _Pragma("unroll") for (int i_ = 0; i_ < G; ++i_) AT_DMA(i_, (tbase + NT + i_) % NSLOT); } } while (0)
#define AT_KLOAD(sl) do { const AT_LAS unsigned char* kb = lds + (sl) * SLOTB + hi * 1024 + r32 * 16; \
        _Pragma("unroll") for (int d0 = 0; d0 < ND0; ++d0) { kf[2 * d0] = *(const AT_LAS bf16x8*)(kb + d0 * 2048); kf[2 * d0 + 1] = *(const AT_LAS bf16x8*)(kb + d0 * 2048 + 512); } } while (0)
#define AT_VLOAD(sl) do { const AT_LAS unsigned char* vp = lds + (sl) * SLOTB + NKP * 1024 + vbl; \
        _Pragma("unroll") for (int i = 0; i < 8; ++i) { vlo[i] = vtr(vp + (i >> 2) * 4096 + (i & 3) * 1024); vhi[i] = vtr(vp + (i >> 2) * 4096 + (i & 3) * 1024 + 512); } } while (0)
#define AT_SUMPACK() do { float sacc = 0.f; \
        _Pragma("unroll") for (int r = 0; r < 16; ++r) sacc += c0[r] + c1[r]; \
        l += sacc; \
        pw[0] = (u32x4){cvtpk(c0[0], c0[1]), cvtpk(c0[2], c0[3]), cvtpk(c0[4], c0[5]), cvtpk(c0[6], c0[7])}; \
        pw[1] = (u32x4){cvtpk(c0[8], c0[9]), cvtpk(c0[10], c0[11]), cvtpk(c0[12], c0[13]), cvtpk(c0[14], c0[15])}; \
        pw[2] = (u32x4){cvtpk(c1[0], c1[1]), cvtpk(c1[2], c1[3]), cvtpk(c1[4], c1[5]), cvtpk(c1[6], c1[7])}; \
        pw[3] = (u32x4){cvtpk(c1[8], c1[9]), cvtpk(c1[10], c1[11]), cvtpk(c1[12], c1[13]), cvtpk(c1[14], c1[15])}; } while (0)
#define AT_QKT(N0, N1) do { _Pragma("unroll") for (int d0 = 0; d0 < ND0; ++d0) { \
            if (d0 == 0) { N0 = __builtin_amdgcn_mfma_f32_32x32x16_bf16(kf[0], qr[0], negm, 0, 0, 0); N1 = __builtin_amdgcn_mfma_f32_32x32x16_bf16(kf[1], qr[0], negm, 0, 0, 0); } \
            else { N0 = __builtin_amdgcn_mfma_f32_32x32x16_bf16(kf[2 * d0], qr[d0], N0, 0, 0, 0); N1 = __builtin_amdgcn_mfma_f32_32x32x16_bf16(kf[2 * d0 + 1], qr[d0], N1, 0, 0, 0); } } } while (0)
#define AT_DECIDE(tt) do { \
        { const int jb = (tt) - (NT - 4); \
          if (jb >= 0) { const int kb0 = 64 * jb + 4 * hi; \
              _Pragma("unroll") for (int r = 0; r < 16; ++r) { const int kv = kb0 + (r & 3) + 8 * (r >> 2); if (kv > qrel) c0[r] = NEGM; if (kv + 32 > qrel) c1[r] = NEGM; } } \
          else if (MOBA) { const bool keep = ((sel >> ((tt) >> 2)) & 1u) != 0u; \
              if (!__all(keep)) { if (!keep) { _Pragma("unroll") for (int r = 0; r < 16; ++r) { c0[r] = NEGM; c1[r] = NEGM; } } } } } \
        if ((tt) + 1 < NT && (((tt) + 1) % G) == 0) AT_GROUP((tt) + 1); } while (0)
#define AT_EXPS() do { _Pragma("unroll") for (int r = 0; r < 16; ++r) { c0[r] = __builtin_amdgcn_exp2f(c0[r]); c1[r] = __builtin_amdgcn_exp2f(c1[r]); } } while (0)
#define AT_PV() do { _Pragma("unroll") for (int d0 = 0; d0 < 2; ++d0) _Pragma("unroll") for (int ks = 0; ks < 4; ++ks) { const int i = d0 * 4 + ks; \
            o[d0] = __builtin_amdgcn_mfma_f32_32x32x16_bf16((bf16x8){vlo[i][0], vlo[i][1], vlo[i][2], vlo[i][3], vhi[i][0], vhi[i][1], vhi[i][2], vhi[i][3]}, __builtin_bit_cast(bf16x8, pw[ks]), o[d0], 0, 0, 0); } } while (0)
#define AT_SGB(mask, n) __builtin_amdgcn_sched_group_barrier(mask, n, 0)
    constexpr int NG = 2 * ND0;
    bf16x8 kf[2 * ND0]; s16x4 vlo[8], vhi[8]; u32x4 pw[4]; f32x16 c0, c1;
    AT_GROUP(0);
    AT_KLOAD(tbase % NSLOT);
    AT_QKT(c0, c1);
    AT_DECIDE(0);
    AT_KLOAD((tbase + 1) % NSLOT);
    AT_EXPS();
    int slot = (tbase + 1) % NSLOT, pslot = tbase % NSLOT;
    const int NTw = NT - 3 + (rb >> 1);
    for (int t = 1; t < NTw; ++t) {
        const int nslot = (t + 1 < NTw) ? ((slot == NSLOT - 1) ? 0 : slot + 1) : slot;
        __builtin_amdgcn_sched_barrier(0);
        { f32x16 n0, n1; float sacc = 0.f;
          const AT_LAS unsigned char* vp = lds + pslot * SLOTB + NKP * 1024 + vbl;
#pragma unroll
          for (int i = 0; i < NG; ++i) {
              if (i >= NG - 2) { const int vi = i - (NG - 2); vlo[vi] = vtr(vp + (vi >> 2) * 4096 + (vi & 3) * 1024); vhi[vi] = vtr(vp + (vi >> 2) * 4096 + (vi & 3) * 1024 + 512); }
              const int d0 = i >> 1;
              if (i & 1) n1 = (d0 == 0) ? __builtin_amdgcn_mfma_f32_32x32x16_bf16(kf[i], qr[d0], negm, 0, 0, 0) : __builtin_amdgcn_mfma_f32_32x32x16_bf16(kf[i], qr[d0], n1, 0, 0, 0);
              else n0 = (d0 == 0) ? __builtin_amdgcn_mfma_f32_32x32x16_bf16(kf[i], qr[d0], negm, 0, 0, 0) : __builtin_amdgcn_mfma_f32_32x32x16_bf16(kf[i], qr[d0], n0, 0, 0, 0);
#pragma unroll
              for (int rr = (i * 32) / NG; rr < ((i + 1) * 32) / NG; ++rr) sacc += (rr < 16) ? c0[rr] : c1[rr - 16];
#pragma unroll
              for (int ww = (i * 16) / NG; ww < ((i + 1) * 16) / NG; ++ww) { const int e = 2 * ww; pw[ww >> 2][ww & 3] = (e < 16) ? cvtpk(c0[e], c0[e + 1]) : cvtpk(c1[e - 16], c1[e - 15]); }
              __builtin_amdgcn_sched_barrier(0); }
          l += sacc; c0 = n0; c1 = n1; }
        AT_DECIDE(t);
        __builtin_amdgcn_sched_barrier(0);
        { const AT_LAS unsigned char* kb = lds + nslot * SLOTB + hi * 1024 + r32 * 16; const AT_LAS unsigned char* vpB = lds + pslot * SLOTB + NKP * 1024 + vbl;
#pragma unroll
          for (int i = 0; i < 8; ++i) {
              if (i + 2 < 8) { const int vi = i + 2; vlo[vi] = vtr(vpB + (vi >> 2) * 4096 + (vi & 3) * 1024); vhi[vi] = vtr(vpB + (vi >> 2) * 4096 + (vi & 3) * 1024 + 512); }
              if (i >= 2 && i < 6) {
#pragma unroll
                  for (int q = (i - 2) * NG / 4; q < (i - 1) * NG / 4; ++q) kf[q] = *(const AT_LAS bf16x8*)(kb + (q >> 1) * 2048 + (q & 1) * 512); }
              o[i >> 2] = __builtin_amdgcn_mfma_f32_32x32x16_bf16((bf16x8){vlo[i][0], vlo[i][1], vlo[i][2], vlo[i][3], vhi[i][0], vhi[i][1], vhi[i][2], vhi[i][3]}, __builtin_bit_cast(bf16x8, pw[i & 3]), o[i >> 2], 0, 0, 0);
#pragma unroll
              for (int rr = 4 * i; rr < 4 * i + 4; ++rr) { if (rr < 16) c0[rr] = __builtin_amdgcn_exp2f(c0[rr]); else c1[rr - 16] = __builtin_amdgcn_exp2f(c1[rr - 16]); }
              __builtin_amdgcn_sched_barrier(0); } }
        pslot = slot; slot = nslot;
    }
    AT_VLOAD(pslot);
    AT_SUMPACK();
    AT_PV();
    for (int t = NTw; t < NT; ++t) { if (t + 1 < NT && ((t + 1) % G) == 0) AT_GROUP(t + 1); }
#undef AT_GROUP
#undef AT_KLOAD
#undef AT_VLOAD
#undef AT_SUMPACK
#undef AT_QKT
#undef AT_DECIDE
#undef AT_EXPS
#undef AT_PV
#undef AT_SGB
#undef AT_DMA
    AT_QLOAD((has_next ? qb_next : qb) * 256);
    __builtin_amdgcn_sched_barrier(0);
#undef AT_QLOAD
    l = swap_sum(l);
    { const float rl = __builtin_amdgcn_rcpf(l);
      unsigned short* Ow = T.O + (rowbase + q0 + rb * 32 + r32) * T.po + hi * 8;
#pragma unroll
      for (int kp = 0; kp < 4; ++kp) { const int d0 = kp >> 1, g0 = (kp & 1) * 2;
          unsigned ax = cvtpk(o[d0][4 * g0] * rl, o[d0][4 * g0 + 1] * rl), ay = cvtpk(o[d0][4 * g0 + 2] * rl, o[d0][4 * g0 + 3] * rl);
          unsigned bx = cvtpk(o[d0][4 * g0 + 4] * rl, o[d0][4 * g0 + 5] * rl), by = cvtpk(o[d0][4 * g0 + 6] * rl, o[d0][4 * g0 + 7] * rl);
          { auto r_ = __builtin_amdgcn_permlane32_swap(ax, bx, false, false); ax = r_[0]; bx = r_[1]; }
          { auto r_ = __builtin_amdgcn_permlane32_swap(ay, by, false, false); ay = r_[0]; by = r_[1]; }
          *(u32x4*)(Ow + 16 * kp) = (u32x4){ax, ay, bx, by}; } }
}
#undef AT_LAS
}

namespace ssd {
typedef short bf16x8 __attribute__((ext_vector_type(8)));
typedef short v4i16_t __attribute__((ext_vector_type(4)));
typedef float f32x16 __attribute__((ext_vector_type(16)));
typedef unsigned u32x4 __attribute__((ext_vector_type(4)));
#define SS_LAS __attribute__((address_space(3)))
__device__ __forceinline__ int crow(int r, int hi) { return (r & 3) + 8 * (r >> 2) + 4 * hi; }
__device__ __forceinline__ v4i16_t vtr(const SS_LAS unsigned char* p) { return __builtin_amdgcn_ds_read_tr16_b64_v4i16((SS_LAS v4i16_t*)p); }
__device__ __forceinline__ bf16x8 tr_frag(const SS_LAS unsigned char* img, int pitch, int k0, int c0, int lane) {
    const int g4 = lane >> 4, q = (lane & 15) >> 2, p4 = lane & 3;
    const SS_LAS unsigned char* a = img + (k0 + 8 * (g4 >> 1) + q) * pitch + (c0 + 16 * (g4 & 1) + 4 * p4) * 2;
    const v4i16_t lo = vtr(a), hi4 = vtr(a + 4 * pitch);
    return (bf16x8){lo[0], lo[1], lo[2], lo[3], hi4[0], hi4[1], hi4[2], hi4[3]};
}
__device__ __forceinline__ bf16x8 row_frag(const SS_LAS unsigned char* img, int pitch, int r0, int k0, int lane) {
    return *(const SS_LAS bf16x8*)(img + (r0 + (lane & 31)) * pitch + (k0 + 8 * (lane >> 5)) * 2);
}

constexpr int PX4 = 576;
constexpr int PB_T = 320;
constexpr int PR = 272;
constexpr int PX1 = 192;

__device__ __forceinline__ void dt_cs(int t0, int g, const float* DTR, const float* dtb, const float* alog, SS_LAS float* csl, SS_LAS float* dtl, SS_LAS float* wtot, int tid, int lane, int wid) {
    const int l = tid >> 2, hh = tid & 3, h = 4 * g + hh;
    const float r = DTR[(size_t)(t0 + l) * 8 + h] + dtb[h]; const float ex = __expf(fminf(r, 20.f)); const float dt = (r > 20.f) ? r : ((ex < 0.01f) ? ex * (1.f - ex * (0.5f - ex * 0.33333333f)) : __logf(1.f + ex));
    float v = dt * (-expf(alog[h]));
#pragma unroll
    for (int off = 4; off < 64; off <<= 1) { const float t = __builtin_bit_cast(float, __builtin_amdgcn_ds_bpermute(((lane - off) & 63) << 2, __builtin_bit_cast(int, v))); if (lane >= off) v += t; }
    if (lane >= 60) wtot[wid * 4 + hh] = v;
    __syncthreads();
    float base = 0.f;
    for (int w = 0; w < wid; ++w) base += wtot[w * 4 + hh];
    csl[tid] = v + base; dtl[tid] = dt;
    __syncthreads();
}
__device__ __forceinline__ void conv_load(u32x4 (&x)[19], const unsigned short* raw, int t0, int l0, int col, bool on = true) {
    const int pos0 = t0 & 2047;
#pragma unroll
    for (int i = 0; i < 19; ++i) { const int l = l0 - 3 + i; x[i] = (u32x4){0u, 0u, 0u, 0u}; if (on && pos0 + l >= 0) x[i] = *(const u32x4*)(raw + (size_t)(t0 + l) * 1024 + col); }
}
struct ConvW { float w[4][8], b[8]; };
__device__ __forceinline__ void conv_wload(ConvW& W, const float* cw, const float* cb, int col) {
#pragma unroll
    for (int k = 0; k < 4; ++k) { const f32x4 a = *(const f32x4*)(cw + k * 1024 + col) * -1.44269504088896341f, c = *(const f32x4*)(cw + k * 1024 + col + 4) * -1.44269504088896341f;
        W.w[k][0] = a.x; W.w[k][1] = a.y; W.w[k][2] = a.z; W.w[k][3] = a.w; W.w[k][4] = c.x; W.w[k][5] = c.y; W.w[k][6] = c.z; W.w[k][7] = c.w; }
    { const f32x4 a = *(const f32x4*)(cb + col) * -1.44269504088896341f, c = *(const f32x4*)(cb + col + 4) * -1.44269504088896341f; W.b[0] = a.x; W.b[1] = a.y; W.b[2] = a.z; W.b[3] = a.w; W.b[4] = c.x; W.b[5] = c.y; W.b[6] = c.z; W.b[7] = c.w; }
}
typedef float f32x2s __attribute__((ext_vector_type(2)));
__device__ __forceinline__ f32x2s pk_add1(f32x2s a) { asm("" : "+v"(a)); return a + 1.0f; }
__device__ __forceinline__ void conv_compute(const u32x4 (&x)[19], int l0, const ConvW& W, SS_LAS unsigned char* img, int pitch, const SS_LAS float* sc, bool scaled) {
#pragma unroll
    for (int i = 0; i < 16; ++i) { const int l = l0 + i; float o[8]; const float s = (scaled ? sc[l * 4] : 1.f) * -0.693147180559945309f;
#pragma unroll
        for (int j = 0; j < 8; j += 2) { float a0 = W.b[j], a1 = W.b[j + 1];
#pragma unroll
            for (int k = 0; k < 4; ++k) { const unsigned wd = (j < 2) ? x[i + k].x : (j < 4) ? x[i + k].y : (j < 6) ? x[i + k].z : x[i + k].w; a0 += W.w[k][j] * bflo(wd); a1 += W.w[k][j + 1] * bfhi(wd); }
            const f32x2s d = pk_add1((f32x2s){__builtin_amdgcn_exp2f(a0), __builtin_amdgcn_exp2f(a1)});
            o[j] = a0 * __builtin_amdgcn_rcpf(d.x) * s; o[j + 1] = a1 * __builtin_amdgcn_rcpf(d.y) * s; }
        u32x4 p; p.x = pk2(o[0], o[1]); p.y = pk2(o[2], o[3]); p.z = pk2(o[4], o[5]); p.w = pk2(o[6], o[7]);
        *(SS_LAS u32x4*)(img + l * pitch) = p; }
}

__device__ __forceinline__ void states_unit(SS_LAS unsigned char* lds, int bc, int g, const unsigned short* XBC, const float* DTR, const float* cw, const float* cb, const float* dtb, const float* alog, unsigned short* ST, float* CEND) {
    int tid_ = threadIdx.x; asm volatile("" : "+v"(tid_));
    const int tid = tid_, lane = tid & 63, r32 = lane & 31, hi = lane >> 5; const int wid = __builtin_amdgcn_readfirstlane(tid >> 6);
    const int t0 = bc * 128;
    SS_LAS unsigned char* XD = lds; SS_LAS unsigned char* BI = lds + 128 * PX4;
    SS_LAS float* csl = (SS_LAS float*)(lds + 128 * PX4 + 128 * PB_T); SS_LAS float* dtl = csl + 512; SS_LAS float* wtot = dtl + 512; SS_LAS float* scl = wtot + 32;
    const int ch = tid % 48, l0 = (tid / 48) * 16; const int col = (ch < 32) ? g * 256 + ch * 8 : 512 + g * 128 + (ch - 32) * 8;
    u32x4 xr[19]; ConvW W;
    if (tid < 384) { conv_load(xr, XBC, t0, l0, col); conv_wload(W, cw, cb, col); }
    dt_cs(t0, g, DTR, dtb, alog, csl, dtl, wtot, tid, lane, wid);
    scl[tid] = dtl[tid] * __expf(csl[508 + (tid & 3)] - csl[tid]);
    if (tid < 4) CEND[bc * 8 + g * 4 + tid] = csl[508 + tid];
    __syncthreads();
    if (tid < 384) {
        const bool isx = ch < 32; conv_compute(xr, l0, W, isx ? XD + ch * 16 : BI + (ch - 32) * 16, isx ? PX4 : PB_T, scl + (isx ? (ch >> 3) : 0), isx); }
    __syncthreads();
    const int pt = wid >> 2, nt = wid & 3;
#pragma unroll 1
    for (int hh = 0; hh < 4; ++hh) {
        f32x16 acc = f32x16{};
#pragma unroll
        for (int ks = 0; ks < 8; ++ks) {
            const bf16x8 a = tr_frag(XD, PX4, 16 * ks, hh * 64 + 32 * pt, lane);
            const bf16x8 b = tr_frag(BI, PB_T, 16 * ks, 32 * nt, lane);
            acc = __builtin_amdgcn_mfma_f32_32x32x16_bf16(a, b, acc, 0, 0, 0); }
        unsigned short* o = ST + (((size_t)(bc * 8 + g * 4 + hh) * 64 + 32 * pt) << 7) + 32 * nt + r32;
#pragma unroll
        for (int r = 0; r < 16; r += 2) { const unsigned w = pk2(acc[r], acc[r + 1]); o[(size_t)crow(r, hi) << 7] = (unsigned short)w; o[(size_t)crow(r + 1, hi) << 7] = (unsigned short)(w >> 16); }
    }
    __syncthreads();
}

__device__ __forceinline__ void out_unit(SS_LAS unsigned char* lds, int bc, int g, const unsigned short* XBC, const unsigned short* VZ, const float* DTR, const float* cw, const float* cb, const float* dtb, const float* alog,
                                         const unsigned short* HIN, const float* Dsk, const SS_LAS float* gnl, unsigned short* MIX, u32x4 (&xr)[19], bool preloaded, int next_bc, int next_g) {
    int tid_ = threadIdx.x; asm volatile("" : "+v"(tid_));
    const int tid = tid_, lane = tid & 63, r32 = lane & 31, hi = lane >> 5; const int wid = __builtin_amdgcn_readfirstlane(tid >> 6);
    const int t0 = bc * 128;
    SS_LAS unsigned char* CI = lds; SS_LAS unsigned char* BI = lds + 128 * PR; SS_LAS unsigned char* XS = lds + 2 * 128 * PR;
    SS_LAS float* csl = (SS_LAS float*)(lds + 2 * 128 * PR + 128 * PX4); SS_LAS float* dtl = csl + 512; SS_LAS float* wtot = dtl + 512;
    const int ch = tid & 63, l0 = (tid >> 6) * 16; const int col = (ch < 32) ? g * 256 + ch * 8 : (ch < 48) ? 512 + g * 128 + (ch - 32) * 8 : 768 + g * 128 + (ch - 48) * 8;
    ConvW W;
    if (!preloaded) conv_load(xr, XBC, t0, l0, col);
    conv_wload(W, cw, cb, col);
    dt_cs(t0, g, DTR, dtb, alog, csl, dtl, wtot, tid, lane, wid);
    const int lt = wid >> 1, st0 = 2 * (wid & 1), pt = wid & 1;
    bf16x8 hb[2][8];
    const unsigned short* hin0 = HIN + (((size_t)(bc * 8 + g * 4) * 64 + 32 * pt + r32) << 7) + 8 * hi;
#pragma unroll
    for (int ks = 0; ks < 8; ++ks) hb[0][ks] = *(const bf16x8*)(hin0 + 16 * ks);
    __builtin_amdgcn_sched_barrier(0);
    conv_compute(xr, l0, W, (ch < 32) ? XS + ch * 16 : (ch < 48) ? BI + (ch - 32) * 16 : CI + (ch - 48) * 16, (ch < 32) ? PX4 : PR, (const SS_LAS float*)csl, false);
    __syncthreads();
    u32x4 zr[8];
    { const unsigned short* zp = VZ + (size_t)(t0 + (tid >> 2)) * 1024 + 512 + g * 256 + (tid & 3) * 64;
#pragma unroll
      for (int c = 0; c < 8; ++c) zr[c] = *(const u32x4*)(zp + c * 8); }
    f32x16 cb2[2]; cb2[0] = f32x16{}; cb2[1] = f32x16{};
#pragma unroll
    for (int ks = 0; ks < 8; ++ks) {
        const bf16x8 a = row_frag(CI, PR, 32 * lt, 16 * ks, lane);
        const bf16x8 b0 = row_frag(BI, PR, 32 * st0, 16 * ks, lane), b1 = row_frag(BI, PR, 32 * st0 + 32, 16 * ks, lane);
        cb2[0] = __builtin_amdgcn_mfma_f32_32x32x16_bf16(a, b0, cb2[0], 0, 0, 0);
        cb2[1] = __builtin_amdgcn_mfma_f32_32x32x16_bf16(a, b1, cb2[1], 0, 0, 0); }
    f32x16 yo[4];
    {
#pragma unroll
      for (int hh = 0; hh < 4; ++hh) { yo[hh] = f32x16{};
          if (hh < 3) {
#pragma unroll
              for (int ks = 0; ks < 8; ++ks) hb[(hh + 1) & 1][ks] = *(const bf16x8*)(hin0 + ((size_t)(hh + 1) << 13) + 16 * ks); }
          __builtin_amdgcn_sched_barrier(0);
#pragma unroll
          for (int ks = 0; ks < 8; ++ks) yo[hh] = __builtin_amdgcn_mfma_f32_32x32x16_bf16(row_frag(CI, PR, 32 * lt, 16 * ks, lane), hb[hh & 1][ks], yo[hh], 0, 0, 0);
          __builtin_amdgcn_sched_barrier(0); }
#pragma unroll
      for (int hh = 0; hh < 4; ++hh)
#pragma unroll
          for (int r = 0; r < 16; ++r) yo[hh][r] *= __expf(csl[(32 * lt + crow(r, hi)) * 4 + hh]); }
    __syncthreads();
#pragma unroll
    for (int pr2 = 0; pr2 < 2; ++pr2) {
#pragma unroll
        for (int e = 0; e < 2; ++e) { const int hh = 2 * pr2 + e; SS_LAS unsigned char* MI = e ? CI : BI;
#pragma unroll
            for (int j = 0; j < 2; ++j) { const int s = 32 * (st0 + j) + r32; const float css = csl[s * 4 + hh], dts = dtl[s * 4 + hh];
#pragma unroll
                for (int r = 0; r < 16; ++r) { const int l = 32 * lt + crow(r, hi); const float cl = csl[l * 4 + hh];
                    float pr_ = cb2[j][r] * __builtin_amdgcn_exp2f(fminf(cl - css, 0.f) * 1.4426950408889634f) * dts; asm volatile("" : "+v"(pr_)); const float v = (s <= l) ? pr_ : 0.f;
                    *(SS_LAS unsigned short*)(MI + l * PR + s * 2) = (unsigned short)f2bf(v); if ((r & 3) == 3) asm volatile("" ::: "memory"); } }
            __builtin_amdgcn_sched_barrier(0); }
        __syncthreads();
        f32x16 yd[2]; yd[0] = yo[2 * pr2]; yd[1] = yo[2 * pr2 + 1];
#pragma unroll
        for (int ks = 0; ks < 8; ++ks) {
            yd[0] = __builtin_amdgcn_mfma_f32_32x32x16_bf16(row_frag(BI, PR, 32 * lt, 16 * ks, lane), tr_frag(XS, PX4, 16 * ks, (2 * pr2) * 64 + 32 * pt, lane), yd[0], 0, 0, 0);
            yd[1] = __builtin_amdgcn_mfma_f32_32x32x16_bf16(row_frag(CI, PR, 32 * lt, 16 * ks, lane), tr_frag(XS, PX4, 16 * ks, (2 * pr2 + 1) * 64 + 32 * pt, lane), yd[1], 0, 0, 0); }
        __syncthreads();
#pragma unroll
        for (int e = 0; e < 2; ++e) { const int hh = 2 * pr2 + e; const float dsk = Dsk[g * 4 + hh]; const int p = 32 * pt + r32;
#pragma unroll
            for (int r = 0; r < 16; ++r) { const int l = 32 * lt + crow(r, hi);
                SS_LAS unsigned short* xp = (SS_LAS unsigned short*)(XS + l * PX4 + (hh * 64 + p) * 2);
                const float y = yd[e][r] + dsk * bf2f(*xp);
                *xp = (unsigned short)f2bf(y); }
            __builtin_amdgcn_sched_barrier(0); }
    }
    asm volatile("s_waitcnt lgkmcnt(0)" ::: "memory"); __builtin_amdgcn_s_barrier(); asm volatile("" ::: "memory");
    { const int l = tid >> 2, q = tid & 3; const SS_LAS unsigned char* rowp = XS + l * PX4 + q * 128; float yv[8][8]; float s = 0.f;
#pragma unroll
      for (int c = 0; c < 8; ++c) { const u32x4 v = *(const SS_LAS u32x4*)(rowp + c * 16); const u32x4 z = zr[c];
          yv[c][0] = bflo(v.x) * silu_f(bflo(z.x)); yv[c][1] = bfhi(v.x) * silu_f(bfhi(z.x)); yv[c][2] = bflo(v.y) * silu_f(bflo(z.y)); yv[c][3] = bfhi(v.y) * silu_f(bfhi(z.y));
          yv[c][4] = bflo(v.z) * silu_f(bflo(z.z)); yv[c][5] = bfhi(v.z) * silu_f(bfhi(z.z)); yv[c][6] = bflo(v.w) * silu_f(bflo(z.w)); yv[c][7] = bfhi(v.w) * silu_f(bfhi(z.w));
#pragma unroll
          for (int j = 0; j < 8; ++j) s += yv[c][j] * yv[c][j]; }
      s += __shfl_xor(s, 1); s += __shfl_xor(s, 2);
      asm volatile("" : "+v"(s));
      { int t2 = tid; asm volatile("" : "+v"(t2)); const int ch2 = t2 & 63, l02 = (t2 >> 6) * 16;
        const int ncol = (ch2 < 32) ? next_g * 256 + ch2 * 8 : (ch2 < 48) ? 512 + next_g * 128 + (ch2 - 32) * 8 : 768 + next_g * 128 + (ch2 - 48) * 8;
        conv_load(xr, XBC, (next_bc >= 0 ? next_bc : 0) * 128, l02, ncol, next_bc >= 0); __builtin_amdgcn_sched_barrier(0); }
      const float rstd = __builtin_amdgcn_rsqf(s * (1.f / 256.f) + 1e-6f); unsigned short* op = MIX + (size_t)(t0 + l) * 1024 + 512 + g * 256 + q * 64;
      const SS_LAS float* gq = gnl + g * 256 + q * 64;
#pragma unroll
      for (int c = 0; c < 8; ++c) { const f32x4 g0 = *(const SS_LAS f32x4*)(gq + c * 8), g1 = *(const SS_LAS f32x4*)(gq + c * 8 + 4); u32x4 o;
          o.x = pk2(yv[c][0] * rstd * g0.x, yv[c][1] * rstd * g0.y); o.y = pk2(yv[c][2] * rstd * g0.z, yv[c][3] * rstd * g0.w);
          o.z = pk2(yv[c][4] * rstd * g1.x, yv[c][5] * rstd * g1.y); o.w = pk2(yv[c][6] * rstd * g1.z, yv[c][7] * rstd * g1.w);
          *(u32x4*)(op + c * 8) = o; } }
    asm volatile("s_waitcnt lgkmcnt(0)" ::: "memory"); __builtin_amdgcn_s_barrier(); asm volatile("" ::: "memory");
}
#undef SS_LAS
}

constexpr int NWAVES = 8, NTHR = 512;
constexpr int T_ = 32768, S_ = 2048, NB_ = 16, D_ = 1024;
constexpr int DFF = 2816, DFF2 = 5632;
constexpr float EPS = 1e-6f;
constexpr size_t MiB = 1u << 20;
constexpr size_t WS_CTL = 0, CTL_ZERO_BYTES = 3 * MiB;
constexpr size_t WS_SSQA = 1 * MiB, WS_SSQB = WS_SSQA + 256 * 1024, WS_SSQC = WS_SSQB + 256 * 1024, WS_SSQQ = WS_SSQC + 256 * 1024, WS_SSQKV = WS_SSQQ + 256 * 1024;
constexpr size_t WS_KMEAN = WS_SSQKV + 256 * 1024;
constexpr size_t WS_DTR = 55 * MiB;
constexpr size_t WS_W_IN0 = 3 * MiB;
constexpr size_t WS_W_OUT0 = WS_W_IN0 + 6656 * 1024;
constexpr size_t WS_W_IN1 = WS_W_OUT0 + 2 * MiB;
constexpr size_t WS_W_UQ = WS_W_IN1 + 2 * MiB;
constexpr size_t WS_W_UKV = WS_W_UQ + 1536 * 1024;
constexpr size_t WS_W_OUT1 = WS_W_UKV + 1 * MiB;
constexpr size_t WS_W_UP = WS_W_OUT1 + 2 * MiB;
constexpr size_t WS_W_DN = WS_W_UP + 22 * MiB;
constexpr size_t WS_TAB64 = 51 * MiB;
constexpr size_t WS_TAB32 = WS_TAB64 + 512 * 1024;
constexpr size_t WS_CWS = 52 * MiB;
constexpr size_t WS_RS0 = 52 * MiB + 512 * 1024;
constexpr size_t WS_DT = 53 * MiB;
constexpr size_t WS_CS = 54 * MiB;
constexpr size_t WS_XN = 56 * MiB;
constexpr size_t WS_BIG = 120 * MiB;
static_assert(WS_W_DN + 11 * MiB <= WS_TAB64, "weights fit");
constexpr size_t L0_QK = WS_BIG, L0_VZ = WS_BIG + 64 * MiB, L0_XBC = WS_BIG + 128 * MiB, L0_DTR = WS_BIG + 192 * MiB, L0_XBCA = WS_BIG + 256 * MiB, L0_MIX = WS_BIG + 320 * MiB;
constexpr size_t L0_ST = WS_BIG + 192 * MiB;
constexpr size_t L0_KC = WS_BIG + 288 * MiB;
constexpr size_t L0_HIN = WS_BIG + 256 * MiB;
constexpr size_t WS_CEND = 53 * MiB;
constexpr size_t L0_CB = L0_DTR;
constexpr size_t L0_YG = L0_QK;
constexpr size_t FF_ACT = WS_BIG + 64 * MiB, FF_UB = WS_BIG + 240 * MiB;
constexpr size_t L1_C1 = WS_BIG, L1_QR = WS_BIG + 64 * MiB, L1_V2 = WS_BIG + 160 * MiB;
constexpr size_t WS_RG = WS_BIG + 384 * MiB;
constexpr size_t WS_SSQPE = 53 * MiB + 64 * 1024;
constexpr size_t L1_K2 = WS_BIG + 288 * MiB;
constexpr size_t L1_O = WS_BIG + 224 * MiB;
constexpr size_t WS_END = 512 * MiB;
constexpr int CW_BAR = 4096;

constexpr int RING_OFF = 0, RING_BYTES = 162816;
constexpr int LDSCTL_OFF = RING_BYTES, MISC_OFF = LDSCTL_OFF + 320;
constexpr int LDS_BYTES = 163840;

struct Args { const float* in[25]; float* out; unsigned char* ws; int ph_lo, ph_hi; };
typedef const __attribute__((address_space(4))) Args* KArgs;
__device__ __forceinline__ KArgs kargs() { KArgs p = (KArgs)__builtin_amdgcn_kernarg_segment_ptr(); asm volatile("" : "+s"(p)); return p; }
#define PH_VARS KArgs A_ = kargs(); unsigned char* ws = A_->ws; float* out = A_->out; const float* x = A_->in[0]; bf16* XN = (bf16*)(ws + WS_XN); const float* TAB64 = (const float*)(ws + WS_TAB64); const float* TAB32 = (const float*)(ws + WS_TAB32); \
    int tid_ = threadIdx.x; asm volatile("" : "+v"(tid_)); const int tid = tid_, lane = tid & 63, wave = __builtin_amdgcn_readfirstlane(tid >> 6); int G = gridDim.x; asm volatile("" : "+s"(G)); const int gw = blockIdx.x * NWAVES + wave, NGW = G * NWAVES; const int gt = blockIdx.x * NTHR + tid, NGT = G * NTHR; \
    (void)out; (void)x; (void)XN; (void)TAB64; (void)TAB32; (void)lane; (void)gw; (void)NGW; (void)gt; (void)NGT;

template <int MAP> __device__ __forceinline__ int src_col(int n0) {
    if (MAP == 1) { const int pn = n0 >> 8, bj = (n0 >> 7) & 1, wc = (n0 >> 5) & 3; return bj * DFF + pn * 128 + wc * 32; }
    if (MAP == 2) { const int pn = n0 >> 8, bj = (n0 >> 7) & 1, wc = (n0 >> 5) & 3; return (pn < 4) ? pn * 256 + wc * 64 + bj * 32 : n0; }
    if (MAP == 3) { const int pn = n0 >> 8, bj = (n0 >> 7) & 1, wc = (n0 >> 5) & 3; if (pn < 4) return (4 * pn + wc) * 128 + bj * 32; const int col = (pn - 4) * 256 + bj * 128 + wc * 32; return (col >> 6) * 128 + 64 + (col & 63); }
    return n0;
}
template <int MAP> __device__ __forceinline__ void tr_load(f32x4 (&v)[8], const float* W, int Nsrc, int item, int nblk, int lane, const float* gain) {
    const int kb = item / nblk, nb = item % nblk, k0 = 64 * kb, n0 = 32 * nb;
    const int nn = src_col<MAP>(n0) + (lane & 7) * 4; const bool ok = (nn >= 0 && nn < Nsrc);
#pragma unroll
    for (int i = 0; i < 8; ++i) { const int kk = 8 * i + (lane >> 3); v[i] = ok ? *(const f32x4*)(W + (size_t)(k0 + kk) * Nsrc + nn) : (f32x4){0.f, 0.f, 0.f, 0.f}; if (gain) v[i] = v[i] * gain[k0 + kk]; }
}
__device__ __forceinline__ void tr_store(const f32x4 (&v)[8], int K, bf16* WT, LAS float* scr, int item, int nblk, int lane) {
    const int kb = item / nblk, nb = item % nblk, k0 = 64 * kb, n0 = 32 * nb;
#pragma unroll
    for (int i = 0; i < 8; ++i) { const int kk = 8 * i + (lane >> 3); LAS float* d = scr + kk * 33 + (lane & 7) * 4; d[0] = v[i].x; d[1] = v[i].y; d[2] = v[i].z; d[3] = v[i].w; }
    LDS_WAIT(); asm volatile("" ::: "memory");
    const int c = lane & 7;
#pragma unroll
    for (int j = 0; j < 4; ++j) { const int n = (lane >> 3) + 8 * j; const LAS float* s = scr + (8 * c) * 33 + n;
        v4u o; o.x = pk2(s[0 * 33], s[1 * 33]); o.y = pk2(s[2 * 33], s[3 * 33]); o.z = pk2(s[4 * 33], s[5 * 33]); o.w = pk2(s[6 * 33], s[7 * 33]);
        *(GAS v4u*)(WT + (size_t)(n0 + n) * K + k0 + 8 * c) = o; }
    LDS_WAIT(); asm volatile("" ::: "memory");
}
template <int MAP = 0> __device__ __forceinline__ void transpose_mat(const float* W, int K, int Nsrc, int Npad, bf16* WT, LAS float* scr, int gw, int NGW, int lane, const float* gain = nullptr) {
    const int nblk = Npad / 32, nitems = (K / 64) * nblk;
    f32x4 cur[8], nxt[8];
    if (gw < nitems) tr_load<MAP>(cur, W, Nsrc, gw, nblk, lane, gain);
    for (int it = gw; it < nitems; it += NGW) {
        const bool more = it + NGW < nitems;
        if (more) tr_load<MAP>(nxt, W, Nsrc, it + NGW, nblk, lane, gain);
        tr_store(cur, K, WT, scr, it, nblk, lane);
        if (more) {
#pragma unroll
            for (int i = 0; i < 8; ++i) cur[i] = nxt[i]; }
    }
}

struct MatDesc { const float* W; bf16* WT; const float* gain; int K, Nsrc, nblk, map; };
__device__ __forceinline__ int src_col_rt(int map, int n0) { return map == 1 ? src_col<1>(n0) : map == 2 ? src_col<2>(n0) : map == 3 ? src_col<3>(n0) : n0; }
__device__ __forceinline__ void trl_load(f32x4 (&v)[8], const MatDesc& d, int item, int lane) {
    const int kb = item / d.nblk, nb = item % d.nblk, k0 = 64 * kb, n0 = 32 * nb;
    const int nn = src_col_rt(d.map, n0) + (lane & 7) * 4; const bool ok = (nn >= 0 && nn < d.Nsrc);
#pragma unroll
    for (int i = 0; i < 8; ++i) { const int kk = 8 * i + (lane >> 3); v[i] = ok ? __builtin_nontemporal_load((const f32x4*)(d.W + (size_t)(k0 + kk) * d.Nsrc + nn)) : (f32x4){0.f, 0.f, 0.f, 0.f}; if (d.gain) v[i] = v[i] * d.gain[k0 + kk]; }
}
constexpr int NIT_W = 1536 + 512 + 512 + 384 + 256 + 512 + 2 * 2816 + 2 * 1408;
__device__ __forceinline__ MatDesc mat_of(KArgs A_, unsigned char* ws, int item, int& local) {
    MatDesc d; int r = item;
    if (r < 1536) { d = MatDesc{A_->in[3], (bf16*)(ws + WS_W_IN0), A_->in[1], 1024, 3080, 96, 2}; local = r; return d; } r -= 1536;
    if (r < 512) { d = MatDesc{A_->in[12], (bf16*)(ws + WS_W_OUT0), nullptr, 1024, 1024, 32, 0}; local = r; return d; } r -= 512;
    if (r < 512) { d = MatDesc{A_->in[13], (bf16*)(ws + WS_W_IN1), A_->in[1] + 1024, 1024, 800, 32, 0}; local = r; return d; } r -= 512;
    if (r < 384) { d = MatDesc{A_->in[15], (bf16*)(ws + WS_W_UQ), A_->in[14], 512, 1536, 48, 0}; local = r; return d; } r -= 384;
    if (r < 256) { d = MatDesc{A_->in[17], (bf16*)(ws + WS_W_UKV), A_->in[16], 256, 2048, 64, 3}; local = r; return d; } r -= 256;
    if (r < 512) { d = MatDesc{A_->in[20], (bf16*)(ws + WS_W_OUT1), nullptr, 1024, 1024, 32, 0}; local = r; return d; } r -= 512;
    if (r < 5632) { const int l = r / 2816; d = MatDesc{A_->in[21] + (size_t)l * 1024 * DFF2, (bf16*)(ws + WS_W_UP) + (size_t)l * DFF2 * 1024, A_->in[2] + l * 1024, 1024, DFF2, 176, 1}; local = r - l * 2816; return d; } r -= 5632;
    { const int l = r / 1408; d = MatDesc{A_->in[24] + (size_t)l * DFF * 1024, (bf16*)(ws + WS_W_DN) + (size_t)l * 1024 * DFF, nullptr, DFF, 1024, 32, 0}; local = r - l * 1408; return d; }
}

__device__ __forceinline__ void rms_rows_1024(const float* x, const float* g, bf16* o, int gw, int NGW, int lane) {
    f32x4 v[4], nx[4];
    if (gw < T_) {
#pragma unroll
        for (int j = 0; j < 4; ++j) v[j] = __builtin_nontemporal_load((const f32x4*)(x + (size_t)gw * D_) + lane + 64 * j); }
    for (int m = gw; m < T_; m += NGW) {
        const bool more = m + NGW < T_;
        if (more) {
#pragma unroll
            for (int j = 0; j < 4; ++j) nx[j] = __builtin_nontemporal_load((const f32x4*)(x + (size_t)(m + NGW) * D_) + lane + 64 * j); }
        float s = 0.f;
#pragma unroll
        for (int j = 0; j < 4; ++j) s += (v[j].x * v[j].x + v[j].y * v[j].y) + (v[j].z * v[j].z + v[j].w * v[j].w);
        const float rstd = 1.f / sqrtf(wave_sum(s) * (1.f / D_) + EPS);
        unsigned long long* o8 = (unsigned long long*)(o + (size_t)m * D_) + lane;
#pragma unroll
        for (int j = 0; j < 4; ++j) { const f32x4 gg = ((const f32x4*)g)[lane + 64 * j];
            o8[64 * j] = (unsigned long long)pk2(v[j].x * rstd * gg.x, v[j].y * rstd * gg.y) | ((unsigned long long)pk2(v[j].z * rstd * gg.z, v[j].w * rstd * gg.w) << 32); }
        if (more) {
#pragma unroll
            for (int j = 0; j < 4; ++j) v[j] = nx[j]; }
    }
}

__device__ __forceinline__ void rms_rows_dt(const float* x, float* RS, bf16* o, float* DTR, const LAS f32x4* W2, int gw, int NGW, int lane) {
    f32x4 v[4], nx[4];
    if (gw < T_) {
#pragma unroll
        for (int j = 0; j < 4; ++j) v[j] = __builtin_nontemporal_load((const f32x4*)(x + (size_t)gw * D_) + lane + 64 * j); }
    for (int m = gw; m < T_; m += NGW) {
        const bool more = m + NGW < T_;
        if (more) {
#pragma unroll
            for (int j = 0; j < 4; ++j) nx[j] = __builtin_nontemporal_load((const f32x4*)(x + (size_t)(m + NGW) * D_) + lane + 64 * j); }
        float s = 0.f; f32x4 d0 = {0.f, 0.f, 0.f, 0.f}, d1 = d0;
#pragma unroll
        for (int j = 0; j < 4; ++j) { s += (v[j].x * v[j].x + v[j].y * v[j].y) + (v[j].z * v[j].z + v[j].w * v[j].w);
#pragma unroll
            for (int e = 0; e < 4; ++e) { const int sl = j * 4 + e; const float xk = v[j][e]; d0 += W2[(sl * 2) * 64 + lane] * xk; d1 += W2[(sl * 2 + 1) * 64 + lane] * xk; } }
        const float rstd = 1.f / sqrtf(wave_sum(s) * (1.f / D_) + EPS);
#pragma unroll
        for (int e = 0; e < 4; ++e) { d0[e] = wave_sum(d0[e]); d1[e] = wave_sum(d1[e]); }
        if (lane == 0) { *(f32x4*)(DTR + (size_t)m * 8) = d0 * rstd; *(f32x4*)(DTR + (size_t)m * 8 + 4) = d1 * rstd; RS[m] = rstd; }
        unsigned long long* o8 = (unsigned long long*)(o + (size_t)m * D_) + lane;
#pragma unroll
        for (int j = 0; j < 4; ++j) o8[64 * j] = (unsigned long long)pk2(v[j].x, v[j].y) | ((unsigned long long)pk2(v[j].z, v[j].w) << 32);
        if (more) {
#pragma unroll
            for (int j = 0; j < 4; ++j) v[j] = nx[j]; }
    }
}

struct EpiF32Res {
    static constexpr bool PERM = false, AFTER_DRAIN = false;
    float* C; const float* R; int ldc;
    __device__ __forceinline__ void operator()(const pg8::f32x4 (&acc)[2][2][4][2], const pg8::Unit& u, int wr, int wc, int fr, int fq) const {
        const int row0 = u.pm * pg8::BM + wr * 64 + fr, col0 = u.pn * pg8::BM + wc * 32 + 4 * fq;
#pragma unroll
        for (int ai = 0; ai < 2; ++ai)
#pragma unroll
            for (int m = 0; m < 4; ++m) { const size_t off = (size_t)(row0 + ai * pg8::HALF + m * 16) * ldc + col0;
                f32x4 r[2][2];
#pragma unroll
                for (int bj = 0; bj < 2; ++bj)
#pragma unroll
                    for (int n = 0; n < 2; ++n) r[bj][n] = *(const f32x4*)(R + off + bj * pg8::HALF + n * 16);
#pragma unroll
                for (int bj = 0; bj < 2; ++bj)
#pragma unroll
                    for (int n = 0; n < 2; ++n) *(f32x4*)(C + off + bj * pg8::HALF + n * 16) = acc[ai][bj][m][n] + r[bj][n];
                asm volatile("" ::: "memory"); }
    }
};

__device__ __forceinline__ void row_ssq_reduce(LAS float* red, const float (&ss)[8], unsigned long long* tgt, int wr, int wc, int fr, int fq) {
    if (fq == 0) {
#pragma unroll
        for (int it = 0; it < 8; ++it) red[((it >> 2) * pg8::HALF + wr * 64 + (it & 3) * 16 + fr) * 4 + wc] = ss[it]; }
    asm volatile("s_waitcnt lgkmcnt(0)" ::: "memory"); __builtin_amdgcn_s_barrier(); asm volatile("" ::: "memory");
    const int lane = fq * 16 + fr;
    if (lane < 32) { const int row = (wr * 4 + wc) * 32 + lane; const f32x4 v = *(const LAS f32x4*)(red + row * 4);
        atomicAdd(tgt + row, (unsigned long long)(((v.x + v.y) + (v.z + v.w)) * 1073741824.0f)); }
}
template <bool RB16, bool OUTF, bool OUTB> struct EpiRes {
    static constexpr bool PERM = true, AFTER_DRAIN = false, TOUCH = false;
    float* C; const void* R; bf16* XB; unsigned long long* SSQ; LAS float* red;
    __device__ __forceinline__ void touch(const pg8::Unit& u, LAS unsigned char* junk, int wid, int lane) const {
        constexpr int ESZ = RB16 ? 2 : 4, LPR = 256 * ESZ / 128;
#pragma unroll
        for (int k = 0; k < LPR / 2; ++k) { const int idx = (k * 8 + wid) * 64 + lane, row = idx / LPR, seg = idx % LPR;
            const char* p_ = (const char*)R + ((size_t)(u.pm * pg8::BM + row) * 1024 + u.pn * pg8::BM) * ESZ + seg * 128;
            __builtin_amdgcn_global_load_lds((const unsigned*)p_, (LAS unsigned*)(junk + wid * 256), 4, 0, 2); }
    }
    struct Raw { f32x4 f[2][2]; v4u h[2]; };
    __device__ __forceinline__ void load_raw(Raw& q, size_t off) const {
#pragma unroll
        for (int bj = 0; bj < 2; ++bj) {
            if (RB16) q.h[bj] = *(const v4u*)((const bf16*)R + off + bj * pg8::HALF);
            else { q.f[bj][0] = *(const f32x4*)((const float*)R + off + bj * pg8::HALF); q.f[bj][1] = *(const f32x4*)((const float*)R + off + bj * pg8::HALF + 4); } }
    }
    __device__ __forceinline__ void operator()(const pg8::f32x4 (&acc)[2][2][4][2], const pg8::Unit& u, int wr, int wc, int fr, int fq) const {
        const int row0 = u.pm * pg8::BM + wr * 64 + fr, col0 = u.pn * pg8::BM + wc * 32 + 8 * fq;
        constexpr int WIN = 8;
        Raw q[8]; float ss[8];
#pragma unroll
        for (int it = 0; it < WIN; ++it) load_raw(q[it], (size_t)(row0 + (it >> 2) * pg8::HALF + (it & 3) * 16) * 1024 + col0);
        __builtin_amdgcn_sched_barrier(0);
#pragma unroll
        for (int it = 0; it < 8; ++it) { const int ai = it >> 2, mm = it & 3; const int row = row0 + ai * pg8::HALF + mm * 16; const size_t off = (size_t)row * 1024 + col0;
            if (it + WIN < 8) { load_raw(q[it + WIN], (size_t)(row0 + ((it + WIN) >> 2) * pg8::HALF + ((it + WIN) & 3) * 16) * 1024 + col0); __builtin_amdgcn_sched_barrier(0); }
            float s = 0.f;
#pragma unroll
            for (int bj = 0; bj < 2; ++bj) {
                f32x4 r0, r1;
                if (RB16) { const v4u w = q[it].h[bj]; r0 = (f32x4){bflo(w.x), bfhi(w.x), bflo(w.y), bfhi(w.y)}; r1 = (f32x4){bflo(w.z), bfhi(w.z), bflo(w.w), bfhi(w.w)}; } else { r0 = q[it].f[bj][0]; r1 = q[it].f[bj][1]; }
                const f32x4 v0 = acc[ai][bj][mm][0] + r0, v1 = acc[ai][bj][mm][1] + r1;
                if (OUTF) { *(f32x4*)(C + off + bj * pg8::HALF) = v0; *(f32x4*)(C + off + bj * pg8::HALF + 4) = v1; }
                if (OUTB) { s += ((v0.x * v0.x + v0.y * v0.y) + (v0.z * v0.z + v0.w * v0.w)) + ((v1.x * v1.x + v1.y * v1.y) + (v1.z * v1.z + v1.w * v1.w));
                    v4u w; w.x = pk2(v0.x, v0.y); w.y = pk2(v0.z, v0.w); w.z = pk2(v1.x, v1.y); w.w = pk2(v1.z, v1.w); *(v4u*)(XB + off + bj * pg8::HALF) = w; } }
            if (OUTB) { s += __shfl_xor(s, 16); s += __shfl_xor(s, 32); ss[it] = s; }
            asm volatile("" ::: "memory"); }
        if (OUTB) row_ssq_reduce(red, ss, SSQ + u.pm * pg8::BM, wr, wc, fr, fq);
    }
};
typedef unsigned v2u __attribute__((ext_vector_type(2))); typedef float f32x2 __attribute__((ext_vector_type(2)));
__device__ __forceinline__ float rstd_of(const unsigned long long* SSQ, int row, float inv_n) { const v2u s = ((const v2u*)SSQ)[row]; const float c = inv_n * (1.0f / 1073741824.0f);
    return __builtin_amdgcn_rsqf(__builtin_fmaf((float)s.y, 4294967296.0f * c, __builtin_fmaf((float)s.x, c, EPS))); }
__device__ __forceinline__ f32x2 pk_add_one(f32x2 a) { asm("" : "+v"(a)); return a + 1.0f; }
template <int N> __device__ __forceinline__ float dpp_shr0(float v) { return __builtin_bit_cast(float, __builtin_amdgcn_update_dpp(0, __builtin_bit_cast(int, v), 0x110 + N, 0xf, 0xf, true)); }
template <int N> __device__ __forceinline__ float dpp_shr_old(float old, float v) { return __builtin_bit_cast(float, __builtin_amdgcn_update_dpp(__builtin_bit_cast(int, old), __builtin_bit_cast(int, v), 0x110 + N, 0xf, 0xf, false)); }
template <int N> __device__ __forceinline__ float dpp_ror(float v) { return __builtin_bit_cast(float, __builtin_amdgcn_update_dpp(0, __builtin_bit_cast(int, v), 0x120 + N, 0xf, 0xf, false)); }
struct EpiFfnUp {
    static constexpr bool PERM = true, AFTER_DRAIN = false;
    bf16* ACT; bf16* UB; const unsigned long long* SSQ; const float* cw; const float* cb;
    __device__ __forceinline__ void operator()(const pg8::f32x4 (&acc)[2][2][4][2], const pg8::Unit& u, int wr, int wc, int fr, int fq) const {
        const int ch0 = u.pn * 128 + wc * 32 + 8 * fq;
        const int rowc = u.pm * pg8::BM + wr * 128;
        float rs[2][4];
#pragma unroll
        for (int ai = 0; ai < 2; ++ai)
#pragma unroll
            for (int m = 0; m < 4; ++m) rs[ai][m] = rstd_of(SSQ, rowc + 8 * fr + 4 * ai + m, 1.0f / 1024.0f);
        unsigned long long keep[2][4];
#pragma unroll
        for (int n = 0; n < 2; ++n) {
            __builtin_amdgcn_sched_barrier(0);
            const int ch = ch0 + 4 * n;
            const f32x4 wg0 = *(const f32x4*)(cw + ch), wg1 = *(const f32x4*)(cw + DFF2 + ch), wg2 = *(const f32x4*)(cw + 2 * DFF2 + ch), bg = *(const f32x4*)(cw + 3 * DFF2 + ch);
            const f32x4 wu0 = *(const f32x4*)(cw + DFF + ch), wu1 = *(const f32x4*)(cw + DFF2 + DFF + ch), wu2 = *(const f32x4*)(cw + 2 * DFF2 + DFF + ch), bu = *(const f32x4*)(cw + 3 * DFF2 + DFF + ch);
            const f32x4 g6 = acc[1][0][2][n] * rs[1][2], g7 = acc[1][0][3][n] * rs[1][3], u6 = acc[1][1][2][n] * rs[1][2], u7 = acc[1][1][3][n] * rs[1][3];
            f32x4 gp2, gp1, up2, up1;
#pragma unroll
            for (int j = 0; j < 4; ++j) { gp2[j] = dpp_shr0<1>(g6[j]); gp1[j] = dpp_shr0<1>(g7[j]); up2[j] = dpp_shr0<1>(u6[j]); up1[j] = dpp_shr0<1>(u7[j]); }
#pragma unroll
            for (int ai = 0; ai < 2; ++ai) {
                f32x4 g[4], uu[4];
#pragma unroll
                for (int m = 0; m < 4; ++m) { if (ai == 1 && m >= 2) { g[m] = (m == 2) ? g6 : g7; uu[m] = (m == 2) ? u6 : u7; } else { g[m] = acc[ai][0][m][n] * rs[ai][m]; uu[m] = acc[ai][1][m][n] * rs[ai][m]; } }
#pragma unroll
                for (int m = 0; m < 4; ++m) {
                    const f32x4 sg1 = (m == 0) ? gp1 : g[m - 1], sg2 = (m == 0) ? gp2 : (m == 1) ? gp1 : g[m - 2];
                    const f32x4 su1 = (m == 0) ? up1 : uu[m - 1], su2 = (m == 0) ? up2 : (m == 1) ? up1 : uu[m - 2];
                    const f32x4 cg = bg + wg0 * sg2 + wg1 * sg1 + wg2 * g[m], cu = bu + wu0 * su2 + wu1 * su1 + wu2 * uu[m];
                    f32x4 r_;
                    { const f32x2 d0 = pk_add_one((f32x2){__builtin_amdgcn_exp2f(cg[0]), __builtin_amdgcn_exp2f(cg[1])}), d1 = pk_add_one((f32x2){__builtin_amdgcn_exp2f(cg[2]), __builtin_amdgcn_exp2f(cg[3])});
                      r_[0] = __builtin_amdgcn_rcpf(d0.x); r_[1] = __builtin_amdgcn_rcpf(d0.y); r_[2] = __builtin_amdgcn_rcpf(d1.x); r_[3] = __builtin_amdgcn_rcpf(d1.y); }
                    const f32x4 a = cg * r_ * cu;
                    const int row = rowc + 8 * fr + 4 * ai + m;
                    const unsigned long long pk_ = (unsigned long long)pk2(a[0], a[1]) | ((unsigned long long)pk2(a[2], a[3]) << 32);
                    if (n == 0) { keep[ai][m] = pk_; asm volatile("" : "+v"(keep[ai][m])); }
                    else if (!(ai == 0 && fr == 0 && m < 2)) { v4u w; w.x = (unsigned)keep[ai][m]; w.y = (unsigned)(keep[ai][m] >> 32); w.z = (unsigned)pk_; w.w = (unsigned)(pk_ >> 32); *(v4u*)(ACT + (size_t)row * DFF + ch0) = w; }
                    if ((ai == 0 && m < 2) || (ai == 1 && m >= 2)) {
                        if ((ai == 0) ? (fr == 0) : (fr == 15)) { bf16* ub = UB + ((size_t)(rowc >> 7) * 4 + m) * DFF2 + ch;
                            *(unsigned long long*)ub = (unsigned long long)pk2(g[m][0], g[m][1]) | ((unsigned long long)pk2(g[m][2], g[m][3]) << 32);
                            *(unsigned long long*)(ub + DFF) = (unsigned long long)pk2(uu[m][0], uu[m][1]) | ((unsigned long long)pk2(uu[m][2], uu[m][3]) << 32); } }
                    if (m == 1) { gp2 = g[2]; gp1 = g[3]; up2 = uu[2]; up1 = uu[3]; }
                }
            }
        }
    }
};


struct EpiScale {
    static constexpr bool PERM = true, AFTER_DRAIN = false;
    bf16* O; int ldc; const unsigned long long* SSQ; float inv_n;
    __device__ __forceinline__ void operator()(const pg8::f32x4 (&acc)[2][2][4][2], const pg8::Unit& u, int wr, int wc, int fr, int fq) const {
        const int row0 = u.pm * pg8::BM + wr * 64 + fr, col0 = u.pn * pg8::BM + wc * 32 + 8 * fq;
        float rsv[8];
#pragma unroll
        for (int i = 0; i < 8; ++i) rsv[i] = rstd_of(SSQ, row0 + (i >> 2) * pg8::HALF + (i & 3) * 16, inv_n);
        __builtin_amdgcn_sched_barrier(0);
#pragma unroll
        for (int ai = 0; ai < 2; ++ai)
#pragma unroll
            for (int m = 0; m < 4; ++m) { const int row = row0 + ai * pg8::HALF + m * 16; const float rs = rsv[ai * 4 + m]; bf16* rowp = O + (size_t)row * ldc + col0;
#pragma unroll
                for (int bj = 0; bj < 2; ++bj) { const f32x4 v0 = acc[ai][bj][m][0] * rs, v1 = acc[ai][bj][m][1] * rs;
                    v4u w; w.x = pk2(v0[0], v0[1]); w.y = pk2(v0[2], v0[3]); w.z = pk2(v1[0], v1[1]); w.w = pk2(v1[2], v1[3]); *(v4u*)(rowp + bj * pg8::HALF) = w; } }
    }
};
struct EpiMlaIn {
    static constexpr bool PERM = true, AFTER_DRAIN = false;
    bf16* O; const unsigned long long* SSQ; unsigned long long* SSQ_Q; unsigned long long* SSQ_KV; float* SSQPE; float* RG; const float* kg; const float* TAB; LAS float* red;
    __device__ __forceinline__ void operator()(const pg8::f32x4 (&acc)[2][2][4][2], const pg8::Unit& u, int wr, int wc, int fr, int fq) const {
        const int row0 = u.pm * pg8::BM + wr * 64 + fr, col0 = u.pn * pg8::BM + wc * 32 + 8 * fq;
        unsigned long long* tgt = (u.pn < 2) ? SSQ_Q : SSQ_KV;
        float rsv[8];
#pragma unroll
        for (int i = 0; i < 8; ++i) rsv[i] = rstd_of(SSQ, row0 + (i >> 2) * pg8::HALF + (i & 3) * 16, 1.0f / 1024.0f);
        if (u.pn < 3) {
        float ss[8];
#pragma unroll
        for (int ai = 0; ai < 2; ++ai)
#pragma unroll
            for (int m = 0; m < 4; ++m) { const int row = row0 + ai * pg8::HALF + m * 16; const float rs = rsv[ai * 4 + m]; bf16* rowp = O + (size_t)row * 1024 + col0; float s = 0.f;
#pragma unroll
                for (int bj = 0; bj < 2; ++bj) { const f32x4 v0 = acc[ai][bj][m][0] * rs, v1 = acc[ai][bj][m][1] * rs;
                    s += (v0[0] * v0[0] + v0[1] * v0[1]) + (v0[2] * v0[2] + v0[3] * v0[3]) + (v1[0] * v1[0] + v1[1] * v1[1]) + (v1[2] * v1[2] + v1[3] * v1[3]);
                    v4u w; w.x = pk2(v0[0], v0[1]); w.y = pk2(v0[2], v0[3]); w.z = pk2(v1[0], v1[1]); w.w = pk2(v1[2], v1[3]); *(v4u*)(rowp + bj * pg8::HALF) = w; }
                s += __shfl_xor(s, 16); s += __shfl_xor(s, 32); ss[ai * 4 + m] = s; asm volatile("" ::: "memory"); }
        row_ssq_reduce(red, ss, tgt + u.pm * pg8::BM, wr, wc, fr, fq);
        } else if (wc == 0) {
            const f32x4 g0 = *(const f32x4*)(kg + 64 + 8 * fq), g1 = *(const f32x4*)(kg + 64 + 8 * fq + 4);
            f32x4 tn[4]; { const float* tb = TAB + ((row0 & 2047) * 16 + 8 * (fq & 1)) * 2; tn[0] = *(const f32x4*)tb; tn[1] = *(const f32x4*)(tb + 4); tn[2] = *(const f32x4*)(tb + 8); tn[3] = *(const f32x4*)(tb + 12); }
#pragma unroll
            for (int ai = 0; ai < 2; ++ai)
#pragma unroll
                for (int m = 0; m < 4; ++m) { const int row = row0 + ai * pg8::HALF + m * 16; const float rs = rsv[ai * 4 + m];
                    const f32x4 ta = tn[0], tb4 = tn[1], tc = tn[2], td = tn[3];
                    if (ai * 4 + m < 7) { const int i1 = ai * 4 + m + 1; const float* tb = TAB + (((row0 + (i1 >> 2) * pg8::HALF + (i1 & 3) * 16) & 2047) * 16 + 8 * (fq & 1)) * 2; tn[0] = *(const f32x4*)tb; tn[1] = *(const f32x4*)(tb + 4); tn[2] = *(const f32x4*)(tb + 8); tn[3] = *(const f32x4*)(tb + 12); }
                    const f32x4 v0 = acc[ai][0][m][0] * rs, v1 = acc[ai][0][m][1] * rs;
                    float s = (v0[0] * v0[0] + v0[1] * v0[1]) + (v0[2] * v0[2] + v0[3] * v0[3]) + (v1[0] * v1[0] + v1[1] * v1[1]) + (v1[2] * v1[2] + v1[3] * v1[3]);
                    s += __shfl_xor(s, 16); s += __shfl_xor(s, 32); if (fq == 0) SSQPE[row] = s;
                    const f32x4 y0 = v0 * g0, y1 = v1 * g1;
                    f32x4 p0, p1;
#pragma unroll
                    for (int j = 0; j < 4; ++j) { p0[j] = __shfl_xor(y0[j], 32); p1[j] = __shfl_xor(y1[j], 32); }
                    const f32x4 c0 = {ta[0], ta[2], tb4[0], tb4[2]}, s0 = {ta[1], ta[3], tb4[1], tb4[3]}, c1 = {tc[0], tc[2], td[0], td[2]}, s1 = {tc[1], tc[3], td[1], td[3]};
                    f32x4 o0, o1;
                    if (fq < 2) { o0 = y0 * c0 - p0 * s0; o1 = y1 * c1 - p1 * s1; } else { o0 = p0 * s0 + y0 * c0; o1 = p1 * s1 + y1 * c1; }
                    float* rg = RG + (size_t)row * 32 + 8 * fq; *(f32x4*)rg = o0; *(f32x4*)(rg + 4) = o1; asm volatile("" ::: "memory"); }
        }
    }
};
struct EpiUkv {
    static constexpr bool PERM = true, AFTER_DRAIN = false;
    bf16* K2; bf16* V2; const unsigned long long* SSQ; const float* SSQPE; const float* RG; const float* kg;
    __device__ __forceinline__ void operator()(const pg8::f32x4 (&acc)[2][2][4][2], const pg8::Unit& u, int wr, int wc, int fr, int fq) const {
        const int row0 = u.pm * pg8::BM + wr * 64 + fr;
        if (u.pn < 4) {
            const int head = 4 * u.pn + wc;
            f32x4 g1[2], g2[2];
#pragma unroll
            for (int n = 0; n < 2; ++n) { g1[n] = *(const f32x4*)(kg + 8 * fq + 4 * n); g2[n] = *(const f32x4*)(kg + 32 + 8 * fq + 4 * n); }
            float rsv[8], pev[8];
#pragma unroll
            for (int i = 0; i < 8; ++i) { const int row = row0 + (i >> 2) * pg8::HALF + (i & 3) * 16; rsv[i] = rstd_of(SSQ, row, 1.0f / 256.0f); pev[i] = SSQPE[row]; }
            f32x4 rga[8][2];
#pragma unroll
            for (int i = 0; i < 3; ++i) { const float* rg = RG + (size_t)(row0 + (i >> 2) * pg8::HALF + (i & 3) * 16) * 32 + 8 * fq; rga[i][0] = *(const f32x4*)rg; rga[i][1] = *(const f32x4*)(rg + 4); }
            __builtin_amdgcn_sched_barrier(0);
#pragma unroll
            for (int i = 0; i < 8; ++i) { const int row = row0 + (i >> 2) * pg8::HALF + (i & 3) * 16; const float rs = rsv[i];
                    if (i + 3 < 8) { const float* rg = RG + (size_t)(row0 + ((i + 3) >> 2) * pg8::HALF + ((i + 3) & 3) * 16) * 32 + 8 * fq; rga[i + 3][0] = *(const f32x4*)rg; rga[i + 3][1] = *(const f32x4*)(rg + 4); __builtin_amdgcn_sched_barrier(0); }
                    const f32x4 rgc0 = rga[i][0], rgc1 = rga[i][1];
                    const int ai = i >> 2, m = i & 3;
                    f32x4 a[2], b[2]; float s = 0.f;
#pragma unroll
                    for (int n = 0; n < 2; ++n) { a[n] = acc[ai][0][m][n] * rs; b[n] = acc[ai][1][m][n] * rs; s += (a[n][0] * a[n][0] + a[n][1] * a[n][1]) + (a[n][2] * a[n][2] + a[n][3] * a[n][3]) + (b[n][0] * b[n][0] + b[n][1] * b[n][1]) + (b[n][2] * b[n][2] + b[n][3] * b[n][3]); }
                    s += __shfl_xor(s, 16); s += __shfl_xor(s, 32);
                    const float rh = __builtin_amdgcn_rsqf((s + pev[i]) * (1.f / 96.f) + EPS);
                    const int pos = row & 2047; bf16* rp = K2 + ((((size_t)(row >> 11) * 16 + head) * 32 + (pos >> 6)) * 12 + fq) * 512 + (pos & 63) * 8;
                    { const f32x4 o0 = a[0] * rh * g1[0], o1 = a[1] * rh * g1[1]; v4u w; w.x = pk2(o0[0], o0[1]); w.y = pk2(o0[2], o0[3]); w.z = pk2(o1[0], o1[1]); w.w = pk2(o1[2], o1[3]); *(v4u*)rp = w; }
                    { const f32x4 o0 = b[0] * rh * g2[0], o1 = b[1] * rh * g2[1]; v4u w; w.x = pk2(o0[0], o0[1]); w.y = pk2(o0[2], o0[3]); w.z = pk2(o1[0], o1[1]); w.w = pk2(o1[2], o1[3]); *(v4u*)(rp + 4 * 512) = w; }
                    { const f32x4 o0 = rgc0 * rh, o1 = rgc1 * rh; v4u w; w.x = pk2(o0[0], o0[1]); w.y = pk2(o0[2], o0[3]); w.z = pk2(o1[0], o1[1]); w.w = pk2(o1[2], o1[3]); *(v4u*)(rp + 8 * 512) = w; }
                    asm volatile("" ::: "memory"); }
        } else {
            bf16* dst = V2 + (u.pn - 4) * 256 + wc * 32 + 8 * fq;
#pragma unroll
            for (int ai = 0; ai < 2; ++ai)
#pragma unroll
                for (int m = 0; m < 4; ++m) { const int row = row0 + ai * pg8::HALF + m * 16; const float rs = rstd_of(SSQ, row, 1.0f / 256.0f); bf16* rp = dst + (size_t)row * 1024;
#pragma unroll
                    for (int bj = 0; bj < 2; ++bj) { const f32x4 v0 = acc[ai][bj][m][0] * rs, v1 = acc[ai][bj][m][1] * rs;
                        v4u w; w.x = pk2(v0[0], v0[1]); w.y = pk2(v0[2], v0[3]); w.z = pk2(v1[0], v1[1]); w.w = pk2(v1[2], v1[3]); *(v4u*)(rp + bj * pg8::HALF) = w; } }
        }
    }
};

struct EpiIn0 {
    static constexpr bool PERM = true, AFTER_DRAIN = false;
    bf16* QK; bf16* KC; const float* TAB; const float* qn; const float* kn; float* KM; float* DTR; const float* RS;
    __device__ __forceinline__ void operator()(const pg8::f32x4 (&acc)[2][2][4][2], const pg8::Unit& u, int wr, int wc, int fr, int fq) const {
        const int row0 = u.pm * pg8::BM + wr * 64 + fr;
        if (u.pn < 4) {
            const bool isq = u.pn < 2; const float* gn = isq ? qn : kn; const int head = 4 * (u.pn & 1) + wc;
            bf16* dst = QK + (isq ? 0 : 512) + head * 64 + 8 * fq;
            f32x4 g1[2], g2[2], ks1[2], ks2[2];
#pragma unroll
            for (int n = 0; n < 2; ++n) { g1[n] = *(const f32x4*)(gn + 8 * fq + 4 * n); g2[n] = *(const f32x4*)(gn + 32 + 8 * fq + 4 * n); ks1[n] = (f32x4){0.f, 0.f, 0.f, 0.f}; ks2[n] = ks1[n]; }
#pragma unroll
            for (int ai = 0; ai < 2; ++ai)
#pragma unroll
                for (int m = 0; m < 4; ++m) { const int row = row0 + ai * pg8::HALF + m * 16, pos = row & 2047;
                    float s = 0.f;
#pragma unroll
                    for (int n = 0; n < 2; ++n) { const f32x4 a = acc[ai][0][m][n], b = acc[ai][1][m][n]; s += (a[0] * a[0] + a[1] * a[1]) + (a[2] * a[2] + a[3] * a[3]) + (b[0] * b[0] + b[1] * b[1]) + (b[2] * b[2] + b[3] * b[3]); }
                    s += __shfl_xor(s, 16); s += __shfl_xor(s, 32);
                    const float rs_ = RS[row];
                    float rstd = rs_ / sqrtf(s * rs_ * rs_ * (1.f / 64.f) + EPS); if (isq) rstd *= 0.18033688011112042f;
                    f32x4 o1[2], o2[2];
#pragma unroll
                    for (int n = 0; n < 2; ++n) { const float* tb = TAB + (pos * 32 + 8 * fq + 4 * n) * 2; const f32x4 t0 = *(const f32x4*)tb, t1 = *(const f32x4*)(tb + 4);
                        const f32x4 cs_ = {t0[0], t0[2], t1[0], t1[2]}, sn = {t0[1], t0[3], t1[1], t1[3]};
                        const f32x4 y1 = acc[ai][0][m][n] * rstd * g1[n], y2 = acc[ai][1][m][n] * rstd * g2[n];
                        o1[n] = y1 * cs_ - y2 * sn; o2[n] = y1 * sn + y2 * cs_; ks1[n] += o1[n]; ks2[n] += o2[n]; }
                    bf16* rp = dst + (size_t)row * 1024; int st2 = 32;
                    if (!isq) { rp = KC + ((((size_t)(row >> 11) * 8 + head) * 32 + (pos >> 6)) * 8 + fq) * 512 + (pos & 63) * 8; st2 = 4 * 512; }
                    { v4u w; w.x = pk2(o1[0][0], o1[0][1]); w.y = pk2(o1[0][2], o1[0][3]); w.z = pk2(o1[1][0], o1[1][1]); w.w = pk2(o1[1][2], o1[1][3]); *(v4u*)rp = w; }
                    { v4u w; w.x = pk2(o2[0][0], o2[0][1]); w.y = pk2(o2[0][2], o2[0][3]); w.z = pk2(o2[1][0], o2[1][1]); w.w = pk2(o2[1][2], o2[1][3]); *(v4u*)(rp + st2) = w; }
                    asm volatile("" ::: "memory"); }
            if (!isq) {
                float* km = KM + (((size_t)(u.pm >> 3) * 8 + (u.pm & 7)) * 8 + head) * 64 + 8 * fq;
                float mine = 0.f;
#pragma unroll
                for (int n = 0; n < 2; ++n)
#pragma unroll
                    for (int j = 0; j < 4; ++j) { float a = ks1[n][j], b = ks2[n][j];
#pragma unroll
                        for (int o = 1; o < 16; o <<= 1) { a += __shfl_xor(a, o); b += __shfl_xor(b, o); }
                        mine = (fr == 4 * n + j) ? a : mine; mine = (fr == 8 + 4 * n + j) ? b : mine; }
                atomicAdd(km + ((fr < 8) ? fr : 24 + fr), mine * (1.f / 256.f)); }
        } else if (u.pn < 12) {
            bf16* dst = QK + (size_t)(u.pn >> 2) * ((size_t)T_ * 1024) + (u.pn & 3) * 256 + wc * 32 + 8 * fq;
#pragma unroll
            for (int ai = 0; ai < 2; ++ai)
#pragma unroll
                for (int m = 0; m < 4; ++m) { const int row = row0 + ai * pg8::HALF + m * 16; const float rs_ = RS[row]; bf16* rp = dst + (size_t)row * 1024;
#pragma unroll
                    for (int bj = 0; bj < 2; ++bj) { const f32x4 v0 = acc[ai][bj][m][0] * rs_, v1 = acc[ai][bj][m][1] * rs_;
                        v4u w; w.x = pk2(v0[0], v0[1]); w.y = pk2(v0[2], v0[3]); w.z = pk2(v1[0], v1[1]); w.w = pk2(v1[2], v1[3]); *(v4u*)(rp + bj * pg8::HALF) = w; } }
        } else if (wc == 0 && fq == 0) {
#pragma unroll
            for (int ai = 0; ai < 2; ++ai)
#pragma unroll
                for (int m = 0; m < 4; ++m) { float* rp = DTR + (size_t)(row0 + ai * pg8::HALF + m * 16) * 8; *(f32x4*)rp = acc[ai][0][m][0]; *(f32x4*)(rp + 4) = acc[ai][0][m][1]; }
        }
    }
};

__device__ __forceinline__ void ffn_fix_rows(int i0, int i1, int step, const bf16* UB, bf16* ACT, const float* cw, const float* cb) {
#pragma unroll 1
    for (int il = i0; il < i1; il += step) {
        const int c0 = (il % (DFF / 8)) * 8, rr = (il / (DFF / 8)) & 1, ck = il / (2 * (DFF / 8)); const bool first = (ck & 15) == 0;
        v4u wg[3], wu[3]; f32x4 kg[3][2], ku[3][2]; float vm[3];
#pragma unroll
        for (int k = 0; k < 3; ++k) { const int rel = rr - 2 + k; const bool ok = (rel >= 0) || !first;
            const size_t srow = (rel >= 0) ? (size_t)ck * 4 + rel : (ok ? (size_t)(ck - 1) * 4 + 4 + rel : (size_t)ck * 4);
            const bf16* src = UB + srow * DFF2; wg[k] = *(const v4u*)(src + c0); wu[k] = *(const v4u*)(src + DFF + c0); vm[k] = ok ? 1.f : 0.f;
            const float* kp = cw + k * DFF2 + c0; kg[k][0] = *(const f32x4*)kp; kg[k][1] = *(const f32x4*)(kp + 4); ku[k][0] = *(const f32x4*)(kp + DFF); ku[k][1] = *(const f32x4*)(kp + DFF + 4); }
        f32x4 ag0 = *(const f32x4*)(cb + c0), ag1 = *(const f32x4*)(cb + c0 + 4), au0 = *(const f32x4*)(cb + DFF + c0), au1 = *(const f32x4*)(cb + DFF + c0 + 4);
#pragma unroll
        for (int k = 0; k < 3; ++k) {
            const f32x4 g0 = (f32x4){bflo(wg[k].x), bfhi(wg[k].x), bflo(wg[k].y), bfhi(wg[k].y)} * vm[k], g1 = (f32x4){bflo(wg[k].z), bfhi(wg[k].z), bflo(wg[k].w), bfhi(wg[k].w)} * vm[k];
            const f32x4 u0 = (f32x4){bflo(wu[k].x), bfhi(wu[k].x), bflo(wu[k].y), bfhi(wu[k].y)} * vm[k], u1 = (f32x4){bflo(wu[k].z), bfhi(wu[k].z), bflo(wu[k].w), bfhi(wu[k].w)} * vm[k];
            ag0 += kg[k][0] * g0; ag1 += kg[k][1] * g1; au0 += ku[k][0] * u0; au1 += ku[k][1] * u1; }
        f32x4 o0, o1;
#pragma unroll
        for (int j = 0; j < 4; ++j) { o0[j] = ag0[j] * __builtin_amdgcn_rcpf(1.f + __expf(-ag0[j])) * au0[j]; o1[j] = ag1[j] * __builtin_amdgcn_rcpf(1.f + __expf(-ag1[j])) * au1[j]; }
        v4u o; o.x = pk2(o0[0], o0[1]); o.y = pk2(o0[2], o0[3]); o.z = pk2(o1[0], o1[1]); o.w = pk2(o1[2], o1[3]);
        *(v4u*)(ACT + ((size_t)ck * 128 + rr) * DFF + c0) = o; }
}

template <class Epi, int AROW = 0> __device__ __forceinline__ void run_gemm(LAS unsigned char* lds, const bf16* A, const bf16* Bt, int M, int N, int K, const Epi& E, int lda = 0) {
    pg8::Gemm g{A, Bt, M, N, K, lda ? lda : K}; pg8::StaticOrder S; S.init(M, N, (int)gridDim.x, (int)blockIdx.x);
    pg8::gemm_phase<Epi, pg8::StaticOrder, PG8_ALIGN, PG8_SP2, AROW>(lds + RING_OFF, g, S, E);
}

#define NPHASES 40
__global__ void __launch_bounds__(NTHR, 2) fwd(Args args) {
    extern __shared__ __attribute__((aligned(16))) unsigned char lds_raw[];
    LAS unsigned char* lds = (LAS unsigned char*)lds_raw;
    volatile LAS unsigned* MISC = (volatile LAS unsigned*)(lds + MISC_OFF);
    {
        const int tid0 = threadIdx.x;
        for (int u = tid0; u < (LDS_BYTES - LDSCTL_OFF) / 4; u += NTHR) ((LAS unsigned*)(lds + LDSCTL_OFF))[u] = 0u;
    }
    __syncthreads();
    int lo, hi; { KArgs A0 = kargs(); lo = A0->ph_lo; hi = A0->ph_hi; }
    const bool multi = (hi - lo) > 1;
    XcdBarrier bar; bar.bar = nullptr; bar.x = 0; bar.st = nullptr;
    if (multi) { KArgs A0 = kargs(); bar = xcd_barrier_post((unsigned*)((gu32*)(A0->ws + WS_CTL) + CW_BAR), MISC + 8); }
#define IN(k) (lo <= (k) && (k) < hi)
#ifndef PROBE_MASK
#define PROBE_MASK 0u
#endif
    unsigned long long pr_acc = 0ull, pr_t = 0ull;
    if (PROBE_MASK) pr_t = __builtin_amdgcn_s_memrealtime();
#define SEAM(k) do { if (IN(k) && IN((k) + 1)) xcd_barrier(bar); \
        if (PROBE_MASK) { const unsigned long long now_ = __builtin_amdgcn_s_memrealtime(); if ((PROBE_MASK >> (k)) & 1u) pr_acc += now_ - pr_t; pr_t = now_; } } while (0)

    if (IN(0)) { PH_VARS
        LAS float* scr = (LAS float*)(lds + RING_OFF + wave * 16384);
        { f32x4 cur[8], nxt[8]; int it = gw, li = 0, ln = 0; MatDesc d{}, dn{};
          if (it < NIT_W) { d = mat_of(A_, ws, it, li); trl_load(cur, d, li, lane); }
          while (it < NIT_W) { const int nit = it + NGW; const bool more = nit < NIT_W;
              if (more) { dn = mat_of(A_, ws, nit, ln); trl_load(nxt, dn, ln, lane); }
              tr_store(cur, d.K, d.WT, scr, li, d.nblk, lane);
              if (more) {
#pragma unroll
                  for (int i = 0; i < 8; ++i) cur[i] = nxt[i];
                  d = dn; li = ln; }
              it = nit; } }
        { float* cws = (float*)(ws + WS_CWS); const float* cw_ = A_->in[22]; const float* cb_ = A_->in[23];
          for (int i = gt; i < 2 * 4 * DFF2; i += NGT) { const int l = i / (4 * DFF2), r = i - l * 4 * DFF2, k = r / DFF2, c = r - k * DFF2;
              const float v = (k < 3) ? cw_[((size_t)l * 3 + k) * DFF2 + c] : cb_[(size_t)l * DFF2 + c]; cws[i] = v * (c < DFF ? -1.44269504088896341f : -0.693147180559945309f); } }
        float* t64 = (float*)(ws + WS_TAB64); float* t32 = (float*)(ws + WS_TAB32);
        for (int i = gt; i < 2048 * 32; i += NGT) { const int pos = i >> 5, f = i & 31; const float inv = 1.0f / powf(10000.0f, (float)(2 * f) / 64.0f); const float ang = (float)pos * inv; t64[2 * i] = cosf(ang); t64[2 * i + 1] = sinf(ang); }
        for (int i = gt; i < 2048 * 16; i += NGT) { const int pos = i >> 4, f = i & 15; const float inv = 1.0f / powf(10000.0f, (float)(2 * f) / 32.0f); const float ang = (float)pos * inv; t32[2 * i] = cosf(ang); t32[2 * i + 1] = sinf(ang); }
        asm volatile("s_waitcnt vmcnt(0) lgkmcnt(0)" ::: "memory"); __syncthreads();
        { LAS f32x4* W2 = (LAS f32x4*)(lds + RING_OFF); const float* Wi = A_->in[3]; const float* gg = A_->in[1];
          for (int i = tid; i < 2048; i += NTHR) { const int ln = i & 63, sh = i >> 6, sl = sh >> 1, half = sh & 1, k = 4 * ln + 256 * (sl >> 2) + (sl & 3);
              W2[i] = *(const f32x4*)(Wi + (size_t)k * 3080 + 3072 + 4 * half) * gg[k]; }
          asm volatile("s_waitcnt vmcnt(0) lgkmcnt(0)" ::: "memory"); __syncthreads();
          rms_rows_dt(x, (float*)(ws + WS_RS0), XN, (float*)(ws + WS_DTR), W2, gw, NGW, lane); }
    }
    SEAM(0);
    if (IN(1)) { PH_VARS EpiIn0 E{(bf16*)(ws + L0_QK), (bf16*)(ws + L0_KC), TAB64, A_->in[10], A_->in[11], (float*)(ws + WS_KMEAN), (float*)(ws + WS_DTR), (const float*)(ws + WS_RS0)}; run_gemm(lds, XN, (const bf16*)(ws + WS_W_IN0), T_, 3072, 1024, E); }
    SEAM(1);
    if (IN(2)) { PH_VARS
        for (int u = blockIdx.x; u < 512; u += G) ssd::states_unit(lds, u >> 1, u & 1, (const bf16*)(ws + L0_XBC), (const float*)(ws + WS_DTR), A_->in[4], A_->in[5], A_->in[6], A_->in[7], (bf16*)(ws + L0_ST), (float*)(ws + WS_CEND));
    }
    SEAM(2);
    if (IN(3)) { PH_VARS
        const bf16* ST = (const bf16*)(ws + L0_ST); const float* CEND = (const float*)(ws + WS_CEND); bf16* HIN = (bf16*)(ws + L0_HIN);
        auto do_scan = [&]() {
        for (int i = gt; i < 16 * 8 * 64 * 128 / 4; i += NGT) {
            const int pn = (i & 2047) * 4, h = (i >> 11) & 7, b = i >> 14; f32x4 hst = {0.f, 0.f, 0.f, 0.f}; f32x4 tmp[16]; float dec[16];
#pragma unroll
            for (int c = 0; c < 16; ++c) { const unsigned long long w_ = *(const unsigned long long*)(ST + (((size_t)((b * 16 + c) * 8 + h) << 13) + pn)); tmp[c] = (f32x4){bflo((unsigned)w_), bfhi((unsigned)w_), bflo((unsigned)(w_ >> 32)), bfhi((unsigned)(w_ >> 32))}; dec[c] = CEND[(b * 16 + c) * 8 + h]; }
#pragma unroll
            for (int c = 0; c < 16; ++c) { const size_t idx = ((size_t)((b * 16 + c) * 8 + h) << 13) + pn;
                *(unsigned long long*)(HIN + idx) = (unsigned long long)pk2(hst.x, hst.y) | ((unsigned long long)pk2(hst.z, hst.w) << 32);
                hst = hst * __expf(dec[c]) + tmp[c]; }
        }
            asm volatile("s_waitcnt vmcnt(0) lgkmcnt(0)" ::: "memory"); };
        const bf16* QK = (const bf16*)(ws + L0_QK); const bf16* VZ = (const bf16*)(ws + L0_VZ); const float* KM = (const float*)(ws + WS_KMEAN); bf16* MIX = (bf16*)(ws + L0_MIX);
        float kb0; { float gm = fabsf(A_->in[11][lane]);
#pragma unroll
          for (int o_ = 1; o_ < 64; o_ <<= 1) gm = fmaxf(gm, __shfl_xor(gm, o_));
          kb0 = 8.0f * 1.02f * gm; }
        { int tb = 0, pbh = -1; at2::bf16x8 qpre[4]; f32x4 gpre[12], tpre[4];
          int un_ = 0; const int scan_at = (int)(blockIdx.x & 3);
          for (int i = blockIdx.x; i < 1024; i += G) {
            if (un_ == scan_at) do_scan(); ++un_;
            const int s_ = i >> 8, c = i & 255, bh = ((c & 7) << 4) | (c >> 4), half = (c >> 3) & 1, qb = (s_ & 1) ? (s_ - 1 + half) : (7 - half - s_), b = bh >> 3, h = bh & 7;
            const int in_ = i + G; const bool hn = (in_ < 1024) && ((in_ & 255) == c);
            at2::Tensors TT{QK + h * 64, (const bf16*)(ws + L0_KC) + (size_t)(b * 8 + h) * (32 * 8 * 512), VZ + h * 64, MIX + h * 64, 1024, 0, 1024, 1024};
            const int sn_ = in_ >> 8, hfn = half, qbn = (sn_ & 1) ? (sn_ - 1 + hfn) : (7 - hfn - sn_);
            at2::attn_unit_p<64, true, false, 2>(lds, TT, (long)b * 2048, qb, KM + b * 4096 + h * 64, nullptr, nullptr, kb0, tb, pbh == bh, hn, qbn, qpre, gpre, tpre);
            tb = (tb + 4 * (qb + 1)) % 6; pbh = hn ? bh : -1; } }
    }
    SEAM(3);
    if (IN(4)) { PH_VARS
        LAS float* gnl = (LAS float*)(lds + 150016);
        gnl[tid] = A_->in[9][tid]; __syncthreads();
#define SSDB_UNIT(u_, xr_, pre_, nb_, ng_) ssd::out_unit(lds, (u_) >> 1, (u_) & 1, (const bf16*)(ws + L0_XBC), (const bf16*)(ws + L0_VZ), (const float*)(ws + WS_DTR), A_->in[4], A_->in[5], A_->in[6], A_->in[7], \
                          (const bf16*)(ws + L0_HIN), A_->in[8], gnl, (bf16*)(ws + L0_MIX), xr_, pre_, nb_, ng_)
        { const int u0 = blockIdx.x, u1 = u0 + G;
          if (u0 < 512) { ssd::u32x4 xr[19]; const bool h1 = u1 < 512;
              SSDB_UNIT(u0, xr, false, h1 ? (u1 >> 1) : -1, u1 & 1);
              if (h1) SSDB_UNIT(u1, xr, true, -1, 0); }
          for (int u = u1 + G; u < 512; u += G) { ssd::u32x4 xr2[19]; SSDB_UNIT(u, xr2, false, -1, 0); } }
#undef SSDB_UNIT
    }
    SEAM(4);
    if (IN(5)) { PH_VARS EpiRes<true, false, true> E{nullptr, XN, XN, (unsigned long long*)(ws + WS_SSQA), (LAS float*)(lds + RING_OFF + pg8::STAGE_BYTES)};     run_gemm(lds, (const bf16*)(ws + L0_MIX), (const bf16*)(ws + WS_W_OUT0), T_, 1024, 1024, E); }
    SEAM(5);
#define FFN_PHASES(P, L, AIN, SSQ_IN, LASTL, SSQ_OUT) \
    if (IN(P)) { PH_VARS EpiFfnUp E{(bf16*)(ws + FF_ACT), (bf16*)(ws + FF_UB), (const unsigned long long*)(ws + (SSQ_IN)), (const float*)(ws + WS_CWS) + (size_t)(L) * 4 * DFF2, nullptr}; \
        run_gemm<EpiFfnUp, 3>(lds, (const bf16*)(ws + (AIN)), (const bf16*)(ws + WS_W_UP) + (size_t)(L) * DFF2 * 1024, T_, DFF2, 1024, E); } \
    SEAM(P); \
    if (IN((P) + 1)) { PH_VARS ffn_fix_rows(gt, 256 * 2 * (DFF / 8), NGT, (const bf16*)(ws + FF_UB), (bf16*)(ws + FF_ACT), A_->in[22] + (size_t)(L) * 3 * DFF2, A_->in[23] + (size_t)(L) * DFF2); } \
    SEAM((P) + 1); \
    if (IN((P) + 2)) { PH_VARS EpiRes<true, LASTL, !LASTL> E{out, (const bf16*)(ws + (AIN)), (bf16*)(ws + (AIN)), (unsigned long long*)(ws + (SSQ_OUT)), (LAS float*)(lds + RING_OFF + pg8::STAGE_BYTES)}; run_gemm(lds, (const bf16*)(ws + FF_ACT), (const bf16*)(ws + WS_W_DN) + (size_t)(L) * 1024 * DFF, T_, 1024, DFF, E); } \
    SEAM((P) + 2);
    FFN_PHASES(6, 0, WS_XN, WS_SSQA, false, WS_SSQB)
    if (IN(9)) { PH_VARS EpiMlaIn E{(bf16*)(ws + L1_C1), (const unsigned long long*)(ws + WS_SSQB), (unsigned long long*)(ws + WS_SSQQ), (unsigned long long*)(ws + WS_SSQKV), (float*)(ws + WS_SSQPE), (float*)(ws + WS_RG), A_->in[19], TAB32, (LAS float*)(lds + RING_OFF + pg8::STAGE_BYTES)}; run_gemm(lds, XN, (const bf16*)(ws + WS_W_IN1), T_, 1024, 1024, E); }
    SEAM(9);
    if (IN(10)) { PH_VARS const bf16* C1 = (const bf16*)(ws + L1_C1);
        { EpiScale E{(bf16*)(ws + L1_QR), 1536, (const unsigned long long*)(ws + WS_SSQQ), 1.0f / 512.0f}; run_gemm(lds, C1, (const bf16*)(ws + WS_W_UQ), T_, 1536, 512, E, 1024); }
        { EpiUkv E{(bf16*)(ws + L1_K2), (bf16*)(ws + L1_V2), (const unsigned long long*)(ws + WS_SSQKV), (const float*)(ws + WS_SSQPE), (const float*)(ws + WS_RG), A_->in[19]}; run_gemm(lds, C1 + 512, (const bf16*)(ws + WS_W_UKV), T_, 2048, 256, E, 1024); } }
    SEAM(10);
    if (IN(11)) { PH_VARS
        const bf16* Q2 = (const bf16*)(ws + L1_QR); const bf16* K2 = (const bf16*)(ws + L1_K2); const bf16* V2 = (const bf16*)(ws + L1_V2); bf16* O = (bf16*)(ws + L1_O);
        float kb1; { float gm = fmaxf(fabsf(A_->in[19][lane]), (lane < 32) ? fabsf(A_->in[19][64 + lane]) : 0.f);
#pragma unroll
          for (int o_ = 1; o_ < 64; o_ <<= 1) gm = fmaxf(gm, __shfl_xor(gm, o_));
          kb1 = 9.797958971f * 1.02f * gm; }
        { int tb = 0, pbh = -1; at2::bf16x8 qpre[6]; f32x4 gpre[12], tpre[4];
          for (int i = blockIdx.x; i < 2048; i += G) {
            const int s_ = i >> 8, bh = i & 255, qb = 7 - s_, b = bh >> 4, h = bh & 15;
            const int in_ = i + G; const bool hn = (in_ < 2048) && ((in_ & 255) == bh);
            at2::Tensors TT{Q2 + h * 96, K2 + (size_t)(b * 16 + h) * (32 * 12 * 512), V2 + h * 64, O + h * 64, 1536, 0, 1024, 1024};
            at2::attn_unit_p<96, false, true, 2>(lds, TT, (long)b * 2048, qb, nullptr, A_->in[18], TAB32, kb1, tb, pbh == bh, hn, 7 - (in_ >> 8), qpre, gpre, tpre);
            tb = (tb + 4 * (qb + 1)) % 6; pbh = hn ? bh : -1; } }
    }
    SEAM(11);
    if (IN(12)) { PH_VARS EpiRes<true, false, true> E{nullptr, XN, (bf16*)(ws + WS_BIG), (unsigned long long*)(ws + WS_SSQC), (LAS float*)(lds + RING_OFF + pg8::STAGE_BYTES)}; run_gemm(lds, (const bf16*)(ws + L1_O), (const bf16*)(ws + WS_W_OUT1), T_, 1024, 1024, E); }
    SEAM(12);
    FFN_PHASES(13, 1, WS_BIG, WS_SSQC, true, WS_SSQB)
    if (PROBE_MASK) { if (blockIdx.x == 0 && threadIdx.x == 0) { const unsigned long long t0 = __builtin_amdgcn_s_memrealtime(); while (__builtin_amdgcn_s_memrealtime() - t0 < pr_acc) __builtin_amdgcn_s_sleep(8); } }
#undef IN
#undef SEAM
}
constexpr int LAST_PHASE = 16;

#ifndef MK_ONE_LAUNCH
#define MK_ONE_LAUNCH 1
#endif
extern "C" void kernel_launch(void* const* d_in, const int* in_sizes, int n_in, void* d_out, int out_size, void* d_ws, size_t ws_size, hipStream_t stream) {
    static int grid = 0;
    if (grid == 0) {
        if (n_in != 25 || out_size != T_ * D_ || ws_size < WS_END) { fprintf(stderr, "kernel_launch: unexpected shapes: n_in %d out %d ws %zu\n", n_in, out_size, ws_size); grid = -1; return; }
        if (hipFuncSetAttribute((const void*)fwd, hipFuncAttributeMaxDynamicSharedMemorySize, LDS_BYTES) != hipSuccess) { fprintf(stderr, "kernel_launch: hipFuncSetAttribute failed\n"); grid = -1; return; }
        int dev = 0, cus = 0, per_cu = 0;
        hipGetDevice(&dev); hipDeviceGetAttribute(&cus, hipDeviceAttributeMultiprocessorCount, dev);
        hipOccupancyMaxActiveBlocksPerMultiprocessor(&per_cu, (const void*)fwd, NTHR, LDS_BYTES);
        (void)hipGetLastError();
        grid = (per_cu >= 1) ? cus : -1;
        if (grid < 0) { fprintf(stderr, "kernel_launch: occupancy query says 0 blocks per CU\n"); return; }
    }
    if (grid < 0) return;
    hipMemsetAsync((char*)d_ws + WS_CTL, 0, CTL_ZERO_BYTES, stream);
    Args a{};
    for (int i = 0; i < 25; ++i) a.in[i] = (const float*)d_in[i];
    a.out = (float*)d_out; a.ws = (unsigned char*)d_ws;
#if MK_ONE_LAUNCH
    a.ph_lo = 0; a.ph_hi = LAST_PHASE;
    hipLaunchKernelGGL(fwd, dim3(grid), dim3(NTHR), LDS_BYTES, stream, a);
#else
    for (int p = 0; p < LAST_PHASE; ++p) { a.ph_lo = p; a.ph_hi = p + 1; hipLaunchKernelGGL(fwd, dim3(grid), dim3(NTHR), LDS_BYTES, stream, a); }
#endif
}
```
